# Optimizing an MI355X kernel written in HIP

```python
import math
import jax, jax.numpy as jnp
from jax import lax
import numpy as np

D_MODEL = 2048
BATCH = 4
SEQ = 2048
DEPTH = 2

M_HEADS = 4
M_HEAD_DIM = 256
M_WIDTH = M_HEADS * M_HEAD_DIM
M_CHUNK = 64
M_CONV = 4
A_HEADS = 8
A_HEAD_DIM = 128
A_WIDTH = A_HEADS * A_HEAD_DIM
MOBA_BLOCK = 256
MOBA_TOPK = 3
Q_CHUNK = 16
REL_BUCKETS = 32
REL_MAX_DIST = 128
N_GROUPS = 4
EXP_PER_GROUP = 8
N_EXPERTS = N_GROUPS * EXP_PER_GROUP
TOP_K_IN_GROUP = 2
D_FF_EXPERT = 256
N_BRANCH = 2
RMS_EPS = 1e-6
LN_EPS = 1e-5
IN_COLS = 4 * M_WIDTH + 2 * M_HEADS + 3 * A_WIDTH + N_BRANCH * D_MODEL

kernel_name = 'hybrid_mlstm_moba_hmoe'


def _split_cols(z):
    sizes = (M_WIDTH,) * 4 + (M_HEADS,) * 2 + (A_WIDTH,) * 3 + (D_MODEL,) * N_BRANCH
    idx, acc = [], 0
    for s in sizes[:-1]:
        acc += s
        idx.append(acc)
    return jnp.split(z, idx, axis=-1)


def rms_norm(x, g):
    xf = x.astype(jnp.float32)
    y = xf * lax.rsqrt(jnp.mean(xf * xf, axis=-1, keepdims=True) + RMS_EPS)
    return (y * g.astype(jnp.float32)).astype(x.dtype)


def causal_dwconv(x, w):
    c = x.shape[-1]
    return lax.conv_general_dilated(x, w[:, None, :], window_strides=(1,),
                                    padding=[(M_CONV - 1, 0)],
                                    dimension_numbers=('NWC', 'WIO', 'NWC'),
                                    feature_group_count=c)


def rel_bucket(n):
    n = jnp.maximum(n, 0)
    max_exact = REL_BUCKETS // 2
    nf = jnp.maximum(n, 1).astype(jnp.float32)
    large = max_exact + (jnp.log(nf / max_exact) / math.log(REL_MAX_DIST / max_exact)
                         * (REL_BUCKETS - max_exact)).astype(jnp.int32)
    large = jnp.minimum(large, REL_BUCKETS - 1)
    return jnp.where(n < max_exact, n, large)


def mlstm_chunkwise(q, k, v, ig, fg):
    B, S, H, dh = q.shape
    nc = S // M_CHUNK
    L = M_CHUNK

    def to_chunks(t):
        t = t.astype(jnp.float32).reshape((B, nc, L) + t.shape[2:])
        return jnp.moveaxis(jnp.moveaxis(t, 3, 2), 1, 0)

    qs = to_chunks(q)
    ks = to_chunks(k * (dh ** -0.5))
    vs = to_chunks(v)
    is_ = to_chunks(ig)
    fs = to_chunks(jax.nn.log_sigmoid(fg.astype(jnp.float32)))
    causal = jnp.tril(jnp.ones((L, L), dtype=bool))

    def step(carry, xs):
        C, n, m = carry
        qc, kc, vc, ic, fc = xs
        b = jnp.cumsum(fc, axis=-1)
        dlog = b[..., :, None] - b[..., None, :] + ic[..., None, :]
        dlog = jnp.where(causal, dlog, -jnp.inf)
        inter = b + m[..., None]
        mt = jnp.maximum(inter, jnp.max(dlog, axis=-1))
        dmat = jnp.exp(dlog - mt[..., None])
        wi = jnp.exp(inter - mt)
        s = jnp.einsum('bhtd,bhsd->bhts', qc, kc) * dmat
        num = (jnp.einsum('bhts,bhse->bhte', s, vc)
               + wi[..., None] * jnp.einsum('bhtd,bhde->bhte', qc, C))
        den = jnp.sum(s, axis=-1) + wi * jnp.einsum('bhtd,bhd->bht', qc, n)
        h = num / jnp.maximum(jnp.abs(den), jnp.exp(-mt))[..., None]
        bl = b[..., -1]
        endlog = bl[..., None] - b + ic
        m_new = jnp.maximum(bl + m, jnp.max(endlog, axis=-1))
        ws = jnp.exp(endlog - m_new[..., None])
        decay = jnp.exp(bl + m - m_new)
        wk = ws[..., None] * kc
        C = decay[..., None, None] * C + jnp.einsum('bhsd,bhse->bhde', wk, vc)
        n = decay[..., None] * n + jnp.sum(wk, axis=2)
        return (C, n, m_new), h

    init = (jnp.zeros((B, H, dh, dh), jnp.float32),
            jnp.zeros((B, H, dh), jnp.float32),
            jnp.zeros((B, H), jnp.float32))
    _, hs = lax.scan(step, init, (qs, ks, vs, is_, fs))
    h = jnp.moveaxis(jnp.moveaxis(hs, 0, 1), 2, 3)
    return h.reshape(B, S, H, dh)


def head_layernorm(h, g):
    mu = jnp.mean(h, axis=-1, keepdims=True)
    var = jnp.mean(jnp.square(h - mu), axis=-1, keepdims=True)
    y = (h - mu) * lax.rsqrt(var + LN_EPS)
    B, S, H, dh = h.shape
    return y.reshape(B, S, H * dh) * g.astype(jnp.float32)


def moba_attention(q, k, v, rel_bias):
    B, S, H, dh = q.shape
    f32 = jnp.float32
    nb = -(-S // MOBA_BLOCK)
    s_pad = nb * MOBA_BLOCK
    topk = min(MOBA_TOPK, nb)
    q = jnp.transpose(q, (0, 2, 1, 3)) * (dh ** -0.5)
    pad = ((0, 0), (0, 0), (0, s_pad - S), (0, 0))
    k = jnp.pad(jnp.transpose(k, (0, 2, 1, 3)), pad)
    v = jnp.pad(jnp.transpose(v, (0, 2, 1, 3)), pad)
    kblk = k.reshape(B, H, nb, MOBA_BLOCK, dh)
    vblk = v.reshape(B, H, nb, MOBA_BLOCK, dh)
    kmean = jnp.mean(kblk.astype(f32), axis=3)
    bidx = jnp.arange(B)[:, None, None, None]
    hidx = jnp.arange(H)[None, :, None, None]
    blk_off = jnp.arange(MOBA_BLOCK)
    nsel = topk * MOBA_BLOCK

    def chunk(ci):
        q0 = ci * Q_CHUNK
        qc = lax.dynamic_slice_in_dim(q, q0, Q_CHUNK, axis=2).astype(f32)
        qpos = q0 + jnp.arange(Q_CHUNK)
        own = q0 // MOBA_BLOCK
        gate = jnp.einsum('bhqd,bhnd->bhqn', qc, kmean)
        gate = jnp.where(jnp.arange(nb) < own, gate, -jnp.inf)
        _, idx = lax.top_k(gate, topk)
        valid = jnp.arange(topk) < own
        ksel = kblk[bidx, hidx, idx]
        vsel = vblk[bidx, hidx, idx]
        kpos = idx[..., None] * MOBA_BLOCK + blk_off
        bias_sel = rel_bias[rel_bucket(qpos[:, None, None] - kpos), hidx[..., None]]
        ls = jnp.einsum('bhqd,bhqkjd->bhqkj', qc, ksel.astype(f32)) + bias_sel
        ls = jnp.where(valid[:, None], ls, -jnp.inf)
        kown = lax.dynamic_slice_in_dim(k, own * MOBA_BLOCK, MOBA_BLOCK, axis=2)
        vown = lax.dynamic_slice_in_dim(v, own * MOBA_BLOCK, MOBA_BLOCK, axis=2)
        rel_own = qpos[:, None] - (own * MOBA_BLOCK + blk_off)[None, :]
        bias_own = jnp.transpose(rel_bias[rel_bucket(rel_own)], (2, 0, 1))
        lo = jnp.einsum('bhqd,bhjd->bhqj', qc, kown.astype(f32)) + bias_own
        lo = jnp.where(rel_own >= 0, lo, -jnp.inf)
        logits = jnp.concatenate([ls.reshape(B, H, Q_CHUNK, nsel), lo], axis=-1)
        p = jax.nn.softmax(logits.astype(f32), axis=-1)
        ps = p[..., :nsel].reshape(B, H, Q_CHUNK, topk, MOBA_BLOCK)
        po = p[..., nsel:]
        out = (jnp.einsum('bhqkj,bhqkjd->bhqd', ps, vsel.astype(f32))
               + jnp.einsum('bhqj,bhjd->bhqd', po, vown.astype(f32)))
        return out.astype(q.dtype)

    outs = lax.map(chunk, jnp.arange(S // Q_CHUNK))
    out = jnp.transpose(outs, (1, 2, 0, 3, 4)).reshape(B, H, S, dh)
    return jnp.transpose(out, (0, 2, 1, 3)).reshape(B, S, H * dh)


def hier_moe(h, w_grp, b_grp, w_exp, b_exp, w1, w3, w2):
    B, S, D = h.shape
    f32 = jnp.float32
    t = h.reshape(-1, D)
    pg = jax.nn.softmax((t @ w_grp).astype(f32) + b_grp.astype(f32), axis=-1)
    pg_top, g_sel = lax.top_k(pg, 1)
    el = ((t @ w_exp).astype(f32) + b_exp.astype(f32)).reshape(-1, N_GROUPS, EXP_PER_GROUP)
    el = jnp.take_along_axis(el, g_sel[:, :, None], axis=1)[:, 0]
    pe_top, e_sel = lax.top_k(jax.nn.softmax(el, axis=-1), TOP_K_IN_GROUP)
    w = pg_top * pe_top / jnp.sum(pe_top, axis=-1, keepdims=True)
    eid = g_sel * EXP_PER_GROUP + e_sel
    combine = jnp.sum(jax.nn.one_hot(eid, N_EXPERTS, dtype=f32) * w[..., None], axis=1)
    hid = jax.nn.silu(jnp.einsum('td,edf->tef', t, w1)) * jnp.einsum('td,edf->tef', t, w3)
    hid = hid * combine[..., None].astype(hid.dtype)
    out = jnp.einsum('tef,efd->td', hid, w2)
    return out.reshape(B, S, D).astype(h.dtype)


def hybrid_layer(x, norm1_g, w_in, conv_w, if_bias, mnorm_g, w_branch_m, w_branch_a,
                 w_out, rel_bias, norm2_g, w_grp, b_grp, w_exp, b_exp, w1, w3, w2):
    B, S, _ = x.shape
    h = rms_norm(x, norm1_g)
    z = h @ w_in
    qm, km, vm, om, im, fm, qa, ka, va, gm, ga = _split_cols(z)
    qk = jax.nn.silu(causal_dwconv(jnp.concatenate([qm, km], axis=-1), conv_w))
    qm, km = qk[..., :M_WIDTH], qk[..., M_WIDTH:]
    heads_m = lambda t: t.reshape(B, S, M_HEADS, M_HEAD_DIM)
    ig = im + if_bias[:M_HEADS]
    fg = fm + if_bias[M_HEADS:]
    hm = mlstm_chunkwise(heads_m(qm), heads_m(km), heads_m(vm), ig, fg)
    hm = (jax.nn.sigmoid(om.astype(jnp.float32)) * head_layernorm(hm, mnorm_g)).astype(x.dtype)
    heads_a = lambda t: t.reshape(B, S, A_HEADS, A_HEAD_DIM)
    ha = moba_attention(heads_a(qa), heads_a(ka), heads_a(va), rel_bias)
    y = jax.nn.sigmoid(gm) * (hm @ w_branch_m) + jax.nn.sigmoid(ga) * (ha @ w_branch_a)
    x = x + y @ w_out
    x = x + hier_moe(rms_norm(x, norm2_g), w_grp, b_grp, w_exp, b_exp, w1, w3, w2)
    return x


def setup_inputs(seed: int = 0) -> dict:
    key = jax.random.key(seed)
    ks = jax.random.split(key, 20)
    f32 = jnp.float32

    def nrm(k, shape, scale):
        return jax.random.normal(k, shape, f32) * scale

    i_bias = nrm(ks[4], (DEPTH, M_HEADS), 0.1)
    f_bias = jnp.linspace(3.0, 6.0, M_HEADS, dtype=f32)[None, :] + nrm(ks[5], (DEPTH, M_HEADS), 0.1)
    return {
        'x': nrm(ks[0], (BATCH, SEQ, D_MODEL), 1.0),
        'norm1_g': 1.0 + nrm(ks[1], (DEPTH, D_MODEL), 0.02),
        'w_in': nrm(ks[2], (DEPTH, D_MODEL, IN_COLS), D_MODEL ** -0.5),
        'conv_w': nrm(ks[3], (DEPTH, M_CONV, 2 * M_WIDTH), M_CONV ** -0.5),
        'if_bias': jnp.concatenate([i_bias, f_bias], axis=-1),
        'mnorm_g': 1.0 + nrm(ks[6], (DEPTH, M_WIDTH), 0.02),
        'w_branch_m': nrm(ks[7], (DEPTH, M_WIDTH, D_MODEL), M_WIDTH ** -0.5),
        'w_branch_a': nrm(ks[8], (DEPTH, A_WIDTH, D_MODEL), A_WIDTH ** -0.5),
        'w_out': nrm(ks[9], (DEPTH, D_MODEL, D_MODEL), D_MODEL ** -0.5),
        'rel_bias': nrm(ks[10], (REL_BUCKETS, A_HEADS), 0.5),
        'norm2_g': 1.0 + nrm(ks[11], (DEPTH, D_MODEL), 0.02),
        'w_grp': nrm(ks[12], (DEPTH, D_MODEL, N_GROUPS), D_MODEL ** -0.5),
        'b_grp': nrm(ks[13], (DEPTH, N_GROUPS), 0.01),
        'w_exp': nrm(ks[14], (DEPTH, D_MODEL, N_EXPERTS), D_MODEL ** -0.5),
        'b_exp': nrm(ks[15], (DEPTH, N_EXPERTS), 0.01),
        'w1': nrm(ks[16], (DEPTH, N_EXPERTS, D_MODEL, D_FF_EXPERT), D_MODEL ** -0.5),
        'w3': nrm(ks[17], (DEPTH, N_EXPERTS, D_MODEL, D_FF_EXPERT), D_MODEL ** -0.5),
        'w2': nrm(ks[18], (DEPTH, N_EXPERTS, D_FF_EXPERT, D_MODEL), D_FF_EXPERT ** -0.5),
        'final_g': 1.0 + nrm(ks[19], (D_MODEL,), 0.02),
    }


def reference(x, norm1_g, w_in, conv_w, if_bias, mnorm_g, w_branch_m, w_branch_a, w_out,
              rel_bias, norm2_g, w_grp, b_grp, w_exp, b_exp, w1, w3, w2, final_g):
    for l in range(DEPTH):
        x = hybrid_layer(x, norm1_g[l], w_in[l], conv_w[l], if_bias[l], mnorm_g[l],
                         w_branch_m[l], w_branch_a[l], w_out[l], rel_bias, norm2_g[l],
                         w_grp[l], b_grp[l], w_exp[l], b_exp[l], w1[l], w3[l], w2[l])
    return rms_norm(x, final_g)
```

```cpp
#define DBLMASK 0u
#include <hip/hip_runtime.h>
#include <stdint.h>
#include <stdio.h>

#ifndef MK_LAUNCHES
#define MK_LAUNCHES 1
#endif

#define GAS __attribute__((address_space(1)))
#define LAS __attribute__((address_space(3)))
typedef unsigned short bf16;
typedef short bf16x8 __attribute__((ext_vector_type(8)));
typedef short bf16x4 __attribute__((ext_vector_type(4)));
typedef float f32x4 __attribute__((ext_vector_type(4)));
typedef unsigned u32x4 __attribute__((ext_vector_type(4)));
typedef unsigned u32x2 __attribute__((ext_vector_type(2)));

constexpr int NTOK = 8192, DM = 2048, SEQ = 2048, NBATCH = 4;
constexpr int INCOLS = 11272;
constexpr int NWAVES = 8, NTHR = 512;
constexpr float RMS_EPS = 1e-6f, LN_EPS = 1e-5f;
constexpr int MPAD = 24576;

constexpr size_t MiB = 1u << 20;
constexpr size_t WS_CTL = 0, CTL_ZERO_BYTES = 1 * MiB;
constexpr size_t WS_MISC = 1 * MiB;
constexpr size_t MS_WIF = WS_MISC + 0;
constexpr size_t MS_WRT = WS_MISC + 256 * 1024;
constexpr size_t MS_IFG = WS_MISC + 1 * MiB;
constexpr size_t MS_KMEAN = MS_IFG + 256 * 1024;
constexpr size_t MS_AS = WS_MISC + 1536 * 1024;
constexpr size_t MS_GT = MS_AS + 128 * 1024;
constexpr size_t MS_WI = MS_GT + 128 * 1024;
constexpr size_t MS_CL = MS_WI + 128 * 1024;
constexpr size_t MS_WS = MS_CL + 128 * 1024;
constexpr size_t MS_DEC = MS_WS + 128 * 1024;
constexpr size_t MS_NST = WS_MISC + 2560 * 1024;
constexpr size_t MS_TOKE = WS_MISC + 3 * MiB;
constexpr size_t MS_TOKP = MS_TOKE + 64 * 1024;
constexpr size_t MS_TOKW = MS_TOKE + 128 * 1024;
constexpr size_t MS_LIST = WS_MISC + 4 * MiB;
constexpr size_t MS_PWL = WS_MISC + 5 * MiB;
constexpr size_t MS_NVEC = WS_MISC + 6 * MiB;
constexpr size_t WS_WINT = 16 * MiB;
constexpr size_t WS_WBM = 104 * MiB;
constexpr size_t WS_WBA = 112 * MiB;
constexpr size_t WS_WOUT = 120 * MiB;
constexpr size_t WS_W13 = 136 * MiB;
constexpr size_t WS_W2 = 264 * MiB;
constexpr size_t WS_H = 328 * MiB;
constexpr size_t WS_R = 360 * MiB;
constexpr size_t WS_ZQK = WS_R;
constexpr size_t WS_HM = WS_R, WS_HA = WS_R + 16 * MiB;
constexpr size_t WS_VMT = WS_R + 32 * MiB;
constexpr size_t WS_OM = WS_R + 48 * MiB;
constexpr size_t WS_QA = WS_R + 64 * MiB, WS_KA = WS_R + 80 * MiB;
constexpr size_t WS_Y = WS_QA;
constexpr size_t WS_VAT = WS_R + 96 * MiB;
constexpr size_t WS_SG = WS_R + 112 * MiB;
constexpr size_t WS_QM = WS_R + 176 * MiB, WS_KM = WS_R + 192 * MiB, WS_KMT = WS_R + 208 * MiB;
constexpr size_t WS_CST = WS_R + 224 * MiB;
constexpr size_t WS_HID = WS_R;
constexpr size_t WS_OP = WS_R + 16 * MiB;
constexpr size_t WS_END = 648 * MiB;
constexpr int CW_BAR = 4096;
constexpr int CW_CNT = 8192;

constexpr int RING_BYTES = 131072;
constexpr int MISC_OFF = 139264;
constexpr int LDS_BYTES = 147456;
constexpr int MO_BAR = 0, MO_CNT = 64, MO_NT = 64 + 128, MO_OFF = 64 + 256, MO_TE = 64 + 512, MO_TR0 = 64 + 1024, MO_MT = 64 + 1536, MO_LOG = 2048;

#define LDS_WAIT() asm volatile("s_waitcnt lgkmcnt(0)" ::: "memory")
#define VM_WAIT() asm volatile("s_waitcnt vmcnt(0)" ::: "memory")

__device__ __forceinline__ float bf2f(unsigned short b) { return __builtin_bit_cast(float, (unsigned)b << 16); }
__device__ __forceinline__ float bflo(unsigned u) { return __builtin_bit_cast(float, u << 16); }
__device__ __forceinline__ float bfhi(unsigned u) { return __builtin_bit_cast(float, u & 0xffff0000u); }
typedef __bf16 bf16x2v __attribute__((ext_vector_type(2)));
typedef float f32x2v __attribute__((ext_vector_type(2)));
__device__ __forceinline__ unsigned cvt_pk_bf16(float lo, float hi) { const f32x2v f = {lo, hi}; const bf16x2v b = __builtin_convertvector(f, bf16x2v); return __builtin_bit_cast(unsigned, b); }
__device__ __forceinline__ float wave_sum(float v) {
#pragma unroll
    for (int o = 1; o < 64; o <<= 1) v += __shfl_xor(v, o);
    return v;
}
__device__ __forceinline__ float rows4_max(float x) { x = fmaxf(x, __shfl_xor(x, 16)); return fmaxf(x, __shfl_xor(x, 32)); }
__device__ __forceinline__ float rows4_sum(float x) { x += __shfl_xor(x, 16); return x + __shfl_xor(x, 32); }
__device__ __forceinline__ int lane_id() { int l; asm volatile("v_mbcnt_lo_u32_b32 %0, -1, 0\n\tv_mbcnt_hi_u32_b32 %0, -1, %0" : "=v"(l)); return l; }
__device__ __forceinline__ float sigmoidf_(float x) { return __builtin_amdgcn_rcpf(1.f + __expf(-x)); }

namespace pg8 {
constexpr int BM = 256, BK = 64, HALF = 128, HTB = HALF * BK * 2, STAGE_BYTES = 8 * HTB, NXCD = 8, WGM = 8;
__device__ __forceinline__ int lds_byte(int r, int c) { const int st = (r >> 4) * 2 + (c >> 5), rr = r & 15, cc = c & 31, ob = rr * 64 + cc * 2; return st * 1024 + (ob ^ (((ob >> 9) & 1) << 5)); }
__device__ __forceinline__ void stage_rc(int b, int& R, int& C) { const int st = b / 1024, sb = b % 1024, swz = sb ^ (((sb >> 9) & 1) << 5); R = (st >> 1) * 16 + swz / 64; C = (st & 1) * 32 + (swz % 64) / 2; }
__device__ __forceinline__ int perm32(int rho) { const int n = rho >> 4, i = rho & 15; return 8 * (i >> 2) + 4 * n + (i & 3); }
struct Unit { int pm, pn, aux; };

__device__ __forceinline__ void static_tile(int L, int nM, int nN, int& pm, int& pn) {
    const int nwg = nM * nN; int wgid = L;
    { const int q = nwg / NXCD, r = nwg % NXCD, xcd = wgid % NXCD, off = wgid / NXCD; wgid = (xcd < r ? xcd * (q + 1) : r * (q + 1) + (xcd - r) * q) + off; }
    const int nig = WGM * nN, gid = wgid / nig, fm = gid * WGM, gsz = (nM - fm) < WGM ? (nM - fm) : WGM;
    pm = fm + ((wgid % nig) % gsz); pn = (wgid % nig) / gsz;
}

template <class Epi, class Sched>
__device__ __forceinline__ void gemm_phase(LAS unsigned char* lds, const int K, const Sched& S, const Epi& E, const int wave0) {
    int tid_ = wave0 * 64 + lane_id(); asm volatile("" : "+v"(tid_));
    const int tid = tid_, wid = __builtin_amdgcn_readfirstlane(tid >> 6), lane = tid & 63, wr = wid >> 2, wc = wid & 3, fr = lane & 15, fq = lane >> 4;
    const int nt = K / BK;
    int RA[2], CA[2]; unsigned voffB[2];
#pragma unroll
    for (int i = 0; i < 2; ++i) { int R, C; stage_rc(tid * 16 + i * 8192, R, C); const int Rb = Epi::PERM ? ((R & ~31) + perm32(R & 31)) : R;
        RA[i] = R; CA[i] = C; voffB[i] = (unsigned)(Rb * K + C) * 2u; }
    const size_t kstep = (size_t)(BK * 2);
    const size_t hstep = (size_t)HALF * K * 2;
    const unsigned ldsw = (unsigned)wid * 1024u;
    const int aoff = lds_byte(wr * 64 + fr, fq * 8), boff = lds_byte(wc * 32 + fr, fq * 8);
#define PG8_SA(b, h) (((b) * 2 + (h)) * HTB)
#define PG8_SB(b, h) ((4 + (b) * 2 + (h)) * HTB)
#define PG8_STAGE(bufoff, gbase, v0, v1) do { \
        __builtin_amdgcn_global_load_lds((const unsigned*)((const char*)(gbase) + (v0)), (LAS unsigned*)(lds + (bufoff) + ldsw), 16, 0, 0); \
        __builtin_amdgcn_global_load_lds((const unsigned*)((const char*)(gbase) + (v1)), (LAS unsigned*)(lds + (bufoff) + ldsw + 8192), 16, 0, 0); } while (0)
#define PG8_STAGE_B(bufoff, gbase) PG8_STAGE(bufoff, gbase, voffB[0], voffB[1])
#define PG8_STAGE_A(bufoff, gbase, VO, h) PG8_STAGE(bufoff, gbase, VO[h][0], VO[h][1])
#define PG8_STAGE_A2(bufoff, gbase, h) do { if (Sched::GATHER && last) { PG8_STAGE_A(bufoff, gbase, vn, h); } else { PG8_STAGE_A(bufoff, gbase, vc, h); } } while (0)
#define PG8_LDA(dst, b, h) do { _Pragma("unroll") for (int m = 0; m < 4; ++m) _Pragma("unroll") for (int k = 0; k < 2; ++k) dst[m][k] = *(const LAS bf16x8*)(lds + PG8_SA(b, h) + aoff + m * 2048 + k * 1024); } while (0)
#define PG8_LDB(dst, b, h) do { _Pragma("unroll") for (int n = 0; n < 2; ++n) _Pragma("unroll") for (int k = 0; k < 2; ++k) dst[n][k] = *(const LAS bf16x8*)(lds + PG8_SB(b, h) + boff + n * 2048 + k * 1024); } while (0)
#define PG8_MMA(ai, bj, At, Bt) do { __builtin_amdgcn_s_setprio(1); _Pragma("unroll") for (int m = 0; m < 4; ++m) _Pragma("unroll") for (int n = 0; n < 2; ++n) _Pragma("unroll") for (int k = 0; k < 2; ++k) \
        acc[ai][bj][m][n] = __builtin_amdgcn_mfma_f32_16x16x32_bf16(Bt[n][k], At[m][k], acc[ai][bj][m][n], 0, 0, 0); __builtin_amdgcn_s_setprio(0); } while (0)
#define PG8_WAIT_V(n) asm volatile("s_waitcnt vmcnt(" #n ")" ::: "memory")
#define PG8_WAIT_L(n) asm volatile("s_waitcnt lgkmcnt(" #n ")" ::: "memory")
#define PG8_BAR __builtin_amdgcn_s_barrier()
#define PG8_SCHED __builtin_amdgcn_sched_barrier(0)
    Unit cur, nxt; int ui = 0;
    if (!S.next(0, cur)) return;
    f32x4 acc[2][2][4][2];
#pragma unroll
    for (int a = 0; a < 2; ++a)
#pragma unroll
        for (int b = 0; b < 2; ++b)
#pragma unroll
            for (int m = 0; m < 4; ++m)
#pragma unroll
                for (int n = 0; n < 2; ++n) acc[a][b][m][n] = (f32x4){0.f, 0.f, 0.f, 0.f};
    bf16x8 At[4][2], B0[2][2], B1[2][2];
    unsigned vc[2][2], vn[2][2];
#pragma unroll
    for (int h = 0; h < 2; ++h)
#pragma unroll
        for (int i = 0; i < 2; ++i) {
            if constexpr (Sched::GATHER) vc[h][i] = (unsigned)(S.arow(cur, h * HALF + RA[i]) * (unsigned)K + (unsigned)CA[i]) * 2u;
            else vc[h][i] = (unsigned)((h * HALF + RA[i]) * K + CA[i]) * 2u;
            vn[h][i] = vc[h][i];
        }
    const char* cA = S.abase(cur); const char* cB = S.bbase(cur);
    PG8_STAGE_B(PG8_SB(0, 0), cB); PG8_STAGE_A(PG8_SA(0, 0), cA, vc, 0); PG8_STAGE_B(PG8_SB(0, 1), cB + hstep); PG8_STAGE_A(PG8_SA(0, 1), cA, vc, 1);
    if (wr == 1) PG8_BAR;
    PG8_WAIT_V(4); PG8_BAR;
    PG8_STAGE_B(PG8_SB(1, 0), cB + kstep); PG8_STAGE_A(PG8_SA(1, 0), cA + kstep, vc, 0); PG8_STAGE_B(PG8_SB(1, 1), cB + hstep + kstep);
    PG8_WAIT_V(6); PG8_BAR;
    for (;;) {
        const bool has_next = S.next(ui + 1, nxt);
        const char* nA = has_next ? S.abase(nxt) : cA; const char* nB = has_next ? S.bbase(nxt) : cB;
        if constexpr (Sched::GATHER) {
            if (has_next) {
                int t2 = wave0 * 64 + lane_id(); asm volatile("" : "+v"(t2));
#pragma unroll
                for (int i = 0; i < 2; ++i) { int R, C; stage_rc(t2 * 16 + i * 8192, R, C);
#pragma unroll
                    for (int h = 0; h < 2; ++h) vn[h][i] = (unsigned)(S.arow(nxt, h * HALF + R) * (unsigned)K + (unsigned)C) * 2u; }
            }
        }
#pragma unroll 1
        for (int t = 0; t < nt; t += 2) {
            const bool last = (t == nt - 2);
            const char* a1 = cA + (size_t)(t + 1) * kstep;
            const char* a2 = last ? nA : cA + (size_t)(t + 2) * kstep; const char* b2 = last ? nB : cB + (size_t)(t + 2) * kstep;
            const char* a3 = a2 + kstep; const char* b3 = b2 + kstep;
            PG8_LDB(B0, 0, 0); PG8_SCHED; PG8_LDA(At, 0, 0); PG8_STAGE_A(PG8_SA(1, 1), a1, vc, 1);
            PG8_WAIT_L(8); PG8_BAR; PG8_WAIT_L(0); PG8_MMA(0, 0, At, B0); PG8_BAR; PG8_SCHED;
            PG8_LDB(B1, 0, 1); PG8_STAGE_B(PG8_SB(0, 0), b2);
            PG8_BAR; PG8_WAIT_L(0); PG8_MMA(0, 1, At, B1); PG8_BAR;
            PG8_LDA(At, 0, 1); PG8_STAGE_A2(PG8_SA(0, 0), a2, 0);
            PG8_BAR; PG8_WAIT_L(0); PG8_MMA(1, 0, At, B0); PG8_BAR; PG8_SCHED;
            PG8_STAGE_B(PG8_SB(0, 1), b2 + hstep);
            PG8_WAIT_V(6); PG8_BAR; PG8_MMA(1, 1, At, B1); PG8_BAR;
            PG8_LDB(B0, 1, 0); PG8_SCHED; PG8_LDA(At, 1, 0); PG8_STAGE_A2(PG8_SA(0, 1), a2, 1);
            PG8_WAIT_L(8); PG8_BAR; PG8_WAIT_L(0); PG8_MMA(0, 0, At, B0); PG8_BAR; PG8_SCHED;
            PG8_LDB(B1, 1, 1); PG8_STAGE_B(PG8_SB(1, 0), b3);
            PG8_BAR; PG8_WAIT_L(0); PG8_MMA(0, 1, At, B1); PG8_BAR;
            PG8_LDA(At, 1, 1); PG8_STAGE_A2(PG8_SA(1, 0), a3, 0);
            PG8_BAR; PG8_WAIT_L(0); PG8_MMA(1, 0, At, B0); PG8_BAR; PG8_SCHED;
            PG8_STAGE_B(PG8_SB(1, 1), b3 + hstep);
            PG8_WAIT_V(6); PG8_BAR; PG8_MMA(1, 1, At, B1); PG8_BAR;
        }
        { const int lz = lane_id(); E(acc, cur, wr, wc, lz & 15, lz >> 4); }
        if (!has_next) break;
        if (!Sched::keep_acc(cur)) {
#pragma unroll
        for (int a = 0; a < 2; ++a)
#pragma unroll
            for (int b = 0; b < 2; ++b)
#pragma unroll
                for (int m = 0; m < 4; ++m)
#pragma unroll
                    for (int n = 0; n < 2; ++n) acc[a][b][m][n] = (f32x4){0.f, 0.f, 0.f, 0.f};
        }
        cur = nxt; cA = nA; cB = nB; ++ui;
        if constexpr (Sched::GATHER) {
#pragma unroll
            for (int h = 0; h < 2; ++h)
#pragma unroll
                for (int i = 0; i < 2; ++i) vc[h][i] = vn[h][i];
        }
    }
    PG8_WAIT_V(0);
    if (wr == 0) PG8_BAR;
    PG8_BAR;
#undef PG8_SA
#undef PG8_SB
#undef PG8_STAGE
#undef PG8_STAGE_A
#undef PG8_STAGE_A2
#undef PG8_STAGE_B
#undef PG8_LDA
#undef PG8_LDB
#undef PG8_MMA
#undef PG8_WAIT_V
#undef PG8_WAIT_L
#undef PG8_BAR
#undef PG8_SCHED
}
}
using pg8::Unit;

#define XB_TMO      128
#define XB_XCNT(j)  (256  + 64 * (j))
#define XB_XSUB(j)  (1280 + 64 * (j))
#define XB_XGEN(j)  (2304 + 64 * (j))
#define XB_TOP      3328
#define XB_TOPGEN   3392
#define XCD_BAR_WORDS 3456
#define XB_SPIN_CAP (1u << 18)
__device__ __forceinline__ unsigned xb_ld(unsigned* p)              { return __hip_atomic_load(p, __ATOMIC_RELAXED, __HIP_MEMORY_SCOPE_AGENT); }
__device__ __forceinline__ unsigned xb_add(unsigned* p, unsigned v) { return __hip_atomic_fetch_add(p, v, __ATOMIC_RELAXED, __HIP_MEMORY_SCOPE_AGENT); }
__device__ __forceinline__ unsigned xb_xcc_id() { return (unsigned)__builtin_amdgcn_s_getreg((3 << 11) | 20) & 0xFu; }
#define XB_SPIN(cond, bar) do { unsigned _sp = 0; while (cond) { __builtin_amdgcn_s_sleep(1); \
    if ((++_sp & 255u) == 0u) { if (xb_ld(&(bar)[XB_TMO])) break; if (_sp > XB_SPIN_CAP) { atomicAdd(&(bar)[XB_TMO], 1u); break; } } } } while (0)
struct XcdBarrier { unsigned* bar; unsigned x; volatile LAS unsigned* st; };
__device__ __forceinline__ XcdBarrier xcd_barrier_post(unsigned* bar, volatile LAS unsigned* st) {
    XcdBarrier b; b.bar = bar; b.x = xb_xcc_id(); b.st = st;
    if (threadIdx.x == 0) (void)xb_add(&bar[XB_XCNT(b.x)], 1u);
    return b;
}
__device__ __forceinline__ void xcd_barrier_complete(unsigned* bar, unsigned x, unsigned& nloc, unsigned& nx) {
    const unsigned G = gridDim.x * gridDim.y * gridDim.z;
    unsigned sum, cnt, mine, sp = 0u;
    for (;;) {
        sum = 0u; cnt = 0u; mine = 0u;
#pragma unroll
        for (unsigned j = 0; j < 16; ++j) { const unsigned c = xb_ld(&bar[XB_XCNT(j)]); sum += c; cnt += (c > 0u) ? 1u : 0u; mine = (j == x) ? c : mine; }
        if (sum == G) break;
        __builtin_amdgcn_s_sleep(1);
        if ((++sp & 255u) == 0u) { if (xb_ld(&bar[XB_TMO])) break; if (sp > XB_SPIN_CAP) { atomicAdd(&bar[XB_TMO], 1u); break; } }
    }
    nloc = mine > 0u ? mine : 1u; nx = cnt > 0u ? cnt : 1u;
}
__device__ __forceinline__ void xcd_barrier(const XcdBarrier& b) {
    asm volatile("s_waitcnt vmcnt(0)" ::: "memory");
    __syncthreads();
    if (threadIdx.x == 0) {
        unsigned* bar = b.bar;
        __builtin_amdgcn_s_waitcnt(0);
        unsigned nloc = b.st[0], nx = b.st[1];
        if (nloc == 0u) { xcd_barrier_complete(bar, b.x, nloc, nx); b.st[0] = nloc; b.st[1] = nx; }
        const unsigned old = xb_add(&bar[XB_XSUB(b.x)], 1u);
        const unsigned gen = old / nloc;
        if (old + 1u == (gen + 1u) * nloc) {
            __builtin_amdgcn_fence(__ATOMIC_RELEASE, "agent");
            asm volatile("s_waitcnt vmcnt(0)" ::: "memory");
            const unsigned og = xb_add(&bar[XB_TOP], 1u);
            const unsigned tg = og / nx;
            if (og + 1u == (tg + 1u) * nx) xb_add(&bar[XB_TOPGEN], 1u);
            else XB_SPIN(xb_ld(&bar[XB_TOPGEN]) == tg, bar);
            __builtin_amdgcn_fence(__ATOMIC_ACQUIRE, "agent");
            xb_add(&bar[XB_XGEN(b.x)], 1u);
            asm volatile("s_waitcnt vmcnt(0)" ::: "memory");
        } else {
            XB_SPIN(xb_ld(&bar[XB_XGEN(b.x)]) == gen, bar);
            __builtin_amdgcn_fence(__ATOMIC_ACQUIRE, "agent");
            asm volatile("s_waitcnt vmcnt(0)" ::: "memory");
        }
    }
    __syncthreads();
}

struct Args { const float* in[19]; float* out; unsigned char* ws; int ph_lo, ph_hi; };
typedef const __attribute__((address_space(4))) Args* ArgsP;
enum { I_X = 0, I_N1G, I_WIN, I_CONVW, I_IFB, I_MNG, I_WBM, I_WBA, I_WOUT, I_RELB, I_N2G, I_WGRP, I_BGRP, I_WEXP, I_BEXP, I_W1, I_W3, I_W2, I_FG };


struct TrDesc { const float* W; bf16* WT; size_t ldn, ldk; int k0, n0, r0; };
__device__ __forceinline__ void tr_load(const TrDesc& d, f32x4 (&tv)[16], int lane) {
    const int nn4 = (lane & 15) * 4, kr = lane >> 4;
#pragma unroll
    for (int i = 0; i < 16; ++i) tv[i] = __builtin_nontemporal_load((const f32x4*)(d.W + (size_t)(d.k0 + 4 * i + kr) * d.ldn + d.n0 + nn4));
}
__device__ __forceinline__ void tr_finish(const TrDesc& d, f32x4 (&tv)[16], LAS float* scr, int lane) {
    const int nn4 = (lane & 15) * 4, kr = lane >> 4;
#pragma unroll
    for (int i = 0; i < 16; i += 4) asm volatile("" : "+v"(tv[i]), "+v"(tv[i + 1]), "+v"(tv[i + 2]), "+v"(tv[i + 3]));
#pragma unroll
    for (int i = 0; i < 16; ++i) { const int kk = 4 * i + kr; const f32x4 v = tv[i];
        LAS float* q = scr + kk * 65 + nn4; q[0] = v.x; q[1] = v.y; q[2] = v.z; q[3] = v.w; }
    LDS_WAIT();
    const int kc = (lane & 7) * 8;
#pragma unroll
    for (int p = 0; p < 8; ++p) { const int nn = 8 * p + (lane >> 3); const LAS float* sp = scr + kc * 65 + nn;
        u32x4 o; o.x = cvt_pk_bf16(sp[0], sp[65]); o.y = cvt_pk_bf16(sp[130], sp[195]); o.z = cvt_pk_bf16(sp[260], sp[325]); o.w = cvt_pk_bf16(sp[390], sp[455]);
        *(u32x4*)(d.WT + (size_t)(d.r0 + nn) * d.ldk + d.k0 + kc) = o; }
    LDS_WAIT();
}
__device__ __forceinline__ int win_src_col(int r) {
    if (r < 2048) return r;
    if (r < 3072) return r + 1024;
    if (r < 5120) return r + 1032;
    if (r < 9216) return r + 2056;
    if (r < 10240) return r - 7168;
    return r - 4088;
}
__device__ __forceinline__ TrDesc tr_decode(ArgsP a, unsigned char* ws, int it) {
    constexpr int PER_LAYER = 5632 + 512 + 512 + 1024 + 4096 + 4096 + 4096;
    const int l = it / PER_LAYER; int r = it % PER_LAYER;
    TrDesc d;
    if (r < 5632) { const int kb = r / 176, ng = r % 176;
        d.W = a->in[I_WIN] + (size_t)l * DM * INCOLS; d.ldn = INCOLS; d.k0 = 64 * kb; d.n0 = win_src_col(64 * ng); d.WT = (bf16*)(ws + WS_WINT) + (size_t)l * 11264 * 2048; d.ldk = 2048; d.r0 = 64 * ng; return d; }
    r -= 5632;
    if (r < 512) { const int kb = r / 32, ng = r % 32;
        d.W = a->in[I_WBM] + (size_t)l * 1024 * 2048; d.ldn = 2048; d.k0 = 64 * kb; d.n0 = 64 * ng; d.WT = (bf16*)(ws + WS_WBM) + (size_t)l * 2048 * 1024; d.ldk = 1024; d.r0 = 64 * ng; return d; }
    r -= 512;
    if (r < 512) { const int kb = r / 32, ng = r % 32;
        d.W = a->in[I_WBA] + (size_t)l * 1024 * 2048; d.ldn = 2048; d.k0 = 64 * kb; d.n0 = 64 * ng; d.WT = (bf16*)(ws + WS_WBA) + (size_t)l * 2048 * 1024; d.ldk = 1024; d.r0 = 64 * ng; return d; }
    r -= 512;
    if (r < 1024) { const int kb = r / 32, ng = r % 32;
        d.W = a->in[I_WOUT] + (size_t)l * 2048 * 2048; d.ldn = 2048; d.k0 = 64 * kb; d.n0 = 64 * ng; d.WT = (bf16*)(ws + WS_WOUT) + (size_t)l * 2048 * 2048; d.ldk = 2048; d.r0 = 64 * ng; return d; }
    r -= 1024;
    if (r < 8192) { const int w3 = r >= 4096; const int q = r & 4095; const int e = q >> 7, rr = q & 127, kb = rr >> 2, ng = rr & 3;
        d.W = a->in[w3 ? I_W3 : I_W1] + (size_t)(l * 32 + e) * 2048 * 256; d.ldn = 256; d.k0 = 64 * kb; d.n0 = 64 * ng;
        d.WT = (bf16*)(ws + WS_W13) + (size_t)(l * 32 + e) * 512 * 2048; d.ldk = 2048; d.r0 = 256 * (ng >> 1) + 64 * (ng & 1) + (w3 ? 128 : 0); return d; }
    r -= 8192;
    { const int e = r >> 7, rr = r & 127, kb = rr >> 5, ng = rr & 31;
        d.W = a->in[I_W2] + (size_t)(l * 32 + e) * 256 * 2048; d.ldn = 2048; d.k0 = 64 * kb; d.n0 = 64 * ng; d.WT = (bf16*)(ws + WS_W2) + (size_t)(l * 32 + e) * 2048 * 256; d.ldk = 256; d.r0 = 64 * ng; return d; }
}
__device__ __forceinline__ void prologue_phase(ArgsP a, LAS unsigned char* lds, int tid, int lane, int wave, int bid, int G, const int part = 0) {
    unsigned char* ws = a->ws;
    LAS float* scr = (LAS float*)(lds + wave * 16640);
    const int gw = bid * NWAVES + wave, NGW = G * NWAVES;
    constexpr int PER_LAYER = 5632 + 512 + 512 + 1024 + 4096 + 4096 + 4096;
    const int it_lo = part == 0 ? 0 : part == 1 ? PER_LAYER : part == 2 ? 5632 : PER_LAYER + 5632;
    const int it_hi = part == 0 ? 5632 : part == 1 ? PER_LAYER + 5632 : part == 2 ? PER_LAYER : 2 * PER_LAYER;
    f32x4 tvA[16], tvB[16]; TrDesc dA, dB;
    int it = it_lo + gw;
    if (it < it_hi) { dA = tr_decode(a, ws, it); tr_load(dA, tvA, lane); }
#pragma unroll 1
    while (it < it_hi) {
        int itn = it + NGW;
        if (itn < it_hi) { dB = tr_decode(a, ws, itn); tr_load(dB, tvB, lane); }
        tr_finish(dA, tvA, scr, lane);
        it = itn; if (it >= it_hi) break;
        itn = it + NGW;
        if (itn < it_hi) { dA = tr_decode(a, ws, itn); tr_load(dA, tvA, lane); }
        tr_finish(dB, tvB, scr, lane);
        it = itn;
    }
    if (part != 0) return;
    const int gt = bid * NTHR + tid, NGT = G * NTHR;
    float* wrt = (float*)(ws + MS_WRT);
    for (int i = gt; i < 2 * 36 * 2048; i += NGT) { const int l = i / (36 * 2048), rr = i % (36 * 2048), n = rr >> 11, k = rr & 2047;
        wrt[i] = n < 4 ? a->in[I_WGRP][((size_t)l * DM + k) * 4 + n] : a->in[I_WEXP][((size_t)l * DM + k) * 32 + (n - 4)]; }
}

__device__ __forceinline__ void moe_tables(unsigned char* ws, int l, LAS unsigned char* misc, int tid) {
    LAS int* cnt = (LAS int*)(misc + MO_CNT); LAS int* ntl = (LAS int*)(misc + MO_NT); LAS int* off = (LAS int*)(misc + MO_OFF);
    LAS int* te = (LAS int*)(misc + MO_TE); LAS int* tr0 = (LAS int*)(misc + MO_TR0); LAS int* mt = (LAS int*)(misc + MO_MT);
    __syncthreads();
    if (tid < 32) { const int c = (int)__hip_atomic_load((unsigned*)(ws + WS_CTL) + CW_CNT + 32 * l + tid, __ATOMIC_RELAXED, __HIP_MEMORY_SCOPE_AGENT); cnt[tid] = c; ntl[tid] = (c + 255) >> 8; }
    __syncthreads();
    if (tid == 0) { int o = 0;
#pragma unroll 1
        for (int e = 0; e < 32; ++e) { off[e] = o; const int n = ntl[e];
#pragma unroll 1
            for (int j = 0; j < n; ++j) { te[o + j] = e; tr0[o + j] = 256 * j; } o += n; } off[32] = o; mt[0] = o; }
    __syncthreads();
}

#ifndef DRYX
#define DRYX 0
#endif
template <int MODE>
__device__ __forceinline__ void norm_phase(ArgsP a, int l, LAS unsigned char* lds, int tid, int lane, int wave, int bid, int G, const bool dry = false) {
    unsigned char* ws = a->ws;
    LAS unsigned char* misc = lds + MISC_OFF;
    if (MODE == 1 || MODE == 3) moe_tables(ws, MODE == 1 ? 0 : 1, misc, tid);
    const LAS int* off = (const LAS int*)(misc + MO_OFF);
    const float* src = (MODE == 0) ? a->in[I_X] : a->out;
    const float* gain = (MODE < 2) ? a->in[I_N1G] + l * DM : (MODE == 2 ? a->in[I_N2G] + l * DM : a->in[I_FG]);
    const int* toke = (const int*)(ws + MS_TOKE); const int* tokp = (const int*)(ws + MS_TOKP);
    const bf16* OP = (const bf16*)(ws + WS_OP);
    bf16* H = (bf16*)(ws + WS_H);
    const int gw = bid * NWAVES + wave, NGW = G * NWAVES;
    constexpr int RP = (MODE == 2) ? 4 : 2;
    for (int m0 = gw * RP; m0 < NTOK; m0 += NGW * RP) {
        f32x4 v[RP][8];
#pragma unroll
        for (int r = 0; r < RP; ++r)
#pragma unroll
            for (int j = 0; j < 8; ++j) v[r][j] = *(const f32x4*)(src + (size_t)(m0 + r) * DM + 256 * j + 4 * lane);
        if (MODE == 1 || MODE == 3) {
#pragma unroll
            for (int r = 0; r < RP; ++r) { const int m = m0 + r;
                const int e0 = toke[2 * m], e1 = toke[2 * m + 1], p0 = tokp[2 * m], p1 = tokp[2 * m + 1];
                const float cw0 = ((const float*)(ws + MS_TOKW))[2 * m], cw1 = ((const float*)(ws + MS_TOKW))[2 * m + 1];
                const bf16* o0 = OP + (size_t)(off[e0] * 256 + p0) * DM + 4 * lane; const bf16* o1 = OP + (size_t)(off[e1] * 256 + p1) * DM + 4 * lane;
                u32x2 ow0[8], ow1[8];
#pragma unroll
                for (int j = 0; j < 8; ++j) { ow0[j] = *(const u32x2*)(o0 + 256 * j); ow1[j] = *(const u32x2*)(o1 + 256 * j); }
                asm volatile("" : "+v"(ow0[0]), "+v"(ow0[1]), "+v"(ow0[2]), "+v"(ow0[3]), "+v"(ow0[4]), "+v"(ow0[5]), "+v"(ow0[6]), "+v"(ow0[7]),
                                  "+v"(ow1[0]), "+v"(ow1[1]), "+v"(ow1[2]), "+v"(ow1[3]), "+v"(ow1[4]), "+v"(ow1[5]), "+v"(ow1[6]), "+v"(ow1[7]));
#pragma unroll
                for (int j = 0; j < 8; ++j) { const u32x2 w0 = ow0[j], w1 = ow1[j];
                    v[r][j].x += cw0 * bflo(w0.x) + cw1 * bflo(w1.x); v[r][j].y += cw0 * bfhi(w0.x) + cw1 * bfhi(w1.x); v[r][j].z += cw0 * bflo(w0.y) + cw1 * bflo(w1.y); v[r][j].w += cw0 * bfhi(w0.y) + cw1 * bfhi(w1.y); }
                if (MODE == 1 && !dry) {
#pragma unroll
                    for (int j = 0; j < 8; ++j) *(f32x4*)(a->out + (size_t)m * DM + 256 * j + 4 * lane) = v[r][j]; }
                asm volatile("" ::: "memory");
            }
        }
        float rs[RP];
#pragma unroll
        for (int r = 0; r < RP; ++r) { float ss = 0.f;
#pragma unroll
            for (int j = 0; j < 8; ++j) ss += (v[r][j].x * v[r][j].x + v[r][j].y * v[r][j].y) + (v[r][j].z * v[r][j].z + v[r][j].w * v[r][j].w);
            rs[r] = __builtin_amdgcn_rsqf(wave_sum(ss) * (1.0f / DM) + RMS_EPS); }
        {
            f32x4 gv[8];
#pragma unroll
            for (int j = 0; j < 8; ++j) gv[j] = *(const f32x4*)(gain + 256 * j + 4 * lane);
            asm volatile("" : "+v"(gv[0]), "+v"(gv[1]), "+v"(gv[2]), "+v"(gv[3]), "+v"(gv[4]), "+v"(gv[5]), "+v"(gv[6]), "+v"(gv[7]));
#pragma unroll
            for (int j = 0; j < 8; ++j)
#pragma unroll
                for (int r = 0; r < RP; ++r) v[r][j] = v[r][j] * rs[r] * gv[j];
        }
        if (MODE == 3) {
#pragma unroll
            for (int r = 0; r < RP; ++r)
#pragma unroll
                for (int j = 0; j < 8; ++j) { if (!dry) *(f32x4*)(a->out + (size_t)(m0 + r) * DM + 256 * j + 4 * lane) = v[r][j]; else asm volatile("" :: "v"(v[r][j])); }
            continue;
        }
#pragma unroll
        for (int r = 0; r < RP; ++r)
#pragma unroll
            for (int j = 0; j < 8; ++j) { u32x2 w; w.x = cvt_pk_bf16(v[r][j].x, v[r][j].y); w.y = cvt_pk_bf16(v[r][j].z, v[r][j].w);
                if (!dry) *(u32x2*)(H + (size_t)(m0 + r) * DM + 256 * j + 4 * lane) = w; else asm volatile("" :: "v"(w)); }
        float keep[RP]; _Pragma("unroll") for (int r = 0; r < RP; ++r) keep[r] = 0.f;
        if (MODE < 2) {
            float a8[RP][8];
#pragma unroll
            for (int r = 0; r < RP; ++r)
#pragma unroll
                for (int n = 0; n < 8; ++n) a8[r][n] = 0.f;
            const float* wg = a->in[I_WIN] + (size_t)l * DM * INCOLS + 4096;
#pragma unroll
            for (int j = 0; j < 8; ++j)
#pragma unroll
                for (int c = 0; c < 4; ++c) { const float* wp = wg + (size_t)(256 * j + 4 * lane + c) * INCOLS;
                    const f32x4 w0 = *(const f32x4*)wp, w1 = *(const f32x4*)(wp + 4);
#pragma unroll
                    for (int r = 0; r < RP; ++r) { const float hv = v[r][j][c];
                        a8[r][0] += hv * w0.x; a8[r][1] += hv * w0.y; a8[r][2] += hv * w0.z; a8[r][3] += hv * w0.w;
                        a8[r][4] += hv * w1.x; a8[r][5] += hv * w1.y; a8[r][6] += hv * w1.z; a8[r][7] += hv * w1.w; }
                    if (c == 3) asm volatile("" ::: "memory"); }
#pragma unroll
            for (int r = 0; r < RP; ++r)
#pragma unroll
                for (int n = 0; n < 8; ++n) { const float d = wave_sum(a8[r][n]); keep[r] = (lane == n) ? d : keep[r]; }
        } else {
            const float* W = (const float*)(ws + MS_WRT) + (size_t)l * 36 * 2048;
            LAS float* logl = (LAS float*)(misc + MO_LOG) + wave * 160;
#pragma unroll 1
            for (int grp = 0; grp < 9; ++grp) {
                float val[16];
                const float* wg = W + (size_t)(4 * grp) * 2048 + 4 * lane;
#pragma unroll
                for (int nl = 0; nl < 4; ++nl) {
                    float d[4] = {0.f, 0.f, 0.f, 0.f};
                    f32x4 wv[8];
#pragma unroll
                    for (int j = 0; j < 8; ++j) wv[j] = *(const f32x4*)(wg + nl * 2048 + 256 * j);
                    asm volatile("" : "+v"(wv[0]), "+v"(wv[1]), "+v"(wv[2]), "+v"(wv[3]), "+v"(wv[4]), "+v"(wv[5]), "+v"(wv[6]), "+v"(wv[7]));
#pragma unroll
                    for (int j = 0; j < 8; ++j) { const f32x4 w = wv[j];
#pragma unroll
                        for (int r = 0; r < 4; ++r) d[r] += (v[r][j].x * w.x + v[r][j].y * w.y) + (v[r][j].z * w.z + v[r][j].w * w.w); }
#pragma unroll
                    for (int r = 0; r < 4; ++r) val[4 * nl + r] = d[r];
                }
#pragma unroll
                for (int i = 0; i < 8; ++i) { const bool hi = (lane & 32) != 0; const float snd = hi ? val[i] : val[i + 8]; const float kp = hi ? val[i + 8] : val[i]; val[i] = kp + __shfl_xor(snd, 32); }
#pragma unroll
                for (int i = 0; i < 4; ++i) { const bool hi = (lane & 16) != 0; const float snd = hi ? val[i] : val[i + 4]; const float kp = hi ? val[i + 4] : val[i]; val[i] = kp + __shfl_xor(snd, 16); }
#pragma unroll
                for (int i = 0; i < 2; ++i) { const bool hi = (lane & 8) != 0; const float snd = hi ? val[i] : val[i + 2]; const float kp = hi ? val[i + 2] : val[i]; val[i] = kp + __shfl_xor(snd, 8); }
                { const bool hi = (lane & 4) != 0; const float snd = hi ? val[0] : val[1]; const float kp = hi ? val[1] : val[0]; val[0] = kp + __shfl_xor(snd, 4); }
                float f = val[0]; f += __shfl_xor(f, 2); f += __shfl_xor(f, 1);
                const int vi = lane >> 2;
                if ((lane & 3) == 0) logl[(vi & 3) * 40 + 4 * grp + (vi >> 2)] = f;
            }
        }
        if (MODE < 2) {
            float* ifg = (float*)(ws + MS_IFG);
            if (lane < 8) {
#pragma unroll
                for (int r = 0; r < RP; ++r) { if (!dry) ifg[(size_t)(m0 + r) * 8 + lane] = keep[r]; else asm volatile("" :: "v"(keep[r])); } }
        } else {
            LAS float* logl = (LAS float*)(misc + MO_LOG) + wave * 160;
            LDS_WAIT();
            if (dry) { asm volatile("" :: "v"(keep[0])); }
            if (lane < RP && !dry) {
                const int m = m0 + lane; const LAS float* lg = logl + lane * 40;
                const float* bg = a->in[I_BGRP] + l * 4; const float* be = a->in[I_BEXP] + l * 32;
                float gv[4]; int gsel = 0;
#pragma unroll
                for (int j = 0; j < 4; ++j) gv[j] = lg[j] + bg[j];
                float gmax = gv[0];
#pragma unroll
                for (int j = 1; j < 4; ++j) if (gv[j] > gmax) { gmax = gv[j]; gsel = j; }
                float gs = 0.f;
#pragma unroll
                for (int j = 0; j < 4; ++j) gs += expf(gv[j] - gmax);
                const float pg = 1.0f / gs;
                float ev[8];
#pragma unroll
                for (int j = 0; j < 8; ++j) ev[j] = lg[4 + 8 * gsel + j] + be[8 * gsel + j];
                int e0 = 0; float m0v = ev[0];
#pragma unroll
                for (int j = 1; j < 8; ++j) if (ev[j] > m0v) { m0v = ev[j]; e0 = j; }
                int e1 = -1; float m1v = -3.0e38f;
#pragma unroll
                for (int j = 0; j < 8; ++j) if (j != e0 && ev[j] > m1v) { m1v = ev[j]; e1 = j; }
                const float p1 = expf(m1v - m0v); const float w0 = pg / (1.0f + p1), w1 = pg * p1 / (1.0f + p1);
                unsigned* cnt = (unsigned*)(ws + WS_CTL) + CW_CNT + 32 * l;
                int* list = (int*)(ws + MS_LIST); float* pwl = (float*)(ws + MS_PWL); int* tke = (int*)(ws + MS_TOKE); int* tkp = (int*)(ws + MS_TOKP);
                const int id0 = 8 * gsel + e0, id1 = 8 * gsel + e1;
                const int q0 = (int)__hip_atomic_fetch_add(cnt + id0, 1u, __ATOMIC_RELAXED, __HIP_MEMORY_SCOPE_AGENT);
                const int q1 = (int)__hip_atomic_fetch_add(cnt + id1, 1u, __ATOMIC_RELAXED, __HIP_MEMORY_SCOPE_AGENT);
                list[id0 * 8192 + q0] = m; pwl[id0 * 8192 + q0] = w0; list[id1 * 8192 + q1] = m; pwl[id1 * 8192 + q1] = w1;
                tke[2 * m] = id0; tke[2 * m + 1] = id1; tkp[2 * m] = q0; tkp[2 * m + 1] = q1;
                ((float*)(ws + MS_TOKW))[2 * m] = w0; ((float*)(ws + MS_TOKW))[2 * m + 1] = w1;
            }
            LDS_WAIT();
        }
    }
}

struct SchedG1 {
    static constexpr bool GATHER = false;
    const char* H; const char* W; int G, c;
    static constexpr int NCV = 21;
    __device__ __forceinline__ bool next(int i, Unit& u) const {
        int L = i * G + c;
        if (G == 256) {
            if (c >= 256 - NCV) return false;
            if (c >= 128 && i == 5) { const int k = c - 128; if (k >= 5 * NCV) return false; L = (k % 5) * 256 + (256 - NCV) + k / 5; }
            else if (i > 5) return false;
        }
        if (L < 1152) { pg8::static_tile(L, 32, 36, u.pm, u.pn); u.aux = 0; return true; }
        const int r = L - 1152; if (r >= 256) return false;
        u.aux = 1 + (r >> 7); const int q = r & 127; u.pm = q & 3; u.pn = q >> 2; return true;
    }
    __device__ __forceinline__ const char* abase(const Unit& u) const { return u.aux == 0 ? H + (size_t)u.pm * 256 * 4096 : W + (size_t)(9216 + (u.aux - 1) * 1024 + u.pm * 256) * 4096; }
    __device__ __forceinline__ const char* bbase(const Unit& u) const { return u.aux == 0 ? W + (size_t)u.pn * 256 * 4096 : H + (size_t)u.pn * 256 * 4096; }
    __device__ __forceinline__ unsigned arow(const Unit&, int) const { return 0u; }
    static __device__ __forceinline__ bool keep_acc(const Unit&) { return false; }
};
struct EpiG1 {
    static constexpr bool PERM = true;
    unsigned char* ws; bool dry;
    __device__ __forceinline__ void operator()(f32x4 (&acc)[2][2][4][2], const Unit& u, int wr, int wc, int fr, int fq) const {
        if (dry) {
#pragma unroll
            for (int ai = 0; ai < 2; ++ai)
#pragma unroll
                for (int bj = 0; bj < 2; ++bj)
#pragma unroll
                    for (int m = 0; m < 4; ++m) asm volatile("" :: "v"(acc[ai][bj][m][0]), "v"(acc[ai][bj][m][1]));
            return; }
        if (u.aux == 0) {
            bf16* dst; int ld, colt, op;
            if (u.pn < 8) { dst = (bf16*)(ws + WS_ZQK); ld = 2048; colt = 256 * u.pn; op = 0; }
            else if (u.pn < 12) { dst = (bf16*)(ws + WS_OM); ld = 1024; colt = 256 * (u.pn - 8); op = 1; }
            else if (u.pn < 16) { dst = (bf16*)(ws + WS_QA); ld = 1024; colt = 256 * (u.pn - 12); op = 2; }
            else if (u.pn < 20) { dst = (bf16*)(ws + WS_KA); ld = 1024; colt = 256 * (u.pn - 16); op = 0; }
            else { dst = (bf16*)(ws + WS_SG); ld = 4096; colt = 256 * (u.pn - 20); op = 1; }
            const float scl = (op == 2) ? 0.12751743074602267f : 1.0f;
            const int row0 = u.pm * 256 + wr * 64 + fr, col0 = colt + wc * 32 + 8 * fq;
#pragma unroll
            for (int ai = 0; ai < 2; ++ai)
#pragma unroll
                for (int m = 0; m < 4; ++m) { bf16* rowp = dst + (size_t)(row0 + ai * 128 + m * 16) * ld + col0;
#pragma unroll
                    for (int bj = 0; bj < 2; ++bj) { f32x4 v0 = acc[ai][bj][m][0] * scl, v1 = acc[ai][bj][m][1] * scl;
                        if (op == 1) {
#pragma unroll
                            for (int j = 0; j < 4; ++j) { v0[j] = sigmoidf_(v0[j]); v1[j] = sigmoidf_(v1[j]); } }
                        u32x4 w; w.x = cvt_pk_bf16(v0[0], v0[1]); w.y = cvt_pk_bf16(v0[2], v0[3]); w.z = cvt_pk_bf16(v1[0], v1[1]); w.w = cvt_pk_bf16(v1[2], v1[3]);
                        *(u32x4*)(rowp + bj * 128) = w; } }
        } else {
            bf16* dst = (bf16*)(ws + (u.aux == 1 ? WS_VMT : WS_VAT));
            const int b = u.pn >> 3, s0 = (u.pn & 7) * 256 + wc * 32 + 8 * fq, rr0 = u.pm * 256 + wr * 64 + fr;
#pragma unroll
            for (int ai = 0; ai < 2; ++ai)
#pragma unroll
                for (int m = 0; m < 4; ++m) { const int rr = rr0 + ai * 128 + m * 16;
#pragma unroll
                    for (int bj = 0; bj < 2; ++bj) { const f32x4 v0 = acc[ai][bj][m][0], v1 = acc[ai][bj][m][1];
                        u32x4 w; w.x = cvt_pk_bf16(v0[0], v0[1]); w.y = cvt_pk_bf16(v0[2], v0[3]); w.z = cvt_pk_bf16(v1[0], v1[1]); w.w = cvt_pk_bf16(v1[2], v1[3]);
                        const int sq = s0 + bj * 128;
                        const size_t off = (u.aux == 1) ? (size_t)((((b * 4 + (rr >> 8)) * 32 + (sq >> 6)) * 2 + ((sq >> 5) & 1)) * 16 + ((rr & 255) >> 4)) * 512 + (size_t)((((sq >> 3) & 3) * 16 + (rr & 15)) * 8)
                                                        : (size_t)(b * 1024 + rr) * 2048 + sq;
                        *(u32x4*)(dst + off) = w; } }
        }
    }
};

__device__ __forceinline__ void gate_unit(ArgsP a, int l, LAS unsigned char* lds, int bh, int tid, int lane, int wave) {
    unsigned char* ws = a->ws;
    {
            const int b = bh >> 2, h = bh & 3;
            LAS float* bl = (LAS float*)lds; LAS float* amx = bl + 32; LAS float* mpv = bl + 64; LAS float* gcv = bl + 96;
            const float* ifg = (const float*)(ws + MS_IFG); const float* ifb = a->in[I_IFB] + l * 8;
            float A[4], Bs[4], CM[4];
#pragma unroll
            for (int cc = 0; cc < 4; ++cc) { const int c = wave + 8 * cc, s = 64 * c + lane; const size_t tok = (size_t)b * SEQ + s;
                const float ig = ifg[tok * 8 + h] + ifb[h], fg = ifg[tok * 8 + 4 + h] + ifb[4 + h];
                const float lf = fminf(fg, 0.f) - log1pf(expf(-fabsf(fg)));
                float bs = lf;
#pragma unroll
                for (int o = 1; o < 64; o <<= 1) { const float t = __shfl_up(bs, o); if (lane >= o) bs += t; }
                const float av = ig - bs; float cm = av;
#pragma unroll
                for (int o = 1; o < 64; o <<= 1) { const float t = __shfl_up(cm, o); if (lane >= o) cm = fmaxf(cm, t); }
                A[cc] = av; Bs[cc] = bs; CM[cc] = cm;
                if (lane == 63) { bl[c] = bs; amx[c] = cm; } }
            __syncthreads();
            if (tid == 0) { float m = 0.f;
#pragma unroll 1
                for (int c = 0; c < 32; ++c) { mpv[c] = m; const float Gm = fmaxf(m, amx[c]); gcv[c] = Gm; m = bl[c] + Gm; } }
            __syncthreads();
            float* AS = (float*)(ws + MS_AS) + bh * 2048; float* GT = (float*)(ws + MS_GT) + bh * 2048; float* WI = (float*)(ws + MS_WI) + bh * 2048;
            float* CL = (float*)(ws + MS_CL) + bh * 2048; float* WSs = (float*)(ws + MS_WS) + bh * 2048; float* DEC = (float*)(ws + MS_DEC) + bh * 32;
#pragma unroll
            for (int cc = 0; cc < 4; ++cc) { const int c = wave + 8 * cc, s = 64 * c + lane; const float mp = mpv[c], Gm = gcv[c], gt = fmaxf(mp, CM[cc]);
                AS[s] = A[cc]; GT[s] = gt; WI[s] = expf(mp - gt); CL[s] = expf(-(Bs[cc] + gt)); WSs[s] = expf(A[cc] - Gm);
                if (lane == 0) DEC[c] = expf(mp - Gm); }
        }
    __syncthreads();
}

__device__ __forceinline__ void conv_phase(ArgsP a, int l, LAS unsigned char* lds, int tid, int lane, int wave, int bid, int G) {
    unsigned char* ws = a->ws;
    u32x4 xv[5];
    const bf16* Z = (const bf16*)(ws + WS_ZQK);
#define CONV_LOAD(u_) do { const int cg_ = (u_) & 7, s0_ = 64 * (((u_) >> 3) & 31), b_ = (u_) >> 8; _Pragma("unroll") for (int i = 0; i < 5; ++i) { \
        const int idx = tid + NTHR * i, row = idx >> 5, ch = idx & 31, sq = s0_ - 3 + row; xv[i] = (u32x4){0u, 0u, 0u, 0u}; \
        if (idx < 67 * 32 && sq >= 0) xv[i] = *(const u32x4*)(Z + (size_t)(b_ * SEQ + sq) * 2048 + cg_ * 256 + ch * 8); } } while (0)
    if (bid < 1024) CONV_LOAD(bid);
    for (int u = bid; u < 1024 + 256; u += G) {
        if (u < 1024) {
            const int cg = u & 7, st = (u >> 3) & 31, b = u >> 8, s0 = 64 * st;
            LAS unsigned char* xt = lds; LAS unsigned char* kt = lds + 36864;
            asm volatile("" : "+v"(xv[0]), "+v"(xv[1]), "+v"(xv[2]), "+v"(xv[3]), "+v"(xv[4]));
#pragma unroll
            for (int i = 0; i < 5; ++i) { const int idx = tid + NTHR * i, row = idx >> 5, ch = idx & 31;
                if (idx < 67 * 32) *(LAS u32x4*)(xt + row * 512 + ch * 16) = xv[i]; }
            LAS float* wst = (LAS float*)(lds + 73728);
            if (cg >= 4 && tid < 64) wst[tid] = ((const float*)(ws + MS_WS))[(size_t)(b * 4 + cg - 4) * 2048 + s0 + tid];
            __syncthreads();
            if (u + G < 1024) CONV_LOAD(u + G);
            const int cp = tid & 127, tg = tid >> 7, c = 2 * cp, gc = cg * 256 + c;
            float w0[4], w1[4];
#pragma unroll
            for (int j = 0; j < 4; ++j) { w0[j] = a->in[I_CONVW][(size_t)(l * 4 + j) * 2048 + gc]; w1[j] = a->in[I_CONVW][(size_t)(l * 4 + j) * 2048 + gc + 1]; }
            bf16* QM = (bf16*)(ws + WS_QM); bf16* KM = (bf16*)(ws + WS_KM);
#pragma unroll 4
            for (int tt = 0; tt < 16; ++tt) { const int t = tg * 16 + tt; float a0 = 0.f, a1 = 0.f;
#pragma unroll
                for (int j = 0; j < 4; ++j) { const unsigned x = *(const LAS unsigned*)(xt + (t + j) * 512 + c * 2); a0 += w0[j] * bflo(x); a1 += w1[j] * bfhi(x); }
                float o0 = a0 * sigmoidf_(a0), o1 = a1 * sigmoidf_(a1);
                const size_t tok = (size_t)b * SEQ + s0 + t;
                if (cg < 4) { *(unsigned*)(QM + tok * 1024 + cg * 256 + c) = cvt_pk_bf16(o0, o1); }
                else { o0 *= 0.0625f; o1 *= 0.0625f; const unsigned p = cvt_pk_bf16(o0, o1);
                    *(unsigned*)(KM + tok * 1024 + (cg - 4) * 256 + c) = p;
                    const float wsv = wst[t]; const unsigned ps = cvt_pk_bf16(o0 * wsv, o1 * wsv);
                    *(LAS unsigned short*)(kt + c * 144 + t * 2) = (unsigned short)(ps & 0xffffu); *(LAS unsigned short*)(kt + (c + 1) * 144 + t * 2) = (unsigned short)(ps >> 16); }
            }
            if (cg >= 4) {
                __syncthreads();
                bf16* KMT = (bf16*)(ws + WS_KMT);
                for (int idx = tid; idx < 2048; idx += NTHR) {
                    const int ks = idx >> 10, dtl = (idx >> 6) & 15, ln = idx & 63, row = dtl * 16 + (ln & 15), ch = ks * 4 + (ln >> 4);
                    const u32x4 v = *(const LAS u32x4*)(kt + row * 144 + ch * 16);
                    *(u32x4*)(KMT + (size_t)(((b * 4 + cg - 4) * 32 + st) * 2) * 8192 + (size_t)idx * 8) = v; }
                if (tid < 256) {
                    float sm = 0.f;
#pragma unroll
                    for (int i = 0; i < 8; ++i) { const u32x4 v = *(const LAS u32x4*)(kt + tid * 144 + i * 16);
                        sm += (bflo(v.x) + bfhi(v.x)) + (bflo(v.y) + bfhi(v.y)) + (bflo(v.z) + bfhi(v.z)) + (bflo(v.w) + bfhi(v.w)); }
                    ((float*)(ws + MS_NST))[(size_t)((b * 4 + cg - 4) * 32 + st) * 256 + tid] = sm; }
            }
        } else if (u < 1280) {
            const int j = u - 1024, b = j >> 6, n = (j >> 3) & 7, h = j & 7;
            const bf16* KA = (const bf16*)(ws + WS_KA) + (size_t)(b * SEQ + n * 256 + wave * 32) * 1024 + h * 128 + 2 * lane;
            float s0 = 0.f, s1 = 0.f;
            unsigned xr[32];
#pragma unroll
            for (int r = 0; r < 32; ++r) xr[r] = *(const unsigned*)(KA + (size_t)r * 1024);
#pragma unroll
            for (int r = 0; r < 32; r += 8) asm volatile("" : "+v"(xr[r]), "+v"(xr[r + 1]), "+v"(xr[r + 2]), "+v"(xr[r + 3]), "+v"(xr[r + 4]), "+v"(xr[r + 5]), "+v"(xr[r + 6]), "+v"(xr[r + 7]));
#pragma unroll
            for (int r = 0; r < 32; ++r) { s0 += bflo(xr[r]); s1 += bfhi(xr[r]); }
            LAS float* part = (LAS float*)lds;
            part[wave * 128 + 2 * lane] = s0; part[wave * 128 + 2 * lane + 1] = s1;
            __syncthreads();
            if (tid < 128) { float t = 0.f;
#pragma unroll
                for (int w = 0; w < 8; ++w) t += part[w * 128 + tid];
                ((float*)(ws + MS_KMEAN))[(size_t)((b * 8 + h) * 8 + n) * 128 + tid] = t * (1.0f / 256.0f); }
        }
        __syncthreads();
    }
}

#undef CONV_LOAD
__device__ __forceinline__ void mlstm_ab_task(unsigned char* ws, int gw, int lane, const bool do_store = true) {
    const int bh = gw >> 7, piece = gw & 127, e0 = (piece >> 3) * 16, d0 = (piece & 7) * 32, q16 = lane & 15, g = lane >> 4;
    const bf16* ka = (const bf16*)(ws + WS_KMT) + (size_t)bh * 32 * 16384 + (size_t)(d0 >> 4) * 512 + lane * 8;
    const bf16* vb = (const bf16*)(ws + WS_VMT) + (size_t)bh * 32 * 16384 + (size_t)(e0 >> 4) * 512 + lane * 8;
    const float* DEC = (const float*)(ws + MS_DEC) + bh * 32;
    bf16* CST = (bf16*)(ws + WS_CST) + (size_t)bh * 32 * 65536 + (size_t)((d0 >> 5) * 16 + (e0 >> 4)) * 512 + (size_t)(((g >> 1) * 16 + q16) * 8 + 4 * (g & 1));
    f32x4 acc[2]; acc[0] = (f32x4){0.f, 0.f, 0.f, 0.f}; acc[1] = acc[0];
    const int decv = __builtin_bit_cast(int, DEC[lane & 31]);
    bf16x8 A0[2][2], B0[2], A1[2][2], B1[2], A2[2][2], B2[2], A3[2][2], B3[2], A4[2][2], B4[2];
#define AB_LOAD(c_, A_, B_) do { const int cc_ = (c_) < 31 ? (c_) : 31; _Pragma("unroll") for (int ks = 0; ks < 2; ++ks) { \
        A_[0][ks] = *(const bf16x8*)(ka + (size_t)cc_ * 16384 + ks * 8192); A_[1][ks] = *(const bf16x8*)(ka + (size_t)cc_ * 16384 + ks * 8192 + 512); B_[ks] = *(const bf16x8*)(vb + (size_t)cc_ * 16384 + ks * 8192); } } while (0)
#define AB_STEP(c_, A_, B_) do { \
        if (do_store) { _Pragma("unroll") for (int f = 0; f < 2; ++f) { u32x2 w; w.x = cvt_pk_bf16(acc[f][0], acc[f][1]); w.y = cvt_pk_bf16(acc[f][2], acc[f][3]); *(u32x2*)(CST + (size_t)(c_) * 65536 + 256 * f) = w; } } \
        const float dec = __builtin_bit_cast(float, __builtin_amdgcn_readlane(decv, (c_))); \
        acc[0] = acc[0] * dec; acc[1] = acc[1] * dec; \
        _Pragma("unroll") for (int ks = 0; ks < 2; ++ks) { \
            acc[0] = __builtin_amdgcn_mfma_f32_16x16x32_bf16(A_[0][ks], B_[ks], acc[0], 0, 0, 0); \
            acc[1] = __builtin_amdgcn_mfma_f32_16x16x32_bf16(A_[1][ks], B_[ks], acc[1], 0, 0, 0); } } while (0)
    AB_LOAD(0, A0, B0); AB_LOAD(1, A1, B1); AB_LOAD(2, A2, B2); AB_LOAD(3, A3, B3); AB_LOAD(4, A4, B4);
#pragma unroll 1
    for (int c = 0; c < 30; c += 5) {
        AB_STEP(c, A0, B0); AB_LOAD(c + 5, A0, B0);
        AB_STEP(c + 1, A1, B1); AB_LOAD(c + 6, A1, B1);
        AB_STEP(c + 2, A2, B2); AB_LOAD(c + 7, A2, B2);
        AB_STEP(c + 3, A3, B3); AB_LOAD(c + 8, A3, B3);
        AB_STEP(c + 4, A4, B4); AB_LOAD(c + 9, A4, B4);
    }
    AB_STEP(30, A0, B0); AB_STEP(31, A1, B1);
    if (!do_store) asm volatile("" :: "v"(acc[0]), "v"(acc[1]));
#undef AB_LOAD
#undef AB_STEP
}

__device__ __forceinline__ void nscan_task(unsigned char* ws, int t, int lane) {
    const int bh = t >> 2, d = (t & 3) * 64 + lane;
    const float* cs = (const float*)(ws + MS_NST) + (size_t)bh * 32 * 256 + d;
    float* nv = (float*)(ws + MS_NVEC) + (size_t)bh * 32 * 256 + d;
    const int decv = __builtin_bit_cast(int, ((const float*)(ws + MS_DEC))[bh * 32 + (lane & 31)]);
    float v[32];
#pragma unroll
    for (int j = 0; j < 32; ++j) v[j] = cs[j * 256];
    float n = 0.f;
#pragma unroll
    for (int j = 0; j < 32; ++j) { nv[j * 256] = n; n = __builtin_bit_cast(float, __builtin_amdgcn_readlane(decv, j)) * n + v[j]; }
}

__device__ __forceinline__ int rel_bucket_dev(int n) {
    if (n < 16) return n;
    int b = 16;
    b += (n >= 19); b += (n >= 21); b += (n >= 24); b += (n >= 27); b += (n >= 31); b += (n >= 35); b += (n >= 40); b += (n >= 46);
    b += (n >= 52); b += (n >= 59); b += (n >= 67); b += (n >= 77); b += (n >= 87); b += (n >= 99); b += (n >= 113);
    return b;
}
constexpr int AT_KT = 0, AT_VT = 34816, AT_TAB = 71680, AT_SEL = 72704, AT_TILES = 73216, AT_CTL = 73600, AT_KM = 73728;
__device__ __forceinline__ void attn_unit(ArgsP a, LAS unsigned char* lds, int uidx, int tid, int lane, int wave) {
    unsigned char* ws = a->ws;
    const int u256 = uidx & 255, second = uidx >> 8, bh = u256 >> 3, kk8 = u256 & 7, si = second ? 15 - kk8 : kk8, wgt = 16 - si;
    const int blk = (wgt - 1) >> 1, half = (wgt - 1) & 1, b = bh >> 3, h = bh & 7, q0 = blk * 256 + half * 128;
    const int q16 = lane & 15, g = lane >> 4;
    LAS float* tab = (LAS float*)(lds + AT_TAB); LAS unsigned* sels = (LAS unsigned*)(lds + AT_SEL); LAS int* tiles = (LAS int*)(lds + AT_TILES);
    LAS unsigned* ctl = (LAS unsigned*)(lds + AT_CTL); LAS float* kms = (LAS float*)(lds + AT_KM);
    const bf16* QA = (const bf16*)(ws + WS_QA); const bf16* KA = (const bf16*)(ws + WS_KA); const bf16* VAT = (const bf16*)(ws + WS_VAT);
    u32x4 sr[8], qst[4];
    const int row0 = tid >> 4, ch = tid & 15;
    const bf16* kbase = KA + (size_t)(b * SEQ + row0) * 1024 + h * 128 + ch * 8;
    const bf16* vbase = VAT + (size_t)(bh * 128 + row0) * 2048 + ch * 8;
#define AT_LOAD(ks0_) do { _Pragma("unroll") for (int i = 0; i < 4; ++i) { \
        sr[i] = *(const u32x4*)(kbase + (size_t)((ks0_) + 32 * i) * 1024); sr[4 + i] = *(const u32x4*)(vbase + (size_t)(32 * i) * 2048 + (ks0_)); } } while (0)
#pragma unroll
    for (int i = 0; i < 4; ++i) qst[i] = *(const u32x4*)(QA + (size_t)(b * SEQ + q0 + row0 + 32 * i) * 1024 + h * 128 + ch * 8);
    AT_LOAD(blk * 256);
    if (tid <= 128) tab[tid] = a->in[I_RELB][rel_bucket_dev(tid) * 8 + h] * 1.4426950408889634f;
    for (int idx = tid; idx < 1024; idx += NTHR) kms[idx] = ((const float*)(ws + MS_KMEAN))[bh * 1024 + idx];
    if (tid == 0) ctl[0] = 0u;
    __syncthreads();
    {
        const int q = tid >> 2, part = tid & 3;
        const bf16* qp = QA + (size_t)(b * SEQ + q0 + q) * 1024 + h * 128 + part * 32;
        float qf32[32];
#pragma unroll
        for (int i = 0; i < 4; ++i) { const u32x4 v = *(const u32x4*)(qp + 8 * i);
            qf32[8 * i + 0] = bflo(v.x); qf32[8 * i + 1] = bfhi(v.x); qf32[8 * i + 2] = bflo(v.y); qf32[8 * i + 3] = bfhi(v.y);
            qf32[8 * i + 4] = bflo(v.z); qf32[8 * i + 5] = bfhi(v.z); qf32[8 * i + 6] = bflo(v.w); qf32[8 * i + 7] = bfhi(v.w); }
        float gate[8];
#pragma unroll
        for (int n = 0; n < 8; ++n) { float s = 0.f;
            if (n < blk) {
#pragma unroll
                for (int d = 0; d < 32; d += 4) { const f32x4 kv = *(const LAS f32x4*)(kms + n * 128 + part * 32 + d);
                    s += (qf32[d] * kv.x + qf32[d + 1] * kv.y) + (qf32[d + 2] * kv.z + qf32[d + 3] * kv.w); }
            }
            s += __shfl_xor(s, 1); s += __shfl_xor(s, 2); gate[n] = s; }
        if (part == 0) {
            unsigned sel;
            if (blk <= 3) sel = (1u << blk) - 1u;
            else { sel = 0u;
#pragma unroll
                for (int it = 0; it < 3; ++it) { int best = 0; float bv = -3.0e38f;
#pragma unroll
                    for (int n = 0; n < 8; ++n) if (n < blk && !((sel >> n) & 1u) && gate[n] > bv) { bv = gate[n]; best = n; }
                    sel |= 1u << best; } }
            sels[q] = sel; atomicOr((unsigned*)ctl, sel);
        }
    }
    __syncthreads();
    if (tid == 0) { int nt = 0; const unsigned any = ctl[0];
        for (int j = 0; j < half + 1; ++j) tiles[nt++] = blk * 256 + 128 * j;
        for (int n = 0; n < blk; ++n) if ((any >> n) & 1u) for (int j = 0; j < 2; ++j) tiles[nt++] = n * 256 + 128 * j;
        ctl[1] = (unsigned)nt; }
    __syncthreads();
    const int ntiles = (int)ctl[1];
    const int qg = wave & 3, kp = wave >> 2;
    int qpos[2]; unsigned mysel[2];
#pragma unroll
    for (int f = 0; f < 2; ++f) { qpos[f] = q0 + 32 * qg + 16 * f + q16; mysel[f] = sels[32 * qg + 16 * f + q16]; }
    constexpr int AT_Q = 77824;
#pragma unroll
    for (int i = 0; i < 4; ++i) *(LAS u32x4*)(lds + AT_Q + (row0 + 32 * i) * 272 + ch * 16) = qst[i];
    const LAS unsigned char* qrow = lds + AT_Q + (32 * qg + q16) * 272 + 16 * g;
    float m_run[2] = {-1.0e30f, -1.0e30f}, l_run[2] = {0.f, 0.f};
    f32x4 oacc[2][8];
#pragma unroll
    for (int f = 0; f < 2; ++f)
#pragma unroll
        for (int m = 0; m < 8; ++m) oacc[f][m] = (f32x4){0.f, 0.f, 0.f, 0.f};
    const int vpos = (ch >> 2) * 32 + 16 * (ch & 1) + 4 * ((ch & 3) >> 1);
#define AT_WRITE() do { _Pragma("unroll") for (int i = 0; i < 4; ++i) { \
        *(LAS u32x4*)(lds + AT_KT + (row0 + 32 * i) * 272 + ch * 16) = sr[i]; \
        *(LAS u32x2*)(lds + AT_VT + (row0 + 32 * i) * 272 + vpos * 2) = (u32x2){sr[4 + i].x, sr[4 + i].y}; \
        *(LAS u32x2*)(lds + AT_VT + (row0 + 32 * i) * 272 + (vpos + 8) * 2) = (u32x2){sr[4 + i].z, sr[4 + i].w}; } } while (0)
    AT_WRITE();
    __syncthreads();
    if (ntiles > 1) { const int k1 = tiles[1]; AT_LOAD(k1); }
    for (int ti = 0; ti < ntiles; ++ti) {
        const int kstart = tiles[ti] + 64 * kp, nblk = kstart >> 8;
        const bool own = (nblk == blk);
        const bool any_ok = own ? true : (__any((((mysel[0] | mysel[1]) >> nblk) & 1u) != 0u) != 0);
        const bool active = own ? (kstart <= q0 + 32 * qg + 31) : any_ok;
        if (active) {
            const LAS unsigned char* kt = lds + AT_KT + 64 * kp * 272; const LAS unsigned char* vt = lds + AT_VT + 64 * kp * 2;
            f32x4 s[2][4];
#pragma unroll
            for (int n = 0; n < 4; ++n) { s[0][n] = (f32x4){0.f, 0.f, 0.f, 0.f}; s[1][n] = s[0][n]; }
#pragma unroll
            for (int ks = 0; ks < 4; ++ks) {
                bf16x8 q0f = *(const LAS bf16x8*)(qrow + 64 * ks), q1f = *(const LAS bf16x8*)(qrow + 16 * 272 + 64 * ks);
                bf16x8 kf[4];
#pragma unroll
                for (int n = 0; n < 4; ++n) kf[n] = *(const LAS bf16x8*)(kt + (16 * n + q16) * 272 + (32 * ks + 8 * g) * 2);
                asm volatile("" : "+v"(q0f), "+v"(q1f), "+v"(kf[0]), "+v"(kf[1]), "+v"(kf[2]), "+v"(kf[3]));
#pragma unroll
                for (int n = 0; n < 4; ++n) {
                    s[0][n] = __builtin_amdgcn_mfma_f32_16x16x32_bf16(kf[n], q0f, s[0][n], 0, 0, 0);
                    s[1][n] = __builtin_amdgcn_mfma_f32_16x16x32_bf16(kf[n], q1f, s[1][n], 0, 0, 0); } }
            const bool far = ((q0 + 32 * qg) - (kstart + 63)) >= 128;
            const float bfar = tab[128];
            float alpha[2];
#pragma unroll
            for (int f = 0; f < 2; ++f) {
                const bool lane_ok = own ? true : (((mysel[f] >> nblk) & 1u) != 0u);
                const int kmax = lane_ok ? (own ? qpos[f] : 0x7fffffff) : -1;
                float mx = -1.0e30f;
                float bs[4][4];
                if (far) {
#pragma unroll
                    for (int n = 0; n < 4; ++n)
#pragma unroll
                        for (int r = 0; r < 4; ++r) bs[n][r] = bfar;
                } else {
#pragma unroll
                    for (int n = 0; n < 4; ++n)
#pragma unroll
                        for (int r = 0; r < 4; ++r) { int di = qpos[f] - (kstart + 16 * n + 4 * g + r); di = di < 0 ? 0 : di; di = di > 128 ? 128 : di; bs[n][r] = tab[di]; }
                }
#pragma unroll
                for (int n = 0; n < 4; ++n) asm volatile("" : "+v"(bs[n][0]), "+v"(bs[n][1]), "+v"(bs[n][2]), "+v"(bs[n][3]));
#pragma unroll
                for (int n = 0; n < 4; ++n)
#pragma unroll
                    for (int r = 0; r < 4; ++r) { const int key = kstart + 16 * n + 4 * g + r;
                        const float v = (key <= kmax) ? s[f][n][r] + bs[n][r] : -1.0e30f;
                        s[f][n][r] = v; mx = fmaxf(mx, v); }
                mx = rows4_max(mx);
                const float m_new = fmaxf(fmaxf(m_run[f], mx), -1.0e29f);
                alpha[f] = __builtin_amdgcn_exp2f(m_run[f] - m_new);
                float psum = 0.f;
#pragma unroll
                for (int n = 0; n < 4; ++n)
#pragma unroll
                    for (int r = 0; r < 4; ++r) { const float p = __builtin_amdgcn_exp2f(s[f][n][r] - m_new); s[f][n][r] = p; psum += p; }
                psum = rows4_sum(psum);
                l_run[f] = l_run[f] * alpha[f] + psum; m_run[f] = m_new;
#pragma unroll
                for (int m = 0; m < 8; ++m) oacc[f][m] = oacc[f][m] * alpha[f];
            }
#pragma unroll
            for (int k2 = 0; k2 < 2; ++k2) {
                bf16x8 pf[2];
#pragma unroll
                for (int f = 0; f < 2; ++f) { u32x4 pb; pb.x = cvt_pk_bf16(s[f][2 * k2][0], s[f][2 * k2][1]); pb.y = cvt_pk_bf16(s[f][2 * k2][2], s[f][2 * k2][3]);
                    pb.z = cvt_pk_bf16(s[f][2 * k2 + 1][0], s[f][2 * k2 + 1][1]); pb.w = cvt_pk_bf16(s[f][2 * k2 + 1][2], s[f][2 * k2 + 1][3]);
                    pf[f] = __builtin_bit_cast(bf16x8, pb); }
#pragma unroll
                for (int mh = 0; mh < 2; ++mh) {
                    bf16x8 af[4];
#pragma unroll
                    for (int m = 0; m < 4; ++m) af[m] = *(const LAS bf16x8*)(vt + (16 * (4 * mh + m) + q16) * 272 + (32 * k2 + 8 * g) * 2);
                    asm volatile("" : "+v"(af[0]), "+v"(af[1]), "+v"(af[2]), "+v"(af[3]));
#pragma unroll
                    for (int m = 0; m < 4; ++m) {
                        oacc[0][4 * mh + m] = __builtin_amdgcn_mfma_f32_16x16x32_bf16(af[m], pf[0], oacc[0][4 * mh + m], 0, 0, 0);
                        oacc[1][4 * mh + m] = __builtin_amdgcn_mfma_f32_16x16x32_bf16(af[m], pf[1], oacc[1][4 * mh + m], 0, 0, 0); } }
            }
        }
        __syncthreads();
        if (ti + 1 < ntiles) { AT_WRITE(); }
        __syncthreads();
        if (ti + 2 < ntiles) { const int kn = tiles[ti + 2]; AT_LOAD(kn); }
    }
    LAS float* mo = (LAS float*)lds; LAS float* ml = (LAS float*)(lds + 65536);
    if (kp == 1) {
#pragma unroll
        for (int f = 0; f < 2; ++f) {
#pragma unroll
            for (int m = 0; m < 8; ++m)
#pragma unroll
                for (int r = 0; r < 4; ++r) mo[((qg * 2 + f) * 8 + m) * 256 + r * 64 + lane] = oacc[f][m][r];
            ml[(qg * 2 + f) * 128 + lane] = m_run[f]; ml[(qg * 2 + f) * 128 + 64 + lane] = l_run[f]; }
    }
    __syncthreads();
    if (kp == 0) {
#pragma unroll
        for (int f = 0; f < 2; ++f) {
            const float m1 = ml[(qg * 2 + f) * 128 + lane], l1 = ml[(qg * 2 + f) * 128 + 64 + lane];
            const float mm = fmaxf(m_run[f], m1), a0 = __builtin_amdgcn_exp2f(m_run[f] - mm), a1 = __builtin_amdgcn_exp2f(m1 - mm);
            const float inv = __builtin_amdgcn_rcpf(l_run[f] * a0 + l1 * a1);
            bf16* HA = (bf16*)(ws + WS_HA) + (size_t)(b * SEQ + qpos[f]) * 1024 + h * 128 + 4 * g;
#pragma unroll
            for (int m = 0; m < 8; ++m) { float o[4];
#pragma unroll
                for (int r = 0; r < 4; ++r) o[r] = (oacc[f][m][r] * a0 + mo[((qg * 2 + f) * 8 + m) * 256 + r * 64 + lane] * a1) * inv;
                u32x2 w; w.x = cvt_pk_bf16(o[0], o[1]); w.y = cvt_pk_bf16(o[2], o[3]); *(u32x2*)(HA + 16 * m) = w; }
        }
    }
#undef AT_LOAD
#undef AT_WRITE
}

constexpr int MC_Q = 0, MC_K = 33792, MC_SP = 67584, MC_SC = 76800, MC_NV = 79104;
__device__ __forceinline__ void mlstm_c_unit(ArgsP a, int l, LAS unsigned char* lds, int u, int tid, int lane, int wave) {
    unsigned char* ws = a->ws;
    const int bh = u >> 5, c = u & 31, b = bh >> 2, h = bh & 3, t0 = 64 * c, q16 = lane & 15, g = lane >> 4;
    const size_t tok0 = (size_t)b * SEQ + t0;
    LAS unsigned char* Qs = lds + MC_Q; LAS unsigned char* Ks = lds + MC_K; LAS unsigned char* Sp = lds + MC_SP;
    LAS float* sc = (LAS float*)(lds + MC_SC); LAS float* as_ = sc; LAS float* gt_ = sc + 64; LAS float* wi_ = sc + 128; LAS float* cl_ = sc + 192; LAS float* qn_ = sc + 256; LAS float* denp = sc + 320;
    LAS float* nvec = (LAS float*)(lds + MC_NV);
    const bf16* QM = (const bf16*)(ws + WS_QM); const bf16* KM = (const bf16*)(ws + WS_KM);
    u32x4 qr[4], kr[4];
#pragma unroll
    for (int i = 0; i < 4; ++i) { const int idx = tid + NTHR * i, row = idx >> 5, ch = idx & 31;
        qr[i] = *(const u32x4*)(QM + (tok0 + row) * 1024 + h * 256 + ch * 8); kr[i] = *(const u32x4*)(KM + (tok0 + row) * 1024 + h * 256 + ch * 8); }
    float sc4[4] = {0.f, 0.f, 0.f, 0.f}; float nv0 = 0.f;
    if (tid < 64) { const int s = bh * 2048 + t0 + tid; sc4[0] = ((const float*)(ws + MS_AS))[s]; sc4[1] = ((const float*)(ws + MS_GT))[s];
        sc4[2] = ((const float*)(ws + MS_WI))[s]; sc4[3] = ((const float*)(ws + MS_CL))[s]; }
    if (tid < 256) nv0 = ((const float*)(ws + MS_NVEC))[(size_t)(bh * 32 + c) * 256 + tid];
    bf16x8 cb[8][2], vbf[2][2];
    {
        const bf16* Cp = (const bf16*)(ws + WS_CST) + (size_t)(bh * 32 + c) * 65536 + (size_t)(2 * wave) * 512 + lane * 8;
        if (c > 0) {
#pragma unroll
            for (int ks = 0; ks < 8; ++ks) { cb[ks][0] = *(const bf16x8*)(Cp + ks * 8192); cb[ks][1] = *(const bf16x8*)(Cp + ks * 8192 + 512); }
        }
    }
#pragma unroll
    for (int i = 0; i < 4; ++i) { const int idx = tid + NTHR * i, row = idx >> 5, ch = idx & 31;
        *(LAS u32x4*)(Qs + row * 528 + ch * 16) = qr[i]; *(LAS u32x4*)(Ks + row * 528 + ch * 16) = kr[i]; }
    {
        const bf16* Vp = (const bf16*)(ws + WS_VMT) + (size_t)(bh * 32 + c) * 16384 + (size_t)(2 * wave) * 512 + lane * 8;
#pragma unroll
        for (int ks = 0; ks < 2; ++ks) { vbf[ks][0] = *(const bf16x8*)(Vp + ks * 8192); vbf[ks][1] = *(const bf16x8*)(Vp + ks * 8192 + 512); }
    }
    if (tid < 64) { as_[tid] = sc4[0]; gt_[tid] = sc4[1]; wi_[tid] = sc4[2]; cl_[tid] = sc4[3]; }
    if (tid < 256) nvec[tid] = nv0;
    __syncthreads();
    f32x4 acc[4][2];
#pragma unroll
    for (int m = 0; m < 4; ++m) { acc[m][0] = (f32x4){0.f, 0.f, 0.f, 0.f}; acc[m][1] = acc[m][0]; }
    if (c > 0) {
#pragma unroll
        for (int ks = 0; ks < 8; ++ks) {
#pragma unroll
            for (int m = 0; m < 4; ++m) { const bf16x8 af = *(const LAS bf16x8*)(Qs + (16 * m + q16) * 528 + (32 * ks + 8 * g) * 2);
                acc[m][0] = __builtin_amdgcn_mfma_f32_16x16x32_bf16(af, cb[ks][0], acc[m][0], 0, 0, 0);
                acc[m][1] = __builtin_amdgcn_mfma_f32_16x16x32_bf16(af, cb[ks][1], acc[m][1], 0, 0, 0); }
        }
#pragma unroll
        for (int m = 0; m < 4; ++m)
#pragma unroll
            for (int r = 0; r < 4; ++r) { const float w = wi_[16 * m + 4 * g + r]; acc[m][0][r] *= w; acc[m][1][r] *= w; }
    }
    {
        const int mS = wave & 3, nS0 = 2 * (wave >> 2);
        f32x4 sacc[2]; sacc[0] = (f32x4){0.f, 0.f, 0.f, 0.f}; sacc[1] = sacc[0];
#pragma unroll
        for (int kh = 0; kh < 4; ++kh) {
            bf16x8 af[2], bq[2][2];
#pragma unroll
            for (int k2 = 0; k2 < 2; ++k2) { const int ks = 2 * kh + k2;
                af[k2] = *(const LAS bf16x8*)(Qs + (16 * mS + q16) * 528 + (32 * ks + 8 * g) * 2);
#pragma unroll
                for (int nn = 0; nn < 2; ++nn) bq[k2][nn] = *(const LAS bf16x8*)(Ks + (16 * (nS0 + nn) + q16) * 528 + (32 * ks + 8 * g) * 2); }
            asm volatile("" : "+v"(af[0]), "+v"(af[1]), "+v"(bq[0][0]), "+v"(bq[0][1]), "+v"(bq[1][0]), "+v"(bq[1][1]));
#pragma unroll
            for (int k2 = 0; k2 < 2; ++k2)
#pragma unroll
                for (int nn = 0; nn < 2; ++nn) sacc[nn] = __builtin_amdgcn_mfma_f32_16x16x32_bf16(af[k2], bq[k2][nn], sacc[nn], 0, 0, 0);
        }
#pragma unroll
        for (int nn = 0; nn < 2; ++nn) { const int s = 16 * (nS0 + nn) + q16; const float av = as_[s];
#pragma unroll
            for (int r = 0; r < 4; ++r) { const int t = 16 * mS + 4 * g + r;
                float val = (s <= t) ? sacc[nn][r] * __expf(av - gt_[t]) : 0.f;
                *(LAS unsigned short*)(Sp + t * 144 + s * 2) = (unsigned short)(cvt_pk_bf16(val, val) & 0xffffu);
                val += __shfl_xor(val, 1); val += __shfl_xor(val, 2); val += __shfl_xor(val, 4); val += __shfl_xor(val, 8);
                if (q16 == 0) denp[(nS0 + nn) * 64 + t] = val; } }
    }
    {
        const int t = tid >> 3, seg = tid & 7; float s = 0.f;
#pragma unroll
        for (int i = 0; i < 4; ++i) { const u32x4 v = *(const LAS u32x4*)(Qs + t * 528 + (seg * 32 + 8 * i) * 2); const LAS float* nv = nvec + seg * 32 + 8 * i;
            s += bflo(v.x) * nv[0] + bfhi(v.x) * nv[1] + bflo(v.y) * nv[2] + bfhi(v.y) * nv[3] + bflo(v.z) * nv[4] + bfhi(v.z) * nv[5] + bflo(v.w) * nv[6] + bfhi(v.w) * nv[7]; }
        s += __shfl_xor(s, 1); s += __shfl_xor(s, 2); s += __shfl_xor(s, 4);
        if (seg == 0) qn_[t] = s;
    }
    __syncthreads();
    {
#pragma unroll
        for (int ks = 0; ks < 2; ++ks) {
            bf16x8 sf[4];
#pragma unroll
            for (int m = 0; m < 4; ++m) sf[m] = *(const LAS bf16x8*)(Sp + (16 * m + q16) * 144 + (32 * ks + 8 * g) * 2);
            asm volatile("" : "+v"(sf[0]), "+v"(sf[1]), "+v"(sf[2]), "+v"(sf[3]));
#pragma unroll
            for (int m = 0; m < 4; ++m) {
                acc[m][0] = __builtin_amdgcn_mfma_f32_16x16x32_bf16(sf[m], vbf[ks][0], acc[m][0], 0, 0, 0);
                acc[m][1] = __builtin_amdgcn_mfma_f32_16x16x32_bf16(sf[m], vbf[ks][1], acc[m][1], 0, 0, 0); }
        }
    }
    LAS float* NUM = (LAS float*)lds;
#pragma unroll
    for (int m = 0; m < 4; ++m)
#pragma unroll
        for (int r = 0; r < 4; ++r) { const int t = 16 * m + 4 * g + r;
            const float den = (denp[t] + denp[64 + t]) + (denp[128 + t] + denp[192 + t]) + wi_[t] * qn_[t];
            const float inv = __builtin_amdgcn_rcpf(fmaxf(fabsf(den), cl_[t]));
            NUM[t * 260 + 32 * wave + q16] = acc[m][0][r] * inv; NUM[t * 260 + 32 * wave + 16 + q16] = acc[m][1][r] * inv; }
    __syncthreads();
    {
        const float* mg = a->in[I_MNG] + l * 1024 + h * 256 + 4 * lane; const f32x4 gn = *(const f32x4*)mg;
        const bf16* OM = (const bf16*)(ws + WS_OM); bf16* HM = (bf16*)(ws + WS_HM);
        u32x2 ovv[8];
#pragma unroll
        for (int i = 0; i < 8; ++i) ovv[i] = *(const u32x2*)(OM + (tok0 + 8 * wave + i) * 1024 + h * 256 + 4 * lane);
        asm volatile("" : "+v"(ovv[0]), "+v"(ovv[1]), "+v"(ovv[2]), "+v"(ovv[3]), "+v"(ovv[4]), "+v"(ovv[5]), "+v"(ovv[6]), "+v"(ovv[7]));
#pragma unroll
        for (int i = 0; i < 8; ++i) { const int t = 8 * wave + i;
            const f32x4 v = *(const LAS f32x4*)(NUM + t * 260 + 4 * lane);
            const float mu = wave_sum((v.x + v.y) + (v.z + v.w)) * (1.0f / 256.0f);
            const f32x4 d = v - mu;
            const float var = wave_sum((d.x * d.x + d.y * d.y) + (d.z * d.z + d.w * d.w)) * (1.0f / 256.0f);
            const float rstd = __builtin_amdgcn_rsqf(var + LN_EPS);
            const u32x2 ov = ovv[i];
            u32x2 w; w.x = cvt_pk_bf16(d.x * rstd * gn.x * bflo(ov.x), d.y * rstd * gn.y * bfhi(ov.x)); w.y = cvt_pk_bf16(d.z * rstd * gn.z * bflo(ov.y), d.w * rstd * gn.w * bfhi(ov.y));
            *(u32x2*)(HM + (tok0 + t) * 1024 + h * 256 + 4 * lane) = w; }
    }
    __syncthreads();
}

struct SchedStd {
    static constexpr bool GATHER = false;
    const char* A; const char* B; int nM, nN, K, G, c;
    __device__ __forceinline__ bool next(int i, Unit& u) const { const int L = i * G + c; if (L >= nM * nN) return false; pg8::static_tile(L, nM, nN, u.pm, u.pn); u.aux = 0; return true; }
    __device__ __forceinline__ const char* abase(const Unit& u) const { return A + (size_t)u.pm * 512 * K; }
    __device__ __forceinline__ const char* bbase(const Unit& u) const { return B + (size_t)u.pn * 512 * K; }
    __device__ __forceinline__ unsigned arow(const Unit&, int) const { return 0u; }
    static __device__ __forceinline__ bool keep_acc(const Unit&) { return false; }
};
struct SchedBr {
    static constexpr bool GATHER = false;
    const char* HM; const char* HA; const char* WM; const char* WA; int G, c;
    __device__ __forceinline__ bool next(int i, Unit& u) const { const int L = (i >> 1) * G + c; if (L >= 256) return false; pg8::static_tile(L, 32, 8, u.pm, u.pn); u.aux = i & 1; return true; }
    __device__ __forceinline__ const char* abase(const Unit& u) const { return (u.aux ? HA : HM) + (size_t)u.pm * 512 * 1024; }
    __device__ __forceinline__ const char* bbase(const Unit& u) const { return (u.aux ? WA : WM) + (size_t)u.pn * 512 * 1024; }
    __device__ __forceinline__ unsigned arow(const Unit&, int) const { return 0u; }
    static __device__ __forceinline__ bool keep_acc(const Unit& u) { return u.aux == 0; }
};
struct EpiBr {
    static constexpr bool PERM = true;
    const bf16* SG; bf16* Y;
    __device__ __forceinline__ void operator()(f32x4 (&acc)[2][2][4][2], const Unit& u, int wr, int wc, int fr, int fq) const {
        const int row0 = u.pm * 256 + wr * 64 + fr, col0 = u.pn * 256 + wc * 32 + 8 * fq;
#pragma unroll
        for (int ai = 0; ai < 2; ++ai) {
            u32x4 sa[4][2], sm[4][2];
#pragma unroll
            for (int m = 0; m < 4; ++m) { const size_t row = row0 + ai * 128 + m * 16;
#pragma unroll
                for (int bj = 0; bj < 2; ++bj) { const int col = col0 + bj * 128;
                    sa[m][bj] = *(const u32x4*)(SG + row * 4096 + 2048 + col);
                    sm[m][bj] = *(const u32x4*)(SG + row * 4096 + (u.aux == 0 ? 0 : 2048) + col); } }
            asm volatile("" : "+v"(sa[0][0]), "+v"(sa[0][1]), "+v"(sa[1][0]), "+v"(sa[1][1]), "+v"(sa[2][0]), "+v"(sa[2][1]), "+v"(sa[3][0]), "+v"(sa[3][1]),
                              "+v"(sm[0][0]), "+v"(sm[0][1]), "+v"(sm[1][0]), "+v"(sm[1][1]), "+v"(sm[2][0]), "+v"(sm[2][1]), "+v"(sm[3][0]), "+v"(sm[3][1]));
#pragma unroll
            for (int m = 0; m < 4; ++m) { const size_t row = row0 + ai * 128 + m * 16;
#pragma unroll
                for (int bj = 0; bj < 2; ++bj) { const int col = col0 + bj * 128;
                    const u32x4 a4 = sa[m][bj], m4 = sm[m][bj];
                    const float ga[8] = {bflo(a4.x), bfhi(a4.x), bflo(a4.y), bfhi(a4.y), bflo(a4.z), bfhi(a4.z), bflo(a4.w), bfhi(a4.w)};
                    if (u.aux == 0) {
                        const float gm[8] = {bflo(m4.x), bfhi(m4.x), bflo(m4.y), bfhi(m4.y), bflo(m4.z), bfhi(m4.z), bflo(m4.w), bfhi(m4.w)};
#pragma unroll
                        for (int j = 0; j < 4; ++j) { acc[ai][bj][m][0][j] *= gm[j] * __builtin_amdgcn_rcpf(fmaxf(ga[j], 1.0e-30f)); acc[ai][bj][m][1][j] *= gm[4 + j] * __builtin_amdgcn_rcpf(fmaxf(ga[4 + j], 1.0e-30f)); }
                    } else {
                        const f32x4 v0 = acc[ai][bj][m][0], v1 = acc[ai][bj][m][1];
                        u32x4 w; w.x = cvt_pk_bf16(v0[0] * ga[0], v0[1] * ga[1]); w.y = cvt_pk_bf16(v0[2] * ga[2], v0[3] * ga[3]);
                        w.z = cvt_pk_bf16(v1[0] * ga[4], v1[1] * ga[5]); w.w = cvt_pk_bf16(v1[2] * ga[6], v1[3] * ga[7]);
                        *(u32x4*)(Y + row * 2048 + col) = w; }
                } }
        }
    }
};
struct EpiOut {
    static constexpr bool PERM = false;
    const float* res; float* out;
    __device__ __forceinline__ void operator()(f32x4 (&acc)[2][2][4][2], const Unit& u, int wr, int wc, int fr, int fq) const {
        const int row0 = u.pm * 256 + wr * 64 + fr, col0 = u.pn * 256 + wc * 32 + 4 * fq;
#pragma unroll
        for (int ai = 0; ai < 2; ++ai) {
            f32x4 rv[4][2][2];
#pragma unroll
            for (int m = 0; m < 4; ++m) { const size_t ro = (size_t)(row0 + ai * 128 + m * 16) * DM + col0;
#pragma unroll
                for (int bj = 0; bj < 2; ++bj)
#pragma unroll
                    for (int n = 0; n < 2; ++n) rv[m][bj][n] = *(const f32x4*)(res + ro + bj * 128 + n * 16); }
#pragma unroll
            for (int m = 0; m < 4; ++m) asm volatile("" : "+v"(rv[m][0][0]), "+v"(rv[m][0][1]), "+v"(rv[m][1][0]), "+v"(rv[m][1][1]));
#pragma unroll
            for (int m = 0; m < 4; ++m) { const size_t ro = (size_t)(row0 + ai * 128 + m * 16) * DM + col0;
#pragma unroll
                for (int bj = 0; bj < 2; ++bj)
#pragma unroll
                    for (int n = 0; n < 2; ++n) *(f32x4*)(out + ro + bj * 128 + n * 16) = rv[m][bj][n] + acc[ai][bj][m][n]; }
        }
    }
};
struct SchedMoe1 {
    static constexpr bool GATHER = true;
    const char* H; const char* W13; const int* LIST; const LAS int* te; const LAS int* tr0; const LAS int* cnt; int MT, G, c;
    __device__ __forceinline__ bool next(int i, Unit& u) const { const int L = i * G + c; if (L >= 2 * MT) return false; u.pm = L >> 1; u.pn = L & 1; u.aux = __builtin_amdgcn_readfirstlane(te[u.pm]); return true; }
    __device__ __forceinline__ const char* abase(const Unit&) const { return H; }
    __device__ __forceinline__ const char* bbase(const Unit& u) const { return W13 + ((size_t)u.aux * 512 + u.pn * 256) * 4096; }
    static __device__ __forceinline__ bool keep_acc(const Unit&) { return false; }
    __device__ __forceinline__ unsigned arow(const Unit& u, int r) const { const int rr = __builtin_amdgcn_readfirstlane(tr0[u.pm]) + r; return rr < __builtin_amdgcn_readfirstlane(cnt[u.aux]) ? (unsigned)LIST[u.aux * 8192 + rr] : 0u; }
};
struct EpiMoe1 {
    static constexpr bool PERM = true;
    bf16* HID; const float* PWL; const LAS int* tr0; const LAS int* cnt;
    __device__ __forceinline__ void operator()(f32x4 (&acc)[2][2][4][2], const Unit& u, int wr, int wc, int fr, int fq) const {
#pragma unroll
        for (int ai = 0; ai < 2; ++ai)
#pragma unroll
            for (int m = 0; m < 4; ++m) { const int r = ai * 128 + wr * 64 + m * 16 + fr;
                const float pw = 1.0f;
                float o[8];
#pragma unroll
                for (int n = 0; n < 2; ++n)
#pragma unroll
                    for (int j = 0; j < 4; ++j) { const float x1 = acc[ai][0][m][n][j], x3 = acc[ai][1][m][n][j]; o[4 * n + j] = x1 * sigmoidf_(x1) * x3 * pw; }
                u32x4 w; w.x = cvt_pk_bf16(o[0], o[1]); w.y = cvt_pk_bf16(o[2], o[3]); w.z = cvt_pk_bf16(o[4], o[5]); w.w = cvt_pk_bf16(o[6], o[7]);
                *(u32x4*)(HID + (size_t)(u.pm * 256 + r) * 256 + u.pn * 128 + wc * 32 + 8 * fq) = w; }
    }
};
struct SchedMoe2 {
    static constexpr bool GATHER = false;
    const char* HID; const char* W2; const LAS int* te; int MT, G, c;
    __device__ __forceinline__ bool next(int i, Unit& u) const { const int L = i * G + c; if (L >= 8 * MT) return false; u.pm = L >> 3; u.pn = L & 7; u.aux = __builtin_amdgcn_readfirstlane(te[u.pm]); return true; }
    __device__ __forceinline__ const char* abase(const Unit& u) const { return HID + (size_t)u.pm * 256 * 512; }
    __device__ __forceinline__ const char* bbase(const Unit& u) const { return W2 + ((size_t)u.aux * 2048 + u.pn * 256) * 512; }
    __device__ __forceinline__ unsigned arow(const Unit&, int) const { return 0u; }
    static __device__ __forceinline__ bool keep_acc(const Unit&) { return false; }
};
struct EpiMoe2 {
    static constexpr bool PERM = true;
    bf16* OP;
    __device__ __forceinline__ void operator()(f32x4 (&acc)[2][2][4][2], const Unit& u, int wr, int wc, int fr, int fq) const {
        const int row0 = u.pm * 256 + wr * 64 + fr, col0 = u.pn * 256 + wc * 32 + 8 * fq;
#pragma unroll
        for (int ai = 0; ai < 2; ++ai)
#pragma unroll
            for (int m = 0; m < 4; ++m) { bf16* rowp = OP + (size_t)(row0 + ai * 128 + m * 16) * DM + col0;
#pragma unroll
                for (int bj = 0; bj < 2; ++bj) { const f32x4 v0 = acc[ai][bj][m][0], v1 = acc[ai][bj][m][1];
                    u32x4 w; w.x = cvt_pk_bf16(v0[0], v0[1]); w.y = cvt_pk_bf16(v0[2], v0[3]); w.z = cvt_pk_bf16(v1[0], v1[1]); w.w = cvt_pk_bf16(v1[2], v1[3]);
                    *(u32x4*)(rowp + bj * 128) = w; } }
    }
};

constexpr int N_PHASES = 22;
__global__ void __launch_bounds__(NTHR, 2) fwd_kernel(Args a) {
    extern __shared__ __attribute__((aligned(16))) unsigned char lds_raw[];
    LAS unsigned char* lds0 = (LAS unsigned char*)lds_raw;
    const int tid0 = threadIdx.x, bid0 = blockIdx.x, G0 = gridDim.x;
    const int wave0 = __builtin_amdgcn_readfirstlane(tid0 >> 6);
#define PH_IDS() ArgsP ap = (ArgsP)__builtin_amdgcn_kernarg_segment_ptr(); asm volatile("" : "+s"(ap)); unsigned lb_ = 0u; asm volatile("" : "+s"(lb_)); LAS unsigned char* lds = lds0 + lb_; LAS unsigned char* misc = lds + MISC_OFF; (void)misc; unsigned char* ws = ap->ws; (void)ws; int bid = bid0, G = G0, wave = wave0; asm volatile("" : "+s"(bid), "+s"(G), "+s"(wave)); int tid = wave * 64 + lane_id(); asm volatile("" : "+v"(tid)); const int lane = tid & 63; (void)lane; (void)wave
    if (tid0 < 4) ((LAS unsigned*)(lds0 + MISC_OFF + MO_BAR))[tid0] = 0u;
    __syncthreads();
#if MK_LAUNCHES == 1
    XcdBarrier bar = xcd_barrier_post((unsigned*)(a.ws + WS_CTL) + CW_BAR, (volatile LAS unsigned*)(lds0 + MISC_OFF + MO_BAR));
#define GRID_BAR() xcd_barrier(bar)
#else
#define GRID_BAR() do { } while (0)
#endif
    const int lo = a.ph_lo, hi = a.ph_hi;
#ifndef PHMASK
#define PHMASK 0xFFFu
#endif
#define IN(k) (lo <= (k) && (k) < hi)
#define EN(b) ((PHMASK >> (b)) & 1u)
#ifndef DBLMASK
#define DBLMASK 0u
#endif
#define REP(b) _Pragma("unroll 1") for (int rep_ = 0; rep_ < (((DBLMASK >> (b)) & 1u) ? 2 : 1); ++rep_)
#define SEAM(k) do { if (IN(k) && IN((k) + 1)) { GRID_BAR(); if ((DBLMASK >> 12) & 1u) GRID_BAR(); } } while (0)

    if (EN(0) && IN(0)) { REP(0) { PH_IDS(); prologue_phase(ap, lds, tid, lane, wave, bid, G); __syncthreads(); }
#ifndef NO_NORM0
        { PH_IDS(); norm_phase<0>(ap, 0, lds, tid, lane, wave, bid, G); }
#endif
    }
    SEAM(0);
#pragma unroll 1
    for (int l = 0; l < 2; ++l) {
        const int pb = 1 + 10 * l;
        if (EN(1) && IN(pb + 0) && l == 1) { if ((DBLMASK >> 18) & 1u) { PH_IDS(); norm_phase<1>(ap, l, lds, tid, lane, wave, bid, G, true); } PH_IDS(); norm_phase<1>(ap, l, lds, tid, lane, wave, bid, G); }
        if (l == 1) SEAM(pb + 0);
        if (EN(2) && IN(pb + 1)) REP(2) { PH_IDS(); (void)tid;
            SchedG1 S{(const char*)(ws + WS_H), (const char*)(ws + WS_WINT) + (size_t)l * 11264 * 4096, G, bid};
            EpiG1 E{ws, ((DBLMASK >> 21) & 1u) && rep_ == 1};
            pg8::gemm_phase<EpiG1, SchedG1>(lds, 2048, S, E, wave);
            for (int bh = G - 1 - bid; bh < 16; bh += G) gate_unit(ap, l, lds, bh, tid, tid & 63, wave);
            __syncthreads();
            if (G == 256 && bid >= 256 - SchedG1::NCV) prologue_phase(ap, lds, tid, tid & 63, wave, bid - (256 - SchedG1::NCV), SchedG1::NCV, 2 + l);
            else if (G != 256) prologue_phase(ap, lds, tid, tid & 63, wave, bid, G, 2 + l);
        }
        SEAM(pb + 1);
        if (EN(3) && IN(pb + 2)) REP(3) { PH_IDS(); conv_phase(ap, l, lds, tid, lane, wave, bid, G); }
        SEAM(pb + 2);
        if (EN(4) && IN(pb + 3)) REP(4) { PH_IDS();
            const int vb = (G % 8 == 0) ? (bid & 7) * (G >> 3) + (bid >> 3) : bid;
            REP(13) { for (int gw = vb * NWAVES + wave; gw < 2048; gw += G * NWAVES) mlstm_ab_task(ws, gw, lane, rep_ == 0 || !((DBLMASK >> 15) & 1u)); }
            if (wave == 0 && vb < 64) nscan_task(ws, vb, lane);
            __syncthreads();
            REP(14) { for (int u = vb; u < 512; u += G) { attn_unit(ap, lds, u, tid, lane, wave); __syncthreads(); if (((DBLMASK >> 16) & 1u) && u < 256) GRID_BAR(); } }
        }
        SEAM(pb + 3);
        if (EN(5) && IN(pb + 4)) REP(5) { PH_IDS(); for (int u = bid; u < 512; u += G) { mlstm_c_unit(ap, l, lds, u, tid, lane, wave); if (((DBLMASK >> 17) & 1u) && u < 256) GRID_BAR(); } }
        SEAM(pb + 4);
        if (EN(6) && IN(pb + 5)) REP(6) { PH_IDS(); (void)tid;
            SchedBr S{(const char*)(ws + WS_HM), (const char*)(ws + WS_HA), (const char*)(ws + WS_WBM) + (size_t)l * 2048 * 2048, (const char*)(ws + WS_WBA) + (size_t)l * 2048 * 2048, G, bid};
            EpiBr E{(const bf16*)(ws + WS_SG), (bf16*)(ws + WS_Y)};
            pg8::gemm_phase<EpiBr, SchedBr>(lds, 1024, S, E, wave);
        }
        SEAM(pb + 5);
        if (EN(7) && IN(pb + 6)) _Pragma("unroll 1") for (int rep_ = 0; rep_ < ((((DBLMASK >> 7) & 1u) && l == 0) ? 2 : 1); ++rep_) { PH_IDS(); (void)tid;
            SchedStd S{(const char*)(ws + WS_Y), (const char*)(ws + WS_WOUT) + (size_t)l * 2048 * 4096, 32, 8, 2048, G, bid};
            EpiOut E{l == 0 ? ap->in[I_X] : (const float*)ap->out, ap->out};
            pg8::gemm_phase<EpiOut, SchedStd>(lds, 2048, S, E, wave);
        }
        SEAM(pb + 6);
        if (EN(8) && IN(pb + 7)) { if ((DBLMASK >> 19) & 1u) { PH_IDS(); norm_phase<2>(ap, l, lds, tid, lane, wave, bid, G, true); } PH_IDS(); norm_phase<2>(ap, l, lds, tid, lane, wave, bid, G); }
        SEAM(pb + 7);
        if (EN(9) && IN(pb + 8)) REP(9) { PH_IDS();
            moe_tables(ws, l, misc, tid);
            SchedMoe1 S{(const char*)(ws + WS_H), (const char*)(ws + WS_W13) + (size_t)l * 32 * 512 * 4096, (const int*)(ws + MS_LIST),
                        (const LAS int*)(misc + MO_TE), (const LAS int*)(misc + MO_TR0), (const LAS int*)(misc + MO_CNT), __builtin_amdgcn_readfirstlane(((const LAS int*)(misc + MO_MT))[0]), G, bid};
            EpiMoe1 E{(bf16*)(ws + WS_HID), (const float*)(ws + MS_PWL), (const LAS int*)(misc + MO_TR0), (const LAS int*)(misc + MO_CNT)};
            pg8::gemm_phase<EpiMoe1, SchedMoe1>(lds, 2048, S, E, wave);
            if (l == 0 && bid >= 2 * S.MT) prologue_phase(ap, lds, tid, tid & 63, wave, bid - 2 * S.MT, G - 2 * S.MT, 1);
        }
        SEAM(pb + 8);
        if (EN(10) && IN(pb + 9)) REP(10) { PH_IDS();
            moe_tables(ws, l, misc, tid);
            SchedMoe2 S{(const char*)(ws + WS_HID), (const char*)(ws + WS_W2) + (size_t)l * 32 * 2048 * 512, (const LAS int*)(misc + MO_TE), __builtin_amdgcn_readfirstlane(((const LAS int*)(misc + MO_MT))[0]), G, bid};
            EpiMoe2 E{(bf16*)(ws + WS_OP)};
            pg8::gemm_phase<EpiMoe2, SchedMoe2>(lds, 256, S, E, wave);
        }
        SEAM(pb + 9);
    }
    if (EN(11) && IN(21)) { if ((DBLMASK >> 20) & 1u) { PH_IDS(); norm_phase<3>(ap, 1, lds, tid, lane, wave, bid, G, true); } PH_IDS(); norm_phase<3>(ap, 1, lds, tid, lane, wave, bid, G); }
#undef IN
#undef SEAM
}

extern "C" void kernel_launch(void* const* d_in, const int* in_sizes, int n_in, void* d_out, int out_size, void* d_ws, size_t ws_size, hipStream_t stream) {
    static int grid = 0;
    if (grid == 0) {
        if (n_in != 19 || out_size != NTOK * DM || ws_size < WS_END) { fprintf(stderr, "kernel_launch: unexpected shapes (n_in %d out %d ws %zu)\n", n_in, out_size, ws_size); grid = -1; return; }
        int dev = 0, cus = 0, per_cu = 0;
        if (hipGetDevice(&dev) != hipSuccess || hipDeviceGetAttribute(&cus, hipDeviceAttributeMultiprocessorCount, dev) != hipSuccess) { grid = -1; return; }
        if (hipFuncSetAttribute((const void*)fwd_kernel, hipFuncAttributeMaxDynamicSharedMemorySize, LDS_BYTES) != hipSuccess) { fprintf(stderr, "kernel_launch: hipFuncSetAttribute failed\n"); grid = -1; return; }
        if (hipOccupancyMaxActiveBlocksPerMultiprocessor(&per_cu, (const void*)fwd_kernel, NTHR, LDS_BYTES) != hipSuccess || per_cu < 1) { fprintf(stderr, "kernel_launch: occupancy query says %d\n", per_cu); }
        (void)hipGetLastError();
        grid = cus;
        if (grid > 256) grid = 256;
    }
    if (grid < 0) return;
    if (hipMemsetAsync((char*)d_ws + WS_CTL, 0, CTL_ZERO_BYTES, stream) != hipSuccess) return;
    Args a{};
    for (int i = 0; i < 19; ++i) a.in[i] = (const float*)d_in[i];
    a.out = (float*)d_out; a.ws = (unsigned char*)d_ws;
#if MK_LAUNCHES == 1
    a.ph_lo = 0; a.ph_hi = N_PHASES;
    hipLaunchKernelGGL(fwd_kernel, dim3(grid), dim3(NTHR), LDS_BYTES, stream, a);
#else
    for (int p = 0; p < N_PHASES; ++p) { a.ph_lo = p; a.ph_hi = p + 1; hipLaunchKernelGGL(fwd_kernel, dim3(grid), dim3(NTHR), LDS_BYTES, stream, a); }
#endif
}
```

```cpp
#define DBLMASK 0u
#include <hip/hip_runtime.h>
#include <stdint.h>
#include <stdio.h>

#ifndef MK_LAUNCHES
#define MK_LAUNCHES 1
#endif

#define GAS __attribute__((address_space(1)))
#define LAS __attribute__((address_space(3)))
typedef unsigned short bf16;
typedef short bf16x8 __attribute__((ext_vector_type(8)));
typedef short bf16x4 __attribute__((ext_vector_type(4)));
typedef float f32x4 __attribute__((ext_vector_type(4)));
typedef unsigned u32x4 __attribute__((ext_vector_type(4)));
typedef unsigned u32x2 __attribute__((ext_vector_type(2)));

constexpr int NTOK = 8192, DM = 2048, SEQ = 2048, NBATCH = 4;
constexpr int INCOLS = 11272;
constexpr int NWAVES = 8, NTHR = 512;
constexpr float RMS_EPS = 1e-6f, LN_EPS = 1e-5f;
constexpr int MPAD = 24576;

constexpr size_t MiB = 1u << 20;
constexpr size_t WS_CTL = 0, CTL_ZERO_BYTES = 1 * MiB;
constexpr size_t WS_MISC = 1 * MiB;
constexpr size_t MS_WIF = WS_MISC + 0;
constexpr size_t MS_WRT = WS_MISC + 256 * 1024;
constexpr size_t MS_IFG = WS_MISC + 1 * MiB;
constexpr size_t MS_KMEAN = MS_IFG + 256 * 1024;
constexpr size_t MS_AS = WS_MISC + 1536 * 1024;
constexpr size_t MS_GT = MS_AS + 128 * 1024;
constexpr size_t MS_WI = MS_GT + 128 * 1024;
constexpr size_t MS_CL = MS_WI + 128 * 1024;
constexpr size_t MS_WS = MS_CL + 128 * 1024;
constexpr size_t MS_DEC = MS_WS + 128 * 1024;
constexpr size_t MS_NST = WS_MISC + 2560 * 1024;
constexpr size_t MS_TOKE = WS_MISC + 3 * MiB;
constexpr size_t MS_TOKP = MS_TOKE + 64 * 1024;
constexpr size_t MS_TOKW = MS_TOKE + 128 * 1024;
constexpr size_t MS_LIST = WS_MISC + 4 * MiB;
constexpr size_t MS_PWL = WS_MISC + 5 * MiB;
constexpr size_t MS_NVEC = WS_MISC + 6 * MiB;
constexpr size_t WS_WINT = 16 * MiB;
constexpr size_t WS_WBM = 104 * MiB;
constexpr size_t WS_WBA = 112 * MiB;
constexpr size_t WS_WOUT = 120 * MiB;
constexpr size_t WS_W13 = 136 * MiB;
constexpr size_t WS_W2 = 264 * MiB;
constexpr size_t WS_H = 328 * MiB;
constexpr size_t WS_R = 360 * MiB;
constexpr size_t WS_ZQK = WS_R;
constexpr size_t WS_HM = WS_R, WS_HA = WS_R + 16 * MiB;
constexpr size_t WS_VMT = WS_R + 32 * MiB;
constexpr size_t WS_OM = WS_R + 48 * MiB;
constexpr size_t WS_QA = WS_R + 64 * MiB, WS_KA = WS_R + 80 * MiB;
constexpr size_t WS_Y = WS_QA;
constexpr size_t WS_VAT = WS_R + 96 * MiB;
constexpr size_t WS_SG = WS_R + 112 * MiB;
constexpr size_t WS_QM = WS_R + 176 * MiB, WS_KM = WS_R + 192 * MiB, WS_KMT = WS_R + 208 * MiB;
constexpr size_t WS_CST = WS_R + 224 * MiB;
constexpr size_t WS_HID = WS_R;
constexpr size_t WS_OP = WS_R + 16 * MiB;
constexpr size_t WS_END = 648 * MiB;
constexpr int CW_BAR = 4096;
constexpr int CW_CNT = 8192;

constexpr int RING_BYTES = 131072;
constexpr int MISC_OFF = 139264;
constexpr int LDS_BYTES = 147456;
constexpr int MO_BAR = 0, MO_CNT = 64, MO_NT = 64 + 128, MO_OFF = 64 + 256, MO_TE = 64 + 512, MO_TR0 = 64 + 1024, MO_MT = 64 + 1536, MO_LOG = 2048;

#define LDS_WAIT() asm volatile("s_waitcnt lgkmcnt(0)" ::: "memory")
#define VM_WAIT() asm volatile("s_waitcnt vmcnt(0)" ::: "memory")

__device__ __forceinline__ float bf2f(unsigned short b) { return __builtin_bit_cast(float, (unsigned)b << 16); }
__device__ __forceinline__ float bflo(unsigned u) { return __builtin_bit_cast(float, u << 16); }
__device__ __forceinline__ float bfhi(unsigned u) { return __builtin_bit_cast(float, u & 0xffff0000u); }
typedef __bf16 bf16x2v __attribute__((ext_vector_type(2)));
typedef float f32x2v __attribute__((ext_vector_type(2)));
__device__ __forceinline__ unsigned cvt_pk_bf16(float lo, float hi) { const f32x2v f = {lo, hi}; const bf16x2v b = __builtin_convertvector(f, bf16x2v); return __builtin_bit_cast(unsigned, b); }
__device__ __forceinline__ float wave_sum(float v) {
#pragma unroll
    for (int o = 1; o < 64; o <<= 1) v += __shfl_xor(v, o);
    return v;
}
__device__ __forceinline__ float rows4_max(float x) { x = fmaxf(x, __shfl_xor(x, 16)); return fmaxf(x, __shfl_xor(x, 32)); }
__device__ __forceinline__ float rows4_sum(float x) { x += __shfl_xor(x, 16); return x + __shfl_xor(x, 32); }
__device__ __forceinline__ int lane_id() { int l; asm volatile("v_mbcnt_lo_u32_b32 %0, -1, 0\n\tv_mbcnt_hi_u32_b32 %0, -1, %0" : "=v"(l)); return l; }
__device__ __forceinline__ float sigmoidf_(float x) { return __builtin_amdgcn_rcpf(1.f + __expf(-x)); }

namespace pg8 {
constexpr int BM = 256, BK = 64, HALF = 128, HTB = HALF * BK * 2, STAGE_BYTES = 8 * HTB, NXCD = 8, WGM = 8;
__device__ __forceinline__ int lds_byte(int r, int c) { const int st = (r >> 4) * 2 + (c >> 5), rr = r & 15, cc = c & 31, ob = rr * 64 + cc * 2; return st * 1024 + (ob ^ (((ob >> 9) & 1) << 5)); }
__device__ __forceinline__ void stage_rc(int b, int& R, int& C) { const int st = b / 1024, sb = b % 1024, swz = sb ^ (((sb >> 9) & 1) << 5); R = (st >> 1) * 16 + swz / 64; C = (st & 1) * 32 + (swz % 64) / 2; }
__device__ __forceinline__ int perm32(int rho) { const int n = rho >> 4, i = rho & 15; return 8 * (i >> 2) + 4 * n + (i & 3); }
struct Unit { int pm, pn, aux; };

__device__ __forceinline__ void static_tile(int L, int nM, int nN, int& pm, int& pn) {
    const int nwg = nM * nN; int wgid = L;
    { const int q = nwg / NXCD, r = nwg % NXCD, xcd = wgid % NXCD, off = wgid / NXCD; wgid = (xcd < r ? xcd * (q + 1) : r * (q + 1) + (xcd - r) * q) + off; }
    const int nig = WGM * nN, gid = wgid / nig, fm = gid * WGM, gsz = (nM - fm) < WGM ? (nM - fm) : WGM;
    pm = fm + ((wgid % nig) % gsz); pn = (wgid % nig) / gsz;
}

template <class Epi, class Sched>
__device__ __forceinline__ void gemm_phase(LAS unsigned char* lds, const int K, const Sched& S, const Epi& E, const int wave0) {
    int tid_ = wave0 * 64 + lane_id(); asm volatile("" : "+v"(tid_));
    const int tid = tid_, wid = __builtin_amdgcn_readfirstlane(tid >> 6), lane = tid & 63, wr = wid >> 2, wc = wid & 3, fr = lane & 15, fq = lane >> 4;
    const int nt = K / BK;
    int RA[2], CA[2]; unsigned voffB[2];
#pragma unroll
    for (int i = 0; i < 2; ++i) { int R, C; stage_rc(tid * 16 + i * 8192, R, C); const int Rb = Epi::PERM ? ((R & ~31) + perm32(R & 31)) : R;
        RA[i] = R; CA[i] = C; voffB[i] = (unsigned)(Rb * K + C) * 2u; }
    const size_t kstep = (size_t)(BK * 2);
    const size_t hstep = (size_t)HALF * K * 2;
    const unsigned ldsw = (unsigned)wid * 1024u;
    const int aoff = lds_byte(wr * 64 + fr, fq * 8), boff = lds_byte(wc * 32 + fr, fq * 8);
#define PG8_SA(b, h) (((b) * 2 + (h)) * HTB)
#define PG8_SB(b, h) ((4 + (b) * 2 + (h)) * HTB)
#define PG8_STAGE(bufoff, gbase, v0, v1) do { \
        __builtin_amdgcn_global_load_lds((const unsigned*)((const char*)(gbase) + (v0)), (LAS unsigned*)(lds + (bufoff) + ldsw), 16, 0, 0); \
        __builtin_amdgcn_global_load_lds((const unsigned*)((const char*)(gbase) + (v1)), (LAS unsigned*)(lds + (bufoff) + ldsw + 8192), 16, 0, 0); } while (0)
#define PG8_STAGE_B(bufoff, gbase) PG8_STAGE(bufoff, gbase, voffB[0], voffB[1])
#define PG8_STAGE_A(bufoff, gbase, VO, h) PG8_STAGE(bufoff, gbase, VO[h][0], VO[h][1])
#define PG8_STAGE_A2(bufoff, gbase, h) do { if (Sched::GATHER && last) { PG8_STAGE_A(bufoff, gbase, vn, h); } else { PG8_STAGE_A(bufoff, gbase, vc, h); } } while (0)
#define PG8_LDA(dst, b, h) do { _Pragma("unroll") for (int m = 0; m < 4; ++m) _Pragma("unroll") for (int k = 0; k < 2; ++k) dst[m][k] = *(const LAS bf16x8*)(lds + PG8_SA(b, h) + aoff + m * 2048 + k * 1024); } while (0)
#define PG8_LDB(dst, b, h) do { _Pragma("unroll") for (int n = 0; n < 2; ++n) _Pragma("unroll") for (int k = 0; k < 2; ++k) dst[n][k] = *(const LAS bf16x8*)(lds + PG8_SB(b, h) + boff + n * 2048 + k * 1024); } while (0)
#define PG8_MMA(ai, bj, At, Bt) do { __builtin_amdgcn_s_setprio(1); _Pragma("unroll") for (int m = 0; m < 4; ++m) _Pragma("unroll") for (int n = 0; n < 2; ++n) _Pragma("unroll") for (int k = 0; k < 2; ++k) \
        acc[ai][bj][m][n] = __builtin_amdgcn_mfma_f32_16x16x32_bf16(Bt[n][k], At[m][k], acc[ai][bj][m][n], 0, 0, 0); __builtin_amdgcn_s_setprio(0); } while (0)
#define PG8_WAIT_V(n) asm volatile("s_waitcnt vmcnt(" #n ")" ::: "memory")
#define PG8_WAIT_L(n) asm volatile("s_waitcnt lgkmcnt(" #n ")" ::: "memory")
#define PG8_BAR __builtin_amdgcn_s_barrier()
#define PG8_SCHED __builtin_amdgcn_sched_barrier(0)
    Unit cur, nxt; int ui = 0;
    if (!S.next(0, cur)) return;
    f32x4 acc[2][2][4][2];
#pragma unroll
    for (int a = 0; a < 2; ++a)
#pragma unroll
        for (int b = 0; b < 2; ++b)
#pragma unroll
            for (int m = 0; m < 4; ++m)
#pragma unroll
                for (int n = 0; n < 2; ++n) acc[a][b][m][n] = (f32x4){0.f, 0.f, 0.f, 0.f};
    bf16x8 At[4][2], B0[2][2], B1[2][2];
    unsigned vc[2][2], vn[2][2];
#pragma unroll
    for (int h = 0; h < 2; ++h)
#pragma unroll
        for (int i = 0; i < 2; ++i) {
            if constexpr (Sched::GATHER) vc[h][i] = (unsigned)(S.arow(cur, h * HALF + RA[i]) * (unsigned)K + (unsigned)CA[i]) * 2u;
            else vc[h][i] = (unsigned)((h * HALF + RA[i]) * K + CA[i]) * 2u;
            vn[h][i] = vc[h][i];
        }
    const char* cA = S.abase(cur); const char* cB = S.bbase(cur);
    PG8_STAGE_B(PG8_SB(0, 0), cB); PG8_STAGE_A(PG8_SA(0, 0), cA, vc, 0); PG8_STAGE_B(PG8_SB(0, 1), cB + hstep); PG8_STAGE_A(PG8_SA(0, 1), cA, vc, 1);
    if (wr == 1) PG8_BAR;
    PG8_WAIT_V(4); PG8_BAR;
    PG8_STAGE_B(PG8_SB(1, 0), cB + kstep); PG8_STAGE_A(PG8_SA(1, 0), cA + kstep, vc, 0); PG8_STAGE_B(PG8_SB(1, 1), cB + hstep + kstep);
    PG8_WAIT_V(6); PG8_BAR;
    for (;;) {
        const bool has_next = S.next(ui + 1, nxt);
        const char* nA = has_next ? S.abase(nxt) : cA; const char* nB = has_next ? S.bbase(nxt) : cB;
        if constexpr (Sched::GATHER) {
            if (has_next) {
                int t2 = wave0 * 64 + lane_id(); asm volatile("" : "+v"(t2));
#pragma unroll
                for (int i = 0; i < 2; ++i) { int R, C; stage_rc(t2 * 16 + i * 8192, R, C);
#pragma unroll
                    for (int h = 0; h < 2; ++h) vn[h][i] = (unsigned)(S.arow(nxt, h * HALF + R) * (unsigned)K + (unsigned)C) * 2u; }
            }
        }
#pragma unroll 1
        for (int t = 0; t < nt; t += 2) {
            const bool last = (t == nt - 2);
            const char* a1 = cA + (size_t)(t + 1) * kstep;
            const char* a2 = last ? nA : cA + (size_t)(t + 2) * kstep; const char* b2 = last ? nB : cB + (size_t)(t + 2) * kstep;
            const char* a3 = a2 + kstep; const char* b3 = b2 + kstep;
            PG8_LDB(B0, 0, 0); PG8_SCHED; PG8_LDA(At, 0, 0); PG8_STAGE_A(PG8_SA(1, 1), a1, vc, 1);
            PG8_WAIT_L(8); PG8_BAR; PG8_WAIT_L(0); PG8_MMA(0, 0, At, B0); PG8_BAR; PG8_SCHED;
            PG8_LDB(B1, 0, 1); PG8_STAGE_B(PG8_SB(0, 0), b2);
            PG8_BAR; PG8_WAIT_L(0); PG8_MMA(0, 1, At, B1); PG8_BAR;
            PG8_LDA(At, 0, 1); PG8_STAGE_A2(PG8_SA(0, 0), a2, 0);
            PG8_BAR; PG8_WAIT_L(0); PG8_MMA(1, 0, At, B0); PG8_BAR; PG8_SCHED;
            PG8_STAGE_B(PG8_SB(0, 1), b2 + hstep);
            PG8_WAIT_V(6); PG8_BAR; PG8_MMA(1, 1, At, B1); PG8_BAR;
            PG8_LDB(B0, 1, 0); PG8_SCHED; PG8_LDA(At, 1, 0); PG8_STAGE_A2(PG8_SA(0, 1), a2, 1);
            PG8_WAIT_L(8); PG8_BAR; PG8_WAIT_L(0); PG8_MMA(0, 0, At, B0); PG8_BAR; PG8_SCHED;
            PG8_LDB(B1, 1, 1); PG8_STAGE_B(PG8_SB(1, 0), b3);
            PG8_BAR; PG8_WAIT_L(0); PG8_MMA(0, 1, At, B1); PG8_BAR;
            PG8_LDA(At, 1, 1); PG8_STAGE_A2(PG8_SA(1, 0), a3, 0);
            PG8_BAR; PG8_WAIT_L(0); PG8_MMA(1, 0, At, B0); PG8_BAR; PG8_SCHED;
            PG8_STAGE_B(PG8_SB(1, 1), b3 + hstep);
            PG8_WAIT_V(6); PG8_BAR; PG8_MMA(1, 1, At, B1); PG8_BAR;
        }
        { const int lz = lane_id(); E(acc, cur, wr, wc, lz & 15, lz >> 4); }
        if (!has_next) break;
        if (!Sched::keep_acc(cur)) {
#pragma unroll
        for (int a = 0; a < 2; ++a)
#pragma unroll
            for (int b = 0; b < 2; ++b)
#pragma unroll
                for (int m = 0; m < 4; ++m)
#pragma unroll
                    for (int n = 0; n < 2; ++n) acc[a][b][m][n] = (f32x4){0.f, 0.f, 0.f, 0.f};
        }
        cur = nxt; cA = nA; cB = nB; ++ui;
        if constexpr (Sched::GATHER) {
#pragma unroll
            for (int h = 0; h < 2; ++h)
#pragma unroll
                for (int i = 0; i < 2; ++i) vc[h][i] = vn[h][i];
        }
    }
    PG8_WAIT_V(0);
    if (wr == 0) PG8_BAR;
    PG8_BAR;
#undef PG8_SA
#undef PG8_SB
#undef PG8_STAGE
#undef PG8_STAGE_A
#undef PG8_STAGE_A2
#undef PG8_STAGE_B
#undef PG8_LDA
#undef PG8_LDB
#undef PG8_MMA
#undef PG8_WAIT_V
#undef PG8_WAIT_L
#undef PG8_BAR
#undef PG8_SCHED
}
}
using pg8::Unit;

#define XB_TMO      128
#define XB_XCNT(j)  (256  + 64 * (j))
#define XB_XSUB(j)  (1280 + 64 * (j))
#define XB_XGEN(j)  (2304 + 64 * (j))
#define XB_TOP      3328
#define XB_TOPGEN   3392
#define XCD_BAR_WORDS 3456
#define XB_SPIN_CAP (1u << 18)
__device__ __forceinline__ unsigned xb_ld(unsigned* p)              { return __hip_atomic_load(p, __ATOMIC_RELAXED, __HIP_MEMORY_SCOPE_AGENT); }
__device__ __forceinline__ unsigned xb_add(unsigned* p, unsigned v) { return __hip_atomic_fetch_add(p, v, __ATOMIC_RELAXED, __HIP_MEMORY_SCOPE_AGENT); }
__device__ __forceinline__ unsigned xb_xcc_id() { return (unsigned)__builtin_amdgcn_s_getreg((3 << 11) | 20) & 0xFu; }
#define XB_SPIN(cond, bar) do { unsigned _sp = 0; while (cond) { __builtin_amdgcn_s_sleep(1); \
    if ((++_sp & 255u) == 0u) { if (xb_ld(&(bar)[XB_TMO])) break; if (_sp > XB_SPIN_CAP) { atomicAdd(&(bar)[XB_TMO], 1u); break; } } } } while (0)
struct XcdBarrier { unsigned* bar; unsigned x; volatile LAS unsigned* st; };
__device__ __forceinline__ XcdBarrier xcd_barrier_post(unsigned* bar, volatile LAS unsigned* st) {
    XcdBarrier b; b.bar = bar; b.x = xb_xcc_id(); b.st = st;
    if (threadIdx.x == 0) (void)xb_add(&bar[XB_XCNT(b.x)], 1u);
    return b;
}
__device__ __forceinline__ void xcd_barrier_complete(unsigned* bar, unsigned x, unsigned& nloc, unsigned& nx) {
    const unsigned G = gridDim.x * gridDim.y * gridDim.z;
    unsigned sum, cnt, mine, sp = 0u;
    for (;;) {
        sum = 0u; cnt = 0u; mine = 0u;
#pragma unroll
        for (unsigned j = 0; j < 16; ++j) { const unsigned c = xb_ld(&bar[XB_XCNT(j)]); sum += c; cnt += (c > 0u) ? 1u : 0u; mine = (j == x) ? c : mine; }
        if (sum == G) break;
        __builtin_amdgcn_s_sleep(1);
        if ((++sp & 255u) == 0u) { if (xb_ld(&bar[XB_TMO])) break; if (sp > XB_SPIN_CAP) { atomicAdd(&bar[XB_TMO], 1u); break; } }
    }
    nloc = mine > 0u ? mine : 1u; nx = cnt > 0u ? cnt : 1u;
}
__device__ __forceinline__ void xcd_barrier(const XcdBarrier& b) {
    asm volatile("s_waitcnt vmcnt(0)" ::: "memory");
    __syncthreads();
    if (threadIdx.x == 0) {
        unsigned* bar = b.bar;
        __builtin_amdgcn_s_waitcnt(0);
        unsigned nloc = b.st[0], nx = b.st[1];
        if (nloc == 0u) { xcd_barrier_complete(bar, b.x, nloc, nx); b.st[0] = nloc; b.st[1] = nx; }
        const unsigned old = xb_add(&bar[XB_XSUB(b.x)], 1u);
        const unsigned gen = old / nloc;
        if (old + 1u == (gen + 1u) * nloc) {
            __builtin_amdgcn_fence(__ATOMIC_RELEASE, "agent");
            asm volatile("s_waitcnt vmcnt(0)" ::: "memory");
            const unsigned og = xb_add(&bar[XB_TOP], 1u);
            const unsigned tg = og / nx;
            if (og + 1u == (tg + 1u) * nx) xb_add(&bar[XB_TOPGEN], 1u);
            else XB_SPIN(xb_ld(&bar[XB_TOPGEN]) == tg, bar);
            __builtin_amdgcn_fence(__ATOMIC_ACQUIRE, "agent");
            xb_add(&bar[XB_XGEN(b.x)], 1u);
            asm volatile("s_waitcnt vmcnt(0)" ::: "memory");
        } else {
            XB_SPIN(xb_ld(&bar[XB_XGEN(b.x)]) == gen, bar);
            __builtin_amdgcn_fence(__ATOMIC_ACQUIRE, "agent");
            asm volatile("s_waitcnt vmcnt(0)" ::: "memory");
        }
    }
    __syncthreads();
}

struct Args { const float* in[19]; float* out; unsigned char* ws; int ph_lo, ph_hi; };
typedef const __attribute__((address_space(4))) Args* ArgsP;
enum { I_X = 0, I_N1G, I_WIN, I_CONVW, I_IFB, I_MNG, I_WBM, I_WBA, I_WOUT, I_RELB, I_N2G, I_WGRP, I_BGRP, I_WEXP, I_BEXP, I_W1, I_W3, I_W2, I_FG };


struct TrDesc { const float* W; bf16* WT; size_t ldn, ldk; int k0, n0, r0; };
__device__ __forceinline__ void tr_load(const TrDesc& d, f32x4 (&tv)[16], int lane) {
    const int nn4 = (lane & 15) * 4, kr = lane >> 4;
#pragma unroll
    for (int i = 0; i < 16; ++i) tv[i] = __builtin_nontemporal_load((const f32x4*)(d.W + (size_t)(d.k0 + 4 * i + kr) * d.ldn + d.n0 + nn4));
}
__device__ __forceinline__ void tr_finish(const TrDesc& d, f32x4 (&tv)[16], LAS float* scr, int lane) {
    const int nn4 = (lane & 15) * 4, kr = lane >> 4;
#pragma unroll
    for (int i = 0; i < 16; i += 4) asm volatile("" : "+v"(tv[i]), "+v"(tv[i + 1]), "+v"(tv[i + 2]), "+v"(tv[i + 3]));
#pragma unroll
    for (int i = 0; i < 16; ++i) { const int kk = 4 * i + kr; const f32x4 v = tv[i];
        LAS float* q = scr + kk * 65 + nn4; q[0] = v.x; q[1] = v.y; q[2] = v.z; q[3] = v.w; }
    LDS_WAIT();
    const int kc = (lane & 7) * 8;
#pragma unroll
    for (int p = 0; p < 8; ++p) { const int nn = 8 * p + (lane >> 3); const LAS float* sp = scr + kc * 65 + nn;
        u32x4 o; o.x = cvt_pk_bf16(sp[0], sp[65]); o.y = cvt_pk_bf16(sp[130], sp[195]); o.z = cvt_pk_bf16(sp[260], sp[325]); o.w = cvt_pk_bf16(sp[390], sp[455]);
        *(u32x4*)(d.WT + (size_t)(d.r0 + nn) * d.ldk + d.k0 + kc) = o; }
    LDS_WAIT();
}
__device__ __forceinline__ int win_src_col(int r) {
    if (r < 2048) return r;
    if (r < 3072) return r + 1024;
    if (r < 5120) return r + 1032;
    if (r < 9216) return r + 2056;
    if (r < 10240) return r - 7168;
    return r - 4088;
}
__device__ __forceinline__ TrDesc tr_decode(ArgsP a, unsigned char* ws, int it) {
    constexpr int PER_LAYER = 5632 + 512 + 512 + 1024 + 4096 + 4096 + 4096;
    const int l = it / PER_LAYER; int r = it % PER_LAYER;
    TrDesc d;
    if (r < 5632) { const int kb = r / 176, ng = r % 176;
        d.W = a->in[I_WIN] + (size_t)l * DM * INCOLS; d.ldn = INCOLS; d.k0 = 64 * kb; d.n0 = win_src_col(64 * ng); d.WT = (bf16*)(ws + WS_WINT) + (size_t)l * 11264 * 2048; d.ldk = 2048; d.r0 = 64 * ng; return d; }
    r -= 5632;
    if (r < 512) { const int kb = r / 32, ng = r % 32;
        d.W = a->in[I_WBM] + (size_t)l * 1024 * 2048; d.ldn = 2048; d.k0 = 64 * kb; d.n0 = 64 * ng; d.WT = (bf16*)(ws + WS_WBM) + (size_t)l * 2048 * 1024; d.ldk = 1024; d.r0 = 64 * ng; return d; }
    r -= 512;
    if (r < 512) { const int kb = r / 32, ng = r % 32;
        d.W = a->in[I_WBA] + (size_t)l * 1024 * 2048; d.ldn = 2048; d.k0 = 64 * kb; d.n0 = 64 * ng; d.WT = (bf16*)(ws + WS_WBA) + (size_t)l * 2048 * 1024; d.ldk = 1024; d.r0 = 64 * ng; return d; }
    r -= 512;
    if (r < 1024) { const int kb = r / 32, ng = r % 32;
        d.W = a->in[I_WOUT] + (size_t)l * 2048 * 2048; d.ldn = 2048; d.k0 = 64 * kb; d.n0 = 64 * ng; d.WT = (bf16*)(ws + WS_WOUT) + (size_t)l * 2048 * 2048; d.ldk = 2048; d.r0 = 64 * ng; return d; }
    r -= 1024;
    if (r < 8192) { const int w3 = r >= 4096; const int q = r & 4095; const int e = q >> 7, rr = q & 127, kb = rr >> 2, ng = rr & 3;
        d.W = a->in[w3 ? I_W3 : I_W1] + (size_t)(l * 32 + e) * 2048 * 256; d.ldn = 256; d.k0 = 64 * kb; d.n0 = 64 * ng;
        d.WT = (bf16*)(ws + WS_W13) + (size_t)(l * 32 + e) * 512 * 2048; d.ldk = 2048; d.r0 = 256 * (ng >> 1) + 64 * (ng & 1) + (w3 ? 128 : 0); return d; }
    r -= 8192;
    { const int e = r >> 7, rr = r & 127, kb = rr >> 5, ng = rr & 31;
        d.W = a->in[I_W2] + (size_t)(l * 32 + e) * 256 * 2048; d.ldn = 2048; d.k0 = 64 * kb; d.n0 = 64 * ng; d.WT = (bf16*)(ws + WS_W2) + (size_t)(l * 32 + e) * 2048 * 256; d.ldk = 256; d.r0 = 64 * ng; return d; }
}
#ifndef CVX
#define CVX 4096
#endif
__device__ __forceinline__ void prologue_phase(ArgsP a, LAS unsigned char* lds, int tid, int lane, int wave, int bid, int G, const int part = 0) {
    unsigned char* ws = a->ws;
    LAS float* scr = (LAS float*)(lds + wave * 16640);
    const int gw = bid * NWAVES + wave, NGW = G * NWAVES;
    constexpr int PER_LAYER = 5632 + 512 + 512 + 1024 + 4096 + 4096 + 4096;
    constexpr int W0 = 5632;
    const int v_lo = part == 0 ? 0 : part == 1 ? PER_LAYER : part == 2 ? W0 + CVX : PER_LAYER + W0 + CVX;
    const int v_hi = part == 0 ? W0 + 2 * CVX : part == 1 ? PER_LAYER + W0 : part == 2 ? PER_LAYER : 2 * PER_LAYER;
    const int split = part == 0 ? W0 + CVX : 0x7fffffff, jump = PER_LAYER - CVX;
#define CV_ITEM(v) ((v) < split ? (v) : (v) + jump)
    f32x4 tvA[16], tvB[16]; TrDesc dA, dB;
    int it = v_lo + gw;
    if (it < v_hi) { dA = tr_decode(a, ws, CV_ITEM(it)); tr_load(dA, tvA, lane); }
#pragma unroll 1
    while (it < v_hi) {
        int itn = it + NGW;
        if (itn < v_hi) { dB = tr_decode(a, ws, CV_ITEM(itn)); tr_load(dB, tvB, lane); }
        tr_finish(dA, tvA, scr, lane);
        it = itn; if (it >= v_hi) break;
        itn = it + NGW;
        if (itn < v_hi) { dA = tr_decode(a, ws, CV_ITEM(itn)); tr_load(dA, tvA, lane); }
        tr_finish(dB, tvB, scr, lane);
        it = itn;
    }
#undef CV_ITEM
    if (part != 0) return;
    const int gt = bid * NTHR + tid, NGT = G * NTHR;
    float* wrt = (float*)(ws + MS_WRT);
    for (int i = gt; i < 2 * 36 * 2048; i += NGT) { const int l = i / (36 * 2048), rr = i % (36 * 2048), n = rr >> 11, k = rr & 2047;
        wrt[i] = n < 4 ? a->in[I_WGRP][((size_t)l * DM + k) * 4 + n] : a->in[I_WEXP][((size_t)l * DM + k) * 32 + (n - 4)]; }
}

__device__ __forceinline__ void moe_tables(unsigned char* ws, int l, LAS unsigned char* misc, int tid) {
    LAS int* cnt = (LAS int*)(misc + MO_CNT); LAS int* ntl = (LAS int*)(misc + MO_NT); LAS int* off = (LAS int*)(misc + MO_OFF);
    LAS int* te = (LAS int*)(misc + MO_TE); LAS int* tr0 = (LAS int*)(misc + MO_TR0); LAS int* mt = (LAS int*)(misc + MO_MT);
    __syncthreads();
    if (tid < 32) { const int c = (int)__hip_atomic_load((unsigned*)(ws + WS_CTL) + CW_CNT + 32 * l + tid, __ATOMIC_RELAXED, __HIP_MEMORY_SCOPE_AGENT); cnt[tid] = c; ntl[tid] = (c + 255) >> 8; }
    __syncthreads();
    if (tid == 0) { int o = 0;
#pragma unroll 1
        for (int e = 0; e < 32; ++e) { off[e] = o; const int n = ntl[e];
#pragma unroll 1
            for (int j = 0; j < n; ++j) { te[o + j] = e; tr0[o + j] = 256 * j; } o += n; } off[32] = o; mt[0] = o; }
    __syncthreads();
}

#ifndef DRYX
#define DRYX 0
#endif
template <int MODE>
__device__ __forceinline__ void norm_phase(ArgsP a, int l, LAS unsigned char* lds, int tid, int lane, int wave, int bid, int G, const bool dry = false) {
    unsigned char* ws = a->ws;
    LAS unsigned char* misc = lds + MISC_OFF;
    if (MODE == 1 || MODE == 3) moe_tables(ws, MODE == 1 ? 0 : 1, misc, tid);
    const LAS int* off = (const LAS int*)(misc + MO_OFF);
    const float* src = (MODE == 0) ? a->in[I_X] : a->out;
    const float* gain = (MODE < 2) ? a->in[I_N1G] + l * DM : (MODE == 2 ? a->in[I_N2G] + l * DM : a->in[I_FG]);
    const int* toke = (const int*)(ws + MS_TOKE); const int* tokp = (const int*)(ws + MS_TOKP);
    const bf16* OP = (const bf16*)(ws + WS_OP);
    bf16* H = (bf16*)(ws + WS_H);
    const int gw = bid * NWAVES + wave, NGW = G * NWAVES;
    constexpr int RP = (MODE == 2) ? 4 : 2;
    for (int m0 = gw * RP; m0 < NTOK; m0 += NGW * RP) {
        f32x4 v[RP][8];
#pragma unroll
        for (int r = 0; r < RP; ++r)
#pragma unroll
            for (int j = 0; j < 8; ++j) v[r][j] = *(const f32x4*)(src + (size_t)(m0 + r) * DM + 256 * j + 4 * lane);
        if (MODE == 1 || MODE == 3) {
#pragma unroll
            for (int r = 0; r < RP; ++r) { const int m = m0 + r;
                const int e0 = toke[2 * m], e1 = toke[2 * m + 1], p0 = tokp[2 * m], p1 = tokp[2 * m + 1];
                const float cw0 = ((const float*)(ws + MS_TOKW))[2 * m], cw1 = ((const float*)(ws + MS_TOKW))[2 * m + 1];
                const bf16* o0 = OP + (size_t)(off[e0] * 256 + p0) * DM + 4 * lane; const bf16* o1 = OP + (size_t)(off[e1] * 256 + p1) * DM + 4 * lane;
                u32x2 ow0[8], ow1[8];
#pragma unroll
                for (int j = 0; j < 8; ++j) { ow0[j] = *(const u32x2*)(o0 + 256 * j); ow1[j] = *(const u32x2*)(o1 + 256 * j); }
                asm volatile("" : "+v"(ow0[0]), "+v"(ow0[1]), "+v"(ow0[2]), "+v"(ow0[3]), "+v"(ow0[4]), "+v"(ow0[5]), "+v"(ow0[6]), "+v"(ow0[7]),
                                  "+v"(ow1[0]), "+v"(ow1[1]), "+v"(ow1[2]), "+v"(ow1[3]), "+v"(ow1[4]), "+v"(ow1[5]), "+v"(ow1[6]), "+v"(ow1[7]));
#pragma unroll
                for (int j = 0; j < 8; ++j) { const u32x2 w0 = ow0[j], w1 = ow1[j];
                    v[r][j].x += cw0 * bflo(w0.x) + cw1 * bflo(w1.x); v[r][j].y += cw0 * bfhi(w0.x) + cw1 * bfhi(w1.x); v[r][j].z += cw0 * bflo(w0.y) + cw1 * bflo(w1.y); v[r][j].w += cw0 * bfhi(w0.y) + cw1 * bfhi(w1.y); }
                if (MODE == 1 && !dry) {
#pragma unroll
                    for (int j = 0; j < 8; ++j) *(f32x4*)(a->out + (size_t)m * DM + 256 * j + 4 * lane) = v[r][j]; }
                asm volatile("" ::: "memory");
            }
        }
        float rs[RP];
#pragma unroll
        for (int r = 0; r < RP; ++r) { float ss = 0.f;
#pragma unroll
            for (int j = 0; j < 8; ++j) ss += (v[r][j].x * v[r][j].x + v[r][j].y * v[r][j].y) + (v[r][j].z * v[r][j].z + v[r][j].w * v[r][j].w);
            rs[r] = __builtin_amdgcn_rsqf(wave_sum(ss) * (1.0f / DM) + RMS_EPS); }
        {
            f32x4 gv[8];
#pragma unroll
            for (int j = 0; j < 8; ++j) gv[j] = *(const f32x4*)(gain + 256 * j + 4 * lane);
            asm volatile("" : "+v"(gv[0]), "+v"(gv[1]), "+v"(gv[2]), "+v"(gv[3]), "+v"(gv[4]), "+v"(gv[5]), "+v"(gv[6]), "+v"(gv[7]));
#pragma unroll
            for (int j = 0; j < 8; ++j)
#pragma unroll
                for (int r = 0; r < RP; ++r) v[r][j] = v[r][j] * rs[r] * gv[j];
        }
        if (MODE == 3) {
#pragma unroll
            for (int r = 0; r < RP; ++r)
#pragma unroll
                for (int j = 0; j < 8; ++j) { if (!dry) *(f32x4*)(a->out + (size_t)(m0 + r) * DM + 256 * j + 4 * lane) = v[r][j]; else asm volatile("" :: "v"(v[r][j])); }
            continue;
        }
#pragma unroll
        for (int r = 0; r < RP; ++r)
#pragma unroll
            for (int j = 0; j < 8; ++j) { u32x2 w; w.x = cvt_pk_bf16(v[r][j].x, v[r][j].y); w.y = cvt_pk_bf16(v[r][j].z, v[r][j].w);
                if (!dry) *(u32x2*)(H + (size_t)(m0 + r) * DM + 256 * j + 4 * lane) = w; else asm volatile("" :: "v"(w)); }
        float keep[RP]; _Pragma("unroll") for (int r = 0; r < RP; ++r) keep[r] = 0.f;
        if (MODE < 2) {
            float a8[RP][8];
#pragma unroll
            for (int r = 0; r < RP; ++r)
#pragma unroll
                for (int n = 0; n < 8; ++n) a8[r][n] = 0.f;
            const float* wg = a->in[I_WIN] + (size_t)l * DM * INCOLS + 4096;
#pragma unroll
            for (int j = 0; j < 8; ++j)
#pragma unroll
                for (int c = 0; c < 4; ++c) { const float* wp = wg + (size_t)(256 * j + 4 * lane + c) * INCOLS;
                    const f32x4 w0 = *(const f32x4*)wp, w1 = *(const f32x4*)(wp + 4);
#pragma unroll
                    for (int r = 0; r < RP; ++r) { const float hv = v[r][j][c];
                        a8[r][0] += hv * w0.x; a8[r][1] += hv * w0.y; a8[r][2] += hv * w0.z; a8[r][3] += hv * w0.w;
                        a8[r][4] += hv * w1.x; a8[r][5] += hv * w1.y; a8[r][6] += hv * w1.z; a8[r][7] += hv * w1.w; }
                    if (c == 3) asm volatile("" ::: "memory"); }
#pragma unroll
            for (int r = 0; r < RP; ++r)
#pragma unroll
                for (int n = 0; n < 8; ++n) { const float d = wave_sum(a8[r][n]); keep[r] = (lane == n) ? d : keep[r]; }
        } else {
            const float* W = (const float*)(ws + MS_WRT) + (size_t)l * 36 * 2048;
            LAS float* logl = (LAS float*)(misc + MO_LOG) + wave * 160;
#pragma unroll 1
            for (int grp = 0; grp < 9; ++grp) {
                float val[16];
                const float* wg = W + (size_t)(4 * grp) * 2048 + 4 * lane;
#pragma unroll
                for (int nl = 0; nl < 4; ++nl) {
                    float d[4] = {0.f, 0.f, 0.f, 0.f};
                    f32x4 wv[8];
#pragma unroll
                    for (int j = 0; j < 8; ++j) wv[j] = *(const f32x4*)(wg + nl * 2048 + 256 * j);
                    asm volatile("" : "+v"(wv[0]), "+v"(wv[1]), "+v"(wv[2]), "+v"(wv[3]), "+v"(wv[4]), "+v"(wv[5]), "+v"(wv[6]), "+v"(wv[7]));
#pragma unroll
                    for (int j = 0; j < 8; ++j) { const f32x4 w = wv[j];
#pragma unroll
                        for (int r = 0; r < 4; ++r) d[r] += (v[r][j].x * w.x + v[r][j].y * w.y) + (v[r][j].z * w.z + v[r][j].w * w.w); }
#pragma unroll
                    for (int r = 0; r < 4; ++r) val[4 * nl + r] = d[r];
                }
#pragma unroll
                for (int i = 0; i < 8; ++i) { const bool hi = (lane & 32) != 0; const float snd = hi ? val[i] : val[i + 8]; const float kp = hi ? val[i + 8] : val[i]; val[i] = kp + __shfl_xor(snd, 32); }
#pragma unroll
                for (int i = 0; i < 4; ++i) { const bool hi = (lane & 16) != 0; const float snd = hi ? val[i] : val[i + 4]; const float kp = hi ? val[i + 4] : val[i]; val[i] = kp + __shfl_xor(snd, 16); }
#pragma unroll
                for (int i = 0; i < 2; ++i) { const bool hi = (lane & 8) != 0; const float snd = hi ? val[i] : val[i + 2]; const float kp = hi ? val[i + 2] : val[i]; val[i] = kp + __shfl_xor(snd, 8); }
                { const bool hi = (lane & 4) != 0; const float snd = hi ? val[0] : val[1]; const float kp = hi ? val[1] : val[0]; val[0] = kp + __shfl_xor(snd, 4); }
                float f = val[0]; f += __shfl_xor(f, 2); f += __shfl_xor(f, 1);
                const int vi = lane >> 2;
                if ((lane & 3) == 0) logl[(vi & 3) * 40 + 4 * grp + (vi >> 2)] = f;
            }
        }
        if (MODE < 2) {
            float* ifg = (float*)(ws + MS_IFG);
            if (lane < 8) {
#pragma unroll
                for (int r = 0; r < RP; ++r) { if (!dry) ifg[(size_t)(m0 + r) * 8 + lane] = keep[r]; else asm volatile("" :: "v"(keep[r])); } }
        } else {
            LAS float* logl = (LAS float*)(misc + MO_LOG) + wave * 160;
            LDS_WAIT();
            if (dry) { asm volatile("" :: "v"(keep[0])); }
            if (lane < RP && !dry) {
                const int m = m0 + lane; const LAS float* lg = logl + lane * 40;
                const float* bg = a->in[I_BGRP] + l * 4; const float* be = a->in[I_BEXP] + l * 32;
                float gv[4]; int gsel = 0;
#pragma unroll
                for (int j = 0; j < 4; ++j) gv[j] = lg[j] + bg[j];
                float gmax = gv[0];
#pragma unroll
                for (int j = 1; j < 4; ++j) if (gv[j] > gmax) { gmax = gv[j]; gsel = j; }
                float gs = 0.f;
#pragma unroll
                for (int j = 0; j < 4; ++j) gs += expf(gv[j] - gmax);
                const float pg = 1.0f / gs;
                float ev[8];
#pragma unroll
                for (int j = 0; j < 8; ++j) ev[j] = lg[4 + 8 * gsel + j] + be[8 * gsel + j];
                int e0 = 0; float m0v = ev[0];
#pragma unroll
                for (int j = 1; j < 8; ++j) if (ev[j] > m0v) { m0v = ev[j]; e0 = j; }
                int e1 = -1; float m1v = -3.0e38f;
#pragma unroll
                for (int j = 0; j < 8; ++j) if (j != e0 && ev[j] > m1v) { m1v = ev[j]; e1 = j; }
                const float p1 = expf(m1v - m0v); const float w0 = pg / (1.0f + p1), w1 = pg * p1 / (1.0f + p1);
                unsigned* cnt = (unsigned*)(ws + WS_CTL) + CW_CNT + 32 * l;
                int* list = (int*)(ws + MS_LIST); float* pwl = (float*)(ws + MS_PWL); int* tke = (int*)(ws + MS_TOKE); int* tkp = (int*)(ws + MS_TOKP);
                const int id0 = 8 * gsel + e0, id1 = 8 * gsel + e1;
                const int q0 = (int)__hip_atomic_fetch_add(cnt + id0, 1u, __ATOMIC_RELAXED, __HIP_MEMORY_SCOPE_AGENT);
                const int q1 = (int)__hip_atomic_fetch_add(cnt + id1, 1u, __ATOMIC_RELAXED, __HIP_MEMORY_SCOPE_AGENT);
                list[id0 * 8192 + q0] = m; pwl[id0 * 8192 + q0] = w0; list[id1 * 8192 + q1] = m; pwl[id1 * 8192 + q1] = w1;
                tke[2 * m] = id0; tke[2 * m + 1] = id1; tkp[2 * m] = q0; tkp[2 * m + 1] = q1;
                ((float*)(ws + MS_TOKW))[2 * m] = w0; ((float*)(ws + MS_TOKW))[2 * m + 1] = w1;
            }
            LDS_WAIT();
        }
    }
}

struct SchedG1 {
    static constexpr bool GATHER = false;
    const char* H; const char* W; int G, c;
    static constexpr int NCV = 21;
    __device__ __forceinline__ bool next(int i, Unit& u) const {
        int L = i * G + c;
        if (G == 256) {
            if (c >= 256 - NCV) return false;
            if (c >= 128 && i == 5) { const int k = c - 128; if (k >= 5 * NCV) return false; L = (k % 5) * 256 + (256 - NCV) + k / 5; }
            else if (i > 5) return false;
        }
        if (L < 1152) { pg8::static_tile(L, 32, 36, u.pm, u.pn); u.aux = 0; return true; }
        const int r = L - 1152; if (r >= 256) return false;
        u.aux = 1 + (r >> 7); const int q = r & 127; u.pm = q & 3; u.pn = q >> 2; return true;
    }
    __device__ __forceinline__ const char* abase(const Unit& u) const { return u.aux == 0 ? H + (size_t)u.pm * 256 * 4096 : W + (size_t)(9216 + (u.aux - 1) * 1024 + u.pm * 256) * 4096; }
    __device__ __forceinline__ const char* bbase(const Unit& u) const { return u.aux == 0 ? W + (size_t)u.pn * 256 * 4096 : H + (size_t)u.pn * 256 * 4096; }
    __device__ __forceinline__ unsigned arow(const Unit&, int) const { return 0u; }
    static __device__ __forceinline__ bool keep_acc(const Unit&) { return false; }
};
struct EpiG1 {
    static constexpr bool PERM = true;
    unsigned char* ws; bool dry;
    __device__ __forceinline__ void operator()(f32x4 (&acc)[2][2][4][2], const Unit& u, int wr, int wc, int fr, int fq) const {
        if (dry) {
#pragma unroll
            for (int ai = 0; ai < 2; ++ai)
#pragma unroll
                for (int bj = 0; bj < 2; ++bj)
#pragma unroll
                    for (int m = 0; m < 4; ++m) asm volatile("" :: "v"(acc[ai][bj][m][0]), "v"(acc[ai][bj][m][1]));
            return; }
        if (u.aux == 0) {
            bf16* dst; int ld, colt, op;
            if (u.pn < 8) { dst = (bf16*)(ws + WS_ZQK); ld = 2048; colt = 256 * u.pn; op = 0; }
            else if (u.pn < 12) { dst = (bf16*)(ws + WS_OM); ld = 1024; colt = 256 * (u.pn - 8); op = 1; }
            else if (u.pn < 16) { dst = (bf16*)(ws + WS_QA); ld = 1024; colt = 256 * (u.pn - 12); op = 2; }
            else if (u.pn < 20) { dst = (bf16*)(ws + WS_KA); ld = 1024; colt = 256 * (u.pn - 16); op = 0; }
            else { dst = (bf16*)(ws + WS_SG); ld = 4096; colt = 256 * (u.pn - 20); op = 1; }
            const float scl = (op == 2) ? 0.12751743074602267f : 1.0f;
            const int row0 = u.pm * 256 + wr * 64 + fr, col0 = colt + wc * 32 + 8 * fq;
#pragma unroll
            for (int ai = 0; ai < 2; ++ai)
#pragma unroll
                for (int m = 0; m < 4; ++m) { bf16* rowp = dst + (size_t)(row0 + ai * 128 + m * 16) * ld + col0;
#pragma unroll
                    for (int bj = 0; bj < 2; ++bj) { f32x4 v0 = acc[ai][bj][m][0] * scl, v1 = acc[ai][bj][m][1] * scl;
                        if (op == 1) {
#pragma unroll
                            for (int j = 0; j < 4; ++j) { v0[j] = sigmoidf_(v0[j]); v1[j] = sigmoidf_(v1[j]); } }
                        u32x4 w; w.x = cvt_pk_bf16(v0[0], v0[1]); w.y = cvt_pk_bf16(v0[2], v0[3]); w.z = cvt_pk_bf16(v1[0], v1[1]); w.w = cvt_pk_bf16(v1[2], v1[3]);
                        *(u32x4*)(rowp + bj * 128) = w; } }
        } else {
            bf16* dst = (bf16*)(ws + (u.aux == 1 ? WS_VMT : WS_VAT));
            const int b = u.pn >> 3, s0 = (u.pn & 7) * 256 + wc * 32 + 8 * fq, rr0 = u.pm * 256 + wr * 64 + fr;
#pragma unroll
            for (int ai = 0; ai < 2; ++ai)
#pragma unroll
                for (int m = 0; m < 4; ++m) { const int rr = rr0 + ai * 128 + m * 16;
#pragma unroll
                    for (int bj = 0; bj < 2; ++bj) { const f32x4 v0 = acc[ai][bj][m][0], v1 = acc[ai][bj][m][1];
                        u32x4 w; w.x = cvt_pk_bf16(v0[0], v0[1]); w.y = cvt_pk_bf16(v0[2], v0[3]); w.z = cvt_pk_bf16(v1[0], v1[1]); w.w = cvt_pk_bf16(v1[2], v1[3]);
                        const int sq = s0 + bj * 128;
                        const size_t off = (u.aux == 1) ? (size_t)((((b * 4 + (rr >> 8)) * 32 + (sq >> 6)) * 2 + ((sq >> 5) & 1)) * 16 + ((rr & 255) >> 4)) * 512 + (size_t)((((sq >> 3) & 3) * 16 + (rr & 15)) * 8)
                                                        : (size_t)(b * 1024 + rr) * 2048 + sq;
                        *(u32x4*)(dst + off) = w; } }
        }
    }
};

__device__ __forceinline__ void gate_unit(ArgsP a, int l, LAS unsigned char* lds, int bh, int tid, int lane, int wave) {
    unsigned char* ws = a->ws;
    {
            const int b = bh >> 2, h = bh & 3;
            LAS float* bl = (LAS float*)lds; LAS float* amx = bl + 32; LAS float* mpv = bl + 64; LAS float* gcv = bl + 96;
            const float* ifg = (const float*)(ws + MS_IFG); const float* ifb = a->in[I_IFB] + l * 8;
            float A[4], Bs[4], CM[4];
#pragma unroll
            for (int cc = 0; cc < 4; ++cc) { const int c = wave + 8 * cc, s = 64 * c + lane; const size_t tok = (size_t)b * SEQ + s;
                const float ig = ifg[tok * 8 + h] + ifb[h], fg = ifg[tok * 8 + 4 + h] + ifb[4 + h];
                const float lf = fminf(fg, 0.f) - log1pf(expf(-fabsf(fg)));
                float bs = lf;
#pragma unroll
                for (int o = 1; o < 64; o <<= 1) { const float t = __shfl_up(bs, o); if (lane >= o) bs += t; }
                const float av = ig - bs; float cm = av;
#pragma unroll
                for (int o = 1; o < 64; o <<= 1) { const float t = __shfl_up(cm, o); if (lane >= o) cm = fmaxf(cm, t); }
                A[cc] = av; Bs[cc] = bs; CM[cc] = cm;
                if (lane == 63) { bl[c] = bs; amx[c] = cm; } }
            __syncthreads();
            if (tid == 0) { float m = 0.f;
#pragma unroll 1
                for (int c = 0; c < 32; ++c) { mpv[c] = m; const float Gm = fmaxf(m, amx[c]); gcv[c] = Gm; m = bl[c] + Gm; } }
            __syncthreads();
            float* AS = (float*)(ws + MS_AS) + bh * 2048; float* GT = (float*)(ws + MS_GT) + bh * 2048; float* WI = (float*)(ws + MS_WI) + bh * 2048;
            float* CL = (float*)(ws + MS_CL) + bh * 2048; float* WSs = (float*)(ws + MS_WS) + bh * 2048; float* DEC = (float*)(ws + MS_DEC) + bh * 32;
#pragma unroll
            for (int cc = 0; cc < 4; ++cc) { const int c = wave + 8 * cc, s = 64 * c + lane; const float mp = mpv[c], Gm = gcv[c], gt = fmaxf(mp, CM[cc]);
                AS[s] = A[cc]; GT[s] = gt; WI[s] = expf(mp - gt); CL[s] = expf(-(Bs[cc] + gt)); WSs[s] = expf(A[cc] - Gm);
                if (lane == 0) DEC[c] = expf(mp - Gm); }
        }
    __syncthreads();
}

__device__ __forceinline__ void conv_phase(ArgsP a, int l, LAS unsigned char* lds, int tid, int lane, int wave, int bid, int G) {
    unsigned char* ws = a->ws;
    u32x4 xv[5];
    const bf16* Z = (const bf16*)(ws + WS_ZQK);
#define CONV_LOAD(u_) do { const int cg_ = (u_) & 7, s0_ = 64 * (((u_) >> 3) & 31), b_ = (u_) >> 8; _Pragma("unroll") for (int i = 0; i < 5; ++i) { \
        const int idx = tid + NTHR * i, row = idx >> 5, ch = idx & 31, sq = s0_ - 3 + row; xv[i] = (u32x4){0u, 0u, 0u, 0u}; \
        if (idx < 67 * 32 && sq >= 0) xv[i] = *(const u32x4*)(Z + (size_t)(b_ * SEQ + sq) * 2048 + cg_ * 256 + ch * 8); } } while (0)
    if (bid < 1024) CONV_LOAD(bid);
    for (int u = bid; u < 1024 + 256; u += G) {
        if (u < 1024) {
            const int cg = u & 7, st = (u >> 3) & 31, b = u >> 8, s0 = 64 * st;
            LAS unsigned char* xt = lds; LAS unsigned char* kt = lds + 36864;
            asm volatile("" : "+v"(xv[0]), "+v"(xv[1]), "+v"(xv[2]), "+v"(xv[3]), "+v"(xv[4]));
#pragma unroll
            for (int i = 0; i < 5; ++i) { const int idx = tid + NTHR * i, row = idx >> 5, ch = idx & 31;
                if (idx < 67 * 32) *(LAS u32x4*)(xt + row * 512 + ch * 16) = xv[i]; }
            LAS float* wst = (LAS float*)(lds + 73728);
            if (cg >= 4 && tid < 64) wst[tid] = ((const float*)(ws + MS_WS))[(size_t)(b * 4 + cg - 4) * 2048 + s0 + tid];
            __syncthreads();
            if (u + G < 1024) CONV_LOAD(u + G);
            const int cp = tid & 127, tg = tid >> 7, c = 2 * cp, gc = cg * 256 + c;
            float w0[4], w1[4];
#pragma unroll
            for (int j = 0; j < 4; ++j) { w0[j] = a->in[I_CONVW][(size_t)(l * 4 + j) * 2048 + gc]; w1[j] = a->in[I_CONVW][(size_t)(l * 4 + j) * 2048 + gc + 1]; }
            bf16* QM = (bf16*)(ws + WS_QM); bf16* KM = (bf16*)(ws + WS_KM);
#pragma unroll 4
            for (int tt = 0; tt < 16; ++tt) { const int t = tg * 16 + tt; float a0 = 0.f, a1 = 0.f;
#pragma unroll
                for (int j = 0; j < 4; ++j) { const unsigned x = *(const LAS unsigned*)(xt + (t + j) * 512 + c * 2); a0 += w0[j] * bflo(x); a1 += w1[j] * bfhi(x); }
                float o0 = a0 * sigmoidf_(a0), o1 = a1 * sigmoidf_(a1);
                const size_t tok = (size_t)b * SEQ + s0 + t;
                if (cg < 4) { *(unsigned*)(QM + tok * 1024 + cg * 256 + c) = cvt_pk_bf16(o0, o1); }
                else { o0 *= 0.0625f; o1 *= 0.0625f; const unsigned p = cvt_pk_bf16(o0, o1);
                    *(unsigned*)(KM + tok * 1024 + (cg - 4) * 256 + c) = p;
                    const float wsv = wst[t]; const unsigned ps = cvt_pk_bf16(o0 * wsv, o1 * wsv);
                    *(LAS unsigned short*)(kt + c * 144 + t * 2) = (unsigned short)(ps & 0xffffu); *(LAS unsigned short*)(kt + (c + 1) * 144 + t * 2) = (unsigned short)(ps >> 16); }
            }
            if (cg >= 4) {
                __syncthreads();
                bf16* KMT = (bf16*)(ws + WS_KMT);
                for (int idx = tid; idx < 2048; idx += NTHR) {
                    const int ks = idx >> 10, dtl = (idx >> 6) & 15, ln = idx & 63, row = dtl * 16 + (ln & 15), ch = ks * 4 + (ln >> 4);
                    const u32x4 v = *(const LAS u32x4*)(kt + row * 144 + ch * 16);
                    *(u32x4*)(KMT + (size_t)(((b * 4 + cg - 4) * 32 + st) * 2) * 8192 + (size_t)idx * 8) = v; }
                if (tid < 256) {
                    float sm = 0.f;
#pragma unroll
                    for (int i = 0; i < 8; ++i) { const u32x4 v = *(const LAS u32x4*)(kt + tid * 144 + i * 16);
                        sm += (bflo(v.x) + bfhi(v.x)) + (bflo(v.y) + bfhi(v.y)) + (bflo(v.z) + bfhi(v.z)) + (bflo(v.w) + bfhi(v.w)); }
                    ((float*)(ws + MS_NST))[(size_t)((b * 4 + cg - 4) * 32 + st) * 256 + tid] = sm; }
            }
        } else if (u < 1280) {
            const int j = u - 1024, b = j >> 6, n = (j >> 3) & 7, h = j & 7;
            const bf16* KA = (const bf16*)(ws + WS_KA) + (size_t)(b * SEQ + n * 256 + wave * 32) * 1024 + h * 128 + 2 * lane;
            float s0 = 0.f, s1 = 0.f;
            unsigned xr[32];
#pragma unroll
            for (int r = 0; r < 32; ++r) xr[r] = *(const unsigned*)(KA + (size_t)r * 1024);
#pragma unroll
            for (int r = 0; r < 32; r += 8) asm volatile("" : "+v"(xr[r]), "+v"(xr[r + 1]), "+v"(xr[r + 2]), "+v"(xr[r + 3]), "+v"(xr[r + 4]), "+v"(xr[r + 5]), "+v"(xr[r + 6]), "+v"(xr[r + 7]));
#pragma unroll
            for (int r = 0; r < 32; ++r) { s0 += bflo(xr[r]); s1 += bfhi(xr[r]); }
            LAS float* part = (LAS float*)lds;
            part[wave * 128 + 2 * lane] = s0; part[wave * 128 + 2 * lane + 1] = s1;
            __syncthreads();
            if (tid < 128) { float t = 0.f;
#pragma unroll
                for (int w = 0; w < 8; ++w) t += part[w * 128 + tid];
                ((float*)(ws + MS_KMEAN))[(size_t)((b * 8 + h) * 8 + n) * 128 + tid] = t * (1.0f / 256.0f); }
        }
        __syncthreads();
    }
}

#undef CONV_LOAD
__device__ __forceinline__ void mlstm_ab_task(unsigned char* ws, int gw, int lane, const bool do_store = true) {
    const int bh = gw >> 7, piece = gw & 127, e0 = (piece >> 3) * 16, d0 = (piece & 7) * 32, q16 = lane & 15, g = lane >> 4;
    const bf16* ka = (const bf16*)(ws + WS_KMT) + (size_t)bh * 32 * 16384 + (size_t)(d0 >> 4) * 512 + lane * 8;
    const bf16* vb = (const bf16*)(ws + WS_VMT) + (size_t)bh * 32 * 16384 + (size_t)(e0 >> 4) * 512 + lane * 8;
    const float* DEC = (const float*)(ws + MS_DEC) + bh * 32;
    bf16* CST = (bf16*)(ws + WS_CST) + (size_t)bh * 32 * 65536 + (size_t)((d0 >> 5) * 16 + (e0 >> 4)) * 512 + (size_t)(((g >> 1) * 16 + q16) * 8 + 4 * (g & 1));
    f32x4 acc[2]; acc[0] = (f32x4){0.f, 0.f, 0.f, 0.f}; acc[1] = acc[0];
    const int decv = __builtin_bit_cast(int, DEC[lane & 31]);
    bf16x8 A0[2][2], B0[2], A1[2][2], B1[2], A2[2][2], B2[2], A3[2][2], B3[2], A4[2][2], B4[2];
#define AB_LOAD(c_, A_, B_) do { const int cc_ = (c_) < 31 ? (c_) : 31; _Pragma("unroll") for (int ks = 0; ks < 2; ++ks) { \
        A_[0][ks] = *(const bf16x8*)(ka + (size_t)cc_ * 16384 + ks * 8192); A_[1][ks] = *(const bf16x8*)(ka + (size_t)cc_ * 16384 + ks * 8192 + 512); B_[ks] = *(const bf16x8*)(vb + (size_t)cc_ * 16384 + ks * 8192); } } while (0)
#define AB_STEP(c_, A_, B_) do { \
        if (do_store) { _Pragma("unroll") for (int f = 0; f < 2; ++f) { u32x2 w; w.x = cvt_pk_bf16(acc[f][0], acc[f][1]); w.y = cvt_pk_bf16(acc[f][2], acc[f][3]); *(u32x2*)(CST + (size_t)(c_) * 65536 + 256 * f) = w; } } \
        const float dec = __builtin_bit_cast(float, __builtin_amdgcn_readlane(decv, (c_))); \
        acc[0] = acc[0] * dec; acc[1] = acc[1] * dec; \
        _Pragma("unroll") for (int ks = 0; ks < 2; ++ks) { \
            acc[0] = __builtin_amdgcn_mfma_f32_16x16x32_bf16(A_[0][ks], B_[ks], acc[0], 0, 0, 0); \
            acc[1] = __builtin_amdgcn_mfma_f32_16x16x32_bf16(A_[1][ks], B_[ks], acc[1], 0, 0, 0); } } while (0)
    AB_LOAD(0, A0, B0); AB_LOAD(1, A1, B1); AB_LOAD(2, A2, B2); AB_LOAD(3, A3, B3); AB_LOAD(4, A4, B4);
#pragma unroll 1
    for (int c = 0; c < 30; c += 5) {
        AB_STEP(c, A0, B0); AB_LOAD(c + 5, A0, B0);
        AB_STEP(c + 1, A1, B1); AB_LOAD(c + 6, A1, B1);
        AB_STEP(c + 2, A2, B2); AB_LOAD(c + 7, A2, B2);
        AB_STEP(c + 3, A3, B3); AB_LOAD(c + 8, A3, B3);
        AB_STEP(c + 4, A4, B4); AB_LOAD(c + 9, A4, B4);
    }
    AB_STEP(30, A0, B0); AB_STEP(31, A1, B1);
    if (!do_store) asm volatile("" :: "v"(acc[0]), "v"(acc[1]));
#undef AB_LOAD
#undef AB_STEP
}

__device__ __forceinline__ void nscan_task(unsigned char* ws, int t, int lane) {
    const int bh = t >> 2, d = (t & 3) * 64 + lane;
    const float* cs = (const float*)(ws + MS_NST) + (size_t)bh * 32 * 256 + d;
    float* nv = (float*)(ws + MS_NVEC) + (size_t)bh * 32 * 256 + d;
    const int decv = __builtin_bit_cast(int, ((const float*)(ws + MS_DEC))[bh * 32 + (lane & 31)]);
    float v[32];
#pragma unroll
    for (int j = 0; j < 32; ++j) v[j] = cs[j * 256];
    float n = 0.f;
#pragma unroll
    for (int j = 0; j < 32; ++j) { nv[j * 256] = n; n = __builtin_bit_cast(float, __builtin_amdgcn_readlane(decv, j)) * n + v[j]; }
}

__device__ __forceinline__ int rel_bucket_dev(int n) {
    if (n < 16) return n;
    int b = 16;
    b += (n >= 19); b += (n >= 21); b += (n >= 24); b += (n >= 27); b += (n >= 31); b += (n >= 35); b += (n >= 40); b += (n >= 46);
    b += (n >= 52); b += (n >= 59); b += (n >= 67); b += (n >= 77); b += (n >= 87); b += (n >= 99); b += (n >= 113);
    return b;
}
constexpr int AT_KT = 0, AT_VT = 34816, AT_TAB = 71680, AT_SEL = 72704, AT_TILES = 73216, AT_CTL = 73600, AT_KM = 73728;
__device__ __forceinline__ void attn_unit(ArgsP a, LAS unsigned char* lds, int uidx, int tid, int lane, int wave) {
    unsigned char* ws = a->ws;
    const int u256 = uidx & 255, second = uidx >> 8, bh = u256 >> 3, kk8 = u256 & 7, si = second ? 15 - kk8 : kk8, wgt = 16 - si;
    const int blk = (wgt - 1) >> 1, half = (wgt - 1) & 1, b = bh >> 3, h = bh & 7, q0 = blk * 256 + half * 128;
    const int q16 = lane & 15, g = lane >> 4;
    LAS float* tab = (LAS float*)(lds + AT_TAB); LAS unsigned* sels = (LAS unsigned*)(lds + AT_SEL); LAS int* tiles = (LAS int*)(lds + AT_TILES);
    LAS unsigned* ctl = (LAS unsigned*)(lds + AT_CTL); LAS float* kms = (LAS float*)(lds + AT_KM);
    const bf16* QA = (const bf16*)(ws + WS_QA); const bf16* KA = (const bf16*)(ws + WS_KA); const bf16* VAT = (const bf16*)(ws + WS_VAT);
    u32x4 sr[8], qst[4];
    const int row0 = tid >> 4, ch = tid & 15;
    const bf16* kbase = KA + (size_t)(b * SEQ + row0) * 1024 + h * 128 + ch * 8;
    const bf16* vbase = VAT + (size_t)(bh * 128 + row0) * 2048 + ch * 8;
#define AT_LOAD(ks0_) do { _Pragma("unroll") for (int i = 0; i < 4; ++i) { \
        sr[i] = *(const u32x4*)(kbase + (size_t)((ks0_) + 32 * i) * 1024); sr[4 + i] = *(const u32x4*)(vbase + (size_t)(32 * i) * 2048 + (ks0_)); } } while (0)
#pragma unroll
    for (int i = 0; i < 4; ++i) qst[i] = *(const u32x4*)(QA + (size_t)(b * SEQ + q0 + row0 + 32 * i) * 1024 + h * 128 + ch * 8);
    AT_LOAD(blk * 256);
    if (tid <= 128) tab[tid] = a->in[I_RELB][rel_bucket_dev(tid) * 8 + h] * 1.4426950408889634f;
    for (int idx = tid; idx < 1024; idx += NTHR) kms[idx] = ((const float*)(ws + MS_KMEAN))[bh * 1024 + idx];
    if (tid == 0) ctl[0] = 0u;
    __syncthreads();
    {
        const int q = tid >> 2, part = tid & 3;
        const bf16* qp = QA + (size_t)(b * SEQ + q0 + q) * 1024 + h * 128 + part * 32;
        float qf32[32];
#pragma unroll
        for (int i = 0; i < 4; ++i) { const u32x4 v = *(const u32x4*)(qp + 8 * i);
            qf32[8 * i + 0] = bflo(v.x); qf32[8 * i + 1] = bfhi(v.x); qf32[8 * i + 2] = bflo(v.y); qf32[8 * i + 3] = bfhi(v.y);
            qf32[8 * i + 4] = bflo(v.z); qf32[8 * i + 5] = bfhi(v.z); qf32[8 * i + 6] = bflo(v.w); qf32[8 * i + 7] = bfhi(v.w); }
        float gate[8];
#pragma unroll
        for (int n = 0; n < 8; ++n) { float s = 0.f;
            if (n < blk) {
#pragma unroll
                for (int d = 0; d < 32; d += 4) { const f32x4 kv = *(const LAS f32x4*)(kms + n * 128 + part * 32 + d);
                    s += (qf32[d] * kv.x + qf32[d + 1] * kv.y) + (qf32[d + 2] * kv.z + qf32[d + 3] * kv.w); }
            }
            s += __shfl_xor(s, 1); s += __shfl_xor(s, 2); gate[n] = s; }
        if (part == 0) {
            unsigned sel;
            if (blk <= 3) sel = (1u << blk) - 1u;
            else { sel = 0u;
#pragma unroll
                for (int it = 0; it < 3; ++it) { int best = 0; float bv = -3.0e38f;
#pragma unroll
                    for (int n = 0; n < 8; ++n) if (n < blk && !((sel >> n) & 1u) && gate[n] > bv) { bv = gate[n]; best = n; }
                    sel |= 1u << best; } }
            sels[q] = sel; atomicOr((unsigned*)ctl, sel);
        }
    }
    __syncthreads();
    if (tid == 0) { int nt = 0; const unsigned any = ctl[0];
        for (int j = 0; j < half + 1; ++j) tiles[nt++] = blk * 256 + 128 * j;
        for (int n = 0; n < blk; ++n) if ((any >> n) & 1u) for (int j = 0; j < 2; ++j) tiles[nt++] = n * 256 + 128 * j;
        ctl[1] = (unsigned)nt; }
    __syncthreads();
    const int ntiles = (int)ctl[1];
    const int qg = wave & 3, kp = wave >> 2;
    int qpos[2]; unsigned mysel[2];
#pragma unroll
    for (int f = 0; f < 2; ++f) { qpos[f] = q0 + 32 * qg + 16 * f + q16; mysel[f] = sels[32 * qg + 16 * f + q16]; }
    constexpr int AT_Q = 77824;
#pragma unroll
    for (int i = 0; i < 4; ++i) *(LAS u32x4*)(lds + AT_Q + (row0 + 32 * i) * 272 + ch * 16) = qst[i];
    const LAS unsigned char* qrow = lds + AT_Q + (32 * qg + q16) * 272 + 16 * g;
    float m_run[2] = {-1.0e30f, -1.0e30f}, l_run[2] = {0.f, 0.f};
    f32x4 oacc[2][8];
#pragma unroll
    for (int f = 0; f < 2; ++f)
#pragma unroll
        for (int m = 0; m < 8; ++m) oacc[f][m] = (f32x4){0.f, 0.f, 0.f, 0.f};
    const int vpos = (ch >> 2) * 32 + 16 * (ch & 1) + 4 * ((ch & 3) >> 1);
#define AT_WRITE() do { _Pragma("unroll") for (int i = 0; i < 4; ++i) { \
        *(LAS u32x4*)(lds + AT_KT + (row0 + 32 * i) * 272 + ch * 16) = sr[i]; \
        *(LAS u32x2*)(lds + AT_VT + (row0 + 32 * i) * 272 + vpos * 2) = (u32x2){sr[4 + i].x, sr[4 + i].y}; \
        *(LAS u32x2*)(lds + AT_VT + (row0 + 32 * i) * 272 + (vpos + 8) * 2) = (u32x2){sr[4 + i].z, sr[4 + i].w}; } } while (0)
    AT_WRITE();
    __syncthreads();
    if (ntiles > 1) { const int k1 = tiles[1]; AT_LOAD(k1); }
    for (int ti = 0; ti < ntiles; ++ti) {
        const int kstart = tiles[ti] + 64 * kp, nblk = kstart >> 8;
        const bool own = (nblk == blk);
        const bool any_ok = own ? true : (__any((((mysel[0] | mysel[1]) >> nblk) & 1u) != 0u) != 0);
        const bool active = own ? (kstart <= q0 + 32 * qg + 31) : any_ok;
        if (active) {
            const LAS unsigned char* kt = lds + AT_KT + 64 * kp * 272; const LAS unsigned char* vt = lds + AT_VT + 64 * kp * 2;
            f32x4 s[2][4];
#pragma unroll
            for (int n = 0; n < 4; ++n) { s[0][n] = (f32x4){0.f, 0.f, 0.f, 0.f}; s[1][n] = s[0][n]; }
#pragma unroll
            for (int ks = 0; ks < 4; ++ks) {
                bf16x8 q0f = *(const LAS bf16x8*)(qrow + 64 * ks), q1f = *(const LAS bf16x8*)(qrow + 16 * 272 + 64 * ks);
                bf16x8 kf[4];
#pragma unroll
                for (int n = 0; n < 4; ++n) kf[n] = *(const LAS bf16x8*)(kt + (16 * n + q16) * 272 + (32 * ks + 8 * g) * 2);
                asm volatile("" : "+v"(q0f), "+v"(q1f), "+v"(kf[0]), "+v"(kf[1]), "+v"(kf[2]), "+v"(kf[3]));
#pragma unroll
                for (int n = 0; n < 4; ++n) {
                    s[0][n] = __builtin_amdgcn_mfma_f32_16x16x32_bf16(kf[n], q0f, s[0][n], 0, 0, 0);
                    s[1][n] = __builtin_amdgcn_mfma_f32_16x16x32_bf16(kf[n], q1f, s[1][n], 0, 0, 0); } }
            const bool far = ((q0 + 32 * qg) - (kstart + 63)) >= 128;
            const float bfar = tab[128];
            float alpha[2];
#pragma unroll
            for (int f = 0; f < 2; ++f) {
                const bool lane_ok = own ? true : (((mysel[f] >> nblk) & 1u) != 0u);
                const int kmax = lane_ok ? (own ? qpos[f] : 0x7fffffff) : -1;
                float mx = -1.0e30f;
                float bs[4][4];
                if (far) {
#pragma unroll
                    for (int n = 0; n < 4; ++n)
#pragma unroll
                        for (int r = 0; r < 4; ++r) bs[n][r] = bfar;
                } else {
#pragma unroll
                    for (int n = 0; n < 4; ++n)
#pragma unroll
                        for (int r = 0; r < 4; ++r) { int di = qpos[f] - (kstart + 16 * n + 4 * g + r); di = di < 0 ? 0 : di; di = di > 128 ? 128 : di; bs[n][r] = tab[di]; }
                }
#pragma unroll
                for (int n = 0; n < 4; ++n) asm volatile("" : "+v"(bs[n][0]), "+v"(bs[n][1]), "+v"(bs[n][2]), "+v"(bs[n][3]));
#pragma unroll
                for (int n = 0; n < 4; ++n)
#pragma unroll
                    for (int r = 0; r < 4; ++r) { const int key = kstart + 16 * n + 4 * g + r;
                        const float v = (key <= kmax) ? s[f][n][r] + bs[n][r] : -1.0e30f;
                        s[f][n][r] = v; mx = fmaxf(mx, v); }
                mx = rows4_max(mx);
                const float m_new = fmaxf(fmaxf(m_run[f], mx), -1.0e29f);
                alpha[f] = __builtin_amdgcn_exp2f(m_run[f] - m_new);
                float psum = 0.f;
#pragma unroll
                for (int n = 0; n < 4; ++n)
#pragma unroll
                    for (int r = 0; r < 4; ++r) { const float p = __builtin_amdgcn_exp2f(s[f][n][r] - m_new); s[f][n][r] = p; psum += p; }
                psum = rows4_sum(psum);
                l_run[f] = l_run[f] * alpha[f] + psum; m_run[f] = m_new;
#pragma unroll
                for (int m = 0; m < 8; ++m) oacc[f][m] = oacc[f][m] * alpha[f];
            }
#pragma unroll
            for (int k2 = 0; k2 < 2; ++k2) {
                bf16x8 pf[2];
#pragma unroll
                for (int f = 0; f < 2; ++f) { u32x4 pb; pb.x = cvt_pk_bf16(s[f][2 * k2][0], s[f][2 * k2][1]); pb.y = cvt_pk_bf16(s[f][2 * k2][2], s[f][2 * k2][3]);
                    pb.z = cvt_pk_bf16(s[f][2 * k2 + 1][0], s[f][2 * k2 + 1][1]); pb.w = cvt_pk_bf16(s[f][2 * k2 + 1][2], s[f][2 * k2 + 1][3]);
                    pf[f] = __builtin_bit_cast(bf16x8, pb); }
#pragma unroll
                for (int mh = 0; mh < 2; ++mh) {
                    bf16x8 af[4];
#pragma unroll
                    for (int m = 0; m < 4; ++m) af[m] = *(const LAS bf16x8*)(vt + (16 * (4 * mh + m) + q16) * 272 + (32 * k2 + 8 * g) * 2);
                    asm volatile("" : "+v"(af[0]), "+v"(af[1]), "+v"(af[2]), "+v"(af[3]));
#pragma unroll
                    for (int m = 0; m < 4; ++m) {
                        oacc[0][4 * mh + m] = __builtin_amdgcn_mfma_f32_16x16x32_bf16(af[m], pf[0], oacc[0][4 * mh + m], 0, 0, 0);
                        oacc[1][4 * mh + m] = __builtin_amdgcn_mfma_f32_16x16x32_bf16(af[m], pf[1], oacc[1][4 * mh + m], 0, 0, 0); } }
            }
        }
        __syncthreads();
        if (ti + 1 < ntiles) { AT_WRITE(); }
        __syncthreads();
        if (ti + 2 < ntiles) { const int kn = tiles[ti + 2]; AT_LOAD(kn); }
    }
    LAS float* mo = (LAS float*)lds; LAS float* ml = (LAS float*)(lds + 65536);
    if (kp == 1) {
#pragma unroll
        for (int f = 0; f < 2; ++f) {
#pragma unroll
            for (int m = 0; m < 8; ++m)
#pragma unroll
                for (int r = 0; r < 4; ++r) mo[((qg * 2 + f) * 8 + m) * 256 + r * 64 + lane] = oacc[f][m][r];
            ml[(qg * 2 + f) * 128 + lane] = m_run[f]; ml[(qg * 2 + f) * 128 + 64 + lane] = l_run[f]; }
    }
    __syncthreads();
    if (kp == 0) {
#pragma unroll
        for (int f = 0; f < 2; ++f) {
            const float m1 = ml[(qg * 2 + f) * 128 + lane], l1 = ml[(qg * 2 + f) * 128 + 64 + lane];
            const float mm = fmaxf(m_run[f], m1), a0 = __builtin_amdgcn_exp2f(m_run[f] - mm), a1 = __builtin_amdgcn_exp2f(m1 - mm);
            const float inv = __builtin_amdgcn_rcpf(l_run[f] * a0 + l1 * a1);
            bf16* HA = (bf16*)(ws + WS_HA) + (size_t)(b * SEQ + qpos[f]) * 1024 + h * 128 + 4 * g;
#pragma unroll
            for (int m = 0; m < 8; ++m) { float o[4];
#pragma unroll
                for (int r = 0; r < 4; ++r) o[r] = (oacc[f][m][r] * a0 + mo[((qg * 2 + f) * 8 + m) * 256 + r * 64 + lane] * a1) * inv;
                u32x2 w; w.x = cvt_pk_bf16(o[0], o[1]); w.y = cvt_pk_bf16(o[2], o[3]); *(u32x2*)(HA + 16 * m) = w; }
        }
    }
#undef AT_LOAD
#undef AT_WRITE
}

constexpr int MC_Q = 0, MC_K = 33792, MC_SP = 67584, MC_SC = 76800, MC_NV = 79104;
__device__ __forceinline__ void mlstm_c_unit(ArgsP a, int l, LAS unsigned char* lds, int u, int tid, int lane, int wave) {
    unsigned char* ws = a->ws;
    const int bh = u >> 5, c = u & 31, b = bh >> 2, h = bh & 3, t0 = 64 * c, q16 = lane & 15, g = lane >> 4;
    const size_t tok0 = (size_t)b * SEQ + t0;
    LAS unsigned char* Qs = lds + MC_Q; LAS unsigned char* Ks = lds + MC_K; LAS unsigned char* Sp = lds + MC_SP;
    LAS float* sc = (LAS float*)(lds + MC_SC); LAS float* as_ = sc; LAS float* gt_ = sc + 64; LAS float* wi_ = sc + 128; LAS float* cl_ = sc + 192; LAS float* qn_ = sc + 256; LAS float* denp = sc + 320;
    LAS float* nvec = (LAS float*)(lds + MC_NV);
    const bf16* QM = (const bf16*)(ws + WS_QM); const bf16* KM = (const bf16*)(ws + WS_KM);
    u32x4 qr[4], kr[4];
#pragma unroll
    for (int i = 0; i < 4; ++i) { const int idx = tid + NTHR * i, row = idx >> 5, ch = idx & 31;
        qr[i] = *(const u32x4*)(QM + (tok0 + row) * 1024 + h * 256 + ch * 8); kr[i] = *(const u32x4*)(KM + (tok0 + row) * 1024 + h * 256 + ch * 8); }
    float sc4[4] = {0.f, 0.f, 0.f, 0.f}; float nv0 = 0.f;
    if (tid < 64) { const int s = bh * 2048 + t0 + tid; sc4[0] = ((const float*)(ws + MS_AS))[s]; sc4[1] = ((const float*)(ws + MS_GT))[s];
        sc4[2] = ((const float*)(ws + MS_WI))[s]; sc4[3] = ((const float*)(ws + MS_CL))[s]; }
    if (tid < 256) nv0 = ((const float*)(ws + MS_NVEC))[(size_t)(bh * 32 + c) * 256 + tid];
    bf16x8 cb[8][2], vbf[2][2];
    {
        const bf16* Cp = (const bf16*)(ws + WS_CST) + (size_t)(bh * 32 + c) * 65536 + (size_t)(2 * wave) * 512 + lane * 8;
        if (c > 0) {
#pragma unroll
            for (int ks = 0; ks < 8; ++ks) { cb[ks][0] = *(const bf16x8*)(Cp + ks * 8192); cb[ks][1] = *(const bf16x8*)(Cp + ks * 8192 + 512); }
        }
    }
#pragma unroll
    for (int i = 0; i < 4; ++i) { const int idx = tid + NTHR * i, row = idx >> 5, ch = idx & 31;
        *(LAS u32x4*)(Qs + row * 528 + ch * 16) = qr[i]; *(LAS u32x4*)(Ks + row * 528 + ch * 16) = kr[i]; }
    {
        const bf16* Vp = (const bf16*)(ws + WS_VMT) + (size_t)(bh * 32 + c) * 16384 + (size_t)(2 * wave) * 512 + lane * 8;
#pragma unroll
        for (int ks = 0; ks < 2; ++ks) { vbf[ks][0] = *(const bf16x8*)(Vp + ks * 8192); vbf[ks][1] = *(const bf16x8*)(Vp + ks * 8192 + 512); }
    }
    if (tid < 64) { as_[tid] = sc4[0]; gt_[tid] = sc4[1]; wi_[tid] = sc4[2]; cl_[tid] = sc4[3]; }
    if (tid < 256) nvec[tid] = nv0;
    __syncthreads();
    f32x4 acc[4][2];
#pragma unroll
    for (int m = 0; m < 4; ++m) { acc[m][0] = (f32x4){0.f, 0.f, 0.f, 0.f}; acc[m][1] = acc[m][0]; }
    if (c > 0) {
#pragma unroll
        for (int ks = 0; ks < 8; ++ks) {
#pragma unroll
            for (int m = 0; m < 4; ++m) { const bf16x8 af = *(const LAS bf16x8*)(Qs + (16 * m + q16) * 528 + (32 * ks + 8 * g) * 2);
                acc[m][0] = __builtin_amdgcn_mfma_f32_16x16x32_bf16(af, cb[ks][0], acc[m][0], 0, 0, 0);
                acc[m][1] = __builtin_amdgcn_mfma_f32_16x16x32_bf16(af, cb[ks][1], acc[m][1], 0, 0, 0); }
        }
#pragma unroll
        for (int m = 0; m < 4; ++m)
#pragma unroll
            for (int r = 0; r < 4; ++r) { const float w = wi_[16 * m + 4 * g + r]; acc[m][0][r] *= w; acc[m][1][r] *= w; }
    }
    {
        const int mS = wave & 3, nS0 = 2 * (wave >> 2);
        f32x4 sacc[2]; sacc[0] = (f32x4){0.f, 0.f, 0.f, 0.f}; sacc[1] = sacc[0];
#pragma unroll
        for (int kh = 0; kh < 4; ++kh) {
            bf16x8 af[2], bq[2][2];
#pragma unroll
            for (int k2 = 0; k2 < 2; ++k2) { const int ks = 2 * kh + k2;
                af[k2] = *(const LAS bf16x8*)(Qs + (16 * mS + q16) * 528 + (32 * ks + 8 * g) * 2);
#pragma unroll
                for (int nn = 0; nn < 2; ++nn) bq[k2][nn] = *(const LAS bf16x8*)(Ks + (16 * (nS0 + nn) + q16) * 528 + (32 * ks + 8 * g) * 2); }
            asm volatile("" : "+v"(af[0]), "+v"(af[1]), "+v"(bq[0][0]), "+v"(bq[0][1]), "+v"(bq[1][0]), "+v"(bq[1][1]));
#pragma unroll
            for (int k2 = 0; k2 < 2; ++k2)
#pragma unroll
                for (int nn = 0; nn < 2; ++nn) sacc[nn] = __builtin_amdgcn_mfma_f32_16x16x32_bf16(af[k2], bq[k2][nn], sacc[nn], 0, 0, 0);
        }
#pragma unroll
        for (int nn = 0; nn < 2; ++nn) { const int s = 16 * (nS0 + nn) + q16; const float av = as_[s];
#pragma unroll
            for (int r = 0; r < 4; ++r) { const int t = 16 * mS + 4 * g + r;
                float val = (s <= t) ? sacc[nn][r] * __expf(av - gt_[t]) : 0.f;
                *(LAS unsigned short*)(Sp + t * 144 + s * 2) = (unsigned short)(cvt_pk_bf16(val, val) & 0xffffu);
                val += __shfl_xor(val, 1); val += __shfl_xor(val, 2); val += __shfl_xor(val, 4); val += __shfl_xor(val, 8);
                if (q16 == 0) denp[(nS0 + nn) * 64 + t] = val; } }
    }
    {
        const int t = tid >> 3, seg = tid & 7; float s = 0.f;
#pragma unroll
        for (int i = 0; i < 4; ++i) { const u32x4 v = *(const LAS u32x4*)(Qs + t * 528 + (seg * 32 + 8 * i) * 2); const LAS float* nv = nvec + seg * 32 + 8 * i;
            s += bflo(v.x) * nv[0] + bfhi(v.x) * nv[1] + bflo(v.y) * nv[2] + bfhi(v.y) * nv[3] + bflo(v.z) * nv[4] + bfhi(v.z) * nv[5] + bflo(v.w) * nv[6] + bfhi(v.w) * nv[7]; }
        s += __shfl_xor(s, 1); s += __shfl_xor(s, 2); s += __shfl_xor(s, 4);
        if (seg == 0) qn_[t] = s;
    }
    __syncthreads();
    {
#pragma unroll
        for (int ks = 0; ks < 2; ++ks) {
            bf16x8 sf[4];
#pragma unroll
            for (int m = 0; m < 4; ++m) sf[m] = *(const LAS bf16x8*)(Sp + (16 * m + q16) * 144 + (32 * ks + 8 * g) * 2);
            asm volatile("" : "+v"(sf[0]), "+v"(sf[1]), "+v"(sf[2]), "+v"(sf[3]));
#pragma unroll
            for (int m = 0; m < 4; ++m) {
                acc[m][0] = __builtin_amdgcn_mfma_f32_16x16x32_bf16(sf[m], vbf[ks][0], acc[m][0], 0, 0, 0);
                acc[m][1] = __builtin_amdgcn_mfma_f32_16x16x32_bf16(sf[m], vbf[ks][1], acc[m][1], 0, 0, 0); }
        }
    }
    LAS float* NUM = (LAS float*)lds;
#pragma unroll
    for (int m = 0; m < 4; ++m)
#pragma unroll
        for (int r = 0; r < 4; ++r) { const int t = 16 * m + 4 * g + r;
            const float den = (denp[t] + denp[64 + t]) + (denp[128 + t] + denp[192 + t]) + wi_[t] * qn_[t];
            const float inv = __builtin_amdgcn_rcpf(fmaxf(fabsf(den), cl_[t]));
            NUM[t * 260 + 32 * wave + q16] = acc[m][0][r] * inv; NUM[t * 260 + 32 * wave + 16 + q16] = acc[m][1][r] * inv; }
    __syncthreads();
    {
        const float* mg = a->in[I_MNG] + l * 1024 + h * 256 + 4 * lane; const f32x4 gn = *(const f32x4*)mg;
        const bf16* OM = (const bf16*)(ws + WS_OM); bf16* HM = (bf16*)(ws + WS_HM);
        u32x2 ovv[8];
#pragma unroll
        for (int i = 0; i < 8; ++i) ovv[i] = *(const u32x2*)(OM + (tok0 + 8 * wave + i) * 1024 + h * 256 + 4 * lane);
        asm volatile("" : "+v"(ovv[0]), "+v"(ovv[1]), "+v"(ovv[2]), "+v"(ovv[3]), "+v"(ovv[4]), "+v"(ovv[5]), "+v"(ovv[6]), "+v"(ovv[7]));
#pragma unroll
        for (int i = 0; i < 8; ++i) { const int t = 8 * wave + i;
            const f32x4 v = *(const LAS f32x4*)(NUM + t * 260 + 4 * lane);
            const float mu = wave_sum((v.x + v.y) + (v.z + v.w)) * (1.0f / 256.0f);
            const f32x4 d = v - mu;
            const float var = wave_sum((d.x * d.x + d.y * d.y) + (d.z * d.z + d.w * d.w)) * (1.0f / 256.0f);
            const float rstd = __builtin_amdgcn_rsqf(var + LN_EPS);
            const u32x2 ov = ovv[i];
            u32x2 w; w.x = cvt_pk_bf16(d.x * rstd * gn.x * bflo(ov.x), d.y * rstd * gn.y * bfhi(ov.x)); w.y = cvt_pk_bf16(d.z * rstd * gn.z * bflo(ov.y), d.w * rstd * gn.w * bfhi(ov.y));
            *(u32x2*)(HM + (tok0 + t) * 1024 + h * 256 + 4 * lane) = w; }
    }
    __syncthreads();
}

struct SchedStd {
    static constexpr bool GATHER = false;
    const char* A; const char* B; int nM, nN, K, G, c;
    __device__ __forceinline__ bool next(int i, Unit& u) const { const int L = i * G + c; if (L >= nM * nN) return false; pg8::static_tile(L, nM, nN, u.pm, u.pn); u.aux = 0; return true; }
    __device__ __forceinline__ const char* abase(const Unit& u) const { return A + (size_t)u.pm * 512 * K; }
    __device__ __forceinline__ const char* bbase(const Unit& u) const { return B + (size_t)u.pn * 512 * K; }
    __device__ __forceinline__ unsigned arow(const Unit&, int) const { return 0u; }
    static __device__ __forceinline__ bool keep_acc(const Unit&) { return false; }
};
struct SchedBr {
    static constexpr bool GATHER = false;
    const char* HM; const char* HA; const char* WM; const char* WA; int G, c;
    __device__ __forceinline__ bool next(int i, Unit& u) const { const int L = (i >> 1) * G + c; if (L >= 256) return false; pg8::static_tile(L, 32, 8, u.pm, u.pn); u.aux = i & 1; return true; }
    __device__ __forceinline__ const char* abase(const Unit& u) const { return (u.aux ? HA : HM) + (size_t)u.pm * 512 * 1024; }
    __device__ __forceinline__ const char* bbase(const Unit& u) const { return (u.aux ? WA : WM) + (size_t)u.pn * 512 * 1024; }
    __device__ __forceinline__ unsigned arow(const Unit&, int) const { return 0u; }
    static __device__ __forceinline__ bool keep_acc(const Unit& u) { return u.aux == 0; }
};
struct EpiBr {
    static constexpr bool PERM = true;
    const bf16* SG; bf16* Y;
    __device__ __forceinline__ void operator()(f32x4 (&acc)[2][2][4][2], const Unit& u, int wr, int wc, int fr, int fq) const {
        const int row0 = u.pm * 256 + wr * 64 + fr, col0 = u.pn * 256 + wc * 32 + 8 * fq;
#pragma unroll
        for (int ai = 0; ai < 2; ++ai) {
            u32x4 sa[4][2], sm[4][2];
#pragma unroll
            for (int m = 0; m < 4; ++m) { const size_t row = row0 + ai * 128 + m * 16;
#pragma unroll
                for (int bj = 0; bj < 2; ++bj) { const int col = col0 + bj * 128;
                    sa[m][bj] = *(const u32x4*)(SG + row * 4096 + 2048 + col);
                    sm[m][bj] = *(const u32x4*)(SG + row * 4096 + (u.aux == 0 ? 0 : 2048) + col); } }
            asm volatile("" : "+v"(sa[0][0]), "+v"(sa[0][1]), "+v"(sa[1][0]), "+v"(sa[1][1]), "+v"(sa[2][0]), "+v"(sa[2][1]), "+v"(sa[3][0]), "+v"(sa[3][1]),
                              "+v"(sm[0][0]), "+v"(sm[0][1]), "+v"(sm[1][0]), "+v"(sm[1][1]), "+v"(sm[2][0]), "+v"(sm[2][1]), "+v"(sm[3][0]), "+v"(sm[3][1]));
#pragma unroll
            for (int m = 0; m < 4; ++m) { const size_t row = row0 + ai * 128 + m * 16;
#pragma unroll
                for (int bj = 0; bj < 2; ++bj) { const int col = col0 + bj * 128;
                    const u32x4 a4 = sa[m][bj], m4 = sm[m][bj];
                    const float ga[8] = {bflo(a4.x), bfhi(a4.x), bflo(a4.y), bfhi(a4.y), bflo(a4.z), bfhi(a4.z), bflo(a4.w), bfhi(a4.w)};
                    if (u.aux == 0) {
                        const float gm[8] = {bflo(m4.x), bfhi(m4.x), bflo(m4.y), bfhi(m4.y), bflo(m4.z), bfhi(m4.z), bflo(m4.w), bfhi(m4.w)};
#pragma unroll
                        for (int j = 0; j < 4; ++j) { acc[ai][bj][m][0][j] *= gm[j] * __builtin_amdgcn_rcpf(fmaxf(ga[j], 1.0e-30f)); acc[ai][bj][m][1][j] *= gm[4 + j] * __builtin_amdgcn_rcpf(fmaxf(ga[4 + j], 1.0e-30f)); }
                    } else {
                        const f32x4 v0 = acc[ai][bj][m][0], v1 = acc[ai][bj][m][1];
                        u32x4 w; w.x = cvt_pk_bf16(v0[0] * ga[0], v0[1] * ga[1]); w.y = cvt_pk_bf16(v0[2] * ga[2], v0[3] * ga[3]);
                        w.z = cvt_pk_bf16(v1[0] * ga[4], v1[1] * ga[5]); w.w = cvt_pk_bf16(v1[2] * ga[6], v1[3] * ga[7]);
                        *(u32x4*)(Y + row * 2048 + col) = w; }
                } }
        }
    }
};
struct EpiOut {
    static constexpr bool PERM = false;
    const float* res; float* out;
    __device__ __forceinline__ void operator()(f32x4 (&acc)[2][2][4][2], const Unit& u, int wr, int wc, int fr, int fq) const {
        const int row0 = u.pm * 256 + wr * 64 + fr, col0 = u.pn * 256 + wc * 32 + 4 * fq;
#pragma unroll
        for (int ai = 0; ai < 2; ++ai) {
            f32x4 rv[4][2][2];
#pragma unroll
            for (int m = 0; m < 4; ++m) { const size_t ro = (size_t)(row0 + ai * 128 + m * 16) * DM + col0;
#pragma unroll
                for (int bj = 0; bj < 2; ++bj)
#pragma unroll
                    for (int n = 0; n < 2; ++n) rv[m][bj][n] = *(const f32x4*)(res + ro + bj * 128 + n * 16); }
#pragma unroll
            for (int m = 0; m < 4; ++m) asm volatile("" : "+v"(rv[m][0][0]), "+v"(rv[m][0][1]), "+v"(rv[m][1][0]), "+v"(rv[m][1][1]));
#pragma unroll
            for (int m = 0; m < 4; ++m) { const size_t ro = (size_t)(row0 + ai * 128 + m * 16) * DM + col0;
#pragma unroll
                for (int bj = 0; bj < 2; ++bj)
#pragma unroll
                    for (int n = 0; n < 2; ++n) *(f32x4*)(out + ro + bj * 128 + n * 16) = rv[m][bj][n] + acc[ai][bj][m][n]; }
        }
    }
};
struct SchedMoe1 {
    static constexpr bool GATHER = true;
    const char* H; const char* W13; const int* LIST; const LAS int* te; const LAS int* tr0; const LAS int* cnt; int MT, G, c;
    __device__ __forceinline__ bool next(int i, Unit& u) const { const int L = i * G + c; if (L >= 2 * MT) return false; u.pm = L >> 1; u.pn = L & 1; u.aux = __builtin_amdgcn_readfirstlane(te[u.pm]); return true; }
    __device__ __forceinline__ const char* abase(const Unit&) const { return H; }
    __device__ __forceinline__ const char* bbase(const Unit& u) const { return W13 + ((size_t)u.aux * 512 + u.pn * 256) * 4096; }
    static __device__ __forceinline__ bool keep_acc(const Unit&) { return false; }
    __device__ __forceinline__ unsigned arow(const Unit& u, int r) const { const int rr = __builtin_amdgcn_readfirstlane(tr0[u.pm]) + r; return rr < __builtin_amdgcn_readfirstlane(cnt[u.aux]) ? (unsigned)LIST[u.aux * 8192 + rr] : 0u; }
};
struct EpiMoe1 {
    static constexpr bool PERM = true;
    bf16* HID; const float* PWL; const LAS int* tr0; const LAS int* cnt;
    __device__ __forceinline__ void operator()(f32x4 (&acc)[2][2][4][2], const Unit& u, int wr, int wc, int fr, int fq) const {
#pragma unroll
        for (int ai = 0; ai < 2; ++ai)
#pragma unroll
            for (int m = 0; m < 4; ++m) { const int r = ai * 128 + wr * 64 + m * 16 + fr;
                const float pw = 1.0f;
                float o[8];
#pragma unroll
                for (int n = 0; n < 2; ++n)
#pragma unroll
                    for (int j = 0; j < 4; ++j) { const float x1 = acc[ai][0][m][n][j], x3 = acc[ai][1][m][n][j]; o[4 * n + j] = x1 * sigmoidf_(x1) * x3 * pw; }
                u32x4 w; w.x = cvt_pk_bf16(o[0], o[1]); w.y = cvt_pk_bf16(o[2], o[3]); w.z = cvt_pk_bf16(o[4], o[5]); w.w = cvt_pk_bf16(o[6], o[7]);
                *(u32x4*)(HID + (size_t)(u.pm * 256 + r) * 256 + u.pn * 128 + wc * 32 + 8 * fq) = w; }
    }
};
struct SchedMoe2 {
    static constexpr bool GATHER = false;
    const char* HID; const char* W2; const LAS int* te; int MT, G, c;
    __device__ __forceinline__ bool next(int i, Unit& u) const { const int L = i * G + c; if (L >= 8 * MT) return false; u.pm = L >> 3; u.pn = L & 7; u.aux = __builtin_amdgcn_readfirstlane(te[u.pm]); return true; }
    __device__ __forceinline__ const char* abase(const Unit& u) const { return HID + (size_t)u.pm * 256 * 512; }
    __device__ __forceinline__ const char* bbase(const Unit& u) const { return W2 + ((size_t)u.aux * 2048 + u.pn * 256) * 512; }
    __device__ __forceinline__ unsigned arow(const Unit&, int) const { return 0u; }
    static __device__ __forceinline__ bool keep_acc(const Unit&) { return false; }
};
struct EpiMoe2 {
    static constexpr bool PERM = true;
    bf16* OP;
    __device__ __forceinline__ void operator()(f32x4 (&acc)[2][2][4][2], const Unit& u, int wr, int wc, int fr, int fq) const {
        const int row0 = u.pm * 256 + wr * 64 + fr, col0 = u.pn * 256 + wc * 32 + 8 * fq;
#pragma unroll
        for (int ai = 0; ai < 2; ++ai)
#pragma unroll
            for (int m = 0; m < 4; ++m) { bf16* rowp = OP + (size_t)(row0 + ai * 128 + m * 16) * DM + col0;
#pragma unroll
                for (int bj = 0; bj < 2; ++bj) { const f32x4 v0 = acc[ai][bj][m][0], v1 = acc[ai][bj][m][1];
                    u32x4 w; w.x = cvt_pk_bf16(v0[0], v0[1]); w.y = cvt_pk_bf16(v0[2], v0[3]); w.z = cvt_pk_bf16(v1[0], v1[1]); w.w = cvt_pk_bf16(v1[2], v1[3]);
                    *(u32x4*)(rowp + bj * 128) = w; } }
    }
};

constexpr int N_PHASES = 22;
__global__ void __launch_bounds__(NTHR, 2) fwd_kernel(Args a) {
    extern __shared__ __attribute__((aligned(16))) unsigned char lds_raw[];
    LAS unsigned char* lds0 = (LAS unsigned char*)lds_raw;
    const int tid0 = threadIdx.x, bid0 = blockIdx.x, G0 = gridDim.x;
    const int wave0 = __builtin_amdgcn_readfirstlane(tid0 >> 6);
#define PH_IDS() ArgsP ap = (ArgsP)__builtin_amdgcn_kernarg_segment_ptr(); asm volatile("" : "+s"(ap)); unsigned lb_ = 0u; asm volatile("" : "+s"(lb_)); LAS unsigned char* lds = lds0 + lb_; LAS unsigned char* misc = lds + MISC_OFF; (void)misc; unsigned char* ws = ap->ws; (void)ws; int bid = bid0, G = G0, wave = wave0; asm volatile("" : "+s"(bid), "+s"(G), "+s"(wave)); int tid = wave * 64 + lane_id(); asm volatile("" : "+v"(tid)); const int lane = tid & 63; (void)lane; (void)wave
    if (tid0 < 4) ((LAS unsigned*)(lds0 + MISC_OFF + MO_BAR))[tid0] = 0u;
    __syncthreads();
#if MK_LAUNCHES == 1
    XcdBarrier bar = xcd_barrier_post((unsigned*)(a.ws + WS_CTL) + CW_BAR, (volatile LAS unsigned*)(lds0 + MISC_OFF + MO_BAR));
#define GRID_BAR() xcd_barrier(bar)
#else
#define GRID_BAR() do { } while (0)
#endif
    const int lo = a.ph_lo, hi = a.ph_hi;
#ifndef PHMASK
#define PHMASK 0xFFFu
#endif
#define IN(k) (lo <= (k) && (k) < hi)
#define EN(b) ((PHMASK >> (b)) & 1u)
#ifndef DBLMASK
#define DBLMASK 0u
#endif
#define REP(b) _Pragma("unroll 1") for (int rep_ = 0; rep_ < (((DBLMASK >> (b)) & 1u) ? 2 : 1); ++rep_)
#define SEAM(k) do { if (IN(k) && IN((k) + 1)) { GRID_BAR(); if ((DBLMASK >> 12) & 1u) GRID_BAR(); } } while (0)

    if (EN(0) && IN(0)) { REP(0) { PH_IDS(); prologue_phase(ap, lds, tid, lane, wave, bid, G); __syncthreads(); }
#ifndef NO_NORM0
        { PH_IDS(); norm_phase<0>(ap, 0, lds, tid, lane, wave, bid, G); }
#endif
    }
    SEAM(0);
#pragma unroll 1
    for (int l = 0; l < 2; ++l) {
        const int pb = 1 + 10 * l;
        if (EN(1) && IN(pb + 0) && l == 1) { if ((DBLMASK >> 18) & 1u) { PH_IDS(); norm_phase<1>(ap, l, lds, tid, lane, wave, bid, G, true); } PH_IDS(); norm_phase<1>(ap, l, lds, tid, lane, wave, bid, G); }
        if (l == 1) SEAM(pb + 0);
        if (EN(2) && IN(pb + 1)) REP(2) { PH_IDS(); (void)tid;
            SchedG1 S{(const char*)(ws + WS_H), (const char*)(ws + WS_WINT) + (size_t)l * 11264 * 4096, G, bid};
            EpiG1 E{ws, ((DBLMASK >> 21) & 1u) && rep_ == 1};
            pg8::gemm_phase<EpiG1, SchedG1>(lds, 2048, S, E, wave);
            for (int bh = G - 1 - bid; bh < 16; bh += G) gate_unit(ap, l, lds, bh, tid, tid & 63, wave);
            __syncthreads();
            if (G == 256 && bid >= 256 - SchedG1::NCV) prologue_phase(ap, lds, tid, tid & 63, wave, bid - (256 - SchedG1::NCV), SchedG1::NCV, 2 + l);
            else if (G != 256) prologue_phase(ap, lds, tid, tid & 63, wave, bid, G, 2 + l);
        }
        SEAM(pb + 1);
        if (EN(3) && IN(pb + 2)) REP(3) { PH_IDS(); conv_phase(ap, l, lds, tid, lane, wave, bid, G); }
        SEAM(pb + 2);
        if (EN(4) && IN(pb + 3)) REP(4) { PH_IDS();
            const int vb = (G % 8 == 0) ? (bid & 7) * (G >> 3) + (bid >> 3) : bid;
            REP(13) { for (int gw = vb * NWAVES + wave; gw < 2048; gw += G * NWAVES) mlstm_ab_task(ws, gw, lane, rep_ == 0 || !((DBLMASK >> 15) & 1u)); }
            if (wave == 0 && vb < 64) nscan_task(ws, vb, lane);
            __syncthreads();
            REP(14) { for (int u = vb; u < 512; u += G) { attn_unit(ap, lds, u, tid, lane, wave); __syncthreads(); if (((DBLMASK >> 16) & 1u) && u < 256) GRID_BAR(); } }
        }
        SEAM(pb + 3);
        if (EN(5) && IN(pb + 4)) REP(5) { PH_IDS(); for (int u = bid; u < 512; u += G) { mlstm_c_unit(ap, l, lds, u, tid, lane, wave); if (((DBLMASK >> 17) & 1u) && u < 256) GRID_BAR(); } }
        SEAM(pb + 4);
        if (EN(6) && IN(pb + 5)) REP(6) { PH_IDS(); (void)tid;
            SchedBr S{(const char*)(ws + WS_HM), (const char*)(ws + WS_HA), (const char*)(ws + WS_WBM) + (size_t)l * 2048 * 2048, (const char*)(ws + WS_WBA) + (size_t)l * 2048 * 2048, G, bid};
            EpiBr E{(const bf16*)(ws + WS_SG), (bf16*)(ws + WS_Y)};
            pg8::gemm_phase<EpiBr, SchedBr>(lds, 1024, S, E, wave);
        }
        SEAM(pb + 5);
        if (EN(7) && IN(pb + 6)) _Pragma("unroll 1") for (int rep_ = 0; rep_ < ((((DBLMASK >> 7) & 1u) && l == 0) ? 2 : 1); ++rep_) { PH_IDS(); (void)tid;
            SchedStd S{(const char*)(ws + WS_Y), (const char*)(ws + WS_WOUT) + (size_t)l * 2048 * 4096, 32, 8, 2048, G, bid};
            EpiOut E{l == 0 ? ap->in[I_X] : (const float*)ap->out, ap->out};
            pg8::gemm_phase<EpiOut, SchedStd>(lds, 2048, S, E, wave);
        }
        SEAM(pb + 6);
        if (EN(8) && IN(pb + 7)) { if ((DBLMASK >> 19) & 1u) { PH_IDS(); norm_phase<2>(ap, l, lds, tid, lane, wave, bid, G, true); } PH_IDS(); norm_phase<2>(ap, l, lds, tid, lane, wave, bid, G); }
        SEAM(pb + 7);
        if (EN(9) && IN(pb + 8)) REP(9) { PH_IDS();
            moe_tables(ws, l, misc, tid);
            SchedMoe1 S{(const char*)(ws + WS_H), (const char*)(ws + WS_W13) + (size_t)l * 32 * 512 * 4096, (const int*)(ws + MS_LIST),
                        (const LAS int*)(misc + MO_TE), (const LAS int*)(misc + MO_TR0), (const LAS int*)(misc + MO_CNT), __builtin_amdgcn_readfirstlane(((const LAS int*)(misc + MO_MT))[0]), G, bid};
            EpiMoe1 E{(bf16*)(ws + WS_HID), (const float*)(ws + MS_PWL), (const LAS int*)(misc + MO_TR0), (const LAS int*)(misc + MO_CNT)};
            pg8::gemm_phase<EpiMoe1, SchedMoe1>(lds, 2048, S, E, wave);
            if (l == 0 && bid >= 2 * S.MT) prologue_phase(ap, lds, tid, tid & 63, wave, bid - 2 * S.MT, G - 2 * S.MT, 1);
        }
        SEAM(pb + 8);
        if (EN(10) && IN(pb + 9)) REP(10) { PH_IDS();
            moe_tables(ws, l, misc, tid);
            SchedMoe2 S{(const char*)(ws + WS_HID), (const char*)(ws + WS_W2) + (size_t)l * 32 * 2048 * 512, (const LAS int*)(misc + MO_TE), __builtin_amdgcn_readfirstlane(((const LAS int*)(misc + MO_MT))[0]), G, bid};
            EpiMoe2 E{(bf16*)(ws + WS_OP)};
            pg8::gemm_phase<EpiMoe2, SchedMoe2>(lds, 256, S, E, wave);
        }
        SEAM(pb + 9);
    }
    if (EN(11) && IN(21)) { if ((DBLMASK >> 20) & 1u) { PH_IDS(); norm_phase<3>(ap, 1, lds, tid, lane, wave, bid, G, true); } PH_IDS(); norm_phase<3>(ap, 1, lds, tid, lane, wave, bid, G); }
#undef IN
#undef SEAM
}

extern "C" void kernel_launch(void* const* d_in, const int* in_sizes, int n_in, void* d_out, int out_size, void* d_ws, size_t ws_size, hipStream_t stream) {
    static int grid = 0;
    if (grid == 0) {
        if (n_in != 19 || out_size != NTOK * DM || ws_size < WS_END) { fprintf(stderr, "kernel_launch: unexpected shapes (n_in %d out %d ws %zu)\n", n_in, out_size, ws_size); grid = -1; return; }
        int dev = 0, cus = 0, per_cu = 0;
        if (hipGetDevice(&dev) != hipSuccess || hipDeviceGetAttribute(&cus, hipDeviceAttributeMultiprocessorCount, dev) != hipSuccess) { grid = -1; return; }
        if (hipFuncSetAttribute((const void*)fwd_kernel, hipFuncAttributeMaxDynamicSharedMemorySize, LDS_BYTES) != hipSuccess) { fprintf(stderr, "kernel_launch: hipFuncSetAttribute failed\n"); grid = -1; return; }
        if (hipOccupancyMaxActiveBlocksPerMultiprocessor(&per_cu, (const void*)fwd_kernel, NTHR, LDS_BYTES) != hipSuccess || per_cu < 1) { fprintf(stderr, "kernel_launch: occupancy query says %d\n", per_cu); }
        (void)hipGetLastError();
        grid = cus;
        if (grid > 256) grid = 256;
    }
    if (grid < 0) return;
    if (hipMemsetAsync((char*)d_ws + WS_CTL, 0, CTL_ZERO_BYTES, stream) != hipSuccess) return;
    Args a{};
    for (int i = 0; i < 19; ++i) a.in[i] = (const float*)d_in[i];
    a.out = (float*)d_out; a.ws = (unsigned char*)d_ws;
#if MK_LAUNCHES == 1
    a.ph_lo = 0; a.ph_hi = N_PHASES;
    hipLaunchKernelGGL(fwd_kernel, dim3(grid), dim3(NTHR), LDS_BYTES, stream, a);
#else
    for (int p = 0; p < N_PHASES; ++p) { a.ph_lo = p; a.ph_hi = p + 1; hipLaunchKernelGGL(fwd_kernel, dim3(grid), dim3(NTHR), LDS_BYTES, stream, a); }
#endif
}
```

```cpp
#define DBLMASK 0u
#include <hip/hip_runtime.h>
#include <stdint.h>
#include <stdio.h>

#ifndef MK_LAUNCHES
#define MK_LAUNCHES 1
#endif

#define GAS __attribute__((address_space(1)))
#define LAS __attribute__((address_space(3)))
typedef unsigned short bf16;
typedef short bf16x8 __attribute__((ext_vector_type(8)));
typedef short bf16x4 __attribute__((ext_vector_type(4)));
typedef float f32x4 __attribute__((ext_vector_type(4)));
typedef unsigned u32x4 __attribute__((ext_vector_type(4)));
typedef unsigned u32x2 __attribute__((ext_vector_type(2)));

constexpr int NTOK = 8192, DM = 2048, SEQ = 2048, NBATCH = 4;
constexpr int INCOLS = 11272;
constexpr int NWAVES = 8, NTHR = 512;
constexpr float RMS_EPS = 1e-6f, LN_EPS = 1e-5f;
constexpr int MPAD = 24576;

constexpr size_t MiB = 1u << 20;
constexpr size_t WS_CTL = 0, CTL_ZERO_BYTES = 1 * MiB;
constexpr size_t WS_MISC = 1 * MiB;
constexpr size_t MS_WIF = WS_MISC + 0;
constexpr size_t MS_WRT = WS_MISC + 256 * 1024;
constexpr size_t MS_IFG = WS_MISC + 1 * MiB;
constexpr size_t MS_KMEAN = MS_IFG + 256 * 1024;
constexpr size_t MS_AS = WS_MISC + 1536 * 1024;
constexpr size_t MS_GT = MS_AS + 128 * 1024;
constexpr size_t MS_WI = MS_GT + 128 * 1024;
constexpr size_t MS_CL = MS_WI + 128 * 1024;
constexpr size_t MS_WS = MS_CL + 128 * 1024;
constexpr size_t MS_DEC = MS_WS + 128 * 1024;
constexpr size_t MS_NST = WS_MISC + 2560 * 1024;
constexpr size_t MS_TOKE = WS_MISC + 3 * MiB;
constexpr size_t MS_TOKP = MS_TOKE + 64 * 1024;
constexpr size_t MS_TOKW = MS_TOKE + 128 * 1024;
constexpr size_t MS_LIST = WS_MISC + 4 * MiB;
constexpr size_t MS_PWL = WS_MISC + 5 * MiB;
constexpr size_t MS_NVEC = WS_MISC + 6 * MiB;
constexpr size_t WS_WINT = 16 * MiB;
constexpr size_t WS_WBM = 104 * MiB;
constexpr size_t WS_WBA = 112 * MiB;
constexpr size_t WS_WOUT = 120 * MiB;
constexpr size_t WS_W13 = 136 * MiB;
constexpr size_t WS_W2 = 264 * MiB;
constexpr size_t WS_H = 328 * MiB;
constexpr size_t WS_R = 360 * MiB;
constexpr size_t WS_ZQK = WS_R;
constexpr size_t WS_HM = WS_R, WS_HA = WS_R + 16 * MiB;
constexpr size_t WS_VMT = WS_R + 32 * MiB;
constexpr size_t WS_OM = WS_R + 48 * MiB;
constexpr size_t WS_QA = WS_R + 64 * MiB, WS_KA = WS_R + 80 * MiB;
constexpr size_t WS_Y = WS_QA;
constexpr size_t WS_VAT = WS_R + 96 * MiB;
constexpr size_t WS_SG = WS_R + 112 * MiB;
constexpr size_t WS_QM = WS_R + 176 * MiB, WS_KM = WS_R + 192 * MiB, WS_KMT = WS_R + 208 * MiB;
constexpr size_t WS_CST = WS_R + 224 * MiB;
constexpr size_t WS_HID = WS_R;
constexpr size_t WS_OP = WS_R + 16 * MiB;
constexpr size_t WS_END = 648 * MiB;
constexpr int CW_BAR = 4096;
constexpr int CW_CNT = 8192;

constexpr int RING_BYTES = 131072;
constexpr int MISC_OFF = 139264;
constexpr int LDS_BYTES = 147456;
constexpr int MO_BAR = 0, MO_CNT = 64, MO_NT = 64 + 128, MO_OFF = 64 + 256, MO_TE = 64 + 512, MO_TR0 = 64 + 1024, MO_MT = 64 + 1536, MO_LOG = 2048;

#define LDS_WAIT() asm volatile("s_waitcnt lgkmcnt(0)" ::: "memory")
#define VM_WAIT() asm volatile("s_waitcnt vmcnt(0)" ::: "memory")

__device__ __forceinline__ float bf2f(unsigned short b) { return __builtin_bit_cast(float, (unsigned)b << 16); }
__device__ __forceinline__ float bflo(unsigned u) { return __builtin_bit_cast(float, u << 16); }
__device__ __forceinline__ float bfhi(unsigned u) { return __builtin_bit_cast(float, u & 0xffff0000u); }
typedef __bf16 bf16x2v __attribute__((ext_vector_type(2)));
typedef float f32x2v __attribute__((ext_vector_type(2)));
__device__ __forceinline__ unsigned cvt_pk_bf16(float lo, float hi) { const f32x2v f = {lo, hi}; const bf16x2v b = __builtin_convertvector(f, bf16x2v); return __builtin_bit_cast(unsigned, b); }
__device__ __forceinline__ float wave_sum(float v) {
#pragma unroll
    for (int o = 1; o < 64; o <<= 1) v += __shfl_xor(v, o);
    return v;
}
__device__ __forceinline__ float rows4_max(float x) { x = fmaxf(x, __shfl_xor(x, 16)); return fmaxf(x, __shfl_xor(x, 32)); }
__device__ __forceinline__ float rows4_sum(float x) { x += __shfl_xor(x, 16); return x + __shfl_xor(x, 32); }
__device__ __forceinline__ int lane_id() { int l; asm volatile("v_mbcnt_lo_u32_b32 %0, -1, 0\n\tv_mbcnt_hi_u32_b32 %0, -1, %0" : "=v"(l)); return l; }
__device__ __forceinline__ float sigmoidf_(float x) { return __builtin_amdgcn_rcpf(1.f + __expf(-x)); }

namespace pg8 {
constexpr int BM = 256, BK = 64, HALF = 128, HTB = HALF * BK * 2, STAGE_BYTES = 8 * HTB, NXCD = 8, WGM = 8;
__device__ __forceinline__ int lds_byte(int r, int c) { const int st = (r >> 4) * 2 + (c >> 5), rr = r & 15, cc = c & 31, ob = rr * 64 + cc * 2; return st * 1024 + (ob ^ (((ob >> 9) & 1) << 5)); }
__device__ __forceinline__ void stage_rc(int b, int& R, int& C) { const int st = b / 1024, sb = b % 1024, swz = sb ^ (((sb >> 9) & 1) << 5); R = (st >> 1) * 16 + swz / 64; C = (st & 1) * 32 + (swz % 64) / 2; }
__device__ __forceinline__ int perm32(int rho) { const int n = rho >> 4, i = rho & 15; return 8 * (i >> 2) + 4 * n + (i & 3); }
struct Unit { int pm, pn, aux; };

__device__ __forceinline__ void static_tile(int L, int nM, int nN, int& pm, int& pn) {
    const int nwg = nM * nN; int wgid = L;
    { const int q = nwg / NXCD, r = nwg % NXCD, xcd = wgid % NXCD, off = wgid / NXCD; wgid = (xcd < r ? xcd * (q + 1) : r * (q + 1) + (xcd - r) * q) + off; }
    const int nig = WGM * nN, gid = wgid / nig, fm = gid * WGM, gsz = (nM - fm) < WGM ? (nM - fm) : WGM;
    pm = fm + ((wgid % nig) % gsz); pn = (wgid % nig) / gsz;
}

template <class Epi, class Sched>
__device__ __forceinline__ void gemm_phase(LAS unsigned char* lds, const int K, const Sched& S, const Epi& E, const int wave0) {
    int tid_ = wave0 * 64 + lane_id(); asm volatile("" : "+v"(tid_));
    const int tid = tid_, wid = __builtin_amdgcn_readfirstlane(tid >> 6), lane = tid & 63, wr = wid >> 2, wc = wid & 3, fr = lane & 15, fq = lane >> 4;
    const int nt = K / BK;
    int RA[2], CA[2]; unsigned voffB[2];
#pragma unroll
    for (int i = 0; i < 2; ++i) { int R, C; stage_rc(tid * 16 + i * 8192, R, C); const int Rb = Epi::PERM ? ((R & ~31) + perm32(R & 31)) : R;
        RA[i] = R; CA[i] = C; voffB[i] = (unsigned)(Rb * K + C) * 2u; }
    const size_t kstep = (size_t)(BK * 2);
    const size_t hstep = (size_t)HALF * K * 2;
    const unsigned ldsw = (unsigned)wid * 1024u;
    const int aoff = lds_byte(wr * 64 + fr, fq * 8), boff = lds_byte(wc * 32 + fr, fq * 8);
#define PG8_SA(b, h) (((b) * 2 + (h)) * HTB)
#define PG8_SB(b, h) ((4 + (b) * 2 + (h)) * HTB)
#define PG8_STAGE(bufoff, gbase, v0, v1) do { \
        __builtin_amdgcn_global_load_lds((const unsigned*)((const char*)(gbase) + (v0)), (LAS unsigned*)(lds + (bufoff) + ldsw), 16, 0, 0); \
        __builtin_amdgcn_global_load_lds((const unsigned*)((const char*)(gbase) + (v1)), (LAS unsigned*)(lds + (bufoff) + ldsw + 8192), 16, 0, 0); } while (0)
#define PG8_STAGE_B(bufoff, gbase) PG8_STAGE(bufoff, gbase, voffB[0], voffB[1])
#define PG8_STAGE_A(bufoff, gbase, VO, h) PG8_STAGE(bufoff, gbase, VO[h][0], VO[h][1])
#define PG8_STAGE_A2(bufoff, gbase, h) do { if (Sched::GATHER && last) { PG8_STAGE_A(bufoff, gbase, vn, h); } else { PG8_STAGE_A(bufoff, gbase, vc, h); } } while (0)
#define PG8_LDA(dst, b, h) do { _Pragma("unroll") for (int m = 0; m < 4; ++m) _Pragma("unroll") for (int k = 0; k < 2; ++k) dst[m][k] = *(const LAS bf16x8*)(lds + PG8_SA(b, h) + aoff + m * 2048 + k * 1024); } while (0)
#define PG8_LDB(dst, b, h) do { _Pragma("unroll") for (int n = 0; n < 2; ++n) _Pragma("unroll") for (int k = 0; k < 2; ++k) dst[n][k] = *(const LAS bf16x8*)(lds + PG8_SB(b, h) + boff + n * 2048 + k * 1024); } while (0)
#define PG8_MMA(ai, bj, At, Bt) do { __builtin_amdgcn_s_setprio(1); _Pragma("unroll") for (int m = 0; m < 4; ++m) _Pragma("unroll") for (int n = 0; n < 2; ++n) _Pragma("unroll") for (int k = 0; k < 2; ++k) \
        acc[ai][bj][m][n] = __builtin_amdgcn_mfma_f32_16x16x32_bf16(Bt[n][k], At[m][k], acc[ai][bj][m][n], 0, 0, 0); __builtin_amdgcn_s_setprio(0); } while (0)
#define PG8_WAIT_V(n) asm volatile("s_waitcnt vmcnt(" #n ")" ::: "memory")
#define PG8_WAIT_L(n) asm volatile("s_waitcnt lgkmcnt(" #n ")" ::: "memory")
#define PG8_BAR __builtin_amdgcn_s_barrier()
#define PG8_SCHED __builtin_amdgcn_sched_barrier(0)
    Unit cur, nxt; int ui = 0;
    if (!S.next(0, cur)) return;
    f32x4 acc[2][2][4][2];
#pragma unroll
    for (int a = 0; a < 2; ++a)
#pragma unroll
        for (int b = 0; b < 2; ++b)
#pragma unroll
            for (int m = 0; m < 4; ++m)
#pragma unroll
                for (int n = 0; n < 2; ++n) acc[a][b][m][n] = (f32x4){0.f, 0.f, 0.f, 0.f};
    bf16x8 At[4][2], B0[2][2], B1[2][2];
    unsigned vc[2][2], vn[2][2];
#pragma unroll
    for (int h = 0; h < 2; ++h)
#pragma unroll
        for (int i = 0; i < 2; ++i) {
            if constexpr (Sched::GATHER) vc[h][i] = (unsigned)(S.arow(cur, h * HALF + RA[i]) * (unsigned)K + (unsigned)CA[i]) * 2u;
            else vc[h][i] = (unsigned)((h * HALF + RA[i]) * K + CA[i]) * 2u;
            vn[h][i] = vc[h][i];
        }
    const char* cA = S.abase(cur); const char* cB = S.bbase(cur);
    PG8_STAGE_B(PG8_SB(0, 0), cB); PG8_STAGE_A(PG8_SA(0, 0), cA, vc, 0); PG8_STAGE_B(PG8_SB(0, 1), cB + hstep); PG8_STAGE_A(PG8_SA(0, 1), cA, vc, 1);
    if (wr == 1) PG8_BAR;
    PG8_WAIT_V(4); PG8_BAR;
    PG8_STAGE_B(PG8_SB(1, 0), cB + kstep); PG8_STAGE_A(PG8_SA(1, 0), cA + kstep, vc, 0); PG8_STAGE_B(PG8_SB(1, 1), cB + hstep + kstep);
    PG8_WAIT_V(6); PG8_BAR;
    for (;;) {
        const bool has_next = S.next(ui + 1, nxt);
        const char* nA = has_next ? S.abase(nxt) : cA; const char* nB = has_next ? S.bbase(nxt) : cB;
        if constexpr (Sched::GATHER) {
            if (has_next) {
                int t2 = wave0 * 64 + lane_id(); asm volatile("" : "+v"(t2));
#pragma unroll
                for (int i = 0; i < 2; ++i) { int R, C; stage_rc(t2 * 16 + i * 8192, R, C);
#pragma unroll
                    for (int h = 0; h < 2; ++h) vn[h][i] = (unsigned)(S.arow(nxt, h * HALF + R) * (unsigned)K + (unsigned)C) * 2u; }
            }
        }
#pragma unroll 1
        for (int t = 0; t < nt; t += 2) {
            const bool last = (t == nt - 2);
            const char* a1 = cA + (size_t)(t + 1) * kstep;
            const char* a2 = last ? nA : cA + (size_t)(t + 2) * kstep; const char* b2 = last ? nB : cB + (size_t)(t + 2) * kstep;
            const char* a3 = a2 + kstep; const char* b3 = b2 + kstep;
            PG8_LDB(B0, 0, 0); PG8_SCHED; PG8_LDA(At, 0, 0); PG8_STAGE_A(PG8_SA(1, 1), a1, vc, 1);
            PG8_WAIT_L(8); PG8_BAR; PG8_WAIT_L(0); PG8_MMA(0, 0, At, B0); PG8_BAR; PG8_SCHED;
            PG8_LDB(B1, 0, 1); PG8_STAGE_B(PG8_SB(0, 0), b2);
            PG8_BAR; PG8_WAIT_L(0); PG8_MMA(0, 1, At, B1); PG8_BAR;
            PG8_LDA(At, 0, 1); PG8_STAGE_A2(PG8_SA(0, 0), a2, 0);
            PG8_BAR; PG8_WAIT_L(0); PG8_MMA(1, 0, At, B0); PG8_BAR; PG8_SCHED;
            PG8_STAGE_B(PG8_SB(0, 1), b2 + hstep);
            PG8_WAIT_V(6); PG8_BAR; PG8_MMA(1, 1, At, B1); PG8_BAR;
            PG8_LDB(B0, 1, 0); PG8_SCHED; PG8_LDA(At, 1, 0); PG8_STAGE_A2(PG8_SA(0, 1), a2, 1);
            PG8_WAIT_L(8); PG8_BAR; PG8_WAIT_L(0); PG8_MMA(0, 0, At, B0); PG8_BAR; PG8_SCHED;
            PG8_LDB(B1, 1, 1); PG8_STAGE_B(PG8_SB(1, 0), b3);
            PG8_BAR; PG8_WAIT_L(0); PG8_MMA(0, 1, At, B1); PG8_BAR;
            PG8_LDA(At, 1, 1); PG8_STAGE_A2(PG8_SA(1, 0), a3, 0);
            PG8_BAR; PG8_WAIT_L(0); PG8_MMA(1, 0, At, B0); PG8_BAR; PG8_SCHED;
            PG8_STAGE_B(PG8_SB(1, 1), b3 + hstep);
            PG8_WAIT_V(6); PG8_BAR; PG8_MMA(1, 1, At, B1); PG8_BAR;
        }
        { const int lz = lane_id(); E(acc, cur, wr, wc, lz & 15, lz >> 4); }
        if (!has_next) break;
        if (!Sched::keep_acc(cur)) {
#pragma unroll
        for (int a = 0; a < 2; ++a)
#pragma unroll
            for (int b = 0; b < 2; ++b)
#pragma unroll
                for (int m = 0; m < 4; ++m)
#pragma unroll
                    for (int n = 0; n < 2; ++n) acc[a][b][m][n] = (f32x4){0.f, 0.f, 0.f, 0.f};
        }
        cur = nxt; cA = nA; cB = nB; ++ui;
        if constexpr (Sched::GATHER) {
#pragma unroll
            for (int h = 0; h < 2; ++h)
#pragma unroll
                for (int i = 0; i < 2; ++i) vc[h][i] = vn[h][i];
        }
    }
    PG8_WAIT_V(0);
    if (wr == 0) PG8_BAR;
    PG8_BAR;
#undef PG8_SA
#undef PG8_SB
#undef PG8_STAGE
#undef PG8_STAGE_A
#undef PG8_STAGE_A2
#undef PG8_STAGE_B
#undef PG8_LDA
#undef PG8_LDB
#undef PG8_MMA
#undef PG8_WAIT_V
#undef PG8_WAIT_L
#undef PG8_BAR
#undef PG8_SCHED
}
}
using pg8::Unit;

#define XB_TMO      128
#define XB_XCNT(j)  (256  + 64 * (j))
#define XB_XSUB(j)  (1280 + 64 * (j))
#define XB_XGEN(j)  (2304 + 64 * (j))
#define XB_TOP      3328
#define XB_TOPGEN   3392
#define XCD_BAR_WORDS 3456
#define XB_SPIN_CAP (1u << 18)
__device__ __forceinline__ unsigned xb_ld(unsigned* p)              { return __hip_atomic_load(p, __ATOMIC_RELAXED, __HIP_MEMORY_SCOPE_AGENT); }
__device__ __forceinline__ unsigned xb_add(unsigned* p, unsigned v) { return __hip_atomic_fetch_add(p, v, __ATOMIC_RELAXED, __HIP_MEMORY_SCOPE_AGENT); }
__device__ __forceinline__ unsigned xb_xcc_id() { return (unsigned)__builtin_amdgcn_s_getreg((3 << 11) | 20) & 0xFu; }
#define XB_SPIN(cond, bar) do { unsigned _sp = 0; while (cond) { __builtin_amdgcn_s_sleep(1); \
    if ((++_sp & 255u) == 0u) { if (xb_ld(&(bar)[XB_TMO])) break; if (_sp > XB_SPIN_CAP) { atomicAdd(&(bar)[XB_TMO], 1u); break; } } } } while (0)
struct XcdBarrier { unsigned* bar; unsigned x; volatile LAS unsigned* st; };
__device__ __forceinline__ XcdBarrier xcd_barrier_post(unsigned* bar, volatile LAS unsigned* st) {
    XcdBarrier b; b.bar = bar; b.x = xb_xcc_id(); b.st = st;
    if (threadIdx.x == 0) (void)xb_add(&bar[XB_XCNT(b.x)], 1u);
    return b;
}
__device__ __forceinline__ void xcd_barrier_complete(unsigned* bar, unsigned x, unsigned& nloc, unsigned& nx) {
    const unsigned G = gridDim.x * gridDim.y * gridDim.z;
    unsigned sum, cnt, mine, sp = 0u;
    for (;;) {
        sum = 0u; cnt = 0u; mine = 0u;
#pragma unroll
        for (unsigned j = 0; j < 16; ++j) { const unsigned c = xb_ld(&bar[XB_XCNT(j)]); sum += c; cnt += (c > 0u) ? 1u : 0u; mine = (j == x) ? c : mine; }
        if (sum == G) break;
        __builtin_amdgcn_s_sleep(1);
        if ((++sp & 255u) == 0u) { if (xb_ld(&bar[XB_TMO])) break; if (sp > XB_SPIN_CAP) { atomicAdd(&bar[XB_TMO], 1u); break; } }
    }
    nloc = mine > 0u ? mine : 1u; nx = cnt > 0u ? cnt : 1u;
}
__device__ __forceinline__ void xcd_barrier(const XcdBarrier& b) {
    asm volatile("s_waitcnt vmcnt(0)" ::: "memory");
    __syncthreads();
    if (threadIdx.x == 0) {
        unsigned* bar = b.bar;
        __builtin_amdgcn_s_waitcnt(0);
        unsigned nloc = b.st[0], nx = b.st[1];
        if (nloc == 0u) { xcd_barrier_complete(bar, b.x, nloc, nx); b.st[0] = nloc; b.st[1] = nx; }
        const unsigned old = xb_add(&bar[XB_XSUB(b.x)], 1u);
        const unsigned gen = old / nloc;
        if (old + 1u == (gen + 1u) * nloc) {
            __builtin_amdgcn_fence(__ATOMIC_RELEASE, "agent");
            asm volatile("s_waitcnt vmcnt(0)" ::: "memory");
            const unsigned og = xb_add(&bar[XB_TOP], 1u);
            const unsigned tg = og / nx;
            if (og + 1u == (tg + 1u) * nx) xb_add(&bar[XB_TOPGEN], 1u);
            else XB_SPIN(xb_ld(&bar[XB_TOPGEN]) == tg, bar);
            __builtin_amdgcn_fence(__ATOMIC_ACQUIRE, "agent");
            xb_add(&bar[XB_XGEN(b.x)], 1u);
            asm volatile("s_waitcnt vmcnt(0)" ::: "memory");
        } else {
            XB_SPIN(xb_ld(&bar[XB_XGEN(b.x)]) == gen, bar);
            __builtin_amdgcn_fence(__ATOMIC_ACQUIRE, "agent");
            asm volatile("s_waitcnt vmcnt(0)" ::: "memory");
        }
    }
    __syncthreads();
}

struct Args { const float* in[19]; float* out; unsigned char* ws; int ph_lo, ph_hi; };
typedef const __attribute__((address_space(4))) Args* ArgsP;
enum { I_X = 0, I_N1G, I_WIN, I_CONVW, I_IFB, I_MNG, I_WBM, I_WBA, I_WOUT, I_RELB, I_N2G, I_WGRP, I_BGRP, I_WEXP, I_BEXP, I_W1, I_W3, I_W2, I_FG };


struct TrDesc { const float* W; bf16* WT; size_t ldn, ldk; int k0, n0, r0; };
__device__ __forceinline__ void tr_load(const TrDesc& d, f32x4 (&tv)[16], int lane) {
    const int nn4 = (lane & 15) * 4, kr = lane >> 4;
#pragma unroll
    for (int i = 0; i < 16; ++i) tv[i] = __builtin_nontemporal_load((const f32x4*)(d.W + (size_t)(d.k0 + 4 * i + kr) * d.ldn + d.n0 + nn4));
}
__device__ __forceinline__ void tr_finish(const TrDesc& d, f32x4 (&tv)[16], LAS float* scr, int lane) {
    const int nn4 = (lane & 15) * 4, kr = lane >> 4;
#pragma unroll
    for (int i = 0; i < 16; i += 4) asm volatile("" : "+v"(tv[i]), "+v"(tv[i + 1]), "+v"(tv[i + 2]), "+v"(tv[i + 3]));
#pragma unroll
    for (int i = 0; i < 16; ++i) { const int kk = 4 * i + kr; const f32x4 v = tv[i];
        LAS float* q = scr + kk * 65 + nn4; q[0] = v.x; q[1] = v.y; q[2] = v.z; q[3] = v.w; }
    LDS_WAIT();
    const int kc = (lane & 7) * 8;
#pragma unroll
    for (int p = 0; p < 8; ++p) { const int nn = 8 * p + (lane >> 3); const LAS float* sp = scr + kc * 65 + nn;
        u32x4 o; o.x = cvt_pk_bf16(sp[0], sp[65]); o.y = cvt_pk_bf16(sp[130], sp[195]); o.z = cvt_pk_bf16(sp[260], sp[325]); o.w = cvt_pk_bf16(sp[390], sp[455]);
        *(u32x4*)(d.WT + (size_t)(d.r0 + nn) * d.ldk + d.k0 + kc) = o; }
    LDS_WAIT();
}
__device__ __forceinline__ int win_src_col(int r) {
    if (r < 2048) return r;
    if (r < 3072) return r + 1024;
    if (r < 5120) return r + 1032;
    if (r < 9216) return r + 2056;
    if (r < 10240) return r - 7168;
    return r - 4088;
}
__device__ __forceinline__ TrDesc tr_decode(ArgsP a, unsigned char* ws, int it) {
    constexpr int PER_LAYER = 5632 + 512 + 512 + 1024 + 4096 + 4096 + 4096;
    const int l = it / PER_LAYER; int r = it % PER_LAYER;
    TrDesc d;
    if (r < 5632) { const int kb = r / 176, ng = r % 176;
        d.W = a->in[I_WIN] + (size_t)l * DM * INCOLS; d.ldn = INCOLS; d.k0 = 64 * kb; d.n0 = win_src_col(64 * ng); d.WT = (bf16*)(ws + WS_WINT) + (size_t)l * 11264 * 2048; d.ldk = 2048; d.r0 = 64 * ng; return d; }
    r -= 5632;
    if (r < 512) { const int kb = r / 32, ng = r % 32;
        d.W = a->in[I_WBM] + (size_t)l * 1024 * 2048; d.ldn = 2048; d.k0 = 64 * kb; d.n0 = 64 * ng; d.WT = (bf16*)(ws + WS_WBM) + (size_t)l * 2048 * 1024; d.ldk = 1024; d.r0 = 64 * ng; return d; }
    r -= 512;
    if (r < 512) { const int kb = r / 32, ng = r % 32;
        d.W = a->in[I_WBA] + (size_t)l * 1024 * 2048; d.ldn = 2048; d.k0 = 64 * kb; d.n0 = 64 * ng; d.WT = (bf16*)(ws + WS_WBA) + (size_t)l * 2048 * 1024; d.ldk = 1024; d.r0 = 64 * ng; return d; }
    r -= 512;
    if (r < 1024) { const int kb = r / 32, ng = r % 32;
        d.W = a->in[I_WOUT] + (size_t)l * 2048 * 2048; d.ldn = 2048; d.k0 = 64 * kb; d.n0 = 64 * ng; d.WT = (bf16*)(ws + WS_WOUT) + (size_t)l * 2048 * 2048; d.ldk = 2048; d.r0 = 64 * ng; return d; }
    r -= 1024;
    if (r < 8192) { const int w3 = r >= 4096; const int q = r & 4095; const int e = q >> 7, rr = q & 127, kb = rr >> 2, ng = rr & 3;
        d.W = a->in[w3 ? I_W3 : I_W1] + (size_t)(l * 32 + e) * 2048 * 256; d.ldn = 256; d.k0 = 64 * kb; d.n0 = 64 * ng;
        d.WT = (bf16*)(ws + WS_W13) + (size_t)(l * 32 + e) * 512 * 2048; d.ldk = 2048; d.r0 = 256 * (ng >> 1) + 64 * (ng & 1) + (w3 ? 128 : 0); return d; }
    r -= 8192;
    { const int e = r >> 7, rr = r & 127, kb = rr >> 5, ng = rr & 31;
        d.W = a->in[I_W2] + (size_t)(l * 32 + e) * 256 * 2048; d.ldn = 2048; d.k0 = 64 * kb; d.n0 = 64 * ng; d.WT = (bf16*)(ws + WS_W2) + (size_t)(l * 32 + e) * 2048 * 256; d.ldk = 256; d.r0 = 64 * ng; return d; }
}
#ifndef CVX
#define CVX 4096
#endif
__device__ __forceinline__ void prologue_phase(ArgsP a, LAS unsigned char* lds, int tid, int lane, int wave, int bid, int G, const int part = 0) {
    unsigned char* ws = a->ws;
    LAS float* scr = (LAS float*)(lds + wave * 16640);
    const int gw = bid * NWAVES + wave, NGW = G * NWAVES;
    constexpr int PER_LAYER = 5632 + 512 + 512 + 1024 + 4096 + 4096 + 4096;
    constexpr int W0 = 5632, W2I = PER_LAYER - 4096;
    const int v_lo = part == 0 ? 0 : part == 1 ? PER_LAYER : part == 2 ? W0 + CVX : part == 3 ? PER_LAYER + W0 : PER_LAYER + W2I;
    const int v_hi = part == 0 ? W0 + CVX : part == 1 ? PER_LAYER + W0 : part == 2 ? PER_LAYER : part == 3 ? PER_LAYER + W2I : 2 * PER_LAYER;
#define CV_ITEM(v) (v)
    f32x4 tvA[16], tvB[16]; TrDesc dA, dB;
    int it = v_lo + gw;
    if (it < v_hi) {
        int rem = (v_hi - 1 - it) / NGW;
        dA = tr_decode(a, ws, CV_ITEM(it)); tr_load(dA, tvA, lane);
#pragma unroll 1
        while (rem >= 2) {
            dB = tr_decode(a, ws, CV_ITEM(it + NGW)); tr_load(dB, tvB, lane);
            tr_finish(dA, tvA, scr, lane);
            it += 2 * NGW;
            dA = tr_decode(a, ws, CV_ITEM(it)); tr_load(dA, tvA, lane);
            tr_finish(dB, tvB, scr, lane);
            rem -= 2;
        }
        if (rem == 1) { dB = tr_decode(a, ws, CV_ITEM(it + NGW)); tr_load(dB, tvB, lane); tr_finish(dA, tvA, scr, lane); tr_finish(dB, tvB, scr, lane); }
        else tr_finish(dA, tvA, scr, lane);
    }
#undef CV_ITEM
    if (part != 0) return;
    const int gt = bid * NTHR + tid, NGT = G * NTHR;
    float* wrt = (float*)(ws + MS_WRT);
    for (int i = gt; i < 2 * 36 * 2048; i += NGT) { const int l = i / (36 * 2048), rr = i % (36 * 2048), n = rr >> 11, k = rr & 2047;
        wrt[i] = n < 4 ? a->in[I_WGRP][((size_t)l * DM + k) * 4 + n] : a->in[I_WEXP][((size_t)l * DM + k) * 32 + (n - 4)]; }
}

__device__ __forceinline__ void moe_tables(unsigned char* ws, int l, LAS unsigned char* misc, int tid) {
    LAS int* cnt = (LAS int*)(misc + MO_CNT); LAS int* ntl = (LAS int*)(misc + MO_NT); LAS int* off = (LAS int*)(misc + MO_OFF);
    LAS int* te = (LAS int*)(misc + MO_TE); LAS int* tr0 = (LAS int*)(misc + MO_TR0); LAS int* mt = (LAS int*)(misc + MO_MT);
    __syncthreads();
    if (tid < 32) { const int c = (int)__hip_atomic_load((unsigned*)(ws + WS_CTL) + CW_CNT + 32 * l + tid, __ATOMIC_RELAXED, __HIP_MEMORY_SCOPE_AGENT); cnt[tid] = c; ntl[tid] = (c + 255) >> 8; }
    __syncthreads();
    if (tid == 0) { int o = 0;
#pragma unroll 1
        for (int e = 0; e < 32; ++e) { off[e] = o; const int n = ntl[e];
#pragma unroll 1
            for (int j = 0; j < n; ++j) { te[o + j] = e; tr0[o + j] = 256 * j; } o += n; } off[32] = o; mt[0] = o; }
    __syncthreads();
}

#ifndef DRYX
#define DRYX 0
#endif
template <int MODE>
__device__ __forceinline__ void norm_phase(ArgsP a, int l, LAS unsigned char* lds, int tid, int lane, int wave, int bid, int G, const bool dry = false) {
    unsigned char* ws = a->ws;
    LAS unsigned char* misc = lds + MISC_OFF;
    if (MODE == 1 || MODE == 3) moe_tables(ws, MODE == 1 ? 0 : 1, misc, tid);
    const LAS int* off = (const LAS int*)(misc + MO_OFF);
    const float* src = (MODE == 0) ? a->in[I_X] : a->out;
    const float* gain = (MODE < 2) ? a->in[I_N1G] + l * DM : (MODE == 2 ? a->in[I_N2G] + l * DM : a->in[I_FG]);
    const int* toke = (const int*)(ws + MS_TOKE); const int* tokp = (const int*)(ws + MS_TOKP);
    const bf16* OP = (const bf16*)(ws + WS_OP);
    bf16* H = (bf16*)(ws + WS_H);
    const int gw = bid * NWAVES + wave, NGW = G * NWAVES;
    constexpr int RP = (MODE == 2) ? 4 : 2;
    for (int m0 = gw * RP; m0 < NTOK; m0 += NGW * RP) {
        f32x4 v[RP][8];
#pragma unroll
        for (int r = 0; r < RP; ++r)
#pragma unroll
            for (int j = 0; j < 8; ++j) v[r][j] = *(const f32x4*)(src + (size_t)(m0 + r) * DM + 256 * j + 4 * lane);
        if (MODE == 1 || MODE == 3) {
#pragma unroll
            for (int r = 0; r < RP; ++r) { const int m = m0 + r;
                const int e0 = toke[2 * m], e1 = toke[2 * m + 1], p0 = tokp[2 * m], p1 = tokp[2 * m + 1];
                const float cw0 = ((const float*)(ws + MS_TOKW))[2 * m], cw1 = ((const float*)(ws + MS_TOKW))[2 * m + 1];
                const bf16* o0 = OP + (size_t)(off[e0] * 256 + p0) * DM + 4 * lane; const bf16* o1 = OP + (size_t)(off[e1] * 256 + p1) * DM + 4 * lane;
                u32x2 ow0[8], ow1[8];
#pragma unroll
                for (int j = 0; j < 8; ++j) { ow0[j] = *(const u32x2*)(o0 + 256 * j); ow1[j] = *(const u32x2*)(o1 + 256 * j); }
                asm volatile("" : "+v"(ow0[0]), "+v"(ow0[1]), "+v"(ow0[2]), "+v"(ow0[3]), "+v"(ow0[4]), "+v"(ow0[5]), "+v"(ow0[6]), "+v"(ow0[7]),
                                  "+v"(ow1[0]), "+v"(ow1[1]), "+v"(ow1[2]), "+v"(ow1[3]), "+v"(ow1[4]), "+v"(ow1[5]), "+v"(ow1[6]), "+v"(ow1[7]));
#pragma unroll
                for (int j = 0; j < 8; ++j) { const u32x2 w0 = ow0[j], w1 = ow1[j];
                    v[r][j].x += cw0 * bflo(w0.x) + cw1 * bflo(w1.x); v[r][j].y += cw0 * bfhi(w0.x) + cw1 * bfhi(w1.x); v[r][j].z += cw0 * bflo(w0.y) + cw1 * bflo(w1.y); v[r][j].w += cw0 * bfhi(w0.y) + cw1 * bfhi(w1.y); }
                if (MODE == 1 && !dry) {
#pragma unroll
                    for (int j = 0; j < 8; ++j) *(f32x4*)(a->out + (size_t)m * DM + 256 * j + 4 * lane) = v[r][j]; }
                asm volatile("" ::: "memory");
            }
        }
        float rs[RP];
#pragma unroll
        for (int r = 0; r < RP; ++r) { float ss = 0.f;
#pragma unroll
            for (int j = 0; j < 8; ++j) ss += (v[r][j].x * v[r][j].x + v[r][j].y * v[r][j].y) + (v[r][j].z * v[r][j].z + v[r][j].w * v[r][j].w);
            rs[r] = __builtin_amdgcn_rsqf(wave_sum(ss) * (1.0f / DM) + RMS_EPS); }
        {
            f32x4 gv[8];
#pragma unroll
            for (int j = 0; j < 8; ++j) gv[j] = *(const f32x4*)(gain + 256 * j + 4 * lane);
            asm volatile("" : "+v"(gv[0]), "+v"(gv[1]), "+v"(gv[2]), "+v"(gv[3]), "+v"(gv[4]), "+v"(gv[5]), "+v"(gv[6]), "+v"(gv[7]));
#pragma unroll
            for (int j = 0; j < 8; ++j)
#pragma unroll
                for (int r = 0; r < RP; ++r) v[r][j] = v[r][j] * rs[r] * gv[j];
        }
        if (MODE == 3) {
#pragma unroll
            for (int r = 0; r < RP; ++r)
#pragma unroll
                for (int j = 0; j < 8; ++j) { if (!dry) *(f32x4*)(a->out + (size_t)(m0 + r) * DM + 256 * j + 4 * lane) = v[r][j]; else asm volatile("" :: "v"(v[r][j])); }
            continue;
        }
#pragma unroll
        for (int r = 0; r < RP; ++r)
#pragma unroll
            for (int j = 0; j < 8; ++j) { u32x2 w; w.x = cvt_pk_bf16(v[r][j].x, v[r][j].y); w.y = cvt_pk_bf16(v[r][j].z, v[r][j].w);
                if (!dry) *(u32x2*)(H + (size_t)(m0 + r) * DM + 256 * j + 4 * lane) = w; else asm volatile("" :: "v"(w)); }
        float keep[RP]; _Pragma("unroll") for (int r = 0; r < RP; ++r) keep[r] = 0.f;
        if (MODE < 2) {
            float a8[RP][8];
#pragma unroll
            for (int r = 0; r < RP; ++r)
#pragma unroll
                for (int n = 0; n < 8; ++n) a8[r][n] = 0.f;
            const float* wg = a->in[I_WIN] + (size_t)l * DM * INCOLS + 4096;
#pragma unroll
            for (int j = 0; j < 8; ++j)
#pragma unroll
                for (int c = 0; c < 4; ++c) { const float* wp = wg + (size_t)(256 * j + 4 * lane + c) * INCOLS;
                    const f32x4 w0 = *(const f32x4*)wp, w1 = *(const f32x4*)(wp + 4);
#pragma unroll
                    for (int r = 0; r < RP; ++r) { const float hv = v[r][j][c];
                        a8[r][0] += hv * w0.x; a8[r][1] += hv * w0.y; a8[r][2] += hv * w0.z; a8[r][3] += hv * w0.w;
                        a8[r][4] += hv * w1.x; a8[r][5] += hv * w1.y; a8[r][6] += hv * w1.z; a8[r][7] += hv * w1.w; }
                    if (c == 3) asm volatile("" ::: "memory"); }
#pragma unroll
            for (int r = 0; r < RP; ++r)
#pragma unroll
                for (int n = 0; n < 8; ++n) { const float d = wave_sum(a8[r][n]); keep[r] = (lane == n) ? d : keep[r]; }
        } else {
            const float* W = (const float*)(ws + MS_WRT) + (size_t)l * 36 * 2048;
            LAS float* logl = (LAS float*)(misc + MO_LOG) + wave * 160;
#pragma unroll 1
            for (int grp = 0; grp < 9; ++grp) {
                float val[16];
                const float* wg = W + (size_t)(4 * grp) * 2048 + 4 * lane;
#pragma unroll
                for (int nl = 0; nl < 4; ++nl) {
                    float d[4] = {0.f, 0.f, 0.f, 0.f};
                    f32x4 wv[8];
#pragma unroll
                    for (int j = 0; j < 8; ++j) wv[j] = *(const f32x4*)(wg + nl * 2048 + 256 * j);
                    asm volatile("" : "+v"(wv[0]), "+v"(wv[1]), "+v"(wv[2]), "+v"(wv[3]), "+v"(wv[4]), "+v"(wv[5]), "+v"(wv[6]), "+v"(wv[7]));
#pragma unroll
                    for (int j = 0; j < 8; ++j) { const f32x4 w = wv[j];
#pragma unroll
                        for (int r = 0; r < 4; ++r) d[r] += (v[r][j].x * w.x + v[r][j].y * w.y) + (v[r][j].z * w.z + v[r][j].w * w.w); }
#pragma unroll
                    for (int r = 0; r < 4; ++r) val[4 * nl + r] = d[r];
                }
#pragma unroll
                for (int i = 0; i < 8; ++i) { const bool hi = (lane & 32) != 0; const float snd = hi ? val[i] : val[i + 8]; const float kp = hi ? val[i + 8] : val[i]; val[i] = kp + __shfl_xor(snd, 32); }
#pragma unroll
                for (int i = 0; i < 4; ++i) { const bool hi = (lane & 16) != 0; const float snd = hi ? val[i] : val[i + 4]; const float kp = hi ? val[i + 4] : val[i]; val[i] = kp + __shfl_xor(snd, 16); }
#pragma unroll
                for (int i = 0; i < 2; ++i) { const bool hi = (lane & 8) != 0; const float snd = hi ? val[i] : val[i + 2]; const float kp = hi ? val[i + 2] : val[i]; val[i] = kp + __shfl_xor(snd, 8); }
                { const bool hi = (lane & 4) != 0; const float snd = hi ? val[0] : val[1]; const float kp = hi ? val[1] : val[0]; val[0] = kp + __shfl_xor(snd, 4); }
                float f = val[0]; f += __shfl_xor(f, 2); f += __shfl_xor(f, 1);
                const int vi = lane >> 2;
                if ((lane & 3) == 0) logl[(vi & 3) * 40 + 4 * grp + (vi >> 2)] = f;
            }
        }
        if (MODE < 2) {
            float* ifg = (float*)(ws + MS_IFG);
            if (lane < 8) {
#pragma unroll
                for (int r = 0; r < RP; ++r) { if (!dry) ifg[(size_t)(m0 + r) * 8 + lane] = keep[r]; else asm volatile("" :: "v"(keep[r])); } }
        } else {
            LAS float* logl = (LAS float*)(misc + MO_LOG) + wave * 160;
            LDS_WAIT();
            if (dry) { asm volatile("" :: "v"(keep[0])); }
            if (lane < RP && !dry) {
                const int m = m0 + lane; const LAS float* lg = logl + lane * 40;
                const float* bg = a->in[I_BGRP] + l * 4; const float* be = a->in[I_BEXP] + l * 32;
                float gv[4]; int gsel = 0;
#pragma unroll
                for (int j = 0; j < 4; ++j) gv[j] = lg[j] + bg[j];
                float gmax = gv[0];
#pragma unroll
                for (int j = 1; j < 4; ++j) if (gv[j] > gmax) { gmax = gv[j]; gsel = j; }
                float gs = 0.f;
#pragma unroll
                for (int j = 0; j < 4; ++j) gs += expf(gv[j] - gmax);
                const float pg = 1.0f / gs;
                float ev[8];
#pragma unroll
                for (int j = 0; j < 8; ++j) ev[j] = lg[4 + 8 * gsel + j] + be[8 * gsel + j];
                int e0 = 0; float m0v = ev[0];
#pragma unroll
                for (int j = 1; j < 8; ++j) if (ev[j] > m0v) { m0v = ev[j]; e0 = j; }
                int e1 = -1; float m1v = -3.0e38f;
#pragma unroll
                for (int j = 0; j < 8; ++j) if (j != e0 && ev[j] > m1v) { m1v = ev[j]; e1 = j; }
                const float p1 = expf(m1v - m0v); const float w0 = pg / (1.0f + p1), w1 = pg * p1 / (1.0f + p1);
                unsigned* cnt = (unsigned*)(ws + WS_CTL) + CW_CNT + 32 * l;
                int* list = (int*)(ws + MS_LIST); float* pwl = (float*)(ws + MS_PWL); int* tke = (int*)(ws + MS_TOKE); int* tkp = (int*)(ws + MS_TOKP);
                const int id0 = 8 * gsel + e0, id1 = 8 * gsel + e1;
                const int q0 = (int)__hip_atomic_fetch_add(cnt + id0, 1u, __ATOMIC_RELAXED, __HIP_MEMORY_SCOPE_AGENT);
                const int q1 = (int)__hip_atomic_fetch_add(cnt + id1, 1u, __ATOMIC_RELAXED, __HIP_MEMORY_SCOPE_AGENT);
                list[id0 * 8192 + q0] = m; pwl[id0 * 8192 + q0] = w0; list[id1 * 8192 + q1] = m; pwl[id1 * 8192 + q1] = w1;
                tke[2 * m] = id0; tke[2 * m + 1] = id1; tkp[2 * m] = q0; tkp[2 * m + 1] = q1;
                ((float*)(ws + MS_TOKW))[2 * m] = w0; ((float*)(ws + MS_TOKW))[2 * m + 1] = w1;
            }
            LDS_WAIT();
        }
    }
}

struct SchedG1 {
    static constexpr bool GATHER = false;
    const char* H; const char* W; int G, c;
    static constexpr int NCV = 21;
    __device__ __forceinline__ bool next(int i, Unit& u) const {
        int L = i * G + c;
        if (G == 256) {
            if (c >= 256 - NCV) return false;
            if (c >= 128 && i == 5) { const int k = c - 128; if (k >= 5 * NCV) return false; L = (k % 5) * 256 + (256 - NCV) + k / 5; }
            else if (i > 5) return false;
        }
        if (L < 1152) { pg8::static_tile(L, 32, 36, u.pm, u.pn); u.aux = 0; return true; }
        const int r = L - 1152; if (r >= 256) return false;
        u.aux = 1 + (r >> 7); const int q = r & 127; u.pm = q & 3; u.pn = q >> 2; return true;
    }
    __device__ __forceinline__ const char* abase(const Unit& u) const { return u.aux == 0 ? H + (size_t)u.pm * 256 * 4096 : W + (size_t)(9216 + (u.aux - 1) * 1024 + u.pm * 256) * 4096; }
    __device__ __forceinline__ const char* bbase(const Unit& u) const { return u.aux == 0 ? W + (size_t)u.pn * 256 * 4096 : H + (size_t)u.pn * 256 * 4096; }
    __device__ __forceinline__ unsigned arow(const Unit&, int) const { return 0u; }
    static __device__ __forceinline__ bool keep_acc(const Unit&) { return false; }
};
struct EpiG1 {
    static constexpr bool PERM = true;
    unsigned char* ws; bool dry;
    __device__ __forceinline__ void operator()(f32x4 (&acc)[2][2][4][2], const Unit& u, int wr, int wc, int fr, int fq) const {
        if (dry) {
#pragma unroll
            for (int ai = 0; ai < 2; ++ai)
#pragma unroll
                for (int bj = 0; bj < 2; ++bj)
#pragma unroll
                    for (int m = 0; m < 4; ++m) asm volatile("" :: "v"(acc[ai][bj][m][0]), "v"(acc[ai][bj][m][1]));
            return; }
        if (u.aux == 0) {
            bf16* dst; int ld, colt, op;
            if (u.pn < 8) { dst = (bf16*)(ws + WS_ZQK); ld = 2048; colt = 256 * u.pn; op = 0; }
            else if (u.pn < 12) { dst = (bf16*)(ws + WS_OM); ld = 1024; colt = 256 * (u.pn - 8); op = 1; }
            else if (u.pn < 16) { dst = (bf16*)(ws + WS_QA); ld = 1024; colt = 256 * (u.pn - 12); op = 2; }
            else if (u.pn < 20) { dst = (bf16*)(ws + WS_KA); ld = 1024; colt = 256 * (u.pn - 16); op = 0; }
            else { dst = (bf16*)(ws + WS_SG); ld = 4096; colt = 256 * (u.pn - 20); op = 1; }
            const float scl = (op == 2) ? 0.12751743074602267f : 1.0f;
            const int row0 = u.pm * 256 + wr * 64 + fr, col0 = colt + wc * 32 + 8 * fq;
#pragma unroll
            for (int ai = 0; ai < 2; ++ai)
#pragma unroll
                for (int m = 0; m < 4; ++m) { bf16* rowp = dst + (size_t)(row0 + ai * 128 + m * 16) * ld + col0;
#pragma unroll
                    for (int bj = 0; bj < 2; ++bj) { f32x4 v0 = acc[ai][bj][m][0] * scl, v1 = acc[ai][bj][m][1] * scl;
                        if (op == 1) {
#pragma unroll
                            for (int j = 0; j < 4; ++j) { v0[j] = sigmoidf_(v0[j]); v1[j] = sigmoidf_(v1[j]); } }
                        u32x4 w; w.x = cvt_pk_bf16(v0[0], v0[1]); w.y = cvt_pk_bf16(v0[2], v0[3]); w.z = cvt_pk_bf16(v1[0], v1[1]); w.w = cvt_pk_bf16(v1[2], v1[3]);
                        *(u32x4*)(rowp + bj * 128) = w; } }
        } else {
            bf16* dst = (bf16*)(ws + (u.aux == 1 ? WS_VMT : WS_VAT));
            const int b = u.pn >> 3, s0 = (u.pn & 7) * 256 + wc * 32 + 8 * fq, rr0 = u.pm * 256 + wr * 64 + fr;
#pragma unroll
            for (int ai = 0; ai < 2; ++ai)
#pragma unroll
                for (int m = 0; m < 4; ++m) { const int rr = rr0 + ai * 128 + m * 16;
#pragma unroll
                    for (int bj = 0; bj < 2; ++bj) { const f32x4 v0 = acc[ai][bj][m][0], v1 = acc[ai][bj][m][1];
                        u32x4 w; w.x = cvt_pk_bf16(v0[0], v0[1]); w.y = cvt_pk_bf16(v0[2], v0[3]); w.z = cvt_pk_bf16(v1[0], v1[1]); w.w = cvt_pk_bf16(v1[2], v1[3]);
                        const int sq = s0 + bj * 128;
                        const size_t off = (u.aux == 1) ? (size_t)((((b * 4 + (rr >> 8)) * 32 + (sq >> 6)) * 2 + ((sq >> 5) & 1)) * 16 + ((rr & 255) >> 4)) * 512 + (size_t)((((sq >> 3) & 3) * 16 + (rr & 15)) * 8)
                                                        : (size_t)(b * 1024 + rr) * 2048 + sq;
                        *(u32x4*)(dst + off) = w; } }
        }
    }
};

__device__ __forceinline__ void gate_unit(ArgsP a, int l, LAS unsigned char* lds, int bh, int tid, int lane, int wave) {
    unsigned char* ws = a->ws;
    {
            const int b = bh >> 2, h = bh & 3;
            LAS float* bl = (LAS float*)lds; LAS float* amx = bl + 32; LAS float* mpv = bl + 64; LAS float* gcv = bl + 96;
            const float* ifg = (const float*)(ws + MS_IFG); const float* ifb = a->in[I_IFB] + l * 8;
            float A[4], Bs[4], CM[4];
#pragma unroll
            for (int cc = 0; cc < 4; ++cc) { const int c = wave + 8 * cc, s = 64 * c + lane; const size_t tok = (size_t)b * SEQ + s;
                const float ig = ifg[tok * 8 + h] + ifb[h], fg = ifg[tok * 8 + 4 + h] + ifb[4 + h];
                const float lf = fminf(fg, 0.f) - log1pf(expf(-fabsf(fg)));
                float bs = lf;
#pragma unroll
                for (int o = 1; o < 64; o <<= 1) { const float t = __shfl_up(bs, o); if (lane >= o) bs += t; }
                const float av = ig - bs; float cm = av;
#pragma unroll
                for (int o = 1; o < 64; o <<= 1) { const float t = __shfl_up(cm, o); if (lane >= o) cm = fmaxf(cm, t); }
                A[cc] = av; Bs[cc] = bs; CM[cc] = cm;
                if (lane == 63) { bl[c] = bs; amx[c] = cm; } }
            __syncthreads();
            if (tid == 0) { float m = 0.f;
#pragma unroll 1
                for (int c = 0; c < 32; ++c) { mpv[c] = m; const float Gm = fmaxf(m, amx[c]); gcv[c] = Gm; m = bl[c] + Gm; } }
            __syncthreads();
            float* AS = (float*)(ws + MS_AS) + bh * 2048; float* GT = (float*)(ws + MS_GT) + bh * 2048; float* WI = (float*)(ws + MS_WI) + bh * 2048;
            float* CL = (float*)(ws + MS_CL) + bh * 2048; float* WSs = (float*)(ws + MS_WS) + bh * 2048; float* DEC = (float*)(ws + MS_DEC) + bh * 32;
#pragma unroll
            for (int cc = 0; cc < 4; ++cc) { const int c = wave + 8 * cc, s = 64 * c + lane; const float mp = mpv[c], Gm = gcv[c], gt = fmaxf(mp, CM[cc]);
                AS[s] = A[cc]; GT[s] = gt; WI[s] = expf(mp - gt); CL[s] = expf(-(Bs[cc] + gt)); WSs[s] = expf(A[cc] - Gm);
                if (lane == 0) DEC[c] = expf(mp - Gm); }
        }
    __syncthreads();
}

__device__ __forceinline__ void conv_phase(ArgsP a, int l, LAS unsigned char* lds, int tid, int lane, int wave, int bid, int G) {
    unsigned char* ws = a->ws;
    u32x4 xv[5];
    const bf16* Z = (const bf16*)(ws + WS_ZQK);
#define CONV_LOAD(u_) do { const int cg_ = (u_) & 7, s0_ = 64 * (((u_) >> 3) & 31), b_ = (u_) >> 8; _Pragma("unroll") for (int i = 0; i < 5; ++i) { \
        const int idx = tid + NTHR * i, row = idx >> 5, ch = idx & 31, sq = s0_ - 3 + row; xv[i] = (u32x4){0u, 0u, 0u, 0u}; \
        if (idx < 67 * 32 && sq >= 0) xv[i] = *(const u32x4*)(Z + (size_t)(b_ * SEQ + sq) * 2048 + cg_ * 256 + ch * 8); } } while (0)
    if (bid < 1024) CONV_LOAD(bid);
    for (int u = bid; u < 1024 + 256; u += G) {
        if (u < 1024) {
            const int cg = u & 7, st = (u >> 3) & 31, b = u >> 8, s0 = 64 * st;
            LAS unsigned char* xt = lds; LAS unsigned char* kt = lds + 36864;
            asm volatile("" : "+v"(xv[0]), "+v"(xv[1]), "+v"(xv[2]), "+v"(xv[3]), "+v"(xv[4]));
#pragma unroll
            for (int i = 0; i < 5; ++i) { const int idx = tid + NTHR * i, row = idx >> 5, ch = idx & 31;
                if (idx < 67 * 32) *(LAS u32x4*)(xt + row * 512 + ch * 16) = xv[i]; }
            LAS float* wst = (LAS float*)(lds + 73728);
            if (cg >= 4 && tid < 64) wst[tid] = ((const float*)(ws + MS_WS))[(size_t)(b * 4 + cg - 4) * 2048 + s0 + tid];
            __syncthreads();
            if (u + G < 1024) CONV_LOAD(u + G);
            const int cp = tid & 127, tg = tid >> 7, c = 2 * cp, gc = cg * 256 + c;
            float w0[4], w1[4];
#pragma unroll
            for (int j = 0; j < 4; ++j) { w0[j] = a->in[I_CONVW][(size_t)(l * 4 + j) * 2048 + gc]; w1[j] = a->in[I_CONVW][(size_t)(l * 4 + j) * 2048 + gc + 1]; }
            bf16* QM = (bf16*)(ws + WS_QM); bf16* KM = (bf16*)(ws + WS_KM);
#pragma unroll 4
            for (int tt = 0; tt < 16; ++tt) { const int t = tg * 16 + tt; float a0 = 0.f, a1 = 0.f;
#pragma unroll
                for (int j = 0; j < 4; ++j) { const unsigned x = *(const LAS unsigned*)(xt + (t + j) * 512 + c * 2); a0 += w0[j] * bflo(x); a1 += w1[j] * bfhi(x); }
                float o0 = a0 * sigmoidf_(a0), o1 = a1 * sigmoidf_(a1);
                const size_t tok = (size_t)b * SEQ + s0 + t;
                if (cg < 4) { *(unsigned*)(QM + tok * 1024 + cg * 256 + c) = cvt_pk_bf16(o0, o1); }
                else { o0 *= 0.0625f; o1 *= 0.0625f; const unsigned p = cvt_pk_bf16(o0, o1);
                    *(unsigned*)(KM + tok * 1024 + (cg - 4) * 256 + c) = p;
                    const float wsv = wst[t]; const unsigned ps = cvt_pk_bf16(o0 * wsv, o1 * wsv);
                    *(LAS unsigned short*)(kt + c * 144 + t * 2) = (unsigned short)(ps & 0xffffu); *(LAS unsigned short*)(kt + (c + 1) * 144 + t * 2) = (unsigned short)(ps >> 16); }
            }
            if (cg >= 4) {
                __syncthreads();
                bf16* KMT = (bf16*)(ws + WS_KMT);
                for (int idx = tid; idx < 2048; idx += NTHR) {
                    const int ks = idx >> 10, dtl = (idx >> 6) & 15, ln = idx & 63, row = dtl * 16 + (ln & 15), ch = ks * 4 + (ln >> 4);
                    const u32x4 v = *(const LAS u32x4*)(kt + row * 144 + ch * 16);
                    *(u32x4*)(KMT + (size_t)(((b * 4 + cg - 4) * 32 + st) * 2) * 8192 + (size_t)idx * 8) = v; }
                if (tid < 256) {
                    float sm = 0.f;
#pragma unroll
                    for (int i = 0; i < 8; ++i) { const u32x4 v = *(const LAS u32x4*)(kt + tid * 144 + i * 16);
                        sm += (bflo(v.x) + bfhi(v.x)) + (bflo(v.y) + bfhi(v.y)) + (bflo(v.z) + bfhi(v.z)) + (bflo(v.w) + bfhi(v.w)); }
                    ((float*)(ws + MS_NST))[(size_t)((b * 4 + cg - 4) * 32 + st) * 256 + tid] = sm; }
            }
        } else if (u < 1280) {
            const int j = u - 1024, b = j >> 6, n = (j >> 3) & 7, h = j & 7;
            const bf16* KA = (const bf16*)(ws + WS_KA) + (size_t)(b * SEQ + n * 256 + wave * 32) * 1024 + h * 128 + 2 * lane;
            float s0 = 0.f, s1 = 0.f;
            unsigned xr[32];
#pragma unroll
            for (int r = 0; r < 32; ++r) xr[r] = *(const unsigned*)(KA + (size_t)r * 1024);
#pragma unroll
            for (int r = 0; r < 32; r += 8) asm volatile("" : "+v"(xr[r]), "+v"(xr[r + 1]), "+v"(xr[r + 2]), "+v"(xr[r + 3]), "+v"(xr[r + 4]), "+v"(xr[r + 5]), "+v"(xr[r + 6]), "+v"(xr[r + 7]));
#pragma unroll
            for (int r = 0; r < 32; ++r) { s0 += bflo(xr[r]); s1 += bfhi(xr[r]); }
            LAS float* part = (LAS float*)lds;
            part[wave * 128 + 2 * lane] = s0; part[wave * 128 + 2 * lane + 1] = s1;
            __syncthreads();
            if (tid < 128) { float t = 0.f;
#pragma unroll
                for (int w = 0; w < 8; ++w) t += part[w * 128 + tid];
                ((float*)(ws + MS_KMEAN))[(size_t)((b * 8 + h) * 8 + n) * 128 + tid] = t * (1.0f / 256.0f); }
        }
        __syncthreads();
    }
}

#undef CONV_LOAD
__device__ __forceinline__ void mlstm_ab_task(unsigned char* ws, int gw, int lane, const bool do_store = true) {
    const int bh = gw >> 7, piece = gw & 127, e0 = (piece >> 3) * 16, d0 = (piece & 7) * 32, q16 = lane & 15, g = lane >> 4;
    const bf16* ka = (const bf16*)(ws + WS_KMT) + (size_t)bh * 32 * 16384 + (size_t)(d0 >> 4) * 512 + lane * 8;
    const bf16* vb = (const bf16*)(ws + WS_VMT) + (size_t)bh * 32 * 16384 + (size_t)(e0 >> 4) * 512 + lane * 8;
    const float* DEC = (const float*)(ws + MS_DEC) + bh * 32;
    bf16* CST = (bf16*)(ws + WS_CST) + (size_t)bh * 32 * 65536 + (size_t)((d0 >> 5) * 16 + (e0 >> 4)) * 512 + (size_t)(((g >> 1) * 16 + q16) * 8 + 4 * (g & 1));
    f32x4 acc[2]; acc[0] = (f32x4){0.f, 0.f, 0.f, 0.f}; acc[1] = acc[0];
    const int decv = __builtin_bit_cast(int, DEC[lane & 31]);
    bf16x8 A0[2][2], B0[2], A1[2][2], B1[2], A2[2][2], B2[2], A3[2][2], B3[2], A4[2][2], B4[2];
#define AB_LOAD(c_, A_, B_) do { const int cc_ = (c_) < 31 ? (c_) : 31; _Pragma("unroll") for (int ks = 0; ks < 2; ++ks) { \
        A_[0][ks] = *(const bf16x8*)(ka + (size_t)cc_ * 16384 + ks * 8192); A_[1][ks] = *(const bf16x8*)(ka + (size_t)cc_ * 16384 + ks * 8192 + 512); B_[ks] = *(const bf16x8*)(vb + (size_t)cc_ * 16384 + ks * 8192); } } while (0)
#define AB_STEP(c_, A_, B_) do { \
        if (do_store) { _Pragma("unroll") for (int f = 0; f < 2; ++f) { u32x2 w; w.x = cvt_pk_bf16(acc[f][0], acc[f][1]); w.y = cvt_pk_bf16(acc[f][2], acc[f][3]); *(u32x2*)(CST + (size_t)(c_) * 65536 + 256 * f) = w; } } \
        const float dec = __builtin_bit_cast(float, __builtin_amdgcn_readlane(decv, (c_))); \
        acc[0] = acc[0] * dec; acc[1] = acc[1] * dec; \
        _Pragma("unroll") for (int ks = 0; ks < 2; ++ks) { \
            acc[0] = __builtin_amdgcn_mfma_f32_16x16x32_bf16(A_[0][ks], B_[ks], acc[0], 0, 0, 0); \
            acc[1] = __builtin_amdgcn_mfma_f32_16x16x32_bf16(A_[1][ks], B_[ks], acc[1], 0, 0, 0); } } while (0)
    AB_LOAD(0, A0, B0); AB_LOAD(1, A1, B1); AB_LOAD(2, A2, B2); AB_LOAD(3, A3, B3); AB_LOAD(4, A4, B4);
#pragma unroll 1
    for (int c = 0; c < 30; c += 5) {
        AB_STEP(c, A0, B0); AB_LOAD(c + 5, A0, B0);
        AB_STEP(c + 1, A1, B1); AB_LOAD(c + 6, A1, B1);
        AB_STEP(c + 2, A2, B2); AB_LOAD(c + 7, A2, B2);
        AB_STEP(c + 3, A3, B3); AB_LOAD(c + 8, A3, B3);
        AB_STEP(c + 4, A4, B4); AB_LOAD(c + 9, A4, B4);
    }
    AB_STEP(30, A0, B0); AB_STEP(31, A1, B1);
    if (!do_store) asm volatile("" :: "v"(acc[0]), "v"(acc[1]));
#undef AB_LOAD
#undef AB_STEP
}

__device__ __forceinline__ void nscan_task(unsigned char* ws, int t, int lane) {
    const int bh = t >> 2, d = (t & 3) * 64 + lane;
    const float* cs = (const float*)(ws + MS_NST) + (size_t)bh * 32 * 256 + d;
    float* nv = (float*)(ws + MS_NVEC) + (size_t)bh * 32 * 256 + d;
    const int decv = __builtin_bit_cast(int, ((const float*)(ws + MS_DEC))[bh * 32 + (lane & 31)]);
    float v[32];
#pragma unroll
    for (int j = 0; j < 32; ++j) v[j] = cs[j * 256];
    float n = 0.f;
#pragma unroll
    for (int j = 0; j < 32; ++j) { nv[j * 256] = n; n = __builtin_bit_cast(float, __builtin_amdgcn_readlane(decv, j)) * n + v[j]; }
}

__device__ __forceinline__ int rel_bucket_dev(int n) {
    if (n < 16) return n;
    int b = 16;
    b += (n >= 19); b += (n >= 21); b += (n >= 24); b += (n >= 27); b += (n >= 31); b += (n >= 35); b += (n >= 40); b += (n >= 46);
    b += (n >= 52); b += (n >= 59); b += (n >= 67); b += (n >= 77); b += (n >= 87); b += (n >= 99); b += (n >= 113);
    return b;
}
constexpr int AT_KT = 0, AT_VT = 34816, AT_TAB = 71680, AT_SEL = 72704, AT_TILES = 73216, AT_CTL = 73600, AT_KM = 73728;
__device__ __forceinline__ void attn_unit(ArgsP a, LAS unsigned char* lds, int uidx, int tid, int lane, int wave) {
    unsigned char* ws = a->ws;
    const int u256 = uidx & 255, second = uidx >> 8, bh = u256 >> 3, kk8 = u256 & 7, si = second ? 15 - kk8 : kk8, wgt = 16 - si;
    const int blk = (wgt - 1) >> 1, half = (wgt - 1) & 1, b = bh >> 3, h = bh & 7, q0 = blk * 256 + half * 128;
    const int q16 = lane & 15, g = lane >> 4;
    LAS float* tab = (LAS float*)(lds + AT_TAB); LAS unsigned* sels = (LAS unsigned*)(lds + AT_SEL); LAS int* tiles = (LAS int*)(lds + AT_TILES);
    LAS unsigned* ctl = (LAS unsigned*)(lds + AT_CTL); LAS float* kms = (LAS float*)(lds + AT_KM);
    const bf16* QA = (const bf16*)(ws + WS_QA); const bf16* KA = (const bf16*)(ws + WS_KA); const bf16* VAT = (const bf16*)(ws + WS_VAT);
    u32x4 sr[8], qst[4];
    const int row0 = tid >> 4, ch = tid & 15;
    const bf16* kbase = KA + (size_t)(b * SEQ + row0) * 1024 + h * 128 + ch * 8;
    const bf16* vbase = VAT + (size_t)(bh * 128 + row0) * 2048 + ch * 8;
#define AT_LOAD(ks0_) do { _Pragma("unroll") for (int i = 0; i < 4; ++i) { \
        sr[i] = *(const u32x4*)(kbase + (size_t)((ks0_) + 32 * i) * 1024); sr[4 + i] = *(const u32x4*)(vbase + (size_t)(32 * i) * 2048 + (ks0_)); } } while (0)
#pragma unroll
    for (int i = 0; i < 4; ++i) qst[i] = *(const u32x4*)(QA + (size_t)(b * SEQ + q0 + row0 + 32 * i) * 1024 + h * 128 + ch * 8);
    AT_LOAD(blk * 256);
    if (tid <= 128) tab[tid] = a->in[I_RELB][rel_bucket_dev(tid) * 8 + h] * 1.4426950408889634f;
    for (int idx = tid; idx < 1024; idx += NTHR) kms[idx] = ((const float*)(ws + MS_KMEAN))[bh * 1024 + idx];
    if (tid == 0) ctl[0] = 0u;
    __syncthreads();
    {
        const int q = tid >> 2, part = tid & 3;
        const bf16* qp = QA + (size_t)(b * SEQ + q0 + q) * 1024 + h * 128 + part * 32;
        float qf32[32];
#pragma unroll
        for (int i = 0; i < 4; ++i) { const u32x4 v = *(const u32x4*)(qp + 8 * i);
            qf32[8 * i + 0] = bflo(v.x); qf32[8 * i + 1] = bfhi(v.x); qf32[8 * i + 2] = bflo(v.y); qf32[8 * i + 3] = bfhi(v.y);
            qf32[8 * i + 4] = bflo(v.z); qf32[8 * i + 5] = bfhi(v.z); qf32[8 * i + 6] = bflo(v.w); qf32[8 * i + 7] = bfhi(v.w); }
        float gate[8];
#pragma unroll
        for (int n = 0; n < 8; ++n) { float s = 0.f;
            if (n < blk) {
#pragma unroll
                for (int d = 0; d < 32; d += 4) { const f32x4 kv = *(const LAS f32x4*)(kms + n * 128 + part * 32 + d);
                    s += (qf32[d] * kv.x + qf32[d + 1] * kv.y) + (qf32[d + 2] * kv.z + qf32[d + 3] * kv.w); }
            }
            s += __shfl_xor(s, 1); s += __shfl_xor(s, 2); gate[n] = s; }
        if (part == 0) {
            unsigned sel;
            if (blk <= 3) sel = (1u << blk) - 1u;
            else { sel = 0u;
#pragma unroll
                for (int it = 0; it < 3; ++it) { int best = 0; float bv = -3.0e38f;
#pragma unroll
                    for (int n = 0; n < 8; ++n) if (n < blk && !((sel >> n) & 1u) && gate[n] > bv) { bv = gate[n]; best = n; }
                    sel |= 1u << best; } }
            sels[q] = sel; atomicOr((unsigned*)ctl, sel);
        }
    }
    __syncthreads();
    if (tid == 0) { int nt = 0; const unsigned any = ctl[0];
        for (int j = 0; j < half + 1; ++j) tiles[nt++] = blk * 256 + 128 * j;
        for (int n = 0; n < blk; ++n) if ((any >> n) & 1u) for (int j = 0; j < 2; ++j) tiles[nt++] = n * 256 + 128 * j;
        ctl[1] = (unsigned)nt; }
    __syncthreads();
    const int ntiles = (int)ctl[1];
    const int qg = wave & 3, kp = wave >> 2;
    int qpos[2]; unsigned mysel[2];
#pragma unroll
    for (int f = 0; f < 2; ++f) { qpos[f] = q0 + 32 * qg + 16 * f + q16; mysel[f] = sels[32 * qg + 16 * f + q16]; }
    constexpr int AT_Q = 77824;
#pragma unroll
    for (int i = 0; i < 4; ++i) *(LAS u32x4*)(lds + AT_Q + (row0 + 32 * i) * 272 + ch * 16) = qst[i];
    const LAS unsigned char* qrow = lds + AT_Q + (32 * qg + q16) * 272 + 16 * g;
    float m_run[2] = {-1.0e30f, -1.0e30f}, l_run[2] = {0.f, 0.f};
    f32x4 oacc[2][8];
#pragma unroll
    for (int f = 0; f < 2; ++f)
#pragma unroll
        for (int m = 0; m < 8; ++m) oacc[f][m] = (f32x4){0.f, 0.f, 0.f, 0.f};
    const int vpos = (ch >> 2) * 32 + 16 * (ch & 1) + 4 * ((ch & 3) >> 1);
#define AT_WRITE() do { _Pragma("unroll") for (int i = 0; i < 4; ++i) { \
        *(LAS u32x4*)(lds + AT_KT + (row0 + 32 * i) * 272 + ch * 16) = sr[i]; \
        *(LAS u32x2*)(lds + AT_VT + (row0 + 32 * i) * 272 + vpos * 2) = (u32x2){sr[4 + i].x, sr[4 + i].y}; \
        *(LAS u32x2*)(lds + AT_VT + (row0 + 32 * i) * 272 + (vpos + 8) * 2) = (u32x2){sr[4 + i].z, sr[4 + i].w}; } } while (0)
    AT_WRITE();
    __syncthreads();
    if (ntiles > 1) { const int k1 = tiles[1]; AT_LOAD(k1); }
    for (int ti = 0; ti < ntiles; ++ti) {
        const int kstart = tiles[ti] + 64 * kp, nblk = kstart >> 8;
        const bool own = (nblk == blk);
        const bool any_ok = own ? true : (__any((((mysel[0] | mysel[1]) >> nblk) & 1u) != 0u) != 0);
        const bool active = own ? (kstart <= q0 + 32 * qg + 31) : any_ok;
        if (active) {
            const LAS unsigned char* kt = lds + AT_KT + 64 * kp * 272; const LAS unsigned char* vt = lds + AT_VT + 64 * kp * 2;
            f32x4 s[2][4];
#pragma unroll
            for (int n = 0; n < 4; ++n) { s[0][n] = (f32x4){0.f, 0.f, 0.f, 0.f}; s[1][n] = s[0][n]; }
#pragma unroll
            for (int ks = 0; ks < 4; ++ks) {
                bf16x8 q0f = *(const LAS bf16x8*)(qrow + 64 * ks), q1f = *(const LAS bf16x8*)(qrow + 16 * 272 + 64 * ks);
                bf16x8 kf[4];
#pragma unroll
                for (int n = 0; n < 4; ++n) kf[n] = *(const LAS bf16x8*)(kt + (16 * n + q16) * 272 + (32 * ks + 8 * g) * 2);
                asm volatile("" : "+v"(q0f), "+v"(q1f), "+v"(kf[0]), "+v"(kf[1]), "+v"(kf[2]), "+v"(kf[3]));
#pragma unroll
                for (int n = 0; n < 4; ++n) {
                    s[0][n] = __builtin_amdgcn_mfma_f32_16x16x32_bf16(kf[n], q0f, s[0][n], 0, 0, 0);
                    s[1][n] = __builtin_amdgcn_mfma_f32_16x16x32_bf16(kf[n], q1f, s[1][n], 0, 0, 0); } }
            const bool far = ((q0 + 32 * qg) - (kstart + 63)) >= 128;
            const float bfar = tab[128];
            float alpha[2];
#pragma unroll
            for (int f = 0; f < 2; ++f) {
                const bool lane_ok = own ? true : (((mysel[f] >> nblk) & 1u) != 0u);
                const int kmax = lane_ok ? (own ? qpos[f] : 0x7fffffff) : -1;
                float mx = -1.0e30f;
                float bs[4][4];
                if (far) {
#pragma unroll
                    for (int n = 0; n < 4; ++n)
#pragma unroll
                        for (int r = 0; r < 4; ++r) bs[n][r] = bfar;
                } else {
#pragma unroll
                    for (int n = 0; n < 4; ++n)
#pragma unroll
                        for (int r = 0; r < 4; ++r) { int di = qpos[f] - (kstart + 16 * n + 4 * g + r); di = di < 0 ? 0 : di; di = di > 128 ? 128 : di; bs[n][r] = tab[di]; }
                }
#pragma unroll
                for (int n = 0; n < 4; ++n) asm volatile("" : "+v"(bs[n][0]), "+v"(bs[n][1]), "+v"(bs[n][2]), "+v"(bs[n][3]));
#pragma unroll
                for (int n = 0; n < 4; ++n)
#pragma unroll
                    for (int r = 0; r < 4; ++r) { const int key = kstart + 16 * n + 4 * g + r;
                        const float v = (key <= kmax) ? s[f][n][r] + bs[n][r] : -1.0e30f;
                        s[f][n][r] = v; mx = fmaxf(mx, v); }
                mx = rows4_max(mx);
                const float m_new = fmaxf(fmaxf(m_run[f], mx), -1.0e29f);
                alpha[f] = __builtin_amdgcn_exp2f(m_run[f] - m_new);
                float psum = 0.f;
#pragma unroll
                for (int n = 0; n < 4; ++n)
#pragma unroll
                    for (int r = 0; r < 4; ++r) { const float p = __builtin_amdgcn_exp2f(s[f][n][r] - m_new); s[f][n][r] = p; psum += p; }
                psum = rows4_sum(psum);
                l_run[f] = l_run[f] * alpha[f] + psum; m_run[f] = m_new;
#pragma unroll
                for (int m = 0; m < 8; ++m) oacc[f][m] = oacc[f][m] * alpha[f];
            }
#pragma unroll
            for (int k2 = 0; k2 < 2; ++k2) {
                bf16x8 pf[2];
#pragma unroll
                for (int f = 0; f < 2; ++f) { u32x4 pb; pb.x = cvt_pk_bf16(s[f][2 * k2][0], s[f][2 * k2][1]); pb.y = cvt_pk_bf16(s[f][2 * k2][2], s[f][2 * k2][3]);
                    pb.z = cvt_pk_bf16(s[f][2 * k2 + 1][0], s[f][2 * k2 + 1][1]); pb.w = cvt_pk_bf16(s[f][2 * k2 + 1][2], s[f][2 * k2 + 1][3]);
                    pf[f] = __builtin_bit_cast(bf16x8, pb); }
#pragma unroll
                for (int mh = 0; mh < 2; ++mh) {
                    bf16x8 af[4];
#pragma unroll
                    for (int m = 0; m < 4; ++m) af[m] = *(const LAS bf16x8*)(vt + (16 * (4 * mh + m) + q16) * 272 + (32 * k2 + 8 * g) * 2);
                    asm volatile("" : "+v"(af[0]), "+v"(af[1]), "+v"(af[2]), "+v"(af[3]));
#pragma unroll
                    for (int m = 0; m < 4; ++m) {
                        oacc[0][4 * mh + m] = __builtin_amdgcn_mfma_f32_16x16x32_bf16(af[m], pf[0], oacc[0][4 * mh + m], 0, 0, 0);
                        oacc[1][4 * mh + m] = __builtin_amdgcn_mfma_f32_16x16x32_bf16(af[m], pf[1], oacc[1][4 * mh + m], 0, 0, 0); } }
            }
        }
        __syncthreads();
        if (ti + 1 < ntiles) { AT_WRITE(); }
        __syncthreads();
        if (ti + 2 < ntiles) { const int kn = tiles[ti + 2]; AT_LOAD(kn); }
    }
    LAS float* mo = (LAS float*)lds; LAS float* ml = (LAS float*)(lds + 65536);
    if (kp == 1) {
#pragma unroll
        for (int f = 0; f < 2; ++f) {
#pragma unroll
            for (int m = 0; m < 8; ++m)
#pragma unroll
                for (int r = 0; r < 4; ++r) mo[((qg * 2 + f) * 8 + m) * 256 + r * 64 + lane] = oacc[f][m][r];
            ml[(qg * 2 + f) * 128 + lane] = m_run[f]; ml[(qg * 2 + f) * 128 + 64 + lane] = l_run[f]; }
    }
    __syncthreads();
    if (kp == 0) {
#pragma unroll
        for (int f = 0; f < 2; ++f) {
            const float m1 = ml[(qg * 2 + f) * 128 + lane], l1 = ml[(qg * 2 + f) * 128 + 64 + lane];
            const float mm = fmaxf(m_run[f], m1), a0 = __builtin_amdgcn_exp2f(m_run[f] - mm), a1 = __builtin_amdgcn_exp2f(m1 - mm);
            const float inv = __builtin_amdgcn_rcpf(l_run[f] * a0 + l1 * a1);
            bf16* HA = (bf16*)(ws + WS_HA) + (size_t)(b * SEQ + qpos[f]) * 1024 + h * 128 + 4 * g;
#pragma unroll
            for (int m = 0; m < 8; ++m) { float o[4];
#pragma unroll
                for (int r = 0; r < 4; ++r) o[r] = (oacc[f][m][r] * a0 + mo[((qg * 2 + f) * 8 + m) * 256 + r * 64 + lane] * a1) * inv;
                u32x2 w; w.x = cvt_pk_bf16(o[0], o[1]); w.y = cvt_pk_bf16(o[2], o[3]); *(u32x2*)(HA + 16 * m) = w; }
        }
    }
#undef AT_LOAD
#undef AT_WRITE
}

constexpr int MC_Q = 0, MC_K = 33792, MC_SP = 67584, MC_SC = 76800, MC_NV = 79104;
__device__ __forceinline__ void mlstm_c_unit(ArgsP a, int l, LAS unsigned char* lds, int u, int tid, int lane, int wave) {
    unsigned char* ws = a->ws;
    const int bh = u >> 5, c = u & 31, b = bh >> 2, h = bh & 3, t0 = 64 * c, q16 = lane & 15, g = lane >> 4;
    const size_t tok0 = (size_t)b * SEQ + t0;
    LAS unsigned char* Qs = lds + MC_Q; LAS unsigned char* Ks = lds + MC_K; LAS unsigned char* Sp = lds + MC_SP;
    LAS float* sc = (LAS float*)(lds + MC_SC); LAS float* as_ = sc; LAS float* gt_ = sc + 64; LAS float* wi_ = sc + 128; LAS float* cl_ = sc + 192; LAS float* qn_ = sc + 256; LAS float* denp = sc + 320;
    LAS float* nvec = (LAS float*)(lds + MC_NV);
    const bf16* QM = (const bf16*)(ws + WS_QM); const bf16* KM = (const bf16*)(ws + WS_KM);
    u32x4 qr[4], kr[4];
#pragma unroll
    for (int i = 0; i < 4; ++i) { const int idx = tid + NTHR * i, row = idx >> 5, ch = idx & 31;
        qr[i] = *(const u32x4*)(QM + (tok0 + row) * 1024 + h * 256 + ch * 8); kr[i] = *(const u32x4*)(KM + (tok0 + row) * 1024 + h * 256 + ch * 8); }
    float sc4[4] = {0.f, 0.f, 0.f, 0.f}; float nv0 = 0.f;
    if (tid < 64) { const int s = bh * 2048 + t0 + tid; sc4[0] = ((const float*)(ws + MS_AS))[s]; sc4[1] = ((const float*)(ws + MS_GT))[s];
        sc4[2] = ((const float*)(ws + MS_WI))[s]; sc4[3] = ((const float*)(ws + MS_CL))[s]; }
    if (tid < 256) nv0 = ((const float*)(ws + MS_NVEC))[(size_t)(bh * 32 + c) * 256 + tid];
    bf16x8 cb[8][2], vbf[2][2];
    {
        const bf16* Cp = (const bf16*)(ws + WS_CST) + (size_t)(bh * 32 + c) * 65536 + (size_t)(2 * wave) * 512 + lane * 8;
        if (c > 0) {
#pragma unroll
            for (int ks = 0; ks < 8; ++ks) { cb[ks][0] = *(const bf16x8*)(Cp + ks * 8192); cb[ks][1] = *(const bf16x8*)(Cp + ks * 8192 + 512); }
        }
    }
#pragma unroll
    for (int i = 0; i < 4; ++i) { const int idx = tid + NTHR * i, row = idx >> 5, ch = idx & 31;
        *(LAS u32x4*)(Qs + row * 528 + ch * 16) = qr[i]; *(LAS u32x4*)(Ks + row * 528 + ch * 16) = kr[i]; }
    {
        const bf16* Vp = (const bf16*)(ws + WS_VMT) + (size_t)(bh * 32 + c) * 16384 + (size_t)(2 * wave) * 512 + lane * 8;
#pragma unroll
        for (int ks = 0; ks < 2; ++ks) { vbf[ks][0] = *(const bf16x8*)(Vp + ks * 8192); vbf[ks][1] = *(const bf16x8*)(Vp + ks * 8192 + 512); }
    }
    if (tid < 64) { as_[tid] = sc4[0]; gt_[tid] = sc4[1]; wi_[tid] = sc4[2]; cl_[tid] = sc4[3]; }
    if (tid < 256) nvec[tid] = nv0;
    __syncthreads();
    f32x4 acc[4][2];
#pragma unroll
    for (int m = 0; m < 4; ++m) { acc[m][0] = (f32x4){0.f, 0.f, 0.f, 0.f}; acc[m][1] = acc[m][0]; }
    if (c > 0) {
#pragma unroll
        for (int ks = 0; ks < 8; ++ks) {
#pragma unroll
            for (int m = 0; m < 4; ++m) { const bf16x8 af = *(const LAS bf16x8*)(Qs + (16 * m + q16) * 528 + (32 * ks + 8 * g) * 2);
                acc[m][0] = __builtin_amdgcn_mfma_f32_16x16x32_bf16(af, cb[ks][0], acc[m][0], 0, 0, 0);
                acc[m][1] = __builtin_amdgcn_mfma_f32_16x16x32_bf16(af, cb[ks][1], acc[m][1], 0, 0, 0); }
        }
#pragma unroll
        for (int m = 0; m < 4; ++m)
#pragma unroll
            for (int r = 0; r < 4; ++r) { const float w = wi_[16 * m + 4 * g + r]; acc[m][0][r] *= w; acc[m][1][r] *= w; }
    }
    {
        const int mS = wave & 3, nS0 = 2 * (wave >> 2);
        f32x4 sacc[2]; sacc[0] = (f32x4){0.f, 0.f, 0.f, 0.f}; sacc[1] = sacc[0];
#pragma unroll
        for (int kh = 0; kh < 4; ++kh) {
            bf16x8 af[2], bq[2][2];
#pragma unroll
            for (int k2 = 0; k2 < 2; ++k2) { const int ks = 2 * kh + k2;
                af[k2] = *(const LAS bf16x8*)(Qs + (16 * mS + q16) * 528 + (32 * ks + 8 * g) * 2);
#pragma unroll
                for (int nn = 0; nn < 2; ++nn) bq[k2][nn] = *(const LAS bf16x8*)(Ks + (16 * (nS0 + nn) + q16) * 528 + (32 * ks + 8 * g) * 2); }
            asm volatile("" : "+v"(af[0]), "+v"(af[1]), "+v"(bq[0][0]), "+v"(bq[0][1]), "+v"(bq[1][0]), "+v"(bq[1][1]));
#pragma unroll
            for (int k2 = 0; k2 < 2; ++k2)
#pragma unroll
                for (int nn = 0; nn < 2; ++nn) sacc[nn] = __builtin_amdgcn_mfma_f32_16x16x32_bf16(af[k2], bq[k2][nn], sacc[nn], 0, 0, 0);
        }
#pragma unroll
        for (int nn = 0; nn < 2; ++nn) { const int s = 16 * (nS0 + nn) + q16; const float av = as_[s];
#pragma unroll
            for (int r = 0; r < 4; ++r) { const int t = 16 * mS + 4 * g + r;
                float val = (s <= t) ? sacc[nn][r] * __expf(av - gt_[t]) : 0.f;
                *(LAS unsigned short*)(Sp + t * 144 + s * 2) = (unsigned short)(cvt_pk_bf16(val, val) & 0xffffu);
                val += __shfl_xor(val, 1); val += __shfl_xor(val, 2); val += __shfl_xor(val, 4); val += __shfl_xor(val, 8);
                if (q16 == 0) denp[(nS0 + nn) * 64 + t] = val; } }
    }
    {
        const int t = tid >> 3, seg = tid & 7; float s = 0.f;
#pragma unroll
        for (int i = 0; i < 4; ++i) { const u32x4 v = *(const LAS u32x4*)(Qs + t * 528 + (seg * 32 + 8 * i) * 2); const LAS float* nv = nvec + seg * 32 + 8 * i;
            s += bflo(v.x) * nv[0] + bfhi(v.x) * nv[1] + bflo(v.y) * nv[2] + bfhi(v.y) * nv[3] + bflo(v.z) * nv[4] + bfhi(v.z) * nv[5] + bflo(v.w) * nv[6] + bfhi(v.w) * nv[7]; }
        s += __shfl_xor(s, 1); s += __shfl_xor(s, 2); s += __shfl_xor(s, 4);
        if (seg == 0) qn_[t] = s;
    }
    __syncthreads();
    {
#pragma unroll
        for (int ks = 0; ks < 2; ++ks) {
            bf16x8 sf[4];
#pragma unroll
            for (int m = 0; m < 4; ++m) sf[m] = *(const LAS bf16x8*)(Sp + (16 * m + q16) * 144 + (32 * ks + 8 * g) * 2);
            asm volatile("" : "+v"(sf[0]), "+v"(sf[1]), "+v"(sf[2]), "+v"(sf[3]));
#pragma unroll
            for (int m = 0; m < 4; ++m) {
                acc[m][0] = __builtin_amdgcn_mfma_f32_16x16x32_bf16(sf[m], vbf[ks][0], acc[m][0], 0, 0, 0);
                acc[m][1] = __builtin_amdgcn_mfma_f32_16x16x32_bf16(sf[m], vbf[ks][1], acc[m][1], 0, 0, 0); }
        }
    }
    LAS float* NUM = (LAS float*)lds;
#pragma unroll
    for (int m = 0; m < 4; ++m)
#pragma unroll
        for (int r = 0; r < 4; ++r) { const int t = 16 * m + 4 * g + r;
            const float den = (denp[t] + denp[64 + t]) + (denp[128 + t] + denp[192 + t]) + wi_[t] * qn_[t];
            const float inv = __builtin_amdgcn_rcpf(fmaxf(fabsf(den), cl_[t]));
            NUM[t * 260 + 32 * wave + q16] = acc[m][0][r] * inv; NUM[t * 260 + 32 * wave + 16 + q16] = acc[m][1][r] * inv; }
    __syncthreads();
    {
        const float* mg = a->in[I_MNG] + l * 1024 + h * 256 + 4 * lane; const f32x4 gn = *(const f32x4*)mg;
        const bf16* OM = (const bf16*)(ws + WS_OM); bf16* HM = (bf16*)(ws + WS_HM);
        u32x2 ovv[8];
#pragma unroll
        for (int i = 0; i < 8; ++i) ovv[i] = *(const u32x2*)(OM + (tok0 + 8 * wave + i) * 1024 + h * 256 + 4 * lane);
        asm volatile("" : "+v"(ovv[0]), "+v"(ovv[1]), "+v"(ovv[2]), "+v"(ovv[3]), "+v"(ovv[4]), "+v"(ovv[5]), "+v"(ovv[6]), "+v"(ovv[7]));
#pragma unroll
        for (int i = 0; i < 8; ++i) { const int t = 8 * wave + i;
            const f32x4 v = *(const LAS f32x4*)(NUM + t * 260 + 4 * lane);
            const float mu = wave_sum((v.x + v.y) + (v.z + v.w)) * (1.0f / 256.0f);
            const f32x4 d = v - mu;
            const float var = wave_sum((d.x * d.x + d.y * d.y) + (d.z * d.z + d.w * d.w)) * (1.0f / 256.0f);
            const float rstd = __builtin_amdgcn_rsqf(var + LN_EPS);
            const u32x2 ov = ovv[i];
            u32x2 w; w.x = cvt_pk_bf16(d.x * rstd * gn.x * bflo(ov.x), d.y * rstd * gn.y * bfhi(ov.x)); w.y = cvt_pk_bf16(d.z * rstd * gn.z * bflo(ov.y), d.w * rstd * gn.w * bfhi(ov.y));
            *(u32x2*)(HM + (tok0 + t) * 1024 + h * 256 + 4 * lane) = w; }
    }
    __syncthreads();
}

struct SchedStd {
    static constexpr bool GATHER = false;
    const char* A; const char* B; int nM, nN, K, G, c;
    __device__ __forceinline__ bool next(int i, Unit& u) const { const int L = i * G + c; if (L >= nM * nN) return false; pg8::static_tile(L, nM, nN, u.pm, u.pn); u.aux = 0; return true; }
    __device__ __forceinline__ const char* abase(const Unit& u) const { return A + (size_t)u.pm * 512 * K; }
    __device__ __forceinline__ const char* bbase(const Unit& u) const { return B + (size_t)u.pn * 512 * K; }
    __device__ __forceinline__ unsigned arow(const Unit&, int) const { return 0u; }
    static __device__ __forceinline__ bool keep_acc(const Unit&) { return false; }
};
struct SchedBr {
    static constexpr bool GATHER = false;
    const char* HM; const char* HA; const char* WM; const char* WA; int G, c;
    __device__ __forceinline__ bool next(int i, Unit& u) const { const int L = (i >> 1) * G + c; if (L >= 256) return false; pg8::static_tile(L, 32, 8, u.pm, u.pn); u.aux = i & 1; return true; }
    __device__ __forceinline__ const char* abase(const Unit& u) const { return (u.aux ? HA : HM) + (size_t)u.pm * 512 * 1024; }
    __device__ __forceinline__ const char* bbase(const Unit& u) const { return (u.aux ? WA : WM) + (size_t)u.pn * 512 * 1024; }
    __device__ __forceinline__ unsigned arow(const Unit&, int) const { return 0u; }
    static __device__ __forceinline__ bool keep_acc(const Unit& u) { return u.aux == 0; }
};
struct EpiBr {
    static constexpr bool PERM = true;
    const bf16* SG; bf16* Y;
    __device__ __forceinline__ void operator()(f32x4 (&acc)[2][2][4][2], const Unit& u, int wr, int wc, int fr, int fq) const {
        const int row0 = u.pm * 256 + wr * 64 + fr, col0 = u.pn * 256 + wc * 32 + 8 * fq;
#pragma unroll
        for (int ai = 0; ai < 2; ++ai) {
            u32x4 sa[4][2], sm[4][2];
#pragma unroll
            for (int m = 0; m < 4; ++m) { const size_t row = row0 + ai * 128 + m * 16;
#pragma unroll
                for (int bj = 0; bj < 2; ++bj) { const int col = col0 + bj * 128;
                    sa[m][bj] = *(const u32x4*)(SG + row * 4096 + 2048 + col);
                    sm[m][bj] = *(const u32x4*)(SG + row * 4096 + (u.aux == 0 ? 0 : 2048) + col); } }
            asm volatile("" : "+v"(sa[0][0]), "+v"(sa[0][1]), "+v"(sa[1][0]), "+v"(sa[1][1]), "+v"(sa[2][0]), "+v"(sa[2][1]), "+v"(sa[3][0]), "+v"(sa[3][1]),
                              "+v"(sm[0][0]), "+v"(sm[0][1]), "+v"(sm[1][0]), "+v"(sm[1][1]), "+v"(sm[2][0]), "+v"(sm[2][1]), "+v"(sm[3][0]), "+v"(sm[3][1]));
#pragma unroll
            for (int m = 0; m < 4; ++m) { const size_t row = row0 + ai * 128 + m * 16;
#pragma unroll
                for (int bj = 0; bj < 2; ++bj) { const int col = col0 + bj * 128;
                    const u32x4 a4 = sa[m][bj], m4 = sm[m][bj];
                    const float ga[8] = {bflo(a4.x), bfhi(a4.x), bflo(a4.y), bfhi(a4.y), bflo(a4.z), bfhi(a4.z), bflo(a4.w), bfhi(a4.w)};
                    if (u.aux == 0) {
                        const float gm[8] = {bflo(m4.x), bfhi(m4.x), bflo(m4.y), bfhi(m4.y), bflo(m4.z), bfhi(m4.z), bflo(m4.w), bfhi(m4.w)};
#pragma unroll
                        for (int j = 0; j < 4; ++j) { acc[ai][bj][m][0][j] *= gm[j] * __builtin_amdgcn_rcpf(fmaxf(ga[j], 1.0e-30f)); acc[ai][bj][m][1][j] *= gm[4 + j] * __builtin_amdgcn_rcpf(fmaxf(ga[4 + j], 1.0e-30f)); }
                    } else {
                        const f32x4 v0 = acc[ai][bj][m][0], v1 = acc[ai][bj][m][1];
                        u32x4 w; w.x = cvt_pk_bf16(v0[0] * ga[0], v0[1] * ga[1]); w.y = cvt_pk_bf16(v0[2] * ga[2], v0[3] * ga[3]);
                        w.z = cvt_pk_bf16(v1[0] * ga[4], v1[1] * ga[5]); w.w = cvt_pk_bf16(v1[2] * ga[6], v1[3] * ga[7]);
                        *(u32x4*)(Y + row * 2048 + col) = w; }
                } }
        }
    }
};
struct EpiOut {
    static constexpr bool PERM = false;
    const float* res; float* out;
    __device__ __forceinline__ void operator()(f32x4 (&acc)[2][2][4][2], const Unit& u, int wr, int wc, int fr, int fq) const {
        const int row0 = u.pm * 256 + wr * 64 + fr, col0 = u.pn * 256 + wc * 32 + 4 * fq;
#pragma unroll
        for (int ai = 0; ai < 2; ++ai) {
            f32x4 rv[4][2][2];
#pragma unroll
            for (int m = 0; m < 4; ++m) { const size_t ro = (size_t)(row0 + ai * 128 + m * 16) * DM + col0;
#pragma unroll
                for (int bj = 0; bj < 2; ++bj)
#pragma unroll
                    for (int n = 0; n < 2; ++n) rv[m][bj][n] = *(const f32x4*)(res + ro + bj * 128 + n * 16); }
#pragma unroll
            for (int m = 0; m < 4; ++m) asm volatile("" : "+v"(rv[m][0][0]), "+v"(rv[m][0][1]), "+v"(rv[m][1][0]), "+v"(rv[m][1][1]));
#pragma unroll
            for (int m = 0; m < 4; ++m) { const size_t ro = (size_t)(row0 + ai * 128 + m * 16) * DM + col0;
#pragma unroll
                for (int bj = 0; bj < 2; ++bj)
#pragma unroll
                    for (int n = 0; n < 2; ++n) *(f32x4*)(out + ro + bj * 128 + n * 16) = rv[m][bj][n] + acc[ai][bj][m][n]; }
        }
    }
};
struct SchedMoe1 {
    static constexpr bool GATHER = true;
    const char* H; const char* W13; const int* LIST; const LAS int* te; const LAS int* tr0; const LAS int* cnt; int MT, G, c;
    __device__ __forceinline__ bool next(int i, Unit& u) const { const int L = i * G + c; if (L >= 2 * MT) return false; u.pm = L >> 1; u.pn = L & 1; u.aux = __builtin_amdgcn_readfirstlane(te[u.pm]); return true; }
    __device__ __forceinline__ const char* abase(const Unit&) const { return H; }
    __device__ __forceinline__ const char* bbase(const Unit& u) const { return W13 + ((size_t)u.aux * 512 + u.pn * 256) * 4096; }
    static __device__ __forceinline__ bool keep_acc(const Unit&) { return false; }
    __device__ __forceinline__ unsigned arow(const Unit& u, int r) const { const int rr = __builtin_amdgcn_readfirstlane(tr0[u.pm]) + r; return rr < __builtin_amdgcn_readfirstlane(cnt[u.aux]) ? (unsigned)LIST[u.aux * 8192 + rr] : 0u; }
};
struct EpiMoe1 {
    static constexpr bool PERM = true;
    bf16* HID; const float* PWL; const LAS int* tr0; const LAS int* cnt;
    __device__ __forceinline__ void operator()(f32x4 (&acc)[2][2][4][2], const Unit& u, int wr, int wc, int fr, int fq) const {
#pragma unroll
        for (int ai = 0; ai < 2; ++ai)
#pragma unroll
            for (int m = 0; m < 4; ++m) { const int r = ai * 128 + wr * 64 + m * 16 + fr;
                const float pw = 1.0f;
                float o[8];
#pragma unroll
                for (int n = 0; n < 2; ++n)
#pragma unroll
                    for (int j = 0; j < 4; ++j) { const float x1 = acc[ai][0][m][n][j], x3 = acc[ai][1][m][n][j]; o[4 * n + j] = x1 * sigmoidf_(x1) * x3 * pw; }
                u32x4 w; w.x = cvt_pk_bf16(o[0], o[1]); w.y = cvt_pk_bf16(o[2], o[3]); w.z = cvt_pk_bf16(o[4], o[5]); w.w = cvt_pk_bf16(o[6], o[7]);
                *(u32x4*)(HID + (size_t)(u.pm * 256 + r) * 256 + u.pn * 128 + wc * 32 + 8 * fq) = w; }
    }
};
struct SchedMoe2 {
    static constexpr bool GATHER = false;
    const char* HID; const char* W2; const LAS int* te; int MT, G, c;
    __device__ __forceinline__ bool next(int i, Unit& u) const { const int L = i * G + c; if (L >= 8 * MT) return false; u.pm = L >> 3; u.pn = L & 7; u.aux = __builtin_amdgcn_readfirstlane(te[u.pm]); return true; }
    __device__ __forceinline__ const char* abase(const Unit& u) const { return HID + (size_t)u.pm * 256 * 512; }
    __device__ __forceinline__ const char* bbase(const Unit& u) const { return W2 + ((size_t)u.aux * 2048 + u.pn * 256) * 512; }
    __device__ __forceinline__ unsigned arow(const Unit&, int) const { return 0u; }
    static __device__ __forceinline__ bool keep_acc(const Unit&) { return false; }
};
struct EpiMoe2 {
    static constexpr bool PERM = true;
    bf16* OP;
    __device__ __forceinline__ void operator()(f32x4 (&acc)[2][2][4][2], const Unit& u, int wr, int wc, int fr, int fq) const {
        const int row0 = u.pm * 256 + wr * 64 + fr, col0 = u.pn * 256 + wc * 32 + 8 * fq;
#pragma unroll
        for (int ai = 0; ai < 2; ++ai)
#pragma unroll
            for (int m = 0; m < 4; ++m) { bf16* rowp = OP + (size_t)(row0 + ai * 128 + m * 16) * DM + col0;
#pragma unroll
                for (int bj = 0; bj < 2; ++bj) { const f32x4 v0 = acc[ai][bj][m][0], v1 = acc[ai][bj][m][1];
                    u32x4 w; w.x = cvt_pk_bf16(v0[0], v0[1]); w.y = cvt_pk_bf16(v0[2], v0[3]); w.z = cvt_pk_bf16(v1[0], v1[1]); w.w = cvt_pk_bf16(v1[2], v1[3]);
                    *(u32x4*)(rowp + bj * 128) = w; } }
    }
};

constexpr int N_PHASES = 22;
__global__ void __launch_bounds__(NTHR, 2) fwd_kernel(Args a) {
    extern __shared__ __attribute__((aligned(16))) unsigned char lds_raw[];
    LAS unsigned char* lds0 = (LAS unsigned char*)lds_raw;
    const int tid0 = threadIdx.x, bid0 = blockIdx.x, G0 = gridDim.x;
    const int wave0 = __builtin_amdgcn_readfirstlane(tid0 >> 6);
#define PH_IDS() ArgsP ap = (ArgsP)__builtin_amdgcn_kernarg_segment_ptr(); asm volatile("" : "+s"(ap)); unsigned lb_ = 0u; asm volatile("" : "+s"(lb_)); LAS unsigned char* lds = lds0 + lb_; LAS unsigned char* misc = lds + MISC_OFF; (void)misc; unsigned char* ws = ap->ws; (void)ws; int bid = bid0, G = G0, wave = wave0; asm volatile("" : "+s"(bid), "+s"(G), "+s"(wave)); int tid = wave * 64 + lane_id(); asm volatile("" : "+v"(tid)); const int lane = tid & 63; (void)lane; (void)wave
    if (tid0 < 4) ((LAS unsigned*)(lds0 + MISC_OFF + MO_BAR))[tid0] = 0u;
    __syncthreads();
#if MK_LAUNCHES == 1
    XcdBarrier bar = xcd_barrier_post((unsigned*)(a.ws + WS_CTL) + CW_BAR, (volatile LAS unsigned*)(lds0 + MISC_OFF + MO_BAR));
#define GRID_BAR() xcd_barrier(bar)
#else
#define GRID_BAR() do { } while (0)
#endif
    const int lo = a.ph_lo, hi = a.ph_hi;
#ifndef PHMASK
#define PHMASK 0xFFFu
#endif
#define IN(k) (lo <= (k) && (k) < hi)
#define EN(b) ((PHMASK >> (b)) & 1u)
#ifndef DBLMASK
#define DBLMASK 0u
#endif
#define REP(b) _Pragma("unroll 1") for (int rep_ = 0; rep_ < (((DBLMASK >> (b)) & 1u) ? 2 : 1); ++rep_)
#define SEAM(k) do { if (IN(k) && IN((k) + 1)) { GRID_BAR(); if ((DBLMASK >> 12) & 1u) GRID_BAR(); } } while (0)

    if (EN(0) && IN(0)) { REP(0) { PH_IDS(); prologue_phase(ap, lds, tid, lane, wave, bid, G); __syncthreads(); }
#ifndef NO_NORM0
        { PH_IDS(); norm_phase<0>(ap, 0, lds, tid, lane, wave, bid, G); }
#endif
    }
    SEAM(0);
#pragma unroll 1
    for (int l = 0; l < 2; ++l) {
        const int pb = 1 + 10 * l;
        if (EN(1) && IN(pb + 0) && l == 1) { if ((DBLMASK >> 18) & 1u) { PH_IDS(); norm_phase<1>(ap, l, lds, tid, lane, wave, bid, G, true); } PH_IDS(); norm_phase<1>(ap, l, lds, tid, lane, wave, bid, G); }
        if (l == 1) SEAM(pb + 0);
        if (EN(2) && IN(pb + 1)) REP(2) { PH_IDS(); (void)tid;
#ifdef STAG
            for (int i = 0; i < ((bid >> 3) & 7); ++i) __builtin_amdgcn_s_sleep(STAG);
#endif
            SchedG1 S{(const char*)(ws + WS_H), (const char*)(ws + WS_WINT) + (size_t)l * 11264 * 4096, G, bid};
            EpiG1 E{ws, ((DBLMASK >> 21) & 1u) && rep_ == 1};
            pg8::gemm_phase<EpiG1, SchedG1>(lds, 2048, S, E, wave);
            for (int bh = G - 1 - bid; bh < 16; bh += G) gate_unit(ap, l, lds, bh, tid, tid & 63, wave);
            __syncthreads();
            if (G == 256 && bid >= 256 - SchedG1::NCV) prologue_phase(ap, lds, tid, tid & 63, wave, bid - (256 - SchedG1::NCV), SchedG1::NCV, 2 + l);
            else if (G != 256) prologue_phase(ap, lds, tid, tid & 63, wave, bid, G, 2 + l);
        }
        SEAM(pb + 1);
        if (EN(3) && IN(pb + 2)) REP(3) { PH_IDS(); conv_phase(ap, l, lds, tid, lane, wave, bid, G); }
        SEAM(pb + 2);
        if (EN(4) && IN(pb + 3)) REP(4) { PH_IDS();
            const int vb = (G % 8 == 0) ? (bid & 7) * (G >> 3) + (bid >> 3) : bid;
            REP(13) { for (int gw = vb * NWAVES + wave; gw < 2048; gw += G * NWAVES) mlstm_ab_task(ws, gw, lane, rep_ == 0 || !((DBLMASK >> 15) & 1u)); }
            if (wave == 0 && vb < 64) nscan_task(ws, vb, lane);
            __syncthreads();
            REP(14) { for (int u = vb; u < 512; u += G) { attn_unit(ap, lds, u, tid, lane, wave); __syncthreads(); if (((DBLMASK >> 16) & 1u) && u < 256) GRID_BAR(); } }
        }
        SEAM(pb + 3);
        if (EN(5) && IN(pb + 4)) REP(5) { PH_IDS(); for (int u = bid; u < 512; u += G) { mlstm_c_unit(ap, l, lds, u, tid, lane, wave); if (((DBLMASK >> 17) & 1u) && u < 256) GRID_BAR(); } }
        SEAM(pb + 4);
        if (EN(6) && IN(pb + 5)) REP(6) { PH_IDS(); (void)tid;
            SchedBr S{(const char*)(ws + WS_HM), (const char*)(ws + WS_HA), (const char*)(ws + WS_WBM) + (size_t)l * 2048 * 2048, (const char*)(ws + WS_WBA) + (size_t)l * 2048 * 2048, G, bid};
            EpiBr E{(const bf16*)(ws + WS_SG), (bf16*)(ws + WS_Y)};
            pg8::gemm_phase<EpiBr, SchedBr>(lds, 1024, S, E, wave);
        }
        SEAM(pb + 5);
        if (EN(7) && IN(pb + 6)) _Pragma("unroll 1") for (int rep_ = 0; rep_ < ((((DBLMASK >> 7) & 1u) && l == 0) ? 2 : 1); ++rep_) { PH_IDS(); (void)tid;
            SchedStd S{(const char*)(ws + WS_Y), (const char*)(ws + WS_WOUT) + (size_t)l * 2048 * 4096, 32, 8, 2048, G, bid};
            EpiOut E{l == 0 ? ap->in[I_X] : (const float*)ap->out, ap->out};
            pg8::gemm_phase<EpiOut, SchedStd>(lds, 2048, S, E, wave);
        }
        SEAM(pb + 6);
        if (EN(8) && IN(pb + 7)) { if ((DBLMASK >> 19) & 1u) { PH_IDS(); norm_phase<2>(ap, l, lds, tid, lane, wave, bid, G, true); } PH_IDS(); norm_phase<2>(ap, l, lds, tid, lane, wave, bid, G); }
        SEAM(pb + 7);
        if (EN(9) && IN(pb + 8)) REP(9) { PH_IDS();
            moe_tables(ws, l, misc, tid);
            SchedMoe1 S{(const char*)(ws + WS_H), (const char*)(ws + WS_W13) + (size_t)l * 32 * 512 * 4096, (const int*)(ws + MS_LIST),
                        (const LAS int*)(misc + MO_TE), (const LAS int*)(misc + MO_TR0), (const LAS int*)(misc + MO_CNT), __builtin_amdgcn_readfirstlane(((const LAS int*)(misc + MO_MT))[0]), G, bid};
            EpiMoe1 E{(bf16*)(ws + WS_HID), (const float*)(ws + MS_PWL), (const LAS int*)(misc + MO_TR0), (const LAS int*)(misc + MO_CNT)};
            pg8::gemm_phase<EpiMoe1, SchedMoe1>(lds, 2048, S, E, wave);
            if (bid >= 2 * S.MT) prologue_phase(ap, lds, tid, tid & 63, wave, bid - 2 * S.MT, G - 2 * S.MT, l == 0 ? 1 : 4);
        }
        SEAM(pb + 8);
        if (EN(10) && IN(pb + 9)) REP(10) { PH_IDS();
            moe_tables(ws, l, misc, tid);
#ifdef STAG
            for (int i = 0; i < ((bid >> 3) & 7); ++i) __builtin_amdgcn_s_sleep(STAG);
#endif
            SchedMoe2 S{(const char*)(ws + WS_HID), (const char*)(ws + WS_W2) + (size_t)l * 32 * 2048 * 512, (const LAS int*)(misc + MO_TE), __builtin_amdgcn_readfirstlane(((const LAS int*)(misc + MO_MT))[0]), G, bid};
            EpiMoe2 E{(bf16*)(ws + WS_OP)};
            pg8::gemm_phase<EpiMoe2, SchedMoe2>(lds, 256, S, E, wave);
        }
        SEAM(pb + 9);
    }
    if (EN(11) && IN(21)) { if ((DBLMASK >> 20) & 1u) { PH_IDS(); norm_phase<3>(ap, 1, lds, tid, lane, wave, bid, G, true); } PH_IDS(); norm_phase<3>(ap, 1, lds, tid, lane, wave, bid, G); }
#undef IN
#undef SEAM
}

extern "C" void kernel_launch(void* const* d_in, const int* in_sizes, int n_in, void* d_out, int out_size, void* d_ws, size_t ws_size, hipStream_t stream) {
    static int grid = 0;
    if (grid == 0) {
        if (n_in != 19 || out_size != NTOK * DM || ws_size < WS_END) { fprintf(stderr, "kernel_launch: unexpected shapes (n_in %d out %d ws %zu)\n", n_in, out_size, ws_size); grid = -1; return; }
        int dev = 0, cus = 0, per_cu = 0;
        if (hipGetDevice(&dev) != hipSuccess || hipDeviceGetAttribute(&cus, hipDeviceAttributeMultiprocessorCount, dev) != hipSuccess) { grid = -1; return; }
        if (hipFuncSetAttribute((const void*)fwd_kernel, hipFuncAttributeMaxDynamicSharedMemorySize, LDS_BYTES) != hipSuccess) { fprintf(stderr, "kernel_launch: hipFuncSetAttribute failed\n"); grid = -1; return; }
        if (hipOccupancyMaxActiveBlocksPerMultiprocessor(&per_cu, (const void*)fwd_kernel, NTHR, LDS_BYTES) != hipSuccess || per_cu < 1) { fprintf(stderr, "kernel_launch: occupancy query says %d\n", per_cu); }
        (void)hipGetLastError();
        grid = cus;
        if (grid > 256) grid = 256;
    }
    if (grid < 0) return;
    if (hipMemsetAsync((char*)d_ws + WS_CTL, 0, CTL_ZERO_BYTES, stream) != hipSuccess) return;
    Args a{};
    for (int i = 0; i < 19; ++i) a.in[i] = (const float*)d_in[i];
    a.out = (float*)d_out; a.ws = (unsigned char*)d_ws;
#if MK_LAUNCHES == 1
    a.ph_lo = 0; a.ph_hi = N_PHASES;
    hipLaunchKernelGGL(fwd_kernel, dim3(grid), dim3(NTHR), LDS_BYTES, stream, a);
#else
    for (int p = 0; p < N_PHASES; ++p) { a.ph_lo = p; a.ph_hi = p + 1; hipLaunchKernelGGL(fwd_kernel, dim3(grid), dim3(NTHR), LDS_BYTES, stream, a); }
#endif
}
```

```cpp
#define DBLMASK 0u
#include <hip/hip_runtime.h>
#include <stdint.h>
#include <stdio.h>

#ifndef MK_LAUNCHES
#define MK_LAUNCHES 1
#endif

#define GAS __attribute__((address_space(1)))
#define LAS __attribute__((address_space(3)))
typedef unsigned short bf16;
typedef short bf16x8 __attribute__((ext_vector_type(8)));
typedef short bf16x4 __attribute__((ext_vector_type(4)));
typedef float f32x4 __attribute__((ext_vector_type(4)));
typedef unsigned u32x4 __attribute__((ext_vector_type(4)));
typedef unsigned u32x2 __attribute__((ext_vector_type(2)));

constexpr int NTOK = 8192, DM = 2048, SEQ = 2048, NBATCH = 4;
constexpr int INCOLS = 11272;
constexpr int NWAVES = 8, NTHR = 512;
constexpr float RMS_EPS = 1e-6f, LN_EPS = 1e-5f;
constexpr int MPAD = 24576;

constexpr size_t MiB = 1u << 20;
constexpr size_t WS_CTL = 0, CTL_ZERO_BYTES = 1 * MiB;
constexpr size_t WS_MISC = 1 * MiB;
constexpr size_t MS_WIF = WS_MISC + 0;
constexpr size_t MS_WRT = WS_MISC + 256 * 1024;
constexpr size_t MS_IFG = WS_MISC + 1 * MiB;
constexpr size_t MS_KMEAN = MS_IFG + 256 * 1024;
constexpr size_t MS_AS = WS_MISC + 1536 * 1024;
constexpr size_t MS_GT = MS_AS + 128 * 1024;
constexpr size_t MS_WI = MS_GT + 128 * 1024;
constexpr size_t MS_CL = MS_WI + 128 * 1024;
constexpr size_t MS_WS = MS_CL + 128 * 1024;
constexpr size_t MS_DEC = MS_WS + 128 * 1024;
constexpr size_t MS_NST = WS_MISC + 2560 * 1024;
constexpr size_t MS_TOKE = WS_MISC + 3 * MiB;
constexpr size_t MS_TOKP = MS_TOKE + 64 * 1024;
constexpr size_t MS_TOKW = MS_TOKE + 128 * 1024;
constexpr size_t MS_LIST = WS_MISC + 4 * MiB;
constexpr size_t MS_PWL = WS_MISC + 5 * MiB;
constexpr size_t MS_NVEC = WS_MISC + 6 * MiB;
constexpr size_t WS_WINT = 16 * MiB;
constexpr size_t WS_WBM = 104 * MiB;
constexpr size_t WS_WBA = 112 * MiB;
constexpr size_t WS_WOUT = 120 * MiB;
constexpr size_t WS_W13 = 136 * MiB;
constexpr size_t WS_W2 = 264 * MiB;
constexpr size_t WS_H = 328 * MiB;
constexpr size_t WS_R = 360 * MiB;
constexpr size_t WS_ZQK = WS_R;
constexpr size_t WS_HM = WS_R, WS_HA = WS_R + 16 * MiB;
constexpr size_t WS_VMT = WS_R + 32 * MiB;
constexpr size_t WS_OM = WS_R + 48 * MiB;
constexpr size_t WS_QA = WS_R + 64 * MiB, WS_KA = WS_R + 80 * MiB;
constexpr size_t WS_Y = WS_QA;
constexpr size_t WS_VAT = WS_R + 96 * MiB;
constexpr size_t WS_SG = WS_R + 112 * MiB;
constexpr size_t WS_QM = WS_R + 176 * MiB, WS_KM = WS_R + 192 * MiB, WS_KMT = WS_R + 208 * MiB;
constexpr size_t WS_CST = WS_R + 224 * MiB;
constexpr size_t WS_HID = WS_R;
constexpr size_t WS_OP = WS_R + 16 * MiB;
constexpr size_t WS_END = 648 * MiB;
constexpr int CW_BAR = 4096;
constexpr int CW_CNT = 8192;

constexpr int RING_BYTES = 131072;
constexpr int MISC_OFF = 139264;
constexpr int LDS_BYTES = 147456;
constexpr int MO_BAR = 0, MO_CNT = 64, MO_NT = 64 + 128, MO_OFF = 64 + 256, MO_TE = 64 + 512, MO_TR0 = 64 + 1024, MO_MT = 64 + 1536, MO_LOG = 2048;

#define LDS_WAIT() asm volatile("s_waitcnt lgkmcnt(0)" ::: "memory")
#define VM_WAIT() asm volatile("s_waitcnt vmcnt(0)" ::: "memory")

__device__ __forceinline__ float bf2f(unsigned short b) { return __builtin_bit_cast(float, (unsigned)b << 16); }
__device__ __forceinline__ float bflo(unsigned u) { return __builtin_bit_cast(float, u << 16); }
__device__ __forceinline__ float bfhi(unsigned u) { return __builtin_bit_cast(float, u & 0xffff0000u); }
typedef __bf16 bf16x2v __attribute__((ext_vector_type(2)));
typedef float f32x2v __attribute__((ext_vector_type(2)));
__device__ __forceinline__ unsigned cvt_pk_bf16(float lo, float hi) { const f32x2v f = {lo, hi}; const bf16x2v b = __builtin_convertvector(f, bf16x2v); return __builtin_bit_cast(unsigned, b); }
__device__ __forceinline__ float wave_sum(float v) {
#pragma unroll
    for (int o = 1; o < 64; o <<= 1) v += __shfl_xor(v, o);
    return v;
}
__device__ __forceinline__ float rows4_max(float x) { x = fmaxf(x, __shfl_xor(x, 16)); return fmaxf(x, __shfl_xor(x, 32)); }
__device__ __forceinline__ float rows4_sum(float x) { x += __shfl_xor(x, 16); return x + __shfl_xor(x, 32); }
__device__ __forceinline__ int lane_id() { int l; asm volatile("v_mbcnt_lo_u32_b32 %0, -1, 0\n\tv_mbcnt_hi_u32_b32 %0, -1, %0" : "=v"(l)); return l; }
__device__ __forceinline__ float sigmoidf_(float x) { return __builtin_amdgcn_rcpf(1.f + __expf(-x)); }

namespace pg8 {
constexpr int BM = 256, BK = 64, HALF = 128, HTB = HALF * BK * 2, STAGE_BYTES = 8 * HTB, NXCD = 8, WGM = 8;
__device__ __forceinline__ int lds_byte(int r, int c) { const int st = (r >> 4) * 2 + (c >> 5), rr = r & 15, cc = c & 31, ob = rr * 64 + cc * 2; return st * 1024 + (ob ^ (((ob >> 9) & 1) << 5)); }
__device__ __forceinline__ void stage_rc(int b, int& R, int& C) { const int st = b / 1024, sb = b % 1024, swz = sb ^ (((sb >> 9) & 1) << 5); R = (st >> 1) * 16 + swz / 64; C = (st & 1) * 32 + (swz % 64) / 2; }
__device__ __forceinline__ int perm32(int rho) { const int n = rho >> 4, i = rho & 15; return 8 * (i >> 2) + 4 * n + (i & 3); }
struct Unit { int pm, pn, aux; };

__device__ __forceinline__ void static_tile(int L, int nM, int nN, int& pm, int& pn) {
    const int nwg = nM * nN; int wgid = L;
    { const int q = nwg / NXCD, r = nwg % NXCD, xcd = wgid % NXCD, off = wgid / NXCD; wgid = (xcd < r ? xcd * (q + 1) : r * (q + 1) + (xcd - r) * q) + off; }
    const int nig = WGM * nN, gid = wgid / nig, fm = gid * WGM, gsz = (nM - fm) < WGM ? (nM - fm) : WGM;
    pm = fm + ((wgid % nig) % gsz); pn = (wgid % nig) / gsz;
}

template <class Epi, class Sched>
__device__ __forceinline__ void gemm_phase(LAS unsigned char* lds, const int K, const Sched& S, const Epi& E, const int wave0) {
    int tid_ = wave0 * 64 + lane_id(); asm volatile("" : "+v"(tid_));
    const int tid = tid_, wid = __builtin_amdgcn_readfirstlane(tid >> 6), lane = tid & 63, wr = wid >> 2, wc = wid & 3, fr = lane & 15, fq = lane >> 4;
    const int nt = K / BK;
    int RA[2], CA[2]; unsigned voffB[2];
#pragma unroll
    for (int i = 0; i < 2; ++i) { int R, C; stage_rc(tid * 16 + i * 8192, R, C); const int Rb = Epi::PERM ? ((R & ~31) + perm32(R & 31)) : R;
        RA[i] = R; CA[i] = C; voffB[i] = (unsigned)(Rb * K + C) * 2u; }
    const size_t kstep = (size_t)(BK * 2);
    const size_t hstep = (size_t)HALF * K * 2;
    const unsigned ldsw = (unsigned)wid * 1024u;
    const int aoff = lds_byte(wr * 64 + fr, fq * 8), boff = lds_byte(wc * 32 + fr, fq * 8);
#define PG8_SA(b, h) (((b) * 2 + (h)) * HTB)
#define PG8_SB(b, h) ((4 + (b) * 2 + (h)) * HTB)
#define PG8_STAGE(bufoff, gbase, v0, v1) do { \
        __builtin_amdgcn_global_load_lds((const unsigned*)((const char*)(gbase) + (v0)), (LAS unsigned*)(lds + (bufoff) + ldsw), 16, 0, 0); \
        __builtin_amdgcn_global_load_lds((const unsigned*)((const char*)(gbase) + (v1)), (LAS unsigned*)(lds + (bufoff) + ldsw + 8192), 16, 0, 0); } while (0)
#define PG8_STAGE_B(bufoff, gbase) PG8_STAGE(bufoff, gbase, voffB[0], voffB[1])
#define PG8_STAGE_A(bufoff, gbase, VO, h) PG8_STAGE(bufoff, gbase, VO[h][0], VO[h][1])
#define PG8_STAGE_A2(bufoff, gbase, h) do { if (Sched::GATHER && last) { PG8_STAGE_A(bufoff, gbase, vn, h); } else { PG8_STAGE_A(bufoff, gbase, vc, h); } } while (0)
#define PG8_LDA(dst, b, h) do { _Pragma("unroll") for (int m = 0; m < 4; ++m) _Pragma("unroll") for (int k = 0; k < 2; ++k) dst[m][k] = *(const LAS bf16x8*)(lds + PG8_SA(b, h) + aoff + m * 2048 + k * 1024); } while (0)
#define PG8_LDB(dst, b, h) do { _Pragma("unroll") for (int n = 0; n < 2; ++n) _Pragma("unroll") for (int k = 0; k < 2; ++k) dst[n][k] = *(const LAS bf16x8*)(lds + PG8_SB(b, h) + boff + n * 2048 + k * 1024); } while (0)
#define PG8_MMA(ai, bj, At, Bt) do { __builtin_amdgcn_s_setprio(1); _Pragma("unroll") for (int m = 0; m < 4; ++m) _Pragma("unroll") for (int n = 0; n < 2; ++n) _Pragma("unroll") for (int k = 0; k < 2; ++k) \
        acc[ai][bj][m][n] = __builtin_amdgcn_mfma_f32_16x16x32_bf16(Bt[n][k], At[m][k], acc[ai][bj][m][n], 0, 0, 0); __builtin_amdgcn_s_setprio(0); } while (0)
#define PG8_WAIT_V(n) asm volatile("s_waitcnt vmcnt(" #n ")" ::: "memory")
#define PG8_WAIT_L(n) asm volatile("s_waitcnt lgkmcnt(" #n ")" ::: "memory")
#define PG8_BAR __builtin_amdgcn_s_barrier()
#define PG8_SCHED __builtin_amdgcn_sched_barrier(0)
    Unit cur, nxt; int ui = 0;
    if (!S.next(0, cur)) return;
    f32x4 acc[2][2][4][2];
#pragma unroll
    for (int a = 0; a < 2; ++a)
#pragma unroll
        for (int b = 0; b < 2; ++b)
#pragma unroll
            for (int m = 0; m < 4; ++m)
#pragma unroll
                for (int n = 0; n < 2; ++n) acc[a][b][m][n] = (f32x4){0.f, 0.f, 0.f, 0.f};
    bf16x8 At[4][2], B0[2][2], B1[2][2];
    unsigned vc[2][2], vn[2][2];
#pragma unroll
    for (int h = 0; h < 2; ++h)
#pragma unroll
        for (int i = 0; i < 2; ++i) {
            if constexpr (Sched::GATHER) vc[h][i] = (unsigned)(S.arow(cur, h * HALF + RA[i]) * (unsigned)K + (unsigned)CA[i]) * 2u;
            else vc[h][i] = (unsigned)((h * HALF + RA[i]) * K + CA[i]) * 2u;
            vn[h][i] = vc[h][i];
        }
    const char* cA = S.abase(cur); const char* cB = S.bbase(cur);
    PG8_STAGE_B(PG8_SB(0, 0), cB); PG8_STAGE_A(PG8_SA(0, 0), cA, vc, 0); PG8_STAGE_B(PG8_SB(0, 1), cB + hstep); PG8_STAGE_A(PG8_SA(0, 1), cA, vc, 1);
    if (wr == 1) PG8_BAR;
    PG8_WAIT_V(4); PG8_BAR;
    PG8_STAGE_B(PG8_SB(1, 0), cB + kstep); PG8_STAGE_A(PG8_SA(1, 0), cA + kstep, vc, 0); PG8_STAGE_B(PG8_SB(1, 1), cB + hstep + kstep);
    PG8_WAIT_V(6); PG8_BAR;
    for (;;) {
        const bool has_next = S.next(ui + 1, nxt);
        const char* nA = has_next ? S.abase(nxt) : cA; const char* nB = has_next ? S.bbase(nxt) : cB;
        if constexpr (Sched::GATHER) {
            if (has_next) {
                int t2 = wave0 * 64 + lane_id(); asm volatile("" : "+v"(t2));
#pragma unroll
                for (int i = 0; i < 2; ++i) { int R, C; stage_rc(t2 * 16 + i * 8192, R, C);
#pragma unroll
                    for (int h = 0; h < 2; ++h) vn[h][i] = (unsigned)(S.arow(nxt, h * HALF + R) * (unsigned)K + (unsigned)C) * 2u; }
            }
        }
#pragma unroll 1
        for (int t = 0; t < nt; t += 2) {
            const bool last = (t == nt - 2);
            const char* a1 = cA + (size_t)(t + 1) * kstep;
            const char* a2 = last ? nA : cA + (size_t)(t + 2) * kstep; const char* b2 = last ? nB : cB + (size_t)(t + 2) * kstep;
            const char* a3 = a2 + kstep; const char* b3 = b2 + kstep;
            PG8_LDB(B0, 0, 0); PG8_SCHED; PG8_LDA(At, 0, 0); PG8_STAGE_A(PG8_SA(1, 1), a1, vc, 1);
            PG8_WAIT_L(8); PG8_BAR; PG8_WAIT_L(0); PG8_MMA(0, 0, At, B0); PG8_BAR; PG8_SCHED;
            PG8_LDB(B1, 0, 1); PG8_STAGE_B(PG8_SB(0, 0), b2);
            PG8_BAR; PG8_WAIT_L(0); PG8_MMA(0, 1, At, B1); PG8_BAR;
            PG8_LDA(At, 0, 1); PG8_STAGE_A2(PG8_SA(0, 0), a2, 0);
            PG8_BAR; PG8_WAIT_L(0); PG8_MMA(1, 0, At, B0); PG8_BAR; PG8_SCHED;
            PG8_STAGE_B(PG8_SB(0, 1), b2 + hstep);
            PG8_WAIT_V(6); PG8_BAR; PG8_MMA(1, 1, At, B1); PG8_BAR;
            PG8_LDB(B0, 1, 0); PG8_SCHED; PG8_LDA(At, 1, 0); PG8_STAGE_A2(PG8_SA(0, 1), a2, 1);
            PG8_WAIT_L(8); PG8_BAR; PG8_WAIT_L(0); PG8_MMA(0, 0, At, B0); PG8_BAR; PG8_SCHED;
            PG8_LDB(B1, 1, 1); PG8_STAGE_B(PG8_SB(1, 0), b3);
            PG8_BAR; PG8_WAIT_L(0); PG8_MMA(0, 1, At, B1); PG8_BAR;
            PG8_LDA(At, 1, 1); PG8_STAGE_A2(PG8_SA(1, 0), a3, 0);
            PG8_BAR; PG8_WAIT_L(0); PG8_MMA(1, 0, At, B0); PG8_BAR; PG8_SCHED;
            PG8_STAGE_B(PG8_SB(1, 1), b3 + hstep);
            PG8_WAIT_V(6); PG8_BAR; PG8_MMA(1, 1, At, B1); PG8_BAR;
        }
        { const int lz = lane_id(); E(acc, cur, wr, wc, lz & 15, lz >> 4); }
        if (!has_next) break;
        if (!Sched::keep_acc(cur)) {
#pragma unroll
        for (int a = 0; a < 2; ++a)
#pragma unroll
            for (int b = 0; b < 2; ++b)
#pragma unroll
                for (int m = 0; m < 4; ++m)
#pragma unroll
                    for (int n = 0; n < 2; ++n) acc[a][b][m][n] = (f32x4){0.f, 0.f, 0.f, 0.f};
        }
        cur = nxt; cA = nA; cB = nB; ++ui;
        if constexpr (Sched::GATHER) {
#pragma unroll
            for (int h = 0; h < 2; ++h)
#pragma unroll
                for (int i = 0; i < 2; ++i) vc[h][i] = vn[h][i];
        }
    }
    PG8_WAIT_V(0);
    if (wr == 0) PG8_BAR;
    PG8_BAR;
#undef PG8_SA
#undef PG8_SB
#undef PG8_STAGE
#undef PG8_STAGE_A
#undef PG8_STAGE_A2
#undef PG8_STAGE_B
#undef PG8_LDA
#undef PG8_LDB
#undef PG8_MMA
#undef PG8_WAIT_V
#undef PG8_WAIT_L
#undef PG8_BAR
#undef PG8_SCHED
}
}
using pg8::Unit;

#define XB_TMO      128
#define XB_XCNT(j)  (256  + 64 * (j))
#define XB_XSUB(j)  (1280 + 64 * (j))
#define XB_XGEN(j)  (2304 + 64 * (j))
#define XB_TOP      3328
#define XB_TOPGEN   3392
#define XCD_BAR_WORDS 3456
#define XB_SPIN_CAP (1u << 18)
__device__ __forceinline__ unsigned xb_ld(unsigned* p)              { return __hip_atomic_load(p, __ATOMIC_RELAXED, __HIP_MEMORY_SCOPE_AGENT); }
__device__ __forceinline__ unsigned xb_add(unsigned* p, unsigned v) { return __hip_atomic_fetch_add(p, v, __ATOMIC_RELAXED, __HIP_MEMORY_SCOPE_AGENT); }
__device__ __forceinline__ unsigned xb_xcc_id() { return (unsigned)__builtin_amdgcn_s_getreg((3 << 11) | 20) & 0xFu; }
#define XB_SPIN(cond, bar) do { unsigned _sp = 0; while (cond) { __builtin_amdgcn_s_sleep(1); \
    if ((++_sp & 255u) == 0u) { if (xb_ld(&(bar)[XB_TMO])) break; if (_sp > XB_SPIN_CAP) { atomicAdd(&(bar)[XB_TMO], 1u); break; } } } } while (0)
struct XcdBarrier { unsigned* bar; unsigned x; volatile LAS unsigned* st; };
__device__ __forceinline__ XcdBarrier xcd_barrier_post(unsigned* bar, volatile LAS unsigned* st) {
    XcdBarrier b; b.bar = bar; b.x = xb_xcc_id(); b.st = st;
    if (threadIdx.x == 0) (void)xb_add(&bar[XB_XCNT(b.x)], 1u);
    return b;
}
__device__ __forceinline__ void xcd_barrier_complete(unsigned* bar, unsigned x, unsigned& nloc, unsigned& nx) {
    const unsigned G = gridDim.x * gridDim.y * gridDim.z;
    unsigned sum, cnt, mine, sp = 0u;
    for (;;) {
        sum = 0u; cnt = 0u; mine = 0u;
#pragma unroll
        for (unsigned j = 0; j < 16; ++j) { const unsigned c = xb_ld(&bar[XB_XCNT(j)]); sum += c; cnt += (c > 0u) ? 1u : 0u; mine = (j == x) ? c : mine; }
        if (sum == G) break;
        __builtin_amdgcn_s_sleep(1);
        if ((++sp & 255u) == 0u) { if (xb_ld(&bar[XB_TMO])) break; if (sp > XB_SPIN_CAP) { atomicAdd(&bar[XB_TMO], 1u); break; } }
    }
    nloc = mine > 0u ? mine : 1u; nx = cnt > 0u ? cnt : 1u;
}
__device__ __forceinline__ void xcd_barrier(const XcdBarrier& b) {
    asm volatile("s_waitcnt vmcnt(0)" ::: "memory");
    __syncthreads();
    if (threadIdx.x == 0) {
        unsigned* bar = b.bar;
        __builtin_amdgcn_s_waitcnt(0);
        unsigned nloc = b.st[0], nx = b.st[1];
        if (nloc == 0u) { xcd_barrier_complete(bar, b.x, nloc, nx); b.st[0] = nloc; b.st[1] = nx; }
        const unsigned old = xb_add(&bar[XB_XSUB(b.x)], 1u);
        const unsigned gen = old / nloc;
        if (old + 1u == (gen + 1u) * nloc) {
            __builtin_amdgcn_fence(__ATOMIC_RELEASE, "agent");
            asm volatile("s_waitcnt vmcnt(0)" ::: "memory");
            const unsigned og = xb_add(&bar[XB_TOP], 1u);
            const unsigned tg = og / nx;
            if (og + 1u == (tg + 1u) * nx) xb_add(&bar[XB_TOPGEN], 1u);
            else XB_SPIN(xb_ld(&bar[XB_TOPGEN]) == tg, bar);
            __builtin_amdgcn_fence(__ATOMIC_ACQUIRE, "agent");
            xb_add(&bar[XB_XGEN(b.x)], 1u);
            asm volatile("s_waitcnt vmcnt(0)" ::: "memory");
        } else {
            XB_SPIN(xb_ld(&bar[XB_XGEN(b.x)]) == gen, bar);
            __builtin_amdgcn_fence(__ATOMIC_ACQUIRE, "agent");
            asm volatile("s_waitcnt vmcnt(0)" ::: "memory");
        }
    }
    __syncthreads();
}

struct Args { const float* in[19]; float* out; unsigned char* ws; int ph_lo, ph_hi; };
typedef const __attribute__((address_space(4))) Args* ArgsP;
enum { I_X = 0, I_N1G, I_WIN, I_CONVW, I_IFB, I_MNG, I_WBM, I_WBA, I_WOUT, I_RELB, I_N2G, I_WGRP, I_BGRP, I_WEXP, I_BEXP, I_W1, I_W3, I_W2, I_FG };


struct TrDesc { const float* W; bf16* WT; size_t ldn, ldk; int k0, n0, r0; };
__device__ __forceinline__ void tr_load(const TrDesc& d, f32x4 (&tv)[16], int lane) {
    const int nn4 = (lane & 15) * 4, kr = lane >> 4;
#pragma unroll
    for (int i = 0; i < 16; ++i) tv[i] = __builtin_nontemporal_load((const f32x4*)(d.W + (size_t)(d.k0 + 4 * i + kr) * d.ldn + d.n0 + nn4));
}
__device__ __forceinline__ void tr_finish(const TrDesc& d, f32x4 (&tv)[16], LAS float* scr, int lane) {
    const int nn4 = (lane & 15) * 4, kr = lane >> 4;
#pragma unroll
    for (int i = 0; i < 16; i += 4) asm volatile("" : "+v"(tv[i]), "+v"(tv[i + 1]), "+v"(tv[i + 2]), "+v"(tv[i + 3]));
#pragma unroll
    for (int i = 0; i < 16; ++i) { const int kk = 4 * i + kr; const f32x4 v = tv[i];
        LAS float* q = scr + kk * 65 + nn4; q[0] = v.x; q[1] = v.y; q[2] = v.z; q[3] = v.w; }
    LDS_WAIT();
    const int kc = (lane & 7) * 8;
#pragma unroll
    for (int p = 0; p < 8; ++p) { const int nn = 8 * p + (lane >> 3); const LAS float* sp = scr + kc * 65 + nn;
        u32x4 o; o.x = cvt_pk_bf16(sp[0], sp[65]); o.y = cvt_pk_bf16(sp[130], sp[195]); o.z = cvt_pk_bf16(sp[260], sp[325]); o.w = cvt_pk_bf16(sp[390], sp[455]);
        *(u32x4*)(d.WT + (size_t)(d.r0 + nn) * d.ldk + d.k0 + kc) = o; }
    LDS_WAIT();
}
__device__ __forceinline__ int win_src_col(int r) {
    if (r < 2048) return r;
    if (r < 3072) return r + 1024;
    if (r < 5120) return r + 1032;
    if (r < 9216) return r + 2056;
    if (r < 10240) return r - 7168;
    return r - 4088;
}
__device__ __forceinline__ TrDesc tr_decode(ArgsP a, unsigned char* ws, int it) {
    constexpr int PER_LAYER = 5632 + 512 + 512 + 1024 + 4096 + 4096 + 4096;
    const int l = it / PER_LAYER; int r = it % PER_LAYER;
    TrDesc d;
    if (r < 5632) { const int kb = r / 176, ng = r % 176;
        d.W = a->in[I_WIN] + (size_t)l * DM * INCOLS; d.ldn = INCOLS; d.k0 = 64 * kb; d.n0 = win_src_col(64 * ng); d.WT = (bf16*)(ws + WS_WINT) + (size_t)l * 11264 * 2048; d.ldk = 2048; d.r0 = 64 * ng; return d; }
    r -= 5632;
    if (r < 512) { const int kb = r / 32, ng = r % 32;
        d.W = a->in[I_WBM] + (size_t)l * 1024 * 2048; d.ldn = 2048; d.k0 = 64 * kb; d.n0 = 64 * ng; d.WT = (bf16*)(ws + WS_WBM) + (size_t)l * 2048 * 1024; d.ldk = 1024; d.r0 = 64 * ng; return d; }
    r -= 512;
    if (r < 512) { const int kb = r / 32, ng = r % 32;
        d.W = a->in[I_WBA] + (size_t)l * 1024 * 2048; d.ldn = 2048; d.k0 = 64 * kb; d.n0 = 64 * ng; d.WT = (bf16*)(ws + WS_WBA) + (size_t)l * 2048 * 1024; d.ldk = 1024; d.r0 = 64 * ng; return d; }
    r -= 512;
    if (r < 1024) { const int kb = r / 32, ng = r % 32;
        d.W = a->in[I_WOUT] + (size_t)l * 2048 * 2048; d.ldn = 2048; d.k0 = 64 * kb; d.n0 = 64 * ng; d.WT = (bf16*)(ws + WS_WOUT) + (size_t)l * 2048 * 2048; d.ldk = 2048; d.r0 = 64 * ng; return d; }
    r -= 1024;
    if (r < 8192) { const int w3 = r >= 4096; const int q = r & 4095; const int e = q >> 7, rr = q & 127, kb = rr >> 2, ng = rr & 3;
        d.W = a->in[w3 ? I_W3 : I_W1] + (size_t)(l * 32 + e) * 2048 * 256; d.ldn = 256; d.k0 = 64 * kb; d.n0 = 64 * ng;
        d.WT = (bf16*)(ws + WS_W13) + (size_t)(l * 32 + e) * 512 * 2048; d.ldk = 2048; d.r0 = 256 * (ng >> 1) + 64 * (ng & 1) + (w3 ? 128 : 0); return d; }
    r -= 8192;
    { const int e = r >> 7, rr = r & 127, kb = rr >> 5, ng = rr & 31;
        d.W = a->in[I_W2] + (size_t)(l * 32 + e) * 256 * 2048; d.ldn = 2048; d.k0 = 64 * kb; d.n0 = 64 * ng; d.WT = (bf16*)(ws + WS_W2) + (size_t)(l * 32 + e) * 2048 * 256; d.ldk = 256; d.r0 = 64 * ng; return d; }
}
#ifndef CVX
#define CVX 4096
#endif
__device__ __forceinline__ void prologue_phase(ArgsP a, LAS unsigned char* lds, int tid, int lane, int wave, int bid, int G, const int part = 0) {
    unsigned char* ws = a->ws;
    LAS float* scr = (LAS float*)(lds + wave * 16640);
    const int gw = bid * NWAVES + wave, NGW = G * NWAVES;
    constexpr int PER_LAYER = 5632 + 512 + 512 + 1024 + 4096 + 4096 + 4096;
    constexpr int W0 = 5632, W2I = PER_LAYER - 4096;
    const int v_lo = part == 0 ? 0 : part == 1 ? PER_LAYER : part == 2 ? W0 + CVX : part == 3 ? PER_LAYER + W0 : PER_LAYER + W2I;
    const int v_hi = part == 0 ? W0 + CVX : part == 1 ? PER_LAYER + W0 : part == 2 ? PER_LAYER : part == 3 ? PER_LAYER + W2I : 2 * PER_LAYER;
#define CV_ITEM(v) (v)
    f32x4 tvA[16], tvB[16]; TrDesc dA, dB;
    int it = v_lo + gw;
    if (it < v_hi) {
        int rem = (v_hi - 1 - it) / NGW;
        dA = tr_decode(a, ws, CV_ITEM(it)); tr_load(dA, tvA, lane);
#pragma unroll 1
        while (rem >= 2) {
            dB = tr_decode(a, ws, CV_ITEM(it + NGW)); tr_load(dB, tvB, lane);
            tr_finish(dA, tvA, scr, lane);
            it += 2 * NGW;
            dA = tr_decode(a, ws, CV_ITEM(it)); tr_load(dA, tvA, lane);
            tr_finish(dB, tvB, scr, lane);
            rem -= 2;
        }
        if (rem == 1) { dB = tr_decode(a, ws, CV_ITEM(it + NGW)); tr_load(dB, tvB, lane); tr_finish(dA, tvA, scr, lane); tr_finish(dB, tvB, scr, lane); }
        else tr_finish(dA, tvA, scr, lane);
    }
#undef CV_ITEM
    if (part != 0) return;
    const int gt = bid * NTHR + tid, NGT = G * NTHR;
    float* wrt = (float*)(ws + MS_WRT);
    for (int i = gt; i < 2 * 36 * 2048; i += NGT) { const int l = i / (36 * 2048), rr = i % (36 * 2048), n = rr >> 11, k = rr & 2047;
        wrt[i] = n < 4 ? a->in[I_WGRP][((size_t)l * DM + k) * 4 + n] : a->in[I_WEXP][((size_t)l * DM + k) * 32 + (n - 4)]; }
}

__device__ __forceinline__ void moe_tables(unsigned char* ws, int l, LAS unsigned char* misc, int tid) {
    LAS int* cnt = (LAS int*)(misc + MO_CNT); LAS int* ntl = (LAS int*)(misc + MO_NT); LAS int* off = (LAS int*)(misc + MO_OFF);
    LAS int* te = (LAS int*)(misc + MO_TE); LAS int* tr0 = (LAS int*)(misc + MO_TR0); LAS int* mt = (LAS int*)(misc + MO_MT);
    __syncthreads();
    if (tid < 32) { const int c = (int)__hip_atomic_load((unsigned*)(ws + WS_CTL) + CW_CNT + 32 * l + tid, __ATOMIC_RELAXED, __HIP_MEMORY_SCOPE_AGENT); cnt[tid] = c; ntl[tid] = (c + 255) >> 8; }
    __syncthreads();
    if (tid == 0) { int o = 0;
#pragma unroll 1
        for (int e = 0; e < 32; ++e) { off[e] = o; const int n = ntl[e];
#pragma unroll 1
            for (int j = 0; j < n; ++j) { te[o + j] = e; tr0[o + j] = 256 * j; } o += n; } off[32] = o; mt[0] = o; }
    __syncthreads();
}

#ifndef DRYX
#define DRYX 0
#endif
template <int MODE>
__device__ __forceinline__ void norm_phase(ArgsP a, int l, LAS unsigned char* lds, int tid, int lane, int wave, int bid, int G, const bool dry = false) {
    unsigned char* ws = a->ws;
    LAS unsigned char* misc = lds + MISC_OFF;
    if (MODE == 1 || MODE == 3) moe_tables(ws, MODE == 1 ? 0 : 1, misc, tid);
    const LAS int* off = (const LAS int*)(misc + MO_OFF);
    const float* src = (MODE == 0) ? a->in[I_X] : a->out;
    const float* gain = (MODE < 2) ? a->in[I_N1G] + l * DM : (MODE == 2 ? a->in[I_N2G] + l * DM : a->in[I_FG]);
    const int* toke = (const int*)(ws + MS_TOKE); const int* tokp = (const int*)(ws + MS_TOKP);
    const bf16* OP = (const bf16*)(ws + WS_OP);
    bf16* H = (bf16*)(ws + WS_H);
    const int gw = bid * NWAVES + wave, NGW = G * NWAVES;
    constexpr int RP = (MODE == 2) ? 4 : 2;
    for (int m0 = gw * RP; m0 < NTOK; m0 += NGW * RP) {
        f32x4 v[RP][8];
#pragma unroll
        for (int r = 0; r < RP; ++r)
#pragma unroll
            for (int j = 0; j < 8; ++j) v[r][j] = *(const f32x4*)(src + (size_t)(m0 + r) * DM + 256 * j + 4 * lane);
        if (MODE == 1 || MODE == 3) {
#pragma unroll
            for (int r = 0; r < RP; ++r) { const int m = m0 + r;
                const int e0 = toke[2 * m], e1 = toke[2 * m + 1], p0 = tokp[2 * m], p1 = tokp[2 * m + 1];
                const float cw0 = ((const float*)(ws + MS_TOKW))[2 * m], cw1 = ((const float*)(ws + MS_TOKW))[2 * m + 1];
                const bf16* o0 = OP + (size_t)(off[e0] * 256 + p0) * DM + 4 * lane; const bf16* o1 = OP + (size_t)(off[e1] * 256 + p1) * DM + 4 * lane;
                u32x2 ow0[8], ow1[8];
#pragma unroll
                for (int j = 0; j < 8; ++j) { ow0[j] = *(const u32x2*)(o0 + 256 * j); ow1[j] = *(const u32x2*)(o1 + 256 * j); }
                asm volatile("" : "+v"(ow0[0]), "+v"(ow0[1]), "+v"(ow0[2]), "+v"(ow0[3]), "+v"(ow0[4]), "+v"(ow0[5]), "+v"(ow0[6]), "+v"(ow0[7]),
                                  "+v"(ow1[0]), "+v"(ow1[1]), "+v"(ow1[2]), "+v"(ow1[3]), "+v"(ow1[4]), "+v"(ow1[5]), "+v"(ow1[6]), "+v"(ow1[7]));
#pragma unroll
                for (int j = 0; j < 8; ++j) { const u32x2 w0 = ow0[j], w1 = ow1[j];
                    v[r][j].x += cw0 * bflo(w0.x) + cw1 * bflo(w1.x); v[r][j].y += cw0 * bfhi(w0.x) + cw1 * bfhi(w1.x); v[r][j].z += cw0 * bflo(w0.y) + cw1 * bflo(w1.y); v[r][j].w += cw0 * bfhi(w0.y) + cw1 * bfhi(w1.y); }
                if (MODE == 1 && !dry) {
#pragma unroll
                    for (int j = 0; j < 8; ++j) *(f32x4*)(a->out + (size_t)m * DM + 256 * j + 4 * lane) = v[r][j]; }
                asm volatile("" ::: "memory");
            }
        }
        float rs[RP];
#pragma unroll
        for (int r = 0; r < RP; ++r) { float ss = 0.f;
#pragma unroll
            for (int j = 0; j < 8; ++j) ss += (v[r][j].x * v[r][j].x + v[r][j].y * v[r][j].y) + (v[r][j].z * v[r][j].z + v[r][j].w * v[r][j].w);
            rs[r] = __builtin_amdgcn_rsqf(wave_sum(ss) * (1.0f / DM) + RMS_EPS); }
        {
            f32x4 gv[8];
#pragma unroll
            for (int j = 0; j < 8; ++j) gv[j] = *(const f32x4*)(gain + 256 * j + 4 * lane);
            asm volatile("" : "+v"(gv[0]), "+v"(gv[1]), "+v"(gv[2]), "+v"(gv[3]), "+v"(gv[4]), "+v"(gv[5]), "+v"(gv[6]), "+v"(gv[7]));
#pragma unroll
            for (int j = 0; j < 8; ++j)
#pragma unroll
                for (int r = 0; r < RP; ++r) v[r][j] = v[r][j] * rs[r] * gv[j];
        }
        if (MODE == 3) {
#pragma unroll
            for (int r = 0; r < RP; ++r)
#pragma unroll
                for (int j = 0; j < 8; ++j) { if (!dry) *(f32x4*)(a->out + (size_t)(m0 + r) * DM + 256 * j + 4 * lane) = v[r][j]; else asm volatile("" :: "v"(v[r][j])); }
            continue;
        }
#pragma unroll
        for (int r = 0; r < RP; ++r)
#pragma unroll
            for (int j = 0; j < 8; ++j) { u32x2 w; w.x = cvt_pk_bf16(v[r][j].x, v[r][j].y); w.y = cvt_pk_bf16(v[r][j].z, v[r][j].w);
                if (!dry) *(u32x2*)(H + (size_t)(m0 + r) * DM + 256 * j + 4 * lane) = w; else asm volatile("" :: "v"(w)); }
        float keep[RP]; _Pragma("unroll") for (int r = 0; r < RP; ++r) keep[r] = 0.f;
        if (MODE < 2) {
            float a8[RP][8];
#pragma unroll
            for (int r = 0; r < RP; ++r)
#pragma unroll
                for (int n = 0; n < 8; ++n) a8[r][n] = 0.f;
            const float* wg = a->in[I_WIN] + (size_t)l * DM * INCOLS + 4096;
#pragma unroll
            for (int j = 0; j < 8; ++j)
#pragma unroll
                for (int c = 0; c < 4; ++c) { const float* wp = wg + (size_t)(256 * j + 4 * lane + c) * INCOLS;
                    const f32x4 w0 = *(const f32x4*)wp, w1 = *(const f32x4*)(wp + 4);
#pragma unroll
                    for (int r = 0; r < RP; ++r) { const float hv = v[r][j][c];
                        a8[r][0] += hv * w0.x; a8[r][1] += hv * w0.y; a8[r][2] += hv * w0.z; a8[r][3] += hv * w0.w;
                        a8[r][4] += hv * w1.x; a8[r][5] += hv * w1.y; a8[r][6] += hv * w1.z; a8[r][7] += hv * w1.w; }
                    if (c == 3) asm volatile("" ::: "memory"); }
#pragma unroll
            for (int r = 0; r < RP; ++r)
#pragma unroll
                for (int n = 0; n < 8; ++n) { const float d = wave_sum(a8[r][n]); keep[r] = (lane == n) ? d : keep[r]; }
        } else {
            const float* W = (const float*)(ws + MS_WRT) + (size_t)l * 36 * 2048;
            LAS float* logl = (LAS float*)(misc + MO_LOG) + wave * 160;
#pragma unroll 1
            for (int grp = 0; grp < 9; ++grp) {
                float val[16];
                const float* wg = W + (size_t)(4 * grp) * 2048 + 4 * lane;
#pragma unroll
                for (int nl = 0; nl < 4; ++nl) {
                    float d[4] = {0.f, 0.f, 0.f, 0.f};
                    f32x4 wv[8];
#pragma unroll
                    for (int j = 0; j < 8; ++j) wv[j] = *(const f32x4*)(wg + nl * 2048 + 256 * j);
                    asm volatile("" : "+v"(wv[0]), "+v"(wv[1]), "+v"(wv[2]), "+v"(wv[3]), "+v"(wv[4]), "+v"(wv[5]), "+v"(wv[6]), "+v"(wv[7]));
#pragma unroll
                    for (int j = 0; j < 8; ++j) { const f32x4 w = wv[j];
#pragma unroll
                        for (int r = 0; r < 4; ++r) d[r] += (v[r][j].x * w.x + v[r][j].y * w.y) + (v[r][j].z * w.z + v[r][j].w * w.w); }
#pragma unroll
                    for (int r = 0; r < 4; ++r) val[4 * nl + r] = d[r];
                }
#pragma unroll
                for (int i = 0; i < 8; ++i) { const bool hi = (lane & 32) != 0; const float snd = hi ? val[i] : val[i + 8]; const float kp = hi ? val[i + 8] : val[i]; val[i] = kp + __shfl_xor(snd, 32); }
#pragma unroll
                for (int i = 0; i < 4; ++i) { const bool hi = (lane & 16) != 0; const float snd = hi ? val[i] : val[i + 4]; const float kp = hi ? val[i + 4] : val[i]; val[i] = kp + __shfl_xor(snd, 16); }
#pragma unroll
                for (int i = 0; i < 2; ++i) { const bool hi = (lane & 8) != 0; const float snd = hi ? val[i] : val[i + 2]; const float kp = hi ? val[i + 2] : val[i]; val[i] = kp + __shfl_xor(snd, 8); }
                { const bool hi = (lane & 4) != 0; const float snd = hi ? val[0] : val[1]; const float kp = hi ? val[1] : val[0]; val[0] = kp + __shfl_xor(snd, 4); }
                float f = val[0]; f += __shfl_xor(f, 2); f += __shfl_xor(f, 1);
                const int vi = lane >> 2;
                if ((lane & 3) == 0) logl[(vi & 3) * 40 + 4 * grp + (vi >> 2)] = f;
            }
        }
        if (MODE < 2) {
            float* ifg = (float*)(ws + MS_IFG);
            if (lane < 8) {
#pragma unroll
                for (int r = 0; r < RP; ++r) { if (!dry) ifg[(size_t)(m0 + r) * 8 + lane] = keep[r]; else asm volatile("" :: "v"(keep[r])); } }
        } else {
            LAS float* logl = (LAS float*)(misc + MO_LOG) + wave * 160;
            LDS_WAIT();
            if (dry) { asm volatile("" :: "v"(keep[0])); }
            if (lane < RP && !dry) {
                const int m = m0 + lane; const LAS float* lg = logl + lane * 40;
                const float* bg = a->in[I_BGRP] + l * 4; const float* be = a->in[I_BEXP] + l * 32;
                float gv[4]; int gsel = 0;
#pragma unroll
                for (int j = 0; j < 4; ++j) gv[j] = lg[j] + bg[j];
                float gmax = gv[0];
#pragma unroll
                for (int j = 1; j < 4; ++j) if (gv[j] > gmax) { gmax = gv[j]; gsel = j; }
                float gs = 0.f;
#pragma unroll
                for (int j = 0; j < 4; ++j) gs += expf(gv[j] - gmax);
                const float pg = 1.0f / gs;
                float ev[8];
#pragma unroll
                for (int j = 0; j < 8; ++j) ev[j] = lg[4 + 8 * gsel + j] + be[8 * gsel + j];
                int e0 = 0; float m0v = ev[0];
#pragma unroll
                for (int j = 1; j < 8; ++j) if (ev[j] > m0v) { m0v = ev[j]; e0 = j; }
                int e1 = -1; float m1v = -3.0e38f;
#pragma unroll
                for (int j = 0; j < 8; ++j) if (j != e0 && ev[j] > m1v) { m1v = ev[j]; e1 = j; }
                const float p1 = expf(m1v - m0v); const float w0 = pg / (1.0f + p1), w1 = pg * p1 / (1.0f + p1);
                unsigned* cnt = (unsigned*)(ws + WS_CTL) + CW_CNT + 32 * l;
                int* list = (int*)(ws + MS_LIST); float* pwl = (float*)(ws + MS_PWL); int* tke = (int*)(ws + MS_TOKE); int* tkp = (int*)(ws + MS_TOKP);
                const int id0 = 8 * gsel + e0, id1 = 8 * gsel + e1;
                const int q0 = (int)__hip_atomic_fetch_add(cnt + id0, 1u, __ATOMIC_RELAXED, __HIP_MEMORY_SCOPE_AGENT);
                const int q1 = (int)__hip_atomic_fetch_add(cnt + id1, 1u, __ATOMIC_RELAXED, __HIP_MEMORY_SCOPE_AGENT);
                list[id0 * 8192 + q0] = m; pwl[id0 * 8192 + q0] = w0; list[id1 * 8192 + q1] = m; pwl[id1 * 8192 + q1] = w1;
                tke[2 * m] = id0; tke[2 * m + 1] = id1; tkp[2 * m] = q0; tkp[2 * m + 1] = q1;
                ((float*)(ws + MS_TOKW))[2 * m] = w0; ((float*)(ws + MS_TOKW))[2 * m + 1] = w1;
            }
            LDS_WAIT();
        }
    }
}

struct SchedG1 {
    static constexpr bool GATHER = false;
    const char* H; const char* W; int G, c;
    static constexpr int NCV = 21;
    __device__ __forceinline__ bool next(int i, Unit& u) const {
        int L = i * G + c;
        if (G == 256) {
            if (c >= 256 - NCV) return false;
            if (c >= 128 && i == 5) { const int k = c - 128; if (k >= 5 * NCV) return false; L = (k % 5) * 256 + (256 - NCV) + k / 5; }
            else if (i > 5) return false;
        }
        if (L < 1152) { pg8::static_tile(L, 32, 36, u.pm, u.pn); u.aux = 0; return true; }
        const int r = L - 1152; if (r >= 256) return false;
        u.aux = 1 + (r >> 7); const int q = r & 127; u.pm = q & 3; u.pn = q >> 2; return true;
    }
    __device__ __forceinline__ const char* abase(const Unit& u) const { return u.aux == 0 ? H + (size_t)u.pm * 256 * 4096 : W + (size_t)(9216 + (u.aux - 1) * 1024 + u.pm * 256) * 4096; }
    __device__ __forceinline__ const char* bbase(const Unit& u) const { return u.aux == 0 ? W + (size_t)u.pn * 256 * 4096 : H + (size_t)u.pn * 256 * 4096; }
    __device__ __forceinline__ unsigned arow(const Unit&, int) const { return 0u; }
    static __device__ __forceinline__ bool keep_acc(const Unit&) { return false; }
};
struct EpiG1 {
    static constexpr bool PERM = true;
    unsigned char* ws; bool dry;
    __device__ __forceinline__ void operator()(f32x4 (&acc)[2][2][4][2], const Unit& u, int wr, int wc, int fr, int fq) const {
        if (dry) {
#pragma unroll
            for (int ai = 0; ai < 2; ++ai)
#pragma unroll
                for (int bj = 0; bj < 2; ++bj)
#pragma unroll
                    for (int m = 0; m < 4; ++m) asm volatile("" :: "v"(acc[ai][bj][m][0]), "v"(acc[ai][bj][m][1]));
            return; }
        if (u.aux == 0) {
            bf16* dst; int ld, colt, op;
            if (u.pn < 8) { dst = (bf16*)(ws + WS_ZQK); ld = 2048; colt = 256 * u.pn; op = 0; }
            else if (u.pn < 12) { dst = (bf16*)(ws + WS_OM); ld = 1024; colt = 256 * (u.pn - 8); op = 1; }
            else if (u.pn < 16) { dst = (bf16*)(ws + WS_QA); ld = 1024; colt = 256 * (u.pn - 12); op = 2; }
            else if (u.pn < 20) { dst = (bf16*)(ws + WS_KA); ld = 1024; colt = 256 * (u.pn - 16); op = 0; }
            else { dst = (bf16*)(ws + WS_SG); ld = 4096; colt = 256 * (u.pn - 20); op = 1; }
            const float scl = (op == 2) ? 0.12751743074602267f : 1.0f;
            const int row0 = u.pm * 256 + wr * 64 + fr, col0 = colt + wc * 32 + 8 * fq;
#pragma unroll
            for (int ai = 0; ai < 2; ++ai)
#pragma unroll
                for (int m = 0; m < 4; ++m) { bf16* rowp = dst + (size_t)(row0 + ai * 128 + m * 16) * ld + col0;
#pragma unroll
                    for (int bj = 0; bj < 2; ++bj) { f32x4 v0 = acc[ai][bj][m][0] * scl, v1 = acc[ai][bj][m][1] * scl;
                        if (op == 1) {
#pragma unroll
                            for (int j = 0; j < 4; ++j) { v0[j] = sigmoidf_(v0[j]); v1[j] = sigmoidf_(v1[j]); } }
                        u32x4 w; w.x = cvt_pk_bf16(v0[0], v0[1]); w.y = cvt_pk_bf16(v0[2], v0[3]); w.z = cvt_pk_bf16(v1[0], v1[1]); w.w = cvt_pk_bf16(v1[2], v1[3]);
                        *(u32x4*)(rowp + bj * 128) = w; } }
        } else {
            bf16* dst = (bf16*)(ws + (u.aux == 1 ? WS_VMT : WS_VAT));
            const int b = u.pn >> 3, s0 = (u.pn & 7) * 256 + wc * 32 + 8 * fq, rr0 = u.pm * 256 + wr * 64 + fr;
#pragma unroll
            for (int ai = 0; ai < 2; ++ai)
#pragma unroll
                for (int m = 0; m < 4; ++m) { const int rr = rr0 + ai * 128 + m * 16;
#pragma unroll
                    for (int bj = 0; bj < 2; ++bj) { const f32x4 v0 = acc[ai][bj][m][0], v1 = acc[ai][bj][m][1];
                        u32x4 w; w.x = cvt_pk_bf16(v0[0], v0[1]); w.y = cvt_pk_bf16(v0[2], v0[3]); w.z = cvt_pk_bf16(v1[0], v1[1]); w.w = cvt_pk_bf16(v1[2], v1[3]);
                        const int sq = s0 + bj * 128;
                        const size_t off = (u.aux == 1) ? (size_t)((((b * 4 + (rr >> 8)) * 32 + (sq >> 6)) * 2 + ((sq >> 5) & 1)) * 16 + ((rr & 255) >> 4)) * 512 + (size_t)((((sq >> 3) & 3) * 16 + (rr & 15)) * 8)
                                                        : (size_t)(b * 1024 + rr) * 2048 + sq;
                        *(u32x4*)(dst + off) = w; } }
        }
    }
};

__device__ __forceinline__ void gate_unit(ArgsP a, int l, LAS unsigned char* lds, int bh, int tid, int lane, int wave) {
    unsigned char* ws = a->ws;
    {
            const int b = bh >> 2, h = bh & 3;
            LAS float* bl = (LAS float*)lds; LAS float* amx = bl + 32; LAS float* mpv = bl + 64; LAS float* gcv = bl + 96;
            const float* ifg = (const float*)(ws + MS_IFG); const float* ifb = a->in[I_IFB] + l * 8;
            float A[4], Bs[4], CM[4];
#pragma unroll
            for (int cc = 0; cc < 4; ++cc) { const int c = wave + 8 * cc, s = 64 * c + lane; const size_t tok = (size_t)b * SEQ + s;
                const float ig = ifg[tok * 8 + h] + ifb[h], fg = ifg[tok * 8 + 4 + h] + ifb[4 + h];
                const float lf = fminf(fg, 0.f) - log1pf(expf(-fabsf(fg)));
                float bs = lf;
#pragma unroll
                for (int o = 1; o < 64; o <<= 1) { const float t = __shfl_up(bs, o); if (lane >= o) bs += t; }
                const float av = ig - bs; float cm = av;
#pragma unroll
                for (int o = 1; o < 64; o <<= 1) { const float t = __shfl_up(cm, o); if (lane >= o) cm = fmaxf(cm, t); }
                A[cc] = av; Bs[cc] = bs; CM[cc] = cm;
                if (lane == 63) { bl[c] = bs; amx[c] = cm; } }
            __syncthreads();
            if (tid == 0) { float m = 0.f;
#pragma unroll 1
                for (int c = 0; c < 32; ++c) { mpv[c] = m; const float Gm = fmaxf(m, amx[c]); gcv[c] = Gm; m = bl[c] + Gm; } }
            __syncthreads();
            float* AS = (float*)(ws + MS_AS) + bh * 2048; float* GT = (float*)(ws + MS_GT) + bh * 2048; float* WI = (float*)(ws + MS_WI) + bh * 2048;
            float* CL = (float*)(ws + MS_CL) + bh * 2048; float* WSs = (float*)(ws + MS_WS) + bh * 2048; float* DEC = (float*)(ws + MS_DEC) + bh * 32;
#pragma unroll
            for (int cc = 0; cc < 4; ++cc) { const int c = wave + 8 * cc, s = 64 * c + lane; const float mp = mpv[c], Gm = gcv[c], gt = fmaxf(mp, CM[cc]);
                AS[s] = A[cc]; GT[s] = gt; WI[s] = expf(mp - gt); CL[s] = expf(-(Bs[cc] + gt)); WSs[s] = expf(A[cc] - Gm);
                if (lane == 0) DEC[c] = expf(mp - Gm); }
        }
    __syncthreads();
}

__device__ __forceinline__ void conv_phase(ArgsP a, int l, LAS unsigned char* lds, int tid, int lane, int wave, int bid, int G) {
    unsigned char* ws = a->ws;
    u32x4 xv[5];
    const bf16* Z = (const bf16*)(ws + WS_ZQK);
#define CONV_LOAD(u_) do { const int cg_ = (u_) & 7, s0_ = 64 * (((u_) >> 3) & 31), b_ = (u_) >> 8; _Pragma("unroll") for (int i = 0; i < 5; ++i) { \
        const int idx = tid + NTHR * i, row = idx >> 5, ch = idx & 31, sq = s0_ - 3 + row; xv[i] = (u32x4){0u, 0u, 0u, 0u}; \
        if (idx < 67 * 32 && sq >= 0) xv[i] = *(const u32x4*)(Z + (size_t)(b_ * SEQ + sq) * 2048 + cg_ * 256 + ch * 8); } } while (0)
    if (bid < 1024) CONV_LOAD(bid);
    for (int u = bid; u < 1024 + 256; u += G) {
        if (u < 1024) {
            const int cg = u & 7, st = (u >> 3) & 31, b = u >> 8, s0 = 64 * st;
            LAS unsigned char* xt = lds; LAS unsigned char* kt = lds + 36864;
            asm volatile("" : "+v"(xv[0]), "+v"(xv[1]), "+v"(xv[2]), "+v"(xv[3]), "+v"(xv[4]));
#pragma unroll
            for (int i = 0; i < 5; ++i) { const int idx = tid + NTHR * i, row = idx >> 5, ch = idx & 31;
                if (idx < 67 * 32) *(LAS u32x4*)(xt + row * 512 + ch * 16) = xv[i]; }
            LAS float* wst = (LAS float*)(lds + 73728);
            if (cg >= 4 && tid < 64) wst[tid] = ((const float*)(ws + MS_WS))[(size_t)(b * 4 + cg - 4) * 2048 + s0 + tid];
            __syncthreads();
            if (u + G < 1024) CONV_LOAD(u + G);
            const int cp = tid & 127, tg = tid >> 7, c = 2 * cp, gc = cg * 256 + c;
            float w0[4], w1[4];
#pragma unroll
            for (int j = 0; j < 4; ++j) { w0[j] = a->in[I_CONVW][(size_t)(l * 4 + j) * 2048 + gc]; w1[j] = a->in[I_CONVW][(size_t)(l * 4 + j) * 2048 + gc + 1]; }
            bf16* QM = (bf16*)(ws + WS_QM); bf16* KM = (bf16*)(ws + WS_KM);
#pragma unroll 4
            for (int tt = 0; tt < 16; ++tt) { const int t = tg * 16 + tt; float a0 = 0.f, a1 = 0.f;
#pragma unroll
                for (int j = 0; j < 4; ++j) { const unsigned x = *(const LAS unsigned*)(xt + (t + j) * 512 + c * 2); a0 += w0[j] * bflo(x); a1 += w1[j] * bfhi(x); }
                float o0 = a0 * sigmoidf_(a0), o1 = a1 * sigmoidf_(a1);
                const size_t tok = (size_t)b * SEQ + s0 + t;
                if (cg < 4) { *(unsigned*)(QM + tok * 1024 + cg * 256 + c) = cvt_pk_bf16(o0, o1); }
                else { o0 *= 0.0625f; o1 *= 0.0625f; const unsigned p = cvt_pk_bf16(o0, o1);
                    *(unsigned*)(KM + tok * 1024 + (cg - 4) * 256 + c) = p;
                    const float wsv = wst[t]; const unsigned ps = cvt_pk_bf16(o0 * wsv, o1 * wsv);
                    *(LAS unsigned short*)(kt + c * 144 + t * 2) = (unsigned short)(ps & 0xffffu); *(LAS unsigned short*)(kt + (c + 1) * 144 + t * 2) = (unsigned short)(ps >> 16); }
            }
            if (cg >= 4) {
                __syncthreads();
                bf16* KMT = (bf16*)(ws + WS_KMT);
                for (int idx = tid; idx < 2048; idx += NTHR) {
                    const int ks = idx >> 10, dtl = (idx >> 6) & 15, ln = idx & 63, row = dtl * 16 + (ln & 15), ch = ks * 4 + (ln >> 4);
                    const u32x4 v = *(const LAS u32x4*)(kt + row * 144 + ch * 16);
                    *(u32x4*)(KMT + (size_t)(((b * 4 + cg - 4) * 32 + st) * 2) * 8192 + (size_t)idx * 8) = v; }
                if (tid < 256) {
                    float sm = 0.f;
#pragma unroll
                    for (int i = 0; i < 8; ++i) { const u32x4 v = *(const LAS u32x4*)(kt + tid * 144 + i * 16);
                        sm += (bflo(v.x) + bfhi(v.x)) + (bflo(v.y) + bfhi(v.y)) + (bflo(v.z) + bfhi(v.z)) + (bflo(v.w) + bfhi(v.w)); }
                    ((float*)(ws + MS_NST))[(size_t)((b * 4 + cg - 4) * 32 + st) * 256 + tid] = sm; }
            }
        } else if (u < 1280) {
            const int j = u - 1024, b = j >> 6, n = (j >> 3) & 7, h = j & 7;
            const bf16* KA = (const bf16*)(ws + WS_KA) + (size_t)(b * SEQ + n * 256 + wave * 32) * 1024 + h * 128 + 2 * lane;
            float s0 = 0.f, s1 = 0.f;
            unsigned xr[32];
#pragma unroll
            for (int r = 0; r < 32; ++r) xr[r] = *(const unsigned*)(KA + (size_t)r * 1024);
#pragma unroll
            for (int r = 0; r < 32; r += 8) asm volatile("" : "+v"(xr[r]), "+v"(xr[r + 1]), "+v"(xr[r + 2]), "+v"(xr[r + 3]), "+v"(xr[r + 4]), "+v"(xr[r + 5]), "+v"(xr[r + 6]), "+v"(xr[r + 7]));
#pragma unroll
            for (int r = 0; r < 32; ++r) { s0 += bflo(xr[r]); s1 += bfhi(xr[r]); }
            LAS float* part = (LAS float*)lds;
            part[wave * 128 + 2 * lane] = s0; part[wave * 128 + 2 * lane + 1] = s1;
            __syncthreads();
            if (tid < 128) { float t = 0.f;
#pragma unroll
                for (int w = 0; w < 8; ++w) t += part[w * 128 + tid];
                ((float*)(ws + MS_KMEAN))[(size_t)((b * 8 + h) * 8 + n) * 128 + tid] = t * (1.0f / 256.0f); }
        }
        __syncthreads();
    }
}

#undef CONV_LOAD
__device__ __forceinline__ void mlstm_ab_task(unsigned char* ws, int gw, int lane, const bool do_store = true) {
    const int bh = gw >> 7, piece = gw & 127, e0 = (piece >> 3) * 16, d0 = (piece & 7) * 32, q16 = lane & 15, g = lane >> 4;
    const bf16* ka = (const bf16*)(ws + WS_KMT) + (size_t)bh * 32 * 16384 + (size_t)(d0 >> 4) * 512 + lane * 8;
    const bf16* vb = (const bf16*)(ws + WS_VMT) + (size_t)bh * 32 * 16384 + (size_t)(e0 >> 4) * 512 + lane * 8;
    const float* DEC = (const float*)(ws + MS_DEC) + bh * 32;
    bf16* CST = (bf16*)(ws + WS_CST) + (size_t)bh * 32 * 65536 + (size_t)((d0 >> 5) * 16 + (e0 >> 4)) * 512 + (size_t)(((g >> 1) * 16 + q16) * 8 + 4 * (g & 1));
    f32x4 acc[2]; acc[0] = (f32x4){0.f, 0.f, 0.f, 0.f}; acc[1] = acc[0];
    const int decv = __builtin_bit_cast(int, DEC[lane & 31]);
    bf16x8 A0[2][2], B0[2], A1[2][2], B1[2], A2[2][2], B2[2], A3[2][2], B3[2], A4[2][2], B4[2];
#define AB_LOAD(c_, A_, B_) do { const int cc_ = (c_) < 31 ? (c_) : 31; _Pragma("unroll") for (int ks = 0; ks < 2; ++ks) { \
        A_[0][ks] = *(const bf16x8*)(ka + (size_t)cc_ * 16384 + ks * 8192); A_[1][ks] = *(const bf16x8*)(ka + (size_t)cc_ * 16384 + ks * 8192 + 512); B_[ks] = *(const bf16x8*)(vb + (size_t)cc_ * 16384 + ks * 8192); } } while (0)
#define AB_STEP(c_, A_, B_) do { \
        if (do_store) { _Pragma("unroll") for (int f = 0; f < 2; ++f) { u32x2 w; w.x = cvt_pk_bf16(acc[f][0], acc[f][1]); w.y = cvt_pk_bf16(acc[f][2], acc[f][3]); *(u32x2*)(CST + (size_t)(c_) * 65536 + 256 * f) = w; } } \
        const float dec = __builtin_bit_cast(float, __builtin_amdgcn_readlane(decv, (c_))); \
        acc[0] = acc[0] * dec; acc[1] = acc[1] * dec; \
        _Pragma("unroll") for (int ks = 0; ks < 2; ++ks) { \
            acc[0] = __builtin_amdgcn_mfma_f32_16x16x32_bf16(A_[0][ks], B_[ks], acc[0], 0, 0, 0); \
            acc[1] = __builtin_amdgcn_mfma_f32_16x16x32_bf16(A_[1][ks], B_[ks], acc[1], 0, 0, 0); } } while (0)
    AB_LOAD(0, A0, B0); AB_LOAD(1, A1, B1); AB_LOAD(2, A2, B2); AB_LOAD(3, A3, B3); AB_LOAD(4, A4, B4);
#pragma unroll 1
    for (int c = 0; c < 30; c += 5) {
        AB_STEP(c, A0, B0); AB_LOAD(c + 5, A0, B0);
        AB_STEP(c + 1, A1, B1); AB_LOAD(c + 6, A1, B1);
        AB_STEP(c + 2, A2, B2); AB_LOAD(c + 7, A2, B2);
        AB_STEP(c + 3, A3, B3); AB_LOAD(c + 8, A3, B3);
        AB_STEP(c + 4, A4, B4); AB_LOAD(c + 9, A4, B4);
    }
    AB_STEP(30, A0, B0); AB_STEP(31, A1, B1);
    if (!do_store) asm volatile("" :: "v"(acc[0]), "v"(acc[1]));
#undef AB_LOAD
#undef AB_STEP
}

__device__ __forceinline__ void nscan_task(unsigned char* ws, int t, int lane) {
    const int bh = t >> 2, d = (t & 3) * 64 + lane;
    const float* cs = (const float*)(ws + MS_NST) + (size_t)bh * 32 * 256 + d;
    float* nv = (float*)(ws + MS_NVEC) + (size_t)bh * 32 * 256 + d;
    const int decv = __builtin_bit_cast(int, ((const float*)(ws + MS_DEC))[bh * 32 + (lane & 31)]);
    float v[32];
#pragma unroll
    for (int j = 0; j < 32; ++j) v[j] = cs[j * 256];
    float n = 0.f;
#pragma unroll
    for (int j = 0; j < 32; ++j) { nv[j * 256] = n; n = __builtin_bit_cast(float, __builtin_amdgcn_readlane(decv, j)) * n + v[j]; }
}

__device__ __forceinline__ int rel_bucket_dev(int n) {
    if (n < 16) return n;
    int b = 16;
    b += (n >= 19); b += (n >= 21); b += (n >= 24); b += (n >= 27); b += (n >= 31); b += (n >= 35); b += (n >= 40); b += (n >= 46);
    b += (n >= 52); b += (n >= 59); b += (n >= 67); b += (n >= 77); b += (n >= 87); b += (n >= 99); b += (n >= 113);
    return b;
}
constexpr int AT_KT = 0, AT_VT = 34816, AT_TAB = 71680, AT_SEL = 72704, AT_TILES = 73216, AT_CTL = 73600, AT_KM = 73728;
__device__ __forceinline__ void attn_unit(ArgsP a, LAS unsigned char* lds, int uidx, int tid, int lane, int wave) {
    unsigned char* ws = a->ws;
    const int u256 = uidx & 255, second = uidx >> 8, bh = u256 >> 3, kk8 = u256 & 7, si = second ? 15 - kk8 : kk8, wgt = 16 - si;
    const int blk = (wgt - 1) >> 1, half = (wgt - 1) & 1, b = bh >> 3, h = bh & 7, q0 = blk * 256 + half * 128;
    const int q16 = lane & 15, g = lane >> 4;
    LAS float* tab = (LAS float*)(lds + AT_TAB); LAS unsigned* sels = (LAS unsigned*)(lds + AT_SEL); LAS int* tiles = (LAS int*)(lds + AT_TILES);
    LAS unsigned* ctl = (LAS unsigned*)(lds + AT_CTL); LAS float* kms = (LAS float*)(lds + AT_KM);
    const bf16* QA = (const bf16*)(ws + WS_QA); const bf16* KA = (const bf16*)(ws + WS_KA); const bf16* VAT = (const bf16*)(ws + WS_VAT);
    u32x4 sr[8], qst[4];
    const int row0 = tid >> 4, ch = tid & 15;
    const bf16* kbase = KA + (size_t)(b * SEQ + row0) * 1024 + h * 128 + ch * 8;
    const bf16* vbase = VAT + (size_t)(bh * 128 + row0) * 2048 + ch * 8;
#define AT_LOAD(ks0_) do { _Pragma("unroll") for (int i = 0; i < 4; ++i) { \
        sr[i] = *(const u32x4*)(kbase + (size_t)((ks0_) + 32 * i) * 1024); sr[4 + i] = *(const u32x4*)(vbase + (size_t)(32 * i) * 2048 + (ks0_)); } } while (0)
#pragma unroll
    for (int i = 0; i < 4; ++i) qst[i] = *(const u32x4*)(QA + (size_t)(b * SEQ + q0 + row0 + 32 * i) * 1024 + h * 128 + ch * 8);
    AT_LOAD(blk * 256);
    if (tid <= 128) tab[tid] = a->in[I_RELB][rel_bucket_dev(tid) * 8 + h] * 1.4426950408889634f;
    for (int idx = tid; idx < 1024; idx += NTHR) kms[idx] = ((const float*)(ws + MS_KMEAN))[bh * 1024 + idx];
    if (tid == 0) ctl[0] = 0u;
    __syncthreads();
    {
        const int q = tid >> 2, part = tid & 3;
        const bf16* qp = QA + (size_t)(b * SEQ + q0 + q) * 1024 + h * 128 + part * 32;
        float qf32[32];
#pragma unroll
        for (int i = 0; i < 4; ++i) { const u32x4 v = *(const u32x4*)(qp + 8 * i);
            qf32[8 * i + 0] = bflo(v.x); qf32[8 * i + 1] = bfhi(v.x); qf32[8 * i + 2] = bflo(v.y); qf32[8 * i + 3] = bfhi(v.y);
            qf32[8 * i + 4] = bflo(v.z); qf32[8 * i + 5] = bfhi(v.z); qf32[8 * i + 6] = bflo(v.w); qf32[8 * i + 7] = bfhi(v.w); }
        float gate[8];
#pragma unroll
        for (int n = 0; n < 8; ++n) { float s = 0.f;
            if (n < blk) {
#pragma unroll
                for (int d = 0; d < 32; d += 4) { const f32x4 kv = *(const LAS f32x4*)(kms + n * 128 + part * 32 + d);
                    s += (qf32[d] * kv.x + qf32[d + 1] * kv.y) + (qf32[d + 2] * kv.z + qf32[d + 3] * kv.w); }
            }
            s += __shfl_xor(s, 1); s += __shfl_xor(s, 2); gate[n] = s; }
        if (part == 0) {
            unsigned sel;
            if (blk <= 3) sel = (1u << blk) - 1u;
            else { sel = 0u;
#pragma unroll
                for (int it = 0; it < 3; ++it) { int best = 0; float bv = -3.0e38f;
#pragma unroll
                    for (int n = 0; n < 8; ++n) if (n < blk && !((sel >> n) & 1u) && gate[n] > bv) { bv = gate[n]; best = n; }
                    sel |= 1u << best; } }
            sels[q] = sel; atomicOr((unsigned*)ctl, sel);
        }
    }
    __syncthreads();
    if (tid == 0) { int nt = 0; const unsigned any = ctl[0];
        for (int j = 0; j < half + 1; ++j) tiles[nt++] = blk * 256 + 128 * j;
        for (int n = 0; n < blk; ++n) if ((any >> n) & 1u) for (int j = 0; j < 2; ++j) tiles[nt++] = n * 256 + 128 * j;
        ctl[1] = (unsigned)nt; }
    __syncthreads();
    const int ntiles = (int)ctl[1];
    const int qg = wave & 3, kp = wave >> 2;
    int qpos[2]; unsigned mysel[2];
#pragma unroll
    for (int f = 0; f < 2; ++f) { qpos[f] = q0 + 32 * qg + 16 * f + q16; mysel[f] = sels[32 * qg + 16 * f + q16]; }
    constexpr int AT_Q = 77824;
#pragma unroll
    for (int i = 0; i < 4; ++i) *(LAS u32x4*)(lds + AT_Q + (row0 + 32 * i) * 272 + ch * 16) = qst[i];
    const LAS unsigned char* qrow = lds + AT_Q + (32 * qg + q16) * 272 + 16 * g;
    float m_run[2] = {-1.0e30f, -1.0e30f}, l_run[2] = {0.f, 0.f};
    f32x4 oacc[2][8];
#pragma unroll
    for (int f = 0; f < 2; ++f)
#pragma unroll
        for (int m = 0; m < 8; ++m) oacc[f][m] = (f32x4){0.f, 0.f, 0.f, 0.f};
    const int vpos = (ch >> 2) * 32 + 16 * (ch & 1) + 4 * ((ch & 3) >> 1);
#define AT_WRITE() do { _Pragma("unroll") for (int i = 0; i < 4; ++i) { \
        *(LAS u32x4*)(lds + AT_KT + (row0 + 32 * i) * 272 + ch * 16) = sr[i]; \
        *(LAS u32x2*)(lds + AT_VT + (row0 + 32 * i) * 272 + vpos * 2) = (u32x2){sr[4 + i].x, sr[4 + i].y}; \
        *(LAS u32x2*)(lds + AT_VT + (row0 + 32 * i) * 272 + (vpos + 8) * 2) = (u32x2){sr[4 + i].z, sr[4 + i].w}; } } while (0)
    AT_WRITE();
    __syncthreads();
    if (ntiles > 1) { const int k1 = tiles[1]; AT_LOAD(k1); }
    for (int ti = 0; ti < ntiles; ++ti) {
        const int kstart = tiles[ti] + 64 * kp, nblk = kstart >> 8;
        const bool own = (nblk == blk);
        const bool any_ok = own ? true : (__any((((mysel[0] | mysel[1]) >> nblk) & 1u) != 0u) != 0);
        const bool active = own ? (kstart <= q0 + 32 * qg + 31) : any_ok;
        if (active) {
            const LAS unsigned char* kt = lds + AT_KT + 64 * kp * 272; const LAS unsigned char* vt = lds + AT_VT + 64 * kp * 2;
            f32x4 s[2][4];
#pragma unroll
            for (int n = 0; n < 4; ++n) { s[0][n] = (f32x4){0.f, 0.f, 0.f, 0.f}; s[1][n] = s[0][n]; }
#pragma unroll
            for (int ks = 0; ks < 4; ++ks) {
                bf16x8 q0f = *(const LAS bf16x8*)(qrow + 64 * ks), q1f = *(const LAS bf16x8*)(qrow + 16 * 272 + 64 * ks);
                bf16x8 kf[4];
#pragma unroll
                for (int n = 0; n < 4; ++n) kf[n] = *(const LAS bf16x8*)(kt + (16 * n + q16) * 272 + (32 * ks + 8 * g) * 2);
                asm volatile("" : "+v"(q0f), "+v"(q1f), "+v"(kf[0]), "+v"(kf[1]), "+v"(kf[2]), "+v"(kf[3]));
#pragma unroll
                for (int n = 0; n < 4; ++n) {
                    s[0][n] = __builtin_amdgcn_mfma_f32_16x16x32_bf16(kf[n], q0f, s[0][n], 0, 0, 0);
                    s[1][n] = __builtin_amdgcn_mfma_f32_16x16x32_bf16(kf[n], q1f, s[1][n], 0, 0, 0); } }
            const bool far = ((q0 + 32 * qg) - (kstart + 63)) >= 128;
            const float bfar = tab[128];
            float alpha[2];
#pragma unroll
            for (int f = 0; f < 2; ++f) {
                const bool lane_ok = own ? true : (((mysel[f] >> nblk) & 1u) != 0u);
                const int kmax = lane_ok ? (own ? qpos[f] : 0x7fffffff) : -1;
                float mx = -1.0e30f;
                float bs[4][4];
                if (far) {
#pragma unroll
                    for (int n = 0; n < 4; ++n)
#pragma unroll
                        for (int r = 0; r < 4; ++r) bs[n][r] = bfar;
                } else {
#pragma unroll
                    for (int n = 0; n < 4; ++n)
#pragma unroll
                        for (int r = 0; r < 4; ++r) { int di = qpos[f] - (kstart + 16 * n + 4 * g + r); di = di < 0 ? 0 : di; di = di > 128 ? 128 : di; bs[n][r] = tab[di]; }
                }
#pragma unroll
                for (int n = 0; n < 4; ++n) asm volatile("" : "+v"(bs[n][0]), "+v"(bs[n][1]), "+v"(bs[n][2]), "+v"(bs[n][3]));
#pragma unroll
                for (int n = 0; n < 4; ++n)
#pragma unroll
                    for (int r = 0; r < 4; ++r) { const int key = kstart + 16 * n + 4 * g + r;
                        const float v = (key <= kmax) ? s[f][n][r] + bs[n][r] : -1.0e30f;
                        s[f][n][r] = v; mx = fmaxf(mx, v); }
                mx = rows4_max(mx);
                const float m_new = fmaxf(fmaxf(m_run[f], mx), -1.0e29f);
                alpha[f] = __builtin_amdgcn_exp2f(m_run[f] - m_new);
                float psum = 0.f;
#pragma unroll
                for (int n = 0; n < 4; ++n)
#pragma unroll
                    for (int r = 0; r < 4; ++r) { const float p = __builtin_amdgcn_exp2f(s[f][n][r] - m_new); s[f][n][r] = p; psum += p; }
                psum = rows4_sum(psum);
                l_run[f] = l_run[f] * alpha[f] + psum; m_run[f] = m_new;
#pragma unroll
                for (int m = 0; m < 8; ++m) oacc[f][m] = oacc[f][m] * alpha[f];
            }
#pragma unroll
            for (int k2 = 0; k2 < 2; ++k2) {
                bf16x8 pf[2];
#pragma unroll
                for (int f = 0; f < 2; ++f) { u32x4 pb; pb.x = cvt_pk_bf16(s[f][2 * k2][0], s[f][2 * k2][1]); pb.y = cvt_pk_bf16(s[f][2 * k2][2], s[f][2 * k2][3]);
                    pb.z = cvt_pk_bf16(s[f][2 * k2 + 1][0], s[f][2 * k2 + 1][1]); pb.w = cvt_pk_bf16(s[f][2 * k2 + 1][2], s[f][2 * k2 + 1][3]);
                    pf[f] = __builtin_bit_cast(bf16x8, pb); }
#pragma unroll
                for (int mh = 0; mh < 2; ++mh) {
                    bf16x8 af[4];
#pragma unroll
                    for (int m = 0; m < 4; ++m) af[m] = *(const LAS bf16x8*)(vt + (16 * (4 * mh + m) + q16) * 272 + (32 * k2 + 8 * g) * 2);
                    asm volatile("" : "+v"(af[0]), "+v"(af[1]), "+v"(af[2]), "+v"(af[3]));
#pragma unroll
                    for (int m = 0; m < 4; ++m) {
                        oacc[0][4 * mh + m] = __builtin_amdgcn_mfma_f32_16x16x32_bf16(af[m], pf[0], oacc[0][4 * mh + m], 0, 0, 0);
                        oacc[1][4 * mh + m] = __builtin_amdgcn_mfma_f32_16x16x32_bf16(af[m], pf[1], oacc[1][4 * mh + m], 0, 0, 0); } }
            }
        }
        __syncthreads();
        if (ti + 1 < ntiles) { AT_WRITE(); }
        __syncthreads();
        if (ti + 2 < ntiles) { const int kn = tiles[ti + 2]; AT_LOAD(kn); }
    }
    LAS float* mo = (LAS float*)lds; LAS float* ml = (LAS float*)(lds + 65536);
    if (kp == 1) {
#pragma unroll
        for (int f = 0; f < 2; ++f) {
#pragma unroll
            for (int m = 0; m < 8; ++m)
#pragma unroll
                for (int r = 0; r < 4; ++r) mo[((qg * 2 + f) * 8 + m) * 256 + r * 64 + lane] = oacc[f][m][r];
            ml[(qg * 2 + f) * 128 + lane] = m_run[f]; ml[(qg * 2 + f) * 128 + 64 + lane] = l_run[f]; }
    }
    __syncthreads();
    if (kp == 0) {
#pragma unroll
        for (int f = 0; f < 2; ++f) {
            const float m1 = ml[(qg * 2 + f) * 128 + lane], l1 = ml[(qg * 2 + f) * 128 + 64 + lane];
            const float mm = fmaxf(m_run[f], m1), a0 = __builtin_amdgcn_exp2f(m_run[f] - mm), a1 = __builtin_amdgcn_exp2f(m1 - mm);
            const float inv = __builtin_amdgcn_rcpf(l_run[f] * a0 + l1 * a1);
            bf16* HA = (bf16*)(ws + WS_HA) + (size_t)(b * SEQ + qpos[f]) * 1024 + h * 128 + 4 * g;
#pragma unroll
            for (int m = 0; m < 8; ++m) { float o[4];
#pragma unroll
                for (int r = 0; r < 4; ++r) o[r] = (oacc[f][m][r] * a0 + mo[((qg * 2 + f) * 8 + m) * 256 + r * 64 + lane] * a1) * inv;
                u32x2 w; w.x = cvt_pk_bf16(o[0], o[1]); w.y = cvt_pk_bf16(o[2], o[3]); *(u32x2*)(HA + 16 * m) = w; }
        }
    }
#undef AT_LOAD
#undef AT_WRITE
}

constexpr int MC_Q = 0, MC_K = 33792, MC_SP = 67584, MC_SC = 76800, MC_NV = 79104;
struct McRegs { u32x4 qr[4], kr[4]; float sc4[4]; float nv0; bf16x8 cb[8][2], vbf[2][2]; u32x2 ovv[8]; };
__device__ __forceinline__ void mc_load_qk(McRegs& R, const unsigned char* ws, int u, int tid) {
    const int bh = u >> 5, c = u & 31, b = bh >> 2, h = bh & 3; const size_t tok0 = (size_t)b * SEQ + 64 * c;
    const bf16* QM = (const bf16*)(ws + WS_QM); const bf16* KM = (const bf16*)(ws + WS_KM);
#pragma unroll
    for (int i = 0; i < 4; ++i) { const int idx = tid + NTHR * i, row = idx >> 5, ch = idx & 31;
        R.qr[i] = *(const u32x4*)(QM + (tok0 + row) * 1024 + h * 256 + ch * 8); R.kr[i] = *(const u32x4*)(KM + (tok0 + row) * 1024 + h * 256 + ch * 8); }
}
__device__ __forceinline__ void mc_load_sc(McRegs& R, const unsigned char* ws, int u, int tid) {
    const int bh = u >> 5, c = u & 31; const int s = bh * 2048 + 64 * c + (tid & 63);
    R.sc4[0] = ((const float*)(ws + MS_AS))[s]; R.sc4[1] = ((const float*)(ws + MS_GT))[s]; R.sc4[2] = ((const float*)(ws + MS_WI))[s]; R.sc4[3] = ((const float*)(ws + MS_CL))[s];
    R.nv0 = ((const float*)(ws + MS_NVEC))[(size_t)(bh * 32 + c) * 256 + (tid & 255)];
}
__device__ __forceinline__ void mc_load_cb(McRegs& R, const unsigned char* ws, int u, int lane, int wave) {
    const bf16* Cp = (const bf16*)(ws + WS_CST) + (size_t)u * 65536 + (size_t)(2 * wave) * 512 + lane * 8;
#pragma unroll
    for (int ks = 0; ks < 8; ++ks) { R.cb[ks][0] = *(const bf16x8*)(Cp + ks * 8192); R.cb[ks][1] = *(const bf16x8*)(Cp + ks * 8192 + 512); }
}
__device__ __forceinline__ void mc_load_v(McRegs& R, const unsigned char* ws, int u, int lane, int wave) {
    const bf16* Vp = (const bf16*)(ws + WS_VMT) + (size_t)u * 16384 + (size_t)(2 * wave) * 512 + lane * 8;
#pragma unroll
    for (int ks = 0; ks < 2; ++ks) { R.vbf[ks][0] = *(const bf16x8*)(Vp + ks * 8192); R.vbf[ks][1] = *(const bf16x8*)(Vp + ks * 8192 + 512); }
}
__device__ __forceinline__ void mc_load_ov(McRegs& R, const unsigned char* ws, int u, int lane, int wave) {
    const int bh = u >> 5, c = u & 31, b = bh >> 2, h = bh & 3; const size_t tok0 = (size_t)b * SEQ + 64 * c;
    const bf16* OM = (const bf16*)(ws + WS_OM);
#pragma unroll
    for (int i = 0; i < 8; ++i) R.ovv[i] = *(const u32x2*)(OM + (tok0 + 8 * wave + i) * 1024 + h * 256 + 4 * lane);
}
template <bool PF, bool HAVE>
__device__ __forceinline__ void mlstm_c_body(ArgsP a, int l, LAS unsigned char* lds, int u, int un, McRegs& R, int tid_, int lane_, int wave) {
    unsigned char* ws = a->ws;
    int tid = wave * 64 + lane_id(); asm volatile("" : "+v"(tid));
    const int lane = tid & 63; (void)tid_; (void)lane_;
    const int bh = u >> 5, c = u & 31, b = bh >> 2, h = bh & 3, t0 = 64 * c, q16 = lane & 15, g = lane >> 4;
    const size_t tok0 = (size_t)b * SEQ + t0;
    LAS unsigned char* Qs = lds + MC_Q; LAS unsigned char* Ks = lds + MC_K; LAS unsigned char* Sp = lds + MC_SP;
    LAS float* sc = (LAS float*)(lds + MC_SC); LAS float* as_ = sc; LAS float* gt_ = sc + 64; LAS float* wi_ = sc + 128; LAS float* cl_ = sc + 192; LAS float* qn_ = sc + 256; LAS float* denp = sc + 320;
    LAS float* nvec = (LAS float*)(lds + MC_NV);
    mc_load_qk(R, ws, u, tid); mc_load_sc(R, ws, u, tid);
    if (!HAVE) mc_load_cb(R, ws, u, lane, wave);
#pragma unroll
    for (int i = 0; i < 4; ++i) { const int idx = tid + NTHR * i, row = idx >> 5, ch = idx & 31;
        *(LAS u32x4*)(Qs + row * 528 + ch * 16) = R.qr[i]; *(LAS u32x4*)(Ks + row * 528 + ch * 16) = R.kr[i]; }
    mc_load_v(R, ws, u, lane, wave);
    if (tid < 64) { as_[tid] = R.sc4[0]; gt_[tid] = R.sc4[1]; wi_[tid] = R.sc4[2]; cl_[tid] = R.sc4[3]; }
    if (tid < 256) nvec[tid] = R.nv0;
    __syncthreads();
    f32x4 acc[4][2];
#pragma unroll
    for (int m = 0; m < 4; ++m) { acc[m][0] = (f32x4){0.f, 0.f, 0.f, 0.f}; acc[m][1] = acc[m][0]; }
    if (c > 0) {
#pragma unroll
        for (int ks = 0; ks < 8; ++ks) {
#pragma unroll
            for (int m = 0; m < 4; ++m) { const bf16x8 af = *(const LAS bf16x8*)(Qs + (16 * m + q16) * 528 + (32 * ks + 8 * g) * 2);
                acc[m][0] = __builtin_amdgcn_mfma_f32_16x16x32_bf16(af, R.cb[ks][0], acc[m][0], 0, 0, 0);
                acc[m][1] = __builtin_amdgcn_mfma_f32_16x16x32_bf16(af, R.cb[ks][1], acc[m][1], 0, 0, 0); }
        }
#pragma unroll
        for (int m = 0; m < 4; ++m)
#pragma unroll
            for (int r = 0; r < 4; ++r) { const float w = wi_[16 * m + 4 * g + r]; acc[m][0][r] *= w; acc[m][1][r] *= w; }
    }
    {
        const int mS = wave & 3, nS0 = 2 * (wave >> 2);
        f32x4 sacc[2]; sacc[0] = (f32x4){0.f, 0.f, 0.f, 0.f}; sacc[1] = sacc[0];
#pragma unroll
        for (int kh = 0; kh < 4; ++kh) {
            bf16x8 af[2], bq[2][2];
#pragma unroll
            for (int k2 = 0; k2 < 2; ++k2) { const int ks = 2 * kh + k2;
                af[k2] = *(const LAS bf16x8*)(Qs + (16 * mS + q16) * 528 + (32 * ks + 8 * g) * 2);
#pragma unroll
                for (int nn = 0; nn < 2; ++nn) bq[k2][nn] = *(const LAS bf16x8*)(Ks + (16 * (nS0 + nn) + q16) * 528 + (32 * ks + 8 * g) * 2); }
            asm volatile("" : "+v"(af[0]), "+v"(af[1]), "+v"(bq[0][0]), "+v"(bq[0][1]), "+v"(bq[1][0]), "+v"(bq[1][1]));
#pragma unroll
            for (int k2 = 0; k2 < 2; ++k2)
#pragma unroll
                for (int nn = 0; nn < 2; ++nn) sacc[nn] = __builtin_amdgcn_mfma_f32_16x16x32_bf16(af[k2], bq[k2][nn], sacc[nn], 0, 0, 0);
        }
#pragma unroll
        for (int nn = 0; nn < 2; ++nn) { const int s = 16 * (nS0 + nn) + q16; const float av = as_[s];
#pragma unroll
            for (int r = 0; r < 4; ++r) { const int t = 16 * mS + 4 * g + r;
                float val = (s <= t) ? sacc[nn][r] * __expf(av - gt_[t]) : 0.f;
                *(LAS unsigned short*)(Sp + t * 144 + s * 2) = (unsigned short)(cvt_pk_bf16(val, val) & 0xffffu);
                val += __shfl_xor(val, 1); val += __shfl_xor(val, 2); val += __shfl_xor(val, 4); val += __shfl_xor(val, 8);
                if (q16 == 0) denp[(nS0 + nn) * 64 + t] = val; } }
    }
    {
        const int t = tid >> 3, seg = tid & 7; float s = 0.f;
#pragma unroll
        for (int i = 0; i < 4; ++i) { const u32x4 v = *(const LAS u32x4*)(Qs + t * 528 + (seg * 32 + 8 * i) * 2); const LAS float* nv = nvec + seg * 32 + 8 * i;
            s += bflo(v.x) * nv[0] + bfhi(v.x) * nv[1] + bflo(v.y) * nv[2] + bfhi(v.y) * nv[3] + bflo(v.z) * nv[4] + bfhi(v.z) * nv[5] + bflo(v.w) * nv[6] + bfhi(v.w) * nv[7]; }
        s += __shfl_xor(s, 1); s += __shfl_xor(s, 2); s += __shfl_xor(s, 4);
        if (seg == 0) qn_[t] = s;
    }
    __syncthreads();
    if (PF) {
#pragma unroll
        for (int ks = 0; ks < 8; ++ks) asm volatile("" :: "v"(R.cb[ks][0]), "v"(R.cb[ks][1]));
        __builtin_amdgcn_sched_barrier(0);
        mc_load_cb(R, ws, un, lane, wave);
        __builtin_amdgcn_sched_barrier(0);
    }
    {
#pragma unroll
        for (int ks = 0; ks < 2; ++ks) {
            bf16x8 sf[4];
#pragma unroll
            for (int m = 0; m < 4; ++m) sf[m] = *(const LAS bf16x8*)(Sp + (16 * m + q16) * 144 + (32 * ks + 8 * g) * 2);
            asm volatile("" : "+v"(sf[0]), "+v"(sf[1]), "+v"(sf[2]), "+v"(sf[3]));
#pragma unroll
            for (int m = 0; m < 4; ++m) {
                acc[m][0] = __builtin_amdgcn_mfma_f32_16x16x32_bf16(sf[m], R.vbf[ks][0], acc[m][0], 0, 0, 0);
                acc[m][1] = __builtin_amdgcn_mfma_f32_16x16x32_bf16(sf[m], R.vbf[ks][1], acc[m][1], 0, 0, 0); }
        }
    }
    LAS float* NUM = (LAS float*)lds;
#pragma unroll
    for (int m = 0; m < 4; ++m)
#pragma unroll
        for (int r = 0; r < 4; ++r) { const int t = 16 * m + 4 * g + r;
            const float den = (denp[t] + denp[64 + t]) + (denp[128 + t] + denp[192 + t]) + wi_[t] * qn_[t];
            const float inv = __builtin_amdgcn_rcpf(fmaxf(fabsf(den), cl_[t]));
            NUM[t * 260 + 32 * wave + q16] = acc[m][0][r] * inv; NUM[t * 260 + 32 * wave + 16 + q16] = acc[m][1][r] * inv; }
    __syncthreads();
    {
        const float* mg = a->in[I_MNG] + l * 1024 + h * 256 + 4 * lane; const f32x4 gn = *(const f32x4*)mg;
        bf16* HM = (bf16*)(ws + WS_HM);
        mc_load_ov(R, ws, u, lane, wave);
        asm volatile("" : "+v"(R.ovv[0]), "+v"(R.ovv[1]), "+v"(R.ovv[2]), "+v"(R.ovv[3]), "+v"(R.ovv[4]), "+v"(R.ovv[5]), "+v"(R.ovv[6]), "+v"(R.ovv[7]));
#pragma unroll
        for (int i = 0; i < 8; ++i) { const int t = 8 * wave + i;
            const f32x4 v = *(const LAS f32x4*)(NUM + t * 260 + 4 * lane);
            const float mu = wave_sum((v.x + v.y) + (v.z + v.w)) * (1.0f / 256.0f);
            const f32x4 d = v - mu;
            const float var = wave_sum((d.x * d.x + d.y * d.y) + (d.z * d.z + d.w * d.w)) * (1.0f / 256.0f);
            const float rstd = __builtin_amdgcn_rsqf(var + LN_EPS);
            const u32x2 ov = R.ovv[i];
            u32x2 w; w.x = cvt_pk_bf16(d.x * rstd * gn.x * bflo(ov.x), d.y * rstd * gn.y * bfhi(ov.x)); w.y = cvt_pk_bf16(d.z * rstd * gn.z * bflo(ov.y), d.w * rstd * gn.w * bfhi(ov.y));
            *(u32x2*)(HM + (tok0 + t) * 1024 + h * 256 + 4 * lane) = w; }
    }
    __syncthreads();
}
__device__ __forceinline__ void mlstm_c_phase(ArgsP a, int l, LAS unsigned char* lds, int tid, int lane, int wave, int bid, int G) {
    int u = bid; if (u >= 512) return;
    McRegs R;
    if (u + G < 512 && u + 2 * G >= 512) {
        mlstm_c_body<true, false>(a, l, lds, u, u + G, R, tid, lane, wave);
        mlstm_c_body<false, true>(a, l, lds, u + G, u + G, R, tid, lane, wave);
    } else {
#pragma unroll 1
        for (; u < 512; u += G) mlstm_c_body<false, false>(a, l, lds, u, u, R, tid, lane, wave);
    }
}

struct SchedStd {
    static constexpr bool GATHER = false;
    const char* A; const char* B; int nM, nN, K, G, c;
    __device__ __forceinline__ bool next(int i, Unit& u) const { const int L = i * G + c; if (L >= nM * nN) return false; pg8::static_tile(L, nM, nN, u.pm, u.pn); u.aux = 0; return true; }
    __device__ __forceinline__ const char* abase(const Unit& u) const { return A + (size_t)u.pm * 512 * K; }
    __device__ __forceinline__ const char* bbase(const Unit& u) const { return B + (size_t)u.pn * 512 * K; }
    __device__ __forceinline__ unsigned arow(const Unit&, int) const { return 0u; }
    static __device__ __forceinline__ bool keep_acc(const Unit&) { return false; }
};
struct SchedBr {
    static constexpr bool GATHER = false;
    const char* HM; const char* HA; const char* WM; const char* WA; int G, c;
    __device__ __forceinline__ bool next(int i, Unit& u) const { const int L = (i >> 1) * G + c; if (L >= 256) return false; pg8::static_tile(L, 32, 8, u.pm, u.pn); u.aux = i & 1; return true; }
    __device__ __forceinline__ const char* abase(const Unit& u) const { return (u.aux ? HA : HM) + (size_t)u.pm * 512 * 1024; }
    __device__ __forceinline__ const char* bbase(const Unit& u) const { return (u.aux ? WA : WM) + (size_t)u.pn * 512 * 1024; }
    __device__ __forceinline__ unsigned arow(const Unit&, int) const { return 0u; }
    static __device__ __forceinline__ bool keep_acc(const Unit& u) { return u.aux == 0; }
};
struct EpiBr {
    static constexpr bool PERM = true;
    const bf16* SG; bf16* Y;
    __device__ __forceinline__ void operator()(f32x4 (&acc)[2][2][4][2], const Unit& u, int wr, int wc, int fr, int fq) const {
        const int row0 = u.pm * 256 + wr * 64 + fr, col0 = u.pn * 256 + wc * 32 + 8 * fq;
#pragma unroll
        for (int ai = 0; ai < 2; ++ai) {
            u32x4 sa[4][2], sm[4][2];
#pragma unroll
            for (int m = 0; m < 4; ++m) { const size_t row = row0 + ai * 128 + m * 16;
#pragma unroll
                for (int bj = 0; bj < 2; ++bj) { const int col = col0 + bj * 128;
                    sa[m][bj] = *(const u32x4*)(SG + row * 4096 + 2048 + col);
                    sm[m][bj] = *(const u32x4*)(SG + row * 4096 + (u.aux == 0 ? 0 : 2048) + col); } }
            asm volatile("" : "+v"(sa[0][0]), "+v"(sa[0][1]), "+v"(sa[1][0]), "+v"(sa[1][1]), "+v"(sa[2][0]), "+v"(sa[2][1]), "+v"(sa[3][0]), "+v"(sa[3][1]),
                              "+v"(sm[0][0]), "+v"(sm[0][1]), "+v"(sm[1][0]), "+v"(sm[1][1]), "+v"(sm[2][0]), "+v"(sm[2][1]), "+v"(sm[3][0]), "+v"(sm[3][1]));
#pragma unroll
            for (int m = 0; m < 4; ++m) { const size_t row = row0 + ai * 128 + m * 16;
#pragma unroll
                for (int bj = 0; bj < 2; ++bj) { const int col = col0 + bj * 128;
                    const u32x4 a4 = sa[m][bj], m4 = sm[m][bj];
                    const float ga[8] = {bflo(a4.x), bfhi(a4.x), bflo(a4.y), bfhi(a4.y), bflo(a4.z), bfhi(a4.z), bflo(a4.w), bfhi(a4.w)};
                    if (u.aux == 0) {
                        const float gm[8] = {bflo(m4.x), bfhi(m4.x), bflo(m4.y), bfhi(m4.y), bflo(m4.z), bfhi(m4.z), bflo(m4.w), bfhi(m4.w)};
#pragma unroll
                        for (int j = 0; j < 4; ++j) { acc[ai][bj][m][0][j] *= gm[j] * __builtin_amdgcn_rcpf(fmaxf(ga[j], 1.0e-30f)); acc[ai][bj][m][1][j] *= gm[4 + j] * __builtin_amdgcn_rcpf(fmaxf(ga[4 + j], 1.0e-30f)); }
                    } else {
                        const f32x4 v0 = acc[ai][bj][m][0], v1 = acc[ai][bj][m][1];
                        u32x4 w; w.x = cvt_pk_bf16(v0[0] * ga[0], v0[1] * ga[1]); w.y = cvt_pk_bf16(v0[2] * ga[2], v0[3] * ga[3]);
                        w.z = cvt_pk_bf16(v1[0] * ga[4], v1[1] * ga[5]); w.w = cvt_pk_bf16(v1[2] * ga[6], v1[3] * ga[7]);
                        *(u32x4*)(Y + row * 2048 + col) = w; }
                } }
        }
    }
};
struct EpiOut {
    static constexpr bool PERM = false;
    const float* res; float* out;
    __device__ __forceinline__ void operator()(f32x4 (&acc)[2][2][4][2], const Unit& u, int wr, int wc, int fr, int fq) const {
        const int row0 = u.pm * 256 + wr * 64 + fr, col0 = u.pn * 256 + wc * 32 + 4 * fq;
#pragma unroll
        for (int ai = 0; ai < 2; ++ai) {
            f32x4 rv[4][2][2];
#pragma unroll
            for (int m = 0; m < 4; ++m) { const size_t ro = (size_t)(row0 + ai * 128 + m * 16) * DM + col0;
#pragma unroll
                for (int bj = 0; bj < 2; ++bj)
#pragma unroll
                    for (int n = 0; n < 2; ++n) rv[m][bj][n] = *(const f32x4*)(res + ro + bj * 128 + n * 16); }
#pragma unroll
            for (int m = 0; m < 4; ++m) asm volatile("" : "+v"(rv[m][0][0]), "+v"(rv[m][0][1]), "+v"(rv[m][1][0]), "+v"(rv[m][1][1]));
#pragma unroll
            for (int m = 0; m < 4; ++m) { const size_t ro = (size_t)(row0 + ai * 128 + m * 16) * DM + col0;
#pragma unroll
                for (int bj = 0; bj < 2; ++bj)
#pragma unroll
                    for (int n = 0; n < 2; ++n) *(f32x4*)(out + ro + bj * 128 + n * 16) = rv[m][bj][n] + acc[ai][bj][m][n]; }
        }
    }
};
struct SchedMoe1 {
    static constexpr bool GATHER = true;
    const char* H; const char* W13; const int* LIST; const LAS int* te; const LAS int* tr0; const LAS int* cnt; int MT, G, c;
    __device__ __forceinline__ bool next(int i, Unit& u) const { const int L = i * G + c; if (L >= 2 * MT) return false; u.pm = L >> 1; u.pn = L & 1; u.aux = __builtin_amdgcn_readfirstlane(te[u.pm]); return true; }
    __device__ __forceinline__ const char* abase(const Unit&) const { return H; }
    __device__ __forceinline__ const char* bbase(const Unit& u) const { return W13 + ((size_t)u.aux * 512 + u.pn * 256) * 4096; }
    static __device__ __forceinline__ bool keep_acc(const Unit&) { return false; }
    __device__ __forceinline__ unsigned arow(const Unit& u, int r) const { const int rr = __builtin_amdgcn_readfirstlane(tr0[u.pm]) + r; return rr < __builtin_amdgcn_readfirstlane(cnt[u.aux]) ? (unsigned)LIST[u.aux * 8192 + rr] : 0u; }
};
struct EpiMoe1 {
    static constexpr bool PERM = true;
    bf16* HID; const float* PWL; const LAS int* tr0; const LAS int* cnt;
    __device__ __forceinline__ void operator()(f32x4 (&acc)[2][2][4][2], const Unit& u, int wr, int wc, int fr, int fq) const {
#pragma unroll
        for (int ai = 0; ai < 2; ++ai)
#pragma unroll
            for (int m = 0; m < 4; ++m) { const int r = ai * 128 + wr * 64 + m * 16 + fr;
                const float pw = 1.0f;
                float o[8];
#pragma unroll
                for (int n = 0; n < 2; ++n)
#pragma unroll
                    for (int j = 0; j < 4; ++j) { const float x1 = acc[ai][0][m][n][j], x3 = acc[ai][1][m][n][j]; o[4 * n + j] = x1 * sigmoidf_(x1) * x3 * pw; }
                u32x4 w; w.x = cvt_pk_bf16(o[0], o[1]); w.y = cvt_pk_bf16(o[2], o[3]); w.z = cvt_pk_bf16(o[4], o[5]); w.w = cvt_pk_bf16(o[6], o[7]);
                *(u32x4*)(HID + (size_t)(u.pm * 256 + r) * 256 + u.pn * 128 + wc * 32 + 8 * fq) = w; }
    }
};
struct SchedMoe2 {
    static constexpr bool GATHER = false;
    const char* HID; const char* W2; const LAS int* te; int MT, G, c;
    __device__ __forceinline__ bool next(int i, Unit& u) const { const int L = i * G + c; if (L >= 8 * MT) return false; u.pm = L >> 3; u.pn = L & 7; u.aux = __builtin_amdgcn_readfirstlane(te[u.pm]); return true; }
    __device__ __forceinline__ const char* abase(const Unit& u) const { return HID + (size_t)u.pm * 256 * 512; }
    __device__ __forceinline__ const char* bbase(const Unit& u) const { return W2 + ((size_t)u.aux * 2048 + u.pn * 256) * 512; }
    __device__ __forceinline__ unsigned arow(const Unit&, int) const { return 0u; }
    static __device__ __forceinline__ bool keep_acc(const Unit&) { return false; }
};
struct EpiMoe2 {
    static constexpr bool PERM = true;
    bf16* OP;
    __device__ __forceinline__ void operator()(f32x4 (&acc)[2][2][4][2], const Unit& u, int wr, int wc, int fr, int fq) const {
        const int row0 = u.pm * 256 + wr * 64 + fr, col0 = u.pn * 256 + wc * 32 + 8 * fq;
#pragma unroll
        for (int ai = 0; ai < 2; ++ai)
#pragma unroll
            for (int m = 0; m < 4; ++m) { bf16* rowp = OP + (size_t)(row0 + ai * 128 + m * 16) * DM + col0;
#pragma unroll
                for (int bj = 0; bj < 2; ++bj) { const f32x4 v0 = acc[ai][bj][m][0], v1 = acc[ai][bj][m][1];
                    u32x4 w; w.x = cvt_pk_bf16(v0[0], v0[1]); w.y = cvt_pk_bf16(v0[2], v0[3]); w.z = cvt_pk_bf16(v1[0], v1[1]); w.w = cvt_pk_bf16(v1[2], v1[3]);
                    *(u32x4*)(rowp + bj * 128) = w; } }
    }
};

constexpr int N_PHASES = 22;
__global__ void __launch_bounds__(NTHR, 2) fwd_kernel(Args a) {
    extern __shared__ __attribute__((aligned(16))) unsigned char lds_raw[];
    LAS unsigned char* lds0 = (LAS unsigned char*)lds_raw;
    const int tid0 = threadIdx.x, bid0 = blockIdx.x, G0 = gridDim.x;
    const int wave0 = __builtin_amdgcn_readfirstlane(tid0 >> 6);
#define PH_IDS() ArgsP ap = (ArgsP)__builtin_amdgcn_kernarg_segment_ptr(); asm volatile("" : "+s"(ap)); unsigned lb_ = 0u; asm volatile("" : "+s"(lb_)); LAS unsigned char* lds = lds0 + lb_; LAS unsigned char* misc = lds + MISC_OFF; (void)misc; unsigned char* ws = ap->ws; (void)ws; int bid = bid0, G = G0, wave = wave0; asm volatile("" : "+s"(bid), "+s"(G), "+s"(wave)); int tid = wave * 64 + lane_id(); asm volatile("" : "+v"(tid)); const int lane = tid & 63; (void)lane; (void)wave
    if (tid0 < 4) ((LAS unsigned*)(lds0 + MISC_OFF + MO_BAR))[tid0] = 0u;
    __syncthreads();
#if MK_LAUNCHES == 1
    XcdBarrier bar = xcd_barrier_post((unsigned*)(a.ws + WS_CTL) + CW_BAR, (volatile LAS unsigned*)(lds0 + MISC_OFF + MO_BAR));
#define GRID_BAR() xcd_barrier(bar)
#else
#define GRID_BAR() do { } while (0)
#endif
    const int lo = a.ph_lo, hi = a.ph_hi;
#ifndef PHMASK
#define PHMASK 0xFFFu
#endif
#define IN(k) (lo <= (k) && (k) < hi)
#define EN(b) ((PHMASK >> (b)) & 1u)
#ifndef DBLMASK
#define DBLMASK 0u
#endif
#define REP(b) _Pragma("unroll 1") for (int rep_ = 0; rep_ < (((DBLMASK >> (b)) & 1u) ? 2 : 1); ++rep_)
#define SEAM(k) do { if (IN(k) && IN((k) + 1)) { GRID_BAR(); if ((DBLMASK >> 12) & 1u) GRID_BAR(); } } while (0)

    if (EN(0) && IN(0)) { REP(0) { PH_IDS(); prologue_phase(ap, lds, tid, lane, wave, bid, G); __syncthreads(); }
#ifndef NO_NORM0
        { PH_IDS(); norm_phase<0>(ap, 0, lds, tid, lane, wave, bid, G); }
#endif
    }
    SEAM(0);
#pragma unroll 1
    for (int l = 0; l < 2; ++l) {
        const int pb = 1 + 10 * l;
        if (EN(1) && IN(pb + 0) && l == 1) { if ((DBLMASK >> 18) & 1u) { PH_IDS(); norm_phase<1>(ap, l, lds, tid, lane, wave, bid, G, true); } PH_IDS(); norm_phase<1>(ap, l, lds, tid, lane, wave, bid, G); }
        if (l == 1) SEAM(pb + 0);
        if (EN(2) && IN(pb + 1)) REP(2) { PH_IDS(); (void)tid;
#ifdef STAG
            for (int i = 0; i < ((bid >> 3) & 7); ++i) __builtin_amdgcn_s_sleep(STAG);
#endif
            SchedG1 S{(const char*)(ws + WS_H), (const char*)(ws + WS_WINT) + (size_t)l * 11264 * 4096, G, bid};
            EpiG1 E{ws, ((DBLMASK >> 21) & 1u) && rep_ == 1};
            pg8::gemm_phase<EpiG1, SchedG1>(lds, 2048, S, E, wave);
            for (int bh = G - 1 - bid; bh < 16; bh += G) gate_unit(ap, l, lds, bh, tid, tid & 63, wave);
            __syncthreads();
            if (G == 256 && bid >= 256 - SchedG1::NCV) prologue_phase(ap, lds, tid, tid & 63, wave, bid - (256 - SchedG1::NCV), SchedG1::NCV, 2 + l);
            else if (G != 256) prologue_phase(ap, lds, tid, tid & 63, wave, bid, G, 2 + l);
        }
        SEAM(pb + 1);
        if (EN(3) && IN(pb + 2)) REP(3) { PH_IDS(); conv_phase(ap, l, lds, tid, lane, wave, bid, G); }
        SEAM(pb + 2);
        if (EN(4) && IN(pb + 3)) REP(4) { PH_IDS();
            const int vb = (G % 8 == 0) ? (bid & 7) * (G >> 3) + (bid >> 3) : bid;
            REP(13) { for (int gw = vb * NWAVES + wave; gw < 2048; gw += G * NWAVES) mlstm_ab_task(ws, gw, lane, rep_ == 0 || !((DBLMASK >> 15) & 1u)); }
            if (wave == 0 && vb < 64) nscan_task(ws, vb, lane);
            __syncthreads();
            REP(14) { for (int u = vb; u < 512; u += G) { attn_unit(ap, lds, u, tid, lane, wave); __syncthreads(); if (((DBLMASK >> 16) & 1u) && u < 256) GRID_BAR(); } }
        }
        SEAM(pb + 3);
        if (EN(5) && IN(pb + 4)) REP(5) { PH_IDS(); mlstm_c_phase(ap, l, lds, tid, lane, wave, bid, G); }
        SEAM(pb + 4);
        if (EN(6) && IN(pb + 5)) REP(6) { PH_IDS(); (void)tid;
            SchedBr S{(const char*)(ws + WS_HM), (const char*)(ws + WS_HA), (const char*)(ws + WS_WBM) + (size_t)l * 2048 * 2048, (const char*)(ws + WS_WBA) + (size_t)l * 2048 * 2048, G, bid};
            EpiBr E{(const bf16*)(ws + WS_SG), (bf16*)(ws + WS_Y)};
            pg8::gemm_phase<EpiBr, SchedBr>(lds, 1024, S, E, wave);
        }
        SEAM(pb + 5);
        if (EN(7) && IN(pb + 6)) _Pragma("unroll 1") for (int rep_ = 0; rep_ < ((((DBLMASK >> 7) & 1u) && l == 0) ? 2 : 1); ++rep_) { PH_IDS(); (void)tid;
            SchedStd S{(const char*)(ws + WS_Y), (const char*)(ws + WS_WOUT) + (size_t)l * 2048 * 4096, 32, 8, 2048, G, bid};
            EpiOut E{l == 0 ? ap->in[I_X] : (const float*)ap->out, ap->out};
            pg8::gemm_phase<EpiOut, SchedStd>(lds, 2048, S, E, wave);
        }
        SEAM(pb + 6);
        if (EN(8) && IN(pb + 7)) { if ((DBLMASK >> 19) & 1u) { PH_IDS(); norm_phase<2>(ap, l, lds, tid, lane, wave, bid, G, true); } PH_IDS(); norm_phase<2>(ap, l, lds, tid, lane, wave, bid, G); }
        SEAM(pb + 7);
        if (EN(9) && IN(pb + 8)) REP(9) { PH_IDS();
            moe_tables(ws, l, misc, tid);
            SchedMoe1 S{(const char*)(ws + WS_H), (const char*)(ws + WS_W13) + (size_t)l * 32 * 512 * 4096, (const int*)(ws + MS_LIST),
                        (const LAS int*)(misc + MO_TE), (const LAS int*)(misc + MO_TR0), (const LAS int*)(misc + MO_CNT), __builtin_amdgcn_readfirstlane(((const LAS int*)(misc + MO_MT))[0]), G, bid};
            EpiMoe1 E{(bf16*)(ws + WS_HID), (const float*)(ws + MS_PWL), (const LAS int*)(misc + MO_TR0), (const LAS int*)(misc + MO_CNT)};
            pg8::gemm_phase<EpiMoe1, SchedMoe1>(lds, 2048, S, E, wave);
            if (bid >= 2 * S.MT) prologue_phase(ap, lds, tid, tid & 63, wave, bid - 2 * S.MT, G - 2 * S.MT, l == 0 ? 1 : 4);
        }
        SEAM(pb + 8);
        if (EN(10) && IN(pb + 9)) REP(10) { PH_IDS();
            moe_tables(ws, l, misc, tid);
#ifdef STAG
            for (int i = 0; i < ((bid >> 3) & 7); ++i) __builtin_amdgcn_s_sleep(STAG);
#endif
            SchedMoe2 S{(const char*)(ws + WS_HID), (const char*)(ws + WS_W2) + (size_t)l * 32 * 2048 * 512, (const LAS int*)(misc + MO_TE), __builtin_amdgcn_readfirstlane(((const LAS int*)(misc + MO_MT))[0]), G, bid};
            EpiMoe2 E{(bf16*)(ws + WS_OP)};
            pg8::gemm_phase<EpiMoe2, SchedMoe2>(lds, 256, S, E, wave);
        }
        SEAM(pb + 9);
    }
    if (EN(11) && IN(21)) { if ((DBLMASK >> 20) & 1u) { PH_IDS(); norm_phase<3>(ap, 1, lds, tid, lane, wave, bid, G, true); } PH_IDS(); norm_phase<3>(ap, 1, lds, tid, lane, wave, bid, G); }
#undef IN
#undef SEAM
}

extern "C" void kernel_launch(void* const* d_in, const int* in_sizes, int n_in, void* d_out, int out_size, void* d_ws, size_t ws_size, hipStream_t stream) {
    static int grid = 0;
    if (grid == 0) {
        if (n_in != 19 || out_size != NTOK * DM || ws_size < WS_END) { fprintf(stderr, "kernel_launch: unexpected shapes (n_in %d out %d ws %zu)\n", n_in, out_size, ws_size); grid = -1; return; }
        int dev = 0, cus = 0, per_cu = 0;
        if (hipGetDevice(&dev) != hipSuccess || hipDeviceGetAttribute(&cus, hipDeviceAttributeMultiprocessorCount, dev) != hipSuccess) { grid = -1; return; }
        if (hipFuncSetAttribute((const void*)fwd_kernel, hipFuncAttributeMaxDynamicSharedMemorySize, LDS_BYTES) != hipSuccess) { fprintf(stderr, "kernel_launch: hipFuncSetAttribute failed\n"); grid = -1; return; }
        if (hipOccupancyMaxActiveBlocksPerMultiprocessor(&per_cu, (const void*)fwd_kernel, NTHR, LDS_BYTES) != hipSuccess || per_cu < 1) { fprintf(stderr, "kernel_launch: occupancy query says %d\n", per_cu); }
        (void)hipGetLastError();
        grid = cus;
        if (grid > 256) grid = 256;
    }
    if (grid < 0) return;
    if (hipMemsetAsync((char*)d_ws + WS_CTL, 0, CTL_ZERO_BYTES, stream) != hipSuccess) return;
    Args a{};
    for (int i = 0; i < 19; ++i) a.in[i] = (const float*)d_in[i];
    a.out = (float*)d_out; a.ws = (unsigned char*)d_ws;
#if MK_LAUNCHES == 1
    a.ph_lo = 0; a.ph_hi = N_PHASES;
    hipLaunchKernelGGL(fwd_kernel, dim3(grid), dim3(NTHR), LDS_BYTES, stream, a);
#else
    for (int p = 0; p < N_PHASES; ++p) { a.ph_lo = p; a.ph_hi = p + 1; hipLaunchKernelGGL(fwd_kernel, dim3(grid), dim3(NTHR), LDS_BYTES, stream, a); }
#endif
}
```

```cpp
#define DBLMASK 0u
#include <hip/hip_runtime.h>
#include <stdint.h>
#include <stdio.h>

#ifndef MK_LAUNCHES
#define MK_LAUNCHES 1
#endif

#define GAS __attribute__((address_space(1)))
#define LAS __attribute__((address_space(3)))
typedef unsigned short bf16;
typedef short bf16x8 __attribute__((ext_vector_type(8)));
typedef short bf16x4 __attribute__((ext_vector_type(4)));
typedef float f32x4 __attribute__((ext_vector_type(4)));
typedef unsigned u32x4 __attribute__((ext_vector_type(4)));
typedef unsigned u32x2 __attribute__((ext_vector_type(2)));

constexpr int NTOK = 8192, DM = 2048, SEQ = 2048, NBATCH = 4;
constexpr int INCOLS = 11272;
constexpr int NWAVES = 8, NTHR = 512;
constexpr float RMS_EPS = 1e-6f, LN_EPS = 1e-5f;
constexpr int MPAD = 24576;

constexpr size_t MiB = 1u << 20;
constexpr size_t WS_CTL = 0, CTL_ZERO_BYTES = 1 * MiB;
constexpr size_t WS_MISC = 1 * MiB;
constexpr size_t MS_WIF = WS_MISC + 0;
constexpr size_t MS_WRT = WS_MISC + 256 * 1024;
constexpr size_t MS_IFG = WS_MISC + 1 * MiB;
constexpr size_t MS_KMEAN = MS_IFG + 256 * 1024;
constexpr size_t MS_AS = WS_MISC + 1536 * 1024;
constexpr size_t MS_GT = MS_AS + 128 * 1024;
constexpr size_t MS_WI = MS_GT + 128 * 1024;
constexpr size_t MS_CL = MS_WI + 128 * 1024;
constexpr size_t MS_WS = MS_CL + 128 * 1024;
constexpr size_t MS_DEC = MS_WS + 128 * 1024;
constexpr size_t MS_NST = WS_MISC + 2560 * 1024;
constexpr size_t MS_TOKE = WS_MISC + 3 * MiB;
constexpr size_t MS_TOKP = MS_TOKE + 64 * 1024;
constexpr size_t MS_TOKW = MS_TOKE + 128 * 1024;
constexpr size_t MS_LIST = WS_MISC + 4 * MiB;
constexpr size_t MS_PWL = WS_MISC + 5 * MiB;
constexpr size_t MS_NVEC = WS_MISC + 6 * MiB;
constexpr size_t WS_WINT = 16 * MiB;
constexpr size_t WS_WBM = 104 * MiB;
constexpr size_t WS_WBA = 112 * MiB;
constexpr size_t WS_WOUT = 120 * MiB;
constexpr size_t WS_W13 = 136 * MiB;
constexpr size_t WS_W2 = 264 * MiB;
constexpr size_t WS_H = 328 * MiB;
constexpr size_t WS_R = 360 * MiB;
constexpr size_t WS_ZQK = WS_R;
constexpr size_t WS_HM = WS_R, WS_HA = WS_R + 16 * MiB;
constexpr size_t WS_VMT = WS_R + 32 * MiB;
constexpr size_t WS_OM = WS_R + 48 * MiB;
constexpr size_t WS_QA = WS_R + 64 * MiB, WS_KA = WS_R + 80 * MiB;
constexpr size_t WS_Y = WS_QA;
constexpr size_t WS_VAT = WS_R + 96 * MiB;
constexpr size_t WS_SG = WS_R + 112 * MiB;
constexpr size_t WS_QM = WS_R + 176 * MiB, WS_KM = WS_R + 192 * MiB, WS_KMT = WS_R + 208 * MiB;
constexpr size_t WS_CST = WS_R + 224 * MiB;
constexpr size_t WS_HID = WS_R;
constexpr size_t WS_OP = WS_R + 16 * MiB;
constexpr size_t WS_END = 648 * MiB;
constexpr int CW_BAR = 4096;
constexpr int CW_CNT = 8192;

constexpr int RING_BYTES = 131072;
constexpr int MISC_OFF = 139264;
constexpr int LDS_BYTES = 147456;
constexpr int MO_BAR = 0, MO_CNT = 64, MO_NT = 64 + 128, MO_OFF = 64 + 256, MO_TE = 64 + 512, MO_TR0 = 64 + 1024, MO_MT = 64 + 1536, MO_LOG = 2048;

#define LDS_WAIT() asm volatile("s_waitcnt lgkmcnt(0)" ::: "memory")
#define VM_WAIT() asm volatile("s_waitcnt vmcnt(0)" ::: "memory")

__device__ __forceinline__ float bf2f(unsigned short b) { return __builtin_bit_cast(float, (unsigned)b << 16); }
__device__ __forceinline__ float bflo(unsigned u) { return __builtin_bit_cast(float, u << 16); }
__device__ __forceinline__ float bfhi(unsigned u) { return __builtin_bit_cast(float, u & 0xffff0000u); }
typedef __bf16 bf16x2v __attribute__((ext_vector_type(2)));
typedef float f32x2v __attribute__((ext_vector_type(2)));
__device__ __forceinline__ unsigned cvt_pk_bf16(float lo, float hi) { const f32x2v f = {lo, hi}; const bf16x2v b = __builtin_convertvector(f, bf16x2v); return __builtin_bit_cast(unsigned, b); }
__device__ __forceinline__ float wave_sum(float v) {
#pragma unroll
    for (int o = 1; o < 64; o <<= 1) v += __shfl_xor(v, o);
    return v;
}
__device__ __forceinline__ float rows4_max(float x) { x = fmaxf(x, __shfl_xor(x, 16)); return fmaxf(x, __shfl_xor(x, 32)); }
__device__ __forceinline__ float rows4_sum(float x) { x += __shfl_xor(x, 16); return x + __shfl_xor(x, 32); }
__device__ __forceinline__ int lane_id() { int l; asm volatile("v_mbcnt_lo_u32_b32 %0, -1, 0\n\tv_mbcnt_hi_u32_b32 %0, -1, %0" : "=v"(l)); return l; }
__device__ __forceinline__ float sigmoidf_(float x) { return __builtin_amdgcn_rcpf(1.f + __expf(-x)); }

namespace pg8 {
constexpr int BM = 256, BK = 64, HALF = 128, HTB = HALF * BK * 2, STAGE_BYTES = 8 * HTB, NXCD = 8, WGM = 8;
__device__ __forceinline__ int lds_byte(int r, int c) { const int st = (r >> 4) * 2 + (c >> 5), rr = r & 15, cc = c & 31, ob = rr * 64 + cc * 2; return st * 1024 + (ob ^ (((ob >> 9) & 1) << 5)); }
__device__ __forceinline__ void stage_rc(int b, int& R, int& C) { const int st = b / 1024, sb = b % 1024, swz = sb ^ (((sb >> 9) & 1) << 5); R = (st >> 1) * 16 + swz / 64; C = (st & 1) * 32 + (swz % 64) / 2; }
__device__ __forceinline__ int perm32(int rho) { const int n = rho >> 4, i = rho & 15; return 8 * (i >> 2) + 4 * n + (i & 3); }
struct Unit { int pm, pn, aux; };

__device__ __forceinline__ void static_tile(int L, int nM, int nN, int& pm, int& pn) {
    const int nwg = nM * nN; int wgid = L;
    { const int q = nwg / NXCD, r = nwg % NXCD, xcd = wgid % NXCD, off = wgid / NXCD; wgid = (xcd < r ? xcd * (q + 1) : r * (q + 1) + (xcd - r) * q) + off; }
    const int nig = WGM * nN, gid = wgid / nig, fm = gid * WGM, gsz = (nM - fm) < WGM ? (nM - fm) : WGM;
    pm = fm + ((wgid % nig) % gsz); pn = (wgid % nig) / gsz;
}

template <class Epi, class Sched>
__device__ __forceinline__ void gemm_phase(LAS unsigned char* lds, const int K, const Sched& S, const Epi& E, const int wave0) {
    int tid_ = wave0 * 64 + lane_id(); asm volatile("" : "+v"(tid_));
    const int tid = tid_, wid = __builtin_amdgcn_readfirstlane(tid >> 6), lane = tid & 63, wr = wid >> 2, wc = wid & 3, fr = lane & 15, fq = lane >> 4;
    const int nt = K / BK;
    int RA[2], CA[2]; unsigned voffB[2];
#pragma unroll
    for (int i = 0; i < 2; ++i) { int R, C; stage_rc(tid * 16 + i * 8192, R, C); const int Rb = Epi::PERM ? ((R & ~31) + perm32(R & 31)) : R;
        RA[i] = R; CA[i] = C; voffB[i] = (unsigned)(Rb * K + C) * 2u; }
    const size_t kstep = (size_t)(BK * 2);
    const size_t hstep = (size_t)HALF * K * 2;
    const unsigned ldsw = (unsigned)wid * 1024u;
    const int aoff = lds_byte(wr * 64 + fr, fq * 8), boff = lds_byte(wc * 32 + fr, fq * 8);
#define PG8_SA(b, h) (((b) * 2 + (h)) * HTB)
#define PG8_SB(b, h) ((4 + (b) * 2 + (h)) * HTB)
#define PG8_STAGE(bufoff, gbase, v0, v1) do { \
        __builtin_amdgcn_global_load_lds((const unsigned*)((const char*)(gbase) + (v0)), (LAS unsigned*)(lds + (bufoff) + ldsw), 16, 0, 0); \
        __builtin_amdgcn_global_load_lds((const unsigned*)((const char*)(gbase) + (v1)), (LAS unsigned*)(lds + (bufoff) + ldsw + 8192), 16, 0, 0); } while (0)
#define PG8_STAGE_B(bufoff, gbase) PG8_STAGE(bufoff, gbase, voffB[0], voffB[1])
#define PG8_STAGE_A(bufoff, gbase, VO, h) PG8_STAGE(bufoff, gbase, VO[h][0], VO[h][1])
#define PG8_STAGE_A2(bufoff, gbase, h) do { if (Sched::GATHER && last) { PG8_STAGE_A(bufoff, gbase, vn, h); } else { PG8_STAGE_A(bufoff, gbase, vc, h); } } while (0)
#define PG8_LDA(dst, b, h) do { _Pragma("unroll") for (int m = 0; m < 4; ++m) _Pragma("unroll") for (int k = 0; k < 2; ++k) dst[m][k] = *(const LAS bf16x8*)(lds + PG8_SA(b, h) + aoff + m * 2048 + k * 1024); } while (0)
#define PG8_LDB(dst, b, h) do { _Pragma("unroll") for (int n = 0; n < 2; ++n) _Pragma("unroll") for (int k = 0; k < 2; ++k) dst[n][k] = *(const LAS bf16x8*)(lds + PG8_SB(b, h) + boff + n * 2048 + k * 1024); } while (0)
#define PG8_MMA(ai, bj, At, Bt) do { __builtin_amdgcn_s_setprio(1); _Pragma("unroll") for (int m = 0; m < 4; ++m) _Pragma("unroll") for (int n = 0; n < 2; ++n) _Pragma("unroll") for (int k = 0; k < 2; ++k) \
        acc[ai][bj][m][n] = __builtin_amdgcn_mfma_f32_16x16x32_bf16(Bt[n][k], At[m][k], acc[ai][bj][m][n], 0, 0, 0); __builtin_amdgcn_s_setprio(0); } while (0)
#define PG8_WAIT_V(n) asm volatile("s_waitcnt vmcnt(" #n ")" ::: "memory")
#define PG8_WAIT_L(n) asm volatile("s_waitcnt lgkmcnt(" #n ")" ::: "memory")
#define PG8_BAR __builtin_amdgcn_s_barrier()
#define PG8_SCHED __builtin_amdgcn_sched_barrier(0)
    Unit cur, nxt; int ui = 0;
    if (!S.next(0, cur)) return;
    f32x4 acc[2][2][4][2];
#pragma unroll
    for (int a = 0; a < 2; ++a)
#pragma unroll
        for (int b = 0; b < 2; ++b)
#pragma unroll
            for (int m = 0; m < 4; ++m)
#pragma unroll
                for (int n = 0; n < 2; ++n) acc[a][b][m][n] = (f32x4){0.f, 0.f, 0.f, 0.f};
    bf16x8 At[4][2], B0[2][2], B1[2][2];
    unsigned vc[2][2], vn[2][2];
#pragma unroll
    for (int h = 0; h < 2; ++h)
#pragma unroll
        for (int i = 0; i < 2; ++i) {
            if constexpr (Sched::GATHER) vc[h][i] = (unsigned)(S.arow(cur, h * HALF + RA[i]) * (unsigned)K + (unsigned)CA[i]) * 2u;
            else vc[h][i] = (unsigned)((h * HALF + RA[i]) * K + CA[i]) * 2u;
            vn[h][i] = vc[h][i];
        }
    const char* cA = S.abase(cur); const char* cB = S.bbase(cur);
    PG8_STAGE_B(PG8_SB(0, 0), cB); PG8_STAGE_A(PG8_SA(0, 0), cA, vc, 0); PG8_STAGE_B(PG8_SB(0, 1), cB + hstep); PG8_STAGE_A(PG8_SA(0, 1), cA, vc, 1);
    if (wr == 1) PG8_BAR;
    PG8_WAIT_V(4); PG8_BAR;
    PG8_STAGE_B(PG8_SB(1, 0), cB + kstep); PG8_STAGE_A(PG8_SA(1, 0), cA + kstep, vc, 0); PG8_STAGE_B(PG8_SB(1, 1), cB + hstep + kstep);
    PG8_WAIT_V(6); PG8_BAR;
    for (;;) {
        const bool has_next = S.next(ui + 1, nxt);
        const char* nA = has_next ? S.abase(nxt) : cA; const char* nB = has_next ? S.bbase(nxt) : cB;
        if constexpr (Sched::GATHER) {
            if (has_next) {
                int t2 = wave0 * 64 + lane_id(); asm volatile("" : "+v"(t2));
#pragma unroll
                for (int i = 0; i < 2; ++i) { int R, C; stage_rc(t2 * 16 + i * 8192, R, C);
#pragma unroll
                    for (int h = 0; h < 2; ++h) vn[h][i] = (unsigned)(S.arow(nxt, h * HALF + R) * (unsigned)K + (unsigned)C) * 2u; }
            }
        }
#pragma unroll 1
        for (int t = 0; t < nt; t += 2) {
            const bool last = (t == nt - 2);
            const char* a1 = cA + (size_t)(t + 1) * kstep;
            const char* a2 = last ? nA : cA + (size_t)(t + 2) * kstep; const char* b2 = last ? nB : cB + (size_t)(t + 2) * kstep;
            const char* a3 = a2 + kstep; const char* b3 = b2 + kstep;
            PG8_LDB(B0, 0, 0); PG8_SCHED; PG8_LDA(At, 0, 0); PG8_STAGE_A(PG8_SA(1, 1), a1, vc, 1);
            PG8_WAIT_L(8); PG8_BAR; PG8_WAIT_L(0); PG8_MMA(0, 0, At, B0); PG8_BAR; PG8_SCHED;
            PG8_LDB(B1, 0, 1); PG8_STAGE_B(PG8_SB(0, 0), b2);
            PG8_BAR; PG8_WAIT_L(0); PG8_MMA(0, 1, At, B1); PG8_BAR;
            PG8_LDA(At, 0, 1); PG8_STAGE_A2(PG8_SA(0, 0), a2, 0);
            PG8_BAR; PG8_WAIT_L(0); PG8_MMA(1, 0, At, B0); PG8_BAR; PG8_SCHED;
            PG8_STAGE_B(PG8_SB(0, 1), b2 + hstep);
            PG8_WAIT_V(6); PG8_BAR; PG8_MMA(1, 1, At, B1); PG8_BAR;
            PG8_LDB(B0, 1, 0); PG8_SCHED; PG8_LDA(At, 1, 0); PG8_STAGE_A2(PG8_SA(0, 1), a2, 1);
            PG8_WAIT_L(8); PG8_BAR; PG8_WAIT_L(0); PG8_MMA(0, 0, At, B0); PG8_BAR; PG8_SCHED;
            PG8_LDB(B1, 1, 1); PG8_STAGE_B(PG8_SB(1, 0), b3);
            PG8_BAR; PG8_WAIT_L(0); PG8_MMA(0, 1, At, B1); PG8_BAR;
            PG8_LDA(At, 1, 1); PG8_STAGE_A2(PG8_SA(1, 0), a3, 0);
            PG8_BAR; PG8_WAIT_L(0); PG8_MMA(1, 0, At, B0); PG8_BAR; PG8_SCHED;
            PG8_STAGE_B(PG8_SB(1, 1), b3 + hstep);
            PG8_WAIT_V(6); PG8_BAR; PG8_MMA(1, 1, At, B1); PG8_BAR;
        }
        { const int lz = lane_id(); E(acc, cur, wr, wc, lz & 15, lz >> 4); }
        if (!has_next) break;
        if (!Sched::keep_acc(cur)) {
#pragma unroll
        for (int a = 0; a < 2; ++a)
#pragma unroll
            for (int b = 0; b < 2; ++b)
#pragma unroll
                for (int m = 0; m < 4; ++m)
#pragma unroll
                    for (int n = 0; n < 2; ++n) acc[a][b][m][n] = (f32x4){0.f, 0.f, 0.f, 0.f};
        }
        cur = nxt; cA = nA; cB = nB; ++ui;
        if constexpr (Sched::GATHER) {
#pragma unroll
            for (int h = 0; h < 2; ++h)
#pragma unroll
                for (int i = 0; i < 2; ++i) vc[h][i] = vn[h][i];
        }
    }
    PG8_WAIT_V(0);
    if (wr == 0) PG8_BAR;
    PG8_BAR;
#undef PG8_SA
#undef PG8_SB
#undef PG8_STAGE
#undef PG8_STAGE_A
#undef PG8_STAGE_A2
#undef PG8_STAGE_B
#undef PG8_LDA
#undef PG8_LDB
#undef PG8_MMA
#undef PG8_WAIT_V
#undef PG8_WAIT_L
#undef PG8_BAR
#undef PG8_SCHED
}
}
using pg8::Unit;

#define XB_TMO      128
#define XB_XCNT(j)  (256  + 64 * (j))
#define XB_XSUB(j)  (1280 + 64 * (j))
#define XB_XGEN(j)  (2304 + 64 * (j))
#define XB_TOP      3328
#define XB_TOPGEN   3392
#define XCD_BAR_WORDS 3456
#define XB_SPIN_CAP (1u << 18)
__device__ __forceinline__ unsigned xb_ld(unsigned* p)              { return __hip_atomic_load(p, __ATOMIC_RELAXED, __HIP_MEMORY_SCOPE_AGENT); }
__device__ __forceinline__ unsigned xb_add(unsigned* p, unsigned v) { return __hip_atomic_fetch_add(p, v, __ATOMIC_RELAXED, __HIP_MEMORY_SCOPE_AGENT); }
__device__ __forceinline__ unsigned xb_xcc_id() { return (unsigned)__builtin_amdgcn_s_getreg((3 << 11) | 20) & 0xFu; }
#define XB_SPIN(cond, bar) do { unsigned _sp = 0; while (cond) { __builtin_amdgcn_s_sleep(1); \
    if ((++_sp & 255u) == 0u) { if (xb_ld(&(bar)[XB_TMO])) break; if (_sp > XB_SPIN_CAP) { atomicAdd(&(bar)[XB_TMO], 1u); break; } } } } while (0)
struct XcdBarrier { unsigned* bar; unsigned x; volatile LAS unsigned* st; };
__device__ __forceinline__ XcdBarrier xcd_barrier_post(unsigned* bar, volatile LAS unsigned* st) {
    XcdBarrier b; b.bar = bar; b.x = xb_xcc_id(); b.st = st;
    if (threadIdx.x == 0) (void)xb_add(&bar[XB_XCNT(b.x)], 1u);
    return b;
}
__device__ __forceinline__ void xcd_barrier_complete(unsigned* bar, unsigned x, unsigned& nloc, unsigned& nx) {
    const unsigned G = gridDim.x * gridDim.y * gridDim.z;
    unsigned sum, cnt, mine, sp = 0u;
    for (;;) {
        sum = 0u; cnt = 0u; mine = 0u;
#pragma unroll
        for (unsigned j = 0; j < 16; ++j) { const unsigned c = xb_ld(&bar[XB_XCNT(j)]); sum += c; cnt += (c > 0u) ? 1u : 0u; mine = (j == x) ? c : mine; }
        if (sum == G) break;
        __builtin_amdgcn_s_sleep(1);
        if ((++sp & 255u) == 0u) { if (xb_ld(&bar[XB_TMO])) break; if (sp > XB_SPIN_CAP) { atomicAdd(&bar[XB_TMO], 1u); break; } }
    }
    nloc = mine > 0u ? mine : 1u; nx = cnt > 0u ? cnt : 1u;
}
__device__ __forceinline__ void xcd_barrier(const XcdBarrier& b) {
    asm volatile("s_waitcnt vmcnt(0)" ::: "memory");
    __syncthreads();
    if (threadIdx.x == 0) {
        unsigned* bar = b.bar;
        __builtin_amdgcn_s_waitcnt(0);
        unsigned nloc = b.st[0], nx = b.st[1];
        if (nloc == 0u) { xcd_barrier_complete(bar, b.x, nloc, nx); b.st[0] = nloc; b.st[1] = nx; }
        const unsigned old = xb_add(&bar[XB_XSUB(b.x)], 1u);
        const unsigned gen = old / nloc;
        if (old + 1u == (gen + 1u) * nloc) {
            __builtin_amdgcn_fence(__ATOMIC_RELEASE, "agent");
            asm volatile("s_waitcnt vmcnt(0)" ::: "memory");
            const unsigned og = xb_add(&bar[XB_TOP], 1u);
            const unsigned tg = og / nx;
            if (og + 1u == (tg + 1u) * nx) xb_add(&bar[XB_TOPGEN], 1u);
            else XB_SPIN(xb_ld(&bar[XB_TOPGEN]) == tg, bar);
            __builtin_amdgcn_fence(__ATOMIC_ACQUIRE, "agent");
            xb_add(&bar[XB_XGEN(b.x)], 1u);
            asm volatile("s_waitcnt vmcnt(0)" ::: "memory");
        } else {
            XB_SPIN(xb_ld(&bar[XB_XGEN(b.x)]) == gen, bar);
            __builtin_amdgcn_fence(__ATOMIC_ACQUIRE, "agent");
            asm volatile("s_waitcnt vmcnt(0)" ::: "memory");
        }
    }
    __syncthreads();
}

struct Args { const float* in[19]; float* out; unsigned char* ws; int ph_lo, ph_hi; };
typedef const __attribute__((address_space(4))) Args* ArgsP;
enum { I_X = 0, I_N1G, I_WIN, I_CONVW, I_IFB, I_MNG, I_WBM, I_WBA, I_WOUT, I_RELB, I_N2G, I_WGRP, I_BGRP, I_WEXP, I_BEXP, I_W1, I_W3, I_W2, I_FG };


struct TrDesc { const float* W; bf16* WT; size_t ldn, ldk; int k0, n0, r0; };
__device__ __forceinline__ void tr_load(const TrDesc& d, f32x4 (&tv)[16], int lane) {
    const int nn4 = (lane & 15) * 4, kr = lane >> 4;
#pragma unroll
    for (int i = 0; i < 16; ++i) tv[i] = __builtin_nontemporal_load((const f32x4*)(d.W + (size_t)(d.k0 + 4 * i + kr) * d.ldn + d.n0 + nn4));
}
__device__ __forceinline__ void tr_finish(const TrDesc& d, f32x4 (&tv)[16], LAS float* scr, int lane) {
    const int nn4 = (lane & 15) * 4, kr = lane >> 4;
#pragma unroll
    for (int i = 0; i < 16; i += 4) asm volatile("" : "+v"(tv[i]), "+v"(tv[i + 1]), "+v"(tv[i + 2]), "+v"(tv[i + 3]));
#pragma unroll
    for (int i = 0; i < 16; ++i) { const int kk = 4 * i + kr; const f32x4 v = tv[i];
        LAS float* q = scr + kk * 65 + nn4; q[0] = v.x; q[1] = v.y; q[2] = v.z; q[3] = v.w; }
    LDS_WAIT();
    const int kc = (lane & 7) * 8;
#pragma unroll
    for (int p = 0; p < 8; ++p) { const int nn = 8 * p + (lane >> 3); const LAS float* sp = scr + kc * 65 + nn;
        u32x4 o; o.x = cvt_pk_bf16(sp[0], sp[65]); o.y = cvt_pk_bf16(sp[130], sp[195]); o.z = cvt_pk_bf16(sp[260], sp[325]); o.w = cvt_pk_bf16(sp[390], sp[455]);
        *(u32x4*)(d.WT + (size_t)(d.r0 + nn) * d.ldk + d.k0 + kc) = o; }
    LDS_WAIT();
}
__device__ __forceinline__ int win_src_col(int r) {
    if (r < 2048) return r;
    if (r < 3072) return r + 1024;
    if (r < 5120) return r + 1032;
    if (r < 9216) return r + 2056;
    if (r < 10240) return r - 7168;
    return r - 4088;
}
__device__ __forceinline__ TrDesc tr_decode(ArgsP a, unsigned char* ws, int it) {
    constexpr int PER_LAYER = 5632 + 512 + 512 + 1024 + 4096 + 4096 + 4096;
    const int l = it / PER_LAYER; int r = it % PER_LAYER;
    TrDesc d;
    if (r < 5632) { const int kb = r / 176, ng = r % 176;
        d.W = a->in[I_WIN] + (size_t)l * DM * INCOLS; d.ldn = INCOLS; d.k0 = 64 * kb; d.n0 = win_src_col(64 * ng); d.WT = (bf16*)(ws + WS_WINT) + (size_t)l * 11264 * 2048; d.ldk = 2048; d.r0 = 64 * ng; return d; }
    r -= 5632;
    if (r < 512) { const int kb = r / 32, ng = r % 32;
        d.W = a->in[I_WBM] + (size_t)l * 1024 * 2048; d.ldn = 2048; d.k0 = 64 * kb; d.n0 = 64 * ng; d.WT = (bf16*)(ws + WS_WBM) + (size_t)l * 2048 * 1024; d.ldk = 1024; d.r0 = 64 * ng; return d; }
    r -= 512;
    if (r < 512) { const int kb = r / 32, ng = r % 32;
        d.W = a->in[I_WBA] + (size_t)l * 1024 * 2048; d.ldn = 2048; d.k0 = 64 * kb; d.n0 = 64 * ng; d.WT = (bf16*)(ws + WS_WBA) + (size_t)l * 2048 * 1024; d.ldk = 1024; d.r0 = 64 * ng; return d; }
    r -= 512;
    if (r < 1024) { const int kb = r / 32, ng = r % 32;
        d.W = a->in[I_WOUT] + (size_t)l * 2048 * 2048; d.ldn = 2048; d.k0 = 64 * kb; d.n0 = 64 * ng; d.WT = (bf16*)(ws + WS_WOUT) + (size_t)l * 2048 * 2048; d.ldk = 2048; d.r0 = 64 * ng; return d; }
    r -= 1024;
    if (r < 8192) { const int w3 = r >= 4096; const int q = r & 4095; const int e = q >> 7, rr = q & 127, kb = rr >> 2, ng = rr & 3;
        d.W = a->in[w3 ? I_W3 : I_W1] + (size_t)(l * 32 + e) * 2048 * 256; d.ldn = 256; d.k0 = 64 * kb; d.n0 = 64 * ng;
        d.WT = (bf16*)(ws + WS_W13) + (size_t)(l * 32 + e) * 512 * 2048; d.ldk = 2048; d.r0 = 256 * (ng >> 1) + 64 * (ng & 1) + (w3 ? 128 : 0); return d; }
    r -= 8192;
    { const int e = r >> 7, rr = r & 127, kb = rr >> 5, ng = rr & 31;
        d.W = a->in[I_W2] + (size_t)(l * 32 + e) * 256 * 2048; d.ldn = 2048; d.k0 = 64 * kb; d.n0 = 64 * ng; d.WT = (bf16*)(ws + WS_W2) + (size_t)(l * 32 + e) * 2048 * 256; d.ldk = 256; d.r0 = 64 * ng; return d; }
}
#ifndef CVX
#define CVX 4096
#endif
__device__ __forceinline__ void prologue_phase(ArgsP a, LAS unsigned char* lds, int tid, int lane, int wave, int bid, int G, const int part = 0) {
    unsigned char* ws = a->ws;
    LAS float* scr = (LAS float*)(lds + wave * 16640);
    const int gw = bid * NWAVES + wave, NGW = G * NWAVES;
    constexpr int PER_LAYER = 5632 + 512 + 512 + 1024 + 4096 + 4096 + 4096;
    constexpr int W0 = 5632, W2I = PER_LAYER - 4096;
    const int v_lo = part == 0 ? 0 : part == 1 ? PER_LAYER : part == 2 ? W0 + CVX : part == 3 ? PER_LAYER + W0 : PER_LAYER + W2I;
    const int v_hi = part == 0 ? W0 + CVX : part == 1 ? PER_LAYER + W0 : part == 2 ? PER_LAYER : part == 3 ? PER_LAYER + W2I : 2 * PER_LAYER;
#define CV_ITEM(v) (v)
    f32x4 tvA[16], tvB[16]; TrDesc dA, dB;
    int it = v_lo + gw;
    if (it < v_hi) {
        int rem = (v_hi - 1 - it) / NGW;
        dA = tr_decode(a, ws, CV_ITEM(it)); tr_load(dA, tvA, lane);
#pragma unroll 1
        while (rem >= 2) {
            dB = tr_decode(a, ws, CV_ITEM(it + NGW)); tr_load(dB, tvB, lane);
            tr_finish(dA, tvA, scr, lane);
            it += 2 * NGW;
            dA = tr_decode(a, ws, CV_ITEM(it)); tr_load(dA, tvA, lane);
            tr_finish(dB, tvB, scr, lane);
            rem -= 2;
        }
        if (rem == 1) { dB = tr_decode(a, ws, CV_ITEM(it + NGW)); tr_load(dB, tvB, lane); tr_finish(dA, tvA, scr, lane); tr_finish(dB, tvB, scr, lane); }
        else tr_finish(dA, tvA, scr, lane);
    }
#undef CV_ITEM
    if (part != 0) return;
    const int gt = bid * NTHR + tid, NGT = G * NTHR;
    float* wrt = (float*)(ws + MS_WRT);
    for (int i = gt; i < 2 * 36 * 2048; i += NGT) { const int l = i / (36 * 2048), rr = i % (36 * 2048), n = rr >> 11, k = rr & 2047;
        wrt[i] = n < 4 ? a->in[I_WGRP][((size_t)l * DM + k) * 4 + n] : a->in[I_WEXP][((size_t)l * DM + k) * 32 + (n - 4)]; }
}

__device__ __forceinline__ void moe_tables(unsigned char* ws, int l, LAS unsigned char* misc, int tid) {
    LAS int* cnt = (LAS int*)(misc + MO_CNT); LAS int* ntl = (LAS int*)(misc + MO_NT); LAS int* off = (LAS int*)(misc + MO_OFF);
    LAS int* te = (LAS int*)(misc + MO_TE); LAS int* tr0 = (LAS int*)(misc + MO_TR0); LAS int* mt = (LAS int*)(misc + MO_MT);
    __syncthreads();
    if (tid < 32) { const int c = (int)__hip_atomic_load((unsigned*)(ws + WS_CTL) + CW_CNT + 32 * l + tid, __ATOMIC_RELAXED, __HIP_MEMORY_SCOPE_AGENT); cnt[tid] = c; ntl[tid] = (c + 255) >> 8; }
    __syncthreads();
    if (tid == 0) { int o = 0;
#pragma unroll 1
        for (int e = 0; e < 32; ++e) { off[e] = o; const int n = ntl[e];
#pragma unroll 1
            for (int j = 0; j < n; ++j) { te[o + j] = e; tr0[o + j] = 256 * j; } o += n; } off[32] = o; mt[0] = o; }
    __syncthreads();
}

#ifndef DRYX
#define DRYX 0
#endif
template <int MODE>
__device__ __forceinline__ void norm_phase(ArgsP a, int l, LAS unsigned char* lds, int tid, int lane, int wave, int bid, int G, const bool dry = false) {
    unsigned char* ws = a->ws;
    LAS unsigned char* misc = lds + MISC_OFF;
    if (MODE == 1 || MODE == 3) moe_tables(ws, MODE == 1 ? 0 : 1, misc, tid);
    const LAS int* off = (const LAS int*)(misc + MO_OFF);
    const float* src = (MODE == 0) ? a->in[I_X] : a->out;
    const float* gain = (MODE < 2) ? a->in[I_N1G] + l * DM : (MODE == 2 ? a->in[I_N2G] + l * DM : a->in[I_FG]);
    const int* toke = (const int*)(ws + MS_TOKE); const int* tokp = (const int*)(ws + MS_TOKP);
    const bf16* OP = (const bf16*)(ws + WS_OP);
    bf16* H = (bf16*)(ws + WS_H);
    const int gw = bid * NWAVES + wave, NGW = G * NWAVES;
    constexpr int RP = (MODE == 2) ? 4 : 2;
    for (int m0 = gw * RP; m0 < NTOK; m0 += NGW * RP) {
        f32x4 v[RP][8];
#pragma unroll
        for (int r = 0; r < RP; ++r)
#pragma unroll
            for (int j = 0; j < 8; ++j) v[r][j] = *(const f32x4*)(src + (size_t)(m0 + r) * DM + 256 * j + 4 * lane);
        if (MODE == 1 || MODE == 3) {
#pragma unroll
            for (int r = 0; r < RP; ++r) { const int m = m0 + r;
                const int e0 = toke[2 * m], e1 = toke[2 * m + 1], p0 = tokp[2 * m], p1 = tokp[2 * m + 1];
                const float cw0 = ((const float*)(ws + MS_TOKW))[2 * m], cw1 = ((const float*)(ws + MS_TOKW))[2 * m + 1];
                const bf16* o0 = OP + (size_t)(off[e0] * 256 + p0) * DM + 4 * lane; const bf16* o1 = OP + (size_t)(off[e1] * 256 + p1) * DM + 4 * lane;
                u32x2 ow0[8], ow1[8];
#pragma unroll
                for (int j = 0; j < 8; ++j) { ow0[j] = *(const u32x2*)(o0 + 256 * j); ow1[j] = *(const u32x2*)(o1 + 256 * j); }
                asm volatile("" : "+v"(ow0[0]), "+v"(ow0[1]), "+v"(ow0[2]), "+v"(ow0[3]), "+v"(ow0[4]), "+v"(ow0[5]), "+v"(ow0[6]), "+v"(ow0[7]),
                                  "+v"(ow1[0]), "+v"(ow1[1]), "+v"(ow1[2]), "+v"(ow1[3]), "+v"(ow1[4]), "+v"(ow1[5]), "+v"(ow1[6]), "+v"(ow1[7]));
#pragma unroll
                for (int j = 0; j < 8; ++j) { const u32x2 w0 = ow0[j], w1 = ow1[j];
                    v[r][j].x += cw0 * bflo(w0.x) + cw1 * bflo(w1.x); v[r][j].y += cw0 * bfhi(w0.x) + cw1 * bfhi(w1.x); v[r][j].z += cw0 * bflo(w0.y) + cw1 * bflo(w1.y); v[r][j].w += cw0 * bfhi(w0.y) + cw1 * bfhi(w1.y); }
                if (MODE == 1 && !dry) {
#pragma unroll
                    for (int j = 0; j < 8; ++j) *(f32x4*)(a->out + (size_t)m * DM + 256 * j + 4 * lane) = v[r][j]; }
                asm volatile("" ::: "memory");
            }
        }
        float rs[RP];
#pragma unroll
        for (int r = 0; r < RP; ++r) { float ss = 0.f;
#pragma unroll
            for (int j = 0; j < 8; ++j) ss += (v[r][j].x * v[r][j].x + v[r][j].y * v[r][j].y) + (v[r][j].z * v[r][j].z + v[r][j].w * v[r][j].w);
            rs[r] = __builtin_amdgcn_rsqf(wave_sum(ss) * (1.0f / DM) + RMS_EPS); }
        {
            f32x4 gv[8];
#pragma unroll
            for (int j = 0; j < 8; ++j) gv[j] = *(const f32x4*)(gain + 256 * j + 4 * lane);
            asm volatile("" : "+v"(gv[0]), "+v"(gv[1]), "+v"(gv[2]), "+v"(gv[3]), "+v"(gv[4]), "+v"(gv[5]), "+v"(gv[6]), "+v"(gv[7]));
#pragma unroll
            for (int j = 0; j < 8; ++j)
#pragma unroll
                for (int r = 0; r < RP; ++r) v[r][j] = v[r][j] * rs[r] * gv[j];
        }
        if (MODE == 3) {
#pragma unroll
            for (int r = 0; r < RP; ++r)
#pragma unroll
                for (int j = 0; j < 8; ++j) { if (!dry) *(f32x4*)(a->out + (size_t)(m0 + r) * DM + 256 * j + 4 * lane) = v[r][j]; else asm volatile("" :: "v"(v[r][j])); }
            continue;
        }
#pragma unroll
        for (int r = 0; r < RP; ++r)
#pragma unroll
            for (int j = 0; j < 8; ++j) { u32x2 w; w.x = cvt_pk_bf16(v[r][j].x, v[r][j].y); w.y = cvt_pk_bf16(v[r][j].z, v[r][j].w);
                if (!dry) *(u32x2*)(H + (size_t)(m0 + r) * DM + 256 * j + 4 * lane) = w; else asm volatile("" :: "v"(w)); }
        float keep[RP]; _Pragma("unroll") for (int r = 0; r < RP; ++r) keep[r] = 0.f;
        if (MODE < 2) {
            float a8[RP][8];
#pragma unroll
            for (int r = 0; r < RP; ++r)
#pragma unroll
                for (int n = 0; n < 8; ++n) a8[r][n] = 0.f;
            const float* wg = a->in[I_WIN] + (size_t)l * DM * INCOLS + 4096;
#pragma unroll
            for (int j = 0; j < 8; ++j)
#pragma unroll
                for (int c = 0; c < 4; ++c) { const float* wp = wg + (size_t)(256 * j + 4 * lane + c) * INCOLS;
                    const f32x4 w0 = *(const f32x4*)wp, w1 = *(const f32x4*)(wp + 4);
#pragma unroll
                    for (int r = 0; r < RP; ++r) { const float hv = v[r][j][c];
                        a8[r][0] += hv * w0.x; a8[r][1] += hv * w0.y; a8[r][2] += hv * w0.z; a8[r][3] += hv * w0.w;
                        a8[r][4] += hv * w1.x; a8[r][5] += hv * w1.y; a8[r][6] += hv * w1.z; a8[r][7] += hv * w1.w; }
                    if (c == 3) asm volatile("" ::: "memory"); }
#pragma unroll
            for (int r = 0; r < RP; ++r)
#pragma unroll
                for (int n = 0; n < 8; ++n) { const float d = wave_sum(a8[r][n]); keep[r] = (lane == n) ? d : keep[r]; }
        } else {
            const float* W = (const float*)(ws + MS_WRT) + (size_t)l * 36 * 2048;
            LAS float* logl = (LAS float*)(misc + MO_LOG) + wave * 160;
#pragma unroll 1
            for (int grp = 0; grp < 9; ++grp) {
                float val[16];
                const float* wg = W + (size_t)(4 * grp) * 2048 + 4 * lane;
#pragma unroll
                for (int nl = 0; nl < 4; ++nl) {
                    float d[4] = {0.f, 0.f, 0.f, 0.f};
                    f32x4 wv[8];
#pragma unroll
                    for (int j = 0; j < 8; ++j) wv[j] = *(const f32x4*)(wg + nl * 2048 + 256 * j);
                    asm volatile("" : "+v"(wv[0]), "+v"(wv[1]), "+v"(wv[2]), "+v"(wv[3]), "+v"(wv[4]), "+v"(wv[5]), "+v"(wv[6]), "+v"(wv[7]));
#pragma unroll
                    for (int j = 0; j < 8; ++j) { const f32x4 w = wv[j];
#pragma unroll
                        for (int r = 0; r < 4; ++r) d[r] += (v[r][j].x * w.x + v[r][j].y * w.y) + (v[r][j].z * w.z + v[r][j].w * w.w); }
#pragma unroll
                    for (int r = 0; r < 4; ++r) val[4 * nl + r] = d[r];
                }
#pragma unroll
                for (int i = 0; i < 8; ++i) { const bool hi = (lane & 32) != 0; const float snd = hi ? val[i] : val[i + 8]; const float kp = hi ? val[i + 8] : val[i]; val[i] = kp + __shfl_xor(snd, 32); }
#pragma unroll
                for (int i = 0; i < 4; ++i) { const bool hi = (lane & 16) != 0; const float snd = hi ? val[i] : val[i + 4]; const float kp = hi ? val[i + 4] : val[i]; val[i] = kp + __shfl_xor(snd, 16); }
#pragma unroll
                for (int i = 0; i < 2; ++i) { const bool hi = (lane & 8) != 0; const float snd = hi ? val[i] : val[i + 2]; const float kp = hi ? val[i + 2] : val[i]; val[i] = kp + __shfl_xor(snd, 8); }
                { const bool hi = (lane & 4) != 0; const float snd = hi ? val[0] : val[1]; const float kp = hi ? val[1] : val[0]; val[0] = kp + __shfl_xor(snd, 4); }
                float f = val[0]; f += __shfl_xor(f, 2); f += __shfl_xor(f, 1);
                const int vi = lane >> 2;
                if ((lane & 3) == 0) logl[(vi & 3) * 40 + 4 * grp + (vi >> 2)] = f;
            }
        }
        if (MODE < 2) {
            float* ifg = (float*)(ws + MS_IFG);
            if (lane < 8) {
#pragma unroll
                for (int r = 0; r < RP; ++r) { if (!dry) ifg[(size_t)(m0 + r) * 8 + lane] = keep[r]; else asm volatile("" :: "v"(keep[r])); } }
        } else {
            LAS float* logl = (LAS float*)(misc + MO_LOG) + wave * 160;
            LDS_WAIT();
            if (dry) { asm volatile("" :: "v"(keep[0])); }
            if (lane < RP && !dry) {
                const int m = m0 + lane; const LAS float* lg = logl + lane * 40;
                const float* bg = a->in[I_BGRP] + l * 4; const float* be = a->in[I_BEXP] + l * 32;
                float gv[4]; int gsel = 0;
#pragma unroll
                for (int j = 0; j < 4; ++j) gv[j] = lg[j] + bg[j];
                float gmax = gv[0];
#pragma unroll
                for (int j = 1; j < 4; ++j) if (gv[j] > gmax) { gmax = gv[j]; gsel = j; }
                float gs = 0.f;
#pragma unroll
                for (int j = 0; j < 4; ++j) gs += expf(gv[j] - gmax);
                const float pg = 1.0f / gs;
                float ev[8];
#pragma unroll
                for (int j = 0; j < 8; ++j) ev[j] = lg[4 + 8 * gsel + j] + be[8 * gsel + j];
                int e0 = 0; float m0v = ev[0];
#pragma unroll
                for (int j = 1; j < 8; ++j) if (ev[j] > m0v) { m0v = ev[j]; e0 = j; }
                int e1 = -1; float m1v = -3.0e38f;
#pragma unroll
                for (int j = 0; j < 8; ++j) if (j != e0 && ev[j] > m1v) { m1v = ev[j]; e1 = j; }
                const float p1 = expf(m1v - m0v); const float w0 = pg / (1.0f + p1), w1 = pg * p1 / (1.0f + p1);
                unsigned* cnt = (unsigned*)(ws + WS_CTL) + CW_CNT + 32 * l;
                int* list = (int*)(ws + MS_LIST); float* pwl = (float*)(ws + MS_PWL); int* tke = (int*)(ws + MS_TOKE); int* tkp = (int*)(ws + MS_TOKP);
                const int id0 = 8 * gsel + e0, id1 = 8 * gsel + e1;
                const int q0 = (int)__hip_atomic_fetch_add(cnt + id0, 1u, __ATOMIC_RELAXED, __HIP_MEMORY_SCOPE_AGENT);
                const int q1 = (int)__hip_atomic_fetch_add(cnt + id1, 1u, __ATOMIC_RELAXED, __HIP_MEMORY_SCOPE_AGENT);
                list[id0 * 8192 + q0] = m; pwl[id0 * 8192 + q0] = w0; list[id1 * 8192 + q1] = m; pwl[id1 * 8192 + q1] = w1;
                tke[2 * m] = id0; tke[2 * m + 1] = id1; tkp[2 * m] = q0; tkp[2 * m + 1] = q1;
                ((float*)(ws + MS_TOKW))[2 * m] = w0; ((float*)(ws + MS_TOKW))[2 * m + 1] = w1;
            }
            LDS_WAIT();
        }
    }
}

struct SchedG1 {
    static constexpr bool GATHER = false;
    const char* H; const char* W; int G, c;
    static constexpr int NCV = 21;
    __device__ __forceinline__ bool next(int i, Unit& u) const {
        int L = i * G + c;
        if (G == 256) {
            if (c >= 256 - NCV) return false;
            if (c >= 128 && i == 5) { const int k = c - 128; if (k >= 5 * NCV) return false; L = (k % 5) * 256 + (256 - NCV) + k / 5; }
            else if (i > 5) return false;
        }
        if (L < 1152) { pg8::static_tile(L, 32, 36, u.pm, u.pn); u.aux = 0; return true; }
        const int r = L - 1152; if (r >= 256) return false;
        u.aux = 1 + (r >> 7); const int q = r & 127; u.pm = q & 3; u.pn = q >> 2; return true;
    }
    __device__ __forceinline__ const char* abase(const Unit& u) const { return u.aux == 0 ? H + (size_t)u.pm * 256 * 4096 : W + (size_t)(9216 + (u.aux - 1) * 1024 + u.pm * 256) * 4096; }
    __device__ __forceinline__ const char* bbase(const Unit& u) const { return u.aux == 0 ? W + (size_t)u.pn * 256 * 4096 : H + (size_t)u.pn * 256 * 4096; }
    __device__ __forceinline__ unsigned arow(const Unit&, int) const { return 0u; }
    static __device__ __forceinline__ bool keep_acc(const Unit&) { return false; }
};
struct EpiG1 {
    static constexpr bool PERM = true;
    unsigned char* ws; bool dry;
    __device__ __forceinline__ void operator()(f32x4 (&acc)[2][2][4][2], const Unit& u, int wr, int wc, int fr, int fq) const {
        if (dry) {
#pragma unroll
            for (int ai = 0; ai < 2; ++ai)
#pragma unroll
                for (int bj = 0; bj < 2; ++bj)
#pragma unroll
                    for (int m = 0; m < 4; ++m) asm volatile("" :: "v"(acc[ai][bj][m][0]), "v"(acc[ai][bj][m][1]));
            return; }
        if (u.aux == 0) {
            bf16* dst; int ld, colt, op;
            if (u.pn < 8) { dst = (bf16*)(ws + WS_ZQK); ld = 2048; colt = 256 * u.pn; op = 0; }
            else if (u.pn < 12) { dst = (bf16*)(ws + WS_OM); ld = 1024; colt = 256 * (u.pn - 8); op = 1; }
            else if (u.pn < 16) { dst = (bf16*)(ws + WS_QA); ld = 1024; colt = 256 * (u.pn - 12); op = 2; }
            else if (u.pn < 20) { dst = (bf16*)(ws + WS_KA); ld = 1024; colt = 256 * (u.pn - 16); op = 0; }
            else { dst = (bf16*)(ws + WS_SG); ld = 4096; colt = 256 * (u.pn - 20); op = 1; }
            const float scl = (op == 2) ? 0.12751743074602267f : 1.0f;
            const int row0 = u.pm * 256 + wr * 64 + fr, col0 = colt + wc * 32 + 8 * fq;
#pragma unroll
            for (int ai = 0; ai < 2; ++ai)
#pragma unroll
                for (int m = 0; m < 4; ++m) { bf16* rowp = dst + (size_t)(row0 + ai * 128 + m * 16) * ld + col0;
#pragma unroll
                    for (int bj = 0; bj < 2; ++bj) { f32x4 v0 = acc[ai][bj][m][0] * scl, v1 = acc[ai][bj][m][1] * scl;
                        if (op == 1) {
#pragma unroll
                            for (int j = 0; j < 4; ++j) { v0[j] = sigmoidf_(v0[j]); v1[j] = sigmoidf_(v1[j]); } }
                        u32x4 w; w.x = cvt_pk_bf16(v0[0], v0[1]); w.y = cvt_pk_bf16(v0[2], v0[3]); w.z = cvt_pk_bf16(v1[0], v1[1]); w.w = cvt_pk_bf16(v1[2], v1[3]);
                        *(u32x4*)(rowp + bj * 128) = w; } }
        } else {
            bf16* dst = (bf16*)(ws + (u.aux == 1 ? WS_VMT : WS_VAT));
            const int b = u.pn >> 3, s0 = (u.pn & 7) * 256 + wc * 32 + 8 * fq, rr0 = u.pm * 256 + wr * 64 + fr;
#pragma unroll
            for (int ai = 0; ai < 2; ++ai)
#pragma unroll
                for (int m = 0; m < 4; ++m) { const int rr = rr0 + ai * 128 + m * 16;
#pragma unroll
                    for (int bj = 0; bj < 2; ++bj) { const f32x4 v0 = acc[ai][bj][m][0], v1 = acc[ai][bj][m][1];
                        u32x4 w; w.x = cvt_pk_bf16(v0[0], v0[1]); w.y = cvt_pk_bf16(v0[2], v0[3]); w.z = cvt_pk_bf16(v1[0], v1[1]); w.w = cvt_pk_bf16(v1[2], v1[3]);
                        const int sq = s0 + bj * 128;
                        const size_t off = (u.aux == 1) ? (size_t)((((b * 4 + (rr >> 8)) * 32 + (sq >> 6)) * 2 + ((sq >> 5) & 1)) * 16 + ((rr & 255) >> 4)) * 512 + (size_t)((((sq >> 3) & 3) * 16 + (rr & 15)) * 8)
                                                        : (size_t)(b * 1024 + rr) * 2048 + sq;
                        *(u32x4*)(dst + off) = w; } }
        }
    }
};

__device__ __forceinline__ void gate_unit(ArgsP a, int l, LAS unsigned char* lds, int bh, int tid, int lane, int wave) {
    unsigned char* ws = a->ws;
    {
            const int b = bh >> 2, h = bh & 3;
            LAS float* bl = (LAS float*)lds; LAS float* amx = bl + 32; LAS float* mpv = bl + 64; LAS float* gcv = bl + 96;
            const float* ifg = (const float*)(ws + MS_IFG); const float* ifb = a->in[I_IFB] + l * 8;
            float A[4], Bs[4], CM[4];
#pragma unroll
            for (int cc = 0; cc < 4; ++cc) { const int c = wave + 8 * cc, s = 64 * c + lane; const size_t tok = (size_t)b * SEQ + s;
                const float ig = ifg[tok * 8 + h] + ifb[h], fg = ifg[tok * 8 + 4 + h] + ifb[4 + h];
                const float lf = fminf(fg, 0.f) - log1pf(expf(-fabsf(fg)));
                float bs = lf;
#pragma unroll
                for (int o = 1; o < 64; o <<= 1) { const float t = __shfl_up(bs, o); if (lane >= o) bs += t; }
                const float av = ig - bs; float cm = av;
#pragma unroll
                for (int o = 1; o < 64; o <<= 1) { const float t = __shfl_up(cm, o); if (lane >= o) cm = fmaxf(cm, t); }
                A[cc] = av; Bs[cc] = bs; CM[cc] = cm;
                if (lane == 63) { bl[c] = bs; amx[c] = cm; } }
            __syncthreads();
            if (tid == 0) { float m = 0.f;
#pragma unroll 1
                for (int c = 0; c < 32; ++c) { mpv[c] = m; const float Gm = fmaxf(m, amx[c]); gcv[c] = Gm; m = bl[c] + Gm; } }
            __syncthreads();
            float* AS = (float*)(ws + MS_AS) + bh * 2048; float* GT = (float*)(ws + MS_GT) + bh * 2048; float* WI = (float*)(ws + MS_WI) + bh * 2048;
            float* CL = (float*)(ws + MS_CL) + bh * 2048; float* WSs = (float*)(ws + MS_WS) + bh * 2048; float* DEC = (float*)(ws + MS_DEC) + bh * 32;
#pragma unroll
            for (int cc = 0; cc < 4; ++cc) { const int c = wave + 8 * cc, s = 64 * c + lane; const float mp = mpv[c], Gm = gcv[c], gt = fmaxf(mp, CM[cc]);
                AS[s] = A[cc]; GT[s] = gt; WI[s] = expf(mp - gt); CL[s] = expf(-(Bs[cc] + gt)); WSs[s] = expf(A[cc] - Gm);
                if (lane == 0) DEC[c] = expf(mp - Gm); }
        }
    __syncthreads();
}

__device__ __forceinline__ void conv_phase(ArgsP a, int l, LAS unsigned char* lds, int tid, int lane, int wave, int bid, int G) {
    unsigned char* ws = a->ws;
    u32x4 xv[5];
    const bf16* Z = (const bf16*)(ws + WS_ZQK);
#define CONV_LOAD(u_) do { const int cg_ = (u_) & 7, s0_ = 64 * (((u_) >> 3) & 31), b_ = (u_) >> 8; _Pragma("unroll") for (int i = 0; i < 5; ++i) { \
        const int idx = tid + NTHR * i, row = idx >> 5, ch = idx & 31, sq = s0_ - 3 + row; xv[i] = (u32x4){0u, 0u, 0u, 0u}; \
        if (idx < 67 * 32 && sq >= 0) xv[i] = *(const u32x4*)(Z + (size_t)(b_ * SEQ + sq) * 2048 + cg_ * 256 + ch * 8); } } while (0)
    if (bid < 1024) CONV_LOAD(bid);
    for (int u = bid; u < 1024 + 256; u += G) {
        if (u < 1024) {
            const int cg = u & 7, st = (u >> 3) & 31, b = u >> 8, s0 = 64 * st;
            LAS unsigned char* xt = lds; LAS unsigned char* kt = lds + 36864;
            asm volatile("" : "+v"(xv[0]), "+v"(xv[1]), "+v"(xv[2]), "+v"(xv[3]), "+v"(xv[4]));
#pragma unroll
            for (int i = 0; i < 5; ++i) { const int idx = tid + NTHR * i, row = idx >> 5, ch = idx & 31;
                if (idx < 67 * 32) *(LAS u32x4*)(xt + row * 512 + ch * 16) = xv[i]; }
            LAS float* wst = (LAS float*)(lds + 73728);
            if (cg >= 4 && tid < 64) wst[tid] = ((const float*)(ws + MS_WS))[(size_t)(b * 4 + cg - 4) * 2048 + s0 + tid];
            __syncthreads();
            if (u + G < 1024) CONV_LOAD(u + G);
            const int cp = tid & 127, tg = tid >> 7, c = 2 * cp, gc = cg * 256 + c;
            float w0[4], w1[4];
#pragma unroll
            for (int j = 0; j < 4; ++j) { w0[j] = a->in[I_CONVW][(size_t)(l * 4 + j) * 2048 + gc]; w1[j] = a->in[I_CONVW][(size_t)(l * 4 + j) * 2048 + gc + 1]; }
            bf16* QM = (bf16*)(ws + WS_QM); bf16* KM = (bf16*)(ws + WS_KM);
#pragma unroll 4
            for (int tt = 0; tt < 16; ++tt) { const int t = tg * 16 + tt; float a0 = 0.f, a1 = 0.f;
#pragma unroll
                for (int j = 0; j < 4; ++j) { const unsigned x = *(const LAS unsigned*)(xt + (t + j) * 512 + c * 2); a0 += w0[j] * bflo(x); a1 += w1[j] * bfhi(x); }
                float o0 = a0 * sigmoidf_(a0), o1 = a1 * sigmoidf_(a1);
                const size_t tok = (size_t)b * SEQ + s0 + t;
                if (cg < 4) { *(unsigned*)(QM + tok * 1024 + cg * 256 + c) = cvt_pk_bf16(o0, o1); }
                else { o0 *= 0.0625f; o1 *= 0.0625f; const unsigned p = cvt_pk_bf16(o0, o1);
                    *(unsigned*)(KM + tok * 1024 + (cg - 4) * 256 + c) = p;
                    const float wsv = wst[t]; const unsigned ps = cvt_pk_bf16(o0 * wsv, o1 * wsv);
                    *(LAS unsigned short*)(kt + c * 144 + t * 2) = (unsigned short)(ps & 0xffffu); *(LAS unsigned short*)(kt + (c + 1) * 144 + t * 2) = (unsigned short)(ps >> 16); }
            }
            if (cg >= 4) {
                __syncthreads();
                bf16* KMT = (bf16*)(ws + WS_KMT);
                for (int idx = tid; idx < 2048; idx += NTHR) {
                    const int ks = idx >> 10, dtl = (idx >> 6) & 15, ln = idx & 63, row = dtl * 16 + (ln & 15), ch = ks * 4 + (ln >> 4);
                    const u32x4 v = *(const LAS u32x4*)(kt + row * 144 + ch * 16);
                    *(u32x4*)(KMT + (size_t)(((b * 4 + cg - 4) * 32 + st) * 2) * 8192 + (size_t)idx * 8) = v; }
                if (tid < 256) {
                    float sm = 0.f;
#pragma unroll
                    for (int i = 0; i < 8; ++i) { const u32x4 v = *(const LAS u32x4*)(kt + tid * 144 + i * 16);
                        sm += (bflo(v.x) + bfhi(v.x)) + (bflo(v.y) + bfhi(v.y)) + (bflo(v.z) + bfhi(v.z)) + (bflo(v.w) + bfhi(v.w)); }
                    ((float*)(ws + MS_NST))[(size_t)((b * 4 + cg - 4) * 32 + st) * 256 + tid] = sm; }
            }
        } else if (u < 1280) {
            const int j = u - 1024, b = j >> 6, n = (j >> 3) & 7, h = j & 7;
            const bf16* KA = (const bf16*)(ws + WS_KA) + (size_t)(b * SEQ + n * 256 + wave * 32) * 1024 + h * 128 + 2 * lane;
            float s0 = 0.f, s1 = 0.f;
            unsigned xr[32];
#pragma unroll
            for (int r = 0; r < 32; ++r) xr[r] = *(const unsigned*)(KA + (size_t)r * 1024);
#pragma unroll
            for (int r = 0; r < 32; r += 8) asm volatile("" : "+v"(xr[r]), "+v"(xr[r + 1]), "+v"(xr[r + 2]), "+v"(xr[r + 3]), "+v"(xr[r + 4]), "+v"(xr[r + 5]), "+v"(xr[r + 6]), "+v"(xr[r + 7]));
#pragma unroll
            for (int r = 0; r < 32; ++r) { s0 += bflo(xr[r]); s1 += bfhi(xr[r]); }
            LAS float* part = (LAS float*)lds;
            part[wave * 128 + 2 * lane] = s0; part[wave * 128 + 2 * lane + 1] = s1;
            __syncthreads();
            if (tid < 128) { float t = 0.f;
#pragma unroll
                for (int w = 0; w < 8; ++w) t += part[w * 128 + tid];
                ((float*)(ws + MS_KMEAN))[(size_t)((b * 8 + h) * 8 + n) * 128 + tid] = t * (1.0f / 256.0f); }
        }
        __syncthreads();
    }
}

#undef CONV_LOAD
__device__ __forceinline__ void mlstm_ab_task(unsigned char* ws, int gw, int lane, const bool do_store = true) {
    const int bh = gw >> 7, piece = gw & 127, e0 = (piece >> 3) * 16, d0 = (piece & 7) * 32, q16 = lane & 15, g = lane >> 4;
    const bf16* ka = (const bf16*)(ws + WS_KMT) + (size_t)bh * 32 * 16384 + (size_t)(d0 >> 4) * 512 + lane * 8;
    const bf16* vb = (const bf16*)(ws + WS_VMT) + (size_t)bh * 32 * 16384 + (size_t)(e0 >> 4) * 512 + lane * 8;
    const float* DEC = (const float*)(ws + MS_DEC) + bh * 32;
    bf16* CST = (bf16*)(ws + WS_CST) + (size_t)bh * 32 * 65536 + (size_t)((d0 >> 5) * 16 + (e0 >> 4)) * 512 + (size_t)(((g >> 1) * 16 + q16) * 8 + 4 * (g & 1));
    f32x4 acc[2]; acc[0] = (f32x4){0.f, 0.f, 0.f, 0.f}; acc[1] = acc[0];
    const int decv = __builtin_bit_cast(int, DEC[lane & 31]);
    bf16x8 A0[2][2], B0[2], A1[2][2], B1[2], A2[2][2], B2[2], A3[2][2], B3[2], A4[2][2], B4[2];
#define AB_LOAD(c_, A_, B_) do { const int cc_ = (c_) < 31 ? (c_) : 31; _Pragma("unroll") for (int ks = 0; ks < 2; ++ks) { \
        A_[0][ks] = *(const bf16x8*)(ka + (size_t)cc_ * 16384 + ks * 8192); A_[1][ks] = *(const bf16x8*)(ka + (size_t)cc_ * 16384 + ks * 8192 + 512); B_[ks] = *(const bf16x8*)(vb + (size_t)cc_ * 16384 + ks * 8192); } } while (0)
#define AB_STEP(c_, A_, B_) do { \
        if (do_store) { _Pragma("unroll") for (int f = 0; f < 2; ++f) { u32x2 w; w.x = cvt_pk_bf16(acc[f][0], acc[f][1]); w.y = cvt_pk_bf16(acc[f][2], acc[f][3]); *(u32x2*)(CST + (size_t)(c_) * 65536 + 256 * f) = w; } } \
        const float dec = __builtin_bit_cast(float, __builtin_amdgcn_readlane(decv, (c_))); \
        acc[0] = acc[0] * dec; acc[1] = acc[1] * dec; \
        _Pragma("unroll") for (int ks = 0; ks < 2; ++ks) { \
            acc[0] = __builtin_amdgcn_mfma_f32_16x16x32_bf16(A_[0][ks], B_[ks], acc[0], 0, 0, 0); \
            acc[1] = __builtin_amdgcn_mfma_f32_16x16x32_bf16(A_[1][ks], B_[ks], acc[1], 0, 0, 0); } } while (0)
    AB_LOAD(0, A0, B0); AB_LOAD(1, A1, B1); AB_LOAD(2, A2, B2); AB_LOAD(3, A3, B3); AB_LOAD(4, A4, B4);
#pragma unroll 1
    for (int c = 0; c < 30; c += 5) {
        AB_STEP(c, A0, B0); AB_LOAD(c + 5, A0, B0);
        AB_STEP(c + 1, A1, B1); AB_LOAD(c + 6, A1, B1);
        AB_STEP(c + 2, A2, B2); AB_LOAD(c + 7, A2, B2);
        AB_STEP(c + 3, A3, B3); AB_LOAD(c + 8, A3, B3);
        AB_STEP(c + 4, A4, B4); AB_LOAD(c + 9, A4, B4);
    }
    AB_STEP(30, A0, B0); AB_STEP(31, A1, B1);
    if (!do_store) asm volatile("" :: "v"(acc[0]), "v"(acc[1]));
#undef AB_LOAD
#undef AB_STEP
}

__device__ __forceinline__ void nscan_task(unsigned char* ws, int t, int lane) {
    const int bh = t >> 2, d = (t & 3) * 64 + lane;
    const float* cs = (const float*)(ws + MS_NST) + (size_t)bh * 32 * 256 + d;
    float* nv = (float*)(ws + MS_NVEC) + (size_t)bh * 32 * 256 + d;
    const int decv = __builtin_bit_cast(int, ((const float*)(ws + MS_DEC))[bh * 32 + (lane & 31)]);
    float v[32];
#pragma unroll
    for (int j = 0; j < 32; ++j) v[j] = cs[j * 256];
    float n = 0.f;
#pragma unroll
    for (int j = 0; j < 32; ++j) { nv[j * 256] = n; n = __builtin_bit_cast(float, __builtin_amdgcn_readlane(decv, j)) * n + v[j]; }
}

__device__ __forceinline__ int rel_bucket_dev(int n) {
    if (n < 16) return n;
    int b = 16;
    b += (n >= 19); b += (n >= 21); b += (n >= 24); b += (n >= 27); b += (n >= 31); b += (n >= 35); b += (n >= 40); b += (n >= 46);
    b += (n >= 52); b += (n >= 59); b += (n >= 67); b += (n >= 77); b += (n >= 87); b += (n >= 99); b += (n >= 113);
    return b;
}
constexpr int AT_KT = 0, AT_VT = 34816, AT_TAB = 71680, AT_SEL = 72704, AT_TILES = 73216, AT_CTL = 73600, AT_KM = 73728;
__device__ __forceinline__ void attn_unit(ArgsP a, LAS unsigned char* lds, int uidx, int tid, int lane, int wave) {
    unsigned char* ws = a->ws;
    const int u256 = uidx & 255, second = uidx >> 8, bh = u256 >> 3, kk8 = u256 & 7, si = second ? 15 - kk8 : kk8, wgt = 16 - si;
    const int blk = (wgt - 1) >> 1, half = (wgt - 1) & 1, b = bh >> 3, h = bh & 7, q0 = blk * 256 + half * 128;
    const int q16 = lane & 15, g = lane >> 4;
    LAS float* tab = (LAS float*)(lds + AT_TAB); LAS unsigned* sels = (LAS unsigned*)(lds + AT_SEL); LAS int* tiles = (LAS int*)(lds + AT_TILES);
    LAS unsigned* ctl = (LAS unsigned*)(lds + AT_CTL); LAS float* kms = (LAS float*)(lds + AT_KM);
    const bf16* QA = (const bf16*)(ws + WS_QA); const bf16* KA = (const bf16*)(ws + WS_KA); const bf16* VAT = (const bf16*)(ws + WS_VAT);
    u32x4 sr[8], qst[4];
    const int row0 = tid >> 4, ch = tid & 15;
    const bf16* kbase = KA + (size_t)(b * SEQ + row0) * 1024 + h * 128 + ch * 8;
    const bf16* vbase = VAT + (size_t)(bh * 128 + row0) * 2048 + ch * 8;
#define AT_LOAD(ks0_) do { _Pragma("unroll") for (int i = 0; i < 4; ++i) { \
        sr[i] = *(const u32x4*)(kbase + (size_t)((ks0_) + 32 * i) * 1024); sr[4 + i] = *(const u32x4*)(vbase + (size_t)(32 * i) * 2048 + (ks0_)); } } while (0)
#pragma unroll
    for (int i = 0; i < 4; ++i) qst[i] = *(const u32x4*)(QA + (size_t)(b * SEQ + q0 + row0 + 32 * i) * 1024 + h * 128 + ch * 8);
    AT_LOAD(blk * 256);
    if (tid <= 128) tab[tid] = a->in[I_RELB][rel_bucket_dev(tid) * 8 + h] * 1.4426950408889634f;
    for (int idx = tid; idx < 1024; idx += NTHR) kms[idx] = ((const float*)(ws + MS_KMEAN))[bh * 1024 + idx];
    if (tid == 0) ctl[0] = 0u;
    __syncthreads();
    {
        const int q = tid >> 2, part = tid & 3;
        const bf16* qp = QA + (size_t)(b * SEQ + q0 + q) * 1024 + h * 128 + part * 32;
        float qf32[32];
#pragma unroll
        for (int i = 0; i < 4; ++i) { const u32x4 v = *(const u32x4*)(qp + 8 * i);
            qf32[8 * i + 0] = bflo(v.x); qf32[8 * i + 1] = bfhi(v.x); qf32[8 * i + 2] = bflo(v.y); qf32[8 * i + 3] = bfhi(v.y);
            qf32[8 * i + 4] = bflo(v.z); qf32[8 * i + 5] = bfhi(v.z); qf32[8 * i + 6] = bflo(v.w); qf32[8 * i + 7] = bfhi(v.w); }
        float gate[8];
#pragma unroll
        for (int n = 0; n < 8; ++n) { float s = 0.f;
            if (n < blk) {
#pragma unroll
                for (int d = 0; d < 32; d += 4) { const f32x4 kv = *(const LAS f32x4*)(kms + n * 128 + part * 32 + d);
                    s += (qf32[d] * kv.x + qf32[d + 1] * kv.y) + (qf32[d + 2] * kv.z + qf32[d + 3] * kv.w); }
            }
            s += __shfl_xor(s, 1); s += __shfl_xor(s, 2); gate[n] = s; }
        if (part == 0) {
            unsigned sel;
            if (blk <= 3) sel = (1u << blk) - 1u;
            else { sel = 0u;
#pragma unroll
                for (int it = 0; it < 3; ++it) { int best = 0; float bv = -3.0e38f;
#pragma unroll
                    for (int n = 0; n < 8; ++n) if (n < blk && !((sel >> n) & 1u) && gate[n] > bv) { bv = gate[n]; best = n; }
                    sel |= 1u << best; } }
            sels[q] = sel; atomicOr((unsigned*)ctl, sel);
        }
    }
    __syncthreads();
    if (tid == 0) { int nt = 0; const unsigned any = ctl[0];
        for (int j = 0; j < half + 1; ++j) tiles[nt++] = blk * 256 + 128 * j;
        for (int n = 0; n < blk; ++n) if ((any >> n) & 1u) for (int j = 0; j < 2; ++j) tiles[nt++] = n * 256 + 128 * j;
        ctl[1] = (unsigned)nt; }
    __syncthreads();
    const int ntiles = (int)ctl[1];
    const int qg = wave & 3, kp = wave >> 2;
    int qpos[2]; unsigned mysel[2];
#pragma unroll
    for (int f = 0; f < 2; ++f) { qpos[f] = q0 + 32 * qg + 16 * f + q16; mysel[f] = sels[32 * qg + 16 * f + q16]; }
    constexpr int AT_Q = 77824;
#pragma unroll
    for (int i = 0; i < 4; ++i) *(LAS u32x4*)(lds + AT_Q + (row0 + 32 * i) * 272 + ch * 16) = qst[i];
    const LAS unsigned char* qrow = lds + AT_Q + (32 * qg + q16) * 272 + 16 * g;
    float m_run[2] = {-1.0e30f, -1.0e30f}, l_run[2] = {0.f, 0.f};
    f32x4 oacc[2][8];
#pragma unroll
    for (int f = 0; f < 2; ++f)
#pragma unroll
        for (int m = 0; m < 8; ++m) oacc[f][m] = (f32x4){0.f, 0.f, 0.f, 0.f};
    const int vpos = (ch >> 2) * 32 + 16 * (ch & 1) + 4 * ((ch & 3) >> 1);
#define AT_WRITE() do { _Pragma("unroll") for (int i = 0; i < 4; ++i) { \
        *(LAS u32x4*)(lds + AT_KT + (row0 + 32 * i) * 272 + ch * 16) = sr[i]; \
        *(LAS u32x2*)(lds + AT_VT + (row0 + 32 * i) * 272 + vpos * 2) = (u32x2){sr[4 + i].x, sr[4 + i].y}; \
        *(LAS u32x2*)(lds + AT_VT + (row0 + 32 * i) * 272 + (vpos + 8) * 2) = (u32x2){sr[4 + i].z, sr[4 + i].w}; } } while (0)
    AT_WRITE();
    __syncthreads();
    if (ntiles > 1) { const int k1 = tiles[1]; AT_LOAD(k1); }
    for (int ti = 0; ti < ntiles; ++ti) {
        const int kstart = tiles[ti] + 64 * kp, nblk = kstart >> 8;
        const bool own = (nblk == blk);
        const bool any_ok = own ? true : (__any((((mysel[0] | mysel[1]) >> nblk) & 1u) != 0u) != 0);
        const bool active = own ? (kstart <= q0 + 32 * qg + 31) : any_ok;
        if (active) {
            const LAS unsigned char* kt = lds + AT_KT + 64 * kp * 272; const LAS unsigned char* vt = lds + AT_VT + 64 * kp * 2;
            f32x4 s[2][4];
#pragma unroll
            for (int n = 0; n < 4; ++n) { s[0][n] = (f32x4){0.f, 0.f, 0.f, 0.f}; s[1][n] = s[0][n]; }
#pragma unroll
            for (int ks = 0; ks < 4; ++ks) {
                bf16x8 q0f = *(const LAS bf16x8*)(qrow + 64 * ks), q1f = *(const LAS bf16x8*)(qrow + 16 * 272 + 64 * ks);
                bf16x8 kf[4];
#pragma unroll
                for (int n = 0; n < 4; ++n) kf[n] = *(const LAS bf16x8*)(kt + (16 * n + q16) * 272 + (32 * ks + 8 * g) * 2);
                asm volatile("" : "+v"(q0f), "+v"(q1f), "+v"(kf[0]), "+v"(kf[1]), "+v"(kf[2]), "+v"(kf[3]));
#pragma unroll
                for (int n = 0; n < 4; ++n) {
                    s[0][n] = __builtin_amdgcn_mfma_f32_16x16x32_bf16(kf[n], q0f, s[0][n], 0, 0, 0);
                    s[1][n] = __builtin_amdgcn_mfma_f32_16x16x32_bf16(kf[n], q1f, s[1][n], 0, 0, 0); } }
            const bool far = ((q0 + 32 * qg) - (kstart + 63)) >= 128;
            const float bfar = tab[128];
#pragma unroll
            for (int f = 0; f < 2; ++f) {
                const bool lane_ok = own ? true : (((mysel[f] >> nblk) & 1u) != 0u);
                float psum = 0.f, m_new;
#define AT_MNEW(mx_) fmaxf(((mx_) > m_run[f] + 8.0f) ? (mx_) : m_run[f], -1.0e29f)
                if (far) {
                    const float addc = lane_ok ? bfar : -1.0e30f;
                    float mx = -1.0e30f;
#pragma unroll
                    for (int n = 0; n < 4; ++n)
#pragma unroll
                        for (int r = 0; r < 4; ++r) mx = fmaxf(mx, s[f][n][r]);
                    mx = rows4_max(mx + addc);
                    m_new = AT_MNEW(mx);
                    const float cc = addc - m_new;
#pragma unroll
                    for (int n = 0; n < 4; ++n)
#pragma unroll
                        for (int r = 0; r < 4; ++r) { const float p = __builtin_amdgcn_exp2f(s[f][n][r] + cc); s[f][n][r] = p; psum += p; }
                } else {
                    const int kmax = lane_ok ? (own ? qpos[f] : 0x7fffffff) : -1;
                    float mx = -1.0e30f;
                    float bs[4][4];
#pragma unroll
                    for (int n = 0; n < 4; ++n)
#pragma unroll
                        for (int r = 0; r < 4; ++r) { int di = qpos[f] - (kstart + 16 * n + 4 * g + r); di = di < 0 ? 0 : di; di = di > 128 ? 128 : di; bs[n][r] = tab[di]; }
#pragma unroll
                    for (int n = 0; n < 4; ++n) asm volatile("" : "+v"(bs[n][0]), "+v"(bs[n][1]), "+v"(bs[n][2]), "+v"(bs[n][3]));
#pragma unroll
                    for (int n = 0; n < 4; ++n)
#pragma unroll
                        for (int r = 0; r < 4; ++r) { const int key = kstart + 16 * n + 4 * g + r;
                            const float v = (key <= kmax) ? s[f][n][r] + bs[n][r] : -1.0e30f;
                            s[f][n][r] = v; mx = fmaxf(mx, v); }
                    mx = rows4_max(mx);
                    m_new = AT_MNEW(mx);
#pragma unroll
                    for (int n = 0; n < 4; ++n)
#pragma unroll
                        for (int r = 0; r < 4; ++r) { const float p = __builtin_amdgcn_exp2f(s[f][n][r] - m_new); s[f][n][r] = p; psum += p; }
                }
#undef AT_MNEW
                const float alpha = __builtin_amdgcn_exp2f(m_run[f] - m_new);
                psum = rows4_sum(psum);
                l_run[f] = l_run[f] * alpha + psum;
                if (__any(m_new != m_run[f])) {
#pragma unroll
                    for (int m = 0; m < 8; ++m) oacc[f][m] = oacc[f][m] * alpha;
                }
                m_run[f] = m_new;
            }
#pragma unroll
            for (int k2 = 0; k2 < 2; ++k2) {
                bf16x8 pf[2];
#pragma unroll
                for (int f = 0; f < 2; ++f) { u32x4 pb; pb.x = cvt_pk_bf16(s[f][2 * k2][0], s[f][2 * k2][1]); pb.y = cvt_pk_bf16(s[f][2 * k2][2], s[f][2 * k2][3]);
                    pb.z = cvt_pk_bf16(s[f][2 * k2 + 1][0], s[f][2 * k2 + 1][1]); pb.w = cvt_pk_bf16(s[f][2 * k2 + 1][2], s[f][2 * k2 + 1][3]);
                    pf[f] = __builtin_bit_cast(bf16x8, pb); }
#pragma unroll
                for (int mh = 0; mh < 2; ++mh) {
                    bf16x8 af[4];
#pragma unroll
                    for (int m = 0; m < 4; ++m) af[m] = *(const LAS bf16x8*)(vt + (16 * (4 * mh + m) + q16) * 272 + (32 * k2 + 8 * g) * 2);
                    asm volatile("" : "+v"(af[0]), "+v"(af[1]), "+v"(af[2]), "+v"(af[3]));
#pragma unroll
                    for (int m = 0; m < 4; ++m) {
                        oacc[0][4 * mh + m] = __builtin_amdgcn_mfma_f32_16x16x32_bf16(af[m], pf[0], oacc[0][4 * mh + m], 0, 0, 0);
                        oacc[1][4 * mh + m] = __builtin_amdgcn_mfma_f32_16x16x32_bf16(af[m], pf[1], oacc[1][4 * mh + m], 0, 0, 0); } }
            }
        }
        __syncthreads();
        if (ti + 1 < ntiles) { AT_WRITE(); }
        __syncthreads();
        if (ti + 2 < ntiles) { const int kn = tiles[ti + 2]; AT_LOAD(kn); }
    }
    LAS float* mo = (LAS float*)lds; LAS float* ml = (LAS float*)(lds + 65536);
    if (kp == 1) {
#pragma unroll
        for (int f = 0; f < 2; ++f) {
#pragma unroll
            for (int m = 0; m < 8; ++m)
#pragma unroll
                for (int r = 0; r < 4; ++r) mo[((qg * 2 + f) * 8 + m) * 256 + r * 64 + lane] = oacc[f][m][r];
            ml[(qg * 2 + f) * 128 + lane] = m_run[f]; ml[(qg * 2 + f) * 128 + 64 + lane] = l_run[f]; }
    }
    __syncthreads();
    if (kp == 0) {
#pragma unroll
        for (int f = 0; f < 2; ++f) {
            const float m1 = ml[(qg * 2 + f) * 128 + lane], l1 = ml[(qg * 2 + f) * 128 + 64 + lane];
            const float mm = fmaxf(m_run[f], m1), a0 = __builtin_amdgcn_exp2f(m_run[f] - mm), a1 = __builtin_amdgcn_exp2f(m1 - mm);
            const float inv = __builtin_amdgcn_rcpf(l_run[f] * a0 + l1 * a1);
            bf16* HA = (bf16*)(ws + WS_HA) + (size_t)(b * SEQ + qpos[f]) * 1024 + h * 128 + 4 * g;
#pragma unroll
            for (int m = 0; m < 8; ++m) { float o[4];
#pragma unroll
                for (int r = 0; r < 4; ++r) o[r] = (oacc[f][m][r] * a0 + mo[((qg * 2 + f) * 8 + m) * 256 + r * 64 + lane] * a1) * inv;
                u32x2 w; w.x = cvt_pk_bf16(o[0], o[1]); w.y = cvt_pk_bf16(o[2], o[3]); *(u32x2*)(HA + 16 * m) = w; }
        }
    }
#undef AT_LOAD
#undef AT_WRITE
}

constexpr int MC_Q = 0, MC_K = 33792, MC_SP = 67584, MC_SC = 76800, MC_NV = 79104;
struct McRegs { u32x4 qr[4], kr[4]; float sc4[4]; float nv0; bf16x8 cb[8][2], vbf[2][2]; u32x2 ovv[8]; };
__device__ __forceinline__ void mc_load_qk(McRegs& R, const unsigned char* ws, int u, int tid) {
    const int bh = u >> 5, c = u & 31, b = bh >> 2, h = bh & 3; const size_t tok0 = (size_t)b * SEQ + 64 * c;
    const bf16* QM = (const bf16*)(ws + WS_QM); const bf16* KM = (const bf16*)(ws + WS_KM);
#pragma unroll
    for (int i = 0; i < 4; ++i) { const int idx = tid + NTHR * i, row = idx >> 5, ch = idx & 31;
        R.qr[i] = *(const u32x4*)(QM + (tok0 + row) * 1024 + h * 256 + ch * 8); R.kr[i] = *(const u32x4*)(KM + (tok0 + row) * 1024 + h * 256 + ch * 8); }
}
__device__ __forceinline__ void mc_load_sc(McRegs& R, const unsigned char* ws, int u, int tid) {
    const int bh = u >> 5, c = u & 31; const int s = bh * 2048 + 64 * c + (tid & 63);
    R.sc4[0] = ((const float*)(ws + MS_AS))[s]; R.sc4[1] = ((const float*)(ws + MS_GT))[s]; R.sc4[2] = ((const float*)(ws + MS_WI))[s]; R.sc4[3] = ((const float*)(ws + MS_CL))[s];
    R.nv0 = ((const float*)(ws + MS_NVEC))[(size_t)(bh * 32 + c) * 256 + (tid & 255)];
}
__device__ __forceinline__ void mc_load_cb(McRegs& R, const unsigned char* ws, int u, int lane, int wave) {
    const bf16* Cp = (const bf16*)(ws + WS_CST) + (size_t)u * 65536 + (size_t)(2 * wave) * 512 + lane * 8;
#pragma unroll
    for (int ks = 0; ks < 8; ++ks) { R.cb[ks][0] = *(const bf16x8*)(Cp + ks * 8192); R.cb[ks][1] = *(const bf16x8*)(Cp + ks * 8192 + 512); }
}
__device__ __forceinline__ void mc_load_v(McRegs& R, const unsigned char* ws, int u, int lane, int wave) {
    const bf16* Vp = (const bf16*)(ws + WS_VMT) + (size_t)u * 16384 + (size_t)(2 * wave) * 512 + lane * 8;
#pragma unroll
    for (int ks = 0; ks < 2; ++ks) { R.vbf[ks][0] = *(const bf16x8*)(Vp + ks * 8192); R.vbf[ks][1] = *(const bf16x8*)(Vp + ks * 8192 + 512); }
}
__device__ __forceinline__ void mc_load_ov(McRegs& R, const unsigned char* ws, int u, int lane, int wave) {
    const int bh = u >> 5, c = u & 31, b = bh >> 2, h = bh & 3; const size_t tok0 = (size_t)b * SEQ + 64 * c;
    const bf16* OM = (const bf16*)(ws + WS_OM);
#pragma unroll
    for (int i = 0; i < 8; ++i) R.ovv[i] = *(const u32x2*)(OM + (tok0 + 8 * wave + i) * 1024 + h * 256 + 4 * lane);
}
template <bool PF, bool HAVE>
__device__ __forceinline__ void mlstm_c_body(ArgsP a, int l, LAS unsigned char* lds, int u, int un, McRegs& R, int tid_, int lane_, int wave) {
    unsigned char* ws = a->ws;
    int tid = wave * 64 + lane_id(); asm volatile("" : "+v"(tid));
    const int lane = tid & 63; (void)tid_; (void)lane_;
    const int bh = u >> 5, c = u & 31, b = bh >> 2, h = bh & 3, t0 = 64 * c, q16 = lane & 15, g = lane >> 4;
    const size_t tok0 = (size_t)b * SEQ + t0;
    LAS unsigned char* Qs = lds + MC_Q; LAS unsigned char* Ks = lds + MC_K; LAS unsigned char* Sp = lds + MC_SP;
    LAS float* sc = (LAS float*)(lds + MC_SC); LAS float* as_ = sc; LAS float* gt_ = sc + 64; LAS float* wi_ = sc + 128; LAS float* cl_ = sc + 192; LAS float* qn_ = sc + 256; LAS float* denp = sc + 320;
    LAS float* nvec = (LAS float*)(lds + MC_NV);
    mc_load_qk(R, ws, u, tid); mc_load_sc(R, ws, u, tid);
    if (!HAVE) mc_load_cb(R, ws, u, lane, wave);
#pragma unroll
    for (int i = 0; i < 4; ++i) { const int idx = tid + NTHR * i, row = idx >> 5, ch = idx & 31;
        *(LAS u32x4*)(Qs + row * 528 + ch * 16) = R.qr[i]; *(LAS u32x4*)(Ks + row * 528 + ch * 16) = R.kr[i]; }
    mc_load_v(R, ws, u, lane, wave);
    if (tid < 64) { as_[tid] = R.sc4[0]; gt_[tid] = R.sc4[1]; wi_[tid] = R.sc4[2]; cl_[tid] = R.sc4[3]; }
    if (tid < 256) nvec[tid] = R.nv0;
    __syncthreads();
    f32x4 acc[4][2];
#pragma unroll
    for (int m = 0; m < 4; ++m) { acc[m][0] = (f32x4){0.f, 0.f, 0.f, 0.f}; acc[m][1] = acc[m][0]; }
    if (c > 0) {
#pragma unroll
        for (int ks = 0; ks < 8; ++ks) {
#pragma unroll
            for (int m = 0; m < 4; ++m) { const bf16x8 af = *(const LAS bf16x8*)(Qs + (16 * m + q16) * 528 + (32 * ks + 8 * g) * 2);
                acc[m][0] = __builtin_amdgcn_mfma_f32_16x16x32_bf16(af, R.cb[ks][0], acc[m][0], 0, 0, 0);
                acc[m][1] = __builtin_amdgcn_mfma_f32_16x16x32_bf16(af, R.cb[ks][1], acc[m][1], 0, 0, 0); }
        }
#pragma unroll
        for (int m = 0; m < 4; ++m)
#pragma unroll
            for (int r = 0; r < 4; ++r) { const float w = wi_[16 * m + 4 * g + r]; acc[m][0][r] *= w; acc[m][1][r] *= w; }
    }
    {
        const int mS = wave & 3, nS0 = 2 * (wave >> 2);
        f32x4 sacc[2]; sacc[0] = (f32x4){0.f, 0.f, 0.f, 0.f}; sacc[1] = sacc[0];
#pragma unroll
        for (int kh = 0; kh < 4; ++kh) {
            bf16x8 af[2], bq[2][2];
#pragma unroll
            for (int k2 = 0; k2 < 2; ++k2) { const int ks = 2 * kh + k2;
                af[k2] = *(const LAS bf16x8*)(Qs + (16 * mS + q16) * 528 + (32 * ks + 8 * g) * 2);
#pragma unroll
                for (int nn = 0; nn < 2; ++nn) bq[k2][nn] = *(const LAS bf16x8*)(Ks + (16 * (nS0 + nn) + q16) * 528 + (32 * ks + 8 * g) * 2); }
            asm volatile("" : "+v"(af[0]), "+v"(af[1]), "+v"(bq[0][0]), "+v"(bq[0][1]), "+v"(bq[1][0]), "+v"(bq[1][1]));
#pragma unroll
            for (int k2 = 0; k2 < 2; ++k2)
#pragma unroll
                for (int nn = 0; nn < 2; ++nn) sacc[nn] = __builtin_amdgcn_mfma_f32_16x16x32_bf16(af[k2], bq[k2][nn], sacc[nn], 0, 0, 0);
        }
#pragma unroll
        for (int nn = 0; nn < 2; ++nn) { const int s = 16 * (nS0 + nn) + q16; const float av = as_[s];
#pragma unroll
            for (int r = 0; r < 4; ++r) { const int t = 16 * mS + 4 * g + r;
                float val = (s <= t) ? sacc[nn][r] * __expf(av - gt_[t]) : 0.f;
                *(LAS unsigned short*)(Sp + t * 144 + s * 2) = (unsigned short)(cvt_pk_bf16(val, val) & 0xffffu);
                val += __shfl_xor(val, 1); val += __shfl_xor(val, 2); val += __shfl_xor(val, 4); val += __shfl_xor(val, 8);
                if (q16 == 0) denp[(nS0 + nn) * 64 + t] = val; } }
    }
    {
        const int t = tid >> 3, seg = tid & 7; float s = 0.f;
#pragma unroll
        for (int i = 0; i < 4; ++i) { const u32x4 v = *(const LAS u32x4*)(Qs + t * 528 + (seg * 32 + 8 * i) * 2); const LAS float* nv = nvec + seg * 32 + 8 * i;
            s += bflo(v.x) * nv[0] + bfhi(v.x) * nv[1] + bflo(v.y) * nv[2] + bfhi(v.y) * nv[3] + bflo(v.z) * nv[4] + bfhi(v.z) * nv[5] + bflo(v.w) * nv[6] + bfhi(v.w) * nv[7]; }
        s += __shfl_xor(s, 1); s += __shfl_xor(s, 2); s += __shfl_xor(s, 4);
        if (seg == 0) qn_[t] = s;
    }
    __syncthreads();
    if (PF) {
#pragma unroll
        for (int ks = 0; ks < 8; ++ks) asm volatile("" :: "v"(R.cb[ks][0]), "v"(R.cb[ks][1]));
        __builtin_amdgcn_sched_barrier(0);
        mc_load_cb(R, ws, un, lane, wave);
        __builtin_amdgcn_sched_barrier(0);
    }
    {
#pragma unroll
        for (int ks = 0; ks < 2; ++ks) {
            bf16x8 sf[4];
#pragma unroll
            for (int m = 0; m < 4; ++m) sf[m] = *(const LAS bf16x8*)(Sp + (16 * m + q16) * 144 + (32 * ks + 8 * g) * 2);
            asm volatile("" : "+v"(sf[0]), "+v"(sf[1]), "+v"(sf[2]), "+v"(sf[3]));
#pragma unroll
            for (int m = 0; m < 4; ++m) {
                acc[m][0] = __builtin_amdgcn_mfma_f32_16x16x32_bf16(sf[m], R.vbf[ks][0], acc[m][0], 0, 0, 0);
                acc[m][1] = __builtin_amdgcn_mfma_f32_16x16x32_bf16(sf[m], R.vbf[ks][1], acc[m][1], 0, 0, 0); }
        }
    }
    LAS float* NUM = (LAS float*)lds;
#pragma unroll
    for (int m = 0; m < 4; ++m)
#pragma unroll
        for (int r = 0; r < 4; ++r) { const int t = 16 * m + 4 * g + r;
            const float den = (denp[t] + denp[64 + t]) + (denp[128 + t] + denp[192 + t]) + wi_[t] * qn_[t];
            const float inv = __builtin_amdgcn_rcpf(fmaxf(fabsf(den), cl_[t]));
            NUM[t * 260 + 32 * wave + q16] = acc[m][0][r] * inv; NUM[t * 260 + 32 * wave + 16 + q16] = acc[m][1][r] * inv; }
    __syncthreads();
    {
        const float* mg = a->in[I_MNG] + l * 1024 + h * 256 + 4 * lane; const f32x4 gn = *(const f32x4*)mg;
        bf16* HM = (bf16*)(ws + WS_HM);
        mc_load_ov(R, ws, u, lane, wave);
        asm volatile("" : "+v"(R.ovv[0]), "+v"(R.ovv[1]), "+v"(R.ovv[2]), "+v"(R.ovv[3]), "+v"(R.ovv[4]), "+v"(R.ovv[5]), "+v"(R.ovv[6]), "+v"(R.ovv[7]));
#pragma unroll
        for (int i = 0; i < 8; ++i) { const int t = 8 * wave + i;
            const f32x4 v = *(const LAS f32x4*)(NUM + t * 260 + 4 * lane);
            const float mu = wave_sum((v.x + v.y) + (v.z + v.w)) * (1.0f / 256.0f);
            const f32x4 d = v - mu;
            const float var = wave_sum((d.x * d.x + d.y * d.y) + (d.z * d.z + d.w * d.w)) * (1.0f / 256.0f);
            const float rstd = __builtin_amdgcn_rsqf(var + LN_EPS);
            const u32x2 ov = R.ovv[i];
            u32x2 w; w.x = cvt_pk_bf16(d.x * rstd * gn.x * bflo(ov.x), d.y * rstd * gn.y * bfhi(ov.x)); w.y = cvt_pk_bf16(d.z * rstd * gn.z * bflo(ov.y), d.w * rstd * gn.w * bfhi(ov.y));
            *(u32x2*)(HM + (tok0 + t) * 1024 + h * 256 + 4 * lane) = w; }
    }
    __syncthreads();
}
__device__ __forceinline__ void mlstm_c_phase(ArgsP a, int l, LAS unsigned char* lds, int tid, int lane, int wave, int bid, int G) {
    int u = bid; if (u >= 512) return;
    McRegs R;
    if (u + G < 512 && u + 2 * G >= 512) {
        mlstm_c_body<true, false>(a, l, lds, u, u + G, R, tid, lane, wave);
        mlstm_c_body<false, true>(a, l, lds, u + G, u + G, R, tid, lane, wave);
    } else {
#pragma unroll 1
        for (; u < 512; u += G) mlstm_c_body<false, false>(a, l, lds, u, u, R, tid, lane, wave);
    }
}

struct SchedStd {
    static constexpr bool GATHER = false;
    const char* A; const char* B; int nM, nN, K, G, c;
    __device__ __forceinline__ bool next(int i, Unit& u) const { const int L = i * G + c; if (L >= nM * nN) return false; pg8::static_tile(L, nM, nN, u.pm, u.pn); u.aux = 0; return true; }
    __device__ __forceinline__ const char* abase(const Unit& u) const { return A + (size_t)u.pm * 512 * K; }
    __device__ __forceinline__ const char* bbase(const Unit& u) const { return B + (size_t)u.pn * 512 * K; }
    __device__ __forceinline__ unsigned arow(const Unit&, int) const { return 0u; }
    static __device__ __forceinline__ bool keep_acc(const Unit&) { return false; }
};
struct SchedBr {
    static constexpr bool GATHER = false;
    const char* HM; const char* HA; const char* WM; const char* WA; int G, c;
    __device__ __forceinline__ bool next(int i, Unit& u) const { const int L = (i >> 1) * G + c; if (L >= 256) return false; pg8::static_tile(L, 32, 8, u.pm, u.pn); u.aux = i & 1; return true; }
    __device__ __forceinline__ const char* abase(const Unit& u) const { return (u.aux ? HA : HM) + (size_t)u.pm * 512 * 1024; }
    __device__ __forceinline__ const char* bbase(const Unit& u) const { return (u.aux ? WA : WM) + (size_t)u.pn * 512 * 1024; }
    __device__ __forceinline__ unsigned arow(const Unit&, int) const { return 0u; }
    static __device__ __forceinline__ bool keep_acc(const Unit& u) { return u.aux == 0; }
};
struct EpiBr {
    static constexpr bool PERM = true;
    const bf16* SG; bf16* Y;
    __device__ __forceinline__ void operator()(f32x4 (&acc)[2][2][4][2], const Unit& u, int wr, int wc, int fr, int fq) const {
        const int row0 = u.pm * 256 + wr * 64 + fr, col0 = u.pn * 256 + wc * 32 + 8 * fq;
#pragma unroll
        for (int ai = 0; ai < 2; ++ai) {
            u32x4 sa[4][2], sm[4][2];
#pragma unroll
            for (int m = 0; m < 4; ++m) { const size_t row = row0 + ai * 128 + m * 16;
#pragma unroll
                for (int bj = 0; bj < 2; ++bj) { const int col = col0 + bj * 128;
                    sa[m][bj] = *(const u32x4*)(SG + row * 4096 + 2048 + col);
                    sm[m][bj] = *(const u32x4*)(SG + row * 4096 + (u.aux == 0 ? 0 : 2048) + col); } }
            asm volatile("" : "+v"(sa[0][0]), "+v"(sa[0][1]), "+v"(sa[1][0]), "+v"(sa[1][1]), "+v"(sa[2][0]), "+v"(sa[2][1]), "+v"(sa[3][0]), "+v"(sa[3][1]),
                              "+v"(sm[0][0]), "+v"(sm[0][1]), "+v"(sm[1][0]), "+v"(sm[1][1]), "+v"(sm[2][0]), "+v"(sm[2][1]), "+v"(sm[3][0]), "+v"(sm[3][1]));
#pragma unroll
            for (int m = 0; m < 4; ++m) { const size_t row = row0 + ai * 128 + m * 16;
#pragma unroll
                for (int bj = 0; bj < 2; ++bj) { const int col = col0 + bj * 128;
                    const u32x4 a4 = sa[m][bj], m4 = sm[m][bj];
                    const float ga[8] = {bflo(a4.x), bfhi(a4.x), bflo(a4.y), bfhi(a4.y), bflo(a4.z), bfhi(a4.z), bflo(a4.w), bfhi(a4.w)};
                    if (u.aux == 0) {
                        const float gm[8] = {bflo(m4.x), bfhi(m4.x), bflo(m4.y), bfhi(m4.y), bflo(m4.z), bfhi(m4.z), bflo(m4.w), bfhi(m4.w)};
#pragma unroll
                        for (int j = 0; j < 4; ++j) { acc[ai][bj][m][0][j] *= gm[j] * __builtin_amdgcn_rcpf(fmaxf(ga[j], 1.0e-30f)); acc[ai][bj][m][1][j] *= gm[4 + j] * __builtin_amdgcn_rcpf(fmaxf(ga[4 + j], 1.0e-30f)); }
                    } else {
                        const f32x4 v0 = acc[ai][bj][m][0], v1 = acc[ai][bj][m][1];
                        u32x4 w; w.x = cvt_pk_bf16(v0[0] * ga[0], v0[1] * ga[1]); w.y = cvt_pk_bf16(v0[2] * ga[2], v0[3] * ga[3]);
                        w.z = cvt_pk_bf16(v1[0] * ga[4], v1[1] * ga[5]); w.w = cvt_pk_bf16(v1[2] * ga[6], v1[3] * ga[7]);
                        *(u32x4*)(Y + row * 2048 + col) = w; }
                } }
        }
    }
};
struct EpiOut {
    static constexpr bool PERM = false;
    const float* res; float* out;
    __device__ __forceinline__ void operator()(f32x4 (&acc)[2][2][4][2], const Unit& u, int wr, int wc, int fr, int fq) const {
        const int row0 = u.pm * 256 + wr * 64 + fr, col0 = u.pn * 256 + wc * 32 + 4 * fq;
#pragma unroll
        for (int ai = 0; ai < 2; ++ai) {
            f32x4 rv[4][2][2];
#pragma unroll
            for (int m = 0; m < 4; ++m) { const size_t ro = (size_t)(row0 + ai * 128 + m * 16) * DM + col0;
#pragma unroll
                for (int bj = 0; bj < 2; ++bj)
#pragma unroll
                    for (int n = 0; n < 2; ++n) rv[m][bj][n] = *(const f32x4*)(res + ro + bj * 128 + n * 16); }
#pragma unroll
            for (int m = 0; m < 4; ++m) asm volatile("" : "+v"(rv[m][0][0]), "+v"(rv[m][0][1]), "+v"(rv[m][1][0]), "+v"(rv[m][1][1]));
#pragma unroll
            for (int m = 0; m < 4; ++m) { const size_t ro = (size_t)(row0 + ai * 128 + m * 16) * DM + col0;
#pragma unroll
                for (int bj = 0; bj < 2; ++bj)
#pragma unroll
                    for (int n = 0; n < 2; ++n) *(f32x4*)(out + ro + bj * 128 + n * 16) = rv[m][bj][n] + acc[ai][bj][m][n]; }
        }
    }
};
struct SchedMoe1 {
    static constexpr bool GATHER = true;
    const char* H; const char* W13; const int* LIST; const LAS int* te; const LAS int* tr0; const LAS int* cnt; int MT, G, c;
    __device__ __forceinline__ bool next(int i, Unit& u) const { const int L = i * G + c; if (L >= 2 * MT) return false; u.pm = L >> 1; u.pn = L & 1; u.aux = __builtin_amdgcn_readfirstlane(te[u.pm]); return true; }
    __device__ __forceinline__ const char* abase(const Unit&) const { return H; }
    __device__ __forceinline__ const char* bbase(const Unit& u) const { return W13 + ((size_t)u.aux * 512 + u.pn * 256) * 4096; }
    static __device__ __forceinline__ bool keep_acc(const Unit&) { return false; }
    __device__ __forceinline__ unsigned arow(const Unit& u, int r) const { const int rr = __builtin_amdgcn_readfirstlane(tr0[u.pm]) + r; return rr < __builtin_amdgcn_readfirstlane(cnt[u.aux]) ? (unsigned)LIST[u.aux * 8192 + rr] : 0u; }
};
struct EpiMoe1 {
    static constexpr bool PERM = true;
    bf16* HID; const float* PWL; const LAS int* tr0; const LAS int* cnt;
    __device__ __forceinline__ void operator()(f32x4 (&acc)[2][2][4][2], const Unit& u, int wr, int wc, int fr, int fq) const {
#pragma unroll
        for (int ai = 0; ai < 2; ++ai)
#pragma unroll
            for (int m = 0; m < 4; ++m) { const int r = ai * 128 + wr * 64 + m * 16 + fr;
                const float pw = 1.0f;
                float o[8];
#pragma unroll
                for (int n = 0; n < 2; ++n)
#pragma unroll
                    for (int j = 0; j < 4; ++j) { const float x1 = acc[ai][0][m][n][j], x3 = acc[ai][1][m][n][j]; o[4 * n + j] = x1 * sigmoidf_(x1) * x3 * pw; }
                u32x4 w; w.x = cvt_pk_bf16(o[0], o[1]); w.y = cvt_pk_bf16(o[2], o[3]); w.z = cvt_pk_bf16(o[4], o[5]); w.w = cvt_pk_bf16(o[6], o[7]);
                *(u32x4*)(HID + (size_t)(u.pm * 256 + r) * 256 + u.pn * 128 + wc * 32 + 8 * fq) = w; }
    }
};
struct SchedMoe2 {
    static constexpr bool GATHER = false;
    const char* HID; const char* W2; const LAS int* te; int MT, G, c;
    __device__ __forceinline__ bool next(int i, Unit& u) const { const int L = i * G + c; if (L >= 8 * MT) return false; u.pm = L >> 3; u.pn = L & 7; u.aux = __builtin_amdgcn_readfirstlane(te[u.pm]); return true; }
    __device__ __forceinline__ const char* abase(const Unit& u) const { return HID + (size_t)u.pm * 256 * 512; }
    __device__ __forceinline__ const char* bbase(const Unit& u) const { return W2 + ((size_t)u.aux * 2048 + u.pn * 256) * 512; }
    __device__ __forceinline__ unsigned arow(const Unit&, int) const { return 0u; }
    static __device__ __forceinline__ bool keep_acc(const Unit&) { return false; }
};
struct EpiMoe2 {
    static constexpr bool PERM = true;
    bf16* OP;
    __device__ __forceinline__ void operator()(f32x4 (&acc)[2][2][4][2], const Unit& u, int wr, int wc, int fr, int fq) const {
        const int row0 = u.pm * 256 + wr * 64 + fr, col0 = u.pn * 256 + wc * 32 + 8 * fq;
#pragma unroll
        for (int ai = 0; ai < 2; ++ai)
#pragma unroll
            for (int m = 0; m < 4; ++m) { bf16* rowp = OP + (size_t)(row0 + ai * 128 + m * 16) * DM + col0;
#pragma unroll
                for (int bj = 0; bj < 2; ++bj) { const f32x4 v0 = acc[ai][bj][m][0], v1 = acc[ai][bj][m][1];
                    u32x4 w; w.x = cvt_pk_bf16(v0[0], v0[1]); w.y = cvt_pk_bf16(v0[2], v0[3]); w.z = cvt_pk_bf16(v1[0], v1[1]); w.w = cvt_pk_bf16(v1[2], v1[3]);
                    *(u32x4*)(rowp + bj * 128) = w; } }
    }
};

constexpr int N_PHASES = 22;
__global__ void __launch_bounds__(NTHR, 2) fwd_kernel(Args a) {
    extern __shared__ __attribute__((aligned(16))) unsigned char lds_raw[];
    LAS unsigned char* lds0 = (LAS unsigned char*)lds_raw;
    const int tid0 = threadIdx.x, bid0 = blockIdx.x, G0 = gridDim.x;
    const int wave0 = __builtin_amdgcn_readfirstlane(tid0 >> 6);
#define PH_IDS() ArgsP ap = (ArgsP)__builtin_amdgcn_kernarg_segment_ptr(); asm volatile("" : "+s"(ap)); unsigned lb_ = 0u; asm volatile("" : "+s"(lb_)); LAS unsigned char* lds = lds0 + lb_; LAS unsigned char* misc = lds + MISC_OFF; (void)misc; unsigned char* ws = ap->ws; (void)ws; int bid = bid0, G = G0, wave = wave0; asm volatile("" : "+s"(bid), "+s"(G), "+s"(wave)); int tid = wave * 64 + lane_id(); asm volatile("" : "+v"(tid)); const int lane = tid & 63; (void)lane; (void)wave
    if (tid0 < 4) ((LAS unsigned*)(lds0 + MISC_OFF + MO_BAR))[tid0] = 0u;
    __syncthreads();
#if MK_LAUNCHES == 1
    XcdBarrier bar = xcd_barrier_post((unsigned*)(a.ws + WS_CTL) + CW_BAR, (volatile LAS unsigned*)(lds0 + MISC_OFF + MO_BAR));
#define GRID_BAR() xcd_barrier(bar)
#else
#define GRID_BAR() do { } while (0)
#endif
    const int lo = a.ph_lo, hi = a.ph_hi;
#ifndef PHMASK
#define PHMASK 0xFFFu
#endif
#define IN(k) (lo <= (k) && (k) < hi)
#define EN(b) ((PHMASK >> (b)) & 1u)
#ifndef DBLMASK
#define DBLMASK 0u
#endif
#define REP(b) _Pragma("unroll 1") for (int rep_ = 0; rep_ < (((DBLMASK >> (b)) & 1u) ? 2 : 1); ++rep_)
#define SEAM(k) do { if (IN(k) && IN((k) + 1)) { GRID_BAR(); if ((DBLMASK >> 12) & 1u) GRID_BAR(); } } while (0)

    if (EN(0) && IN(0)) { REP(0) { PH_IDS(); prologue_phase(ap, lds, tid, lane, wave, bid, G); __syncthreads(); }
#ifndef NO_NORM0
        { PH_IDS(); norm_phase<0>(ap, 0, lds, tid, lane, wave, bid, G); }
#endif
    }
    SEAM(0);
#pragma unroll 1
    for (int l = 0; l < 2; ++l) {
        const int pb = 1 + 10 * l;
        if (EN(1) && IN(pb + 0) && l == 1) { if ((DBLMASK >> 18) & 1u) { PH_IDS(); norm_phase<1>(ap, l, lds, tid, lane, wave, bid, G, true); } PH_IDS(); norm_phase<1>(ap, l, lds, tid, lane, wave, bid, G); }
        if (l == 1) SEAM(pb + 0);
        if (EN(2) && IN(pb + 1)) REP(2) { PH_IDS(); (void)tid;
#ifdef STAG
            for (int i = 0; i < ((bid >> 3) & 7); ++i) __builtin_amdgcn_s_sleep(STAG);
#endif
            SchedG1 S{(const char*)(ws + WS_H), (const char*)(ws + WS_WINT) + (size_t)l * 11264 * 4096, G, bid};
            EpiG1 E{ws, ((DBLMASK >> 21) & 1u) && rep_ == 1};
            pg8::gemm_phase<EpiG1, SchedG1>(lds, 2048, S, E, wave);
            for (int bh = G - 1 - bid; bh < 16; bh += G) gate_unit(ap, l, lds, bh, tid, tid & 63, wave);
            __syncthreads();
            if (G == 256 && bid >= 256 - SchedG1::NCV) prologue_phase(ap, lds, tid, tid & 63, wave, bid - (256 - SchedG1::NCV), SchedG1::NCV, 2 + l);
            else if (G != 256) prologue_phase(ap, lds, tid, tid & 63, wave, bid, G, 2 + l);
        }
        SEAM(pb + 1);
        if (EN(3) && IN(pb + 2)) REP(3) { PH_IDS(); conv_phase(ap, l, lds, tid, lane, wave, bid, G); }
        SEAM(pb + 2);
        if (EN(4) && IN(pb + 3)) REP(4) { PH_IDS();
            const int vb = (G % 8 == 0) ? (bid & 7) * (G >> 3) + (bid >> 3) : bid;
            REP(13) { for (int gw = vb * NWAVES + wave; gw < 2048; gw += G * NWAVES) mlstm_ab_task(ws, gw, lane, rep_ == 0 || !((DBLMASK >> 15) & 1u)); }
            if (wave == 0 && vb < 64) nscan_task(ws, vb, lane);
            __syncthreads();
            REP(14) { for (int u = vb; u < 512; u += G) { attn_unit(ap, lds, u, tid, lane, wave); __syncthreads(); if (((DBLMASK >> 16) & 1u) && u < 256) GRID_BAR(); } }
        }
        SEAM(pb + 3);
        if (EN(5) && IN(pb + 4)) REP(5) { PH_IDS(); mlstm_c_phase(ap, l, lds, tid, lane, wave, bid, G); }
        SEAM(pb + 4);
        if (EN(6) && IN(pb + 5)) REP(6) { PH_IDS(); (void)tid;
            SchedBr S{(const char*)(ws + WS_HM), (const char*)(ws + WS_HA), (const char*)(ws + WS_WBM) + (size_t)l * 2048 * 2048, (const char*)(ws + WS_WBA) + (size_t)l * 2048 * 2048, G, bid};
            EpiBr E{(const bf16*)(ws + WS_SG), (bf16*)(ws + WS_Y)};
            pg8::gemm_phase<EpiBr, SchedBr>(lds, 1024, S, E, wave);
        }
        SEAM(pb + 5);
        if (EN(7) && IN(pb + 6)) _Pragma("unroll 1") for (int rep_ = 0; rep_ < ((((DBLMASK >> 7) & 1u) && l == 0) ? 2 : 1); ++rep_) { PH_IDS(); (void)tid;
            SchedStd S{(const char*)(ws + WS_Y), (const char*)(ws + WS_WOUT) + (size_t)l * 2048 * 4096, 32, 8, 2048, G, bid};
            EpiOut E{l == 0 ? ap->in[I_X] : (const float*)ap->out, ap->out};
            pg8::gemm_phase<EpiOut, SchedStd>(lds, 2048, S, E, wave);
        }
        SEAM(pb + 6);
        if (EN(8) && IN(pb + 7)) { if ((DBLMASK >> 19) & 1u) { PH_IDS(); norm_phase<2>(ap, l, lds, tid, lane, wave, bid, G, true); } PH_IDS(); norm_phase<2>(ap, l, lds, tid, lane, wave, bid, G); }
        SEAM(pb + 7);
        if (EN(9) && IN(pb + 8)) REP(9) { PH_IDS();
            moe_tables(ws, l, misc, tid);
            SchedMoe1 S{(const char*)(ws + WS_H), (const char*)(ws + WS_W13) + (size_t)l * 32 * 512 * 4096, (const int*)(ws + MS_LIST),
                        (const LAS int*)(misc + MO_TE), (const LAS int*)(misc + MO_TR0), (const LAS int*)(misc + MO_CNT), __builtin_amdgcn_readfirstlane(((const LAS int*)(misc + MO_MT))[0]), G, bid};
            EpiMoe1 E{(bf16*)(ws + WS_HID), (const float*)(ws + MS_PWL), (const LAS int*)(misc + MO_TR0), (const LAS int*)(misc + MO_CNT)};
            pg8::gemm_phase<EpiMoe1, SchedMoe1>(lds, 2048, S, E, wave);
            if (bid >= 2 * S.MT) prologue_phase(ap, lds, tid, tid & 63, wave, bid - 2 * S.MT, G - 2 * S.MT, l == 0 ? 1 : 4);
        }
        SEAM(pb + 8);
        if (EN(10) && IN(pb + 9)) REP(10) { PH_IDS();
            moe_tables(ws, l, misc, tid);
#ifdef STAG
            for (int i = 0; i < ((bid >> 3) & 7); ++i) __builtin_amdgcn_s_sleep(STAG);
#endif
            SchedMoe2 S{(const char*)(ws + WS_HID), (const char*)(ws + WS_W2) + (size_t)l * 32 * 2048 * 512, (const LAS int*)(misc + MO_TE), __builtin_amdgcn_readfirstlane(((const LAS int*)(misc + MO_MT))[0]), G, bid};
            EpiMoe2 E{(bf16*)(ws + WS_OP)};
            pg8::gemm_phase<EpiMoe2, SchedMoe2>(lds, 256, S, E, wave);
        }
        SEAM(pb + 9);
    }
    if (EN(11) && IN(21)) { if ((DBLMASK >> 20) & 1u) { PH_IDS(); norm_phase<3>(ap, 1, lds, tid, lane, wave, bid, G, true); } PH_IDS(); norm_phase<3>(ap, 1, lds, tid, lane, wave, bid, G); }
#undef IN
#undef SEAM
}

extern "C" void kernel_launch(void* const* d_in, const int* in_sizes, int n_in, void* d_out, int out_size, void* d_ws, size_t ws_size, hipStream_t stream) {
    static int grid = 0;
    if (grid == 0) {
        if (n_in != 19 || out_size != NTOK * DM || ws_size < WS_END) { fprintf(stderr, "kernel_launch: unexpected shapes (n_in %d out %d ws %zu)\n", n_in, out_size, ws_size); grid = -1; return; }
        int dev = 0, cus = 0, per_cu = 0;
        if (hipGetDevice(&dev) != hipSuccess || hipDeviceGetAttribute(&cus, hipDeviceAttributeMultiprocessorCount, dev) != hipSuccess) { grid = -1; return; }
        if (hipFuncSetAttribute((const void*)fwd_kernel, hipFuncAttributeMaxDynamicSharedMemorySize, LDS_BYTES) != hipSuccess) { fprintf(stderr, "kernel_launch: hipFuncSetAttribute failed\n"); grid = -1; return; }
        if (hipOccupancyMaxActiveBlocksPerMultiprocessor(&per_cu, (const void*)fwd_kernel, NTHR, LDS_BYTES) != hipSuccess || per_cu < 1) { fprintf(stderr, "kernel_launch: occupancy query says %d\n", per_cu); }
        (void)hipGetLastError();
        grid = cus;
        if (grid > 256) grid = 256;
    }
    if (grid < 0) return;
    if (hipMemsetAsync((char*)d_ws + WS_CTL, 0, CTL_ZERO_BYTES, stream) != hipSuccess) return;
    Args a{};
    for (int i = 0; i < 19; ++i) a.in[i] = (const float*)d_in[i];
    a.out = (float*)d_out; a.ws = (unsigned char*)d_ws;
#if MK_LAUNCHES == 1
    a.ph_lo = 0; a.ph_hi = N_PHASES;
    hipLaunchKernelGGL(fwd_kernel, dim3(grid), dim3(NTHR), LDS_BYTES, stream, a);
#else
    for (int p = 0; p < N_PHASES; ++p) { a.ph_lo = p; a.ph_hi = p + 1; hipLaunchKernelGGL(fwd_kernel, dim3(grid), dim3(NTHR), LDS_BYTES, stream, a); }
#endif
}
```

```cpp
#define DBLMASK 0u
#include <hip/hip_runtime.h>
#include <stdint.h>
#include <stdio.h>

#ifndef MK_LAUNCHES
#define MK_LAUNCHES 1
#endif

#define GAS __attribute__((address_space(1)))
#define LAS __attribute__((address_space(3)))
typedef unsigned short bf16;
typedef short bf16x8 __attribute__((ext_vector_type(8)));
typedef short bf16x4 __attribute__((ext_vector_type(4)));
typedef float f32x4 __attribute__((ext_vector_type(4)));
typedef unsigned u32x4 __attribute__((ext_vector_type(4)));
typedef unsigned u32x2 __attribute__((ext_vector_type(2)));

constexpr int NTOK = 8192, DM = 2048, SEQ = 2048, NBATCH = 4;
constexpr int INCOLS = 11272;
constexpr int NWAVES = 8, NTHR = 512;
constexpr float RMS_EPS = 1e-6f, LN_EPS = 1e-5f;
constexpr int MPAD = 24576;

constexpr size_t MiB = 1u << 20;
constexpr size_t WS_CTL = 0, CTL_ZERO_BYTES = 1 * MiB;
constexpr size_t WS_MISC = 1 * MiB;
constexpr size_t MS_WIF = WS_MISC + 0;
constexpr size_t MS_WRT = WS_MISC + 256 * 1024;
constexpr size_t MS_IFG = WS_MISC + 1 * MiB;
constexpr size_t MS_KMEAN = MS_IFG + 256 * 1024;
constexpr size_t MS_AS = WS_MISC + 1536 * 1024;
constexpr size_t MS_GT = MS_AS + 128 * 1024;
constexpr size_t MS_WI = MS_GT + 128 * 1024;
constexpr size_t MS_CL = MS_WI + 128 * 1024;
constexpr size_t MS_WS = MS_CL + 128 * 1024;
constexpr size_t MS_DEC = MS_WS + 128 * 1024;
constexpr size_t MS_NST = WS_MISC + 2560 * 1024;
constexpr size_t MS_TOKE = WS_MISC + 3 * MiB;
constexpr size_t MS_TOKP = MS_TOKE + 64 * 1024;
constexpr size_t MS_TOKW = MS_TOKE + 128 * 1024;
constexpr size_t MS_LIST = WS_MISC + 4 * MiB;
constexpr size_t MS_PWL = WS_MISC + 5 * MiB;
constexpr size_t MS_NVEC = WS_MISC + 6 * MiB;
constexpr size_t WS_WINT = 16 * MiB;
constexpr size_t WS_WBM = 104 * MiB;
constexpr size_t WS_WBA = 112 * MiB;
constexpr size_t WS_WOUT = 120 * MiB;
constexpr size_t WS_W13 = 136 * MiB;
constexpr size_t WS_W2 = 264 * MiB;
constexpr size_t WS_H = 328 * MiB;
constexpr size_t WS_R = 360 * MiB;
constexpr size_t WS_ZQK = WS_R;
constexpr size_t WS_HM = WS_R, WS_HA = WS_R + 16 * MiB;
constexpr size_t WS_VMT = WS_R + 32 * MiB;
constexpr size_t WS_OM = WS_R + 48 * MiB;
constexpr size_t WS_QA = WS_R + 64 * MiB, WS_KA = WS_R + 80 * MiB;
constexpr size_t WS_Y = WS_QA;
constexpr size_t WS_VAT = WS_R + 96 * MiB;
constexpr size_t WS_SG = WS_R + 112 * MiB;
constexpr size_t WS_QM = WS_R + 176 * MiB, WS_KM = WS_R + 192 * MiB, WS_KMT = WS_R + 208 * MiB;
constexpr size_t WS_CST = WS_R + 224 * MiB;
constexpr size_t WS_HID = WS_R;
constexpr size_t WS_OP = WS_R + 16 * MiB;
constexpr size_t WS_END = 648 * MiB;
constexpr int CW_BAR = 4096;
constexpr int CW_CNT = 8192;

constexpr int RING_BYTES = 131072;
constexpr int MISC_OFF = 139264;
constexpr int LDS_BYTES = 147456;
constexpr int MO_BAR = 0, MO_CNT = 64, MO_NT = 64 + 128, MO_OFF = 64 + 256, MO_TE = 64 + 512, MO_TR0 = 64 + 1024, MO_MT = 64 + 1536, MO_LOG = 2048;

#define LDS_WAIT() asm volatile("s_waitcnt lgkmcnt(0)" ::: "memory")
#define VM_WAIT() asm volatile("s_waitcnt vmcnt(0)" ::: "memory")

__device__ __forceinline__ float bf2f(unsigned short b) { return __builtin_bit_cast(float, (unsigned)b << 16); }
__device__ __forceinline__ float bflo(unsigned u) { return __builtin_bit_cast(float, u << 16); }
__device__ __forceinline__ float bfhi(unsigned u) { return __builtin_bit_cast(float, u & 0xffff0000u); }
typedef __bf16 bf16x2v __attribute__((ext_vector_type(2)));
typedef float f32x2v __attribute__((ext_vector_type(2)));
__device__ __forceinline__ unsigned cvt_pk_bf16(float lo, float hi) { const f32x2v f = {lo, hi}; const bf16x2v b = __builtin_convertvector(f, bf16x2v); return __builtin_bit_cast(unsigned, b); }
__device__ __forceinline__ float wave_sum(float v) {
#pragma unroll
    for (int o = 1; o < 64; o <<= 1) v += __shfl_xor(v, o);
    return v;
}
__device__ __forceinline__ float rows4_max(float x) { x = fmaxf(x, __shfl_xor(x, 16)); return fmaxf(x, __shfl_xor(x, 32)); }
__device__ __forceinline__ float rows4_sum(float x) { x += __shfl_xor(x, 16); return x + __shfl_xor(x, 32); }
__device__ __forceinline__ int lane_id() { int l; asm volatile("v_mbcnt_lo_u32_b32 %0, -1, 0\n\tv_mbcnt_hi_u32_b32 %0, -1, %0" : "=v"(l)); return l; }
__device__ __forceinline__ float sigmoidf_(float x) { return __builtin_amdgcn_rcpf(1.f + __expf(-x)); }

namespace pg8 {
constexpr int BM = 256, BK = 64, HALF = 128, HTB = HALF * BK * 2, STAGE_BYTES = 8 * HTB, NXCD = 8, WGM = 8;
__device__ __forceinline__ int lds_byte(int r, int c) { const int st = (r >> 4) * 2 + (c >> 5), rr = r & 15, cc = c & 31, ob = rr * 64 + cc * 2; return st * 1024 + (ob ^ (((ob >> 9) & 1) << 5)); }
__device__ __forceinline__ void stage_rc(int b, int& R, int& C) { const int st = b / 1024, sb = b % 1024, swz = sb ^ (((sb >> 9) & 1) << 5); R = (st >> 1) * 16 + swz / 64; C = (st & 1) * 32 + (swz % 64) / 2; }
__device__ __forceinline__ int perm32(int rho) { const int n = rho >> 4, i = rho & 15; return 8 * (i >> 2) + 4 * n + (i & 3); }
struct Unit { int pm, pn, aux; };

__device__ __forceinline__ void static_tile(int L, int nM, int nN, int& pm, int& pn) {
    const int nwg = nM * nN; int wgid = L;
    { const int q = nwg / NXCD, r = nwg % NXCD, xcd = wgid % NXCD, off = wgid / NXCD; wgid = (xcd < r ? xcd * (q + 1) : r * (q + 1) + (xcd - r) * q) + off; }
    const int nig = WGM * nN, gid = wgid / nig, fm = gid * WGM, gsz = (nM - fm) < WGM ? (nM - fm) : WGM;
    pm = fm + ((wgid % nig) % gsz); pn = (wgid % nig) / gsz;
}

template <class Epi, class Sched>
__device__ __forceinline__ void gemm_phase(LAS unsigned char* lds, const int K, const Sched& S, const Epi& E, const int wave0) {
    int tid_ = wave0 * 64 + lane_id(); asm volatile("" : "+v"(tid_));
    const int tid = tid_, wid = __builtin_amdgcn_readfirstlane(tid >> 6), lane = tid & 63, wr = wid >> 2, wc = wid & 3, fr = lane & 15, fq = lane >> 4;
    const int nt = K / BK;
    int RA[2], CA[2]; unsigned voffB[2];
#pragma unroll
    for (int i = 0; i < 2; ++i) { int R, C; stage_rc(tid * 16 + i * 8192, R, C); const int Rb = Epi::PERM ? ((R & ~31) + perm32(R & 31)) : R;
        RA[i] = R; CA[i] = C; voffB[i] = (unsigned)(Rb * K + C) * 2u; }
    const size_t kstep = (size_t)(BK * 2);
    const size_t hstep = (size_t)HALF * K * 2;
    const unsigned ldsw = (unsigned)wid * 1024u;
    const int aoff = lds_byte(wr * 64 + fr, fq * 8), boff = lds_byte(wc * 32 + fr, fq * 8);
#define PG8_SA(b, h) (((b) * 2 + (h)) * HTB)
#define PG8_SB(b, h) ((4 + (b) * 2 + (h)) * HTB)
#define PG8_STAGE(bufoff, gbase, v0, v1) do { \
        __builtin_amdgcn_global_load_lds((const unsigned*)((const char*)(gbase) + (v0)), (LAS unsigned*)(lds + (bufoff) + ldsw), 16, 0, 0); \
        __builtin_amdgcn_global_load_lds((const unsigned*)((const char*)(gbase) + (v1)), (LAS unsigned*)(lds + (bufoff) + ldsw + 8192), 16, 0, 0); } while (0)
#define PG8_STAGE_B(bufoff, gbase) PG8_STAGE(bufoff, gbase, voffB[0], voffB[1])
#define PG8_STAGE_A(bufoff, gbase, VO, h) PG8_STAGE(bufoff, gbase, VO[h][0], VO[h][1])
#define PG8_STAGE_A2(bufoff, gbase, h) do { if (Sched::GATHER && last) { PG8_STAGE_A(bufoff, gbase, vn, h); } else { PG8_STAGE_A(bufoff, gbase, vc, h); } } while (0)
#define PG8_LDA(dst, b, h) do { _Pragma("unroll") for (int m = 0; m < 4; ++m) _Pragma("unroll") for (int k = 0; k < 2; ++k) dst[m][k] = *(const LAS bf16x8*)(lds + PG8_SA(b, h) + aoff + m * 2048 + k * 1024); } while (0)
#define PG8_LDB(dst, b, h) do { _Pragma("unroll") for (int n = 0; n < 2; ++n) _Pragma("unroll") for (int k = 0; k < 2; ++k) dst[n][k] = *(const LAS bf16x8*)(lds + PG8_SB(b, h) + boff + n * 2048 + k * 1024); } while (0)
#define PG8_MMA(ai, bj, At, Bt) do { __builtin_amdgcn_s_setprio(1); _Pragma("unroll") for (int m = 0; m < 4; ++m) _Pragma("unroll") for (int n = 0; n < 2; ++n) _Pragma("unroll") for (int k = 0; k < 2; ++k) \
        acc[ai][bj][m][n] = __builtin_amdgcn_mfma_f32_16x16x32_bf16(Bt[n][k], At[m][k], acc[ai][bj][m][n], 0, 0, 0); __builtin_amdgcn_s_setprio(0); } while (0)
#define PG8_WAIT_V(n) asm volatile("s_waitcnt vmcnt(" #n ")" ::: "memory")
#define PG8_WAIT_L(n) asm volatile("s_waitcnt lgkmcnt(" #n ")" ::: "memory")
#define PG8_BAR __builtin_amdgcn_s_barrier()
#define PG8_SCHED __builtin_amdgcn_sched_barrier(0)
    Unit cur, nxt; int ui = 0;
    if (!S.next(0, cur)) return;
    f32x4 acc[2][2][4][2];
#pragma unroll
    for (int a = 0; a < 2; ++a)
#pragma unroll
        for (int b = 0; b < 2; ++b)
#pragma unroll
            for (int m = 0; m < 4; ++m)
#pragma unroll
                for (int n = 0; n < 2; ++n) acc[a][b][m][n] = (f32x4){0.f, 0.f, 0.f, 0.f};
    bf16x8 At[4][2], B0[2][2], B1[2][2];
    unsigned vc[2][2], vn[2][2];
#pragma unroll
    for (int h = 0; h < 2; ++h)
#pragma unroll
        for (int i = 0; i < 2; ++i) {
            if constexpr (Sched::GATHER) vc[h][i] = (unsigned)(S.arow(cur, h * HALF + RA[i]) * (unsigned)K + (unsigned)CA[i]) * 2u;
            else vc[h][i] = (unsigned)((h * HALF + RA[i]) * K + CA[i]) * 2u;
            vn[h][i] = vc[h][i];
        }
    const char* cA = S.abase(cur); const char* cB = S.bbase(cur);
    PG8_STAGE_B(PG8_SB(0, 0), cB); PG8_STAGE_A(PG8_SA(0, 0), cA, vc, 0); PG8_STAGE_B(PG8_SB(0, 1), cB + hstep); PG8_STAGE_A(PG8_SA(0, 1), cA, vc, 1);
    if (wr == 1) PG8_BAR;
    PG8_WAIT_V(4); PG8_BAR;
    PG8_STAGE_B(PG8_SB(1, 0), cB + kstep); PG8_STAGE_A(PG8_SA(1, 0), cA + kstep, vc, 0); PG8_STAGE_B(PG8_SB(1, 1), cB + hstep + kstep);
    PG8_WAIT_V(6); PG8_BAR;
    for (;;) {
        const bool has_next = S.next(ui + 1, nxt);
        const char* nA = has_next ? S.abase(nxt) : cA; const char* nB = has_next ? S.bbase(nxt) : cB;
        if constexpr (Sched::GATHER) {
            if (has_next) {
                int t2 = wave0 * 64 + lane_id(); asm volatile("" : "+v"(t2));
#pragma unroll
                for (int i = 0; i < 2; ++i) { int R, C; stage_rc(t2 * 16 + i * 8192, R, C);
#pragma unroll
                    for (int h = 0; h < 2; ++h) vn[h][i] = (unsigned)(S.arow(nxt, h * HALF + R) * (unsigned)K + (unsigned)C) * 2u; }
            }
        }
#pragma unroll 1
        for (int t = 0; t < nt; t += 2) {
            const bool last = (t == nt - 2);
            const char* a1 = cA + (size_t)(t + 1) * kstep;
            const char* a2 = last ? nA : cA + (size_t)(t + 2) * kstep; const char* b2 = last ? nB : cB + (size_t)(t + 2) * kstep;
            const char* a3 = a2 + kstep; const char* b3 = b2 + kstep;
            PG8_LDB(B0, 0, 0); PG8_SCHED; PG8_LDA(At, 0, 0); PG8_STAGE_A(PG8_SA(1, 1), a1, vc, 1);
            PG8_WAIT_L(8); PG8_BAR; PG8_WAIT_L(0); PG8_MMA(0, 0, At, B0); PG8_BAR; PG8_SCHED;
            PG8_LDB(B1, 0, 1); PG8_STAGE_B(PG8_SB(0, 0), b2);
            PG8_BAR; PG8_WAIT_L(0); PG8_MMA(0, 1, At, B1); PG8_BAR;
            PG8_LDA(At, 0, 1); PG8_STAGE_A2(PG8_SA(0, 0), a2, 0);
            PG8_BAR; PG8_WAIT_L(0); PG8_MMA(1, 0, At, B0); PG8_BAR; PG8_SCHED;
            PG8_STAGE_B(PG8_SB(0, 1), b2 + hstep);
            PG8_WAIT_V(6); PG8_BAR; PG8_MMA(1, 1, At, B1); PG8_BAR;
            PG8_LDB(B0, 1, 0); PG8_SCHED; PG8_LDA(At, 1, 0); PG8_STAGE_A2(PG8_SA(0, 1), a2, 1);
            PG8_WAIT_L(8); PG8_BAR; PG8_WAIT_L(0); PG8_MMA(0, 0, At, B0); PG8_BAR; PG8_SCHED;
            PG8_LDB(B1, 1, 1); PG8_STAGE_B(PG8_SB(1, 0), b3);
            PG8_BAR; PG8_WAIT_L(0); PG8_MMA(0, 1, At, B1); PG8_BAR;
            PG8_LDA(At, 1, 1); PG8_STAGE_A2(PG8_SA(1, 0), a3, 0);
            PG8_BAR; PG8_WAIT_L(0); PG8_MMA(1, 0, At, B0); PG8_BAR; PG8_SCHED;
            PG8_STAGE_B(PG8_SB(1, 1), b3 + hstep);
            PG8_WAIT_V(6); PG8_BAR; PG8_MMA(1, 1, At, B1); PG8_BAR;
        }
        { const int lz = lane_id(); E(acc, cur, wr, wc, lz & 15, lz >> 4); }
        if (!has_next) break;
        if (!Sched::keep_acc(cur)) {
#pragma unroll
        for (int a = 0; a < 2; ++a)
#pragma unroll
            for (int b = 0; b < 2; ++b)
#pragma unroll
                for (int m = 0; m < 4; ++m)
#pragma unroll
                    for (int n = 0; n < 2; ++n) acc[a][b][m][n] = (f32x4){0.f, 0.f, 0.f, 0.f};
        }
        cur = nxt; cA = nA; cB = nB; ++ui;
        if constexpr (Sched::GATHER) {
#pragma unroll
            for (int h = 0; h < 2; ++h)
#pragma unroll
                for (int i = 0; i < 2; ++i) vc[h][i] = vn[h][i];
        }
    }
    PG8_WAIT_V(0);
    if (wr == 0) PG8_BAR;
    PG8_BAR;
#undef PG8_SA
#undef PG8_SB
#undef PG8_STAGE
#undef PG8_STAGE_A
#undef PG8_STAGE_A2
#undef PG8_STAGE_B
#undef PG8_LDA
#undef PG8_LDB
#undef PG8_MMA
#undef PG8_WAIT_V
#undef PG8_WAIT_L
#undef PG8_BAR
#undef PG8_SCHED
}
}
using pg8::Unit;

#define XB_TMO      128
#define XB_XCNT(j)  (256  + 64 * (j))
#define XB_XSUB(j)  (1280 + 64 * (j))
#define XB_XGEN(j)  (2304 + 64 * (j))
#define XB_TOP      3328
#define XB_TOPGEN   3392
#define XCD_BAR_WORDS 3456
#define XB_SPIN_CAP (1u << 18)
__device__ __forceinline__ unsigned xb_ld(unsigned* p)              { return __hip_atomic_load(p, __ATOMIC_RELAXED, __HIP_MEMORY_SCOPE_AGENT); }
__device__ __forceinline__ unsigned xb_add(unsigned* p, unsigned v) { return __hip_atomic_fetch_add(p, v, __ATOMIC_RELAXED, __HIP_MEMORY_SCOPE_AGENT); }
__device__ __forceinline__ unsigned xb_xcc_id() { return (unsigned)__builtin_amdgcn_s_getreg((3 << 11) | 20) & 0xFu; }
#define XB_SPIN(cond, bar) do { unsigned _sp = 0; while (cond) { __builtin_amdgcn_s_sleep(1); \
    if ((++_sp & 255u) == 0u) { if (xb_ld(&(bar)[XB_TMO])) break; if (_sp > XB_SPIN_CAP) { atomicAdd(&(bar)[XB_TMO], 1u); break; } } } } while (0)
struct XcdBarrier { unsigned* bar; unsigned x; volatile LAS unsigned* st; };
__device__ __forceinline__ XcdBarrier xcd_barrier_post(unsigned* bar, volatile LAS unsigned* st) {
    XcdBarrier b; b.bar = bar; b.x = xb_xcc_id(); b.st = st;
    if (threadIdx.x == 0) (void)xb_add(&bar[XB_XCNT(b.x)], 1u);
    return b;
}
__device__ __forceinline__ void xcd_barrier_complete(unsigned* bar, unsigned x, unsigned& nloc, unsigned& nx) {
    const unsigned G = gridDim.x * gridDim.y * gridDim.z;
    unsigned sum, cnt, mine, sp = 0u;
    for (;;) {
        sum = 0u; cnt = 0u; mine = 0u;
#pragma unroll
        for (unsigned j = 0; j < 16; ++j) { const unsigned c = xb_ld(&bar[XB_XCNT(j)]); sum += c; cnt += (c > 0u) ? 1u : 0u; mine = (j == x) ? c : mine; }
        if (sum == G) break;
        __builtin_amdgcn_s_sleep(1);
        if ((++sp & 255u) == 0u) { if (xb_ld(&bar[XB_TMO])) break; if (sp > XB_SPIN_CAP) { atomicAdd(&bar[XB_TMO], 1u); break; } }
    }
    nloc = mine > 0u ? mine : 1u; nx = cnt > 0u ? cnt : 1u;
}
__device__ __forceinline__ void xcd_barrier(const XcdBarrier& b) {
    asm volatile("s_waitcnt vmcnt(0)" ::: "memory");
    __syncthreads();
    if (threadIdx.x == 0) {
        unsigned* bar = b.bar;
        __builtin_amdgcn_s_waitcnt(0);
        unsigned nloc = b.st[0], nx = b.st[1];
        if (nloc == 0u) { xcd_barrier_complete(bar, b.x, nloc, nx); b.st[0] = nloc; b.st[1] = nx; }
        const unsigned old = xb_add(&bar[XB_XSUB(b.x)], 1u);
        const unsigned gen = old / nloc;
        if (old + 1u == (gen + 1u) * nloc) {
            __builtin_amdgcn_fence(__ATOMIC_RELEASE, "agent");
            asm volatile("s_waitcnt vmcnt(0)" ::: "memory");
            const unsigned og = xb_add(&bar[XB_TOP], 1u);
            const unsigned tg = og / nx;
            if (og + 1u == (tg + 1u) * nx) xb_add(&bar[XB_TOPGEN], 1u);
            else XB_SPIN(xb_ld(&bar[XB_TOPGEN]) == tg, bar);
            __builtin_amdgcn_fence(__ATOMIC_ACQUIRE, "agent");
            xb_add(&bar[XB_XGEN(b.x)], 1u);
            asm volatile("s_waitcnt vmcnt(0)" ::: "memory");
        } else {
            XB_SPIN(xb_ld(&bar[XB_XGEN(b.x)]) == gen, bar);
            __builtin_amdgcn_fence(__ATOMIC_ACQUIRE, "agent");
            asm volatile("s_waitcnt vmcnt(0)" ::: "memory");
        }
    }
    __syncthreads();
}

struct Args { const float* in[19]; float* out; unsigned char* ws; int ph_lo, ph_hi; };
typedef const __attribute__((address_space(4))) Args* ArgsP;
enum { I_X = 0, I_N1G, I_WIN, I_CONVW, I_IFB, I_MNG, I_WBM, I_WBA, I_WOUT, I_RELB, I_N2G, I_WGRP, I_BGRP, I_WEXP, I_BEXP, I_W1, I_W3, I_W2, I_FG };


struct TrDesc { const float* W; bf16* WT; size_t ldn, ldk; int k0, n0, r0; };
__device__ __forceinline__ void tr_load(const TrDesc& d, f32x4 (&tv)[16], int lane) {
    const int nn4 = (lane & 15) * 4, kr = lane >> 4;
#pragma unroll
    for (int i = 0; i < 16; ++i) tv[i] = __builtin_nontemporal_load((const f32x4*)(d.W + (size_t)(d.k0 + 4 * i + kr) * d.ldn + d.n0 + nn4));
}
__device__ __forceinline__ void tr_finish(const TrDesc& d, f32x4 (&tv)[16], LAS float* scr, int lane) {
    const int nn4 = (lane & 15) * 4, kr = lane >> 4;
#pragma unroll
    for (int i = 0; i < 16; i += 4) asm volatile("" : "+v"(tv[i]), "+v"(tv[i + 1]), "+v"(tv[i + 2]), "+v"(tv[i + 3]));
#pragma unroll
    for (int i = 0; i < 16; ++i) { const int kk = 4 * i + kr; const f32x4 v = tv[i];
        LAS float* q = scr + kk * 65 + nn4; q[0] = v.x; q[1] = v.y; q[2] = v.z; q[3] = v.w; }
    LDS_WAIT();
    const int kc = (lane & 7) * 8;
#pragma unroll
    for (int p = 0; p < 8; ++p) { const int nn = 8 * p + (lane >> 3); const LAS float* sp = scr + kc * 65 + nn;
        u32x4 o; o.x = cvt_pk_bf16(sp[0], sp[65]); o.y = cvt_pk_bf16(sp[130], sp[195]); o.z = cvt_pk_bf16(sp[260], sp[325]); o.w = cvt_pk_bf16(sp[390], sp[455]);
        *(u32x4*)(d.WT + (size_t)(d.r0 + nn) * d.ldk + d.k0 + kc) = o; }
    LDS_WAIT();
}
__device__ __forceinline__ int win_src_col(int r) {
    if (r < 2048) return r;
    if (r < 3072) return r + 1024;
    if (r < 5120) return r + 1032;
    if (r < 9216) return r + 2056;
    if (r < 10240) return r - 7168;
    return r - 4088;
}
__device__ __forceinline__ TrDesc tr_decode(ArgsP a, unsigned char* ws, int it) {
    constexpr int PER_LAYER = 5632 + 512 + 512 + 1024 + 4096 + 4096 + 4096;
    const int l = it / PER_LAYER; int r = it % PER_LAYER;
    TrDesc d;
    if (r < 5632) { const int kb = r / 176, ng = r % 176;
        d.W = a->in[I_WIN] + (size_t)l * DM * INCOLS; d.ldn = INCOLS; d.k0 = 64 * kb; d.n0 = win_src_col(64 * ng); d.WT = (bf16*)(ws + WS_WINT) + (size_t)l * 11264 * 2048; d.ldk = 2048; d.r0 = 64 * ng; return d; }
    r -= 5632;
    if (r < 512) { const int kb = r / 32, ng = r % 32;
        d.W = a->in[I_WBM] + (size_t)l * 1024 * 2048; d.ldn = 2048; d.k0 = 64 * kb; d.n0 = 64 * ng; d.WT = (bf16*)(ws + WS_WBM) + (size_t)l * 2048 * 1024; d.ldk = 1024; d.r0 = 64 * ng; return d; }
    r -= 512;
    if (r < 512) { const int kb = r / 32, ng = r % 32;
        d.W = a->in[I_WBA] + (size_t)l * 1024 * 2048; d.ldn = 2048; d.k0 = 64 * kb; d.n0 = 64 * ng; d.WT = (bf16*)(ws + WS_WBA) + (size_t)l * 2048 * 1024; d.ldk = 1024; d.r0 = 64 * ng; return d; }
    r -= 512;
    if (r < 1024) { const int kb = r / 32, ng = r % 32;
        d.W = a->in[I_WOUT] + (size_t)l * 2048 * 2048; d.ldn = 2048; d.k0 = 64 * kb; d.n0 = 64 * ng; d.WT = (bf16*)(ws + WS_WOUT) + (size_t)l * 2048 * 2048; d.ldk = 2048; d.r0 = 64 * ng; return d; }
    r -= 1024;
    if (r < 8192) { const int w3 = r >= 4096; const int q = r & 4095; const int e = q >> 7, rr = q & 127, kb = rr >> 2, ng = rr & 3;
        d.W = a->in[w3 ? I_W3 : I_W1] + (size_t)(l * 32 + e) * 2048 * 256; d.ldn = 256; d.k0 = 64 * kb; d.n0 = 64 * ng;
        d.WT = (bf16*)(ws + WS_W13) + (size_t)(l * 32 + e) * 512 * 2048; d.ldk = 2048; d.r0 = 256 * (ng >> 1) + 64 * (ng & 1) + (w3 ? 128 : 0); return d; }
    r -= 8192;
    { const int e = r >> 7, rr = r & 127, kb = rr >> 5, ng = rr & 31;
        d.W = a->in[I_W2] + (size_t)(l * 32 + e) * 256 * 2048; d.ldn = 2048; d.k0 = 64 * kb; d.n0 = 64 * ng; d.WT = (bf16*)(ws + WS_W2) + (size_t)(l * 32 + e) * 2048 * 256; d.ldk = 256; d.r0 = 64 * ng; return d; }
}
#ifndef CVX
#define CVX 4096
#endif
__device__ __forceinline__ void prologue_phase(ArgsP a, LAS unsigned char* lds, int tid, int lane, int wave, int bid, int G, const int part = 0) {
    unsigned char* ws = a->ws;
    LAS float* scr = (LAS float*)(lds + wave * 16640);
    const int gw = bid * NWAVES + wave, NGW = G * NWAVES;
    constexpr int PER_LAYER = 5632 + 512 + 512 + 1024 + 4096 + 4096 + 4096;
    constexpr int W0 = 5632, W2I = PER_LAYER - 4096;
    const int v_lo = part == 0 ? 0 : part == 1 ? PER_LAYER : part == 2 ? W0 + CVX : part == 3 ? PER_LAYER + W0 : PER_LAYER + W2I;
    const int v_hi = part == 0 ? W0 + CVX : part == 1 ? PER_LAYER + W0 : part == 2 ? PER_LAYER : part == 3 ? PER_LAYER + W2I : 2 * PER_LAYER;
#define CV_ITEM(v) (v)
    f32x4 tvA[16], tvB[16]; TrDesc dA, dB;
    int it = v_lo + gw;
    if (it < v_hi) {
        int rem = (v_hi - 1 - it) / NGW;
        dA = tr_decode(a, ws, CV_ITEM(it)); tr_load(dA, tvA, lane);
#pragma unroll 1
        while (rem >= 2) {
            dB = tr_decode(a, ws, CV_ITEM(it + NGW)); tr_load(dB, tvB, lane);
            tr_finish(dA, tvA, scr, lane);
            it += 2 * NGW;
            dA = tr_decode(a, ws, CV_ITEM(it)); tr_load(dA, tvA, lane);
            tr_finish(dB, tvB, scr, lane);
            rem -= 2;
        }
        if (rem == 1) { dB = tr_decode(a, ws, CV_ITEM(it + NGW)); tr_load(dB, tvB, lane); tr_finish(dA, tvA, scr, lane); tr_finish(dB, tvB, scr, lane); }
        else tr_finish(dA, tvA, scr, lane);
    }
#undef CV_ITEM
    if (part != 0) return;
    const int gt = bid * NTHR + tid, NGT = G * NTHR;
    float* wrt = (float*)(ws + MS_WRT);
    for (int i = gt; i < 2 * 36 * 2048; i += NGT) { const int l = i / (36 * 2048), rr = i % (36 * 2048), n = rr >> 11, k = rr & 2047;
        wrt[i] = n < 4 ? a->in[I_WGRP][((size_t)l * DM + k) * 4 + n] : a->in[I_WEXP][((size_t)l * DM + k) * 32 + (n - 4)]; }
}

__device__ __forceinline__ void moe_tables(unsigned char* ws, int l, LAS unsigned char* misc, int tid) {
    LAS int* cnt = (LAS int*)(misc + MO_CNT); LAS int* ntl = (LAS int*)(misc + MO_NT); LAS int* off = (LAS int*)(misc + MO_OFF);
    LAS int* te = (LAS int*)(misc + MO_TE); LAS int* tr0 = (LAS int*)(misc + MO_TR0); LAS int* mt = (LAS int*)(misc + MO_MT);
    __syncthreads();
    if (tid < 32) { const int c = (int)__hip_atomic_load((unsigned*)(ws + WS_CTL) + CW_CNT + 32 * l + tid, __ATOMIC_RELAXED, __HIP_MEMORY_SCOPE_AGENT); cnt[tid] = c; ntl[tid] = (c + 255) >> 8; }
    __syncthreads();
    if (tid == 0) { int o = 0;
#pragma unroll 1
        for (int e = 0; e < 32; ++e) { off[e] = o; const int n = ntl[e];
#pragma unroll 1
            for (int j = 0; j < n; ++j) { te[o + j] = e; tr0[o + j] = 256 * j; } o += n; } off[32] = o; mt[0] = o; }
    __syncthreads();
}

#ifndef DRYX
#define DRYX 0
#endif
template <int MODE>
__device__ __forceinline__ void norm_phase(ArgsP a, int l, LAS unsigned char* lds, int tid, int lane, int wave, int bid, int G, const bool dry = false) {
    unsigned char* ws = a->ws;
    LAS unsigned char* misc = lds + MISC_OFF;
    if (MODE == 1 || MODE == 3) moe_tables(ws, MODE == 1 ? 0 : 1, misc, tid);
    const LAS int* off = (const LAS int*)(misc + MO_OFF);
    const float* src = (MODE == 0) ? a->in[I_X] : a->out;
    const float* gain = (MODE < 2) ? a->in[I_N1G] + l * DM : (MODE == 2 ? a->in[I_N2G] + l * DM : a->in[I_FG]);
    const int* toke = (const int*)(ws + MS_TOKE); const int* tokp = (const int*)(ws + MS_TOKP);
    const bf16* OP = (const bf16*)(ws + WS_OP);
    bf16* H = (bf16*)(ws + WS_H);
    const int gw = bid * NWAVES + wave, NGW = G * NWAVES;
    constexpr int RP = (MODE == 2) ? 4 : 2;
    for (int m0 = gw * RP; m0 < NTOK; m0 += NGW * RP) {
        f32x4 v[RP][8];
        const bf16* orow[RP][2]; float cw[RP][2];
        if (MODE == 1 || MODE == 3) {
#pragma unroll
            for (int r = 0; r < RP; ++r) { const int m = m0 + r;
                const int e0 = toke[2 * m], e1 = toke[2 * m + 1], p0 = tokp[2 * m], p1 = tokp[2 * m + 1];
                cw[r][0] = ((const float*)(ws + MS_TOKW))[2 * m]; cw[r][1] = ((const float*)(ws + MS_TOKW))[2 * m + 1];
                orow[r][0] = OP + (size_t)(off[e0] * 256 + p0) * DM + 4 * lane; orow[r][1] = OP + (size_t)(off[e1] * 256 + p1) * DM + 4 * lane; }
        }
#pragma unroll
        for (int r = 0; r < RP; ++r)
#pragma unroll
            for (int j = 0; j < 8; ++j) v[r][j] = *(const f32x4*)(src + (size_t)(m0 + r) * DM + 256 * j + 4 * lane);
        if (MODE == 1 || MODE == 3) {
            u32x2 ow[RP][2][8];
#pragma unroll
            for (int r = 0; r < RP; ++r)
#pragma unroll
                for (int j = 0; j < 8; ++j) { ow[r][0][j] = *(const u32x2*)(orow[r][0] + 256 * j); ow[r][1][j] = *(const u32x2*)(orow[r][1] + 256 * j); }
#pragma unroll
            for (int r = 0; r < RP; ++r)
                asm volatile("" : "+v"(ow[r][0][0]), "+v"(ow[r][0][1]), "+v"(ow[r][0][2]), "+v"(ow[r][0][3]), "+v"(ow[r][0][4]), "+v"(ow[r][0][5]), "+v"(ow[r][0][6]), "+v"(ow[r][0][7]),
                                  "+v"(ow[r][1][0]), "+v"(ow[r][1][1]), "+v"(ow[r][1][2]), "+v"(ow[r][1][3]), "+v"(ow[r][1][4]), "+v"(ow[r][1][5]), "+v"(ow[r][1][6]), "+v"(ow[r][1][7]));
#pragma unroll
            for (int r = 0; r < RP; ++r) { const int m = m0 + r; const float cw0 = cw[r][0], cw1 = cw[r][1];
#pragma unroll
                for (int j = 0; j < 8; ++j) { const u32x2 w0 = ow[r][0][j], w1 = ow[r][1][j];
                    v[r][j].x += cw0 * bflo(w0.x) + cw1 * bflo(w1.x); v[r][j].y += cw0 * bfhi(w0.x) + cw1 * bfhi(w1.x); v[r][j].z += cw0 * bflo(w0.y) + cw1 * bflo(w1.y); v[r][j].w += cw0 * bfhi(w0.y) + cw1 * bfhi(w1.y); }
                if (MODE == 1 && !dry) {
#pragma unroll
                    for (int j = 0; j < 8; ++j) *(f32x4*)(a->out + (size_t)m * DM + 256 * j + 4 * lane) = v[r][j]; }
            }
        }
        float rs[RP];
#pragma unroll
        for (int r = 0; r < RP; ++r) { float ss = 0.f;
#pragma unroll
            for (int j = 0; j < 8; ++j) ss += (v[r][j].x * v[r][j].x + v[r][j].y * v[r][j].y) + (v[r][j].z * v[r][j].z + v[r][j].w * v[r][j].w);
            rs[r] = __builtin_amdgcn_rsqf(wave_sum(ss) * (1.0f / DM) + RMS_EPS); }
        {
            f32x4 gv[8];
#pragma unroll
            for (int j = 0; j < 8; ++j) gv[j] = *(const f32x4*)(gain + 256 * j + 4 * lane);
            asm volatile("" : "+v"(gv[0]), "+v"(gv[1]), "+v"(gv[2]), "+v"(gv[3]), "+v"(gv[4]), "+v"(gv[5]), "+v"(gv[6]), "+v"(gv[7]));
#pragma unroll
            for (int j = 0; j < 8; ++j)
#pragma unroll
                for (int r = 0; r < RP; ++r) v[r][j] = v[r][j] * rs[r] * gv[j];
        }
        if (MODE == 3) {
#pragma unroll
            for (int r = 0; r < RP; ++r)
#pragma unroll
                for (int j = 0; j < 8; ++j) { if (!dry) *(f32x4*)(a->out + (size_t)(m0 + r) * DM + 256 * j + 4 * lane) = v[r][j]; else asm volatile("" :: "v"(v[r][j])); }
            continue;
        }
#pragma unroll
        for (int r = 0; r < RP; ++r)
#pragma unroll
            for (int j = 0; j < 8; ++j) { u32x2 w; w.x = cvt_pk_bf16(v[r][j].x, v[r][j].y); w.y = cvt_pk_bf16(v[r][j].z, v[r][j].w);
                if (!dry) *(u32x2*)(H + (size_t)(m0 + r) * DM + 256 * j + 4 * lane) = w; else asm volatile("" :: "v"(w)); }
        float keep[RP]; _Pragma("unroll") for (int r = 0; r < RP; ++r) keep[r] = 0.f;
        if (MODE < 2) {
            float a8[RP][8];
#pragma unroll
            for (int r = 0; r < RP; ++r)
#pragma unroll
                for (int n = 0; n < 8; ++n) a8[r][n] = 0.f;
            const float* wg = a->in[I_WIN] + (size_t)l * DM * INCOLS + 4096;
#pragma unroll
            for (int j = 0; j < 8; ++j)
#pragma unroll
                for (int c = 0; c < 4; ++c) { const float* wp = wg + (size_t)(256 * j + 4 * lane + c) * INCOLS;
                    const f32x4 w0 = *(const f32x4*)wp, w1 = *(const f32x4*)(wp + 4);
#pragma unroll
                    for (int r = 0; r < RP; ++r) { const float hv = v[r][j][c];
                        a8[r][0] += hv * w0.x; a8[r][1] += hv * w0.y; a8[r][2] += hv * w0.z; a8[r][3] += hv * w0.w;
                        a8[r][4] += hv * w1.x; a8[r][5] += hv * w1.y; a8[r][6] += hv * w1.z; a8[r][7] += hv * w1.w; }
                    if (c == 3) asm volatile("" ::: "memory"); }
#pragma unroll
            for (int r = 0; r < RP; ++r)
#pragma unroll
                for (int n = 0; n < 8; ++n) { const float d = wave_sum(a8[r][n]); keep[r] = (lane == n) ? d : keep[r]; }
        } else {
            const float* W = (const float*)(ws + MS_WRT) + (size_t)l * 36 * 2048;
            LAS float* logl = (LAS float*)(misc + MO_LOG) + wave * 160;
#pragma unroll 1
            for (int grp = 0; grp < 9; ++grp) {
                float val[16];
                const float* wg = W + (size_t)(4 * grp) * 2048 + 4 * lane;
#pragma unroll
                for (int nl = 0; nl < 4; ++nl) {
                    float d[4] = {0.f, 0.f, 0.f, 0.f};
                    f32x4 wv[8];
#pragma unroll
                    for (int j = 0; j < 8; ++j) wv[j] = *(const f32x4*)(wg + nl * 2048 + 256 * j);
                    asm volatile("" : "+v"(wv[0]), "+v"(wv[1]), "+v"(wv[2]), "+v"(wv[3]), "+v"(wv[4]), "+v"(wv[5]), "+v"(wv[6]), "+v"(wv[7]));
#pragma unroll
                    for (int j = 0; j < 8; ++j) { const f32x4 w = wv[j];
#pragma unroll
                        for (int r = 0; r < 4; ++r) d[r] += (v[r][j].x * w.x + v[r][j].y * w.y) + (v[r][j].z * w.z + v[r][j].w * w.w); }
#pragma unroll
                    for (int r = 0; r < 4; ++r) val[4 * nl + r] = d[r];
                }
#pragma unroll
                for (int i = 0; i < 8; ++i) { const bool hi = (lane & 32) != 0; const float snd = hi ? val[i] : val[i + 8]; const float kp = hi ? val[i + 8] : val[i]; val[i] = kp + __shfl_xor(snd, 32); }
#pragma unroll
                for (int i = 0; i < 4; ++i) { const bool hi = (lane & 16) != 0; const float snd = hi ? val[i] : val[i + 4]; const float kp = hi ? val[i + 4] : val[i]; val[i] = kp + __shfl_xor(snd, 16); }
#pragma unroll
                for (int i = 0; i < 2; ++i) { const bool hi = (lane & 8) != 0; const float snd = hi ? val[i] : val[i + 2]; const float kp = hi ? val[i + 2] : val[i]; val[i] = kp + __shfl_xor(snd, 8); }
                { const bool hi = (lane & 4) != 0; const float snd = hi ? val[0] : val[1]; const float kp = hi ? val[1] : val[0]; val[0] = kp + __shfl_xor(snd, 4); }
                float f = val[0]; f += __shfl_xor(f, 2); f += __shfl_xor(f, 1);
                const int vi = lane >> 2;
                if ((lane & 3) == 0) logl[(vi & 3) * 40 + 4 * grp + (vi >> 2)] = f;
            }
        }
        if (MODE < 2) {
            float* ifg = (float*)(ws + MS_IFG);
            if (lane < 8) {
#pragma unroll
                for (int r = 0; r < RP; ++r) { if (!dry) ifg[(size_t)(m0 + r) * 8 + lane] = keep[r]; else asm volatile("" :: "v"(keep[r])); } }
        } else {
            LAS float* logl = (LAS float*)(misc + MO_LOG) + wave * 160;
            LDS_WAIT();
            if (dry) { asm volatile("" :: "v"(keep[0])); }
            if (lane < RP && !dry) {
                const int m = m0 + lane; const LAS float* lg = logl + lane * 40;
                const float* bg = a->in[I_BGRP] + l * 4; const float* be = a->in[I_BEXP] + l * 32;
                float gv[4]; int gsel = 0;
#pragma unroll
                for (int j = 0; j < 4; ++j) gv[j] = lg[j] + bg[j];
                float gmax = gv[0];
#pragma unroll
                for (int j = 1; j < 4; ++j) if (gv[j] > gmax) { gmax = gv[j]; gsel = j; }
                float gs = 0.f;
#pragma unroll
                for (int j = 0; j < 4; ++j) gs += expf(gv[j] - gmax);
                const float pg = 1.0f / gs;
                float ev[8];
#pragma unroll
                for (int j = 0; j < 8; ++j) ev[j] = lg[4 + 8 * gsel + j] + be[8 * gsel + j];
                int e0 = 0; float m0v = ev[0];
#pragma unroll
                for (int j = 1; j < 8; ++j) if (ev[j] > m0v) { m0v = ev[j]; e0 = j; }
                int e1 = -1; float m1v = -3.0e38f;
#pragma unroll
                for (int j = 0; j < 8; ++j) if (j != e0 && ev[j] > m1v) { m1v = ev[j]; e1 = j; }
                const float p1 = expf(m1v - m0v); const float w0 = pg / (1.0f + p1), w1 = pg * p1 / (1.0f + p1);
                unsigned* cnt = (unsigned*)(ws + WS_CTL) + CW_CNT + 32 * l;
                int* list = (int*)(ws + MS_LIST); float* pwl = (float*)(ws + MS_PWL); int* tke = (int*)(ws + MS_TOKE); int* tkp = (int*)(ws + MS_TOKP);
                const int id0 = 8 * gsel + e0, id1 = 8 * gsel + e1;
                const int q0 = (int)__hip_atomic_fetch_add(cnt + id0, 1u, __ATOMIC_RELAXED, __HIP_MEMORY_SCOPE_AGENT);
                const int q1 = (int)__hip_atomic_fetch_add(cnt + id1, 1u, __ATOMIC_RELAXED, __HIP_MEMORY_SCOPE_AGENT);
                list[id0 * 8192 + q0] = m; pwl[id0 * 8192 + q0] = w0; list[id1 * 8192 + q1] = m; pwl[id1 * 8192 + q1] = w1;
                tke[2 * m] = id0; tke[2 * m + 1] = id1; tkp[2 * m] = q0; tkp[2 * m + 1] = q1;
                ((float*)(ws + MS_TOKW))[2 * m] = w0; ((float*)(ws + MS_TOKW))[2 * m + 1] = w1;
            }
            LDS_WAIT();
        }
    }
}

struct SchedG1 {
    static constexpr bool GATHER = false;
    const char* H; const char* W; int G, c;
    static constexpr int NCV = 21;
    __device__ __forceinline__ bool next(int i, Unit& u) const {
        int L = i * G + c;
        if (G == 256) {
            if (c >= 256 - NCV) return false;
            if (c >= 128 && i == 5) { const int k = c - 128; if (k >= 5 * NCV) return false; L = (k % 5) * 256 + (256 - NCV) + k / 5; }
            else if (i > 5) return false;
        }
        if (L < 1152) { pg8::static_tile(L, 32, 36, u.pm, u.pn); u.aux = 0; return true; }
        const int r = L - 1152; if (r >= 256) return false;
        u.aux = 1 + (r >> 7); const int q = r & 127; u.pm = q & 3; u.pn = q >> 2; return true;
    }
    __device__ __forceinline__ const char* abase(const Unit& u) const { return u.aux == 0 ? H + (size_t)u.pm * 256 * 4096 : W + (size_t)(9216 + (u.aux - 1) * 1024 + u.pm * 256) * 4096; }
    __device__ __forceinline__ const char* bbase(const Unit& u) const { return u.aux == 0 ? W + (size_t)u.pn * 256 * 4096 : H + (size_t)u.pn * 256 * 4096; }
    __device__ __forceinline__ unsigned arow(const Unit&, int) const { return 0u; }
    static __device__ __forceinline__ bool keep_acc(const Unit&) { return false; }
};
struct EpiG1 {
    static constexpr bool PERM = true;
    unsigned char* ws; bool dry;
    __device__ __forceinline__ void operator()(f32x4 (&acc)[2][2][4][2], const Unit& u, int wr, int wc, int fr, int fq) const {
        if (dry) {
#pragma unroll
            for (int ai = 0; ai < 2; ++ai)
#pragma unroll
                for (int bj = 0; bj < 2; ++bj)
#pragma unroll
                    for (int m = 0; m < 4; ++m) asm volatile("" :: "v"(acc[ai][bj][m][0]), "v"(acc[ai][bj][m][1]));
            return; }
        if (u.aux == 0) {
            bf16* dst; int ld, colt, op;
            if (u.pn < 8) { dst = (bf16*)(ws + WS_ZQK); ld = 2048; colt = 256 * u.pn; op = 0; }
            else if (u.pn < 12) { dst = (bf16*)(ws + WS_OM); ld = 1024; colt = 256 * (u.pn - 8); op = 1; }
            else if (u.pn < 16) { dst = (bf16*)(ws + WS_QA); ld = 1024; colt = 256 * (u.pn - 12); op = 2; }
            else if (u.pn < 20) { dst = (bf16*)(ws + WS_KA); ld = 1024; colt = 256 * (u.pn - 16); op = 0; }
            else { dst = (bf16*)(ws + WS_SG); ld = 4096; colt = 256 * (u.pn - 20); op = 1; }
            const float scl = (op == 2) ? 0.12751743074602267f : 1.0f;
            const int row0 = u.pm * 256 + wr * 64 + fr, col0 = colt + wc * 32 + 8 * fq;
#pragma unroll
            for (int ai = 0; ai < 2; ++ai)
#pragma unroll
                for (int m = 0; m < 4; ++m) { bf16* rowp = dst + (size_t)(row0 + ai * 128 + m * 16) * ld + col0;
#pragma unroll
                    for (int bj = 0; bj < 2; ++bj) { f32x4 v0 = acc[ai][bj][m][0] * scl, v1 = acc[ai][bj][m][1] * scl;
                        if (op == 1) {
#pragma unroll
                            for (int j = 0; j < 4; ++j) { v0[j] = sigmoidf_(v0[j]); v1[j] = sigmoidf_(v1[j]); } }
                        u32x4 w; w.x = cvt_pk_bf16(v0[0], v0[1]); w.y = cvt_pk_bf16(v0[2], v0[3]); w.z = cvt_pk_bf16(v1[0], v1[1]); w.w = cvt_pk_bf16(v1[2], v1[3]);
                        *(u32x4*)(rowp + bj * 128) = w; } }
        } else {
            bf16* dst = (bf16*)(ws + (u.aux == 1 ? WS_VMT : WS_VAT));
            const int b = u.pn >> 3, s0 = (u.pn & 7) * 256 + wc * 32 + 8 * fq, rr0 = u.pm * 256 + wr * 64 + fr;
#pragma unroll
            for (int ai = 0; ai < 2; ++ai)
#pragma unroll
                for (int m = 0; m < 4; ++m) { const int rr = rr0 + ai * 128 + m * 16;
#pragma unroll
                    for (int bj = 0; bj < 2; ++bj) { const f32x4 v0 = acc[ai][bj][m][0], v1 = acc[ai][bj][m][1];
                        u32x4 w; w.x = cvt_pk_bf16(v0[0], v0[1]); w.y = cvt_pk_bf16(v0[2], v0[3]); w.z = cvt_pk_bf16(v1[0], v1[1]); w.w = cvt_pk_bf16(v1[2], v1[3]);
                        const int sq = s0 + bj * 128;
                        const size_t off = (u.aux == 1) ? (size_t)((((b * 4 + (rr >> 8)) * 32 + (sq >> 6)) * 2 + ((sq >> 5) & 1)) * 16 + ((rr & 255) >> 4)) * 512 + (size_t)((((sq >> 3) & 3) * 16 + (rr & 15)) * 8)
                                                        : (size_t)(b * 1024 + rr) * 2048 + sq;
                        *(u32x4*)(dst + off) = w; } }
        }
    }
};

__device__ __forceinline__ void gate_unit(ArgsP a, int l, LAS unsigned char* lds, int bh, int tid, int lane, int wave) {
    unsigned char* ws = a->ws;
    {
            const int b = bh >> 2, h = bh & 3;
            LAS float* bl = (LAS float*)lds; LAS float* amx = bl + 32; LAS float* mpv = bl + 64; LAS float* gcv = bl + 96;
            const float* ifg = (const float*)(ws + MS_IFG); const float* ifb = a->in[I_IFB] + l * 8;
            float A[4], Bs[4], CM[4];
#pragma unroll
            for (int cc = 0; cc < 4; ++cc) { const int c = wave + 8 * cc, s = 64 * c + lane; const size_t tok = (size_t)b * SEQ + s;
                const float ig = ifg[tok * 8 + h] + ifb[h], fg = ifg[tok * 8 + 4 + h] + ifb[4 + h];
                const float lf = fminf(fg, 0.f) - log1pf(expf(-fabsf(fg)));
                float bs = lf;
#pragma unroll
                for (int o = 1; o < 64; o <<= 1) { const float t = __shfl_up(bs, o); if (lane >= o) bs += t; }
                const float av = ig - bs; float cm = av;
#pragma unroll
                for (int o = 1; o < 64; o <<= 1) { const float t = __shfl_up(cm, o); if (lane >= o) cm = fmaxf(cm, t); }
                A[cc] = av; Bs[cc] = bs; CM[cc] = cm;
                if (lane == 63) { bl[c] = bs; amx[c] = cm; } }
            __syncthreads();
            if (tid == 0) { float m = 0.f;
#pragma unroll 1
                for (int c = 0; c < 32; ++c) { mpv[c] = m; const float Gm = fmaxf(m, amx[c]); gcv[c] = Gm; m = bl[c] + Gm; } }
            __syncthreads();
            float* AS = (float*)(ws + MS_AS) + bh * 2048; float* GT = (float*)(ws + MS_GT) + bh * 2048; float* WI = (float*)(ws + MS_WI) + bh * 2048;
            float* CL = (float*)(ws + MS_CL) + bh * 2048; float* WSs = (float*)(ws + MS_WS) + bh * 2048; float* DEC = (float*)(ws + MS_DEC) + bh * 32;
#pragma unroll
            for (int cc = 0; cc < 4; ++cc) { const int c = wave + 8 * cc, s = 64 * c + lane; const float mp = mpv[c], Gm = gcv[c], gt = fmaxf(mp, CM[cc]);
                AS[s] = A[cc]; GT[s] = gt; WI[s] = expf(mp - gt); CL[s] = expf(-(Bs[cc] + gt)); WSs[s] = expf(A[cc] - Gm);
                if (lane == 0) DEC[c] = expf(mp - Gm); }
        }
    __syncthreads();
}

__device__ __forceinline__ void conv_phase(ArgsP a, int l, LAS unsigned char* lds, int tid, int lane, int wave, int bid, int G) {
    unsigned char* ws = a->ws;
    u32x4 xv[5];
    const bf16* Z = (const bf16*)(ws + WS_ZQK);
#define CONV_LOAD(u_) do { const int cg_ = (u_) & 7, s0_ = 64 * (((u_) >> 3) & 31), b_ = (u_) >> 8; _Pragma("unroll") for (int i = 0; i < 5; ++i) { \
        const int idx = tid + NTHR * i, row = idx >> 5, ch = idx & 31, sq = s0_ - 3 + row; xv[i] = (u32x4){0u, 0u, 0u, 0u}; \
        if (idx < 67 * 32 && sq >= 0) xv[i] = *(const u32x4*)(Z + (size_t)(b_ * SEQ + sq) * 2048 + cg_ * 256 + ch * 8); } } while (0)
    if (bid < 1024) CONV_LOAD(bid);
    for (int u = bid; u < 1024 + 256; u += G) {
        if (u < 1024) {
            const int cg = u & 7, st = (u >> 3) & 31, b = u >> 8, s0 = 64 * st;
            LAS unsigned char* xt = lds; LAS unsigned char* kt = lds + 36864;
            asm volatile("" : "+v"(xv[0]), "+v"(xv[1]), "+v"(xv[2]), "+v"(xv[3]), "+v"(xv[4]));
#pragma unroll
            for (int i = 0; i < 5; ++i) { const int idx = tid + NTHR * i, row = idx >> 5, ch = idx & 31;
                if (idx < 67 * 32) *(LAS u32x4*)(xt + row * 512 + ch * 16) = xv[i]; }
            LAS float* wst = (LAS float*)(lds + 73728);
            if (cg >= 4 && tid < 64) wst[tid] = ((const float*)(ws + MS_WS))[(size_t)(b * 4 + cg - 4) * 2048 + s0 + tid];
            __syncthreads();
            if (u + G < 1024) CONV_LOAD(u + G);
            const int cp = tid & 127, tg = tid >> 7, c = 2 * cp, gc = cg * 256 + c;
            float w0[4], w1[4];
#pragma unroll
            for (int j = 0; j < 4; ++j) { w0[j] = a->in[I_CONVW][(size_t)(l * 4 + j) * 2048 + gc]; w1[j] = a->in[I_CONVW][(size_t)(l * 4 + j) * 2048 + gc + 1]; }
            bf16* QM = (bf16*)(ws + WS_QM); bf16* KM = (bf16*)(ws + WS_KM);
#pragma unroll 4
            for (int tt = 0; tt < 16; ++tt) { const int t = tg * 16 + tt; float a0 = 0.f, a1 = 0.f;
#pragma unroll
                for (int j = 0; j < 4; ++j) { const unsigned x = *(const LAS unsigned*)(xt + (t + j) * 512 + c * 2); a0 += w0[j] * bflo(x); a1 += w1[j] * bfhi(x); }
                float o0 = a0 * sigmoidf_(a0), o1 = a1 * sigmoidf_(a1);
                const size_t tok = (size_t)b * SEQ + s0 + t;
                if (cg < 4) { *(unsigned*)(QM + tok * 1024 + cg * 256 + c) = cvt_pk_bf16(o0, o1); }
                else { o0 *= 0.0625f; o1 *= 0.0625f; const unsigned p = cvt_pk_bf16(o0, o1);
                    *(unsigned*)(KM + tok * 1024 + (cg - 4) * 256 + c) = p;
                    const float wsv = wst[t]; const unsigned ps = cvt_pk_bf16(o0 * wsv, o1 * wsv);
                    *(LAS unsigned short*)(kt + c * 144 + t * 2) = (unsigned short)(ps & 0xffffu); *(LAS unsigned short*)(kt + (c + 1) * 144 + t * 2) = (unsigned short)(ps >> 16); }
            }
            if (cg >= 4) {
                __syncthreads();
                bf16* KMT = (bf16*)(ws + WS_KMT);
                for (int idx = tid; idx < 2048; idx += NTHR) {
                    const int ks = idx >> 10, dtl = (idx >> 6) & 15, ln = idx & 63, row = dtl * 16 + (ln & 15), ch = ks * 4 + (ln >> 4);
                    const u32x4 v = *(const LAS u32x4*)(kt + row * 144 + ch * 16);
                    *(u32x4*)(KMT + (size_t)(((b * 4 + cg - 4) * 32 + st) * 2) * 8192 + (size_t)idx * 8) = v; }
                if (tid < 256) {
                    float sm = 0.f;
#pragma unroll
                    for (int i = 0; i < 8; ++i) { const u32x4 v = *(const LAS u32x4*)(kt + tid * 144 + i * 16);
                        sm += (bflo(v.x) + bfhi(v.x)) + (bflo(v.y) + bfhi(v.y)) + (bflo(v.z) + bfhi(v.z)) + (bflo(v.w) + bfhi(v.w)); }
                    ((float*)(ws + MS_NST))[(size_t)((b * 4 + cg - 4) * 32 + st) * 256 + tid] = sm; }
            }
        } else if (u < 1280) {
            const int j = u - 1024, b = j >> 6, n = (j >> 3) & 7, h = j & 7;
            const bf16* KA = (const bf16*)(ws + WS_KA) + (size_t)(b * SEQ + n * 256 + wave * 32) * 1024 + h * 128 + 2 * lane;
            float s0 = 0.f, s1 = 0.f;
            unsigned xr[32];
#pragma unroll
            for (int r = 0; r < 32; ++r) xr[r] = *(const unsigned*)(KA + (size_t)r * 1024);
#pragma unroll
            for (int r = 0; r < 32; r += 8) asm volatile("" : "+v"(xr[r]), "+v"(xr[r + 1]), "+v"(xr[r + 2]), "+v"(xr[r + 3]), "+v"(xr[r + 4]), "+v"(xr[r + 5]), "+v"(xr[r + 6]), "+v"(xr[r + 7]));
#pragma unroll
            for (int r = 0; r < 32; ++r) { s0 += bflo(xr[r]); s1 += bfhi(xr[r]); }
            LAS float* part = (LAS float*)lds;
            part[wave * 128 + 2 * lane] = s0; part[wave * 128 + 2 * lane + 1] = s1;
            __syncthreads();
            if (tid < 128) { float t = 0.f;
#pragma unroll
                for (int w = 0; w < 8; ++w) t += part[w * 128 + tid];
                ((float*)(ws + MS_KMEAN))[(size_t)((b * 8 + h) * 8 + n) * 128 + tid] = t * (1.0f / 256.0f); }
        }
        __syncthreads();
    }
}

#undef CONV_LOAD
__device__ __forceinline__ void mlstm_ab_task(unsigned char* ws, int gw, int lane, const bool do_store = true) {
    const int bh = gw >> 7, piece = gw & 127, e0 = (piece >> 3) * 16, d0 = (piece & 7) * 32, q16 = lane & 15, g = lane >> 4;
    const bf16* ka = (const bf16*)(ws + WS_KMT) + (size_t)bh * 32 * 16384 + (size_t)(d0 >> 4) * 512 + lane * 8;
    const bf16* vb = (const bf16*)(ws + WS_VMT) + (size_t)bh * 32 * 16384 + (size_t)(e0 >> 4) * 512 + lane * 8;
    const float* DEC = (const float*)(ws + MS_DEC) + bh * 32;
    bf16* CST = (bf16*)(ws + WS_CST) + (size_t)bh * 32 * 65536 + (size_t)((d0 >> 5) * 16 + (e0 >> 4)) * 512 + (size_t)(((g >> 1) * 16 + q16) * 8 + 4 * (g & 1));
    f32x4 acc[2]; acc[0] = (f32x4){0.f, 0.f, 0.f, 0.f}; acc[1] = acc[0];
    const int decv = __builtin_bit_cast(int, DEC[lane & 31]);
    bf16x8 A0[2][2], B0[2], A1[2][2], B1[2], A2[2][2], B2[2], A3[2][2], B3[2], A4[2][2], B4[2];
#define AB_LOAD(c_, A_, B_) do { const int cc_ = (c_) < 31 ? (c_) : 31; _Pragma("unroll") for (int ks = 0; ks < 2; ++ks) { \
        A_[0][ks] = *(const bf16x8*)(ka + (size_t)cc_ * 16384 + ks * 8192); A_[1][ks] = *(const bf16x8*)(ka + (size_t)cc_ * 16384 + ks * 8192 + 512); B_[ks] = *(const bf16x8*)(vb + (size_t)cc_ * 16384 + ks * 8192); } } while (0)
#define AB_STEP(c_, A_, B_) do { \
        if (do_store) { _Pragma("unroll") for (int f = 0; f < 2; ++f) { u32x2 w; w.x = cvt_pk_bf16(acc[f][0], acc[f][1]); w.y = cvt_pk_bf16(acc[f][2], acc[f][3]); *(u32x2*)(CST + (size_t)(c_) * 65536 + 256 * f) = w; } } \
        const float dec = __builtin_bit_cast(float, __builtin_amdgcn_readlane(decv, (c_))); \
        acc[0] = acc[0] * dec; acc[1] = acc[1] * dec; \
        _Pragma("unroll") for (int ks = 0; ks < 2; ++ks) { \
            acc[0] = __builtin_amdgcn_mfma_f32_16x16x32_bf16(A_[0][ks], B_[ks], acc[0], 0, 0, 0); \
            acc[1] = __builtin_amdgcn_mfma_f32_16x16x32_bf16(A_[1][ks], B_[ks], acc[1], 0, 0, 0); } } while (0)
    AB_LOAD(0, A0, B0); AB_LOAD(1, A1, B1); AB_LOAD(2, A2, B2); AB_LOAD(3, A3, B3); AB_LOAD(4, A4, B4);
#pragma unroll 1
    for (int c = 0; c < 30; c += 5) {
        AB_STEP(c, A0, B0); AB_LOAD(c + 5, A0, B0);
        AB_STEP(c + 1, A1, B1); AB_LOAD(c + 6, A1, B1);
        AB_STEP(c + 2, A2, B2); AB_LOAD(c + 7, A2, B2);
        AB_STEP(c + 3, A3, B3); AB_LOAD(c + 8, A3, B3);
        AB_STEP(c + 4, A4, B4); AB_LOAD(c + 9, A4, B4);
    }
    AB_STEP(30, A0, B0); AB_STEP(31, A1, B1);
    if (!do_store) asm volatile("" :: "v"(acc[0]), "v"(acc[1]));
#undef AB_LOAD
#undef AB_STEP
}

__device__ __forceinline__ void nscan_task(unsigned char* ws, int t, int lane) {
    const int bh = t >> 2, d = (t & 3) * 64 + lane;
    const float* cs = (const float*)(ws + MS_NST) + (size_t)bh * 32 * 256 + d;
    float* nv = (float*)(ws + MS_NVEC) + (size_t)bh * 32 * 256 + d;
    const int decv = __builtin_bit_cast(int, ((const float*)(ws + MS_DEC))[bh * 32 + (lane & 31)]);
    float v[32];
#pragma unroll
    for (int j = 0; j < 32; ++j) v[j] = cs[j * 256];
    float n = 0.f;
#pragma unroll
    for (int j = 0; j < 32; ++j) { nv[j * 256] = n; n = __builtin_bit_cast(float, __builtin_amdgcn_readlane(decv, j)) * n + v[j]; }
}

__device__ __forceinline__ int rel_bucket_dev(int n) {
    if (n < 16) return n;
    int b = 16;
    b += (n >= 19); b += (n >= 21); b += (n >= 24); b += (n >= 27); b += (n >= 31); b += (n >= 35); b += (n >= 40); b += (n >= 46);
    b += (n >= 52); b += (n >= 59); b += (n >= 67); b += (n >= 77); b += (n >= 87); b += (n >= 99); b += (n >= 113);
    return b;
}
constexpr int AT_KT = 0, AT_VT = 34816, AT_TAB = 71680, AT_SEL = 72704, AT_TILES = 73216, AT_CTL = 73600, AT_KM = 73728;
__device__ __forceinline__ void attn_unit(ArgsP a, LAS unsigned char* lds, int uidx, int tid, int lane, int wave) {
    unsigned char* ws = a->ws;
    const int u256 = uidx & 255, second = uidx >> 8, bh = u256 >> 3, kk8 = u256 & 7, si = second ? 15 - kk8 : kk8, wgt = 16 - si;
    const int blk = (wgt - 1) >> 1, half = (wgt - 1) & 1, b = bh >> 3, h = bh & 7, q0 = blk * 256 + half * 128;
    const int q16 = lane & 15, g = lane >> 4;
    LAS float* tab = (LAS float*)(lds + AT_TAB); LAS unsigned* sels = (LAS unsigned*)(lds + AT_SEL); LAS int* tiles = (LAS int*)(lds + AT_TILES);
    LAS unsigned* ctl = (LAS unsigned*)(lds + AT_CTL); LAS float* kms = (LAS float*)(lds + AT_KM);
    const bf16* QA = (const bf16*)(ws + WS_QA); const bf16* KA = (const bf16*)(ws + WS_KA); const bf16* VAT = (const bf16*)(ws + WS_VAT);
    u32x4 sr[8], qst[4];
    const int row0 = tid >> 4, ch = tid & 15;
    const bf16* kbase = KA + (size_t)(b * SEQ + row0) * 1024 + h * 128 + ch * 8;
    const bf16* vbase = VAT + (size_t)(bh * 128 + row0) * 2048 + ch * 8;
#define AT_LOAD(ks0_) do { _Pragma("unroll") for (int i = 0; i < 4; ++i) { \
        sr[i] = *(const u32x4*)(kbase + (size_t)((ks0_) + 32 * i) * 1024); sr[4 + i] = *(const u32x4*)(vbase + (size_t)(32 * i) * 2048 + (ks0_)); } } while (0)
#pragma unroll
    for (int i = 0; i < 4; ++i) qst[i] = *(const u32x4*)(QA + (size_t)(b * SEQ + q0 + row0 + 32 * i) * 1024 + h * 128 + ch * 8);
    AT_LOAD(blk * 256);
    if (tid <= 128) tab[tid] = a->in[I_RELB][rel_bucket_dev(tid) * 8 + h] * 1.4426950408889634f;
    for (int idx = tid; idx < 1024; idx += NTHR) kms[idx] = ((const float*)(ws + MS_KMEAN))[bh * 1024 + idx];
    if (tid == 0) ctl[0] = 0u;
    __syncthreads();
    {
        const int q = tid >> 2, part = tid & 3;
        const bf16* qp = QA + (size_t)(b * SEQ + q0 + q) * 1024 + h * 128 + part * 32;
        float qf32[32];
#pragma unroll
        for (int i = 0; i < 4; ++i) { const u32x4 v = *(const u32x4*)(qp + 8 * i);
            qf32[8 * i + 0] = bflo(v.x); qf32[8 * i + 1] = bfhi(v.x); qf32[8 * i + 2] = bflo(v.y); qf32[8 * i + 3] = bfhi(v.y);
            qf32[8 * i + 4] = bflo(v.z); qf32[8 * i + 5] = bfhi(v.z); qf32[8 * i + 6] = bflo(v.w); qf32[8 * i + 7] = bfhi(v.w); }
        float gate[8];
#pragma unroll
        for (int n = 0; n < 8; ++n) { float s = 0.f;
            if (n < blk) {
#pragma unroll
                for (int d = 0; d < 32; d += 4) { const f32x4 kv = *(const LAS f32x4*)(kms + n * 128 + part * 32 + d);
                    s += (qf32[d] * kv.x + qf32[d + 1] * kv.y) + (qf32[d + 2] * kv.z + qf32[d + 3] * kv.w); }
            }
            s += __shfl_xor(s, 1); s += __shfl_xor(s, 2); gate[n] = s; }
        if (part == 0) {
            unsigned sel;
            if (blk <= 3) sel = (1u << blk) - 1u;
            else { sel = 0u;
#pragma unroll
                for (int it = 0; it < 3; ++it) { int best = 0; float bv = -3.0e38f;
#pragma unroll
                    for (int n = 0; n < 8; ++n) if (n < blk && !((sel >> n) & 1u) && gate[n] > bv) { bv = gate[n]; best = n; }
                    sel |= 1u << best; } }
            sels[q] = sel; atomicOr((unsigned*)ctl, sel);
        }
    }
    __syncthreads();
    if (tid == 0) { int nt = 0; const unsigned any = ctl[0];
        for (int j = 0; j < half + 1; ++j) tiles[nt++] = blk * 256 + 128 * j;
        for (int n = 0; n < blk; ++n) if ((any >> n) & 1u) for (int j = 0; j < 2; ++j) tiles[nt++] = n * 256 + 128 * j;
        ctl[1] = (unsigned)nt; }
    __syncthreads();
    const int ntiles = (int)ctl[1];
    const int qg = wave & 3, kp = wave >> 2;
    int qpos[2]; unsigned mysel[2];
#pragma unroll
    for (int f = 0; f < 2; ++f) { qpos[f] = q0 + 32 * qg + 16 * f + q16; mysel[f] = sels[32 * qg + 16 * f + q16]; }
    constexpr int AT_Q = 77824;
#pragma unroll
    for (int i = 0; i < 4; ++i) *(LAS u32x4*)(lds + AT_Q + (row0 + 32 * i) * 272 + ch * 16) = qst[i];
    const LAS unsigned char* qrow = lds + AT_Q + (32 * qg + q16) * 272 + 16 * g;
    float m_run[2] = {-1.0e30f, -1.0e30f}, l_run[2] = {0.f, 0.f};
    f32x4 oacc[2][8];
#pragma unroll
    for (int f = 0; f < 2; ++f)
#pragma unroll
        for (int m = 0; m < 8; ++m) oacc[f][m] = (f32x4){0.f, 0.f, 0.f, 0.f};
    const int vpos = (ch >> 2) * 32 + 16 * (ch & 1) + 4 * ((ch & 3) >> 1);
#define AT_WRITE() do { _Pragma("unroll") for (int i = 0; i < 4; ++i) { \
        *(LAS u32x4*)(lds + AT_KT + (row0 + 32 * i) * 272 + ch * 16) = sr[i]; \
        *(LAS u32x2*)(lds + AT_VT + (row0 + 32 * i) * 272 + vpos * 2) = (u32x2){sr[4 + i].x, sr[4 + i].y}; \
        *(LAS u32x2*)(lds + AT_VT + (row0 + 32 * i) * 272 + (vpos + 8) * 2) = (u32x2){sr[4 + i].z, sr[4 + i].w}; } } while (0)
    AT_WRITE();
    __syncthreads();
    if (ntiles > 1) { const int k1 = tiles[1]; AT_LOAD(k1); }
    for (int ti = 0; ti < ntiles; ++ti) {
        const int kstart = tiles[ti] + 64 * kp, nblk = kstart >> 8;
        const bool own = (nblk == blk);
        const bool any_ok = own ? true : (__any((((mysel[0] | mysel[1]) >> nblk) & 1u) != 0u) != 0);
        const bool active = own ? (kstart <= q0 + 32 * qg + 31) : any_ok;
        if (active) {
            const LAS unsigned char* kt = lds + AT_KT + 64 * kp * 272; const LAS unsigned char* vt = lds + AT_VT + 64 * kp * 2;
            f32x4 s[2][4];
#pragma unroll
            for (int n = 0; n < 4; ++n) { s[0][n] = (f32x4){0.f, 0.f, 0.f, 0.f}; s[1][n] = s[0][n]; }
#pragma unroll
            for (int ks = 0; ks < 4; ++ks) {
                bf16x8 q0f = *(const LAS bf16x8*)(qrow + 64 * ks), q1f = *(const LAS bf16x8*)(qrow + 16 * 272 + 64 * ks);
                bf16x8 kf[4];
#pragma unroll
                for (int n = 0; n < 4; ++n) kf[n] = *(const LAS bf16x8*)(kt + (16 * n + q16) * 272 + (32 * ks + 8 * g) * 2);
                asm volatile("" : "+v"(q0f), "+v"(q1f), "+v"(kf[0]), "+v"(kf[1]), "+v"(kf[2]), "+v"(kf[3]));
#pragma unroll
                for (int n = 0; n < 4; ++n) {
                    s[0][n] = __builtin_amdgcn_mfma_f32_16x16x32_bf16(kf[n], q0f, s[0][n], 0, 0, 0);
                    s[1][n] = __builtin_amdgcn_mfma_f32_16x16x32_bf16(kf[n], q1f, s[1][n], 0, 0, 0); } }
            const bool far = ((q0 + 32 * qg) - (kstart + 63)) >= 128;
            const float bfar = tab[128];
#pragma unroll
            for (int f = 0; f < 2; ++f) {
                const bool lane_ok = own ? true : (((mysel[f] >> nblk) & 1u) != 0u);
                float psum = 0.f, m_new;
#define AT_MNEW(mx_) fmaxf(((mx_) > m_run[f] + 8.0f) ? (mx_) : m_run[f], -1.0e29f)
                if (far) {
                    const float addc = lane_ok ? bfar : -1.0e30f;
                    float mx = -1.0e30f;
#pragma unroll
                    for (int n = 0; n < 4; ++n)
#pragma unroll
                        for (int r = 0; r < 4; ++r) mx = fmaxf(mx, s[f][n][r]);
                    mx = rows4_max(mx + addc);
                    m_new = AT_MNEW(mx);
                    const float cc = addc - m_new;
#pragma unroll
                    for (int n = 0; n < 4; ++n)
#pragma unroll
                        for (int r = 0; r < 4; ++r) { const float p = __builtin_amdgcn_exp2f(s[f][n][r] + cc); s[f][n][r] = p; psum += p; }
                } else {
                    const int kmax = lane_ok ? (own ? qpos[f] : 0x7fffffff) : -1;
                    float mx = -1.0e30f;
                    float bs[4][4];
#pragma unroll
                    for (int n = 0; n < 4; ++n)
#pragma unroll
                        for (int r = 0; r < 4; ++r) { int di = qpos[f] - (kstart + 16 * n + 4 * g + r); di = di < 0 ? 0 : di; di = di > 128 ? 128 : di; bs[n][r] = tab[di]; }
#pragma unroll
                    for (int n = 0; n < 4; ++n) asm volatile("" : "+v"(bs[n][0]), "+v"(bs[n][1]), "+v"(bs[n][2]), "+v"(bs[n][3]));
#pragma unroll
                    for (int n = 0; n < 4; ++n)
#pragma unroll
                        for (int r = 0; r < 4; ++r) { const int key = kstart + 16 * n + 4 * g + r;
                            const float v = (key <= kmax) ? s[f][n][r] + bs[n][r] : -1.0e30f;
                            s[f][n][r] = v; mx = fmaxf(mx, v); }
                    mx = rows4_max(mx);
                    m_new = AT_MNEW(mx);
#pragma unroll
                    for (int n = 0; n < 4; ++n)
#pragma unroll
                        for (int r = 0; r < 4; ++r) { const float p = __builtin_amdgcn_exp2f(s[f][n][r] - m_new); s[f][n][r] = p; psum += p; }
                }
#undef AT_MNEW
                const float alpha = __builtin_amdgcn_exp2f(m_run[f] - m_new);
                psum = rows4_sum(psum);
                l_run[f] = l_run[f] * alpha + psum;
                if (__any(m_new != m_run[f])) {
#pragma unroll
                    for (int m = 0; m < 8; ++m) oacc[f][m] = oacc[f][m] * alpha;
                }
                m_run[f] = m_new;
            }
#pragma unroll
            for (int k2 = 0; k2 < 2; ++k2) {
                bf16x8 pf[2];
#pragma unroll
                for (int f = 0; f < 2; ++f) { u32x4 pb; pb.x = cvt_pk_bf16(s[f][2 * k2][0], s[f][2 * k2][1]); pb.y = cvt_pk_bf16(s[f][2 * k2][2], s[f][2 * k2][3]);
                    pb.z = cvt_pk_bf16(s[f][2 * k2 + 1][0], s[f][2 * k2 + 1][1]); pb.w = cvt_pk_bf16(s[f][2 * k2 + 1][2], s[f][2 * k2 + 1][3]);
                    pf[f] = __builtin_bit_cast(bf16x8, pb); }
#pragma unroll
                for (int mh = 0; mh < 2; ++mh) {
                    bf16x8 af[4];
#pragma unroll
                    for (int m = 0; m < 4; ++m) af[m] = *(const LAS bf16x8*)(vt + (16 * (4 * mh + m) + q16) * 272 + (32 * k2 + 8 * g) * 2);
                    asm volatile("" : "+v"(af[0]), "+v"(af[1]), "+v"(af[2]), "+v"(af[3]));
#pragma unroll
                    for (int m = 0; m < 4; ++m) {
                        oacc[0][4 * mh + m] = __builtin_amdgcn_mfma_f32_16x16x32_bf16(af[m], pf[0], oacc[0][4 * mh + m], 0, 0, 0);
                        oacc[1][4 * mh + m] = __builtin_amdgcn_mfma_f32_16x16x32_bf16(af[m], pf[1], oacc[1][4 * mh + m], 0, 0, 0); } }
            }
        }
        __syncthreads();
        if (ti + 1 < ntiles) { AT_WRITE(); }
        __syncthreads();
        if (ti + 2 < ntiles) { const int kn = tiles[ti + 2]; AT_LOAD(kn); }
    }
    LAS float* mo = (LAS float*)lds; LAS float* ml = (LAS float*)(lds + 65536);
    if (kp == 1) {
#pragma unroll
        for (int f = 0; f < 2; ++f) {
#pragma unroll
            for (int m = 0; m < 8; ++m)
#pragma unroll
                for (int r = 0; r < 4; ++r) mo[((qg * 2 + f) * 8 + m) * 256 + r * 64 + lane] = oacc[f][m][r];
            ml[(qg * 2 + f) * 128 + lane] = m_run[f]; ml[(qg * 2 + f) * 128 + 64 + lane] = l_run[f]; }
    }
    __syncthreads();
    if (kp == 0) {
#pragma unroll
        for (int f = 0; f < 2; ++f) {
            const float m1 = ml[(qg * 2 + f) * 128 + lane], l1 = ml[(qg * 2 + f) * 128 + 64 + lane];
            const float mm = fmaxf(m_run[f], m1), a0 = __builtin_amdgcn_exp2f(m_run[f] - mm), a1 = __builtin_amdgcn_exp2f(m1 - mm);
            const float inv = __builtin_amdgcn_rcpf(l_run[f] * a0 + l1 * a1);
            bf16* HA = (bf16*)(ws + WS_HA) + (size_t)(b * SEQ + qpos[f]) * 1024 + h * 128 + 4 * g;
#pragma unroll
            for (int m = 0; m < 8; ++m) { float o[4];
#pragma unroll
                for (int r = 0; r < 4; ++r) o[r] = (oacc[f][m][r] * a0 + mo[((qg * 2 + f) * 8 + m) * 256 + r * 64 + lane] * a1) * inv;
                u32x2 w; w.x = cvt_pk_bf16(o[0], o[1]); w.y = cvt_pk_bf16(o[2], o[3]); *(u32x2*)(HA + 16 * m) = w; }
        }
    }
#undef AT_LOAD
#undef AT_WRITE
}

constexpr int MC_Q = 0, MC_K = 33792, MC_SP = 67584, MC_SC = 76800, MC_NV = 79104;
struct McRegs { u32x4 qr[4], kr[4]; float sc4[4]; float nv0; bf16x8 cb[8][2], vbf[2][2]; u32x2 ovv[8]; };
__device__ __forceinline__ void mc_load_qk(McRegs& R, const unsigned char* ws, int u, int tid) {
    const int bh = u >> 5, c = u & 31, b = bh >> 2, h = bh & 3; const size_t tok0 = (size_t)b * SEQ + 64 * c;
    const bf16* QM = (const bf16*)(ws + WS_QM); const bf16* KM = (const bf16*)(ws + WS_KM);
#pragma unroll
    for (int i = 0; i < 4; ++i) { const int idx = tid + NTHR * i, row = idx >> 5, ch = idx & 31;
        R.qr[i] = *(const u32x4*)(QM + (tok0 + row) * 1024 + h * 256 + ch * 8); R.kr[i] = *(const u32x4*)(KM + (tok0 + row) * 1024 + h * 256 + ch * 8); }
}
__device__ __forceinline__ void mc_load_sc(McRegs& R, const unsigned char* ws, int u, int tid) {
    const int bh = u >> 5, c = u & 31; const int s = bh * 2048 + 64 * c + (tid & 63);
    R.sc4[0] = ((const float*)(ws + MS_AS))[s]; R.sc4[1] = ((const float*)(ws + MS_GT))[s]; R.sc4[2] = ((const float*)(ws + MS_WI))[s]; R.sc4[3] = ((const float*)(ws + MS_CL))[s];
    R.nv0 = ((const float*)(ws + MS_NVEC))[(size_t)(bh * 32 + c) * 256 + (tid & 255)];
}
__device__ __forceinline__ void mc_load_cb(McRegs& R, const unsigned char* ws, int u, int lane, int wave) {
    const bf16* Cp = (const bf16*)(ws + WS_CST) + (size_t)u * 65536 + (size_t)(2 * wave) * 512 + lane * 8;
#pragma unroll
    for (int ks = 0; ks < 8; ++ks) { R.cb[ks][0] = *(const bf16x8*)(Cp + ks * 8192); R.cb[ks][1] = *(const bf16x8*)(Cp + ks * 8192 + 512); }
}
__device__ __forceinline__ void mc_load_v(McRegs& R, const unsigned char* ws, int u, int lane, int wave) {
    const bf16* Vp = (const bf16*)(ws + WS_VMT) + (size_t)u * 16384 + (size_t)(2 * wave) * 512 + lane * 8;
#pragma unroll
    for (int ks = 0; ks < 2; ++ks) { R.vbf[ks][0] = *(const bf16x8*)(Vp + ks * 8192); R.vbf[ks][1] = *(const bf16x8*)(Vp + ks * 8192 + 512); }
}
__device__ __forceinline__ void mc_load_ov(McRegs& R, const unsigned char* ws, int u, int lane, int wave) {
    const int bh = u >> 5, c = u & 31, b = bh >> 2, h = bh & 3; const size_t tok0 = (size_t)b * SEQ + 64 * c;
    const bf16* OM = (const bf16*)(ws + WS_OM);
#pragma unroll
    for (int i = 0; i < 8; ++i) R.ovv[i] = *(const u32x2*)(OM + (tok0 + 8 * wave + i) * 1024 + h * 256 + 4 * lane);
}
template <bool PF, bool HAVE>
__device__ __forceinline__ void mlstm_c_body(ArgsP a, int l, LAS unsigned char* lds, int u, int un, McRegs& R, int tid_, int lane_, int wave) {
    unsigned char* ws = a->ws;
    int tid = wave * 64 + lane_id(); asm volatile("" : "+v"(tid));
    const int lane = tid & 63; (void)tid_; (void)lane_;
    const int bh = u >> 5, c = u & 31, b = bh >> 2, h = bh & 3, t0 = 64 * c, q16 = lane & 15, g = lane >> 4;
    const size_t tok0 = (size_t)b * SEQ + t0;
    LAS unsigned char* Qs = lds + MC_Q; LAS unsigned char* Ks = lds + MC_K; LAS unsigned char* Sp = lds + MC_SP;
    LAS float* sc = (LAS float*)(lds + MC_SC); LAS float* as_ = sc; LAS float* gt_ = sc + 64; LAS float* wi_ = sc + 128; LAS float* cl_ = sc + 192; LAS float* qn_ = sc + 256; LAS float* denp = sc + 320;
    LAS float* nvec = (LAS float*)(lds + MC_NV);
    mc_load_qk(R, ws, u, tid); mc_load_sc(R, ws, u, tid);
    if (!HAVE) mc_load_cb(R, ws, u, lane, wave);
#pragma unroll
    for (int i = 0; i < 4; ++i) { const int idx = tid + NTHR * i, row = idx >> 5, ch = idx & 31;
        *(LAS u32x4*)(Qs + row * 528 + ch * 16) = R.qr[i]; *(LAS u32x4*)(Ks + row * 528 + ch * 16) = R.kr[i]; }
    mc_load_v(R, ws, u, lane, wave);
    if (tid < 64) { as_[tid] = R.sc4[0]; gt_[tid] = R.sc4[1]; wi_[tid] = R.sc4[2]; cl_[tid] = R.sc4[3]; }
    if (tid < 256) nvec[tid] = R.nv0;
    __syncthreads();
    f32x4 acc[4][2];
#pragma unroll
    for (int m = 0; m < 4; ++m) { acc[m][0] = (f32x4){0.f, 0.f, 0.f, 0.f}; acc[m][1] = acc[m][0]; }
    if (c > 0) {
#pragma unroll
        for (int ks = 0; ks < 8; ++ks) {
#pragma unroll
            for (int m = 0; m < 4; ++m) { const bf16x8 af = *(const LAS bf16x8*)(Qs + (16 * m + q16) * 528 + (32 * ks + 8 * g) * 2);
                acc[m][0] = __builtin_amdgcn_mfma_f32_16x16x32_bf16(af, R.cb[ks][0], acc[m][0], 0, 0, 0);
                acc[m][1] = __builtin_amdgcn_mfma_f32_16x16x32_bf16(af, R.cb[ks][1], acc[m][1], 0, 0, 0); }
        }
#pragma unroll
        for (int m = 0; m < 4; ++m)
#pragma unroll
            for (int r = 0; r < 4; ++r) { const float w = wi_[16 * m + 4 * g + r]; acc[m][0][r] *= w; acc[m][1][r] *= w; }
    }
    {
        const int mS = wave & 3, nS0 = 2 * (wave >> 2);
        f32x4 sacc[2]; sacc[0] = (f32x4){0.f, 0.f, 0.f, 0.f}; sacc[1] = sacc[0];
#pragma unroll
        for (int kh = 0; kh < 4; ++kh) {
            bf16x8 af[2], bq[2][2];
#pragma unroll
            for (int k2 = 0; k2 < 2; ++k2) { const int ks = 2 * kh + k2;
                af[k2] = *(const LAS bf16x8*)(Qs + (16 * mS + q16) * 528 + (32 * ks + 8 * g) * 2);
#pragma unroll
                for (int nn = 0; nn < 2; ++nn) bq[k2][nn] = *(const LAS bf16x8*)(Ks + (16 * (nS0 + nn) + q16) * 528 + (32 * ks + 8 * g) * 2); }
            asm volatile("" : "+v"(af[0]), "+v"(af[1]), "+v"(bq[0][0]), "+v"(bq[0][1]), "+v"(bq[1][0]), "+v"(bq[1][1]));
#pragma unroll
            for (int k2 = 0; k2 < 2; ++k2)
#pragma unroll
                for (int nn = 0; nn < 2; ++nn) sacc[nn] = __builtin_amdgcn_mfma_f32_16x16x32_bf16(af[k2], bq[k2][nn], sacc[nn], 0, 0, 0);
        }
#pragma unroll
        for (int nn = 0; nn < 2; ++nn) { const int s = 16 * (nS0 + nn) + q16; const float av = as_[s];
#pragma unroll
            for (int r = 0; r < 4; ++r) { const int t = 16 * mS + 4 * g + r;
                float val = (s <= t) ? sacc[nn][r] * __expf(av - gt_[t]) : 0.f;
                *(LAS unsigned short*)(Sp + t * 144 + s * 2) = (unsigned short)(cvt_pk_bf16(val, val) & 0xffffu);
                val += __shfl_xor(val, 1); val += __shfl_xor(val, 2); val += __shfl_xor(val, 4); val += __shfl_xor(val, 8);
                if (q16 == 0) denp[(nS0 + nn) * 64 + t] = val; } }
    }
    {
        const int t = tid >> 3, seg = tid & 7; float s = 0.f;
#pragma unroll
        for (int i = 0; i < 4; ++i) { const u32x4 v = *(const LAS u32x4*)(Qs + t * 528 + (seg * 32 + 8 * i) * 2); const LAS float* nv = nvec + seg * 32 + 8 * i;
            s += bflo(v.x) * nv[0] + bfhi(v.x) * nv[1] + bflo(v.y) * nv[2] + bfhi(v.y) * nv[3] + bflo(v.z) * nv[4] + bfhi(v.z) * nv[5] + bflo(v.w) * nv[6] + bfhi(v.w) * nv[7]; }
        s += __shfl_xor(s, 1); s += __shfl_xor(s, 2); s += __shfl_xor(s, 4);
        if (seg == 0) qn_[t] = s;
    }
    __syncthreads();
    if (PF) {
#pragma unroll
        for (int ks = 0; ks < 8; ++ks) asm volatile("" :: "v"(R.cb[ks][0]), "v"(R.cb[ks][1]));
        __builtin_amdgcn_sched_barrier(0);
        mc_load_cb(R, ws, un, lane, wave);
        __builtin_amdgcn_sched_barrier(0);
    }
    {
#pragma unroll
        for (int ks = 0; ks < 2; ++ks) {
            bf16x8 sf[4];
#pragma unroll
            for (int m = 0; m < 4; ++m) sf[m] = *(const LAS bf16x8*)(Sp + (16 * m + q16) * 144 + (32 * ks + 8 * g) * 2);
            asm volatile("" : "+v"(sf[0]), "+v"(sf[1]), "+v"(sf[2]), "+v"(sf[3]));
#pragma unroll
            for (int m = 0; m < 4; ++m) {
                acc[m][0] = __builtin_amdgcn_mfma_f32_16x16x32_bf16(sf[m], R.vbf[ks][0], acc[m][0], 0, 0, 0);
                acc[m][1] = __builtin_amdgcn_mfma_f32_16x16x32_bf16(sf[m], R.vbf[ks][1], acc[m][1], 0, 0, 0); }
        }
    }
    LAS float* NUM = (LAS float*)lds;
#pragma unroll
    for (int m = 0; m < 4; ++m)
#pragma unroll
        for (int r = 0; r < 4; ++r) { const int t = 16 * m + 4 * g + r;
            const float den = (denp[t] + denp[64 + t]) + (denp[128 + t] + denp[192 + t]) + wi_[t] * qn_[t];
            const float inv = __builtin_amdgcn_rcpf(fmaxf(fabsf(den), cl_[t]));
            NUM[t * 260 + 32 * wave + q16] = acc[m][0][r] * inv; NUM[t * 260 + 32 * wave + 16 + q16] = acc[m][1][r] * inv; }
    __syncthreads();
    {
        const float* mg = a->in[I_MNG] + l * 1024 + h * 256 + 4 * lane; const f32x4 gn = *(const f32x4*)mg;
        bf16* HM = (bf16*)(ws + WS_HM);
        mc_load_ov(R, ws, u, lane, wave);
        asm volatile("" : "+v"(R.ovv[0]), "+v"(R.ovv[1]), "+v"(R.ovv[2]), "+v"(R.ovv[3]), "+v"(R.ovv[4]), "+v"(R.ovv[5]), "+v"(R.ovv[6]), "+v"(R.ovv[7]));
#pragma unroll
        for (int i = 0; i < 8; ++i) { const int t = 8 * wave + i;
            const f32x4 v = *(const LAS f32x4*)(NUM + t * 260 + 4 * lane);
            const float mu = wave_sum((v.x + v.y) + (v.z + v.w)) * (1.0f / 256.0f);
            const f32x4 d = v - mu;
            const float var = wave_sum((d.x * d.x + d.y * d.y) + (d.z * d.z + d.w * d.w)) * (1.0f / 256.0f);
            const float rstd = __builtin_amdgcn_rsqf(var + LN_EPS);
            const u32x2 ov = R.ovv[i];
            u32x2 w; w.x = cvt_pk_bf16(d.x * rstd * gn.x * bflo(ov.x), d.y * rstd * gn.y * bfhi(ov.x)); w.y = cvt_pk_bf16(d.z * rstd * gn.z * bflo(ov.y), d.w * rstd * gn.w * bfhi(ov.y));
            *(u32x2*)(HM + (tok0 + t) * 1024 + h * 256 + 4 * lane) = w; }
    }
    __syncthreads();
}
__device__ __forceinline__ void mlstm_c_phase(ArgsP a, int l, LAS unsigned char* lds, int tid, int lane, int wave, int bid, int G) {
    int u = bid; if (u >= 512) return;
    McRegs R;
    if (u + G < 512 && u + 2 * G >= 512) {
        mlstm_c_body<true, false>(a, l, lds, u, u + G, R, tid, lane, wave);
        mlstm_c_body<false, true>(a, l, lds, u + G, u + G, R, tid, lane, wave);
    } else {
#pragma unroll 1
        for (; u < 512; u += G) mlstm_c_body<false, false>(a, l, lds, u, u, R, tid, lane, wave);
    }
}

struct SchedStd {
    static constexpr bool GATHER = false;
    const char* A; const char* B; int nM, nN, K, G, c;
    __device__ __forceinline__ bool next(int i, Unit& u) const { const int L = i * G + c; if (L >= nM * nN) return false; pg8::static_tile(L, nM, nN, u.pm, u.pn); u.aux = 0; return true; }
    __device__ __forceinline__ const char* abase(const Unit& u) const { return A + (size_t)u.pm * 512 * K; }
    __device__ __forceinline__ const char* bbase(const Unit& u) const { return B + (size_t)u.pn * 512 * K; }
    __device__ __forceinline__ unsigned arow(const Unit&, int) const { return 0u; }
    static __device__ __forceinline__ bool keep_acc(const Unit&) { return false; }
};
struct SchedBr {
    static constexpr bool GATHER = false;
    const char* HM; const char* HA; const char* WM; const char* WA; int G, c;
    __device__ __forceinline__ bool next(int i, Unit& u) const { const int L = (i >> 1) * G + c; if (L >= 256) return false; pg8::static_tile(L, 32, 8, u.pm, u.pn); u.aux = i & 1; return true; }
    __device__ __forceinline__ const char* abase(const Unit& u) const { return (u.aux ? HA : HM) + (size_t)u.pm * 512 * 1024; }
    __device__ __forceinline__ const char* bbase(const Unit& u) const { return (u.aux ? WA : WM) + (size_t)u.pn * 512 * 1024; }
    __device__ __forceinline__ unsigned arow(const Unit&, int) const { return 0u; }
    static __device__ __forceinline__ bool keep_acc(const Unit& u) { return u.aux == 0; }
};
struct EpiBr {
    static constexpr bool PERM = true;
    const bf16* SG; bf16* Y;
    __device__ __forceinline__ void operator()(f32x4 (&acc)[2][2][4][2], const Unit& u, int wr, int wc, int fr, int fq) const {
        const int row0 = u.pm * 256 + wr * 64 + fr, col0 = u.pn * 256 + wc * 32 + 8 * fq;
#pragma unroll
        for (int ai = 0; ai < 2; ++ai) {
            u32x4 sa[4][2], sm[4][2];
#pragma unroll
            for (int m = 0; m < 4; ++m) { const size_t row = row0 + ai * 128 + m * 16;
#pragma unroll
                for (int bj = 0; bj < 2; ++bj) { const int col = col0 + bj * 128;
                    sa[m][bj] = *(const u32x4*)(SG + row * 4096 + 2048 + col);
                    sm[m][bj] = *(const u32x4*)(SG + row * 4096 + (u.aux == 0 ? 0 : 2048) + col); } }
            asm volatile("" : "+v"(sa[0][0]), "+v"(sa[0][1]), "+v"(sa[1][0]), "+v"(sa[1][1]), "+v"(sa[2][0]), "+v"(sa[2][1]), "+v"(sa[3][0]), "+v"(sa[3][1]),
                              "+v"(sm[0][0]), "+v"(sm[0][1]), "+v"(sm[1][0]), "+v"(sm[1][1]), "+v"(sm[2][0]), "+v"(sm[2][1]), "+v"(sm[3][0]), "+v"(sm[3][1]));
#pragma unroll
            for (int m = 0; m < 4; ++m) { const size_t row = row0 + ai * 128 + m * 16;
#pragma unroll
                for (int bj = 0; bj < 2; ++bj) { const int col = col0 + bj * 128;
                    const u32x4 a4 = sa[m][bj], m4 = sm[m][bj];
                    const float ga[8] = {bflo(a4.x), bfhi(a4.x), bflo(a4.y), bfhi(a4.y), bflo(a4.z), bfhi(a4.z), bflo(a4.w), bfhi(a4.w)};
                    if (u.aux == 0) {
                        const float gm[8] = {bflo(m4.x), bfhi(m4.x), bflo(m4.y), bfhi(m4.y), bflo(m4.z), bfhi(m4.z), bflo(m4.w), bfhi(m4.w)};
#pragma unroll
                        for (int j = 0; j < 4; ++j) { acc[ai][bj][m][0][j] *= gm[j] * __builtin_amdgcn_rcpf(fmaxf(ga[j], 1.0e-30f)); acc[ai][bj][m][1][j] *= gm[4 + j] * __builtin_amdgcn_rcpf(fmaxf(ga[4 + j], 1.0e-30f)); }
                    } else {
                        const f32x4 v0 = acc[ai][bj][m][0], v1 = acc[ai][bj][m][1];
                        u32x4 w; w.x = cvt_pk_bf16(v0[0] * ga[0], v0[1] * ga[1]); w.y = cvt_pk_bf16(v0[2] * ga[2], v0[3] * ga[3]);
                        w.z = cvt_pk_bf16(v1[0] * ga[4], v1[1] * ga[5]); w.w = cvt_pk_bf16(v1[2] * ga[6], v1[3] * ga[7]);
                        *(u32x4*)(Y + row * 2048 + col) = w; }
                } }
        }
    }
};
struct EpiOut {
    static constexpr bool PERM = false;
    const float* res; float* out;
    __device__ __forceinline__ void operator()(f32x4 (&acc)[2][2][4][2], const Unit& u, int wr, int wc, int fr, int fq) const {
        const int row0 = u.pm * 256 + wr * 64 + fr, col0 = u.pn * 256 + wc * 32 + 4 * fq;
#pragma unroll
        for (int ai = 0; ai < 2; ++ai) {
            f32x4 rv[4][2][2];
#pragma unroll
            for (int m = 0; m < 4; ++m) { const size_t ro = (size_t)(row0 + ai * 128 + m * 16) * DM + col0;
#pragma unroll
                for (int bj = 0; bj < 2; ++bj)
#pragma unroll
                    for (int n = 0; n < 2; ++n) rv[m][bj][n] = *(const f32x4*)(res + ro + bj * 128 + n * 16); }
#pragma unroll
            for (int m = 0; m < 4; ++m) asm volatile("" : "+v"(rv[m][0][0]), "+v"(rv[m][0][1]), "+v"(rv[m][1][0]), "+v"(rv[m][1][1]));
#pragma unroll
            for (int m = 0; m < 4; ++m) { const size_t ro = (size_t)(row0 + ai * 128 + m * 16) * DM + col0;
#pragma unroll
                for (int bj = 0; bj < 2; ++bj)
#pragma unroll
                    for (int n = 0; n < 2; ++n) *(f32x4*)(out + ro + bj * 128 + n * 16) = rv[m][bj][n] + acc[ai][bj][m][n]; }
        }
    }
};
struct SchedMoe1 {
    static constexpr bool GATHER = true;
    const char* H; const char* W13; const int* LIST; const LAS int* te; const LAS int* tr0; const LAS int* cnt; int MT, G, c;
    __device__ __forceinline__ bool next(int i, Unit& u) const { const int L = i * G + c; if (L >= 2 * MT) return false; u.pm = L >> 1; u.pn = L & 1; u.aux = __builtin_amdgcn_readfirstlane(te[u.pm]); return true; }
    __device__ __forceinline__ const char* abase(const Unit&) const { return H; }
    __device__ __forceinline__ const char* bbase(const Unit& u) const { return W13 + ((size_t)u.aux * 512 + u.pn * 256) * 4096; }
    static __device__ __forceinline__ bool keep_acc(const Unit&) { return false; }
    __device__ __forceinline__ unsigned arow(const Unit& u, int r) const { const int rr = __builtin_amdgcn_readfirstlane(tr0[u.pm]) + r; return rr < __builtin_amdgcn_readfirstlane(cnt[u.aux]) ? (unsigned)LIST[u.aux * 8192 + rr] : 0u; }
};
struct EpiMoe1 {
    static constexpr bool PERM = true;
    bf16* HID; const float* PWL; const LAS int* tr0; const LAS int* cnt;
    __device__ __forceinline__ void operator()(f32x4 (&acc)[2][2][4][2], const Unit& u, int wr, int wc, int fr, int fq) const {
#pragma unroll
        for (int ai = 0; ai < 2; ++ai)
#pragma unroll
            for (int m = 0; m < 4; ++m) { const int r = ai * 128 + wr * 64 + m * 16 + fr;
                const float pw = 1.0f;
                float o[8];
#pragma unroll
                for (int n = 0; n < 2; ++n)
#pragma unroll
                    for (int j = 0; j < 4; ++j) { const float x1 = acc[ai][0][m][n][j], x3 = acc[ai][1][m][n][j]; o[4 * n + j] = x1 * sigmoidf_(x1) * x3 * pw; }
                u32x4 w; w.x = cvt_pk_bf16(o[0], o[1]); w.y = cvt_pk_bf16(o[2], o[3]); w.z = cvt_pk_bf16(o[4], o[5]); w.w = cvt_pk_bf16(o[6], o[7]);
                *(u32x4*)(HID + (size_t)(u.pm * 256 + r) * 256 + u.pn * 128 + wc * 32 + 8 * fq) = w; }
    }
};
struct SchedMoe2 {
    static constexpr bool GATHER = false;
    const char* HID; const char* W2; const LAS int* te; int MT, G, c;
    __device__ __forceinline__ bool next(int i, Unit& u) const { const int L = i * G + c; if (L >= 8 * MT) return false; u.pm = L >> 3; u.pn = L & 7; u.aux = __builtin_amdgcn_readfirstlane(te[u.pm]); return true; }
    __device__ __forceinline__ const char* abase(const Unit& u) const { return HID + (size_t)u.pm * 256 * 512; }
    __device__ __forceinline__ const char* bbase(const Unit& u) const { return W2 + ((size_t)u.aux * 2048 + u.pn * 256) * 512; }
    __device__ __forceinline__ unsigned arow(const Unit&, int) const { return 0u; }
    static __device__ __forceinline__ bool keep_acc(const Unit&) { return false; }
};
struct EpiMoe2 {
    static constexpr bool PERM = true;
    bf16* OP;
    __device__ __forceinline__ void operator()(f32x4 (&acc)[2][2][4][2], const Unit& u, int wr, int wc, int fr, int fq) const {
        const int row0 = u.pm * 256 + wr * 64 + fr, col0 = u.pn * 256 + wc * 32 + 8 * fq;
#pragma unroll
        for (int ai = 0; ai < 2; ++ai)
#pragma unroll
            for (int m = 0; m < 4; ++m) { bf16* rowp = OP + (size_t)(row0 + ai * 128 + m * 16) * DM + col0;
#pragma unroll
                for (int bj = 0; bj < 2; ++bj) { const f32x4 v0 = acc[ai][bj][m][0], v1 = acc[ai][bj][m][1];
                    u32x4 w; w.x = cvt_pk_bf16(v0[0], v0[1]); w.y = cvt_pk_bf16(v0[2], v0[3]); w.z = cvt_pk_bf16(v1[0], v1[1]); w.w = cvt_pk_bf16(v1[2], v1[3]);
                    *(u32x4*)(rowp + bj * 128) = w; } }
    }
};

constexpr int N_PHASES = 22;
__global__ void __launch_bounds__(NTHR, 2) fwd_kernel(Args a) {
    extern __shared__ __attribute__((aligned(16))) unsigned char lds_raw[];
    LAS unsigned char* lds0 = (LAS unsigned char*)lds_raw;
    const int tid0 = threadIdx.x, bid0 = blockIdx.x, G0 = gridDim.x;
    const int wave0 = __builtin_amdgcn_readfirstlane(tid0 >> 6);
#define PH_IDS() ArgsP ap = (ArgsP)__builtin_amdgcn_kernarg_segment_ptr(); asm volatile("" : "+s"(ap)); unsigned lb_ = 0u; asm volatile("" : "+s"(lb_)); LAS unsigned char* lds = lds0 + lb_; LAS unsigned char* misc = lds + MISC_OFF; (void)misc; unsigned char* ws = ap->ws; (void)ws; int bid = bid0, G = G0, wave = wave0; asm volatile("" : "+s"(bid), "+s"(G), "+s"(wave)); int tid = wave * 64 + lane_id(); asm volatile("" : "+v"(tid)); const int lane = tid & 63; (void)lane; (void)wave
    if (tid0 < 4) ((LAS unsigned*)(lds0 + MISC_OFF + MO_BAR))[tid0] = 0u;
    __syncthreads();
#if MK_LAUNCHES == 1
    XcdBarrier bar = xcd_barrier_post((unsigned*)(a.ws + WS_CTL) + CW_BAR, (volatile LAS unsigned*)(lds0 + MISC_OFF + MO_BAR));
#define GRID_BAR() xcd_barrier(bar)
#else
#define GRID_BAR() do { } while (0)
#endif
    const int lo = a.ph_lo, hi = a.ph_hi;
#ifndef PHMASK
#define PHMASK 0xFFFu
#endif
#define IN(k) (lo <= (k) && (k) < hi)
#define EN(b) ((PHMASK >> (b)) & 1u)
#ifndef DBLMASK
#define DBLMASK 0u
#endif
#define REP(b) _Pragma("unroll 1") for (int rep_ = 0; rep_ < (((DBLMASK >> (b)) & 1u) ? 2 : 1); ++rep_)
#define SEAM(k) do { if (IN(k) && IN((k) + 1)) { GRID_BAR(); if ((DBLMASK >> 12) & 1u) GRID_BAR(); } } while (0)

    if (EN(0) && IN(0)) { REP(0) { PH_IDS(); prologue_phase(ap, lds, tid, lane, wave, bid, G); __syncthreads(); }
#ifndef NO_NORM0
        { PH_IDS(); norm_phase<0>(ap, 0, lds, tid, lane, wave, bid, G); }
#endif
    }
    SEAM(0);
#pragma unroll 1
    for (int l = 0; l < 2; ++l) {
        const int pb = 1 + 10 * l;
        if (EN(1) && IN(pb + 0) && l == 1) { if ((DBLMASK >> 18) & 1u) { PH_IDS(); norm_phase<1>(ap, l, lds, tid, lane, wave, bid, G, true); } PH_IDS(); norm_phase<1>(ap, l, lds, tid, lane, wave, bid, G); }
        if (l == 1) SEAM(pb + 0);
        if (EN(2) && IN(pb + 1)) REP(2) { PH_IDS(); (void)tid;
#ifdef STAG
            for (int i = 0; i < ((bid >> 3) & 7); ++i) __builtin_amdgcn_s_sleep(STAG);
#endif
            SchedG1 S{(const char*)(ws + WS_H), (const char*)(ws + WS_WINT) + (size_t)l * 11264 * 4096, G, bid};
            EpiG1 E{ws, ((DBLMASK >> 21) & 1u) && rep_ == 1};
            pg8::gemm_phase<EpiG1, SchedG1>(lds, 2048, S, E, wave);
            for (int bh = G - 1 - bid; bh < 16; bh += G) gate_unit(ap, l, lds, bh, tid, tid & 63, wave);
            __syncthreads();
            if (G == 256 && bid >= 256 - SchedG1::NCV) prologue_phase(ap, lds, tid, tid & 63, wave, bid - (256 - SchedG1::NCV), SchedG1::NCV, 2 + l);
            else if (G != 256) prologue_phase(ap, lds, tid, tid & 63, wave, bid, G, 2 + l);
        }
        SEAM(pb + 1);
        if (EN(3) && IN(pb + 2)) REP(3) { PH_IDS(); conv_phase(ap, l, lds, tid, lane, wave, bid, G); }
        SEAM(pb + 2);
        if (EN(4) && IN(pb + 3)) REP(4) { PH_IDS();
            const int vb = (G % 8 == 0) ? (bid & 7) * (G >> 3) + (bid >> 3) : bid;
            REP(13) { for (int gw = vb * NWAVES + wave; gw < 2048; gw += G * NWAVES) mlstm_ab_task(ws, gw, lane, rep_ == 0 || !((DBLMASK >> 15) & 1u)); }
            if (wave == 0 && vb < 64) nscan_task(ws, vb, lane);
            __syncthreads();
            REP(14) { for (int u = vb; u < 512; u += G) { attn_unit(ap, lds, u, tid, lane, wave); __syncthreads(); if (((DBLMASK >> 16) & 1u) && u < 256) GRID_BAR(); } }
        }
        SEAM(pb + 3);
        if (EN(5) && IN(pb + 4)) REP(5) { PH_IDS(); mlstm_c_phase(ap, l, lds, tid, lane, wave, bid, G); }
        SEAM(pb + 4);
        if (EN(6) && IN(pb + 5)) REP(6) { PH_IDS(); (void)tid;
            SchedBr S{(const char*)(ws + WS_HM), (const char*)(ws + WS_HA), (const char*)(ws + WS_WBM) + (size_t)l * 2048 * 2048, (const char*)(ws + WS_WBA) + (size_t)l * 2048 * 2048, G, bid};
            EpiBr E{(const bf16*)(ws + WS_SG), (bf16*)(ws + WS_Y)};
            pg8::gemm_phase<EpiBr, SchedBr>(lds, 1024, S, E, wave);
        }
        SEAM(pb + 5);
        if (EN(7) && IN(pb + 6)) _Pragma("unroll 1") for (int rep_ = 0; rep_ < ((((DBLMASK >> 7) & 1u) && l == 0) ? 2 : 1); ++rep_) { PH_IDS(); (void)tid;
            SchedStd S{(const char*)(ws + WS_Y), (const char*)(ws + WS_WOUT) + (size_t)l * 2048 * 4096, 32, 8, 2048, G, bid};
            EpiOut E{l == 0 ? ap->in[I_X] : (const float*)ap->out, ap->out};
            pg8::gemm_phase<EpiOut, SchedStd>(lds, 2048, S, E, wave);
        }
        SEAM(pb + 6);
        if (EN(8) && IN(pb + 7)) { if ((DBLMASK >> 19) & 1u) { PH_IDS(); norm_phase<2>(ap, l, lds, tid, lane, wave, bid, G, true); } PH_IDS(); norm_phase<2>(ap, l, lds, tid, lane, wave, bid, G); }
        SEAM(pb + 7);
        if (EN(9) && IN(pb + 8)) REP(9) { PH_IDS();
            moe_tables(ws, l, misc, tid);
            SchedMoe1 S{(const char*)(ws + WS_H), (const char*)(ws + WS_W13) + (size_t)l * 32 * 512 * 4096, (const int*)(ws + MS_LIST),
                        (const LAS int*)(misc + MO_TE), (const LAS int*)(misc + MO_TR0), (const LAS int*)(misc + MO_CNT), __builtin_amdgcn_readfirstlane(((const LAS int*)(misc + MO_MT))[0]), G, bid};
            EpiMoe1 E{(bf16*)(ws + WS_HID), (const float*)(ws + MS_PWL), (const LAS int*)(misc + MO_TR0), (const LAS int*)(misc + MO_CNT)};
            pg8::gemm_phase<EpiMoe1, SchedMoe1>(lds, 2048, S, E, wave);
            if (bid >= 2 * S.MT) prologue_phase(ap, lds, tid, tid & 63, wave, bid - 2 * S.MT, G - 2 * S.MT, l == 0 ? 1 : 4);
        }
        SEAM(pb + 8);
        if (EN(10) && IN(pb + 9)) REP(10) { PH_IDS();
            moe_tables(ws, l, misc, tid);
#ifdef STAG
            for (int i = 0; i < ((bid >> 3) & 7); ++i) __builtin_amdgcn_s_sleep(STAG);
#endif
            SchedMoe2 S{(const char*)(ws + WS_HID), (const char*)(ws + WS_W2) + (size_t)l * 32 * 2048 * 512, (const LAS int*)(misc + MO_TE), __builtin_amdgcn_readfirstlane(((const LAS int*)(misc + MO_MT))[0]), G, bid};
            EpiMoe2 E{(bf16*)(ws + WS_OP)};
            pg8::gemm_phase<EpiMoe2, SchedMoe2>(lds, 256, S, E, wave);
        }
        SEAM(pb + 9);
    }
    if (EN(11) && IN(21)) { if ((DBLMASK >> 20) & 1u) { PH_IDS(); norm_phase<3>(ap, 1, lds, tid, lane, wave, bid, G, true); } PH_IDS(); norm_phase<3>(ap, 1, lds, tid, lane, wave, bid, G); }
#undef IN
#undef SEAM
}

extern "C" void kernel_launch(void* const* d_in, const int* in_sizes, int n_in, void* d_out, int out_size, void* d_ws, size_t ws_size, hipStream_t stream) {
    static int grid = 0;
    if (grid == 0) {
        if (n_in != 19 || out_size != NTOK * DM || ws_size < WS_END) { fprintf(stderr, "kernel_launch: unexpected shapes (n_in %d out %d ws %zu)\n", n_in, out_size, ws_size); grid = -1; return; }
        int dev = 0, cus = 0, per_cu = 0;
        if (hipGetDevice(&dev) != hipSuccess || hipDeviceGetAttribute(&cus, hipDeviceAttributeMultiprocessorCount, dev) != hipSuccess) { grid = -1; return; }
        if (hipFuncSetAttribute((const void*)fwd_kernel, hipFuncAttributeMaxDynamicSharedMemorySize, LDS_BYTES) != hipSuccess) { fprintf(stderr, "kernel_launch: hipFuncSetAttribute failed\n"); grid = -1; return; }
        if (hipOccupancyMaxActiveBlocksPerMultiprocessor(&per_cu, (const void*)fwd_kernel, NTHR, LDS_BYTES) != hipSuccess || per_cu < 1) { fprintf(stderr, "kernel_launch: occupancy query says %d\n", per_cu); }
        (void)hipGetLastError();
        grid = cus;
        if (grid > 256) grid = 256;
    }
    if (grid < 0) return;
    if (hipMemsetAsync((char*)d_ws + WS_CTL, 0, CTL_ZERO_BYTES, stream) != hipSuccess) return;
    Args a{};
    for (int i = 0; i < 19; ++i) a.in[i] = (const float*)d_in[i];
    a.out = (float*)d_out; a.ws = (unsigned char*)d_ws;
#if MK_LAUNCHES == 1
    a.ph_lo = 0; a.ph_hi = N_PHASES;
    hipLaunchKernelGGL(fwd_kernel, dim3(grid), dim3(NTHR), LDS_BYTES, stream, a);
#else
    for (int p = 0; p < N_PHASES; ++p) { a.ph_lo = p; a.ph_hi = p + 1; hipLaunchKernelGGL(fwd_kernel, dim3(grid), dim3(NTHR), LDS_BYTES, stream, a); }
#endif
}
```

```cpp
#define DBLMASK 0u
#include <hip/hip_runtime.h>
#include <stdint.h>
#include <stdio.h>

#ifndef MK_LAUNCHES
#define MK_LAUNCHES 1
#endif

#define GAS __attribute__((address_space(1)))
#define LAS __attribute__((address_space(3)))
typedef unsigned short bf16;
typedef short bf16x8 __attribute__((ext_vector_type(8)));
typedef short bf16x4 __attribute__((ext_vector_type(4)));
typedef float f32x4 __attribute__((ext_vector_type(4)));
typedef unsigned u32x4 __attribute__((ext_vector_type(4)));
typedef unsigned u32x2 __attribute__((ext_vector_type(2)));

constexpr int NTOK = 8192, DM = 2048, SEQ = 2048, NBATCH = 4;
constexpr int INCOLS = 11272;
constexpr int NWAVES = 8, NTHR = 512;
constexpr float RMS_EPS = 1e-6f, LN_EPS = 1e-5f;
constexpr int MPAD = 24576;

constexpr size_t MiB = 1u << 20;
constexpr size_t WS_CTL = 0, CTL_ZERO_BYTES = 1 * MiB;
constexpr size_t WS_MISC = 1 * MiB;
constexpr size_t MS_WIF = WS_MISC + 0;
constexpr size_t MS_WRT = WS_MISC + 256 * 1024;
constexpr size_t MS_IFG = WS_MISC + 1 * MiB;
constexpr size_t MS_KMEAN = MS_IFG + 256 * 1024;
constexpr size_t MS_AS = WS_MISC + 1536 * 1024;
constexpr size_t MS_GT = MS_AS + 128 * 1024;
constexpr size_t MS_WI = MS_GT + 128 * 1024;
constexpr size_t MS_CL = MS_WI + 128 * 1024;
constexpr size_t MS_WS = MS_CL + 128 * 1024;
constexpr size_t MS_DEC = MS_WS + 128 * 1024;
constexpr size_t MS_NST = WS_MISC + 2560 * 1024;
constexpr size_t MS_TOKE = WS_MISC + 3 * MiB;
constexpr size_t MS_TOKP = MS_TOKE + 64 * 1024;
constexpr size_t MS_TOKW = MS_TOKE + 128 * 1024;
constexpr size_t MS_LIST = WS_MISC + 4 * MiB;
constexpr size_t MS_PWL = WS_MISC + 5 * MiB;
constexpr size_t MS_NVEC = WS_MISC + 6 * MiB;
constexpr size_t WS_WINT = 16 * MiB;
constexpr size_t WS_WBM = 104 * MiB;
constexpr size_t WS_WBA = 112 * MiB;
constexpr size_t WS_WOUT = 120 * MiB;
constexpr size_t WS_W13 = 136 * MiB;
constexpr size_t WS_W2 = 264 * MiB;
constexpr size_t WS_H = 328 * MiB;
constexpr size_t WS_R = 360 * MiB;
constexpr size_t WS_ZQK = WS_R;
constexpr size_t WS_HM = WS_R, WS_HA = WS_R + 16 * MiB;
constexpr size_t WS_VMT = WS_R + 32 * MiB;
constexpr size_t WS_OM = WS_R + 48 * MiB;
constexpr size_t WS_QA = WS_R + 64 * MiB, WS_KA = WS_R + 80 * MiB;
constexpr size_t WS_Y = WS_QA;
constexpr size_t WS_VAT = WS_R + 96 * MiB;
constexpr size_t WS_SG = WS_R + 112 * MiB;
constexpr size_t WS_QM = WS_R + 176 * MiB, WS_KM = WS_R + 192 * MiB, WS_KMT = WS_R + 208 * MiB;
constexpr size_t WS_CST = WS_R + 224 * MiB;
constexpr size_t WS_HID = WS_R;
constexpr size_t WS_OP = WS_R + 16 * MiB;
constexpr size_t WS_END = 648 * MiB;
constexpr int CW_BAR = 4096;
constexpr int CW_CNT = 8192;

constexpr int RING_BYTES = 131072;
constexpr int MISC_OFF = 139264;
constexpr int LDS_BYTES = 147456;
constexpr int MO_BAR = 0, MO_CNT = 64, MO_NT = 64 + 128, MO_OFF = 64 + 256, MO_TE = 64 + 512, MO_TR0 = 64 + 1024, MO_MT = 64 + 1536, MO_LOG = 2048;

#define LDS_WAIT() asm volatile("s_waitcnt lgkmcnt(0)" ::: "memory")
#define VM_WAIT() asm volatile("s_waitcnt vmcnt(0)" ::: "memory")

__device__ __forceinline__ float bf2f(unsigned short b) { return __builtin_bit_cast(float, (unsigned)b << 16); }
__device__ __forceinline__ float bflo(unsigned u) { return __builtin_bit_cast(float, u << 16); }
__device__ __forceinline__ float bfhi(unsigned u) { return __builtin_bit_cast(float, u & 0xffff0000u); }
typedef __bf16 bf16x2v __attribute__((ext_vector_type(2)));
typedef float f32x2v __attribute__((ext_vector_type(2)));
__device__ __forceinline__ unsigned cvt_pk_bf16(float lo, float hi) { const f32x2v f = {lo, hi}; const bf16x2v b = __builtin_convertvector(f, bf16x2v); return __builtin_bit_cast(unsigned, b); }
__device__ __forceinline__ float wave_sum(float v) {
#pragma unroll
    for (int o = 1; o < 64; o <<= 1) v += __shfl_xor(v, o);
    return v;
}
__device__ __forceinline__ float rows4_max(float x) { x = fmaxf(x, __shfl_xor(x, 16)); return fmaxf(x, __shfl_xor(x, 32)); }
__device__ __forceinline__ float rows4_sum(float x) { x += __shfl_xor(x, 16); return x + __shfl_xor(x, 32); }
__device__ __forceinline__ int lane_id() { int l; asm volatile("v_mbcnt_lo_u32_b32 %0, -1, 0\n\tv_mbcnt_hi_u32_b32 %0, -1, %0" : "=v"(l)); return l; }
__device__ __forceinline__ float sigmoidf_(float x) { return __builtin_amdgcn_rcpf(1.f + __expf(-x)); }

namespace pg8 {
constexpr int BM = 256, BK = 64, HALF = 128, HTB = HALF * BK * 2, STAGE_BYTES = 8 * HTB, NXCD = 8, WGM = 8;
__device__ __forceinline__ int lds_byte(int r, int c) { const int st = (r >> 4) * 2 + (c >> 5), rr = r & 15, cc = c & 31, ob = rr * 64 + cc * 2; return st * 1024 + (ob ^ (((ob >> 9) & 1) << 5)); }
__device__ __forceinline__ void stage_rc(int b, int& R, int& C) { const int st = b / 1024, sb = b % 1024, swz = sb ^ (((sb >> 9) & 1) << 5); R = (st >> 1) * 16 + swz / 64; C = (st & 1) * 32 + (swz % 64) / 2; }
__device__ __forceinline__ int perm32(int rho) { const int n = rho >> 4, i = rho & 15; return 8 * (i >> 2) + 4 * n + (i & 3); }
struct Unit { int pm, pn, aux; };

__device__ __forceinline__ void static_tile(int L, int nM, int nN, int& pm, int& pn) {
    const int nwg = nM * nN; int wgid = L;
    { const int q = nwg / NXCD, r = nwg % NXCD, xcd = wgid % NXCD, off = wgid / NXCD; wgid = (xcd < r ? xcd * (q + 1) : r * (q + 1) + (xcd - r) * q) + off; }
    const int nig = WGM * nN, gid = wgid / nig, fm = gid * WGM, gsz = (nM - fm) < WGM ? (nM - fm) : WGM;
    pm = fm + ((wgid % nig) % gsz); pn = (wgid % nig) / gsz;
}

template <class Epi, class Sched>
__device__ __forceinline__ void gemm_phase(LAS unsigned char* lds, const int K, const Sched& S, const Epi& E, const int wave0) {
    int tid_ = wave0 * 64 + lane_id(); asm volatile("" : "+v"(tid_));
    const int tid = tid_, wid = __builtin_amdgcn_readfirstlane(tid >> 6), lane = tid & 63, wr = wid >> 2, wc = wid & 3, fr = lane & 15, fq = lane >> 4;
    const int nt = K / BK;
    int RA[2], CA[2]; unsigned voffB[2];
#pragma unroll
    for (int i = 0; i < 2; ++i) { int R, C; stage_rc(tid * 16 + i * 8192, R, C); const int Rb = Epi::PERM ? ((R & ~31) + perm32(R & 31)) : R;
        RA[i] = R; CA[i] = C; voffB[i] = (unsigned)(Rb * K + C) * 2u; }
    const size_t kstep = (size_t)(BK * 2);
    const size_t hstep = (size_t)HALF * K * 2;
    const unsigned ldsw = (unsigned)wid * 1024u;
    const int aoff = lds_byte(wr * 64 + fr, fq * 8), boff = lds_byte(wc * 32 + fr, fq * 8);
#define PG8_SA(b, h) (((b) * 2 + (h)) * HTB)
#define PG8_SB(b, h) ((4 + (b) * 2 + (h)) * HTB)
#define PG8_STAGE(bufoff, gbase, v0, v1) do { \
        __builtin_amdgcn_global_load_lds((const unsigned*)((const char*)(gbase) + (v0)), (LAS unsigned*)(lds + (bufoff) + ldsw), 16, 0, 0); \
        __builtin_amdgcn_global_load_lds((const unsigned*)((const char*)(gbase) + (v1)), (LAS unsigned*)(lds + (bufoff) + ldsw + 8192), 16, 0, 0); } while (0)
#define PG8_STAGE_B(bufoff, gbase) PG8_STAGE(bufoff, gbase, voffB[0], voffB[1])
#define PG8_STAGE_A(bufoff, gbase, VO, h) PG8_STAGE(bufoff, gbase, VO[h][0], VO[h][1])
#define PG8_STAGE_A2(bufoff, gbase, h) do { if (Sched::GATHER && last) { PG8_STAGE_A(bufoff, gbase, vn, h); } else { PG8_STAGE_A(bufoff, gbase, vc, h); } } while (0)
#define PG8_LDA(dst, b, h) do { _Pragma("unroll") for (int m = 0; m < 4; ++m) _Pragma("unroll") for (int k = 0; k < 2; ++k) dst[m][k] = *(const LAS bf16x8*)(lds + PG8_SA(b, h) + aoff + m * 2048 + k * 1024); } while (0)
#define PG8_LDB(dst, b, h) do { _Pragma("unroll") for (int n = 0; n < 2; ++n) _Pragma("unroll") for (int k = 0; k < 2; ++k) dst[n][k] = *(const LAS bf16x8*)(lds + PG8_SB(b, h) + boff + n * 2048 + k * 1024); } while (0)
#define PG8_MMA(ai, bj, At, Bt) do { __builtin_amdgcn_s_setprio(1); _Pragma("unroll") for (int m = 0; m < 4; ++m) _Pragma("unroll") for (int n = 0; n < 2; ++n) _Pragma("unroll") for (int k = 0; k < 2; ++k) \
        acc[ai][bj][m][n] = __builtin_amdgcn_mfma_f32_16x16x32_bf16(Bt[n][k], At[m][k], acc[ai][bj][m][n], 0, 0, 0); __builtin_amdgcn_s_setprio(0); } while (0)
#define PG8_WAIT_V(n) asm volatile("s_waitcnt vmcnt(" #n ")" ::: "memory")
#define PG8_WAIT_L(n) asm volatile("s_waitcnt lgkmcnt(" #n ")" ::: "memory")
#define PG8_BAR __builtin_amdgcn_s_barrier()
#define PG8_SCHED __builtin_amdgcn_sched_barrier(0)
    Unit cur, nxt; int ui = 0;
    if (!S.next(0, cur)) return;
    f32x4 acc[2][2][4][2];
#pragma unroll
    for (int a = 0; a < 2; ++a)
#pragma unroll
        for (int b = 0; b < 2; ++b)
#pragma unroll
            for (int m = 0; m < 4; ++m)
#pragma unroll
                for (int n = 0; n < 2; ++n) acc[a][b][m][n] = (f32x4){0.f, 0.f, 0.f, 0.f};
    bf16x8 At[4][2], B0[2][2], B1[2][2];
    unsigned vc[2][2], vn[2][2];
#pragma unroll
    for (int h = 0; h < 2; ++h)
#pragma unroll
        for (int i = 0; i < 2; ++i) {
            if constexpr (Sched::GATHER) vc[h][i] = (unsigned)(S.arow(cur, h * HALF + RA[i]) * (unsigned)K + (unsigned)CA[i]) * 2u;
            else vc[h][i] = (unsigned)((h * HALF + RA[i]) * K + CA[i]) * 2u;
            vn[h][i] = vc[h][i];
        }
    const char* cA = S.abase(cur); const char* cB = S.bbase(cur);
    PG8_STAGE_B(PG8_SB(0, 0), cB); PG8_STAGE_A(PG8_SA(0, 0), cA, vc, 0); PG8_STAGE_B(PG8_SB(0, 1), cB + hstep); PG8_STAGE_A(PG8_SA(0, 1), cA, vc, 1);
    if (wr == 1) PG8_BAR;
    PG8_WAIT_V(4); PG8_BAR;
    PG8_STAGE_B(PG8_SB(1, 0), cB + kstep); PG8_STAGE_A(PG8_SA(1, 0), cA + kstep, vc, 0); PG8_STAGE_B(PG8_SB(1, 1), cB + hstep + kstep);
    PG8_WAIT_V(6); PG8_BAR;
    for (;;) {
        const bool has_next = S.next(ui + 1, nxt);
        const char* nA = has_next ? S.abase(nxt) : cA; const char* nB = has_next ? S.bbase(nxt) : cB;
        if constexpr (Sched::GATHER) {
            if (has_next) {
                int t2 = wave0 * 64 + lane_id(); asm volatile("" : "+v"(t2));
#pragma unroll
                for (int i = 0; i < 2; ++i) { int R, C; stage_rc(t2 * 16 + i * 8192, R, C);
#pragma unroll
                    for (int h = 0; h < 2; ++h) vn[h][i] = (unsigned)(S.arow(nxt, h * HALF + R) * (unsigned)K + (unsigned)C) * 2u; }
            }
        }
#pragma unroll 1
        for (int t = 0; t < nt; t += 2) {
            const bool last = (t == nt - 2);
            const char* a1 = cA + (size_t)(t + 1) * kstep;
            const char* a2 = last ? nA : cA + (size_t)(t + 2) * kstep; const char* b2 = last ? nB : cB + (size_t)(t + 2) * kstep;
            const char* a3 = a2 + kstep; const char* b3 = b2 + kstep;
            PG8_LDB(B0, 0, 0); PG8_SCHED; PG8_LDA(At, 0, 0); PG8_STAGE_A(PG8_SA(1, 1), a1, vc, 1);
            PG8_WAIT_L(8); PG8_BAR; PG8_WAIT_L(0); PG8_MMA(0, 0, At, B0); PG8_BAR; PG8_SCHED;
            PG8_LDB(B1, 0, 1); PG8_STAGE_B(PG8_SB(0, 0), b2);
            PG8_BAR; PG8_WAIT_L(0); PG8_MMA(0, 1, At, B1); PG8_BAR;
            PG8_LDA(At, 0, 1); PG8_STAGE_A2(PG8_SA(0, 0), a2, 0);
            PG8_BAR; PG8_WAIT_L(0); PG8_MMA(1, 0, At, B0); PG8_BAR; PG8_SCHED;
            PG8_STAGE_B(PG8_SB(0, 1), b2 + hstep);
            PG8_WAIT_V(6); PG8_BAR; PG8_MMA(1, 1, At, B1); PG8_BAR;
            PG8_LDB(B0, 1, 0); PG8_SCHED; PG8_LDA(At, 1, 0); PG8_STAGE_A2(PG8_SA(0, 1), a2, 1);
            PG8_WAIT_L(8); PG8_BAR; PG8_WAIT_L(0); PG8_MMA(0, 0, At, B0); PG8_BAR; PG8_SCHED;
            PG8_LDB(B1, 1, 1); PG8_STAGE_B(PG8_SB(1, 0), b3);
            PG8_BAR; PG8_WAIT_L(0); PG8_MMA(0, 1, At, B1); PG8_BAR;
            PG8_LDA(At, 1, 1); PG8_STAGE_A2(PG8_SA(1, 0), a3, 0);
            PG8_BAR; PG8_WAIT_L(0); PG8_MMA(1, 0, At, B0); PG8_BAR; PG8_SCHED;
            PG8_STAGE_B(PG8_SB(1, 1), b3 + hstep);
            PG8_WAIT_V(6); PG8_BAR; PG8_MMA(1, 1, At, B1); PG8_BAR;
        }
        { const int lz = lane_id(); E(acc, cur, wr, wc, lz & 15, lz >> 4); }
        if (!has_next) break;
        if (!Sched::keep_acc(cur)) {
#pragma unroll
        for (int a = 0; a < 2; ++a)
#pragma unroll
            for (int b = 0; b < 2; ++b)
#pragma unroll
                for (int m = 0; m < 4; ++m)
#pragma unroll
                    for (int n = 0; n < 2; ++n) acc[a][b][m][n] = (f32x4){0.f, 0.f, 0.f, 0.f};
        }
        cur = nxt; cA = nA; cB = nB; ++ui;
        if constexpr (Sched::GATHER) {
#pragma unroll
            for (int h = 0; h < 2; ++h)
#pragma unroll
                for (int i = 0; i < 2; ++i) vc[h][i] = vn[h][i];
        }
    }
    PG8_WAIT_V(0);
    if (wr == 0) PG8_BAR;
    PG8_BAR;
#undef PG8_SA
#undef PG8_SB
#undef PG8_STAGE
#undef PG8_STAGE_A
#undef PG8_STAGE_A2
#undef PG8_STAGE_B
#undef PG8_LDA
#undef PG8_LDB
#undef PG8_MMA
#undef PG8_WAIT_V
#undef PG8_WAIT_L
#undef PG8_BAR
#undef PG8_SCHED
}
}
using pg8::Unit;

#define XB_TMO      128
#define XB_XCNT(j)  (256  + 64 * (j))
#define XB_XSUB(j)  (1280 + 64 * (j))
#define XB_XGEN(j)  (2304 + 64 * (j))
#define XB_TOP      3328
#define XB_TOPGEN   3392
#define XCD_BAR_WORDS 3456
#define XB_SPIN_CAP (1u << 18)
__device__ __forceinline__ unsigned xb_ld(unsigned* p)              { return __hip_atomic_load(p, __ATOMIC_RELAXED, __HIP_MEMORY_SCOPE_AGENT); }
__device__ __forceinline__ unsigned xb_add(unsigned* p, unsigned v) { return __hip_atomic_fetch_add(p, v, __ATOMIC_RELAXED, __HIP_MEMORY_SCOPE_AGENT); }
__device__ __forceinline__ unsigned xb_xcc_id() { return (unsigned)__builtin_amdgcn_s_getreg((3 << 11) | 20) & 0xFu; }
#define XB_SPIN(cond, bar) do { unsigned _sp = 0; while (cond) { __builtin_amdgcn_s_sleep(1); \
    if ((++_sp & 255u) == 0u) { if (xb_ld(&(bar)[XB_TMO])) break; if (_sp > XB_SPIN_CAP) { atomicAdd(&(bar)[XB_TMO], 1u); break; } } } } while (0)
struct XcdBarrier { unsigned* bar; unsigned x; volatile LAS unsigned* st; };
__device__ __forceinline__ XcdBarrier xcd_barrier_post(unsigned* bar, volatile LAS unsigned* st) {
    XcdBarrier b; b.bar = bar; b.x = xb_xcc_id(); b.st = st;
    if (threadIdx.x == 0) (void)xb_add(&bar[XB_XCNT(b.x)], 1u);
    return b;
}
__device__ __forceinline__ void xcd_barrier_complete(unsigned* bar, unsigned x, unsigned& nloc, unsigned& nx) {
    const unsigned G = gridDim.x * gridDim.y * gridDim.z;
    unsigned sum, cnt, mine, sp = 0u;
    for (;;) {
        sum = 0u; cnt = 0u; mine = 0u;
#pragma unroll
        for (unsigned j = 0; j < 16; ++j) { const unsigned c = xb_ld(&bar[XB_XCNT(j)]); sum += c; cnt += (c > 0u) ? 1u : 0u; mine = (j == x) ? c : mine; }
        if (sum == G) break;
        __builtin_amdgcn_s_sleep(1);
        if ((++sp & 255u) == 0u) { if (xb_ld(&bar[XB_TMO])) break; if (sp > XB_SPIN_CAP) { atomicAdd(&bar[XB_TMO], 1u); break; } }
    }
    nloc = mine > 0u ? mine : 1u; nx = cnt > 0u ? cnt : 1u;
}
__device__ __forceinline__ void xcd_barrier(const XcdBarrier& b) {
    asm volatile("s_waitcnt vmcnt(0)" ::: "memory");
    __syncthreads();
    if (threadIdx.x == 0) {
        unsigned* bar = b.bar;
        __builtin_amdgcn_s_waitcnt(0);
        unsigned nloc = b.st[0], nx = b.st[1];
        if (nloc == 0u) { xcd_barrier_complete(bar, b.x, nloc, nx); b.st[0] = nloc; b.st[1] = nx; }
        const unsigned old = xb_add(&bar[XB_XSUB(b.x)], 1u);
        const unsigned gen = old / nloc;
        if (old + 1u == (gen + 1u) * nloc) {
            __builtin_amdgcn_fence(__ATOMIC_RELEASE, "agent");
            asm volatile("s_waitcnt vmcnt(0)" ::: "memory");
            const unsigned og = xb_add(&bar[XB_TOP], 1u);
            const unsigned tg = og / nx;
            if (og + 1u == (tg + 1u) * nx) xb_add(&bar[XB_TOPGEN], 1u);
            else XB_SPIN(xb_ld(&bar[XB_TOPGEN]) == tg, bar);
            __builtin_amdgcn_fence(__ATOMIC_ACQUIRE, "agent");
            xb_add(&bar[XB_XGEN(b.x)], 1u);
            asm volatile("s_waitcnt vmcnt(0)" ::: "memory");
        } else {
            XB_SPIN(xb_ld(&bar[XB_XGEN(b.x)]) == gen, bar);
            __builtin_amdgcn_fence(__ATOMIC_ACQUIRE, "agent");
            asm volatile("s_waitcnt vmcnt(0)" ::: "memory");
        }
    }
    __syncthreads();
}

struct Args { const float* in[19]; float* out; unsigned char* ws; int ph_lo, ph_hi; };
typedef const __attribute__((address_space(4))) Args* ArgsP;
enum { I_X = 0, I_N1G, I_WIN, I_CONVW, I_IFB, I_MNG, I_WBM, I_WBA, I_WOUT, I_RELB, I_N2G, I_WGRP, I_BGRP, I_WEXP, I_BEXP, I_W1, I_W3, I_W2, I_FG };


struct TrDesc { const float* W; bf16* WT; size_t ldn, ldk; int k0, n0, r0; };
__device__ __forceinline__ void tr_load(const TrDesc& d, f32x4 (&tv)[16], int lane) {
    const int nn4 = (lane & 15) * 4, kr = lane >> 4;
#pragma unroll
    for (int i = 0; i < 16; ++i) tv[i] = __builtin_nontemporal_load((const f32x4*)(d.W + (size_t)(d.k0 + 4 * i + kr) * d.ldn + d.n0 + nn4));
}
__device__ __forceinline__ void tr_finish(const TrDesc& d, f32x4 (&tv)[16], LAS float* scr, int lane) {
    const int nn4 = (lane & 15) * 4, kr = lane >> 4;
#pragma unroll
    for (int i = 0; i < 16; i += 4) asm volatile("" : "+v"(tv[i]), "+v"(tv[i + 1]), "+v"(tv[i + 2]), "+v"(tv[i + 3]));
#pragma unroll
    for (int i = 0; i < 16; ++i) { const int kk = 4 * i + kr; const f32x4 v = tv[i];
        LAS float* q = scr + kk * 65 + nn4; q[0] = v.x; q[1] = v.y; q[2] = v.z; q[3] = v.w; }
    LDS_WAIT();
    const int kc = (lane & 7) * 8;
#pragma unroll
    for (int p = 0; p < 8; ++p) { const int nn = 8 * p + (lane >> 3); const LAS float* sp = scr + kc * 65 + nn;
        u32x4 o; o.x = cvt_pk_bf16(sp[0], sp[65]); o.y = cvt_pk_bf16(sp[130], sp[195]); o.z = cvt_pk_bf16(sp[260], sp[325]); o.w = cvt_pk_bf16(sp[390], sp[455]);
        *(u32x4*)(d.WT + (size_t)(d.r0 + nn) * d.ldk + d.k0 + kc) = o; }
    LDS_WAIT();
}
__device__ __forceinline__ int win_src_col(int r) {
    if (r < 2048) return r;
    if (r < 3072) return r + 1024;
    if (r < 5120) return r + 1032;
    if (r < 9216) return r + 2056;
    if (r < 10240) return r - 7168;
    return r - 4088;
}
__device__ __forceinline__ TrDesc tr_decode(ArgsP a, unsigned char* ws, int it) {
    constexpr int PER_LAYER = 5632 + 512 + 512 + 1024 + 4096 + 4096 + 4096;
    const int l = it / PER_LAYER; int r = it % PER_LAYER;
    TrDesc d;
    if (r < 5632) { const int kb = r / 176, ng = r % 176;
        d.W = a->in[I_WIN] + (size_t)l * DM * INCOLS; d.ldn = INCOLS; d.k0 = 64 * kb; d.n0 = win_src_col(64 * ng); d.WT = (bf16*)(ws + WS_WINT) + (size_t)l * 11264 * 2048; d.ldk = 2048; d.r0 = 64 * ng; return d; }
    r -= 5632;
    if (r < 512) { const int kb = r / 32, ng = r % 32;
        d.W = a->in[I_WBM] + (size_t)l * 1024 * 2048; d.ldn = 2048; d.k0 = 64 * kb; d.n0 = 64 * ng; d.WT = (bf16*)(ws + WS_WBM) + (size_t)l * 2048 * 1024; d.ldk = 1024; d.r0 = 64 * ng; return d; }
    r -= 512;
    if (r < 512) { const int kb = r / 32, ng = r % 32;
        d.W = a->in[I_WBA] + (size_t)l * 1024 * 2048; d.ldn = 2048; d.k0 = 64 * kb; d.n0 = 64 * ng; d.WT = (bf16*)(ws + WS_WBA) + (size_t)l * 2048 * 1024; d.ldk = 1024; d.r0 = 64 * ng; return d; }
    r -= 512;
    if (r < 1024) { const int kb = r / 32, ng = r % 32;
        d.W = a->in[I_WOUT] + (size_t)l * 2048 * 2048; d.ldn = 2048; d.k0 = 64 * kb; d.n0 = 64 * ng; d.WT = (bf16*)(ws + WS_WOUT) + (size_t)l * 2048 * 2048; d.ldk = 2048; d.r0 = 64 * ng; return d; }
    r -= 1024;
    if (r < 8192) { const int w3 = r >= 4096; const int q = r & 4095; const int e = q >> 7, rr = q & 127, kb = rr >> 2, ng = rr & 3;
        d.W = a->in[w3 ? I_W3 : I_W1] + (size_t)(l * 32 + e) * 2048 * 256; d.ldn = 256; d.k0 = 64 * kb; d.n0 = 64 * ng;
        d.WT = (bf16*)(ws + WS_W13) + (size_t)(l * 32 + e) * 512 * 2048; d.ldk = 2048; d.r0 = 256 * (ng >> 1) + 64 * (ng & 1) + (w3 ? 128 : 0); return d; }
    r -= 8192;
    { const int e = r >> 7, rr = r & 127, kb = rr >> 5, ng = rr & 31;
        d.W = a->in[I_W2] + (size_t)(l * 32 + e) * 256 * 2048; d.ldn = 2048; d.k0 = 64 * kb; d.n0 = 64 * ng; d.WT = (bf16*)(ws + WS_W2) + (size_t)(l * 32 + e) * 2048 * 256; d.ldk = 256; d.r0 = 64 * ng; return d; }
}
#ifndef CVX
#define CVX 4096
#endif
__device__ __forceinline__ void prologue_phase(ArgsP a, LAS unsigned char* lds, int tid, int lane, int wave, int bid, int G, const int part = 0) {
    unsigned char* ws = a->ws;
    LAS float* scr = (LAS float*)(lds + wave * 16640);
    const int gw = bid * NWAVES + wave, NGW = G * NWAVES;
    constexpr int PER_LAYER = 5632 + 512 + 512 + 1024 + 4096 + 4096 + 4096;
    constexpr int W0 = 5632, W2I = PER_LAYER - 4096;
    const int v_lo = part == 0 ? 0 : part == 1 ? PER_LAYER : part == 2 ? W0 + CVX : part == 3 ? PER_LAYER + W0 : PER_LAYER + W2I;
    const int v_hi = part == 0 ? W0 + CVX : part == 1 ? PER_LAYER + W0 : part == 2 ? PER_LAYER : part == 3 ? PER_LAYER + W2I : 2 * PER_LAYER;
#define CV_ITEM(v) (v)
    f32x4 tvA[16], tvB[16]; TrDesc dA, dB;
    int it = v_lo + gw;
    if (it < v_hi) {
        int rem = (v_hi - 1 - it) / NGW;
        dA = tr_decode(a, ws, CV_ITEM(it)); tr_load(dA, tvA, lane);
#pragma unroll 1
        while (rem >= 2) {
            dB = tr_decode(a, ws, CV_ITEM(it + NGW)); tr_load(dB, tvB, lane);
            tr_finish(dA, tvA, scr, lane);
            it += 2 * NGW;
            dA = tr_decode(a, ws, CV_ITEM(it)); tr_load(dA, tvA, lane);
            tr_finish(dB, tvB, scr, lane);
            rem -= 2;
        }
        if (rem == 1) { dB = tr_decode(a, ws, CV_ITEM(it + NGW)); tr_load(dB, tvB, lane); tr_finish(dA, tvA, scr, lane); tr_finish(dB, tvB, scr, lane); }
        else tr_finish(dA, tvA, scr, lane);
    }
#undef CV_ITEM
    if (part != 0) return;
    const int gt = bid * NTHR + tid, NGT = G * NTHR;
    float* wrt = (float*)(ws + MS_WRT);
    for (int i = gt; i < 2 * 36 * 2048; i += NGT) { const int l = i / (36 * 2048), rr = i % (36 * 2048), n = rr >> 11, k = rr & 2047;
        wrt[i] = n < 4 ? a->in[I_WGRP][((size_t)l * DM + k) * 4 + n] : a->in[I_WEXP][((size_t)l * DM + k) * 32 + (n - 4)]; }
}

__device__ __forceinline__ void moe_tables(unsigned char* ws, int l, LAS unsigned char* misc, int tid) {
    LAS int* cnt = (LAS int*)(misc + MO_CNT); LAS int* ntl = (LAS int*)(misc + MO_NT); LAS int* off = (LAS int*)(misc + MO_OFF);
    LAS int* te = (LAS int*)(misc + MO_TE); LAS int* tr0 = (LAS int*)(misc + MO_TR0); LAS int* mt = (LAS int*)(misc + MO_MT);
    __syncthreads();
    if (tid < 32) { const int c = (int)__hip_atomic_load((unsigned*)(ws + WS_CTL) + CW_CNT + 32 * l + tid, __ATOMIC_RELAXED, __HIP_MEMORY_SCOPE_AGENT); cnt[tid] = c; ntl[tid] = (c + 255) >> 8; }
    __syncthreads();
    if (tid == 0) { int o = 0;
#pragma unroll 1
        for (int e = 0; e < 32; ++e) { off[e] = o; const int n = ntl[e];
#pragma unroll 1
            for (int j = 0; j < n; ++j) { te[o + j] = e; tr0[o + j] = 256 * j; } o += n; } off[32] = o; mt[0] = o; }
    __syncthreads();
}

#ifndef DRYX
#define DRYX 0
#endif
template <int MODE>
__device__ __forceinline__ void norm_phase(ArgsP a, int l, LAS unsigned char* lds, int tid, int lane, int wave, int bid, int G, const bool dry = false) {
    unsigned char* ws = a->ws;
    LAS unsigned char* misc = lds + MISC_OFF;
    if (MODE == 1 || MODE == 3) moe_tables(ws, MODE == 1 ? 0 : 1, misc, tid);
    const LAS int* off = (const LAS int*)(misc + MO_OFF);
    const float* src = (MODE == 0) ? a->in[I_X] : a->out;
    const float* gain = (MODE < 2) ? a->in[I_N1G] + l * DM : (MODE == 2 ? a->in[I_N2G] + l * DM : a->in[I_FG]);
    const int* toke = (const int*)(ws + MS_TOKE); const int* tokp = (const int*)(ws + MS_TOKP);
    const bf16* OP = (const bf16*)(ws + WS_OP);
    bf16* H = (bf16*)(ws + WS_H);
    const int gw = bid * NWAVES + wave, NGW = G * NWAVES;
    constexpr int RP = (MODE == 2) ? 4 : 2;
    LAS float* gwl = (LAS float*)lds;
    if (MODE < 2) {
        const float* wg = a->in[I_WIN] + (size_t)l * DM * INCOLS + 4096;
        f32x4 t0[4], t1[4];
#pragma unroll
        for (int i = 0; i < 4; ++i) { const float* wp = wg + (size_t)(tid + NTHR * i) * INCOLS; t0[i] = *(const f32x4*)wp; t1[i] = *(const f32x4*)(wp + 4); }
#pragma unroll
        for (int i = 0; i < 4; ++i) { const int k = tid + NTHR * i;
            gwl[k] = t0[i].x; gwl[2048 + k] = t0[i].y; gwl[4096 + k] = t0[i].z; gwl[6144 + k] = t0[i].w;
            gwl[8192 + k] = t1[i].x; gwl[10240 + k] = t1[i].y; gwl[12288 + k] = t1[i].z; gwl[14336 + k] = t1[i].w; }
        __syncthreads();
    }
    for (int m0 = gw * RP; m0 < NTOK; m0 += NGW * RP) {
        f32x4 v[RP][8];
        const bf16* orow[RP][2]; float cw[RP][2];
        if (MODE == 1 || MODE == 3) {
#pragma unroll
            for (int r = 0; r < RP; ++r) { const int m = m0 + r;
                const int e0 = toke[2 * m], e1 = toke[2 * m + 1], p0 = tokp[2 * m], p1 = tokp[2 * m + 1];
                cw[r][0] = ((const float*)(ws + MS_TOKW))[2 * m]; cw[r][1] = ((const float*)(ws + MS_TOKW))[2 * m + 1];
                orow[r][0] = OP + (size_t)(off[e0] * 256 + p0) * DM + 4 * lane; orow[r][1] = OP + (size_t)(off[e1] * 256 + p1) * DM + 4 * lane; }
        }
#pragma unroll
        for (int r = 0; r < RP; ++r)
#pragma unroll
            for (int j = 0; j < 8; ++j) v[r][j] = *(const f32x4*)(src + (size_t)(m0 + r) * DM + 256 * j + 4 * lane);
        if (MODE == 1 || MODE == 3) {
            u32x2 ow[RP][2][8];
#pragma unroll
            for (int r = 0; r < RP; ++r)
#pragma unroll
                for (int j = 0; j < 8; ++j) { ow[r][0][j] = *(const u32x2*)(orow[r][0] + 256 * j); ow[r][1][j] = *(const u32x2*)(orow[r][1] + 256 * j); }
#pragma unroll
            for (int r = 0; r < RP; ++r)
                asm volatile("" : "+v"(ow[r][0][0]), "+v"(ow[r][0][1]), "+v"(ow[r][0][2]), "+v"(ow[r][0][3]), "+v"(ow[r][0][4]), "+v"(ow[r][0][5]), "+v"(ow[r][0][6]), "+v"(ow[r][0][7]),
                                  "+v"(ow[r][1][0]), "+v"(ow[r][1][1]), "+v"(ow[r][1][2]), "+v"(ow[r][1][3]), "+v"(ow[r][1][4]), "+v"(ow[r][1][5]), "+v"(ow[r][1][6]), "+v"(ow[r][1][7]));
#pragma unroll
            for (int r = 0; r < RP; ++r) { const int m = m0 + r; const float cw0 = cw[r][0], cw1 = cw[r][1];
#pragma unroll
                for (int j = 0; j < 8; ++j) { const u32x2 w0 = ow[r][0][j], w1 = ow[r][1][j];
                    v[r][j].x += cw0 * bflo(w0.x) + cw1 * bflo(w1.x); v[r][j].y += cw0 * bfhi(w0.x) + cw1 * bfhi(w1.x); v[r][j].z += cw0 * bflo(w0.y) + cw1 * bflo(w1.y); v[r][j].w += cw0 * bfhi(w0.y) + cw1 * bfhi(w1.y); }
                if (MODE == 1 && !dry) {
#pragma unroll
                    for (int j = 0; j < 8; ++j) *(f32x4*)(a->out + (size_t)m * DM + 256 * j + 4 * lane) = v[r][j]; }
            }
        }
        float rs[RP];
#pragma unroll
        for (int r = 0; r < RP; ++r) { float ss = 0.f;
#pragma unroll
            for (int j = 0; j < 8; ++j) ss += (v[r][j].x * v[r][j].x + v[r][j].y * v[r][j].y) + (v[r][j].z * v[r][j].z + v[r][j].w * v[r][j].w);
            rs[r] = __builtin_amdgcn_rsqf(wave_sum(ss) * (1.0f / DM) + RMS_EPS); }
        {
            f32x4 gv[8];
            int l4 = 4 * lane; asm volatile("" : "+v"(l4)); const float* gp = gain + l4;
#pragma unroll
            for (int j = 0; j < 8; ++j) gv[j] = *(const f32x4*)(gp + 256 * j);
            asm volatile("" : "+v"(gv[0]), "+v"(gv[1]), "+v"(gv[2]), "+v"(gv[3]), "+v"(gv[4]), "+v"(gv[5]), "+v"(gv[6]), "+v"(gv[7]));
#pragma unroll
            for (int j = 0; j < 8; ++j)
#pragma unroll
                for (int r = 0; r < RP; ++r) v[r][j] = v[r][j] * rs[r] * gv[j];
        }
        if (MODE == 3) {
#pragma unroll
            for (int r = 0; r < RP; ++r)
#pragma unroll
                for (int j = 0; j < 8; ++j) { if (!dry) *(f32x4*)(a->out + (size_t)(m0 + r) * DM + 256 * j + 4 * lane) = v[r][j]; else asm volatile("" :: "v"(v[r][j])); }
            continue;
        }
#pragma unroll
        for (int r = 0; r < RP; ++r)
#pragma unroll
            for (int j = 0; j < 8; ++j) { u32x2 w; w.x = cvt_pk_bf16(v[r][j].x, v[r][j].y); w.y = cvt_pk_bf16(v[r][j].z, v[r][j].w);
                if (!dry) *(u32x2*)(H + (size_t)(m0 + r) * DM + 256 * j + 4 * lane) = w; else asm volatile("" :: "v"(w)); }
        float keep[RP]; _Pragma("unroll") for (int r = 0; r < RP; ++r) keep[r] = 0.f;
        if (MODE < 2) {
            float a8[RP][8];
#pragma unroll
            for (int r = 0; r < RP; ++r)
#pragma unroll
                for (int n = 0; n < 8; ++n) a8[r][n] = 0.f;
#pragma unroll
            for (int j = 0; j < 8; ++j) {
#pragma unroll
                for (int nh = 0; nh < 2; ++nh) {
                    f32x4 wn[4];
#pragma unroll
                    for (int n = 0; n < 4; ++n) wn[n] = *(const LAS f32x4*)(gwl + (4 * nh + n) * 2048 + 256 * j + 4 * lane);
                    asm volatile("" : "+v"(wn[0]), "+v"(wn[1]), "+v"(wn[2]), "+v"(wn[3]));
#pragma unroll
                    for (int r = 0; r < RP; ++r)
#pragma unroll
                        for (int n = 0; n < 4; ++n) a8[r][4 * nh + n] += (v[r][j].x * wn[n].x + v[r][j].y * wn[n].y) + (v[r][j].z * wn[n].z + v[r][j].w * wn[n].w);
                }
            }
#pragma unroll
            for (int r = 0; r < RP; ++r)
#pragma unroll
                for (int n = 0; n < 8; ++n) { const float d = wave_sum(a8[r][n]); keep[r] = (lane == n) ? d : keep[r]; }
        } else {
            const float* W = (const float*)(ws + MS_WRT) + (size_t)l * 36 * 2048;
            LAS float* logl = (LAS float*)(misc + MO_LOG) + wave * 160;
#pragma unroll 1
            for (int grp = 0; grp < 9; ++grp) {
                float val[16];
                const float* wg = W + (size_t)(4 * grp) * 2048 + 4 * lane;
#pragma unroll
                for (int nl = 0; nl < 4; ++nl) {
                    float d[4] = {0.f, 0.f, 0.f, 0.f};
                    f32x4 wv[8];
#pragma unroll
                    for (int j = 0; j < 8; ++j) wv[j] = *(const f32x4*)(wg + nl * 2048 + 256 * j);
                    asm volatile("" : "+v"(wv[0]), "+v"(wv[1]), "+v"(wv[2]), "+v"(wv[3]), "+v"(wv[4]), "+v"(wv[5]), "+v"(wv[6]), "+v"(wv[7]));
#pragma unroll
                    for (int j = 0; j < 8; ++j) { const f32x4 w = wv[j];
#pragma unroll
                        for (int r = 0; r < 4; ++r) d[r] += (v[r][j].x * w.x + v[r][j].y * w.y) + (v[r][j].z * w.z + v[r][j].w * w.w); }
#pragma unroll
                    for (int r = 0; r < 4; ++r) val[4 * nl + r] = d[r];
                }
#pragma unroll
                for (int i = 0; i < 8; ++i) { const bool hi = (lane & 32) != 0; const float snd = hi ? val[i] : val[i + 8]; const float kp = hi ? val[i + 8] : val[i]; val[i] = kp + __shfl_xor(snd, 32); }
#pragma unroll
                for (int i = 0; i < 4; ++i) { const bool hi = (lane & 16) != 0; const float snd = hi ? val[i] : val[i + 4]; const float kp = hi ? val[i + 4] : val[i]; val[i] = kp + __shfl_xor(snd, 16); }
#pragma unroll
                for (int i = 0; i < 2; ++i) { const bool hi = (lane & 8) != 0; const float snd = hi ? val[i] : val[i + 2]; const float kp = hi ? val[i + 2] : val[i]; val[i] = kp + __shfl_xor(snd, 8); }
                { const bool hi = (lane & 4) != 0; const float snd = hi ? val[0] : val[1]; const float kp = hi ? val[1] : val[0]; val[0] = kp + __shfl_xor(snd, 4); }
                float f = val[0]; f += __shfl_xor(f, 2); f += __shfl_xor(f, 1);
                const int vi = lane >> 2;
                if ((lane & 3) == 0) logl[(vi & 3) * 40 + 4 * grp + (vi >> 2)] = f;
            }
        }
        if (MODE < 2) {
            float* ifg = (float*)(ws + MS_IFG);
            if (lane < 8) {
#pragma unroll
                for (int r = 0; r < RP; ++r) { if (!dry) ifg[(size_t)(m0 + r) * 8 + lane] = keep[r]; else asm volatile("" :: "v"(keep[r])); } }
        } else {
            LAS float* logl = (LAS float*)(misc + MO_LOG) + wave * 160;
            LDS_WAIT();
            if (dry) { asm volatile("" :: "v"(keep[0])); }
            if (lane < RP && !dry) {
                const int m = m0 + lane; const LAS float* lg = logl + lane * 40;
                const float* bg = a->in[I_BGRP] + l * 4; const float* be = a->in[I_BEXP] + l * 32;
                float gv[4]; int gsel = 0;
#pragma unroll
                for (int j = 0; j < 4; ++j) gv[j] = lg[j] + bg[j];
                float gmax = gv[0];
#pragma unroll
                for (int j = 1; j < 4; ++j) if (gv[j] > gmax) { gmax = gv[j]; gsel = j; }
                float gs = 0.f;
#pragma unroll
                for (int j = 0; j < 4; ++j) gs += expf(gv[j] - gmax);
                const float pg = 1.0f / gs;
                float ev[8];
#pragma unroll
                for (int j = 0; j < 8; ++j) ev[j] = lg[4 + 8 * gsel + j] + be[8 * gsel + j];
                int e0 = 0; float m0v = ev[0];
#pragma unroll
                for (int j = 1; j < 8; ++j) if (ev[j] > m0v) { m0v = ev[j]; e0 = j; }
                int e1 = -1; float m1v = -3.0e38f;
#pragma unroll
                for (int j = 0; j < 8; ++j) if (j != e0 && ev[j] > m1v) { m1v = ev[j]; e1 = j; }
                const float p1 = expf(m1v - m0v); const float w0 = pg / (1.0f + p1), w1 = pg * p1 / (1.0f + p1);
                unsigned* cnt = (unsigned*)(ws + WS_CTL) + CW_CNT + 32 * l;
                int* list = (int*)(ws + MS_LIST); float* pwl = (float*)(ws + MS_PWL); int* tke = (int*)(ws + MS_TOKE); int* tkp = (int*)(ws + MS_TOKP);
                const int id0 = 8 * gsel + e0, id1 = 8 * gsel + e1;
                const int q0 = (int)__hip_atomic_fetch_add(cnt + id0, 1u, __ATOMIC_RELAXED, __HIP_MEMORY_SCOPE_AGENT);
                const int q1 = (int)__hip_atomic_fetch_add(cnt + id1, 1u, __ATOMIC_RELAXED, __HIP_MEMORY_SCOPE_AGENT);
                list[id0 * 8192 + q0] = m; pwl[id0 * 8192 + q0] = w0; list[id1 * 8192 + q1] = m; pwl[id1 * 8192 + q1] = w1;
                tke[2 * m] = id0; tke[2 * m + 1] = id1; tkp[2 * m] = q0; tkp[2 * m + 1] = q1;
                ((float*)(ws + MS_TOKW))[2 * m] = w0; ((float*)(ws + MS_TOKW))[2 * m + 1] = w1;
            }
            LDS_WAIT();
        }
    }
}

struct SchedG1 {
    static constexpr bool GATHER = false;
    const char* H; const char* W; int G, c;
    static constexpr int NCV = 21;
    __device__ __forceinline__ bool next(int i, Unit& u) const {
        int L = i * G + c;
        if (G == 256) {
            if (c >= 256 - NCV) return false;
            if (c >= 128 && i == 5) { const int k = c - 128; if (k >= 5 * NCV) return false; L = (k % 5) * 256 + (256 - NCV) + k / 5; }
            else if (i > 5) return false;
        }
        if (L < 1152) { pg8::static_tile(L, 32, 36, u.pm, u.pn); u.aux = 0; return true; }
        const int r = L - 1152; if (r >= 256) return false;
        u.aux = 1 + (r >> 7); const int q = r & 127; u.pm = q & 3; u.pn = q >> 2; return true;
    }
    __device__ __forceinline__ const char* abase(const Unit& u) const { return u.aux == 0 ? H + (size_t)u.pm * 256 * 4096 : W + (size_t)(9216 + (u.aux - 1) * 1024 + u.pm * 256) * 4096; }
    __device__ __forceinline__ const char* bbase(const Unit& u) const { return u.aux == 0 ? W + (size_t)u.pn * 256 * 4096 : H + (size_t)u.pn * 256 * 4096; }
    __device__ __forceinline__ unsigned arow(const Unit&, int) const { return 0u; }
    static __device__ __forceinline__ bool keep_acc(const Unit&) { return false; }
};
struct EpiG1 {
    static constexpr bool PERM = true;
    unsigned char* ws; bool dry;
    __device__ __forceinline__ void operator()(f32x4 (&acc)[2][2][4][2], const Unit& u, int wr, int wc, int fr, int fq) const {
        if (dry) {
#pragma unroll
            for (int ai = 0; ai < 2; ++ai)
#pragma unroll
                for (int bj = 0; bj < 2; ++bj)
#pragma unroll
                    for (int m = 0; m < 4; ++m) asm volatile("" :: "v"(acc[ai][bj][m][0]), "v"(acc[ai][bj][m][1]));
            return; }
        if (u.aux == 0) {
            bf16* dst; int ld, colt, op;
            if (u.pn < 8) { dst = (bf16*)(ws + WS_ZQK); ld = 2048; colt = 256 * u.pn; op = 0; }
            else if (u.pn < 12) { dst = (bf16*)(ws + WS_OM); ld = 1024; colt = 256 * (u.pn - 8); op = 1; }
            else if (u.pn < 16) { dst = (bf16*)(ws + WS_QA); ld = 1024; colt = 256 * (u.pn - 12); op = 2; }
            else if (u.pn < 20) { dst = (bf16*)(ws + WS_KA); ld = 1024; colt = 256 * (u.pn - 16); op = 0; }
            else { dst = (bf16*)(ws + WS_SG); ld = 4096; colt = 256 * (u.pn - 20); op = 1; }
            const float scl = (op == 2) ? 0.12751743074602267f : 1.0f;
            const int row0 = u.pm * 256 + wr * 64 + fr, col0 = colt + wc * 32 + 8 * fq;
#pragma unroll
            for (int ai = 0; ai < 2; ++ai)
#pragma unroll
                for (int m = 0; m < 4; ++m) { bf16* rowp = dst + (size_t)(row0 + ai * 128 + m * 16) * ld + col0;
#pragma unroll
                    for (int bj = 0; bj < 2; ++bj) { f32x4 v0 = acc[ai][bj][m][0] * scl, v1 = acc[ai][bj][m][1] * scl;
                        if (op == 1) {
#pragma unroll
                            for (int j = 0; j < 4; ++j) { v0[j] = sigmoidf_(v0[j]); v1[j] = sigmoidf_(v1[j]); } }
                        u32x4 w; w.x = cvt_pk_bf16(v0[0], v0[1]); w.y = cvt_pk_bf16(v0[2], v0[3]); w.z = cvt_pk_bf16(v1[0], v1[1]); w.w = cvt_pk_bf16(v1[2], v1[3]);
                        *(u32x4*)(rowp + bj * 128) = w; } }
        } else {
            bf16* dst = (bf16*)(ws + (u.aux == 1 ? WS_VMT : WS_VAT));
            const int b = u.pn >> 3, s0 = (u.pn & 7) * 256 + wc * 32 + 8 * fq, rr0 = u.pm * 256 + wr * 64 + fr;
#pragma unroll
            for (int ai = 0; ai < 2; ++ai)
#pragma unroll
                for (int m = 0; m < 4; ++m) { const int rr = rr0 + ai * 128 + m * 16;
#pragma unroll
                    for (int bj = 0; bj < 2; ++bj) { const f32x4 v0 = acc[ai][bj][m][0], v1 = acc[ai][bj][m][1];
                        u32x4 w; w.x = cvt_pk_bf16(v0[0], v0[1]); w.y = cvt_pk_bf16(v0[2], v0[3]); w.z = cvt_pk_bf16(v1[0], v1[1]); w.w = cvt_pk_bf16(v1[2], v1[3]);
                        const int sq = s0 + bj * 128;
                        const size_t off = (u.aux == 1) ? (size_t)((((b * 4 + (rr >> 8)) * 32 + (sq >> 6)) * 2 + ((sq >> 5) & 1)) * 16 + ((rr & 255) >> 4)) * 512 + (size_t)((((sq >> 3) & 3) * 16 + (rr & 15)) * 8)
                                                        : (size_t)(b * 1024 + rr) * 2048 + sq;
                        *(u32x4*)(dst + off) = w; } }
        }
    }
};

__device__ __forceinline__ void gate_unit(ArgsP a, int l, LAS unsigned char* lds, int bh, int tid, int lane, int wave) {
    unsigned char* ws = a->ws;
    {
            const int b = bh >> 2, h = bh & 3;
            LAS float* bl = (LAS float*)lds; LAS float* amx = bl + 32; LAS float* mpv = bl + 64; LAS float* gcv = bl + 96;
            const float* ifg = (const float*)(ws + MS_IFG); const float* ifb = a->in[I_IFB] + l * 8;
            float A[4], Bs[4], CM[4];
#pragma unroll
            for (int cc = 0; cc < 4; ++cc) { const int c = wave + 8 * cc, s = 64 * c + lane; const size_t tok = (size_t)b * SEQ + s;
                const float ig = ifg[tok * 8 + h] + ifb[h], fg = ifg[tok * 8 + 4 + h] + ifb[4 + h];
                const float lf = fminf(fg, 0.f) - log1pf(expf(-fabsf(fg)));
                float bs = lf;
#pragma unroll
                for (int o = 1; o < 64; o <<= 1) { const float t = __shfl_up(bs, o); if (lane >= o) bs += t; }
                const float av = ig - bs; float cm = av;
#pragma unroll
                for (int o = 1; o < 64; o <<= 1) { const float t = __shfl_up(cm, o); if (lane >= o) cm = fmaxf(cm, t); }
                A[cc] = av; Bs[cc] = bs; CM[cc] = cm;
                if (lane == 63) { bl[c] = bs; amx[c] = cm; } }
            __syncthreads();
            if (tid == 0) { float m = 0.f;
#pragma unroll 1
                for (int c = 0; c < 32; ++c) { mpv[c] = m; const float Gm = fmaxf(m, amx[c]); gcv[c] = Gm; m = bl[c] + Gm; } }
            __syncthreads();
            float* AS = (float*)(ws + MS_AS) + bh * 2048; float* GT = (float*)(ws + MS_GT) + bh * 2048; float* WI = (float*)(ws + MS_WI) + bh * 2048;
            float* CL = (float*)(ws + MS_CL) + bh * 2048; float* WSs = (float*)(ws + MS_WS) + bh * 2048; float* DEC = (float*)(ws + MS_DEC) + bh * 32;
#pragma unroll
            for (int cc = 0; cc < 4; ++cc) { const int c = wave + 8 * cc, s = 64 * c + lane; const float mp = mpv[c], Gm = gcv[c], gt = fmaxf(mp, CM[cc]);
                AS[s] = A[cc]; GT[s] = gt; WI[s] = expf(mp - gt); CL[s] = expf(-(Bs[cc] + gt)); WSs[s] = expf(A[cc] - Gm);
                if (lane == 0) DEC[c] = expf(mp - Gm); }
        }
    __syncthreads();
}

__device__ __forceinline__ void conv_phase(ArgsP a, int l, LAS unsigned char* lds, int tid, int lane, int wave, int bid, int G) {
    unsigned char* ws = a->ws;
    u32x4 xv[5];
    const bf16* Z = (const bf16*)(ws + WS_ZQK);
#define CONV_LOAD(u_) do { const int cg_ = (u_) & 7, s0_ = 64 * (((u_) >> 3) & 31), b_ = (u_) >> 8; _Pragma("unroll") for (int i = 0; i < 5; ++i) { \
        const int idx = tid + NTHR * i, row = idx >> 5, ch = idx & 31, sq = s0_ - 3 + row; xv[i] = (u32x4){0u, 0u, 0u, 0u}; \
        if (idx < 67 * 32 && sq >= 0) xv[i] = *(const u32x4*)(Z + (size_t)(b_ * SEQ + sq) * 2048 + cg_ * 256 + ch * 8); } } while (0)
    if (bid < 1024) CONV_LOAD(bid);
    for (int u = bid; u < 1024 + 256; u += G) {
        if (u < 1024) {
            const int cg = u & 7, st = (u >> 3) & 31, b = u >> 8, s0 = 64 * st;
            LAS unsigned char* xt = lds; LAS unsigned char* kt = lds + 36864;
            asm volatile("" : "+v"(xv[0]), "+v"(xv[1]), "+v"(xv[2]), "+v"(xv[3]), "+v"(xv[4]));
#pragma unroll
            for (int i = 0; i < 5; ++i) { const int idx = tid + NTHR * i, row = idx >> 5, ch = idx & 31;
                if (idx < 67 * 32) *(LAS u32x4*)(xt + row * 512 + ch * 16) = xv[i]; }
            LAS float* wst = (LAS float*)(lds + 73728);
            if (cg >= 4 && tid < 64) wst[tid] = ((const float*)(ws + MS_WS))[(size_t)(b * 4 + cg - 4) * 2048 + s0 + tid];
            __syncthreads();
            if (u + G < 1024) CONV_LOAD(u + G);
            const int cp = tid & 127, tg = tid >> 7, c = 2 * cp, gc = cg * 256 + c;
            float w0[4], w1[4];
#pragma unroll
            for (int j = 0; j < 4; ++j) { w0[j] = a->in[I_CONVW][(size_t)(l * 4 + j) * 2048 + gc]; w1[j] = a->in[I_CONVW][(size_t)(l * 4 + j) * 2048 + gc + 1]; }
            bf16* QM = (bf16*)(ws + WS_QM); bf16* KM = (bf16*)(ws + WS_KM);
#pragma unroll 4
            for (int tt = 0; tt < 16; ++tt) { const int t = tg * 16 + tt; float a0 = 0.f, a1 = 0.f;
#pragma unroll
                for (int j = 0; j < 4; ++j) { const unsigned x = *(const LAS unsigned*)(xt + (t + j) * 512 + c * 2); a0 += w0[j] * bflo(x); a1 += w1[j] * bfhi(x); }
                float o0 = a0 * sigmoidf_(a0), o1 = a1 * sigmoidf_(a1);
                const size_t tok = (size_t)b * SEQ + s0 + t;
                if (cg < 4) { *(unsigned*)(QM + tok * 1024 + cg * 256 + c) = cvt_pk_bf16(o0, o1); }
                else { o0 *= 0.0625f; o1 *= 0.0625f; const unsigned p = cvt_pk_bf16(o0, o1);
                    *(unsigned*)(KM + tok * 1024 + (cg - 4) * 256 + c) = p;
                    const float wsv = wst[t]; const unsigned ps = cvt_pk_bf16(o0 * wsv, o1 * wsv);
                    *(LAS unsigned short*)(kt + c * 144 + t * 2) = (unsigned short)(ps & 0xffffu); *(LAS unsigned short*)(kt + (c + 1) * 144 + t * 2) = (unsigned short)(ps >> 16); }
            }
            if (cg >= 4) {
                __syncthreads();
                bf16* KMT = (bf16*)(ws + WS_KMT);
                for (int idx = tid; idx < 2048; idx += NTHR) {
                    const int ks = idx >> 10, dtl = (idx >> 6) & 15, ln = idx & 63, row = dtl * 16 + (ln & 15), ch = ks * 4 + (ln >> 4);
                    const u32x4 v = *(const LAS u32x4*)(kt + row * 144 + ch * 16);
                    *(u32x4*)(KMT + (size_t)(((b * 4 + cg - 4) * 32 + st) * 2) * 8192 + (size_t)idx * 8) = v; }
                if (tid < 256) {
                    float sm = 0.f;
#pragma unroll
                    for (int i = 0; i < 8; ++i) { const u32x4 v = *(const LAS u32x4*)(kt + tid * 144 + i * 16);
                        sm += (bflo(v.x) + bfhi(v.x)) + (bflo(v.y) + bfhi(v.y)) + (bflo(v.z) + bfhi(v.z)) + (bflo(v.w) + bfhi(v.w)); }
                    ((float*)(ws + MS_NST))[(size_t)((b * 4 + cg - 4) * 32 + st) * 256 + tid] = sm; }
            }
        } else if (u < 1280) {
            const int j = u - 1024, b = j >> 6, n = (j >> 3) & 7, h = j & 7;
            const bf16* KA = (const bf16*)(ws + WS_KA) + (size_t)(b * SEQ + n * 256 + wave * 32) * 1024 + h * 128 + 2 * lane;
            float s0 = 0.f, s1 = 0.f;
            unsigned xr[32];
#pragma unroll
            for (int r = 0; r < 32; ++r) xr[r] = *(const unsigned*)(KA + (size_t)r * 1024);
#pragma unroll
            for (int r = 0; r < 32; r += 8) asm volatile("" : "+v"(xr[r]), "+v"(xr[r + 1]), "+v"(xr[r + 2]), "+v"(xr[r + 3]), "+v"(xr[r + 4]), "+v"(xr[r + 5]), "+v"(xr[r + 6]), "+v"(xr[r + 7]));
#pragma unroll
            for (int r = 0; r < 32; ++r) { s0 += bflo(xr[r]); s1 += bfhi(xr[r]); }
            LAS float* part = (LAS float*)lds;
            part[wave * 128 + 2 * lane] = s0; part[wave * 128 + 2 * lane + 1] = s1;
            __syncthreads();
            if (tid < 128) { float t = 0.f;
#pragma unroll
                for (int w = 0; w < 8; ++w) t += part[w * 128 + tid];
                ((float*)(ws + MS_KMEAN))[(size_t)((b * 8 + h) * 8 + n) * 128 + tid] = t * (1.0f / 256.0f); }
        }
        __syncthreads();
    }
}

#undef CONV_LOAD
__device__ __forceinline__ void mlstm_ab_task(unsigned char* ws, int gw, int lane, const bool do_store = true) {
    const int bh = gw >> 7, piece = gw & 127, e0 = (piece >> 3) * 16, d0 = (piece & 7) * 32, q16 = lane & 15, g = lane >> 4;
    const bf16* ka = (const bf16*)(ws + WS_KMT) + (size_t)bh * 32 * 16384 + (size_t)(d0 >> 4) * 512 + lane * 8;
    const bf16* vb = (const bf16*)(ws + WS_VMT) + (size_t)bh * 32 * 16384 + (size_t)(e0 >> 4) * 512 + lane * 8;
    const float* DEC = (const float*)(ws + MS_DEC) + bh * 32;
    bf16* CST = (bf16*)(ws + WS_CST) + (size_t)bh * 32 * 65536 + (size_t)((d0 >> 5) * 16 + (e0 >> 4)) * 512 + (size_t)(((g >> 1) * 16 + q16) * 8 + 4 * (g & 1));
    f32x4 acc[2]; acc[0] = (f32x4){0.f, 0.f, 0.f, 0.f}; acc[1] = acc[0];
    const int decv = __builtin_bit_cast(int, DEC[lane & 31]);
    bf16x8 A0[2][2], B0[2], A1[2][2], B1[2], A2[2][2], B2[2], A3[2][2], B3[2], A4[2][2], B4[2];
#define AB_LOAD(c_, A_, B_) do { const int cc_ = (c_) < 31 ? (c_) : 31; _Pragma("unroll") for (int ks = 0; ks < 2; ++ks) { \
        A_[0][ks] = *(const bf16x8*)(ka + (size_t)cc_ * 16384 + ks * 8192); A_[1][ks] = *(const bf16x8*)(ka + (size_t)cc_ * 16384 + ks * 8192 + 512); B_[ks] = *(const bf16x8*)(vb + (size_t)cc_ * 16384 + ks * 8192); } } while (0)
#define AB_STEP(c_, A_, B_) do { \
        if (do_store) { _Pragma("unroll") for (int f = 0; f < 2; ++f) { u32x2 w; w.x = cvt_pk_bf16(acc[f][0], acc[f][1]); w.y = cvt_pk_bf16(acc[f][2], acc[f][3]); *(u32x2*)(CST + (size_t)(c_) * 65536 + 256 * f) = w; } } \
        const float dec = __builtin_bit_cast(float, __builtin_amdgcn_readlane(decv, (c_))); \
        acc[0] = acc[0] * dec; acc[1] = acc[1] * dec; \
        _Pragma("unroll") for (int ks = 0; ks < 2; ++ks) { \
            acc[0] = __builtin_amdgcn_mfma_f32_16x16x32_bf16(A_[0][ks], B_[ks], acc[0], 0, 0, 0); \
            acc[1] = __builtin_amdgcn_mfma_f32_16x16x32_bf16(A_[1][ks], B_[ks], acc[1], 0, 0, 0); } } while (0)
    AB_LOAD(0, A0, B0); AB_LOAD(1, A1, B1); AB_LOAD(2, A2, B2); AB_LOAD(3, A3, B3); AB_LOAD(4, A4, B4);
#pragma unroll 1
    for (int c = 0; c < 30; c += 5) {
        AB_STEP(c, A0, B0); AB_LOAD(c + 5, A0, B0);
        AB_STEP(c + 1, A1, B1); AB_LOAD(c + 6, A1, B1);
        AB_STEP(c + 2, A2, B2); AB_LOAD(c + 7, A2, B2);
        AB_STEP(c + 3, A3, B3); AB_LOAD(c + 8, A3, B3);
        AB_STEP(c + 4, A4, B4); AB_LOAD(c + 9, A4, B4);
    }
    AB_STEP(30, A0, B0); AB_STEP(31, A1, B1);
    if (!do_store) asm volatile("" :: "v"(acc[0]), "v"(acc[1]));
#undef AB_LOAD
#undef AB_STEP
}

__device__ __forceinline__ void nscan_task(unsigned char* ws, int t, int lane) {
    const int bh = t >> 2, d = (t & 3) * 64 + lane;
    const float* cs = (const float*)(ws + MS_NST) + (size_t)bh * 32 * 256 + d;
    float* nv = (float*)(ws + MS_NVEC) + (size_t)bh * 32 * 256 + d;
    const int decv = __builtin_bit_cast(int, ((const float*)(ws + MS_DEC))[bh * 32 + (lane & 31)]);
    float v[32];
#pragma unroll
    for (int j = 0; j < 32; ++j) v[j] = cs[j * 256];
    float n = 0.f;
#pragma unroll
    for (int j = 0; j < 32; ++j) { nv[j * 256] = n; n = __builtin_bit_cast(float, __builtin_amdgcn_readlane(decv, j)) * n + v[j]; }
}

__device__ __forceinline__ int rel_bucket_dev(int n) {
    if (n < 16) return n;
    int b = 16;
    b += (n >= 19); b += (n >= 21); b += (n >= 24); b += (n >= 27); b += (n >= 31); b += (n >= 35); b += (n >= 40); b += (n >= 46);
    b += (n >= 52); b += (n >= 59); b += (n >= 67); b += (n >= 77); b += (n >= 87); b += (n >= 99); b += (n >= 113);
    return b;
}
constexpr int AT_KT = 0, AT_VT = 34816, AT_TAB = 71680, AT_SEL = 72704, AT_TILES = 73216, AT_CTL = 73600, AT_KM = 73728;
__device__ __forceinline__ void attn_unit(ArgsP a, LAS unsigned char* lds, int uidx, int tid, int lane, int wave) {
    unsigned char* ws = a->ws;
    const int u256 = uidx & 255, second = uidx >> 8, bh = u256 >> 3, kk8 = u256 & 7, si = second ? 15 - kk8 : kk8, wgt = 16 - si;
    const int blk = (wgt - 1) >> 1, half = (wgt - 1) & 1, b = bh >> 3, h = bh & 7, q0 = blk * 256 + half * 128;
    const int q16 = lane & 15, g = lane >> 4;
    LAS float* tab = (LAS float*)(lds + AT_TAB); LAS unsigned* sels = (LAS unsigned*)(lds + AT_SEL); LAS int* tiles = (LAS int*)(lds + AT_TILES);
    LAS unsigned* ctl = (LAS unsigned*)(lds + AT_CTL); LAS float* kms = (LAS float*)(lds + AT_KM);
    const bf16* QA = (const bf16*)(ws + WS_QA); const bf16* KA = (const bf16*)(ws + WS_KA); const bf16* VAT = (const bf16*)(ws + WS_VAT);
    u32x4 sr[8], qst[4];
    const int row0 = tid >> 4, ch = tid & 15;
    const bf16* kbase = KA + (size_t)(b * SEQ + row0) * 1024 + h * 128 + ch * 8;
    const bf16* vbase = VAT + (size_t)(bh * 128 + row0) * 2048 + ch * 8;
#define AT_LOAD(ks0_) do { _Pragma("unroll") for (int i = 0; i < 4; ++i) { \
        sr[i] = *(const u32x4*)(kbase + (size_t)((ks0_) + 32 * i) * 1024); sr[4 + i] = *(const u32x4*)(vbase + (size_t)(32 * i) * 2048 + (ks0_)); } } while (0)
#pragma unroll
    for (int i = 0; i < 4; ++i) qst[i] = *(const u32x4*)(QA + (size_t)(b * SEQ + q0 + row0 + 32 * i) * 1024 + h * 128 + ch * 8);
    AT_LOAD(blk * 256);
    if (tid <= 128) tab[tid] = a->in[I_RELB][rel_bucket_dev(tid) * 8 + h] * 1.4426950408889634f;
    for (int idx = tid; idx < 1024; idx += NTHR) kms[idx] = ((const float*)(ws + MS_KMEAN))[bh * 1024 + idx];
    if (tid == 0) ctl[0] = 0u;
    __syncthreads();
    {
        const int q = tid >> 2, part = tid & 3;
        const bf16* qp = QA + (size_t)(b * SEQ + q0 + q) * 1024 + h * 128 + part * 32;
        float qf32[32];
#pragma unroll
        for (int i = 0; i < 4; ++i) { const u32x4 v = *(const u32x4*)(qp + 8 * i);
            qf32[8 * i + 0] = bflo(v.x); qf32[8 * i + 1] = bfhi(v.x); qf32[8 * i + 2] = bflo(v.y); qf32[8 * i + 3] = bfhi(v.y);
            qf32[8 * i + 4] = bflo(v.z); qf32[8 * i + 5] = bfhi(v.z); qf32[8 * i + 6] = bflo(v.w); qf32[8 * i + 7] = bfhi(v.w); }
        float gate[8];
#pragma unroll
        for (int n = 0; n < 8; ++n) { float s = 0.f;
            if (n < blk) {
#pragma unroll
                for (int d = 0; d < 32; d += 4) { const f32x4 kv = *(const LAS f32x4*)(kms + n * 128 + part * 32 + d);
                    s += (qf32[d] * kv.x + qf32[d + 1] * kv.y) + (qf32[d + 2] * kv.z + qf32[d + 3] * kv.w); }
            }
            s += __shfl_xor(s, 1); s += __shfl_xor(s, 2); gate[n] = s; }
        if (part == 0) {
            unsigned sel;
            if (blk <= 3) sel = (1u << blk) - 1u;
            else { sel = 0u;
#pragma unroll
                for (int it = 0; it < 3; ++it) { int best = 0; float bv = -3.0e38f;
#pragma unroll
                    for (int n = 0; n < 8; ++n) if (n < blk && !((sel >> n) & 1u) && gate[n] > bv) { bv = gate[n]; best = n; }
                    sel |= 1u << best; } }
            sels[q] = sel; atomicOr((unsigned*)ctl, sel);
        }
    }
    __syncthreads();
    if (tid == 0) { int nt = 0; const unsigned any = ctl[0];
        for (int j = 0; j < half + 1; ++j) tiles[nt++] = blk * 256 + 128 * j;
        for (int n = 0; n < blk; ++n) if ((any >> n) & 1u) for (int j = 0; j < 2; ++j) tiles[nt++] = n * 256 + 128 * j;
        ctl[1] = (unsigned)nt; }
    __syncthreads();
    const int ntiles = (int)ctl[1];
    const int qg = wave & 3, kp = wave >> 2;
    int qpos[2]; unsigned mysel[2];
#pragma unroll
    for (int f = 0; f < 2; ++f) { qpos[f] = q0 + 32 * qg + 16 * f + q16; mysel[f] = sels[32 * qg + 16 * f + q16]; }
    constexpr int AT_Q = 77824;
#pragma unroll
    for (int i = 0; i < 4; ++i) *(LAS u32x4*)(lds + AT_Q + (row0 + 32 * i) * 272 + ch * 16) = qst[i];
    const LAS unsigned char* qrow = lds + AT_Q + (32 * qg + q16) * 272 + 16 * g;
    float m_run[2] = {-1.0e30f, -1.0e30f}, l_run[2] = {0.f, 0.f};
    f32x4 oacc[2][8];
#pragma unroll
    for (int f = 0; f < 2; ++f)
#pragma unroll
        for (int m = 0; m < 8; ++m) oacc[f][m] = (f32x4){0.f, 0.f, 0.f, 0.f};
    const int vpos = (ch >> 2) * 32 + 16 * (ch & 1) + 4 * ((ch & 3) >> 1);
#define AT_WRITE() do { _Pragma("unroll") for (int i = 0; i < 4; ++i) { \
        *(LAS u32x4*)(lds + AT_KT + (row0 + 32 * i) * 272 + ch * 16) = sr[i]; \
        *(LAS u32x2*)(lds + AT_VT + (row0 + 32 * i) * 272 + vpos * 2) = (u32x2){sr[4 + i].x, sr[4 + i].y}; \
        *(LAS u32x2*)(lds + AT_VT + (row0 + 32 * i) * 272 + (vpos + 8) * 2) = (u32x2){sr[4 + i].z, sr[4 + i].w}; } } while (0)
    AT_WRITE();
    __syncthreads();
    if (ntiles > 1) { const int k1 = tiles[1]; AT_LOAD(k1); }
    for (int ti = 0; ti < ntiles; ++ti) {
        const int kstart = tiles[ti] + 64 * kp, nblk = kstart >> 8;
        const bool own = (nblk == blk);
        const bool any_ok = own ? true : (__any((((mysel[0] | mysel[1]) >> nblk) & 1u) != 0u) != 0);
        const bool active = own ? (kstart <= q0 + 32 * qg + 31) : any_ok;
        if (active) {
            const LAS unsigned char* kt = lds + AT_KT + 64 * kp * 272; const LAS unsigned char* vt = lds + AT_VT + 64 * kp * 2;
            f32x4 s[2][4];
#pragma unroll
            for (int n = 0; n < 4; ++n) { s[0][n] = (f32x4){0.f, 0.f, 0.f, 0.f}; s[1][n] = s[0][n]; }
#pragma unroll
            for (int ks = 0; ks < 4; ++ks) {
                bf16x8 q0f = *(const LAS bf16x8*)(qrow + 64 * ks), q1f = *(const LAS bf16x8*)(qrow + 16 * 272 + 64 * ks);
                bf16x8 kf[4];
#pragma unroll
                for (int n = 0; n < 4; ++n) kf[n] = *(const LAS bf16x8*)(kt + (16 * n + q16) * 272 + (32 * ks + 8 * g) * 2);
                asm volatile("" : "+v"(q0f), "+v"(q1f), "+v"(kf[0]), "+v"(kf[1]), "+v"(kf[2]), "+v"(kf[3]));
#pragma unroll
                for (int n = 0; n < 4; ++n) {
                    s[0][n] = __builtin_amdgcn_mfma_f32_16x16x32_bf16(kf[n], q0f, s[0][n], 0, 0, 0);
                    s[1][n] = __builtin_amdgcn_mfma_f32_16x16x32_bf16(kf[n], q1f, s[1][n], 0, 0, 0); } }
            const bool far = ((q0 + 32 * qg) - (kstart + 63)) >= 128;
            const float bfar = tab[128];
#pragma unroll
            for (int f = 0; f < 2; ++f) {
                const bool lane_ok = own ? true : (((mysel[f] >> nblk) & 1u) != 0u);
                float psum = 0.f, m_new;
#define AT_MNEW(mx_) fmaxf(((mx_) > m_run[f] + 8.0f) ? (mx_) : m_run[f], -1.0e29f)
                if (far) {
                    const float addc = lane_ok ? bfar : -1.0e30f;
                    float mx = -1.0e30f;
#pragma unroll
                    for (int n = 0; n < 4; ++n)
#pragma unroll
                        for (int r = 0; r < 4; ++r) mx = fmaxf(mx, s[f][n][r]);
                    mx = rows4_max(mx + addc);
                    m_new = AT_MNEW(mx);
                    const float cc = addc - m_new;
#pragma unroll
                    for (int n = 0; n < 4; ++n)
#pragma unroll
                        for (int r = 0; r < 4; ++r) { const float p = __builtin_amdgcn_exp2f(s[f][n][r] + cc); s[f][n][r] = p; psum += p; }
                } else {
                    const int kmax = lane_ok ? (own ? qpos[f] : 0x7fffffff) : -1;
                    float mx = -1.0e30f;
                    float bs[4][4];
#pragma unroll
                    for (int n = 0; n < 4; ++n)
#pragma unroll
                        for (int r = 0; r < 4; ++r) { int di = qpos[f] - (kstart + 16 * n + 4 * g + r); di = di < 0 ? 0 : di; di = di > 128 ? 128 : di; bs[n][r] = tab[di]; }
#pragma unroll
                    for (int n = 0; n < 4; ++n) asm volatile("" : "+v"(bs[n][0]), "+v"(bs[n][1]), "+v"(bs[n][2]), "+v"(bs[n][3]));
#pragma unroll
                    for (int n = 0; n < 4; ++n)
#pragma unroll
                        for (int r = 0; r < 4; ++r) { const int key = kstart + 16 * n + 4 * g + r;
                            const float v = (key <= kmax) ? s[f][n][r] + bs[n][r] : -1.0e30f;
                            s[f][n][r] = v; mx = fmaxf(mx, v); }
                    mx = rows4_max(mx);
                    m_new = AT_MNEW(mx);
#pragma unroll
                    for (int n = 0; n < 4; ++n)
#pragma unroll
                        for (int r = 0; r < 4; ++r) { const float p = __builtin_amdgcn_exp2f(s[f][n][r] - m_new); s[f][n][r] = p; psum += p; }
                }
#undef AT_MNEW
                const float alpha = __builtin_amdgcn_exp2f(m_run[f] - m_new);
                psum = rows4_sum(psum);
                l_run[f] = l_run[f] * alpha + psum;
                if (__any(m_new != m_run[f])) {
#pragma unroll
                    for (int m = 0; m < 8; ++m) oacc[f][m] = oacc[f][m] * alpha;
                }
                m_run[f] = m_new;
            }
#pragma unroll
            for (int k2 = 0; k2 < 2; ++k2) {
                bf16x8 pf[2];
#pragma unroll
                for (int f = 0; f < 2; ++f) { u32x4 pb; pb.x = cvt_pk_bf16(s[f][2 * k2][0], s[f][2 * k2][1]); pb.y = cvt_pk_bf16(s[f][2 * k2][2], s[f][2 * k2][3]);
                    pb.z = cvt_pk_bf16(s[f][2 * k2 + 1][0], s[f][2 * k2 + 1][1]); pb.w = cvt_pk_bf16(s[f][2 * k2 + 1][2], s[f][2 * k2 + 1][3]);
                    pf[f] = __builtin_bit_cast(bf16x8, pb); }
#pragma unroll
                for (int mh = 0; mh < 2; ++mh) {
                    bf16x8 af[4];
#pragma unroll
                    for (int m = 0; m < 4; ++m) af[m] = *(const LAS bf16x8*)(vt + (16 * (4 * mh + m) + q16) * 272 + (32 * k2 + 8 * g) * 2);
                    asm volatile("" : "+v"(af[0]), "+v"(af[1]), "+v"(af[2]), "+v"(af[3]));
#pragma unroll
                    for (int m = 0; m < 4; ++m) {
                        oacc[0][4 * mh + m] = __builtin_amdgcn_mfma_f32_16x16x32_bf16(af[m], pf[0], oacc[0][4 * mh + m], 0, 0, 0);
                        oacc[1][4 * mh + m] = __builtin_amdgcn_mfma_f32_16x16x32_bf16(af[m], pf[1], oacc[1][4 * mh + m], 0, 0, 0); } }
            }
        }
        __syncthreads();
        if (ti + 1 < ntiles) { AT_WRITE(); }
        __syncthreads();
        if (ti + 2 < ntiles) { const int kn = tiles[ti + 2]; AT_LOAD(kn); }
    }
    LAS float* mo = (LAS float*)lds; LAS float* ml = (LAS float*)(lds + 65536);
    if (kp == 1) {
#pragma unroll
        for (int f = 0; f < 2; ++f) {
#pragma unroll
            for (int m = 0; m < 8; ++m)
#pragma unroll
                for (int r = 0; r < 4; ++r) mo[((qg * 2 + f) * 8 + m) * 256 + r * 64 + lane] = oacc[f][m][r];
            ml[(qg * 2 + f) * 128 + lane] = m_run[f]; ml[(qg * 2 + f) * 128 + 64 + lane] = l_run[f]; }
    }
    __syncthreads();
    if (kp == 0) {
#pragma unroll
        for (int f = 0; f < 2; ++f) {
            const float m1 = ml[(qg * 2 + f) * 128 + lane], l1 = ml[(qg * 2 + f) * 128 + 64 + lane];
            const float mm = fmaxf(m_run[f], m1), a0 = __builtin_amdgcn_exp2f(m_run[f] - mm), a1 = __builtin_amdgcn_exp2f(m1 - mm);
            const float inv = __builtin_amdgcn_rcpf(l_run[f] * a0 + l1 * a1);
            bf16* HA = (bf16*)(ws + WS_HA) + (size_t)(b * SEQ + qpos[f]) * 1024 + h * 128 + 4 * g;
#pragma unroll
            for (int m = 0; m < 8; ++m) { float o[4];
#pragma unroll
                for (int r = 0; r < 4; ++r) o[r] = (oacc[f][m][r] * a0 + mo[((qg * 2 + f) * 8 + m) * 256 + r * 64 + lane] * a1) * inv;
                u32x2 w; w.x = cvt_pk_bf16(o[0], o[1]); w.y = cvt_pk_bf16(o[2], o[3]); *(u32x2*)(HA + 16 * m) = w; }
        }
    }
#undef AT_LOAD
#undef AT_WRITE
}

constexpr int MC_Q = 0, MC_K = 33792, MC_SP = 67584, MC_SC = 76800, MC_NV = 79104;
struct McRegs { u32x4 qr[4], kr[4]; float sc4[4]; float nv0; bf16x8 cb[8][2], vbf[2][2]; u32x2 ovv[8]; };
__device__ __forceinline__ void mc_load_qk(McRegs& R, const unsigned char* ws, int u, int tid) {
    const int bh = u >> 5, c = u & 31, b = bh >> 2, h = bh & 3; const size_t tok0 = (size_t)b * SEQ + 64 * c;
    const bf16* QM = (const bf16*)(ws + WS_QM); const bf16* KM = (const bf16*)(ws + WS_KM);
#pragma unroll
    for (int i = 0; i < 4; ++i) { const int idx = tid + NTHR * i, row = idx >> 5, ch = idx & 31;
        R.qr[i] = *(const u32x4*)(QM + (tok0 + row) * 1024 + h * 256 + ch * 8); R.kr[i] = *(const u32x4*)(KM + (tok0 + row) * 1024 + h * 256 + ch * 8); }
}
__device__ __forceinline__ void mc_load_sc(McRegs& R, const unsigned char* ws, int u, int tid) {
    const int bh = u >> 5, c = u & 31; const int s = bh * 2048 + 64 * c + (tid & 63);
    R.sc4[0] = ((const float*)(ws + MS_AS))[s]; R.sc4[1] = ((const float*)(ws + MS_GT))[s]; R.sc4[2] = ((const float*)(ws + MS_WI))[s]; R.sc4[3] = ((const float*)(ws + MS_CL))[s];
    R.nv0 = ((const float*)(ws + MS_NVEC))[(size_t)(bh * 32 + c) * 256 + (tid & 255)];
}
__device__ __forceinline__ void mc_load_cb(McRegs& R, const unsigned char* ws, int u, int lane, int wave) {
    const bf16* Cp = (const bf16*)(ws + WS_CST) + (size_t)u * 65536 + (size_t)(2 * wave) * 512 + lane * 8;
#pragma unroll
    for (int ks = 0; ks < 8; ++ks) { R.cb[ks][0] = *(const bf16x8*)(Cp + ks * 8192); R.cb[ks][1] = *(const bf16x8*)(Cp + ks * 8192 + 512); }
}
__device__ __forceinline__ void mc_load_v(McRegs& R, const unsigned char* ws, int u, int lane, int wave) {
    const bf16* Vp = (const bf16*)(ws + WS_VMT) + (size_t)u * 16384 + (size_t)(2 * wave) * 512 + lane * 8;
#pragma unroll
    for (int ks = 0; ks < 2; ++ks) { R.vbf[ks][0] = *(const bf16x8*)(Vp + ks * 8192); R.vbf[ks][1] = *(const bf16x8*)(Vp + ks * 8192 + 512); }
}
__device__ __forceinline__ void mc_load_ov(McRegs& R, const unsigned char* ws, int u, int lane, int wave) {
    const int bh = u >> 5, c = u & 31, b = bh >> 2, h = bh & 3; const size_t tok0 = (size_t)b * SEQ + 64 * c;
    const bf16* OM = (const bf16*)(ws + WS_OM);
#pragma unroll
    for (int i = 0; i < 8; ++i) R.ovv[i] = *(const u32x2*)(OM + (tok0 + 8 * wave + i) * 1024 + h * 256 + 4 * lane);
}
template <bool PF, bool HAVE>
__device__ __forceinline__ void mlstm_c_body(ArgsP a, int l, LAS unsigned char* lds, int u, int un, McRegs& R, int tid_, int lane_, int wave) {
    unsigned char* ws = a->ws;
    int tid = wave * 64 + lane_id(); asm volatile("" : "+v"(tid));
    const int lane = tid & 63; (void)tid_; (void)lane_;
    const int bh = u >> 5, c = u & 31, b = bh >> 2, h = bh & 3, t0 = 64 * c, q16 = lane & 15, g = lane >> 4;
    const size_t tok0 = (size_t)b * SEQ + t0;
    LAS unsigned char* Qs = lds + MC_Q; LAS unsigned char* Ks = lds + MC_K; LAS unsigned char* Sp = lds + MC_SP;
    LAS float* sc = (LAS float*)(lds + MC_SC); LAS float* as_ = sc; LAS float* gt_ = sc + 64; LAS float* wi_ = sc + 128; LAS float* cl_ = sc + 192; LAS float* qn_ = sc + 256; LAS float* denp = sc + 320;
    LAS float* nvec = (LAS float*)(lds + MC_NV);
    mc_load_qk(R, ws, u, tid); mc_load_sc(R, ws, u, tid);
    if (!HAVE) mc_load_cb(R, ws, u, lane, wave);
#pragma unroll
    for (int i = 0; i < 4; ++i) { const int idx = tid + NTHR * i, row = idx >> 5, ch = idx & 31;
        *(LAS u32x4*)(Qs + row * 528 + ch * 16) = R.qr[i]; *(LAS u32x4*)(Ks + row * 528 + ch * 16) = R.kr[i]; }
    mc_load_v(R, ws, u, lane, wave);
    if (tid < 64) { as_[tid] = R.sc4[0]; gt_[tid] = R.sc4[1]; wi_[tid] = R.sc4[2]; cl_[tid] = R.sc4[3]; }
    if (tid < 256) nvec[tid] = R.nv0;
    __syncthreads();
    f32x4 acc[4][2];
#pragma unroll
    for (int m = 0; m < 4; ++m) { acc[m][0] = (f32x4){0.f, 0.f, 0.f, 0.f}; acc[m][1] = acc[m][0]; }
    if (c > 0) {
#pragma unroll
        for (int ks = 0; ks < 8; ++ks) {
#pragma unroll
            for (int m = 0; m < 4; ++m) { const bf16x8 af = *(const LAS bf16x8*)(Qs + (16 * m + q16) * 528 + (32 * ks + 8 * g) * 2);
                acc[m][0] = __builtin_amdgcn_mfma_f32_16x16x32_bf16(af, R.cb[ks][0], acc[m][0], 0, 0, 0);
                acc[m][1] = __builtin_amdgcn_mfma_f32_16x16x32_bf16(af, R.cb[ks][1], acc[m][1], 0, 0, 0); }
        }
#pragma unroll
        for (int m = 0; m < 4; ++m)
#pragma unroll
            for (int r = 0; r < 4; ++r) { const float w = wi_[16 * m + 4 * g + r]; acc[m][0][r] *= w; acc[m][1][r] *= w; }
    }
    {
        const int mS = wave & 3, nS0 = 2 * (wave >> 2);
        f32x4 sacc[2]; sacc[0] = (f32x4){0.f, 0.f, 0.f, 0.f}; sacc[1] = sacc[0];
#pragma unroll
        for (int kh = 0; kh < 4; ++kh) {
            bf16x8 af[2], bq[2][2];
#pragma unroll
            for (int k2 = 0; k2 < 2; ++k2) { const int ks = 2 * kh + k2;
                af[k2] = *(const LAS bf16x8*)(Qs + (16 * mS + q16) * 528 + (32 * ks + 8 * g) * 2);
#pragma unroll
                for (int nn = 0; nn < 2; ++nn) bq[k2][nn] = *(const LAS bf16x8*)(Ks + (16 * (nS0 + nn) + q16) * 528 + (32 * ks + 8 * g) * 2); }
            asm volatile("" : "+v"(af[0]), "+v"(af[1]), "+v"(bq[0][0]), "+v"(bq[0][1]), "+v"(bq[1][0]), "+v"(bq[1][1]));
#pragma unroll
            for (int k2 = 0; k2 < 2; ++k2)
#pragma unroll
                for (int nn = 0; nn < 2; ++nn) sacc[nn] = __builtin_amdgcn_mfma_f32_16x16x32_bf16(af[k2], bq[k2][nn], sacc[nn], 0, 0, 0);
        }
#pragma unroll
        for (int nn = 0; nn < 2; ++nn) { const int s = 16 * (nS0 + nn) + q16; const float av = as_[s];
#pragma unroll
            for (int r = 0; r < 4; ++r) { const int t = 16 * mS + 4 * g + r;
                float val = (s <= t) ? sacc[nn][r] * __expf(av - gt_[t]) : 0.f;
                *(LAS unsigned short*)(Sp + t * 144 + s * 2) = (unsigned short)(cvt_pk_bf16(val, val) & 0xffffu);
                val += __shfl_xor(val, 1); val += __shfl_xor(val, 2); val += __shfl_xor(val, 4); val += __shfl_xor(val, 8);
                if (q16 == 0) denp[(nS0 + nn) * 64 + t] = val; } }
    }
    {
        const int t = tid >> 3, seg = tid & 7; float s = 0.f;
#pragma unroll
        for (int i = 0; i < 4; ++i) { const u32x4 v = *(const LAS u32x4*)(Qs + t * 528 + (seg * 32 + 8 * i) * 2); const LAS float* nv = nvec + seg * 32 + 8 * i;
            s += bflo(v.x) * nv[0] + bfhi(v.x) * nv[1] + bflo(v.y) * nv[2] + bfhi(v.y) * nv[3] + bflo(v.z) * nv[4] + bfhi(v.z) * nv[5] + bflo(v.w) * nv[6] + bfhi(v.w) * nv[7]; }
        s += __shfl_xor(s, 1); s += __shfl_xor(s, 2); s += __shfl_xor(s, 4);
        if (seg == 0) qn_[t] = s;
    }
    __syncthreads();
    if (PF) {
#pragma unroll
        for (int ks = 0; ks < 8; ++ks) asm volatile("" :: "v"(R.cb[ks][0]), "v"(R.cb[ks][1]));
        __builtin_amdgcn_sched_barrier(0);
        mc_load_cb(R, ws, un, lane, wave);
        __builtin_amdgcn_sched_barrier(0);
    }
    {
#pragma unroll
        for (int ks = 0; ks < 2; ++ks) {
            bf16x8 sf[4];
#pragma unroll
            for (int m = 0; m < 4; ++m) sf[m] = *(const LAS bf16x8*)(Sp + (16 * m + q16) * 144 + (32 * ks + 8 * g) * 2);
            asm volatile("" : "+v"(sf[0]), "+v"(sf[1]), "+v"(sf[2]), "+v"(sf[3]));
#pragma unroll
            for (int m = 0; m < 4; ++m) {
                acc[m][0] = __builtin_amdgcn_mfma_f32_16x16x32_bf16(sf[m], R.vbf[ks][0], acc[m][0], 0, 0, 0);
                acc[m][1] = __builtin_amdgcn_mfma_f32_16x16x32_bf16(sf[m], R.vbf[ks][1], acc[m][1], 0, 0, 0); }
        }
    }
    LAS float* NUM = (LAS float*)lds;
#pragma unroll
    for (int m = 0; m < 4; ++m)
#pragma unroll
        for (int r = 0; r < 4; ++r) { const int t = 16 * m + 4 * g + r;
            const float den = (denp[t] + denp[64 + t]) + (denp[128 + t] + denp[192 + t]) + wi_[t] * qn_[t];
            const float inv = __builtin_amdgcn_rcpf(fmaxf(fabsf(den), cl_[t]));
            NUM[t * 260 + 32 * wave + q16] = acc[m][0][r] * inv; NUM[t * 260 + 32 * wave + 16 + q16] = acc[m][1][r] * inv; }
    __syncthreads();
    {
        const float* mg = a->in[I_MNG] + l * 1024 + h * 256 + 4 * lane; const f32x4 gn = *(const f32x4*)mg;
        bf16* HM = (bf16*)(ws + WS_HM);
        mc_load_ov(R, ws, u, lane, wave);
        asm volatile("" : "+v"(R.ovv[0]), "+v"(R.ovv[1]), "+v"(R.ovv[2]), "+v"(R.ovv[3]), "+v"(R.ovv[4]), "+v"(R.ovv[5]), "+v"(R.ovv[6]), "+v"(R.ovv[7]));
#pragma unroll
        for (int i = 0; i < 8; ++i) { const int t = 8 * wave + i;
            const f32x4 v = *(const LAS f32x4*)(NUM + t * 260 + 4 * lane);
            const float mu = wave_sum((v.x + v.y) + (v.z + v.w)) * (1.0f / 256.0f);
            const f32x4 d = v - mu;
            const float var = wave_sum((d.x * d.x + d.y * d.y) + (d.z * d.z + d.w * d.w)) * (1.0f / 256.0f);
            const float rstd = __builtin_amdgcn_rsqf(var + LN_EPS);
            const u32x2 ov = R.ovv[i];
            u32x2 w; w.x = cvt_pk_bf16(d.x * rstd * gn.x * bflo(ov.x), d.y * rstd * gn.y * bfhi(ov.x)); w.y = cvt_pk_bf16(d.z * rstd * gn.z * bflo(ov.y), d.w * rstd * gn.w * bfhi(ov.y));
            *(u32x2*)(HM + (tok0 + t) * 1024 + h * 256 + 4 * lane) = w; }
    }
    __syncthreads();
}
__device__ __forceinline__ void mlstm_c_phase(ArgsP a, int l, LAS unsigned char* lds, int tid, int lane, int wave, int bid, int G) {
    int u = bid; if (u >= 512) return;
    McRegs R;
    if (u + G < 512 && u + 2 * G >= 512) {
        mlstm_c_body<true, false>(a, l, lds, u, u + G, R, tid, lane, wave);
        mlstm_c_body<false, true>(a, l, lds, u + G, u + G, R, tid, lane, wave);
    } else {
#pragma unroll 1
        for (; u < 512; u += G) mlstm_c_body<false, false>(a, l, lds, u, u, R, tid, lane, wave);
    }
}

struct SchedStd {
    static constexpr bool GATHER = false;
    const char* A; const char* B; int nM, nN, K, G, c;
    __device__ __forceinline__ bool next(int i, Unit& u) const { const int L = i * G + c; if (L >= nM * nN) return false; pg8::static_tile(L, nM, nN, u.pm, u.pn); u.aux = 0; return true; }
    __device__ __forceinline__ const char* abase(const Unit& u) const { return A + (size_t)u.pm * 512 * K; }
    __device__ __forceinline__ const char* bbase(const Unit& u) const { return B + (size_t)u.pn * 512 * K; }
    __device__ __forceinline__ unsigned arow(const Unit&, int) const { return 0u; }
    static __device__ __forceinline__ bool keep_acc(const Unit&) { return false; }
};
struct SchedBr {
    static constexpr bool GATHER = false;
    const char* HM; const char* HA; const char* WM; const char* WA; int G, c;
    __device__ __forceinline__ bool next(int i, Unit& u) const { const int L = (i >> 1) * G + c; if (L >= 256) return false; pg8::static_tile(L, 32, 8, u.pm, u.pn); u.aux = i & 1; return true; }
    __device__ __forceinline__ const char* abase(const Unit& u) const { return (u.aux ? HA : HM) + (size_t)u.pm * 512 * 1024; }
    __device__ __forceinline__ const char* bbase(const Unit& u) const { return (u.aux ? WA : WM) + (size_t)u.pn * 512 * 1024; }
    __device__ __forceinline__ unsigned arow(const Unit&, int) const { return 0u; }
    static __device__ __forceinline__ bool keep_acc(const Unit& u) { return u.aux == 0; }
};
struct EpiBr {
    static constexpr bool PERM = true;
    const bf16* SG; bf16* Y;
    __device__ __forceinline__ void operator()(f32x4 (&acc)[2][2][4][2], const Unit& u, int wr, int wc, int fr, int fq) const {
        const int row0 = u.pm * 256 + wr * 64 + fr, col0 = u.pn * 256 + wc * 32 + 8 * fq;
#pragma unroll
        for (int ai = 0; ai < 2; ++ai) {
            u32x4 sa[4][2], sm[4][2];
#pragma unroll
            for (int m = 0; m < 4; ++m) { const size_t row = row0 + ai * 128 + m * 16;
#pragma unroll
                for (int bj = 0; bj < 2; ++bj) { const int col = col0 + bj * 128;
                    sa[m][bj] = *(const u32x4*)(SG + row * 4096 + 2048 + col);
                    sm[m][bj] = *(const u32x4*)(SG + row * 4096 + (u.aux == 0 ? 0 : 2048) + col); } }
            asm volatile("" : "+v"(sa[0][0]), "+v"(sa[0][1]), "+v"(sa[1][0]), "+v"(sa[1][1]), "+v"(sa[2][0]), "+v"(sa[2][1]), "+v"(sa[3][0]), "+v"(sa[3][1]),
                              "+v"(sm[0][0]), "+v"(sm[0][1]), "+v"(sm[1][0]), "+v"(sm[1][1]), "+v"(sm[2][0]), "+v"(sm[2][1]), "+v"(sm[3][0]), "+v"(sm[3][1]));
#pragma unroll
            for (int m = 0; m < 4; ++m) { const size_t row = row0 + ai * 128 + m * 16;
#pragma unroll
                for (int bj = 0; bj < 2; ++bj) { const int col = col0 + bj * 128;
                    const u32x4 a4 = sa[m][bj], m4 = sm[m][bj];
                    const float ga[8] = {bflo(a4.x), bfhi(a4.x), bflo(a4.y), bfhi(a4.y), bflo(a4.z), bfhi(a4.z), bflo(a4.w), bfhi(a4.w)};
                    if (u.aux == 0) {
                        const float gm[8] = {bflo(m4.x), bfhi(m4.x), bflo(m4.y), bfhi(m4.y), bflo(m4.z), bfhi(m4.z), bflo(m4.w), bfhi(m4.w)};
#pragma unroll
                        for (int j = 0; j < 4; ++j) { acc[ai][bj][m][0][j] *= gm[j] * __builtin_amdgcn_rcpf(fmaxf(ga[j], 1.0e-30f)); acc[ai][bj][m][1][j] *= gm[4 + j] * __builtin_amdgcn_rcpf(fmaxf(ga[4 + j], 1.0e-30f)); }
                    } else {
                        const f32x4 v0 = acc[ai][bj][m][0], v1 = acc[ai][bj][m][1];
                        u32x4 w; w.x = cvt_pk_bf16(v0[0] * ga[0], v0[1] * ga[1]); w.y = cvt_pk_bf16(v0[2] * ga[2], v0[3] * ga[3]);
                        w.z = cvt_pk_bf16(v1[0] * ga[4], v1[1] * ga[5]); w.w = cvt_pk_bf16(v1[2] * ga[6], v1[3] * ga[7]);
                        *(u32x4*)(Y + row * 2048 + col) = w; }
                } }
        }
    }
};
struct EpiOut {
    static constexpr bool PERM = false;
    const float* res; float* out;
    __device__ __forceinline__ void operator()(f32x4 (&acc)[2][2][4][2], const Unit& u, int wr, int wc, int fr, int fq) const {
        const int row0 = u.pm * 256 + wr * 64 + fr, col0 = u.pn * 256 + wc * 32 + 4 * fq;
#pragma unroll
        for (int ai = 0; ai < 2; ++ai) {
            f32x4 rv[4][2][2];
#pragma unroll
            for (int m = 0; m < 4; ++m) { const size_t ro = (size_t)(row0 + ai * 128 + m * 16) * DM + col0;
#pragma unroll
                for (int bj = 0; bj < 2; ++bj)
#pragma unroll
                    for (int n = 0; n < 2; ++n) rv[m][bj][n] = *(const f32x4*)(res + ro + bj * 128 + n * 16); }
#pragma unroll
            for (int m = 0; m < 4; ++m) asm volatile("" : "+v"(rv[m][0][0]), "+v"(rv[m][0][1]), "+v"(rv[m][1][0]), "+v"(rv[m][1][1]));
#pragma unroll
            for (int m = 0; m < 4; ++m) { const size_t ro = (size_t)(row0 + ai * 128 + m * 16) * DM + col0;
#pragma unroll
                for (int bj = 0; bj < 2; ++bj)
#pragma unroll
                    for (int n = 0; n < 2; ++n) *(f32x4*)(out + ro + bj * 128 + n * 16) = rv[m][bj][n] + acc[ai][bj][m][n]; }
        }
    }
};
struct SchedMoe1 {
    static constexpr bool GATHER = true;
    const char* H; const char* W13; const int* LIST; const LAS int* te; const LAS int* tr0; const LAS int* cnt; int MT, G, c;
    __device__ __forceinline__ bool next(int i, Unit& u) const { const int L = i * G + c; if (L >= 2 * MT) return false; u.pm = L >> 1; u.pn = L & 1; u.aux = __builtin_amdgcn_readfirstlane(te[u.pm]); return true; }
    __device__ __forceinline__ const char* abase(const Unit&) const { return H; }
    __device__ __forceinline__ const char* bbase(const Unit& u) const { return W13 + ((size_t)u.aux * 512 + u.pn * 256) * 4096; }
    static __device__ __forceinline__ bool keep_acc(const Unit&) { return false; }
    __device__ __forceinline__ unsigned arow(const Unit& u, int r) const { const int rr = __builtin_amdgcn_readfirstlane(tr0[u.pm]) + r; return rr < __builtin_amdgcn_readfirstlane(cnt[u.aux]) ? (unsigned)LIST[u.aux * 8192 + rr] : 0u; }
};
struct EpiMoe1 {
    static constexpr bool PERM = true;
    bf16* HID; const float* PWL; const LAS int* tr0; const LAS int* cnt;
    __device__ __forceinline__ void operator()(f32x4 (&acc)[2][2][4][2], const Unit& u, int wr, int wc, int fr, int fq) const {
#pragma unroll
        for (int ai = 0; ai < 2; ++ai)
#pragma unroll
            for (int m = 0; m < 4; ++m) { const int r = ai * 128 + wr * 64 + m * 16 + fr;
                const float pw = 1.0f;
                float o[8];
#pragma unroll
                for (int n = 0; n < 2; ++n)
#pragma unroll
                    for (int j = 0; j < 4; ++j) { const float x1 = acc[ai][0][m][n][j], x3 = acc[ai][1][m][n][j]; o[4 * n + j] = x1 * sigmoidf_(x1) * x3 * pw; }
                u32x4 w; w.x = cvt_pk_bf16(o[0], o[1]); w.y = cvt_pk_bf16(o[2], o[3]); w.z = cvt_pk_bf16(o[4], o[5]); w.w = cvt_pk_bf16(o[6], o[7]);
                *(u32x4*)(HID + (size_t)(u.pm * 256 + r) * 256 + u.pn * 128 + wc * 32 + 8 * fq) = w; }
    }
};
struct SchedMoe2 {
    static constexpr bool GATHER = false;
    const char* HID; const char* W2; const LAS int* te; int MT, G, c;
    __device__ __forceinline__ bool next(int i, Unit& u) const { const int L = i * G + c; if (L >= 8 * MT) return false; u.pm = L >> 3; u.pn = L & 7; u.aux = __builtin_amdgcn_readfirstlane(te[u.pm]); return true; }
    __device__ __forceinline__ const char* abase(const Unit& u) const { return HID + (size_t)u.pm * 256 * 512; }
    __device__ __forceinline__ const char* bbase(const Unit& u) const { return W2 + ((size_t)u.aux * 2048 + u.pn * 256) * 512; }
    __device__ __forceinline__ unsigned arow(const Unit&, int) const { return 0u; }
    static __device__ __forceinline__ bool keep_acc(const Unit&) { return false; }
};
struct EpiMoe2 {
    static constexpr bool PERM = true;
    bf16* OP;
    __device__ __forceinline__ void operator()(f32x4 (&acc)[2][2][4][2], const Unit& u, int wr, int wc, int fr, int fq) const {
        const int row0 = u.pm * 256 + wr * 64 + fr, col0 = u.pn * 256 + wc * 32 + 8 * fq;
#pragma unroll
        for (int ai = 0; ai < 2; ++ai)
#pragma unroll
            for (int m = 0; m < 4; ++m) { bf16* rowp = OP + (size_t)(row0 + ai * 128 + m * 16) * DM + col0;
#pragma unroll
                for (int bj = 0; bj < 2; ++bj) { const f32x4 v0 = acc[ai][bj][m][0], v1 = acc[ai][bj][m][1];
                    u32x4 w; w.x = cvt_pk_bf16(v0[0], v0[1]); w.y = cvt_pk_bf16(v0[2], v0[3]); w.z = cvt_pk_bf16(v1[0], v1[1]); w.w = cvt_pk_bf16(v1[2], v1[3]);
                    *(u32x4*)(rowp + bj * 128) = w; } }
    }
};

constexpr int N_PHASES = 22;
__global__ void __launch_bounds__(NTHR, 2) fwd_kernel(Args a) {
    extern __shared__ __attribute__((aligned(16))) unsigned char lds_raw[];
    LAS unsigned char* lds0 = (LAS unsigned char*)lds_raw;
    const int tid0 = threadIdx.x, bid0 = blockIdx.x, G0 = gridDim.x;
    const int wave0 = __builtin_amdgcn_readfirstlane(tid0 >> 6);
#define PH_IDS() ArgsP ap = (ArgsP)__builtin_amdgcn_kernarg_segment_ptr(); asm volatile("" : "+s"(ap)); unsigned lb_ = 0u; asm volatile("" : "+s"(lb_)); LAS unsigned char* lds = lds0 + lb_; LAS unsigned char* misc = lds + MISC_OFF; (void)misc; unsigned char* ws = ap->ws; (void)ws; int bid = bid0, G = G0, wave = wave0; asm volatile("" : "+s"(bid), "+s"(G), "+s"(wave)); int tid = wave * 64 + lane_id(); asm volatile("" : "+v"(tid)); const int lane = tid & 63; (void)lane; (void)wave
    if (tid0 < 4) ((LAS unsigned*)(lds0 + MISC_OFF + MO_BAR))[tid0] = 0u;
    __syncthreads();
#if MK_LAUNCHES == 1
    XcdBarrier bar = xcd_barrier_post((unsigned*)(a.ws + WS_CTL) + CW_BAR, (volatile LAS unsigned*)(lds0 + MISC_OFF + MO_BAR));
#define GRID_BAR() xcd_barrier(bar)
#else
#define GRID_BAR() do { } while (0)
#endif
    const int lo = a.ph_lo, hi = a.ph_hi;
#ifndef PHMASK
#define PHMASK 0xFFFu
#endif
#define IN(k) (lo <= (k) && (k) < hi)
#define EN(b) ((PHMASK >> (b)) & 1u)
#ifndef DBLMASK
#define DBLMASK 0u
#endif
#define REP(b) _Pragma("unroll 1") for (int rep_ = 0; rep_ < (((DBLMASK >> (b)) & 1u) ? 2 : 1); ++rep_)
#define SEAM(k) do { if (IN(k) && IN((k) + 1)) { GRID_BAR(); if ((DBLMASK >> 12) & 1u) GRID_BAR(); } } while (0)

    if (EN(0) && IN(0)) { REP(0) { PH_IDS(); prologue_phase(ap, lds, tid, lane, wave, bid, G); __syncthreads(); }
#ifndef NO_NORM0
        { PH_IDS(); norm_phase<0>(ap, 0, lds, tid, lane, wave, bid, G); }
#endif
    }
    SEAM(0);
#pragma unroll 1
    for (int l = 0; l < 2; ++l) {
        const int pb = 1 + 10 * l;
        if (EN(1) && IN(pb + 0) && l == 1) { if ((DBLMASK >> 18) & 1u) { PH_IDS(); norm_phase<1>(ap, l, lds, tid, lane, wave, bid, G, true); } PH_IDS(); norm_phase<1>(ap, l, lds, tid, lane, wave, bid, G); }
        if (l == 1) SEAM(pb + 0);
        if (EN(2) && IN(pb + 1)) REP(2) { PH_IDS(); (void)tid;
#ifdef STAG
            for (int i = 0; i < ((bid >> 3) & 7); ++i) __builtin_amdgcn_s_sleep(STAG);
#endif
            SchedG1 S{(const char*)(ws + WS_H), (const char*)(ws + WS_WINT) + (size_t)l * 11264 * 4096, G, bid};
            EpiG1 E{ws, ((DBLMASK >> 21) & 1u) && rep_ == 1};
            pg8::gemm_phase<EpiG1, SchedG1>(lds, 2048, S, E, wave);
            for (int bh = G - 1 - bid; bh < 16; bh += G) gate_unit(ap, l, lds, bh, tid, tid & 63, wave);
            __syncthreads();
            if (G == 256 && bid >= 256 - SchedG1::NCV) prologue_phase(ap, lds, tid, tid & 63, wave, bid - (256 - SchedG1::NCV), SchedG1::NCV, 2 + l);
            else if (G != 256) prologue_phase(ap, lds, tid, tid & 63, wave, bid, G, 2 + l);
        }
        SEAM(pb + 1);
        if (EN(3) && IN(pb + 2)) REP(3) { PH_IDS(); conv_phase(ap, l, lds, tid, lane, wave, bid, G); }
        SEAM(pb + 2);
        if (EN(4) && IN(pb + 3)) REP(4) { PH_IDS();
            const int vb = (G % 8 == 0) ? (bid & 7) * (G >> 3) + (bid >> 3) : bid;
            REP(13) { for (int gw = vb * NWAVES + wave; gw < 2048; gw += G * NWAVES) mlstm_ab_task(ws, gw, lane, rep_ == 0 || !((DBLMASK >> 15) & 1u)); }
            if (wave == 0 && vb < 64) nscan_task(ws, vb, lane);
            __syncthreads();
            REP(14) { for (int u = vb; u < 512; u += G) { attn_unit(ap, lds, u, tid, lane, wave); __syncthreads(); if (((DBLMASK >> 16) & 1u) && u < 256) GRID_BAR(); } }
        }
        SEAM(pb + 3);
        if (EN(5) && IN(pb + 4)) REP(5) { PH_IDS(); mlstm_c_phase(ap, l, lds, tid, lane, wave, bid, G); }
        SEAM(pb + 4);
        if (EN(6) && IN(pb + 5)) REP(6) { PH_IDS(); (void)tid;
            SchedBr S{(const char*)(ws + WS_HM), (const char*)(ws + WS_HA), (const char*)(ws + WS_WBM) + (size_t)l * 2048 * 2048, (const char*)(ws + WS_WBA) + (size_t)l * 2048 * 2048, G, bid};
            EpiBr E{(const bf16*)(ws + WS_SG), (bf16*)(ws + WS_Y)};
            pg8::gemm_phase<EpiBr, SchedBr>(lds, 1024, S, E, wave);
        }
        SEAM(pb + 5);
        if (EN(7) && IN(pb + 6)) _Pragma("unroll 1") for (int rep_ = 0; rep_ < ((((DBLMASK >> 7) & 1u) && l == 0) ? 2 : 1); ++rep_) { PH_IDS(); (void)tid;
            SchedStd S{(const char*)(ws + WS_Y), (const char*)(ws + WS_WOUT) + (size_t)l * 2048 * 4096, 32, 8, 2048, G, bid};
            EpiOut E{l == 0 ? ap->in[I_X] : (const float*)ap->out, ap->out};
            pg8::gemm_phase<EpiOut, SchedStd>(lds, 2048, S, E, wave);
        }
        SEAM(pb + 6);
        if (EN(8) && IN(pb + 7)) { if ((DBLMASK >> 19) & 1u) { PH_IDS(); norm_phase<2>(ap, l, lds, tid, lane, wave, bid, G, true); } PH_IDS(); norm_phase<2>(ap, l, lds, tid, lane, wave, bid, G); }
        SEAM(pb + 7);
        if (EN(9) && IN(pb + 8)) REP(9) { PH_IDS();
            moe_tables(ws, l, misc, tid);
            SchedMoe1 S{(const char*)(ws + WS_H), (const char*)(ws + WS_W13) + (size_t)l * 32 * 512 * 4096, (const int*)(ws + MS_LIST),
                        (const LAS int*)(misc + MO_TE), (const LAS int*)(misc + MO_TR0), (const LAS int*)(misc + MO_CNT), __builtin_amdgcn_readfirstlane(((const LAS int*)(misc + MO_MT))[0]), G, bid};
            EpiMoe1 E{(bf16*)(ws + WS_HID), (const float*)(ws + MS_PWL), (const LAS int*)(misc + MO_TR0), (const LAS int*)(misc + MO_CNT)};
            pg8::gemm_phase<EpiMoe1, SchedMoe1>(lds, 2048, S, E, wave);
            if (bid >= 2 * S.MT) prologue_phase(ap, lds, tid, tid & 63, wave, bid - 2 * S.MT, G - 2 * S.MT, l == 0 ? 1 : 4);
        }
        SEAM(pb + 8);
        if (EN(10) && IN(pb + 9)) REP(10) { PH_IDS();
            moe_tables(ws, l, misc, tid);
#ifdef STAG
            for (int i = 0; i < ((bid >> 3) & 7); ++i) __builtin_amdgcn_s_sleep(STAG);
#endif
            SchedMoe2 S{(const char*)(ws + WS_HID), (const char*)(ws + WS_W2) + (size_t)l * 32 * 2048 * 512, (const LAS int*)(misc + MO_TE), __builtin_amdgcn_readfirstlane(((const LAS int*)(misc + MO_MT))[0]), G, bid};
            EpiMoe2 E{(bf16*)(ws + WS_OP)};
            pg8::gemm_phase<EpiMoe2, SchedMoe2>(lds, 256, S, E, wave);
        }
        SEAM(pb + 9);
    }
    if (EN(11) && IN(21)) { if ((DBLMASK >> 20) & 1u) { PH_IDS(); norm_phase<3>(ap, 1, lds, tid, lane, wave, bid, G, true); } PH_IDS(); norm_phase<3>(ap, 1, lds, tid, lane, wave, bid, G); }
#undef IN
#undef SEAM
}

extern "C" void kernel_launch(void* const* d_in, const int* in_sizes, int n_in, void* d_out, int out_size, void* d_ws, size_t ws_size, hipStream_t stream) {
    static int grid = 0;
    if (grid == 0) {
        if (n_in != 19 || out_size != NTOK * DM || ws_size < WS_END) { fprintf(stderr, "kernel_launch: unexpected shapes (n_in %d out %d ws %zu)\n", n_in, out_size, ws_size); grid = -1; return; }
        int dev = 0, cus = 0, per_cu = 0;
        if (hipGetDevice(&dev) != hipSuccess || hipDeviceGetAttribute(&cus, hipDeviceAttributeMultiprocessorCount, dev) != hipSuccess) { grid = -1; return; }
        if (hipFuncSetAttribute((const void*)fwd_kernel, hipFuncAttributeMaxDynamicSharedMemorySize, LDS_BYTES) != hipSuccess) { fprintf(stderr, "kernel_launch: hipFuncSetAttribute failed\n"); grid = -1; return; }
        if (hipOccupancyMaxActiveBlocksPerMultiprocessor(&per_cu, (const void*)fwd_kernel, NTHR, LDS_BYTES) != hipSuccess || per_cu < 1) { fprintf(stderr, "kernel_launch: occupancy query says %d\n", per_cu); }
        (void)hipGetLastError();
        grid = cus;
        if (grid > 256) grid = 256;
    }
    if (grid < 0) return;
    if (hipMemsetAsync((char*)d_ws + WS_CTL, 0, CTL_ZERO_BYTES, stream) != hipSuccess) return;
    Args a{};
    for (int i = 0; i < 19; ++i) a.in[i] = (const float*)d_in[i];
    a.out = (float*)d_out; a.ws = (unsigned char*)d_ws;
#if MK_LAUNCHES == 1
    a.ph_lo = 0; a.ph_hi = N_PHASES;
    hipLaunchKernelGGL(fwd_kernel, dim3(grid), dim3(NTHR), LDS_BYTES, stream, a);
#else
    for (int p = 0; p < N_PHASES; ++p) { a.ph_lo = p; a.ph_hi = p + 1; hipLaunchKernelGGL(fwd_kernel, dim3(grid), dim3(NTHR), LDS_BYTES, stream, a); }
#endif
}
```

```cpp
#define DBLMASK 0u
#include <hip/hip_runtime.h>
#include <stdint.h>
#include <stdio.h>

#ifndef MK_LAUNCHES
#define MK_LAUNCHES 1
#endif

#define GAS __attribute__((address_space(1)))
#define LAS __attribute__((address_space(3)))
typedef unsigned short bf16;
typedef short bf16x8 __attribute__((ext_vector_type(8)));
typedef short bf16x4 __attribute__((ext_vector_type(4)));
typedef float f32x4 __attribute__((ext_vector_type(4)));
typedef unsigned u32x4 __attribute__((ext_vector_type(4)));
typedef unsigned u32x2 __attribute__((ext_vector_type(2)));

constexpr int NTOK = 8192, DM = 2048, SEQ = 2048, NBATCH = 4;
constexpr int INCOLS = 11272;
constexpr int NWAVES = 8, NTHR = 512;
constexpr float RMS_EPS = 1e-6f, LN_EPS = 1e-5f;
constexpr int MPAD = 24576;

constexpr size_t MiB = 1u << 20;
constexpr size_t WS_CTL = 0, CTL_ZERO_BYTES = 1 * MiB;
constexpr size_t WS_MISC = 1 * MiB;
constexpr size_t MS_WIF = WS_MISC + 0;
constexpr size_t MS_WRT = WS_MISC + 256 * 1024;
constexpr size_t MS_IFG = WS_MISC + 1 * MiB;
constexpr size_t MS_KMEAN = MS_IFG + 256 * 1024;
constexpr size_t MS_AS = WS_MISC + 1536 * 1024;
constexpr size_t MS_GT = MS_AS + 128 * 1024;
constexpr size_t MS_WI = MS_GT + 128 * 1024;
constexpr size_t MS_CL = MS_WI + 128 * 1024;
constexpr size_t MS_WS = MS_CL + 128 * 1024;
constexpr size_t MS_DEC = MS_WS + 128 * 1024;
constexpr size_t MS_NST = WS_MISC + 2560 * 1024;
constexpr size_t MS_TOKE = WS_MISC + 3 * MiB;
constexpr size_t MS_TOKP = MS_TOKE + 64 * 1024;
constexpr size_t MS_TOKW = MS_TOKE + 128 * 1024;
constexpr size_t MS_LIST = WS_MISC + 4 * MiB;
constexpr size_t MS_PWL = WS_MISC + 5 * MiB;
constexpr size_t MS_NVEC = WS_MISC + 6 * MiB;
constexpr size_t WS_WINT = 16 * MiB;
constexpr size_t WS_WBM = 104 * MiB;
constexpr size_t WS_WBA = 112 * MiB;
constexpr size_t WS_WOUT = 120 * MiB;
constexpr size_t WS_W13 = 136 * MiB;
constexpr size_t WS_W2 = 264 * MiB;
constexpr size_t WS_H = 328 * MiB;
constexpr size_t WS_R = 360 * MiB;
constexpr size_t WS_ZQK = WS_R;
constexpr size_t WS_HM = WS_R, WS_HA = WS_R + 16 * MiB;
constexpr size_t WS_VMT = WS_R + 32 * MiB;
constexpr size_t WS_OM = WS_R + 48 * MiB;
constexpr size_t WS_QA = WS_R + 64 * MiB, WS_KA = WS_R + 80 * MiB;
constexpr size_t WS_Y = WS_QA;
constexpr size_t WS_VAT = WS_R + 96 * MiB;
constexpr size_t WS_SG = WS_R + 112 * MiB;
constexpr size_t WS_QM = WS_R + 176 * MiB, WS_KM = WS_R + 192 * MiB, WS_KMT = WS_R + 208 * MiB;
constexpr size_t WS_CST = WS_R + 224 * MiB;
constexpr size_t WS_HID = WS_R;
constexpr size_t WS_OP = WS_R + 16 * MiB;
constexpr size_t WS_END = 648 * MiB;
constexpr int CW_BAR = 4096;
constexpr int CW_CNT = 8192;

constexpr int RING_BYTES = 131072;
constexpr int MISC_OFF = 139264;
constexpr int LDS_BYTES = 147456;
constexpr int MO_BAR = 0, MO_CNT = 64, MO_NT = 64 + 128, MO_OFF = 64 + 256, MO_TE = 64 + 512, MO_TR0 = 64 + 1024, MO_MT = 64 + 1536, MO_LOG = 2048;

#define LDS_WAIT() asm volatile("s_waitcnt lgkmcnt(0)" ::: "memory")
#define VM_WAIT() asm volatile("s_waitcnt vmcnt(0)" ::: "memory")

__device__ __forceinline__ float bf2f(unsigned short b) { return __builtin_bit_cast(float, (unsigned)b << 16); }
__device__ __forceinline__ float bflo(unsigned u) { return __builtin_bit_cast(float, u << 16); }
__device__ __forceinline__ float bfhi(unsigned u) { return __builtin_bit_cast(float, u & 0xffff0000u); }
typedef __bf16 bf16x2v __attribute__((ext_vector_type(2)));
typedef float f32x2v __attribute__((ext_vector_type(2)));
typedef float f32x2 __attribute__((ext_vector_type(2)));
__device__ __forceinline__ unsigned cvt_pk_bf16(float lo, float hi) { const f32x2v f = {lo, hi}; const bf16x2v b = __builtin_convertvector(f, bf16x2v); return __builtin_bit_cast(unsigned, b); }
__device__ __forceinline__ float wave_sum(float v) {
#pragma unroll
    for (int o = 1; o < 64; o <<= 1) v += __shfl_xor(v, o);
    return v;
}
__device__ __forceinline__ float rows4_max(float x) { x = fmaxf(x, __shfl_xor(x, 16)); return fmaxf(x, __shfl_xor(x, 32)); }
__device__ __forceinline__ float rows4_sum(float x) { x += __shfl_xor(x, 16); return x + __shfl_xor(x, 32); }
__device__ __forceinline__ int lane_id() { int l; asm volatile("v_mbcnt_lo_u32_b32 %0, -1, 0\n\tv_mbcnt_hi_u32_b32 %0, -1, %0" : "=v"(l)); return l; }
__device__ __forceinline__ float sigmoidf_(float x) { return __builtin_amdgcn_rcpf(1.f + __expf(-x)); }

namespace pg8 {
constexpr int BM = 256, BK = 64, HALF = 128, HTB = HALF * BK * 2, STAGE_BYTES = 8 * HTB, NXCD = 8, WGM = 8;
__device__ __forceinline__ int lds_byte(int r, int c) { const int st = (r >> 4) * 2 + (c >> 5), rr = r & 15, cc = c & 31, ob = rr * 64 + cc * 2; return st * 1024 + (ob ^ (((ob >> 9) & 1) << 5)); }
__device__ __forceinline__ void stage_rc(int b, int& R, int& C) { const int st = b / 1024, sb = b % 1024, swz = sb ^ (((sb >> 9) & 1) << 5); R = (st >> 1) * 16 + swz / 64; C = (st & 1) * 32 + (swz % 64) / 2; }
__device__ __forceinline__ int perm32(int rho) { const int n = rho >> 4, i = rho & 15; return 8 * (i >> 2) + 4 * n + (i & 3); }
struct Unit { int pm, pn, aux; };

__device__ __forceinline__ void static_tile(int L, int nM, int nN, int& pm, int& pn) {
    const int nwg = nM * nN; int wgid = L;
    { const int q = nwg / NXCD, r = nwg % NXCD, xcd = wgid % NXCD, off = wgid / NXCD; wgid = (xcd < r ? xcd * (q + 1) : r * (q + 1) + (xcd - r) * q) + off; }
    const int nig = WGM * nN, gid = wgid / nig, fm = gid * WGM, gsz = (nM - fm) < WGM ? (nM - fm) : WGM;
    pm = fm + ((wgid % nig) % gsz); pn = (wgid % nig) / gsz;
}

template <class Epi, class Sched>
__device__ __forceinline__ void gemm_phase(LAS unsigned char* lds, const int K, const Sched& S, const Epi& E, const int wave0) {
    int tid_ = wave0 * 64 + lane_id(); asm volatile("" : "+v"(tid_));
    const int tid = tid_, wid = __builtin_amdgcn_readfirstlane(tid >> 6), lane = tid & 63, wr = wid >> 2, wc = wid & 3, fr = lane & 15, fq = lane >> 4;
    const int nt = K / BK;
    int RA[2], CA[2]; unsigned voffB[2];
#pragma unroll
    for (int i = 0; i < 2; ++i) { int R, C; stage_rc(tid * 16 + i * 8192, R, C); const int Rb = Epi::PERM ? ((R & ~31) + perm32(R & 31)) : R;
        RA[i] = R; CA[i] = C; voffB[i] = (unsigned)(Rb * K + C) * 2u; }
    const size_t kstep = (size_t)(BK * 2);
    const size_t hstep = (size_t)HALF * K * 2;
    const unsigned ldsw = (unsigned)wid * 1024u;
    const int aoff = lds_byte(wr * 64 + fr, fq * 8), boff = lds_byte(wc * 32 + fr, fq * 8);
#define PG8_SA(b, h) (((b) * 2 + (h)) * HTB)
#define PG8_SB(b, h) ((4 + (b) * 2 + (h)) * HTB)
#define PG8_STAGE(bufoff, gbase, v0, v1) do { \
        __builtin_amdgcn_global_load_lds((const unsigned*)((const char*)(gbase) + (v0)), (LAS unsigned*)(lds + (bufoff) + ldsw), 16, 0, 0); \
        __builtin_amdgcn_global_load_lds((const unsigned*)((const char*)(gbase) + (v1)), (LAS unsigned*)(lds + (bufoff) + ldsw + 8192), 16, 0, 0); } while (0)
#define PG8_STAGE_B(bufoff, gbase) PG8_STAGE(bufoff, gbase, voffB[0], voffB[1])
#define PG8_STAGE_A(bufoff, gbase, VO, h) PG8_STAGE(bufoff, gbase, VO[h][0], VO[h][1])
#define PG8_STAGE_A2(bufoff, gbase, h) do { if (Sched::GATHER && last) { PG8_STAGE_A(bufoff, gbase, vn, h); } else { PG8_STAGE_A(bufoff, gbase, vc, h); } } while (0)
#define PG8_LDA(dst, b, h) do { _Pragma("unroll") for (int m = 0; m < 4; ++m) _Pragma("unroll") for (int k = 0; k < 2; ++k) dst[m][k] = *(const LAS bf16x8*)(lds + PG8_SA(b, h) + aoff + m * 2048 + k * 1024); } while (0)
#define PG8_LDB(dst, b, h) do { _Pragma("unroll") for (int n = 0; n < 2; ++n) _Pragma("unroll") for (int k = 0; k < 2; ++k) dst[n][k] = *(const LAS bf16x8*)(lds + PG8_SB(b, h) + boff + n * 2048 + k * 1024); } while (0)
#define PG8_MMA(ai, bj, At, Bt) do { __builtin_amdgcn_s_setprio(1); _Pragma("unroll") for (int m = 0; m < 4; ++m) _Pragma("unroll") for (int n = 0; n < 2; ++n) _Pragma("unroll") for (int k = 0; k < 2; ++k) \
        acc[ai][bj][m][n] = __builtin_amdgcn_mfma_f32_16x16x32_bf16(Bt[n][k], At[m][k], acc[ai][bj][m][n], 0, 0, 0); __builtin_amdgcn_s_setprio(0); } while (0)
#define PG8_WAIT_V(n) asm volatile("s_waitcnt vmcnt(" #n ")" ::: "memory")
#define PG8_WAIT_L(n) asm volatile("s_waitcnt lgkmcnt(" #n ")" ::: "memory")
#define PG8_BAR __builtin_amdgcn_s_barrier()
#define PG8_SCHED __builtin_amdgcn_sched_barrier(0)
    Unit cur, nxt; int ui = 0;
    if (!S.next(0, cur)) return;
    f32x4 acc[2][2][4][2];
#pragma unroll
    for (int a = 0; a < 2; ++a)
#pragma unroll
        for (int b = 0; b < 2; ++b)
#pragma unroll
            for (int m = 0; m < 4; ++m)
#pragma unroll
                for (int n = 0; n < 2; ++n) acc[a][b][m][n] = (f32x4){0.f, 0.f, 0.f, 0.f};
    bf16x8 At[4][2], B0[2][2], B1[2][2];
    unsigned vc[2][2], vn[2][2];
#pragma unroll
    for (int h = 0; h < 2; ++h)
#pragma unroll
        for (int i = 0; i < 2; ++i) {
            if constexpr (Sched::GATHER) vc[h][i] = (unsigned)(S.arow(cur, h * HALF + RA[i]) * (unsigned)K + (unsigned)CA[i]) * 2u;
            else vc[h][i] = (unsigned)((h * HALF + RA[i]) * K + CA[i]) * 2u;
            vn[h][i] = vc[h][i];
        }
    const char* cA = S.abase(cur); const char* cB = S.bbase(cur);
    PG8_STAGE_B(PG8_SB(0, 0), cB); PG8_STAGE_A(PG8_SA(0, 0), cA, vc, 0); PG8_STAGE_B(PG8_SB(0, 1), cB + hstep); PG8_STAGE_A(PG8_SA(0, 1), cA, vc, 1);
    if (wr == 1) PG8_BAR;
    PG8_WAIT_V(4); PG8_BAR;
    PG8_STAGE_B(PG8_SB(1, 0), cB + kstep); PG8_STAGE_A(PG8_SA(1, 0), cA + kstep, vc, 0); PG8_STAGE_B(PG8_SB(1, 1), cB + hstep + kstep);
    PG8_WAIT_V(6); PG8_BAR;
    for (;;) {
        const bool has_next = S.next(ui + 1, nxt);
        const char* nA = has_next ? S.abase(nxt) : cA; const char* nB = has_next ? S.bbase(nxt) : cB;
        if constexpr (Sched::GATHER) {
            if (has_next) {
                int t2 = wave0 * 64 + lane_id(); asm volatile("" : "+v"(t2));
#pragma unroll
                for (int i = 0; i < 2; ++i) { int R, C; stage_rc(t2 * 16 + i * 8192, R, C);
#pragma unroll
                    for (int h = 0; h < 2; ++h) vn[h][i] = (unsigned)(S.arow(nxt, h * HALF + R) * (unsigned)K + (unsigned)C) * 2u; }
            }
        }
#pragma unroll 1
        for (int t = 0; t < nt; t += 2) {
            const bool last = (t == nt - 2);
            const char* a1 = cA + (size_t)(t + 1) * kstep;
            const char* a2 = last ? nA : cA + (size_t)(t + 2) * kstep; const char* b2 = last ? nB : cB + (size_t)(t + 2) * kstep;
            const char* a3 = a2 + kstep; const char* b3 = b2 + kstep;
            PG8_LDB(B0, 0, 0); PG8_SCHED; PG8_LDA(At, 0, 0); PG8_STAGE_A(PG8_SA(1, 1), a1, vc, 1);
            PG8_WAIT_L(8); PG8_BAR; PG8_WAIT_L(0); PG8_MMA(0, 0, At, B0); PG8_BAR; PG8_SCHED;
            PG8_LDB(B1, 0, 1); PG8_STAGE_B(PG8_SB(0, 0), b2);
            PG8_BAR; PG8_WAIT_L(0); PG8_MMA(0, 1, At, B1); PG8_BAR;
            PG8_LDA(At, 0, 1); PG8_STAGE_A2(PG8_SA(0, 0), a2, 0);
            PG8_BAR; PG8_WAIT_L(0); PG8_MMA(1, 0, At, B0); PG8_BAR; PG8_SCHED;
            PG8_STAGE_B(PG8_SB(0, 1), b2 + hstep);
            PG8_WAIT_V(6); PG8_BAR; PG8_MMA(1, 1, At, B1); PG8_BAR;
            PG8_LDB(B0, 1, 0); PG8_SCHED; PG8_LDA(At, 1, 0); PG8_STAGE_A2(PG8_SA(0, 1), a2, 1);
            PG8_WAIT_L(8); PG8_BAR; PG8_WAIT_L(0); PG8_MMA(0, 0, At, B0); PG8_BAR; PG8_SCHED;
            PG8_LDB(B1, 1, 1); PG8_STAGE_B(PG8_SB(1, 0), b3);
            PG8_BAR; PG8_WAIT_L(0); PG8_MMA(0, 1, At, B1); PG8_BAR;
            PG8_LDA(At, 1, 1); PG8_STAGE_A2(PG8_SA(1, 0), a3, 0);
            PG8_BAR; PG8_WAIT_L(0); PG8_MMA(1, 0, At, B0); PG8_BAR; PG8_SCHED;
            PG8_STAGE_B(PG8_SB(1, 1), b3 + hstep);
            PG8_WAIT_V(6); PG8_BAR; PG8_MMA(1, 1, At, B1); PG8_BAR;
        }
        { const int lz = lane_id(); E(acc, cur, wr, wc, lz & 15, lz >> 4); }
        if (!has_next) break;
        if (!Sched::keep_acc(cur)) {
#pragma unroll
        for (int a = 0; a < 2; ++a)
#pragma unroll
            for (int b = 0; b < 2; ++b)
#pragma unroll
                for (int m = 0; m < 4; ++m)
#pragma unroll
                    for (int n = 0; n < 2; ++n) acc[a][b][m][n] = (f32x4){0.f, 0.f, 0.f, 0.f};
        }
        cur = nxt; cA = nA; cB = nB; ++ui;
        if constexpr (Sched::GATHER) {
#pragma unroll
            for (int h = 0; h < 2; ++h)
#pragma unroll
                for (int i = 0; i < 2; ++i) vc[h][i] = vn[h][i];
        }
    }
    PG8_WAIT_V(0);
    if (wr == 0) PG8_BAR;
    PG8_BAR;
#undef PG8_SA
#undef PG8_SB
#undef PG8_STAGE
#undef PG8_STAGE_A
#undef PG8_STAGE_A2
#undef PG8_STAGE_B
#undef PG8_LDA
#undef PG8_LDB
#undef PG8_MMA
#undef PG8_WAIT_V
#undef PG8_WAIT_L
#undef PG8_BAR
#undef PG8_SCHED
}
}
using pg8::Unit;

#define XB_TMO      128
#define XB_XCNT(j)  (256  + 64 * (j))
#define XB_XSUB(j)  (1280 + 64 * (j))
#define XB_XGEN(j)  (2304 + 64 * (j))
#define XB_TOP      3328
#define XB_TOPGEN   3392
#define XCD_BAR_WORDS 3456
#define XB_SPIN_CAP (1u << 18)
__device__ __forceinline__ unsigned xb_ld(unsigned* p)              { return __hip_atomic_load(p, __ATOMIC_RELAXED, __HIP_MEMORY_SCOPE_AGENT); }
__device__ __forceinline__ unsigned xb_add(unsigned* p, unsigned v) { return __hip_atomic_fetch_add(p, v, __ATOMIC_RELAXED, __HIP_MEMORY_SCOPE_AGENT); }
__device__ __forceinline__ unsigned xb_xcc_id() { return (unsigned)__builtin_amdgcn_s_getreg((3 << 11) | 20) & 0xFu; }
#define XB_SPIN(cond, bar) do { unsigned _sp = 0; while (cond) { __builtin_amdgcn_s_sleep(1); \
    if ((++_sp & 255u) == 0u) { if (xb_ld(&(bar)[XB_TMO])) break; if (_sp > XB_SPIN_CAP) { atomicAdd(&(bar)[XB_TMO], 1u); break; } } } } while (0)
struct XcdBarrier { unsigned* bar; unsigned x; volatile LAS unsigned* st; };
__device__ __forceinline__ XcdBarrier xcd_barrier_post(unsigned* bar, volatile LAS unsigned* st) {
    XcdBarrier b; b.bar = bar; b.x = xb_xcc_id(); b.st = st;
    if (threadIdx.x == 0) (void)xb_add(&bar[XB_XCNT(b.x)], 1u);
    return b;
}
__device__ __forceinline__ void xcd_barrier_complete(unsigned* bar, unsigned x, unsigned& nloc, unsigned& nx) {
    const unsigned G = gridDim.x * gridDim.y * gridDim.z;
    unsigned sum, cnt, mine, sp = 0u;
    for (;;) {
        sum = 0u; cnt = 0u; mine = 0u;
#pragma unroll
        for (unsigned j = 0; j < 16; ++j) { const unsigned c = xb_ld(&bar[XB_XCNT(j)]); sum += c; cnt += (c > 0u) ? 1u : 0u; mine = (j == x) ? c : mine; }
        if (sum == G) break;
        __builtin_amdgcn_s_sleep(1);
        if ((++sp & 255u) == 0u) { if (xb_ld(&bar[XB_TMO])) break; if (sp > XB_SPIN_CAP) { atomicAdd(&bar[XB_TMO], 1u); break; } }
    }
    nloc = mine > 0u ? mine : 1u; nx = cnt > 0u ? cnt : 1u;
}
__device__ __forceinline__ void xcd_barrier(const XcdBarrier& b) {
    asm volatile("s_waitcnt vmcnt(0)" ::: "memory");
    __syncthreads();
    if (threadIdx.x == 0) {
        unsigned* bar = b.bar;
        __builtin_amdgcn_s_waitcnt(0);
        unsigned nloc = b.st[0], nx = b.st[1];
        if (nloc == 0u) { xcd_barrier_complete(bar, b.x, nloc, nx); b.st[0] = nloc; b.st[1] = nx; }
        const unsigned old = xb_add(&bar[XB_XSUB(b.x)], 1u);
        const unsigned gen = old / nloc;
        if (old + 1u == (gen + 1u) * nloc) {
            __builtin_amdgcn_fence(__ATOMIC_RELEASE, "agent");
            asm volatile("s_waitcnt vmcnt(0)" ::: "memory");
            const unsigned og = xb_add(&bar[XB_TOP], 1u);
            const unsigned tg = og / nx;
            if (og + 1u == (tg + 1u) * nx) xb_add(&bar[XB_TOPGEN], 1u);
            else XB_SPIN(xb_ld(&bar[XB_TOPGEN]) == tg, bar);
            __builtin_amdgcn_fence(__ATOMIC_ACQUIRE, "agent");
            xb_add(&bar[XB_XGEN(b.x)], 1u);
            asm volatile("s_waitcnt vmcnt(0)" ::: "memory");
        } else {
            XB_SPIN(xb_ld(&bar[XB_XGEN(b.x)]) == gen, bar);
            __builtin_amdgcn_fence(__ATOMIC_ACQUIRE, "agent");
            asm volatile("s_waitcnt vmcnt(0)" ::: "memory");
        }
    }
    __syncthreads();
}

struct Args { const float* in[19]; float* out; unsigned char* ws; int ph_lo, ph_hi; };
typedef const __attribute__((address_space(4))) Args* ArgsP;
enum { I_X = 0, I_N1G, I_WIN, I_CONVW, I_IFB, I_MNG, I_WBM, I_WBA, I_WOUT, I_RELB, I_N2G, I_WGRP, I_BGRP, I_WEXP, I_BEXP, I_W1, I_W3, I_W2, I_FG };


struct TrDesc { const float* W; bf16* WT; size_t ldn, ldk; int k0, n0, r0; };
__device__ __forceinline__ void tr_load(const TrDesc& d, f32x4 (&tv)[16], int lane) {
    const int nn4 = (lane & 15) * 4, kr = lane >> 4;
#pragma unroll
    for (int i = 0; i < 16; ++i) tv[i] = __builtin_nontemporal_load((const f32x4*)(d.W + (size_t)(d.k0 + 4 * i + kr) * d.ldn + d.n0 + nn4));
}
__device__ __forceinline__ void tr_finish(const TrDesc& d, f32x4 (&tv)[16], LAS float* scr, int lane) {
    const int nn4 = (lane & 15) * 4, kr = lane >> 4;
#pragma unroll
    for (int i = 0; i < 16; i += 4) asm volatile("" : "+v"(tv[i]), "+v"(tv[i + 1]), "+v"(tv[i + 2]), "+v"(tv[i + 3]));
#pragma unroll
    for (int i = 0; i < 16; ++i) { const int kk = 4 * i + kr; const f32x4 v = tv[i];
        LAS float* q = scr + kk * 65 + nn4; q[0] = v.x; q[1] = v.y; q[2] = v.z; q[3] = v.w; }
    LDS_WAIT();
    const int kc = (lane & 7) * 8;
#pragma unroll
    for (int p = 0; p < 8; ++p) { const int nn = 8 * p + (lane >> 3); const LAS float* sp = scr + kc * 65 + nn;
        u32x4 o; o.x = cvt_pk_bf16(sp[0], sp[65]); o.y = cvt_pk_bf16(sp[130], sp[195]); o.z = cvt_pk_bf16(sp[260], sp[325]); o.w = cvt_pk_bf16(sp[390], sp[455]);
        *(u32x4*)(d.WT + (size_t)(d.r0 + nn) * d.ldk + d.k0 + kc) = o; }
    LDS_WAIT();
}
__device__ __forceinline__ int win_src_col(int r) {
    if (r < 2048) return r;
    if (r < 3072) return r + 1024;
    if (r < 5120) return r + 1032;
    if (r < 9216) return r + 2056;
    if (r < 10240) return r - 7168;
    return r - 4088;
}
__device__ __forceinline__ TrDesc tr_decode(ArgsP a, unsigned char* ws, int it) {
    constexpr int PER_LAYER = 5632 + 512 + 512 + 1024 + 4096 + 4096 + 4096;
    const int l = it / PER_LAYER; int r = it % PER_LAYER;
    TrDesc d;
    if (r < 5632) { const int kb = r / 176, ng = r % 176;
        d.W = a->in[I_WIN] + (size_t)l * DM * INCOLS; d.ldn = INCOLS; d.k0 = 64 * kb; d.n0 = win_src_col(64 * ng); d.WT = (bf16*)(ws + WS_WINT) + (size_t)l * 11264 * 2048; d.ldk = 2048; d.r0 = 64 * ng; return d; }
    r -= 5632;
    if (r < 512) { const int kb = r / 32, ng = r % 32;
        d.W = a->in[I_WBM] + (size_t)l * 1024 * 2048; d.ldn = 2048; d.k0 = 64 * kb; d.n0 = 64 * ng; d.WT = (bf16*)(ws + WS_WBM) + (size_t)l * 2048 * 1024; d.ldk = 1024; d.r0 = 64 * ng; return d; }
    r -= 512;
    if (r < 512) { const int kb = r / 32, ng = r % 32;
        d.W = a->in[I_WBA] + (size_t)l * 1024 * 2048; d.ldn = 2048; d.k0 = 64 * kb; d.n0 = 64 * ng; d.WT = (bf16*)(ws + WS_WBA) + (size_t)l * 2048 * 1024; d.ldk = 1024; d.r0 = 64 * ng; return d; }
    r -= 512;
    if (r < 1024) { const int kb = r / 32, ng = r % 32;
        d.W = a->in[I_WOUT] + (size_t)l * 2048 * 2048; d.ldn = 2048; d.k0 = 64 * kb; d.n0 = 64 * ng; d.WT = (bf16*)(ws + WS_WOUT) + (size_t)l * 2048 * 2048; d.ldk = 2048; d.r0 = 64 * ng; return d; }
    r -= 1024;
    if (r < 8192) { const int w3 = r >= 4096; const int q = r & 4095; const int e = q >> 7, rr = q & 127, kb = rr >> 2, ng = rr & 3;
        d.W = a->in[w3 ? I_W3 : I_W1] + (size_t)(l * 32 + e) * 2048 * 256; d.ldn = 256; d.k0 = 64 * kb; d.n0 = 64 * ng;
        d.WT = (bf16*)(ws + WS_W13) + (size_t)(l * 32 + e) * 512 * 2048; d.ldk = 2048; d.r0 = 256 * (ng >> 1) + 64 * (ng & 1) + (w3 ? 128 : 0); return d; }
    r -= 8192;
    { const int e = r >> 7, rr = r & 127, kb = rr >> 5, ng = rr & 31;
        d.W = a->in[I_W2] + (size_t)(l * 32 + e) * 256 * 2048; d.ldn = 2048; d.k0 = 64 * kb; d.n0 = 64 * ng; d.WT = (bf16*)(ws + WS_W2) + (size_t)(l * 32 + e) * 2048 * 256; d.ldk = 256; d.r0 = 64 * ng; return d; }
}
#ifndef CVX
#define CVX 4096
#endif
__device__ __forceinline__ void prologue_phase(ArgsP a, LAS unsigned char* lds, int tid, int lane, int wave, int bid, int G, const int part = 0) {
    unsigned char* ws = a->ws;
    LAS float* scr = (LAS float*)(lds + wave * 16640);
    const int gw = bid * NWAVES + wave, NGW = G * NWAVES;
    constexpr int PER_LAYER = 5632 + 512 + 512 + 1024 + 4096 + 4096 + 4096;
    constexpr int W0 = 5632, W2I = PER_LAYER - 4096;
    const int v_lo = part == 0 ? 0 : part == 1 ? PER_LAYER : part == 2 ? W0 + CVX : part == 3 ? PER_LAYER + W0 : PER_LAYER + W2I;
    const int v_hi = part == 0 ? W0 + CVX : part == 1 ? PER_LAYER + W0 : part == 2 ? PER_LAYER : part == 3 ? PER_LAYER + W2I : 2 * PER_LAYER;
#define CV_ITEM(v) (v)
    f32x4 tvA[16], tvB[16]; TrDesc dA, dB;
    int it = v_lo + gw;
    if (it < v_hi) {
        int rem = (v_hi - 1 - it) / NGW;
        dA = tr_decode(a, ws, CV_ITEM(it)); tr_load(dA, tvA, lane);
#pragma unroll 1
        while (rem >= 2) {
            dB = tr_decode(a, ws, CV_ITEM(it + NGW)); tr_load(dB, tvB, lane);
            tr_finish(dA, tvA, scr, lane);
            it += 2 * NGW;
            dA = tr_decode(a, ws, CV_ITEM(it)); tr_load(dA, tvA, lane);
            tr_finish(dB, tvB, scr, lane);
            rem -= 2;
        }
        if (rem == 1) { dB = tr_decode(a, ws, CV_ITEM(it + NGW)); tr_load(dB, tvB, lane); tr_finish(dA, tvA, scr, lane); tr_finish(dB, tvB, scr, lane); }
        else tr_finish(dA, tvA, scr, lane);
    }
#undef CV_ITEM
    if (part != 0) return;
    const int gt = bid * NTHR + tid, NGT = G * NTHR;
    float* wrt = (float*)(ws + MS_WRT);
    for (int i = gt; i < 2 * 36 * 2048; i += NGT) { const int l = i / (36 * 2048), rr = i % (36 * 2048), n = rr >> 11, k = rr & 2047;
        wrt[i] = n < 4 ? a->in[I_WGRP][((size_t)l * DM + k) * 4 + n] : a->in[I_WEXP][((size_t)l * DM + k) * 32 + (n - 4)]; }
}

__device__ __forceinline__ void moe_tables(unsigned char* ws, int l, LAS unsigned char* misc, int tid) {
    LAS int* cnt = (LAS int*)(misc + MO_CNT); LAS int* ntl = (LAS int*)(misc + MO_NT); LAS int* off = (LAS int*)(misc + MO_OFF);
    LAS int* te = (LAS int*)(misc + MO_TE); LAS int* tr0 = (LAS int*)(misc + MO_TR0); LAS int* mt = (LAS int*)(misc + MO_MT);
    __syncthreads();
    if (tid < 32) { const int c = (int)__hip_atomic_load((unsigned*)(ws + WS_CTL) + CW_CNT + 32 * l + tid, __ATOMIC_RELAXED, __HIP_MEMORY_SCOPE_AGENT); cnt[tid] = c; ntl[tid] = (c + 255) >> 8; }
    __syncthreads();
    if (tid == 0) { int o = 0;
#pragma unroll 1
        for (int e = 0; e < 32; ++e) { off[e] = o; const int n = ntl[e];
#pragma unroll 1
            for (int j = 0; j < n; ++j) { te[o + j] = e; tr0[o + j] = 256 * j; } o += n; } off[32] = o; mt[0] = o; }
    __syncthreads();
}

#ifndef DRYX
#define DRYX 0
#endif
template <int MODE>
__device__ __forceinline__ void norm_phase(ArgsP a, int l, LAS unsigned char* lds, int tid, int lane, int wave, int bid, int G, const bool dry = false) {
    unsigned char* ws = a->ws;
    LAS unsigned char* misc = lds + MISC_OFF;
    if (MODE == 1 || MODE == 3) moe_tables(ws, MODE == 1 ? 0 : 1, misc, tid);
    const LAS int* off = (const LAS int*)(misc + MO_OFF);
    const float* src = (MODE == 0) ? a->in[I_X] : a->out;
    const float* gain = (MODE < 2) ? a->in[I_N1G] + l * DM : (MODE == 2 ? a->in[I_N2G] + l * DM : a->in[I_FG]);
    const int* toke = (const int*)(ws + MS_TOKE); const int* tokp = (const int*)(ws + MS_TOKP);
    const bf16* OP = (const bf16*)(ws + WS_OP);
    bf16* H = (bf16*)(ws + WS_H);
    const int gw = bid * NWAVES + wave, NGW = G * NWAVES;
    constexpr int RP = (MODE == 2) ? 4 : 2;
    LAS float* gwl = (LAS float*)lds;
    if (MODE < 2) {
        const float* wg = a->in[I_WIN] + (size_t)l * DM * INCOLS + 4096;
        f32x4 t0[4], t1[4];
#pragma unroll
        for (int i = 0; i < 4; ++i) { const float* wp = wg + (size_t)(tid + NTHR * i) * INCOLS; t0[i] = *(const f32x4*)wp; t1[i] = *(const f32x4*)(wp + 4); }
#pragma unroll
        for (int i = 0; i < 4; ++i) { const int k = tid + NTHR * i;
            gwl[k] = t0[i].x; gwl[2048 + k] = t0[i].y; gwl[4096 + k] = t0[i].z; gwl[6144 + k] = t0[i].w;
            gwl[8192 + k] = t1[i].x; gwl[10240 + k] = t1[i].y; gwl[12288 + k] = t1[i].z; gwl[14336 + k] = t1[i].w; }
        __syncthreads();
    }
    for (int m0 = gw * RP; m0 < NTOK; m0 += NGW * RP) {
        f32x4 v[RP][8];
        const bf16* orow[RP][2]; float cw[RP][2];
        if (MODE == 1 || MODE == 3) {
#pragma unroll
            for (int r = 0; r < RP; ++r) { const int m = m0 + r;
                const int e0 = toke[2 * m], e1 = toke[2 * m + 1], p0 = tokp[2 * m], p1 = tokp[2 * m + 1];
                cw[r][0] = ((const float*)(ws + MS_TOKW))[2 * m]; cw[r][1] = ((const float*)(ws + MS_TOKW))[2 * m + 1];
                orow[r][0] = OP + (size_t)(off[e0] * 256 + p0) * DM + 4 * lane; orow[r][1] = OP + (size_t)(off[e1] * 256 + p1) * DM + 4 * lane; }
        }
#pragma unroll
        for (int r = 0; r < RP; ++r)
#pragma unroll
            for (int j = 0; j < 8; ++j) v[r][j] = *(const f32x4*)(src + (size_t)(m0 + r) * DM + 256 * j + 4 * lane);
        if (MODE == 1 || MODE == 3) {
            u32x2 ow[RP][2][8];
#pragma unroll
            for (int r = 0; r < RP; ++r)
#pragma unroll
                for (int j = 0; j < 8; ++j) { ow[r][0][j] = *(const u32x2*)(orow[r][0] + 256 * j); ow[r][1][j] = *(const u32x2*)(orow[r][1] + 256 * j); }
#pragma unroll
            for (int r = 0; r < RP; ++r)
                asm volatile("" : "+v"(ow[r][0][0]), "+v"(ow[r][0][1]), "+v"(ow[r][0][2]), "+v"(ow[r][0][3]), "+v"(ow[r][0][4]), "+v"(ow[r][0][5]), "+v"(ow[r][0][6]), "+v"(ow[r][0][7]),
                                  "+v"(ow[r][1][0]), "+v"(ow[r][1][1]), "+v"(ow[r][1][2]), "+v"(ow[r][1][3]), "+v"(ow[r][1][4]), "+v"(ow[r][1][5]), "+v"(ow[r][1][6]), "+v"(ow[r][1][7]));
#pragma unroll
            for (int r = 0; r < RP; ++r) { const int m = m0 + r; const float cw0 = cw[r][0], cw1 = cw[r][1];
#pragma unroll
                for (int j = 0; j < 8; ++j) { const u32x2 w0 = ow[r][0][j], w1 = ow[r][1][j];
                    v[r][j].x += cw0 * bflo(w0.x) + cw1 * bflo(w1.x); v[r][j].y += cw0 * bfhi(w0.x) + cw1 * bfhi(w1.x); v[r][j].z += cw0 * bflo(w0.y) + cw1 * bflo(w1.y); v[r][j].w += cw0 * bfhi(w0.y) + cw1 * bfhi(w1.y); }
                if (MODE == 1 && !dry) {
#pragma unroll
                    for (int j = 0; j < 8; ++j) *(f32x4*)(a->out + (size_t)m * DM + 256 * j + 4 * lane) = v[r][j]; }
            }
        }
        float rs[RP];
#pragma unroll
        for (int r = 0; r < RP; ++r) { float ss = 0.f;
#pragma unroll
            for (int j = 0; j < 8; ++j) ss += (v[r][j].x * v[r][j].x + v[r][j].y * v[r][j].y) + (v[r][j].z * v[r][j].z + v[r][j].w * v[r][j].w);
            rs[r] = __builtin_amdgcn_rsqf(wave_sum(ss) * (1.0f / DM) + RMS_EPS); }
        {
            f32x4 gv[8];
            int l4 = 4 * lane; asm volatile("" : "+v"(l4)); const float* gp = gain + l4;
#pragma unroll
            for (int j = 0; j < 8; ++j) gv[j] = *(const f32x4*)(gp + 256 * j);
            asm volatile("" : "+v"(gv[0]), "+v"(gv[1]), "+v"(gv[2]), "+v"(gv[3]), "+v"(gv[4]), "+v"(gv[5]), "+v"(gv[6]), "+v"(gv[7]));
#pragma unroll
            for (int j = 0; j < 8; ++j)
#pragma unroll
                for (int r = 0; r < RP; ++r) v[r][j] = v[r][j] * rs[r] * gv[j];
        }
        if (MODE == 3) {
#pragma unroll
            for (int r = 0; r < RP; ++r)
#pragma unroll
                for (int j = 0; j < 8; ++j) { if (!dry) *(f32x4*)(a->out + (size_t)(m0 + r) * DM + 256 * j + 4 * lane) = v[r][j]; else asm volatile("" :: "v"(v[r][j])); }
            continue;
        }
#pragma unroll
        for (int r = 0; r < RP; ++r)
#pragma unroll
            for (int j = 0; j < 8; ++j) { u32x2 w; w.x = cvt_pk_bf16(v[r][j].x, v[r][j].y); w.y = cvt_pk_bf16(v[r][j].z, v[r][j].w);
                if (!dry) *(u32x2*)(H + (size_t)(m0 + r) * DM + 256 * j + 4 * lane) = w; else asm volatile("" :: "v"(w)); }
        float keep[RP]; _Pragma("unroll") for (int r = 0; r < RP; ++r) keep[r] = 0.f;
        if (MODE < 2) {
            float a8[RP][8];
#pragma unroll
            for (int r = 0; r < RP; ++r)
#pragma unroll
                for (int n = 0; n < 8; ++n) a8[r][n] = 0.f;
#pragma unroll
            for (int j = 0; j < 8; ++j) {
#pragma unroll
                for (int nh = 0; nh < 2; ++nh) {
                    f32x4 wn[4];
#pragma unroll
                    for (int n = 0; n < 4; ++n) wn[n] = *(const LAS f32x4*)(gwl + (4 * nh + n) * 2048 + 256 * j + 4 * lane);
                    asm volatile("" : "+v"(wn[0]), "+v"(wn[1]), "+v"(wn[2]), "+v"(wn[3]));
#pragma unroll
                    for (int r = 0; r < RP; ++r)
#pragma unroll
                        for (int n = 0; n < 4; ++n) a8[r][4 * nh + n] += (v[r][j].x * wn[n].x + v[r][j].y * wn[n].y) + (v[r][j].z * wn[n].z + v[r][j].w * wn[n].w);
                }
            }
#pragma unroll
            for (int r = 0; r < RP; ++r)
#pragma unroll
                for (int n = 0; n < 8; ++n) { const float d = wave_sum(a8[r][n]); keep[r] = (lane == n) ? d : keep[r]; }
        } else {
            const float* W = (const float*)(ws + MS_WRT) + (size_t)l * 36 * 2048;
            LAS float* logl = (LAS float*)(misc + MO_LOG) + wave * 160;
#pragma unroll 1
            for (int grp = 0; grp < 9; ++grp) {
                float val[16];
                const float* wg = W + (size_t)(4 * grp) * 2048 + 4 * lane;
#pragma unroll
                for (int nl = 0; nl < 4; ++nl) {
                    f32x2 d[4] = {(f32x2){0.f, 0.f}, (f32x2){0.f, 0.f}, (f32x2){0.f, 0.f}, (f32x2){0.f, 0.f}};
                    f32x4 wv[8];
#pragma unroll
                    for (int j = 0; j < 8; ++j) wv[j] = *(const f32x4*)(wg + nl * 2048 + 256 * j);
                    asm volatile("" : "+v"(wv[0]), "+v"(wv[1]), "+v"(wv[2]), "+v"(wv[3]), "+v"(wv[4]), "+v"(wv[5]), "+v"(wv[6]), "+v"(wv[7]));
#pragma unroll
                    for (int j = 0; j < 8; ++j) { const f32x4 w = wv[j];
#pragma unroll
                        for (int r = 0; r < 4; ++r) { d[r] = __builtin_elementwise_fma((f32x2){v[r][j].x, v[r][j].y}, (f32x2){w.x, w.y}, d[r]); d[r] = __builtin_elementwise_fma((f32x2){v[r][j].z, v[r][j].w}, (f32x2){w.z, w.w}, d[r]); } }
#pragma unroll
                    for (int r = 0; r < 4; ++r) val[4 * nl + r] = d[r].x + d[r].y;
                }
#pragma unroll
                for (int i = 0; i < 8; ++i) { const bool hi = (lane & 32) != 0; const float snd = hi ? val[i] : val[i + 8]; const float kp = hi ? val[i + 8] : val[i]; val[i] = kp + __shfl_xor(snd, 32); }
#pragma unroll
                for (int i = 0; i < 4; ++i) { const bool hi = (lane & 16) != 0; const float snd = hi ? val[i] : val[i + 4]; const float kp = hi ? val[i + 4] : val[i]; val[i] = kp + __shfl_xor(snd, 16); }
#pragma unroll
                for (int i = 0; i < 2; ++i) { const bool hi = (lane & 8) != 0; const float snd = hi ? val[i] : val[i + 2]; const float kp = hi ? val[i + 2] : val[i]; val[i] = kp + __shfl_xor(snd, 8); }
                { const bool hi = (lane & 4) != 0; const float snd = hi ? val[0] : val[1]; const float kp = hi ? val[1] : val[0]; val[0] = kp + __shfl_xor(snd, 4); }
                float f = val[0]; f += __shfl_xor(f, 2); f += __shfl_xor(f, 1);
                const int vi = lane >> 2;
                if ((lane & 3) == 0) logl[(vi & 3) * 40 + 4 * grp + (vi >> 2)] = f;
            }
        }
        if (MODE < 2) {
            float* ifg = (float*)(ws + MS_IFG);
            if (lane < 8) {
#pragma unroll
                for (int r = 0; r < RP; ++r) { if (!dry) ifg[(size_t)(m0 + r) * 8 + lane] = keep[r]; else asm volatile("" :: "v"(keep[r])); } }
        } else {
            LAS float* logl = (LAS float*)(misc + MO_LOG) + wave * 160;
            LDS_WAIT();
            if (dry) { asm volatile("" :: "v"(keep[0])); }
            if (lane < RP && !dry) {
                const int m = m0 + lane; const LAS float* lg = logl + lane * 40;
                const float* bg = a->in[I_BGRP] + l * 4; const float* be = a->in[I_BEXP] + l * 32;
                float gv[4]; int gsel = 0;
#pragma unroll
                for (int j = 0; j < 4; ++j) gv[j] = lg[j] + bg[j];
                float gmax = gv[0];
#pragma unroll
                for (int j = 1; j < 4; ++j) if (gv[j] > gmax) { gmax = gv[j]; gsel = j; }
                float gs = 0.f;
#pragma unroll
                for (int j = 0; j < 4; ++j) gs += expf(gv[j] - gmax);
                const float pg = 1.0f / gs;
                float ev[8];
#pragma unroll
                for (int j = 0; j < 8; ++j) ev[j] = lg[4 + 8 * gsel + j] + be[8 * gsel + j];
                int e0 = 0; float m0v = ev[0];
#pragma unroll
                for (int j = 1; j < 8; ++j) if (ev[j] > m0v) { m0v = ev[j]; e0 = j; }
                int e1 = -1; float m1v = -3.0e38f;
#pragma unroll
                for (int j = 0; j < 8; ++j) if (j != e0 && ev[j] > m1v) { m1v = ev[j]; e1 = j; }
                const float p1 = expf(m1v - m0v); const float w0 = pg / (1.0f + p1), w1 = pg * p1 / (1.0f + p1);
                unsigned* cnt = (unsigned*)(ws + WS_CTL) + CW_CNT + 32 * l;
                int* list = (int*)(ws + MS_LIST); float* pwl = (float*)(ws + MS_PWL); int* tke = (int*)(ws + MS_TOKE); int* tkp = (int*)(ws + MS_TOKP);
                const int id0 = 8 * gsel + e0, id1 = 8 * gsel + e1;
                const int q0 = (int)__hip_atomic_fetch_add(cnt + id0, 1u, __ATOMIC_RELAXED, __HIP_MEMORY_SCOPE_AGENT);
                const int q1 = (int)__hip_atomic_fetch_add(cnt + id1, 1u, __ATOMIC_RELAXED, __HIP_MEMORY_SCOPE_AGENT);
                list[id0 * 8192 + q0] = m; pwl[id0 * 8192 + q0] = w0; list[id1 * 8192 + q1] = m; pwl[id1 * 8192 + q1] = w1;
                tke[2 * m] = id0; tke[2 * m + 1] = id1; tkp[2 * m] = q0; tkp[2 * m + 1] = q1;
                ((float*)(ws + MS_TOKW))[2 * m] = w0; ((float*)(ws + MS_TOKW))[2 * m + 1] = w1;
            }
            LDS_WAIT();
        }
    }
}

struct SchedG1 {
    static constexpr bool GATHER = false;
    const char* H; const char* W; int G, c;
    static constexpr int NCV = 21;
    __device__ __forceinline__ bool next(int i, Unit& u) const {
        int L = i * G + c;
        if (G == 256) {
            if (c >= 256 - NCV) return false;
            if (c >= 128 && i == 5) { const int k = c - 128; if (k >= 5 * NCV) return false; L = (k % 5) * 256 + (256 - NCV) + k / 5; }
            else if (i > 5) return false;
        }
        if (L < 1152) { pg8::static_tile(L, 32, 36, u.pm, u.pn); u.aux = 0; return true; }
        const int r = L - 1152; if (r >= 256) return false;
        u.aux = 1 + (r >> 7); const int q = r & 127; u.pm = q & 3; u.pn = q >> 2; return true;
    }
    __device__ __forceinline__ const char* abase(const Unit& u) const { return u.aux == 0 ? H + (size_t)u.pm * 256 * 4096 : W + (size_t)(9216 + (u.aux - 1) * 1024 + u.pm * 256) * 4096; }
    __device__ __forceinline__ const char* bbase(const Unit& u) const { return u.aux == 0 ? W + (size_t)u.pn * 256 * 4096 : H + (size_t)u.pn * 256 * 4096; }
    __device__ __forceinline__ unsigned arow(const Unit&, int) const { return 0u; }
    static __device__ __forceinline__ bool keep_acc(const Unit&) { return false; }
};
struct EpiG1 {
    static constexpr bool PERM = true;
    unsigned char* ws; bool dry;
    __device__ __forceinline__ void operator()(f32x4 (&acc)[2][2][4][2], const Unit& u, int wr, int wc, int fr, int fq) const {
        if (dry) {
#pragma unroll
            for (int ai = 0; ai < 2; ++ai)
#pragma unroll
                for (int bj = 0; bj < 2; ++bj)
#pragma unroll
                    for (int m = 0; m < 4; ++m) asm volatile("" :: "v"(acc[ai][bj][m][0]), "v"(acc[ai][bj][m][1]));
            return; }
        if (u.aux == 0) {
            bf16* dst; int ld, colt, op;
            if (u.pn < 8) { dst = (bf16*)(ws + WS_ZQK); ld = 2048; colt = 256 * u.pn; op = 0; }
            else if (u.pn < 12) { dst = (bf16*)(ws + WS_OM); ld = 1024; colt = 256 * (u.pn - 8); op = 1; }
            else if (u.pn < 16) { dst = (bf16*)(ws + WS_QA); ld = 1024; colt = 256 * (u.pn - 12); op = 2; }
            else if (u.pn < 20) { dst = (bf16*)(ws + WS_KA); ld = 1024; colt = 256 * (u.pn - 16); op = 0; }
            else { dst = (bf16*)(ws + WS_SG); ld = 4096; colt = 256 * (u.pn - 20); op = 1; }
            const float scl = (op == 2) ? 0.12751743074602267f : 1.0f;
            const int row0 = u.pm * 256 + wr * 64 + fr, col0 = colt + wc * 32 + 8 * fq;
#pragma unroll
            for (int ai = 0; ai < 2; ++ai)
#pragma unroll
                for (int m = 0; m < 4; ++m) { bf16* rowp = dst + (size_t)(row0 + ai * 128 + m * 16) * ld + col0;
#pragma unroll
                    for (int bj = 0; bj < 2; ++bj) { f32x4 v0 = acc[ai][bj][m][0] * scl, v1 = acc[ai][bj][m][1] * scl;
                        if (op == 1) {
#pragma unroll
                            for (int j = 0; j < 4; ++j) { v0[j] = sigmoidf_(v0[j]); v1[j] = sigmoidf_(v1[j]); } }
                        u32x4 w; w.x = cvt_pk_bf16(v0[0], v0[1]); w.y = cvt_pk_bf16(v0[2], v0[3]); w.z = cvt_pk_bf16(v1[0], v1[1]); w.w = cvt_pk_bf16(v1[2], v1[3]);
                        *(u32x4*)(rowp + bj * 128) = w; } }
        } else {
            bf16* dst = (bf16*)(ws + (u.aux == 1 ? WS_VMT : WS_VAT));
            const int b = u.pn >> 3, s0 = (u.pn & 7) * 256 + wc * 32 + 8 * fq, rr0 = u.pm * 256 + wr * 64 + fr;
#pragma unroll
            for (int ai = 0; ai < 2; ++ai)
#pragma unroll
                for (int m = 0; m < 4; ++m) { const int rr = rr0 + ai * 128 + m * 16;
#pragma unroll
                    for (int bj = 0; bj < 2; ++bj) { const f32x4 v0 = acc[ai][bj][m][0], v1 = acc[ai][bj][m][1];
                        u32x4 w; w.x = cvt_pk_bf16(v0[0], v0[1]); w.y = cvt_pk_bf16(v0[2], v0[3]); w.z = cvt_pk_bf16(v1[0], v1[1]); w.w = cvt_pk_bf16(v1[2], v1[3]);
                        const int sq = s0 + bj * 128;
                        const size_t off = (u.aux == 1) ? (size_t)((((b * 4 + (rr >> 8)) * 32 + (sq >> 6)) * 2 + ((sq >> 5) & 1)) * 16 + ((rr & 255) >> 4)) * 512 + (size_t)((((sq >> 3) & 3) * 16 + (rr & 15)) * 8)
                                                        : (size_t)(b * 1024 + rr) * 2048 + sq;
                        *(u32x4*)(dst + off) = w; } }
        }
    }
};

__device__ __forceinline__ void gate_unit(ArgsP a, int l, LAS unsigned char* lds, int bh, int tid, int lane, int wave) {
    unsigned char* ws = a->ws;
    {
            const int b = bh >> 2, h = bh & 3;
            LAS float* bl = (LAS float*)lds; LAS float* amx = bl + 32; LAS float* mpv = bl + 64; LAS float* gcv = bl + 96;
            const float* ifg = (const float*)(ws + MS_IFG); const float* ifb = a->in[I_IFB] + l * 8;
            float A[4], Bs[4], CM[4];
#pragma unroll
            for (int cc = 0; cc < 4; ++cc) { const int c = wave + 8 * cc, s = 64 * c + lane; const size_t tok = (size_t)b * SEQ + s;
                const float ig = ifg[tok * 8 + h] + ifb[h], fg = ifg[tok * 8 + 4 + h] + ifb[4 + h];
                const float lf = fminf(fg, 0.f) - log1pf(expf(-fabsf(fg)));
                float bs = lf;
#pragma unroll
                for (int o = 1; o < 64; o <<= 1) { const float t = __shfl_up(bs, o); if (lane >= o) bs += t; }
                const float av = ig - bs; float cm = av;
#pragma unroll
                for (int o = 1; o < 64; o <<= 1) { const float t = __shfl_up(cm, o); if (lane >= o) cm = fmaxf(cm, t); }
                A[cc] = av; Bs[cc] = bs; CM[cc] = cm;
                if (lane == 63) { bl[c] = bs; amx[c] = cm; } }
            __syncthreads();
            if (tid == 0) { float m = 0.f;
#pragma unroll 1
                for (int c = 0; c < 32; ++c) { mpv[c] = m; const float Gm = fmaxf(m, amx[c]); gcv[c] = Gm; m = bl[c] + Gm; } }
            __syncthreads();
            float* AS = (float*)(ws + MS_AS) + bh * 2048; float* GT = (float*)(ws + MS_GT) + bh * 2048; float* WI = (float*)(ws + MS_WI) + bh * 2048;
            float* CL = (float*)(ws + MS_CL) + bh * 2048; float* WSs = (float*)(ws + MS_WS) + bh * 2048; float* DEC = (float*)(ws + MS_DEC) + bh * 32;
#pragma unroll
            for (int cc = 0; cc < 4; ++cc) { const int c = wave + 8 * cc, s = 64 * c + lane; const float mp = mpv[c], Gm = gcv[c], gt = fmaxf(mp, CM[cc]);
                AS[s] = A[cc]; GT[s] = gt; WI[s] = expf(mp - gt); CL[s] = expf(-(Bs[cc] + gt)); WSs[s] = expf(A[cc] - Gm);
                if (lane == 0) DEC[c] = expf(mp - Gm); }
        }
    __syncthreads();
}

__device__ __forceinline__ void conv_phase(ArgsP a, int l, LAS unsigned char* lds, int tid, int lane, int wave, int bid, int G) {
    unsigned char* ws = a->ws;
    u32x4 xv[5];
    const bf16* Z = (const bf16*)(ws + WS_ZQK);
#define CONV_LOAD(u_) do { const int cg_ = (u_) & 7, s0_ = 64 * (((u_) >> 3) & 31), b_ = (u_) >> 8; _Pragma("unroll") for (int i = 0; i < 5; ++i) { \
        const int idx = tid + NTHR * i, row = idx >> 5, ch = idx & 31, sq = s0_ - 3 + row; xv[i] = (u32x4){0u, 0u, 0u, 0u}; \
        if (idx < 67 * 32 && sq >= 0) xv[i] = *(const u32x4*)(Z + (size_t)(b_ * SEQ + sq) * 2048 + cg_ * 256 + ch * 8); } } while (0)
    if (bid < 1024) CONV_LOAD(bid);
    for (int u = bid; u < 1024 + 256; u += G) {
        if (u < 1024) {
            const int cg = u & 7, st = (u >> 3) & 31, b = u >> 8, s0 = 64 * st;
            LAS unsigned char* xt = lds; LAS unsigned char* kt = lds + 36864;
            asm volatile("" : "+v"(xv[0]), "+v"(xv[1]), "+v"(xv[2]), "+v"(xv[3]), "+v"(xv[4]));
#pragma unroll
            for (int i = 0; i < 5; ++i) { const int idx = tid + NTHR * i, row = idx >> 5, ch = idx & 31;
                if (idx < 67 * 32) *(LAS u32x4*)(xt + row * 512 + ch * 16) = xv[i]; }
            LAS float* wst = (LAS float*)(lds + 73728);
            if (cg >= 4 && tid < 64) wst[tid] = ((const float*)(ws + MS_WS))[(size_t)(b * 4 + cg - 4) * 2048 + s0 + tid];
            __syncthreads();
            if (u + G < 1024) CONV_LOAD(u + G);
            const int cp = tid & 127, tg = tid >> 7, c = 2 * cp, gc = cg * 256 + c;
            float w0[4], w1[4];
#pragma unroll
            for (int j = 0; j < 4; ++j) { w0[j] = a->in[I_CONVW][(size_t)(l * 4 + j) * 2048 + gc]; w1[j] = a->in[I_CONVW][(size_t)(l * 4 + j) * 2048 + gc + 1]; }
            bf16* QM = (bf16*)(ws + WS_QM); bf16* KM = (bf16*)(ws + WS_KM);
#pragma unroll 4
            for (int tt = 0; tt < 16; ++tt) { const int t = tg * 16 + tt; float a0 = 0.f, a1 = 0.f;
#pragma unroll
                for (int j = 0; j < 4; ++j) { const unsigned x = *(const LAS unsigned*)(xt + (t + j) * 512 + c * 2); a0 += w0[j] * bflo(x); a1 += w1[j] * bfhi(x); }
                float o0 = a0 * sigmoidf_(a0), o1 = a1 * sigmoidf_(a1);
                const size_t tok = (size_t)b * SEQ + s0 + t;
                if (cg < 4) { *(unsigned*)(QM + tok * 1024 + cg * 256 + c) = cvt_pk_bf16(o0, o1); }
                else { o0 *= 0.0625f; o1 *= 0.0625f; const unsigned p = cvt_pk_bf16(o0, o1);
                    *(unsigned*)(KM + tok * 1024 + (cg - 4) * 256 + c) = p;
                    const float wsv = wst[t]; const unsigned ps = cvt_pk_bf16(o0 * wsv, o1 * wsv);
                    *(LAS unsigned short*)(kt + c * 144 + t * 2) = (unsigned short)(ps & 0xffffu); *(LAS unsigned short*)(kt + (c + 1) * 144 + t * 2) = (unsigned short)(ps >> 16); }
            }
            if (cg >= 4) {
                __syncthreads();
                bf16* KMT = (bf16*)(ws + WS_KMT);
                for (int idx = tid; idx < 2048; idx += NTHR) {
                    const int ks = idx >> 10, dtl = (idx >> 6) & 15, ln = idx & 63, row = dtl * 16 + (ln & 15), ch = ks * 4 + (ln >> 4);
                    const u32x4 v = *(const LAS u32x4*)(kt + row * 144 + ch * 16);
                    *(u32x4*)(KMT + (size_t)(((b * 4 + cg - 4) * 32 + st) * 2) * 8192 + (size_t)idx * 8) = v; }
                if (tid < 256) {
                    float sm = 0.f;
#pragma unroll
                    for (int i = 0; i < 8; ++i) { const u32x4 v = *(const LAS u32x4*)(kt + tid * 144 + i * 16);
                        sm += (bflo(v.x) + bfhi(v.x)) + (bflo(v.y) + bfhi(v.y)) + (bflo(v.z) + bfhi(v.z)) + (bflo(v.w) + bfhi(v.w)); }
                    ((float*)(ws + MS_NST))[(size_t)((b * 4 + cg - 4) * 32 + st) * 256 + tid] = sm; }
            }
        } else if (u < 1280) {
            const int j = u - 1024, b = j >> 6, n = (j >> 3) & 7, h = j & 7;
            const bf16* KA = (const bf16*)(ws + WS_KA) + (size_t)(b * SEQ + n * 256 + wave * 32) * 1024 + h * 128 + 2 * lane;
            float s0 = 0.f, s1 = 0.f;
            unsigned xr[32];
#pragma unroll
            for (int r = 0; r < 32; ++r) xr[r] = *(const unsigned*)(KA + (size_t)r * 1024);
#pragma unroll
            for (int r = 0; r < 32; r += 8) asm volatile("" : "+v"(xr[r]), "+v"(xr[r + 1]), "+v"(xr[r + 2]), "+v"(xr[r + 3]), "+v"(xr[r + 4]), "+v"(xr[r + 5]), "+v"(xr[r + 6]), "+v"(xr[r + 7]));
#pragma unroll
            for (int r = 0; r < 32; ++r) { s0 += bflo(xr[r]); s1 += bfhi(xr[r]); }
            LAS float* part = (LAS float*)lds;
            part[wave * 128 + 2 * lane] = s0; part[wave * 128 + 2 * lane + 1] = s1;
            __syncthreads();
            if (tid < 128) { float t = 0.f;
#pragma unroll
                for (int w = 0; w < 8; ++w) t += part[w * 128 + tid];
                ((float*)(ws + MS_KMEAN))[(size_t)((b * 8 + h) * 8 + n) * 128 + tid] = t * (1.0f / 256.0f); }
        }
        __syncthreads();
    }
}

#undef CONV_LOAD
__device__ __forceinline__ void mlstm_ab_task(unsigned char* ws, int gw, int lane, const bool do_store = true) {
    const int bh = gw >> 7, piece = gw & 127, e0 = (piece >> 3) * 16, d0 = (piece & 7) * 32, q16 = lane & 15, g = lane >> 4;
    const bf16* ka = (const bf16*)(ws + WS_KMT) + (size_t)bh * 32 * 16384 + (size_t)(d0 >> 4) * 512 + lane * 8;
    const bf16* vb = (const bf16*)(ws + WS_VMT) + (size_t)bh * 32 * 16384 + (size_t)(e0 >> 4) * 512 + lane * 8;
    const float* DEC = (const float*)(ws + MS_DEC) + bh * 32;
    bf16* CST = (bf16*)(ws + WS_CST) + (size_t)bh * 32 * 65536 + (size_t)((d0 >> 5) * 16 + (e0 >> 4)) * 512 + (size_t)(((g >> 1) * 16 + q16) * 8 + 4 * (g & 1));
    f32x4 acc[2]; acc[0] = (f32x4){0.f, 0.f, 0.f, 0.f}; acc[1] = acc[0];
    const int decv = __builtin_bit_cast(int, DEC[lane & 31]);
    bf16x8 A0[2][2], B0[2], A1[2][2], B1[2], A2[2][2], B2[2], A3[2][2], B3[2], A4[2][2], B4[2];
#define AB_LOAD(c_, A_, B_) do { const int cc_ = (c_) < 31 ? (c_) : 31; _Pragma("unroll") for (int ks = 0; ks < 2; ++ks) { \
        A_[0][ks] = *(const bf16x8*)(ka + (size_t)cc_ * 16384 + ks * 8192); A_[1][ks] = *(const bf16x8*)(ka + (size_t)cc_ * 16384 + ks * 8192 + 512); B_[ks] = *(const bf16x8*)(vb + (size_t)cc_ * 16384 + ks * 8192); } } while (0)
#define AB_STEP(c_, A_, B_) do { \
        if (do_store) { _Pragma("unroll") for (int f = 0; f < 2; ++f) { u32x2 w; w.x = cvt_pk_bf16(acc[f][0], acc[f][1]); w.y = cvt_pk_bf16(acc[f][2], acc[f][3]); *(u32x2*)(CST + (size_t)(c_) * 65536 + 256 * f) = w; } } \
        const float dec = __builtin_bit_cast(float, __builtin_amdgcn_readlane(decv, (c_))); \
        acc[0] = acc[0] * dec; acc[1] = acc[1] * dec; \
        _Pragma("unroll") for (int ks = 0; ks < 2; ++ks) { \
            acc[0] = __builtin_amdgcn_mfma_f32_16x16x32_bf16(A_[0][ks], B_[ks], acc[0], 0, 0, 0); \
            acc[1] = __builtin_amdgcn_mfma_f32_16x16x32_bf16(A_[1][ks], B_[ks], acc[1], 0, 0, 0); } } while (0)
    AB_LOAD(0, A0, B0); AB_LOAD(1, A1, B1); AB_LOAD(2, A2, B2); AB_LOAD(3, A3, B3); AB_LOAD(4, A4, B4);
#pragma unroll 1
    for (int c = 0; c < 30; c += 5) {
        AB_STEP(c, A0, B0); AB_LOAD(c + 5, A0, B0);
        AB_STEP(c + 1, A1, B1); AB_LOAD(c + 6, A1, B1);
        AB_STEP(c + 2, A2, B2); AB_LOAD(c + 7, A2, B2);
        AB_STEP(c + 3, A3, B3); AB_LOAD(c + 8, A3, B3);
        AB_STEP(c + 4, A4, B4); AB_LOAD(c + 9, A4, B4);
    }
    AB_STEP(30, A0, B0); AB_STEP(31, A1, B1);
    if (!do_store) asm volatile("" :: "v"(acc[0]), "v"(acc[1]));
#undef AB_LOAD
#undef AB_STEP
}

__device__ __forceinline__ void nscan_task(unsigned char* ws, int t, int lane) {
    const int bh = t >> 2, d = (t & 3) * 64 + lane;
    const float* cs = (const float*)(ws + MS_NST) + (size_t)bh * 32 * 256 + d;
    float* nv = (float*)(ws + MS_NVEC) + (size_t)bh * 32 * 256 + d;
    const int decv = __builtin_bit_cast(int, ((const float*)(ws + MS_DEC))[bh * 32 + (lane & 31)]);
    float v[32];
#pragma unroll
    for (int j = 0; j < 32; ++j) v[j] = cs[j * 256];
    float n = 0.f;
#pragma unroll
    for (int j = 0; j < 32; ++j) { nv[j * 256] = n; n = __builtin_bit_cast(float, __builtin_amdgcn_readlane(decv, j)) * n + v[j]; }
}

__device__ __forceinline__ int rel_bucket_dev(int n) {
    if (n < 16) return n;
    int b = 16;
    b += (n >= 19); b += (n >= 21); b += (n >= 24); b += (n >= 27); b += (n >= 31); b += (n >= 35); b += (n >= 40); b += (n >= 46);
    b += (n >= 52); b += (n >= 59); b += (n >= 67); b += (n >= 77); b += (n >= 87); b += (n >= 99); b += (n >= 113);
    return b;
}
constexpr int AT_KT = 0, AT_VT = 34816, AT_TAB = 71680, AT_SEL = 72704, AT_TILES = 73216, AT_CTL = 73600, AT_KM = 73728;
__device__ __forceinline__ void attn_unit(ArgsP a, LAS unsigned char* lds, int uidx, int tid, int lane, int wave) {
    unsigned char* ws = a->ws;
    const int u256 = uidx & 255, second = uidx >> 8, bh = u256 >> 3, kk8 = u256 & 7, si = second ? 15 - kk8 : kk8, wgt = 16 - si;
    const int blk = (wgt - 1) >> 1, half = (wgt - 1) & 1, b = bh >> 3, h = bh & 7, q0 = blk * 256 + half * 128;
    const int q16 = lane & 15, g = lane >> 4;
    LAS float* tab = (LAS float*)(lds + AT_TAB); LAS unsigned* sels = (LAS unsigned*)(lds + AT_SEL); LAS int* tiles = (LAS int*)(lds + AT_TILES);
    LAS unsigned* ctl = (LAS unsigned*)(lds + AT_CTL); LAS float* kms = (LAS float*)(lds + AT_KM);
    const bf16* QA = (const bf16*)(ws + WS_QA); const bf16* KA = (const bf16*)(ws + WS_KA); const bf16* VAT = (const bf16*)(ws + WS_VAT);
    u32x4 sr[8], qst[4];
    const int row0 = tid >> 4, ch = tid & 15;
    const bf16* kbase = KA + (size_t)(b * SEQ + row0) * 1024 + h * 128 + ch * 8;
    const bf16* vbase = VAT + (size_t)(bh * 128 + row0) * 2048 + ch * 8;
#define AT_LOAD(ks0_) do { _Pragma("unroll") for (int i = 0; i < 4; ++i) { \
        sr[i] = *(const u32x4*)(kbase + (size_t)((ks0_) + 32 * i) * 1024); sr[4 + i] = *(const u32x4*)(vbase + (size_t)(32 * i) * 2048 + (ks0_)); } } while (0)
#pragma unroll
    for (int i = 0; i < 4; ++i) qst[i] = *(const u32x4*)(QA + (size_t)(b * SEQ + q0 + row0 + 32 * i) * 1024 + h * 128 + ch * 8);
    AT_LOAD(blk * 256);
    if (tid <= 128) tab[tid] = a->in[I_RELB][rel_bucket_dev(tid) * 8 + h] * 1.4426950408889634f;
    for (int idx = tid; idx < 1024; idx += NTHR) kms[idx] = ((const float*)(ws + MS_KMEAN))[bh * 1024 + idx];
    if (tid == 0) ctl[0] = 0u;
    __syncthreads();
    {
        const int q = tid >> 2, part = tid & 3;
        const bf16* qp = QA + (size_t)(b * SEQ + q0 + q) * 1024 + h * 128 + part * 32;
        float qf32[32];
#pragma unroll
        for (int i = 0; i < 4; ++i) { const u32x4 v = *(const u32x4*)(qp + 8 * i);
            qf32[8 * i + 0] = bflo(v.x); qf32[8 * i + 1] = bfhi(v.x); qf32[8 * i + 2] = bflo(v.y); qf32[8 * i + 3] = bfhi(v.y);
            qf32[8 * i + 4] = bflo(v.z); qf32[8 * i + 5] = bfhi(v.z); qf32[8 * i + 6] = bflo(v.w); qf32[8 * i + 7] = bfhi(v.w); }
        float gate[8];
#pragma unroll
        for (int n = 0; n < 8; ++n) { float s = 0.f;
            if (n < blk) {
#pragma unroll
                for (int d = 0; d < 32; d += 4) { const f32x4 kv = *(const LAS f32x4*)(kms + n * 128 + part * 32 + d);
                    s += (qf32[d] * kv.x + qf32[d + 1] * kv.y) + (qf32[d + 2] * kv.z + qf32[d + 3] * kv.w); }
            }
            s += __shfl_xor(s, 1); s += __shfl_xor(s, 2); gate[n] = s; }
        if (part == 0) {
            unsigned sel;
            if (blk <= 3) sel = (1u << blk) - 1u;
            else { sel = 0u;
#pragma unroll
                for (int it = 0; it < 3; ++it) { int best = 0; float bv = -3.0e38f;
#pragma unroll
                    for (int n = 0; n < 8; ++n) if (n < blk && !((sel >> n) & 1u) && gate[n] > bv) { bv = gate[n]; best = n; }
                    sel |= 1u << best; } }
            sels[q] = sel; atomicOr((unsigned*)ctl, sel);
        }
    }
    __syncthreads();
    if (tid == 0) { int nt = 0; const unsigned any = ctl[0];
        for (int j = 0; j < half + 1; ++j) tiles[nt++] = blk * 256 + 128 * j;
        for (int n = 0; n < blk; ++n) if ((any >> n) & 1u) for (int j = 0; j < 2; ++j) tiles[nt++] = n * 256 + 128 * j;
        ctl[1] = (unsigned)nt; }
    __syncthreads();
    const int ntiles = (int)ctl[1];
    const int qg = wave & 3, kp = wave >> 2;
    int qpos[2]; unsigned mysel[2];
#pragma unroll
    for (int f = 0; f < 2; ++f) { qpos[f] = q0 + 32 * qg + 16 * f + q16; mysel[f] = sels[32 * qg + 16 * f + q16]; }
    constexpr int AT_Q = 77824;
#pragma unroll
    for (int i = 0; i < 4; ++i) *(LAS u32x4*)(lds + AT_Q + (row0 + 32 * i) * 272 + ch * 16) = qst[i];
    const LAS unsigned char* qrow = lds + AT_Q + (32 * qg + q16) * 272 + 16 * g;
    float m_run[2] = {-1.0e30f, -1.0e30f}, l_run[2] = {0.f, 0.f};
    f32x4 oacc[2][8];
#pragma unroll
    for (int f = 0; f < 2; ++f)
#pragma unroll
        for (int m = 0; m < 8; ++m) oacc[f][m] = (f32x4){0.f, 0.f, 0.f, 0.f};
    const int vpos = (ch >> 2) * 32 + 16 * (ch & 1) + 4 * ((ch & 3) >> 1);
#define AT_WRITE() do { _Pragma("unroll") for (int i = 0; i < 4; ++i) { \
        *(LAS u32x4*)(lds + AT_KT + (row0 + 32 * i) * 272 + ch * 16) = sr[i]; \
        *(LAS u32x2*)(lds + AT_VT + (row0 + 32 * i) * 272 + vpos * 2) = (u32x2){sr[4 + i].x, sr[4 + i].y}; \
        *(LAS u32x2*)(lds + AT_VT + (row0 + 32 * i) * 272 + (vpos + 8) * 2) = (u32x2){sr[4 + i].z, sr[4 + i].w}; } } while (0)
    AT_WRITE();
    __syncthreads();
    if (ntiles > 1) { const int k1 = tiles[1]; AT_LOAD(k1); }
    for (int ti = 0; ti < ntiles; ++ti) {
        const int kstart = tiles[ti] + 64 * kp, nblk = kstart >> 8;
        const bool own = (nblk == blk);
        const bool any_ok = own ? true : (__any((((mysel[0] | mysel[1]) >> nblk) & 1u) != 0u) != 0);
        const bool active = own ? (kstart <= q0 + 32 * qg + 31) : any_ok;
        if (active) {
            const LAS unsigned char* kt = lds + AT_KT + 64 * kp * 272; const LAS unsigned char* vt = lds + AT_VT + 64 * kp * 2;
            f32x4 s[2][4];
#pragma unroll
            for (int n = 0; n < 4; ++n) { s[0][n] = (f32x4){0.f, 0.f, 0.f, 0.f}; s[1][n] = s[0][n]; }
#pragma unroll
            for (int ks = 0; ks < 4; ++ks) {
                bf16x8 q0f = *(const LAS bf16x8*)(qrow + 64 * ks), q1f = *(const LAS bf16x8*)(qrow + 16 * 272 + 64 * ks);
                bf16x8 kf[4];
#pragma unroll
                for (int n = 0; n < 4; ++n) kf[n] = *(const LAS bf16x8*)(kt + (16 * n + q16) * 272 + (32 * ks + 8 * g) * 2);
                asm volatile("" : "+v"(q0f), "+v"(q1f), "+v"(kf[0]), "+v"(kf[1]), "+v"(kf[2]), "+v"(kf[3]));
#pragma unroll
                for (int n = 0; n < 4; ++n) {
                    s[0][n] = __builtin_amdgcn_mfma_f32_16x16x32_bf16(kf[n], q0f, s[0][n], 0, 0, 0);
                    s[1][n] = __builtin_amdgcn_mfma_f32_16x16x32_bf16(kf[n], q1f, s[1][n], 0, 0, 0); } }
            const bool far = ((q0 + 32 * qg) - (kstart + 63)) >= 128;
            const float bfar = tab[128];
#pragma unroll
            for (int f = 0; f < 2; ++f) {
                const bool lane_ok = own ? true : (((mysel[f] >> nblk) & 1u) != 0u);
                float psum = 0.f, m_new;
#define AT_MNEW(mx_) fmaxf(((mx_) > m_run[f] + 8.0f) ? (mx_) : m_run[f], -1.0e29f)
                if (far) {
                    const float addc = lane_ok ? bfar : -1.0e30f;
                    float mx = -1.0e30f;
#pragma unroll
                    for (int n = 0; n < 4; ++n)
#pragma unroll
                        for (int r = 0; r < 4; ++r) mx = fmaxf(mx, s[f][n][r]);
                    mx = rows4_max(mx + addc);
                    m_new = AT_MNEW(mx);
                    const float cc = addc - m_new;
#pragma unroll
                    for (int n = 0; n < 4; ++n)
#pragma unroll
                        for (int r = 0; r < 4; ++r) { const float p = __builtin_amdgcn_exp2f(s[f][n][r] + cc); s[f][n][r] = p; psum += p; }
                } else {
                    const int kmax = lane_ok ? (own ? qpos[f] : 0x7fffffff) : -1;
                    float mx = -1.0e30f;
                    float bs[4][4];
#pragma unroll
                    for (int n = 0; n < 4; ++n)
#pragma unroll
                        for (int r = 0; r < 4; ++r) { int di = qpos[f] - (kstart + 16 * n + 4 * g + r); di = di < 0 ? 0 : di; di = di > 128 ? 128 : di; bs[n][r] = tab[di]; }
#pragma unroll
                    for (int n = 0; n < 4; ++n) asm volatile("" : "+v"(bs[n][0]), "+v"(bs[n][1]), "+v"(bs[n][2]), "+v"(bs[n][3]));
#pragma unroll
                    for (int n = 0; n < 4; ++n)
#pragma unroll
                        for (int r = 0; r < 4; ++r) { const int key = kstart + 16 * n + 4 * g + r;
                            const float v = (key <= kmax) ? s[f][n][r] + bs[n][r] : -1.0e30f;
                            s[f][n][r] = v; mx = fmaxf(mx, v); }
                    mx = rows4_max(mx);
                    m_new = AT_MNEW(mx);
#pragma unroll
                    for (int n = 0; n < 4; ++n)
#pragma unroll
                        for (int r = 0; r < 4; ++r) { const float p = __builtin_amdgcn_exp2f(s[f][n][r] - m_new); s[f][n][r] = p; psum += p; }
                }
#undef AT_MNEW
                const float alpha = __builtin_amdgcn_exp2f(m_run[f] - m_new);
                psum = rows4_sum(psum);
                l_run[f] = l_run[f] * alpha + psum;
                if (__any(m_new != m_run[f])) {
#pragma unroll
                    for (int m = 0; m < 8; ++m) oacc[f][m] = oacc[f][m] * alpha;
                }
                m_run[f] = m_new;
            }
#pragma unroll
            for (int k2 = 0; k2 < 2; ++k2) {
                bf16x8 pf[2];
#pragma unroll
                for (int f = 0; f < 2; ++f) { u32x4 pb; pb.x = cvt_pk_bf16(s[f][2 * k2][0], s[f][2 * k2][1]); pb.y = cvt_pk_bf16(s[f][2 * k2][2], s[f][2 * k2][3]);
                    pb.z = cvt_pk_bf16(s[f][2 * k2 + 1][0], s[f][2 * k2 + 1][1]); pb.w = cvt_pk_bf16(s[f][2 * k2 + 1][2], s[f][2 * k2 + 1][3]);
                    pf[f] = __builtin_bit_cast(bf16x8, pb); }
#pragma unroll
                for (int mh = 0; mh < 2; ++mh) {
                    bf16x8 af[4];
#pragma unroll
                    for (int m = 0; m < 4; ++m) af[m] = *(const LAS bf16x8*)(vt + (16 * (4 * mh + m) + q16) * 272 + (32 * k2 + 8 * g) * 2);
                    asm volatile("" : "+v"(af[0]), "+v"(af[1]), "+v"(af[2]), "+v"(af[3]));
#pragma unroll
                    for (int m = 0; m < 4; ++m) {
                        oacc[0][4 * mh + m] = __builtin_amdgcn_mfma_f32_16x16x32_bf16(af[m], pf[0], oacc[0][4 * mh + m], 0, 0, 0);
                        oacc[1][4 * mh + m] = __builtin_amdgcn_mfma_f32_16x16x32_bf16(af[m], pf[1], oacc[1][4 * mh + m], 0, 0, 0); } }
            }
        }
        __syncthreads();
        if (ti + 1 < ntiles) { AT_WRITE(); }
        __syncthreads();
        if (ti + 2 < ntiles) { const int kn = tiles[ti + 2]; AT_LOAD(kn); }
    }
    LAS float* mo = (LAS float*)lds; LAS float* ml = (LAS float*)(lds + 65536);
    if (kp == 1) {
#pragma unroll
        for (int f = 0; f < 2; ++f) {
#pragma unroll
            for (int m = 0; m < 8; ++m)
#pragma unroll
                for (int r = 0; r < 4; ++r) mo[((qg * 2 + f) * 8 + m) * 256 + r * 64 + lane] = oacc[f][m][r];
            ml[(qg * 2 + f) * 128 + lane] = m_run[f]; ml[(qg * 2 + f) * 128 + 64 + lane] = l_run[f]; }
    }
    __syncthreads();
    if (kp == 0) {
#pragma unroll
        for (int f = 0; f < 2; ++f) {
            const float m1 = ml[(qg * 2 + f) * 128 + lane], l1 = ml[(qg * 2 + f) * 128 + 64 + lane];
            const float mm = fmaxf(m_run[f], m1), a0 = __builtin_amdgcn_exp2f(m_run[f] - mm), a1 = __builtin_amdgcn_exp2f(m1 - mm);
            const float inv = __builtin_amdgcn_rcpf(l_run[f] * a0 + l1 * a1);
            bf16* HA = (bf16*)(ws + WS_HA) + (size_t)(b * SEQ + qpos[f]) * 1024 + h * 128 + 4 * g;
#pragma unroll
            for (int m = 0; m < 8; ++m) { float o[4];
#pragma unroll
                for (int r = 0; r < 4; ++r) o[r] = (oacc[f][m][r] * a0 + mo[((qg * 2 + f) * 8 + m) * 256 + r * 64 + lane] * a1) * inv;
                u32x2 w; w.x = cvt_pk_bf16(o[0], o[1]); w.y = cvt_pk_bf16(o[2], o[3]); *(u32x2*)(HA + 16 * m) = w; }
        }
    }
#undef AT_LOAD
#undef AT_WRITE
}

constexpr int MC_Q = 0, MC_K = 33792, MC_SP = 67584, MC_SC = 76800, MC_NV = 79104;
struct McRegs { u32x4 qr[4], kr[4]; float sc4[4]; float nv0; bf16x8 cb[8][2], vbf[2][2]; u32x2 ovv[8]; };
__device__ __forceinline__ void mc_load_qk(McRegs& R, const unsigned char* ws, int u, int tid) {
    const int bh = u >> 5, c = u & 31, b = bh >> 2, h = bh & 3; const size_t tok0 = (size_t)b * SEQ + 64 * c;
    const bf16* QM = (const bf16*)(ws + WS_QM); const bf16* KM = (const bf16*)(ws + WS_KM);
#pragma unroll
    for (int i = 0; i < 4; ++i) { const int idx = tid + NTHR * i, row = idx >> 5, ch = idx & 31;
        R.qr[i] = *(const u32x4*)(QM + (tok0 + row) * 1024 + h * 256 + ch * 8); R.kr[i] = *(const u32x4*)(KM + (tok0 + row) * 1024 + h * 256 + ch * 8); }
}
__device__ __forceinline__ void mc_load_sc(McRegs& R, const unsigned char* ws, int u, int tid) {
    const int bh = u >> 5, c = u & 31; const int s = bh * 2048 + 64 * c + (tid & 63);
    R.sc4[0] = ((const float*)(ws + MS_AS))[s]; R.sc4[1] = ((const float*)(ws + MS_GT))[s]; R.sc4[2] = ((const float*)(ws + MS_WI))[s]; R.sc4[3] = ((const float*)(ws + MS_CL))[s];
    R.nv0 = ((const float*)(ws + MS_NVEC))[(size_t)(bh * 32 + c) * 256 + (tid & 255)];
}
__device__ __forceinline__ void mc_load_cb(McRegs& R, const unsigned char* ws, int u, int lane, int wave) {
    const bf16* Cp = (const bf16*)(ws + WS_CST) + (size_t)u * 65536 + (size_t)(2 * wave) * 512 + lane * 8;
#pragma unroll
    for (int ks = 0; ks < 8; ++ks) { R.cb[ks][0] = *(const bf16x8*)(Cp + ks * 8192); R.cb[ks][1] = *(const bf16x8*)(Cp + ks * 8192 + 512); }
}
__device__ __forceinline__ void mc_load_v(McRegs& R, const unsigned char* ws, int u, int lane, int wave) {
    const bf16* Vp = (const bf16*)(ws + WS_VMT) + (size_t)u * 16384 + (size_t)(2 * wave) * 512 + lane * 8;
#pragma unroll
    for (int ks = 0; ks < 2; ++ks) { R.vbf[ks][0] = *(const bf16x8*)(Vp + ks * 8192); R.vbf[ks][1] = *(const bf16x8*)(Vp + ks * 8192 + 512); }
}
__device__ __forceinline__ void mc_load_ov(McRegs& R, const unsigned char* ws, int u, int lane, int wave) {
    const int bh = u >> 5, c = u & 31, b = bh >> 2, h = bh & 3; const size_t tok0 = (size_t)b * SEQ + 64 * c;
    const bf16* OM = (const bf16*)(ws + WS_OM);
#pragma unroll
    for (int i = 0; i < 8; ++i) R.ovv[i] = *(const u32x2*)(OM + (tok0 + 8 * wave + i) * 1024 + h * 256 + 4 * lane);
}
template <bool PF, bool HAVE>
__device__ __forceinline__ void mlstm_c_body(ArgsP a, int l, LAS unsigned char* lds, int u, int un, McRegs& R, int tid_, int lane_, int wave) {
    unsigned char* ws = a->ws;
    int tid = wave * 64 + lane_id(); asm volatile("" : "+v"(tid));
    const int lane = tid & 63; (void)tid_; (void)lane_;
    const int bh = u >> 5, c = u & 31, b = bh >> 2, h = bh & 3, t0 = 64 * c, q16 = lane & 15, g = lane >> 4;
    const size_t tok0 = (size_t)b * SEQ + t0;
    LAS unsigned char* Qs = lds + MC_Q; LAS unsigned char* Ks = lds + MC_K; LAS unsigned char* Sp = lds + MC_SP;
    LAS float* sc = (LAS float*)(lds + MC_SC); LAS float* as_ = sc; LAS float* gt_ = sc + 64; LAS float* wi_ = sc + 128; LAS float* cl_ = sc + 192; LAS float* qn_ = sc + 256; LAS float* denp = sc + 320;
    LAS float* nvec = (LAS float*)(lds + MC_NV);
    mc_load_qk(R, ws, u, tid); mc_load_sc(R, ws, u, tid);
    if (!HAVE) mc_load_cb(R, ws, u, lane, wave);
#pragma unroll
    for (int i = 0; i < 4; ++i) { const int idx = tid + NTHR * i, row = idx >> 5, ch = idx & 31;
        *(LAS u32x4*)(Qs + row * 528 + ch * 16) = R.qr[i]; *(LAS u32x4*)(Ks + row * 528 + ch * 16) = R.kr[i]; }
    mc_load_v(R, ws, u, lane, wave);
    if (tid < 64) { as_[tid] = R.sc4[0]; gt_[tid] = R.sc4[1]; wi_[tid] = R.sc4[2]; cl_[tid] = R.sc4[3]; }
    if (tid < 256) nvec[tid] = R.nv0;
    __syncthreads();
    f32x4 acc[4][2];
#pragma unroll
    for (int m = 0; m < 4; ++m) { acc[m][0] = (f32x4){0.f, 0.f, 0.f, 0.f}; acc[m][1] = acc[m][0]; }
    if (c > 0) {
#pragma unroll
        for (int ks = 0; ks < 8; ++ks) {
#pragma unroll
            for (int m = 0; m < 4; ++m) { const bf16x8 af = *(const LAS bf16x8*)(Qs + (16 * m + q16) * 528 + (32 * ks + 8 * g) * 2);
                acc[m][0] = __builtin_amdgcn_mfma_f32_16x16x32_bf16(af, R.cb[ks][0], acc[m][0], 0, 0, 0);
                acc[m][1] = __builtin_amdgcn_mfma_f32_16x16x32_bf16(af, R.cb[ks][1], acc[m][1], 0, 0, 0); }
        }
#pragma unroll
        for (int m = 0; m < 4; ++m)
#pragma unroll
            for (int r = 0; r < 4; ++r) { const float w = wi_[16 * m + 4 * g + r]; acc[m][0][r] *= w; acc[m][1][r] *= w; }
    }
    {
        const int mS = wave & 3, nS0 = 2 * (wave >> 2);
        f32x4 sacc[2]; sacc[0] = (f32x4){0.f, 0.f, 0.f, 0.f}; sacc[1] = sacc[0];
#pragma unroll
        for (int kh = 0; kh < 4; ++kh) {
            bf16x8 af[2], bq[2][2];
#pragma unroll
            for (int k2 = 0; k2 < 2; ++k2) { const int ks = 2 * kh + k2;
                af[k2] = *(const LAS bf16x8*)(Qs + (16 * mS + q16) * 528 + (32 * ks + 8 * g) * 2);
#pragma unroll
                for (int nn = 0; nn < 2; ++nn) bq[k2][nn] = *(const LAS bf16x8*)(Ks + (16 * (nS0 + nn) + q16) * 528 + (32 * ks + 8 * g) * 2); }
            asm volatile("" : "+v"(af[0]), "+v"(af[1]), "+v"(bq[0][0]), "+v"(bq[0][1]), "+v"(bq[1][0]), "+v"(bq[1][1]));
#pragma unroll
            for (int k2 = 0; k2 < 2; ++k2)
#pragma unroll
                for (int nn = 0; nn < 2; ++nn) sacc[nn] = __builtin_amdgcn_mfma_f32_16x16x32_bf16(af[k2], bq[k2][nn], sacc[nn], 0, 0, 0);
        }
#pragma unroll
        for (int nn = 0; nn < 2; ++nn) { const int s = 16 * (nS0 + nn) + q16; const float av = as_[s];
#pragma unroll
            for (int r = 0; r < 4; ++r) { const int t = 16 * mS + 4 * g + r;
                float val = (s <= t) ? sacc[nn][r] * __expf(av - gt_[t]) : 0.f;
                *(LAS unsigned short*)(Sp + t * 144 + s * 2) = (unsigned short)(cvt_pk_bf16(val, val) & 0xffffu);
                val += __shfl_xor(val, 1); val += __shfl_xor(val, 2); val += __shfl_xor(val, 4); val += __shfl_xor(val, 8);
                if (q16 == 0) denp[(nS0 + nn) * 64 + t] = val; } }
    }
    {
        const int t = tid >> 3, seg = tid & 7; float s = 0.f;
#pragma unroll
        for (int i = 0; i < 4; ++i) { const u32x4 v = *(const LAS u32x4*)(Qs + t * 528 + (seg * 32 + 8 * i) * 2); const LAS float* nv = nvec + seg * 32 + 8 * i;
            s += bflo(v.x) * nv[0] + bfhi(v.x) * nv[1] + bflo(v.y) * nv[2] + bfhi(v.y) * nv[3] + bflo(v.z) * nv[4] + bfhi(v.z) * nv[5] + bflo(v.w) * nv[6] + bfhi(v.w) * nv[7]; }
        s += __shfl_xor(s, 1); s += __shfl_xor(s, 2); s += __shfl_xor(s, 4);
        if (seg == 0) qn_[t] = s;
    }
    __syncthreads();
    if (PF) {
#pragma unroll
        for (int ks = 0; ks < 8; ++ks) asm volatile("" :: "v"(R.cb[ks][0]), "v"(R.cb[ks][1]));
        __builtin_amdgcn_sched_barrier(0);
        mc_load_cb(R, ws, un, lane, wave);
        __builtin_amdgcn_sched_barrier(0);
    }
    {
#pragma unroll
        for (int ks = 0; ks < 2; ++ks) {
            bf16x8 sf[4];
#pragma unroll
            for (int m = 0; m < 4; ++m) sf[m] = *(const LAS bf16x8*)(Sp + (16 * m + q16) * 144 + (32 * ks + 8 * g) * 2);
            asm volatile("" : "+v"(sf[0]), "+v"(sf[1]), "+v"(sf[2]), "+v"(sf[3]));
#pragma unroll
            for (int m = 0; m < 4; ++m) {
                acc[m][0] = __builtin_amdgcn_mfma_f32_16x16x32_bf16(sf[m], R.vbf[ks][0], acc[m][0], 0, 0, 0);
                acc[m][1] = __builtin_amdgcn_mfma_f32_16x16x32_bf16(sf[m], R.vbf[ks][1], acc[m][1], 0, 0, 0); }
        }
    }
    LAS float* NUM = (LAS float*)lds;
#pragma unroll
    for (int m = 0; m < 4; ++m)
#pragma unroll
        for (int r = 0; r < 4; ++r) { const int t = 16 * m + 4 * g + r;
            const float den = (denp[t] + denp[64 + t]) + (denp[128 + t] + denp[192 + t]) + wi_[t] * qn_[t];
            const float inv = __builtin_amdgcn_rcpf(fmaxf(fabsf(den), cl_[t]));
            NUM[t * 260 + 32 * wave + q16] = acc[m][0][r] * inv; NUM[t * 260 + 32 * wave + 16 + q16] = acc[m][1][r] * inv; }
    __syncthreads();
    {
        const float* mg = a->in[I_MNG] + l * 1024 + h * 256 + 4 * lane; const f32x4 gn = *(const f32x4*)mg;
        bf16* HM = (bf16*)(ws + WS_HM);
        mc_load_ov(R, ws, u, lane, wave);
        asm volatile("" : "+v"(R.ovv[0]), "+v"(R.ovv[1]), "+v"(R.ovv[2]), "+v"(R.ovv[3]), "+v"(R.ovv[4]), "+v"(R.ovv[5]), "+v"(R.ovv[6]), "+v"(R.ovv[7]));
#pragma unroll
        for (int i = 0; i < 8; ++i) { const int t = 8 * wave + i;
            const f32x4 v = *(const LAS f32x4*)(NUM + t * 260 + 4 * lane);
            const float mu = wave_sum((v.x + v.y) + (v.z + v.w)) * (1.0f / 256.0f);
            const f32x4 d = v - mu;
            const float var = wave_sum((d.x * d.x + d.y * d.y) + (d.z * d.z + d.w * d.w)) * (1.0f / 256.0f);
            const float rstd = __builtin_amdgcn_rsqf(var + LN_EPS);
            const u32x2 ov = R.ovv[i];
            u32x2 w; w.x = cvt_pk_bf16(d.x * rstd * gn.x * bflo(ov.x), d.y * rstd * gn.y * bfhi(ov.x)); w.y = cvt_pk_bf16(d.z * rstd * gn.z * bflo(ov.y), d.w * rstd * gn.w * bfhi(ov.y));
            *(u32x2*)(HM + (tok0 + t) * 1024 + h * 256 + 4 * lane) = w; }
    }
    __syncthreads();
}
__device__ __forceinline__ void mlstm_c_phase(ArgsP a, int l, LAS unsigned char* lds, int tid, int lane, int wave, int bid, int G) {
    int u = bid; if (u >= 512) return;
    McRegs R;
    if (u + G < 512 && u + 2 * G >= 512) {
        mlstm_c_body<true, false>(a, l, lds, u, u + G, R, tid, lane, wave);
        mlstm_c_body<false, true>(a, l, lds, u + G, u + G, R, tid, lane, wave);
    } else {
#pragma unroll 1
        for (; u < 512; u += G) mlstm_c_body<false, false>(a, l, lds, u, u, R, tid, lane, wave);
    }
}

struct SchedStd {
    static constexpr bool GATHER = false;
    const char* A; const char* B; int nM, nN, K, G, c;
    __device__ __forceinline__ bool next(int i, Unit& u) const { const int L = i * G + c; if (L >= nM * nN) return false; pg8::static_tile(L, nM, nN, u.pm, u.pn); u.aux = 0; return true; }
    __device__ __forceinline__ const char* abase(const Unit& u) const { return A + (size_t)u.pm * 512 * K; }
    __device__ __forceinline__ const char* bbase(const Unit& u) const { return B + (size_t)u.pn * 512 * K; }
    __device__ __forceinline__ unsigned arow(const Unit&, int) const { return 0u; }
    static __device__ __forceinline__ bool keep_acc(const Unit&) { return false; }
};
struct SchedBr {
    static constexpr bool GATHER = false;
    const char* HM; const char* HA; const char* WM; const char* WA; int G, c;
    __device__ __forceinline__ bool next(int i, Unit& u) const { const int L = (i >> 1) * G + c; if (L >= 256) return false; pg8::static_tile(L, 32, 8, u.pm, u.pn); u.aux = i & 1; return true; }
    __device__ __forceinline__ const char* abase(const Unit& u) const { return (u.aux ? HA : HM) + (size_t)u.pm * 512 * 1024; }
    __device__ __forceinline__ const char* bbase(const Unit& u) const { return (u.aux ? WA : WM) + (size_t)u.pn * 512 * 1024; }
    __device__ __forceinline__ unsigned arow(const Unit&, int) const { return 0u; }
    static __device__ __forceinline__ bool keep_acc(const Unit& u) { return u.aux == 0; }
};
struct EpiBr {
    static constexpr bool PERM = true;
    const bf16* SG; bf16* Y;
    __device__ __forceinline__ void operator()(f32x4 (&acc)[2][2][4][2], const Unit& u, int wr, int wc, int fr, int fq) const {
        const int row0 = u.pm * 256 + wr * 64 + fr, col0 = u.pn * 256 + wc * 32 + 8 * fq;
#pragma unroll
        for (int ai = 0; ai < 2; ++ai) {
            u32x4 sa[4][2], sm[4][2];
#pragma unroll
            for (int m = 0; m < 4; ++m) { const size_t row = row0 + ai * 128 + m * 16;
#pragma unroll
                for (int bj = 0; bj < 2; ++bj) { const int col = col0 + bj * 128;
                    sa[m][bj] = *(const u32x4*)(SG + row * 4096 + 2048 + col);
                    sm[m][bj] = *(const u32x4*)(SG + row * 4096 + (u.aux == 0 ? 0 : 2048) + col); } }
            asm volatile("" : "+v"(sa[0][0]), "+v"(sa[0][1]), "+v"(sa[1][0]), "+v"(sa[1][1]), "+v"(sa[2][0]), "+v"(sa[2][1]), "+v"(sa[3][0]), "+v"(sa[3][1]),
                              "+v"(sm[0][0]), "+v"(sm[0][1]), "+v"(sm[1][0]), "+v"(sm[1][1]), "+v"(sm[2][0]), "+v"(sm[2][1]), "+v"(sm[3][0]), "+v"(sm[3][1]));
#pragma unroll
            for (int m = 0; m < 4; ++m) { const size_t row = row0 + ai * 128 + m * 16;
#pragma unroll
                for (int bj = 0; bj < 2; ++bj) { const int col = col0 + bj * 128;
                    const u32x4 a4 = sa[m][bj], m4 = sm[m][bj];
                    const float ga[8] = {bflo(a4.x), bfhi(a4.x), bflo(a4.y), bfhi(a4.y), bflo(a4.z), bfhi(a4.z), bflo(a4.w), bfhi(a4.w)};
                    if (u.aux == 0) {
                        const float gm[8] = {bflo(m4.x), bfhi(m4.x), bflo(m4.y), bfhi(m4.y), bflo(m4.z), bfhi(m4.z), bflo(m4.w), bfhi(m4.w)};
#pragma unroll
                        for (int j = 0; j < 4; ++j) { acc[ai][bj][m][0][j] *= gm[j] * __builtin_amdgcn_rcpf(fmaxf(ga[j], 1.0e-30f)); acc[ai][bj][m][1][j] *= gm[4 + j] * __builtin_amdgcn_rcpf(fmaxf(ga[4 + j], 1.0e-30f)); }
                    } else {
                        const f32x4 v0 = acc[ai][bj][m][0], v1 = acc[ai][bj][m][1];
                        u32x4 w; w.x = cvt_pk_bf16(v0[0] * ga[0], v0[1] * ga[1]); w.y = cvt_pk_bf16(v0[2] * ga[2], v0[3] * ga[3]);
                        w.z = cvt_pk_bf16(v1[0] * ga[4], v1[1] * ga[5]); w.w = cvt_pk_bf16(v1[2] * ga[6], v1[3] * ga[7]);
                        *(u32x4*)(Y + row * 2048 + col) = w; }
                } }
        }
    }
};
struct EpiOut {
    static constexpr bool PERM = false;
    const float* res; float* out;
    __device__ __forceinline__ void operator()(f32x4 (&acc)[2][2][4][2], const Unit& u, int wr, int wc, int fr, int fq) const {
        const int row0 = u.pm * 256 + wr * 64 + fr, col0 = u.pn * 256 + wc * 32 + 4 * fq;
#pragma unroll
        for (int ai = 0; ai < 2; ++ai) {
            f32x4 rv[4][2][2];
#pragma unroll
            for (int m = 0; m < 4; ++m) { const size_t ro = (size_t)(row0 + ai * 128 + m * 16) * DM + col0;
#pragma unroll
                for (int bj = 0; bj < 2; ++bj)
#pragma unroll
                    for (int n = 0; n < 2; ++n) rv[m][bj][n] = *(const f32x4*)(res + ro + bj * 128 + n * 16); }
#pragma unroll
            for (int m = 0; m < 4; ++m) asm volatile("" : "+v"(rv[m][0][0]), "+v"(rv[m][0][1]), "+v"(rv[m][1][0]), "+v"(rv[m][1][1]));
#pragma unroll
            for (int m = 0; m < 4; ++m) { const size_t ro = (size_t)(row0 + ai * 128 + m * 16) * DM + col0;
#pragma unroll
                for (int bj = 0; bj < 2; ++bj)
#pragma unroll
                    for (int n = 0; n < 2; ++n) *(f32x4*)(out + ro + bj * 128 + n * 16) = rv[m][bj][n] + acc[ai][bj][m][n]; }
        }
    }
};
struct SchedMoe1 {
    static constexpr bool GATHER = true;
    const char* H; const char* W13; const int* LIST; const LAS int* te; const LAS int* tr0; const LAS int* cnt; int MT, G, c;
    __device__ __forceinline__ bool next(int i, Unit& u) const { const int L = i * G + c; if (L >= 2 * MT) return false; u.pm = L >> 1; u.pn = L & 1; u.aux = __builtin_amdgcn_readfirstlane(te[u.pm]); return true; }
    __device__ __forceinline__ const char* abase(const Unit&) const { return H; }
    __device__ __forceinline__ const char* bbase(const Unit& u) const { return W13 + ((size_t)u.aux * 512 + u.pn * 256) * 4096; }
    static __device__ __forceinline__ bool keep_acc(const Unit&) { return false; }
    __device__ __forceinline__ unsigned arow(const Unit& u, int r) const { const int rr = __builtin_amdgcn_readfirstlane(tr0[u.pm]) + r; return rr < __builtin_amdgcn_readfirstlane(cnt[u.aux]) ? (unsigned)LIST[u.aux * 8192 + rr] : 0u; }
};
struct EpiMoe1 {
    static constexpr bool PERM = true;
    bf16* HID; const float* PWL; const LAS int* tr0; const LAS int* cnt;
    __device__ __forceinline__ void operator()(f32x4 (&acc)[2][2][4][2], const Unit& u, int wr, int wc, int fr, int fq) const {
#pragma unroll
        for (int ai = 0; ai < 2; ++ai)
#pragma unroll
            for (int m = 0; m < 4; ++m) { const int r = ai * 128 + wr * 64 + m * 16 + fr;
                const float pw = 1.0f;
                float o[8];
#pragma unroll
                for (int n = 0; n < 2; ++n)
#pragma unroll
                    for (int j = 0; j < 4; ++j) { const float x1 = acc[ai][0][m][n][j], x3 = acc[ai][1][m][n][j]; o[4 * n + j] = x1 * sigmoidf_(x1) * x3 * pw; }
                u32x4 w; w.x = cvt_pk_bf16(o[0], o[1]); w.y = cvt_pk_bf16(o[2], o[3]); w.z = cvt_pk_bf16(o[4], o[5]); w.w = cvt_pk_bf16(o[6], o[7]);
                *(u32x4*)(HID + (size_t)(u.pm * 256 + r) * 256 + u.pn * 128 + wc * 32 + 8 * fq) = w; }
    }
};
struct SchedMoe2 {
    static constexpr bool GATHER = false;
    const char* HID; const char* W2; const LAS int* te; int MT, G, c;
    __device__ __forceinline__ bool next(int i, Unit& u) const { const int L = i * G + c; if (L >= 8 * MT) return false; u.pm = L >> 3; u.pn = L & 7; u.aux = __builtin_amdgcn_readfirstlane(te[u.pm]); return true; }
    __device__ __forceinline__ const char* abase(const Unit& u) const { return HID + (size_t)u.pm * 256 * 512; }
    __device__ __forceinline__ const char* bbase(const Unit& u) const { return W2 + ((size_t)u.aux * 2048 + u.pn * 256) * 512; }
    __device__ __forceinline__ unsigned arow(const Unit&, int) const { return 0u; }
    static __device__ __forceinline__ bool keep_acc(const Unit&) { return false; }
};
struct EpiMoe2 {
    static constexpr bool PERM = true;
    bf16* OP;
    __device__ __forceinline__ void operator()(f32x4 (&acc)[2][2][4][2], const Unit& u, int wr, int wc, int fr, int fq) const {
        const int row0 = u.pm * 256 + wr * 64 + fr, col0 = u.pn * 256 + wc * 32 + 8 * fq;
#pragma unroll
        for (int ai = 0; ai < 2; ++ai)
#pragma unroll
            for (int m = 0; m < 4; ++m) { bf16* rowp = OP + (size_t)(row0 + ai * 128 + m * 16) * DM + col0;
#pragma unroll
                for (int bj = 0; bj < 2; ++bj) { const f32x4 v0 = acc[ai][bj][m][0], v1 = acc[ai][bj][m][1];
                    u32x4 w; w.x = cvt_pk_bf16(v0[0], v0[1]); w.y = cvt_pk_bf16(v0[2], v0[3]); w.z = cvt_pk_bf16(v1[0], v1[1]); w.w = cvt_pk_bf16(v1[2], v1[3]);
                    *(u32x4*)(rowp + bj * 128) = w; } }
    }
};

constexpr int N_PHASES = 22;
__global__ void __launch_bounds__(NTHR, 2) fwd_kernel(Args a) {
    extern __shared__ __attribute__((aligned(16))) unsigned char lds_raw[];
    LAS unsigned char* lds0 = (LAS unsigned char*)lds_raw;
    const int tid0 = threadIdx.x, bid0 = blockIdx.x, G0 = gridDim.x;
    const int wave0 = __builtin_amdgcn_readfirstlane(tid0 >> 6);
#define PH_IDS() ArgsP ap = (ArgsP)__builtin_amdgcn_kernarg_segment_ptr(); asm volatile("" : "+s"(ap)); unsigned lb_ = 0u; asm volatile("" : "+s"(lb_)); LAS unsigned char* lds = lds0 + lb_; LAS unsigned char* misc = lds + MISC_OFF; (void)misc; unsigned char* ws = ap->ws; (void)ws; int bid = bid0, G = G0, wave = wave0; asm volatile("" : "+s"(bid), "+s"(G), "+s"(wave)); int tid = wave * 64 + lane_id(); asm volatile("" : "+v"(tid)); const int lane = tid & 63; (void)lane; (void)wave
    if (tid0 < 4) ((LAS unsigned*)(lds0 + MISC_OFF + MO_BAR))[tid0] = 0u;
    __syncthreads();
#if MK_LAUNCHES == 1
    XcdBarrier bar = xcd_barrier_post((unsigned*)(a.ws + WS_CTL) + CW_BAR, (volatile LAS unsigned*)(lds0 + MISC_OFF + MO_BAR));
#define GRID_BAR() xcd_barrier(bar)
#else
#define GRID_BAR() do { } while (0)
#endif
    const int lo = a.ph_lo, hi = a.ph_hi;
#ifndef PHMASK
#define PHMASK 0xFFFu
#endif
#define IN(k) (lo <= (k) && (k) < hi)
#define EN(b) ((PHMASK >> (b)) & 1u)
#ifndef DBLMASK
#define DBLMASK 0u
#endif
#define REP(b) _Pragma("unroll 1") for (int rep_ = 0; rep_ < (((DBLMASK >> (b)) & 1u) ? 2 : 1); ++rep_)
#define SEAM(k) do { if (IN(k) && IN((k) + 1)) { GRID_BAR(); if ((DBLMASK >> 12) & 1u) GRID_BAR(); } } while (0)

    if (EN(0) && IN(0)) { REP(0) { PH_IDS(); prologue_phase(ap, lds, tid, lane, wave, bid, G); __syncthreads(); }
#ifndef NO_NORM0
        { PH_IDS(); norm_phase<0>(ap, 0, lds, tid, lane, wave, bid, G); }
#endif
    }
    SEAM(0);
#pragma unroll 1
    for (int l = 0; l < 2; ++l) {
        const int pb = 1 + 10 * l;
        if (EN(1) && IN(pb + 0) && l == 1) { if ((DBLMASK >> 18) & 1u) { PH_IDS(); norm_phase<1>(ap, l, lds, tid, lane, wave, bid, G, true); } PH_IDS(); norm_phase<1>(ap, l, lds, tid, lane, wave, bid, G); }
        if (l == 1) SEAM(pb + 0);
        if (EN(2) && IN(pb + 1)) REP(2) { PH_IDS(); (void)tid;
#ifdef STAG
            for (int i = 0; i < ((bid >> 3) & 7); ++i) __builtin_amdgcn_s_sleep(STAG);
#endif
            SchedG1 S{(const char*)(ws + WS_H), (const char*)(ws + WS_WINT) + (size_t)l * 11264 * 4096, G, bid};
            EpiG1 E{ws, ((DBLMASK >> 21) & 1u) && rep_ == 1};
            pg8::gemm_phase<EpiG1, SchedG1>(lds, 2048, S, E, wave);
            for (int bh = G - 1 - bid; bh < 16; bh += G) gate_unit(ap, l, lds, bh, tid, tid & 63, wave);
            __syncthreads();
            if (G == 256 && bid >= 256 - SchedG1::NCV) prologue_phase(ap, lds, tid, tid & 63, wave, bid - (256 - SchedG1::NCV), SchedG1::NCV, 2 + l);
            else if (G != 256) prologue_phase(ap, lds, tid, tid & 63, wave, bid, G, 2 + l);
        }
        SEAM(pb + 1);
        if (EN(3) && IN(pb + 2)) REP(3) { PH_IDS(); conv_phase(ap, l, lds, tid, lane, wave, bid, G); }
        SEAM(pb + 2);
        if (EN(4) && IN(pb + 3)) REP(4) { PH_IDS();
            const int vb = (G % 8 == 0) ? (bid & 7) * (G >> 3) + (bid >> 3) : bid;
            REP(13) { for (int gw = vb * NWAVES + wave; gw < 2048; gw += G * NWAVES) mlstm_ab_task(ws, gw, lane, rep_ == 0 || !((DBLMASK >> 15) & 1u)); }
            if (wave == 0 && vb < 64) nscan_task(ws, vb, lane);
            __syncthreads();
            REP(14) { for (int u = vb; u < 512; u += G) { attn_unit(ap, lds, u, tid, lane, wave); __syncthreads(); if (((DBLMASK >> 16) & 1u) && u < 256) GRID_BAR(); } }
        }
        SEAM(pb + 3);
        if (EN(5) && IN(pb + 4)) REP(5) { PH_IDS(); mlstm_c_phase(ap, l, lds, tid, lane, wave, bid, G); }
        SEAM(pb + 4);
        if (EN(6) && IN(pb + 5)) REP(6) { PH_IDS(); (void)tid;
            SchedBr S{(const char*)(ws + WS_HM), (const char*)(ws + WS_HA), (const char*)(ws + WS_WBM) + (size_t)l * 2048 * 2048, (const char*)(ws + WS_WBA) + (size_t)l * 2048 * 2048, G, bid};
            EpiBr E{(const bf16*)(ws + WS_SG), (bf16*)(ws + WS_Y)};
            pg8::gemm_phase<EpiBr, SchedBr>(lds, 1024, S, E, wave);
        }
        SEAM(pb + 5);
        if (EN(7) && IN(pb + 6)) _Pragma("unroll 1") for (int rep_ = 0; rep_ < ((((DBLMASK >> 7) & 1u) && l == 0) ? 2 : 1); ++rep_) { PH_IDS(); (void)tid;
            SchedStd S{(const char*)(ws + WS_Y), (const char*)(ws + WS_WOUT) + (size_t)l * 2048 * 4096, 32, 8, 2048, G, bid};
            EpiOut E{l == 0 ? ap->in[I_X] : (const float*)ap->out, ap->out};
            pg8::gemm_phase<EpiOut, SchedStd>(lds, 2048, S, E, wave);
        }
        SEAM(pb + 6);
        if (EN(8) && IN(pb + 7)) { if ((DBLMASK >> 19) & 1u) { PH_IDS(); norm_phase<2>(ap, l, lds, tid, lane, wave, bid, G, true); } PH_IDS(); norm_phase<2>(ap, l, lds, tid, lane, wave, bid, G); }
        SEAM(pb + 7);
        if (EN(9) && IN(pb + 8)) REP(9) { PH_IDS();
            moe_tables(ws, l, misc, tid);
            SchedMoe1 S{(const char*)(ws + WS_H), (const char*)(ws + WS_W13) + (size_t)l * 32 * 512 * 4096, (const int*)(ws + MS_LIST),
                        (const LAS int*)(misc + MO_TE), (const LAS int*)(misc + MO_TR0), (const LAS int*)(misc + MO_CNT), __builtin_amdgcn_readfirstlane(((const LAS int*)(misc + MO_MT))[0]), G, bid};
            EpiMoe1 E{(bf16*)(ws + WS_HID), (const float*)(ws + MS_PWL), (const LAS int*)(misc + MO_TR0), (const LAS int*)(misc + MO_CNT)};
            pg8::gemm_phase<EpiMoe1, SchedMoe1>(lds, 2048, S, E, wave);
            if (bid >= 2 * S.MT) prologue_phase(ap, lds, tid, tid & 63, wave, bid - 2 * S.MT, G - 2 * S.MT, l == 0 ? 1 : 4);
        }
        SEAM(pb + 8);
        if (EN(10) && IN(pb + 9)) REP(10) { PH_IDS();
            moe_tables(ws, l, misc, tid);
#ifdef STAG
            for (int i = 0; i < ((bid >> 3) & 7); ++i) __builtin_amdgcn_s_sleep(STAG);
#endif
            SchedMoe2 S{(const char*)(ws + WS_HID), (const char*)(ws + WS_W2) + (size_t)l * 32 * 2048 * 512, (const LAS int*)(misc + MO_TE), __builtin_amdgcn_readfirstlane(((const LAS int*)(misc + MO_MT))[0]), G, bid};
            EpiMoe2 E{(bf16*)(ws + WS_OP)};
            pg8::gemm_phase<EpiMoe2, SchedMoe2>(lds, 256, S, E, wave);
        }
        SEAM(pb + 9);
    }
    if (EN(11) && IN(21)) { if ((DBLMASK >> 20) & 1u) { PH_IDS(); norm_phase<3>(ap, 1, lds, tid, lane, wave, bid, G, true); } PH_IDS(); norm_phase<3>(ap, 1, lds, tid, lane, wave, bid, G); }
#undef IN
#undef SEAM
}

extern "C" void kernel_launch(void* const* d_in, const int* in_sizes, int n_in, void* d_out, int out_size, void* d_ws, size_t ws_size, hipStream_t stream) {
    static int grid = 0;
    if (grid == 0) {
        if (n_in != 19 || out_size != NTOK * DM || ws_size < WS_END) { fprintf(stderr, "kernel_launch: unexpected shapes (n_in %d out %d ws %zu)\n", n_in, out_size, ws_size); grid = -1; return; }
        int dev = 0, cus = 0, per_cu = 0;
        if (hipGetDevice(&dev) != hipSuccess || hipDeviceGetAttribute(&cus, hipDeviceAttributeMultiprocessorCount, dev) != hipSuccess) { grid = -1; return; }
        if (hipFuncSetAttribute((const void*)fwd_kernel, hipFuncAttributeMaxDynamicSharedMemorySize, LDS_BYTES) != hipSuccess) { fprintf(stderr, "kernel_launch: hipFuncSetAttribute failed\n"); grid = -1; return; }
        if (hipOccupancyMaxActiveBlocksPerMultiprocessor(&per_cu, (const void*)fwd_kernel, NTHR, LDS_BYTES) != hipSuccess || per_cu < 1) { fprintf(stderr, "kernel_launch: occupancy query says %d\n", per_cu); }
        (void)hipGetLastError();
        grid = cus;
        if (grid > 256) grid = 256;
    }
    if (grid < 0) return;
    if (hipMemsetAsync((char*)d_ws + WS_CTL, 0, CTL_ZERO_BYTES, stream) != hipSuccess) return;
    Args a{};
    for (int i = 0; i < 19; ++i) a.in[i] = (const float*)d_in[i];
    a.out = (float*)d_out; a.ws = (unsigned char*)d_ws;
#if MK_LAUNCHES == 1
    a.ph_lo = 0; a.ph_hi = N_PHASES;
    hipLaunchKernelGGL(fwd_kernel, dim3(grid), dim3(NTHR), LDS_BYTES, stream, a);
#else
    for (int p = 0; p < N_PHASES; ++p) { a.ph_lo = p; a.ph_hi = p + 1; hipLaunchKernelGGL(fwd_kernel, dim3(grid), dim3(NTHR), LDS_BYTES, stream, a); }
#endif
}
```

```cpp
#define DBLMASK 0u
#include <hip/hip_runtime.h>
#include <stdint.h>
#include <stdio.h>

#ifndef MK_LAUNCHES
#define MK_LAUNCHES 1
#endif

#define GAS __attribute__((address_space(1)))
#define LAS __attribute__((address_space(3)))
typedef unsigned short bf16;
typedef short bf16x8 __attribute__((ext_vector_type(8)));
typedef short bf16x4 __attribute__((ext_vector_type(4)));
typedef float f32x4 __attribute__((ext_vector_type(4)));
typedef unsigned u32x4 __attribute__((ext_vector_type(4)));
typedef unsigned u32x2 __attribute__((ext_vector_type(2)));

constexpr int NTOK = 8192, DM = 2048, SEQ = 2048, NBATCH = 4;
constexpr int INCOLS = 11272;
constexpr int NWAVES = 8, NTHR = 512;
constexpr float RMS_EPS = 1e-6f, LN_EPS = 1e-5f;
constexpr int MPAD = 24576;

constexpr size_t MiB = 1u << 20;
constexpr size_t WS_CTL = 0, CTL_ZERO_BYTES = 1 * MiB;
constexpr size_t WS_MISC = 1 * MiB;
constexpr size_t MS_WIF = WS_MISC + 0;
constexpr size_t MS_WRT = WS_MISC + 256 * 1024;
constexpr size_t MS_IFG = WS_MISC + 1 * MiB;
constexpr size_t MS_KMEAN = MS_IFG + 256 * 1024;
constexpr size_t MS_AS = WS_MISC + 1536 * 1024;
constexpr size_t MS_GT = MS_AS + 128 * 1024;
constexpr size_t MS_WI = MS_GT + 128 * 1024;
constexpr size_t MS_CL = MS_WI + 128 * 1024;
constexpr size_t MS_WS = MS_CL + 128 * 1024;
constexpr size_t MS_DEC = MS_WS + 128 * 1024;
constexpr size_t MS_NST = WS_MISC + 2560 * 1024;
constexpr size_t MS_TOKE = WS_MISC + 3 * MiB;
constexpr size_t MS_TOKP = MS_TOKE + 64 * 1024;
constexpr size_t MS_TOKW = MS_TOKE + 128 * 1024;
constexpr size_t MS_LIST = WS_MISC + 4 * MiB;
constexpr size_t MS_PWL = WS_MISC + 5 * MiB;
constexpr size_t MS_NVEC = WS_MISC + 6 * MiB;
constexpr size_t WS_WINT = 16 * MiB;
constexpr size_t WS_WBM = 104 * MiB;
constexpr size_t WS_WBA = 112 * MiB;
constexpr size_t WS_WOUT = 120 * MiB;
constexpr size_t WS_W13 = 136 * MiB;
constexpr size_t WS_W2 = 264 * MiB;
constexpr size_t WS_H = 328 * MiB;
constexpr size_t WS_R = 360 * MiB;
constexpr size_t WS_ZQK = WS_R;
constexpr size_t WS_HM = WS_R, WS_HA = WS_R + 16 * MiB;
constexpr size_t WS_VMT = WS_R + 32 * MiB;
constexpr size_t WS_OM = WS_R + 48 * MiB;
constexpr size_t WS_QA = WS_R + 64 * MiB, WS_KA = WS_R + 80 * MiB;
constexpr size_t WS_Y = WS_QA;
constexpr size_t WS_VAT = WS_R + 96 * MiB;
constexpr size_t WS_SG = WS_R + 112 * MiB;
constexpr size_t WS_QM = WS_R + 176 * MiB, WS_KM = WS_R + 192 * MiB, WS_KMT = WS_R + 208 * MiB;
constexpr size_t WS_CST = WS_R + 224 * MiB;
constexpr size_t WS_HID = WS_R;
constexpr size_t WS_OP = WS_R + 16 * MiB;
constexpr size_t WS_END = 648 * MiB;
constexpr int CW_BAR = 4096;
constexpr int CW_CNT = 8192;

constexpr int RING_BYTES = 131072;
constexpr int MISC_OFF = 139264;
constexpr int LDS_BYTES = 147456;
constexpr int MO_BAR = 0, MO_CNT = 64, MO_NT = 64 + 128, MO_OFF = 64 + 256, MO_TE = 64 + 512, MO_TR0 = 64 + 1024, MO_MT = 64 + 1536, MO_LOG = 2048;

#define LDS_WAIT() asm volatile("s_waitcnt lgkmcnt(0)" ::: "memory")
#define VM_WAIT() asm volatile("s_waitcnt vmcnt(0)" ::: "memory")

__device__ __forceinline__ float bf2f(unsigned short b) { return __builtin_bit_cast(float, (unsigned)b << 16); }
__device__ __forceinline__ float bflo(unsigned u) { return __builtin_bit_cast(float, u << 16); }
__device__ __forceinline__ float bfhi(unsigned u) { return __builtin_bit_cast(float, u & 0xffff0000u); }
typedef __bf16 bf16x2v __attribute__((ext_vector_type(2)));
typedef float f32x2v __attribute__((ext_vector_type(2)));
typedef float f32x2 __attribute__((ext_vector_type(2)));
__device__ __forceinline__ unsigned cvt_pk_bf16(float lo, float hi) { const f32x2v f = {lo, hi}; const bf16x2v b = __builtin_convertvector(f, bf16x2v); return __builtin_bit_cast(unsigned, b); }
__device__ __forceinline__ float wave_sum(float v) {
#pragma unroll
    for (int o = 1; o < 64; o <<= 1) v += __shfl_xor(v, o);
    return v;
}
__device__ __forceinline__ float rows4_max(float x) { x = fmaxf(x, __shfl_xor(x, 16)); return fmaxf(x, __shfl_xor(x, 32)); }
__device__ __forceinline__ float rows4_sum(float x) { x += __shfl_xor(x, 16); return x + __shfl_xor(x, 32); }
__device__ __forceinline__ int lane_id() { int l; asm volatile("v_mbcnt_lo_u32_b32 %0, -1, 0\n\tv_mbcnt_hi_u32_b32 %0, -1, %0" : "=v"(l)); return l; }
__device__ __forceinline__ float sigmoidf_(float x) { return __builtin_amdgcn_rcpf(1.f + __expf(-x)); }

namespace pg8 {
constexpr int BM = 256, BK = 64, HALF = 128, HTB = HALF * BK * 2, STAGE_BYTES = 8 * HTB, NXCD = 8, WGM = 8;
__device__ __forceinline__ int lds_byte(int r, int c) { const int st = (r >> 4) * 2 + (c >> 5), rr = r & 15, cc = c & 31, ob = rr * 64 + cc * 2; return st * 1024 + (ob ^ (((ob >> 9) & 1) << 5)); }
__device__ __forceinline__ void stage_rc(int b, int& R, int& C) { const int st = b / 1024, sb = b % 1024, swz = sb ^ (((sb >> 9) & 1) << 5); R = (st >> 1) * 16 + swz / 64; C = (st & 1) * 32 + (swz % 64) / 2; }
__device__ __forceinline__ int perm32(int rho) { const int n = rho >> 4, i = rho & 15; return 8 * (i >> 2) + 4 * n + (i & 3); }
struct Unit { int pm, pn, aux; };

__device__ __forceinline__ void static_tile(int L, int nM, int nN, int& pm, int& pn) {
    const int nwg = nM * nN; int wgid = L;
    { const int q = nwg / NXCD, r = nwg % NXCD, xcd = wgid % NXCD, off = wgid / NXCD; wgid = (xcd < r ? xcd * (q + 1) : r * (q + 1) + (xcd - r) * q) + off; }
    const int nig = WGM * nN, gid = wgid / nig, fm = gid * WGM, gsz = (nM - fm) < WGM ? (nM - fm) : WGM;
    pm = fm + ((wgid % nig) % gsz); pn = (wgid % nig) / gsz;
}

template <class Epi, class Sched>
__device__ __forceinline__ void gemm_phase(LAS unsigned char* lds, const int K, const Sched& S, const Epi& E, const int wave0) {
    int tid_ = wave0 * 64 + lane_id(); asm volatile("" : "+v"(tid_));
    const int tid = tid_, wid = __builtin_amdgcn_readfirstlane(tid >> 6), lane = tid & 63, wr = wid >> 2, wc = wid & 3, fr = lane & 15, fq = lane >> 4;
    const int nt = K / BK;
    int RA[2], CA[2]; unsigned voffB[2];
#pragma unroll
    for (int i = 0; i < 2; ++i) { int R, C; stage_rc(tid * 16 + i * 8192, R, C); const int Rb = Epi::PERM ? ((R & ~31) + perm32(R & 31)) : R;
        RA[i] = R; CA[i] = C; voffB[i] = (unsigned)(Rb * K + C) * 2u; }
    const size_t kstep = (size_t)(BK * 2);
    const size_t hstep = (size_t)HALF * K * 2;
    const unsigned ldsw = (unsigned)wid * 1024u;
    const int aoff = lds_byte(wr * 64 + fr, fq * 8), boff = lds_byte(wc * 32 + fr, fq * 8);
#define PG8_SA(b, h) (((b) * 2 + (h)) * HTB)
#define PG8_SB(b, h) ((4 + (b) * 2 + (h)) * HTB)
#define PG8_STAGE(bufoff, gbase, v0, v1) do { \
        __builtin_amdgcn_global_load_lds((const unsigned*)((const char*)(gbase) + (v0)), (LAS unsigned*)(lds + (bufoff) + ldsw), 16, 0, 0); \
        __builtin_amdgcn_global_load_lds((const unsigned*)((const char*)(gbase) + (v1)), (LAS unsigned*)(lds + (bufoff) + ldsw + 8192), 16, 0, 0); } while (0)
#define PG8_STAGE_B(bufoff, gbase) PG8_STAGE(bufoff, gbase, voffB[0], voffB[1])
#define PG8_STAGE_A(bufoff, gbase, VO, h) PG8_STAGE(bufoff, gbase, VO[h][0], VO[h][1])
#define PG8_STAGE_A2(bufoff, gbase, h) do { if (Sched::GATHER && last) { PG8_STAGE_A(bufoff, gbase, vn, h); } else { PG8_STAGE_A(bufoff, gbase, vc, h); } } while (0)
#define PG8_LDA(dst, b, h) do { _Pragma("unroll") for (int m = 0; m < 4; ++m) _Pragma("unroll") for (int k = 0; k < 2; ++k) dst[m][k] = *(const LAS bf16x8*)(lds + PG8_SA(b, h) + aoff + m * 2048 + k * 1024); } while (0)
#define PG8_LDB(dst, b, h) do { _Pragma("unroll") for (int n = 0; n < 2; ++n) _Pragma("unroll") for (int k = 0; k < 2; ++k) dst[n][k] = *(const LAS bf16x8*)(lds + PG8_SB(b, h) + boff + n * 2048 + k * 1024); } while (0)
#define PG8_MMA(ai, bj, At, Bt) do { __builtin_amdgcn_s_setprio(1); _Pragma("unroll") for (int m = 0; m < 4; ++m) _Pragma("unroll") for (int n = 0; n < 2; ++n) _Pragma("unroll") for (int k = 0; k < 2; ++k) \
        acc[ai][bj][m][n] = __builtin_amdgcn_mfma_f32_16x16x32_bf16(Bt[n][k], At[m][k], acc[ai][bj][m][n], 0, 0, 0); __builtin_amdgcn_s_setprio(0); } while (0)
#define PG8_WAIT_V(n) asm volatile("s_waitcnt vmcnt(" #n ")" ::: "memory")
#define PG8_WAIT_L(n) asm volatile("s_waitcnt lgkmcnt(" #n ")" ::: "memory")
#define PG8_BAR __builtin_amdgcn_s_barrier()
#define PG8_SCHED __builtin_amdgcn_sched_barrier(0)
    Unit cur, nxt; int ui = 0;
    if (!S.next(0, cur)) return;
    f32x4 acc[2][2][4][2];
#pragma unroll
    for (int a = 0; a < 2; ++a)
#pragma unroll
        for (int b = 0; b < 2; ++b)
#pragma unroll
            for (int m = 0; m < 4; ++m)
#pragma unroll
                for (int n = 0; n < 2; ++n) acc[a][b][m][n] = (f32x4){0.f, 0.f, 0.f, 0.f};
    bf16x8 At[4][2], B0[2][2], B1[2][2];
    unsigned vc[2][2], vn[2][2];
#pragma unroll
    for (int h = 0; h < 2; ++h)
#pragma unroll
        for (int i = 0; i < 2; ++i) {
            if constexpr (Sched::GATHER) vc[h][i] = (unsigned)(S.arow(cur, h * HALF + RA[i]) * (unsigned)K + (unsigned)CA[i]) * 2u;
            else vc[h][i] = (unsigned)((h * HALF + RA[i]) * K + CA[i]) * 2u;
            vn[h][i] = vc[h][i];
        }
    const char* cA = S.abase(cur); const char* cB = S.bbase(cur);
    PG8_STAGE_B(PG8_SB(0, 0), cB); PG8_STAGE_A(PG8_SA(0, 0), cA, vc, 0); PG8_STAGE_B(PG8_SB(0, 1), cB + hstep); PG8_STAGE_A(PG8_SA(0, 1), cA, vc, 1);
    if (wr == 1) PG8_BAR;
    PG8_WAIT_V(4); PG8_BAR;
    PG8_STAGE_B(PG8_SB(1, 0), cB + kstep); PG8_STAGE_A(PG8_SA(1, 0), cA + kstep, vc, 0); PG8_STAGE_B(PG8_SB(1, 1), cB + hstep + kstep);
    PG8_WAIT_V(6); PG8_BAR;
    for (;;) {
        const bool has_next = S.next(ui + 1, nxt);
        const char* nA = has_next ? S.abase(nxt) : cA; const char* nB = has_next ? S.bbase(nxt) : cB;
        if constexpr (Sched::GATHER) {
            if (has_next) {
                int t2 = wave0 * 64 + lane_id(); asm volatile("" : "+v"(t2));
#pragma unroll
                for (int i = 0; i < 2; ++i) { int R, C; stage_rc(t2 * 16 + i * 8192, R, C);
#pragma unroll
                    for (int h = 0; h < 2; ++h) vn[h][i] = (unsigned)(S.arow(nxt, h * HALF + R) * (unsigned)K + (unsigned)C) * 2u; }
            }
        }
#pragma unroll 1
        for (int t = 0; t < nt; t += 2) {
            const bool last = (t == nt - 2);
            const char* a1 = cA + (size_t)(t + 1) * kstep;
            const char* a2 = last ? nA : cA + (size_t)(t + 2) * kstep; const char* b2 = last ? nB : cB + (size_t)(t + 2) * kstep;
            const char* a3 = a2 + kstep; const char* b3 = b2 + kstep;
            PG8_LDB(B0, 0, 0); PG8_SCHED; PG8_LDA(At, 0, 0); PG8_STAGE_A(PG8_SA(1, 1), a1, vc, 1);
            PG8_WAIT_L(8); PG8_BAR; PG8_WAIT_L(0); PG8_MMA(0, 0, At, B0); PG8_BAR; PG8_SCHED;
            PG8_LDB(B1, 0, 1); PG8_STAGE_B(PG8_SB(0, 0), b2);
            PG8_BAR; PG8_WAIT_L(0); PG8_MMA(0, 1, At, B1); PG8_BAR;
            PG8_LDA(At, 0, 1); PG8_STAGE_A2(PG8_SA(0, 0), a2, 0);
            PG8_BAR; PG8_WAIT_L(0); PG8_MMA(1, 0, At, B0); PG8_BAR; PG8_SCHED;
            PG8_STAGE_B(PG8_SB(0, 1), b2 + hstep);
            PG8_WAIT_V(6); PG8_BAR; PG8_MMA(1, 1, At, B1); PG8_BAR;
            PG8_LDB(B0, 1, 0); PG8_SCHED; PG8_LDA(At, 1, 0); PG8_STAGE_A2(PG8_SA(0, 1), a2, 1);
            PG8_WAIT_L(8); PG8_BAR; PG8_WAIT_L(0); PG8_MMA(0, 0, At, B0); PG8_BAR; PG8_SCHED;
            PG8_LDB(B1, 1, 1); PG8_STAGE_B(PG8_SB(1, 0), b3);
            PG8_BAR; PG8_WAIT_L(0); PG8_MMA(0, 1, At, B1); PG8_BAR;
            PG8_LDA(At, 1, 1); PG8_STAGE_A2(PG8_SA(1, 0), a3, 0);
            PG8_BAR; PG8_WAIT_L(0); PG8_MMA(1, 0, At, B0); PG8_BAR; PG8_SCHED;
            PG8_STAGE_B(PG8_SB(1, 1), b3 + hstep);
            PG8_WAIT_V(6); PG8_BAR; PG8_MMA(1, 1, At, B1); PG8_BAR;
        }
        { const int lz = lane_id(); E(acc, cur, wr, wc, lz & 15, lz >> 4); }
        if (!has_next) break;
        if (!Sched::keep_acc(cur)) {
#pragma unroll
        for (int a = 0; a < 2; ++a)
#pragma unroll
            for (int b = 0; b < 2; ++b)
#pragma unroll
                for (int m = 0; m < 4; ++m)
#pragma unroll
                    for (int n = 0; n < 2; ++n) acc[a][b][m][n] = (f32x4){0.f, 0.f, 0.f, 0.f};
        }
        cur = nxt; cA = nA; cB = nB; ++ui;
        if constexpr (Sched::GATHER) {
#pragma unroll
            for (int h = 0; h < 2; ++h)
#pragma unroll
                for (int i = 0; i < 2; ++i) vc[h][i] = vn[h][i];
        }
    }
    PG8_WAIT_V(0);
    if (wr == 0) PG8_BAR;
    PG8_BAR;
#undef PG8_SA
#undef PG8_SB
#undef PG8_STAGE
#undef PG8_STAGE_A
#undef PG8_STAGE_A2
#undef PG8_STAGE_B
#undef PG8_LDA
#undef PG8_LDB
#undef PG8_MMA
#undef PG8_WAIT_V
#undef PG8_WAIT_L
#undef PG8_BAR
#undef PG8_SCHED
}
}
using pg8::Unit;

#define XB_TMO      128
#define XB_XCNT(j)  (256  + 64 * (j))
#define XB_XSUB(j)  (1280 + 64 * (j))
#define XB_XGEN(j)  (2304 + 64 * (j))
#define XB_TOP      3328
#define XB_TOPGEN   3392
#define XCD_BAR_WORDS 3456
#define XB_SPIN_CAP (1u << 18)
__device__ __forceinline__ unsigned xb_ld(unsigned* p)              { return __hip_atomic_load(p, __ATOMIC_RELAXED, __HIP_MEMORY_SCOPE_AGENT); }
__device__ __forceinline__ unsigned xb_add(unsigned* p, unsigned v) { return __hip_atomic_fetch_add(p, v, __ATOMIC_RELAXED, __HIP_MEMORY_SCOPE_AGENT); }
__device__ __forceinline__ unsigned xb_xcc_id() { return (unsigned)__builtin_amdgcn_s_getreg((3 << 11) | 20) & 0xFu; }
#define XB_SPIN(cond, bar) do { unsigned _sp = 0; while (cond) { __builtin_amdgcn_s_sleep(1); \
    if ((++_sp & 255u) == 0u) { if (xb_ld(&(bar)[XB_TMO])) break; if (_sp > XB_SPIN_CAP) { atomicAdd(&(bar)[XB_TMO], 1u); break; } } } } while (0)
struct XcdBarrier { unsigned* bar; unsigned x; volatile LAS unsigned* st; };
__device__ __forceinline__ XcdBarrier xcd_barrier_post(unsigned* bar, volatile LAS unsigned* st) {
    XcdBarrier b; b.bar = bar; b.x = xb_xcc_id(); b.st = st;
    if (threadIdx.x == 0) (void)xb_add(&bar[XB_XCNT(b.x)], 1u);
    return b;
}
__device__ __forceinline__ void xcd_barrier_complete(unsigned* bar, unsigned x, unsigned& nloc, unsigned& nx) {
    const unsigned G = gridDim.x * gridDim.y * gridDim.z;
    unsigned sum, cnt, mine, sp = 0u;
    for (;;) {
        sum = 0u; cnt = 0u; mine = 0u;
#pragma unroll
        for (unsigned j = 0; j < 16; ++j) { const unsigned c = xb_ld(&bar[XB_XCNT(j)]); sum += c; cnt += (c > 0u) ? 1u : 0u; mine = (j == x) ? c : mine; }
        if (sum == G) break;
        __builtin_amdgcn_s_sleep(1);
        if ((++sp & 255u) == 0u) { if (xb_ld(&bar[XB_TMO])) break; if (sp > XB_SPIN_CAP) { atomicAdd(&bar[XB_TMO], 1u); break; } }
    }
    nloc = mine > 0u ? mine : 1u; nx = cnt > 0u ? cnt : 1u;
}
__device__ __forceinline__ void xcd_barrier(const XcdBarrier& b) {
    asm volatile("s_waitcnt vmcnt(0)" ::: "memory");
    __syncthreads();
    if (threadIdx.x == 0) {
        unsigned* bar = b.bar;
        __builtin_amdgcn_s_waitcnt(0);
        unsigned nloc = b.st[0], nx = b.st[1];
        if (nloc == 0u) { xcd_barrier_complete(bar, b.x, nloc, nx); b.st[0] = nloc; b.st[1] = nx; }
        const unsigned old = xb_add(&bar[XB_XSUB(b.x)], 1u);
        const unsigned gen = old / nloc;
        if (old + 1u == (gen + 1u) * nloc) {
            __builtin_amdgcn_fence(__ATOMIC_RELEASE, "agent");
            asm volatile("s_waitcnt vmcnt(0)" ::: "memory");
            const unsigned og = xb_add(&bar[XB_TOP], 1u);
            const unsigned tg = og / nx;
            if (og + 1u == (tg + 1u) * nx) xb_add(&bar[XB_TOPGEN], 1u);
            else XB_SPIN(xb_ld(&bar[XB_TOPGEN]) == tg, bar);
            __builtin_amdgcn_fence(__ATOMIC_ACQUIRE, "agent");
            xb_add(&bar[XB_XGEN(b.x)], 1u);
            asm volatile("s_waitcnt vmcnt(0)" ::: "memory");
        } else {
            XB_SPIN(xb_ld(&bar[XB_XGEN(b.x)]) == gen, bar);
            __builtin_amdgcn_fence(__ATOMIC_ACQUIRE, "agent");
            asm volatile("s_waitcnt vmcnt(0)" ::: "memory");
        }
    }
    __syncthreads();
}

struct Args { const float* in[19]; float* out; unsigned char* ws; int ph_lo, ph_hi; };
typedef const __attribute__((address_space(4))) Args* ArgsP;
enum { I_X = 0, I_N1G, I_WIN, I_CONVW, I_IFB, I_MNG, I_WBM, I_WBA, I_WOUT, I_RELB, I_N2G, I_WGRP, I_BGRP, I_WEXP, I_BEXP, I_W1, I_W3, I_W2, I_FG };


struct TrDesc { const float* W; bf16* WT; size_t ldn, ldk; int k0, n0, r0; };
__device__ __forceinline__ void tr_load(const TrDesc& d, f32x4 (&tv)[16], int lane) {
    const int nn4 = (lane & 15) * 4, kr = lane >> 4;
#pragma unroll
    for (int i = 0; i < 16; ++i) tv[i] = __builtin_nontemporal_load((const f32x4*)(d.W + (size_t)(d.k0 + 4 * i + kr) * d.ldn + d.n0 + nn4));
}
__device__ __forceinline__ void tr_finish(const TrDesc& d, f32x4 (&tv)[16], LAS float* scr, int lane) {
    const int nn4 = (lane & 15) * 4, kr = lane >> 4;
#pragma unroll
    for (int i = 0; i < 16; i += 4) asm volatile("" : "+v"(tv[i]), "+v"(tv[i + 1]), "+v"(tv[i + 2]), "+v"(tv[i + 3]));
#pragma unroll
    for (int i = 0; i < 16; ++i) { const int kk = 4 * i + kr; const f32x4 v = tv[i];
        LAS float* q = scr + kk * 65 + nn4; q[0] = v.x; q[1] = v.y; q[2] = v.z; q[3] = v.w; }
    LDS_WAIT();
    const int kc = (lane & 7) * 8;
#pragma unroll
    for (int p = 0; p < 8; ++p) { const int nn = 8 * p + (lane >> 3); const LAS float* sp = scr + kc * 65 + nn;
        u32x4 o; o.x = cvt_pk_bf16(sp[0], sp[65]); o.y = cvt_pk_bf16(sp[130], sp[195]); o.z = cvt_pk_bf16(sp[260], sp[325]); o.w = cvt_pk_bf16(sp[390], sp[455]);
        *(u32x4*)(d.WT + (size_t)(d.r0 + nn) * d.ldk + d.k0 + kc) = o; }
    LDS_WAIT();
}
__device__ __forceinline__ int win_src_col(int r) {
    if (r < 2048) return r;
    if (r < 3072) return r + 1024;
    if (r < 5120) return r + 1032;
    if (r < 9216) return r + 2056;
    if (r < 10240) return r - 7168;
    return r - 4088;
}
__device__ __forceinline__ TrDesc tr_decode(ArgsP a, unsigned char* ws, int it) {
    constexpr int PER_LAYER = 5632 + 512 + 512 + 1024 + 4096 + 4096 + 4096;
    const int l = it / PER_LAYER; int r = it % PER_LAYER;
    TrDesc d;
    if (r < 5632) { const int kb = r / 176, ng = r % 176;
        d.W = a->in[I_WIN] + (size_t)l * DM * INCOLS; d.ldn = INCOLS; d.k0 = 64 * kb; d.n0 = win_src_col(64 * ng); d.WT = (bf16*)(ws + WS_WINT) + (size_t)l * 11264 * 2048; d.ldk = 2048; d.r0 = 64 * ng; return d; }
    r -= 5632;
    if (r < 512) { const int kb = r / 32, ng = r % 32;
        d.W = a->in[I_WBM] + (size_t)l * 1024 * 2048; d.ldn = 2048; d.k0 = 64 * kb; d.n0 = 64 * ng; d.WT = (bf16*)(ws + WS_WBM) + (size_t)l * 2048 * 1024; d.ldk = 1024; d.r0 = 64 * ng; return d; }
    r -= 512;
    if (r < 512) { const int kb = r / 32, ng = r % 32;
        d.W = a->in[I_WBA] + (size_t)l * 1024 * 2048; d.ldn = 2048; d.k0 = 64 * kb; d.n0 = 64 * ng; d.WT = (bf16*)(ws + WS_WBA) + (size_t)l * 2048 * 1024; d.ldk = 1024; d.r0 = 64 * ng; return d; }
    r -= 512;
    if (r < 1024) { const int kb = r / 32, ng = r % 32;
        d.W = a->in[I_WOUT] + (size_t)l * 2048 * 2048; d.ldn = 2048; d.k0 = 64 * kb; d.n0 = 64 * ng; d.WT = (bf16*)(ws + WS_WOUT) + (size_t)l * 2048 * 2048; d.ldk = 2048; d.r0 = 64 * ng; return d; }
    r -= 1024;
    if (r < 8192) { const int w3 = r >= 4096; const int q = r & 4095; const int e = q >> 7, rr = q & 127, kb = rr >> 2, ng = rr & 3;
        d.W = a->in[w3 ? I_W3 : I_W1] + (size_t)(l * 32 + e) * 2048 * 256; d.ldn = 256; d.k0 = 64 * kb; d.n0 = 64 * ng;
        d.WT = (bf16*)(ws + WS_W13) + (size_t)(l * 32 + e) * 512 * 2048; d.ldk = 2048; d.r0 = 256 * (ng >> 1) + 64 * (ng & 1) + (w3 ? 128 : 0); return d; }
    r -= 8192;
    { const int e = r >> 7, rr = r & 127, kb = rr >> 5, ng = rr & 31;
        d.W = a->in[I_W2] + (size_t)(l * 32 + e) * 256 * 2048; d.ldn = 2048; d.k0 = 64 * kb; d.n0 = 64 * ng; d.WT = (bf16*)(ws + WS_W2) + (size_t)(l * 32 + e) * 2048 * 256; d.ldk = 256; d.r0 = 64 * ng; return d; }
}
#ifndef CVX
#define CVX 4096
#endif
__device__ __forceinline__ void prologue_phase(ArgsP a, LAS unsigned char* lds, int tid, int lane, int wave, int bid, int G, const int part = 0) {
    unsigned char* ws = a->ws;
    LAS float* scr = (LAS float*)(lds + wave * 16640);
    const int gw = bid * NWAVES + wave, NGW = G * NWAVES;
    constexpr int PER_LAYER = 5632 + 512 + 512 + 1024 + 4096 + 4096 + 4096;
    constexpr int W0 = 5632, W2I = PER_LAYER - 4096;
    const int v_lo = part == 0 ? 0 : part == 1 ? PER_LAYER : part == 2 ? W0 + CVX : part == 3 ? PER_LAYER + W0 : PER_LAYER + W2I;
    const int v_hi = part == 0 ? W0 + CVX : part == 1 ? PER_LAYER + W0 : part == 2 ? PER_LAYER : part == 3 ? PER_LAYER + W2I : 2 * PER_LAYER;
#define CV_ITEM(v) (v)
    f32x4 tvA[16], tvB[16]; TrDesc dA, dB;
    int it = v_lo + gw;
    if (it < v_hi) {
        int rem = (v_hi - 1 - it) / NGW;
        dA = tr_decode(a, ws, CV_ITEM(it)); tr_load(dA, tvA, lane);
#pragma unroll 1
        while (rem >= 2) {
            dB = tr_decode(a, ws, CV_ITEM(it + NGW)); tr_load(dB, tvB, lane);
            tr_finish(dA, tvA, scr, lane);
            it += 2 * NGW;
            dA = tr_decode(a, ws, CV_ITEM(it)); tr_load(dA, tvA, lane);
            tr_finish(dB, tvB, scr, lane);
            rem -= 2;
        }
        if (rem == 1) { dB = tr_decode(a, ws, CV_ITEM(it + NGW)); tr_load(dB, tvB, lane); tr_finish(dA, tvA, scr, lane); tr_finish(dB, tvB, scr, lane); }
        else tr_finish(dA, tvA, scr, lane);
    }
#undef CV_ITEM
    if (part != 0) return;
    const int gt = bid * NTHR + tid, NGT = G * NTHR;
    float* wrt = (float*)(ws + MS_WRT);
    for (int i = gt; i < 2 * 36 * 2048; i += NGT) { const int l = i / (36 * 2048), rr = i % (36 * 2048), n = rr >> 11, k = rr & 2047;
        wrt[i] = n < 4 ? a->in[I_WGRP][((size_t)l * DM + k) * 4 + n] : a->in[I_WEXP][((size_t)l * DM + k) * 32 + (n - 4)]; }
}

__device__ __forceinline__ void moe_tables(unsigned char* ws, int l, LAS unsigned char* misc, int tid) {
    LAS int* cnt = (LAS int*)(misc + MO_CNT); LAS int* ntl = (LAS int*)(misc + MO_NT); LAS int* off = (LAS int*)(misc + MO_OFF);
    LAS int* te = (LAS int*)(misc + MO_TE); LAS int* tr0 = (LAS int*)(misc + MO_TR0); LAS int* mt = (LAS int*)(misc + MO_MT);
    __syncthreads();
    if (tid < 32) { const int c = (int)__hip_atomic_load((unsigned*)(ws + WS_CTL) + CW_CNT + 32 * l + tid, __ATOMIC_RELAXED, __HIP_MEMORY_SCOPE_AGENT); cnt[tid] = c; ntl[tid] = (c + 255) >> 8; }
    __syncthreads();
    if (tid == 0) { int o = 0;
#pragma unroll 1
        for (int e = 0; e < 32; ++e) { off[e] = o; const int n = ntl[e];
#pragma unroll 1
            for (int j = 0; j < n; ++j) { te[o + j] = e; tr0[o + j] = 256 * j; } o += n; } off[32] = o; mt[0] = o; }
    __syncthreads();
}

#ifndef DRYX
#define DRYX 0
#endif
template <int MODE>
__device__ __forceinline__ void norm_phase(ArgsP a, int l, LAS unsigned char* lds, int tid, int lane, int wave, int bid, int G, const bool dry = false) {
    unsigned char* ws = a->ws;
    LAS unsigned char* misc = lds + MISC_OFF;
    if (MODE == 1 || MODE == 3) moe_tables(ws, MODE == 1 ? 0 : 1, misc, tid);
    const LAS int* off = (const LAS int*)(misc + MO_OFF);
    const float* src = (MODE == 0) ? a->in[I_X] : a->out;
    const float* gain = (MODE < 2) ? a->in[I_N1G] + l * DM : (MODE == 2 ? a->in[I_N2G] + l * DM : a->in[I_FG]);
    const int* toke = (const int*)(ws + MS_TOKE); const int* tokp = (const int*)(ws + MS_TOKP);
    const bf16* OP = (const bf16*)(ws + WS_OP);
    bf16* H = (bf16*)(ws + WS_H);
    const int gw = bid * NWAVES + wave, NGW = G * NWAVES;
    constexpr int RP = (MODE == 2) ? 4 : 2;
    LAS float* gwl = (LAS float*)lds;
    if (MODE < 2) {
        const float* wg = a->in[I_WIN] + (size_t)l * DM * INCOLS + 4096;
        f32x4 t0[4], t1[4];
#pragma unroll
        for (int i = 0; i < 4; ++i) { const float* wp = wg + (size_t)(tid + NTHR * i) * INCOLS; t0[i] = *(const f32x4*)wp; t1[i] = *(const f32x4*)(wp + 4); }
#pragma unroll
        for (int i = 0; i < 4; ++i) { const int k = tid + NTHR * i;
            gwl[k] = t0[i].x; gwl[2048 + k] = t0[i].y; gwl[4096 + k] = t0[i].z; gwl[6144 + k] = t0[i].w;
            gwl[8192 + k] = t1[i].x; gwl[10240 + k] = t1[i].y; gwl[12288 + k] = t1[i].z; gwl[14336 + k] = t1[i].w; }
        __syncthreads();
    }
    const int npass = (NTOK + NGW * RP - 1) / (NGW * RP);
    for (int m0_ = gw * RP, it = 0; (MODE == 2) ? (it < npass) : (m0_ < NTOK); m0_ += NGW * RP, ++it) {
        const bool valid = (MODE != 2) || (m0_ < NTOK);
        const int m0 = valid ? m0_ : NTOK - RP;
        f32x4 v[RP][8];
        const bf16* orow[RP][2]; float cw[RP][2];
        if (MODE == 1 || MODE == 3) {
#pragma unroll
            for (int r = 0; r < RP; ++r) { const int m = m0 + r;
                const int e0 = toke[2 * m], e1 = toke[2 * m + 1], p0 = tokp[2 * m], p1 = tokp[2 * m + 1];
                cw[r][0] = ((const float*)(ws + MS_TOKW))[2 * m]; cw[r][1] = ((const float*)(ws + MS_TOKW))[2 * m + 1];
                orow[r][0] = OP + (size_t)(off[e0] * 256 + p0) * DM + 4 * lane; orow[r][1] = OP + (size_t)(off[e1] * 256 + p1) * DM + 4 * lane; }
        }
#pragma unroll
        for (int r = 0; r < RP; ++r)
#pragma unroll
            for (int j = 0; j < 8; ++j) v[r][j] = *(const f32x4*)(src + (size_t)(m0 + r) * DM + 256 * j + 4 * lane);
        if (MODE == 1 || MODE == 3) {
            u32x2 ow[RP][2][8];
#pragma unroll
            for (int r = 0; r < RP; ++r)
#pragma unroll
                for (int j = 0; j < 8; ++j) { ow[r][0][j] = *(const u32x2*)(orow[r][0] + 256 * j); ow[r][1][j] = *(const u32x2*)(orow[r][1] + 256 * j); }
#pragma unroll
            for (int r = 0; r < RP; ++r)
                asm volatile("" : "+v"(ow[r][0][0]), "+v"(ow[r][0][1]), "+v"(ow[r][0][2]), "+v"(ow[r][0][3]), "+v"(ow[r][0][4]), "+v"(ow[r][0][5]), "+v"(ow[r][0][6]), "+v"(ow[r][0][7]),
                                  "+v"(ow[r][1][0]), "+v"(ow[r][1][1]), "+v"(ow[r][1][2]), "+v"(ow[r][1][3]), "+v"(ow[r][1][4]), "+v"(ow[r][1][5]), "+v"(ow[r][1][6]), "+v"(ow[r][1][7]));
#pragma unroll
            for (int r = 0; r < RP; ++r) { const int m = m0 + r; const float cw0 = cw[r][0], cw1 = cw[r][1];
#pragma unroll
                for (int j = 0; j < 8; ++j) { const u32x2 w0 = ow[r][0][j], w1 = ow[r][1][j];
                    v[r][j].x += cw0 * bflo(w0.x) + cw1 * bflo(w1.x); v[r][j].y += cw0 * bfhi(w0.x) + cw1 * bfhi(w1.x); v[r][j].z += cw0 * bflo(w0.y) + cw1 * bflo(w1.y); v[r][j].w += cw0 * bfhi(w0.y) + cw1 * bfhi(w1.y); }
                if (MODE == 1 && !dry) {
#pragma unroll
                    for (int j = 0; j < 8; ++j) *(f32x4*)(a->out + (size_t)m * DM + 256 * j + 4 * lane) = v[r][j]; }
            }
        }
        float rs[RP];
#pragma unroll
        for (int r = 0; r < RP; ++r) { float ss = 0.f;
#pragma unroll
            for (int j = 0; j < 8; ++j) ss += (v[r][j].x * v[r][j].x + v[r][j].y * v[r][j].y) + (v[r][j].z * v[r][j].z + v[r][j].w * v[r][j].w);
            rs[r] = __builtin_amdgcn_rsqf(wave_sum(ss) * (1.0f / DM) + RMS_EPS); }
        {
            f32x4 gv[8];
            int l4 = 4 * lane; asm volatile("" : "+v"(l4)); const float* gp = gain + l4;
#pragma unroll
            for (int j = 0; j < 8; ++j) gv[j] = *(const f32x4*)(gp + 256 * j);
            asm volatile("" : "+v"(gv[0]), "+v"(gv[1]), "+v"(gv[2]), "+v"(gv[3]), "+v"(gv[4]), "+v"(gv[5]), "+v"(gv[6]), "+v"(gv[7]));
#pragma unroll
            for (int j = 0; j < 8; ++j)
#pragma unroll
                for (int r = 0; r < RP; ++r) v[r][j] = v[r][j] * rs[r] * gv[j];
        }
        if (MODE == 3) {
#pragma unroll
            for (int r = 0; r < RP; ++r)
#pragma unroll
                for (int j = 0; j < 8; ++j) { if (!dry) *(f32x4*)(a->out + (size_t)(m0 + r) * DM + 256 * j + 4 * lane) = v[r][j]; else asm volatile("" :: "v"(v[r][j])); }
            continue;
        }
#pragma unroll
        for (int r = 0; r < RP; ++r)
#pragma unroll
            for (int j = 0; j < 8; ++j) { u32x2 w; w.x = cvt_pk_bf16(v[r][j].x, v[r][j].y); w.y = cvt_pk_bf16(v[r][j].z, v[r][j].w);
                if (!dry && valid) *(u32x2*)(H + (size_t)(m0 + r) * DM + 256 * j + 4 * lane) = w; else asm volatile("" :: "v"(w)); }
        float keep[RP]; _Pragma("unroll") for (int r = 0; r < RP; ++r) keep[r] = 0.f;
        if (MODE < 2) {
            float a8[RP][8];
#pragma unroll
            for (int r = 0; r < RP; ++r)
#pragma unroll
                for (int n = 0; n < 8; ++n) a8[r][n] = 0.f;
#pragma unroll
            for (int j = 0; j < 8; ++j) {
#pragma unroll
                for (int nh = 0; nh < 2; ++nh) {
                    f32x4 wn[4];
#pragma unroll
                    for (int n = 0; n < 4; ++n) wn[n] = *(const LAS f32x4*)(gwl + (4 * nh + n) * 2048 + 256 * j + 4 * lane);
                    asm volatile("" : "+v"(wn[0]), "+v"(wn[1]), "+v"(wn[2]), "+v"(wn[3]));
#pragma unroll
                    for (int r = 0; r < RP; ++r)
#pragma unroll
                        for (int n = 0; n < 4; ++n) a8[r][4 * nh + n] += (v[r][j].x * wn[n].x + v[r][j].y * wn[n].y) + (v[r][j].z * wn[n].z + v[r][j].w * wn[n].w);
                }
            }
#pragma unroll
            for (int r = 0; r < RP; ++r)
#pragma unroll
                for (int n = 0; n < 8; ++n) { const float d = wave_sum(a8[r][n]); keep[r] = (lane == n) ? d : keep[r]; }
        } else {
            const float* W = (const float*)(ws + MS_WRT) + (size_t)l * 36 * 2048;
            LAS float* logl = (LAS float*)(misc + MO_LOG) + wave * 160;
            LAS float* wb = (LAS float*)lds;
#define RT_STAGE(g_, buf_) do { _Pragma("unroll") for (int i = 0; i < 4; ++i) \
                __builtin_amdgcn_global_load_lds((const unsigned*)(W + (size_t)(g_) * 8192 + (wave * 4 + i) * 256 + 4 * lane), (LAS unsigned*)(wb + (buf_) * 8192 + (wave * 4 + i) * 256), 16, 0, 0); } while (0)
            RT_STAGE(0, 0);
            asm volatile("s_waitcnt vmcnt(0)" ::: "memory");
            __syncthreads();
#pragma unroll 1
            for (int grp = 0; grp < 9; ++grp) {
                float val[16];
                if (grp < 8) RT_STAGE(grp + 1, (grp + 1) & 1);
                const LAS float* wg = wb + (grp & 1) * 8192 + 4 * lane;
#pragma unroll
                for (int nl = 0; nl < 4; ++nl) {
                    f32x2 d[4] = {(f32x2){0.f, 0.f}, (f32x2){0.f, 0.f}, (f32x2){0.f, 0.f}, (f32x2){0.f, 0.f}};
                    f32x4 wv[8];
#pragma unroll
                    for (int j = 0; j < 8; ++j) wv[j] = *(const LAS f32x4*)(wg + nl * 2048 + 256 * j);
                    asm volatile("" : "+v"(wv[0]), "+v"(wv[1]), "+v"(wv[2]), "+v"(wv[3]), "+v"(wv[4]), "+v"(wv[5]), "+v"(wv[6]), "+v"(wv[7]));
#pragma unroll
                    for (int j = 0; j < 8; ++j) { const f32x4 w = wv[j];
#pragma unroll
                        for (int r = 0; r < 4; ++r) { d[r] = __builtin_elementwise_fma((f32x2){v[r][j].x, v[r][j].y}, (f32x2){w.x, w.y}, d[r]); d[r] = __builtin_elementwise_fma((f32x2){v[r][j].z, v[r][j].w}, (f32x2){w.z, w.w}, d[r]); } }
#pragma unroll
                    for (int r = 0; r < 4; ++r) val[4 * nl + r] = d[r].x + d[r].y;
                    __builtin_amdgcn_sched_barrier(0);
                }
                asm volatile("s_waitcnt vmcnt(0)" ::: "memory");
                __syncthreads();
#pragma unroll
                for (int i = 0; i < 8; ++i) { const bool hi = (lane & 32) != 0; const float snd = hi ? val[i] : val[i + 8]; const float kp = hi ? val[i + 8] : val[i]; val[i] = kp + __shfl_xor(snd, 32); }
#pragma unroll
                for (int i = 0; i < 4; ++i) { const bool hi = (lane & 16) != 0; const float snd = hi ? val[i] : val[i + 4]; const float kp = hi ? val[i + 4] : val[i]; val[i] = kp + __shfl_xor(snd, 16); }
#pragma unroll
                for (int i = 0; i < 2; ++i) { const bool hi = (lane & 8) != 0; const float snd = hi ? val[i] : val[i + 2]; const float kp = hi ? val[i + 2] : val[i]; val[i] = kp + __shfl_xor(snd, 8); }
                { const bool hi = (lane & 4) != 0; const float snd = hi ? val[0] : val[1]; const float kp = hi ? val[1] : val[0]; val[0] = kp + __shfl_xor(snd, 4); }
                float f = val[0]; f += __shfl_xor(f, 2); f += __shfl_xor(f, 1);
                const int vi = lane >> 2;
                if ((lane & 3) == 0) logl[(vi & 3) * 40 + 4 * grp + (vi >> 2)] = f;
            }
        }
        if (MODE < 2) {
            float* ifg = (float*)(ws + MS_IFG);
            if (lane < 8) {
#pragma unroll
                for (int r = 0; r < RP; ++r) { if (!dry) ifg[(size_t)(m0 + r) * 8 + lane] = keep[r]; else asm volatile("" :: "v"(keep[r])); } }
        } else {
            LAS float* logl = (LAS float*)(misc + MO_LOG) + wave * 160;
            LDS_WAIT();
            if (dry) { asm volatile("" :: "v"(keep[0])); }
            if (lane < RP && !dry && valid) {
                const int m = m0 + lane; const LAS float* lg = logl + lane * 40;
                const float* bg = a->in[I_BGRP] + l * 4; const float* be = a->in[I_BEXP] + l * 32;
                float gv[4]; int gsel = 0;
#pragma unroll
                for (int j = 0; j < 4; ++j) gv[j] = lg[j] + bg[j];
                float gmax = gv[0];
#pragma unroll
                for (int j = 1; j < 4; ++j) if (gv[j] > gmax) { gmax = gv[j]; gsel = j; }
                float gs = 0.f;
#pragma unroll
                for (int j = 0; j < 4; ++j) gs += expf(gv[j] - gmax);
                const float pg = 1.0f / gs;
                float ev[8];
#pragma unroll
                for (int j = 0; j < 8; ++j) ev[j] = lg[4 + 8 * gsel + j] + be[8 * gsel + j];
                int e0 = 0; float m0v = ev[0];
#pragma unroll
                for (int j = 1; j < 8; ++j) if (ev[j] > m0v) { m0v = ev[j]; e0 = j; }
                int e1 = -1; float m1v = -3.0e38f;
#pragma unroll
                for (int j = 0; j < 8; ++j) if (j != e0 && ev[j] > m1v) { m1v = ev[j]; e1 = j; }
                const float p1 = expf(m1v - m0v); const float w0 = pg / (1.0f + p1), w1 = pg * p1 / (1.0f + p1);
                unsigned* cnt = (unsigned*)(ws + WS_CTL) + CW_CNT + 32 * l;
                int* list = (int*)(ws + MS_LIST); float* pwl = (float*)(ws + MS_PWL); int* tke = (int*)(ws + MS_TOKE); int* tkp = (int*)(ws + MS_TOKP);
                const int id0 = 8 * gsel + e0, id1 = 8 * gsel + e1;
                const int q0 = (int)__hip_atomic_fetch_add(cnt + id0, 1u, __ATOMIC_RELAXED, __HIP_MEMORY_SCOPE_AGENT);
                const int q1 = (int)__hip_atomic_fetch_add(cnt + id1, 1u, __ATOMIC_RELAXED, __HIP_MEMORY_SCOPE_AGENT);
                list[id0 * 8192 + q0] = m; pwl[id0 * 8192 + q0] = w0; list[id1 * 8192 + q1] = m; pwl[id1 * 8192 + q1] = w1;
                tke[2 * m] = id0; tke[2 * m + 1] = id1; tkp[2 * m] = q0; tkp[2 * m + 1] = q1;
                ((float*)(ws + MS_TOKW))[2 * m] = w0; ((float*)(ws + MS_TOKW))[2 * m + 1] = w1;
            }
            LDS_WAIT();
        }
    }
}

struct SchedG1 {
    static constexpr bool GATHER = false;
    const char* H; const char* W; int G, c;
    static constexpr int NCV = 21;
    __device__ __forceinline__ bool next(int i, Unit& u) const {
        int L = i * G + c;
        if (G == 256) {
            if (c >= 256 - NCV) return false;
            if (c >= 128 && i == 5) { const int k = c - 128; if (k >= 5 * NCV) return false; L = (k % 5) * 256 + (256 - NCV) + k / 5; }
            else if (i > 5) return false;
        }
        if (L < 1152) { pg8::static_tile(L, 32, 36, u.pm, u.pn); u.aux = 0; return true; }
        const int r = L - 1152; if (r >= 256) return false;
        u.aux = 1 + (r >> 7); const int q = r & 127; u.pm = q & 3; u.pn = q >> 2; return true;
    }
    __device__ __forceinline__ const char* abase(const Unit& u) const { return u.aux == 0 ? H + (size_t)u.pm * 256 * 4096 : W + (size_t)(9216 + (u.aux - 1) * 1024 + u.pm * 256) * 4096; }
    __device__ __forceinline__ const char* bbase(const Unit& u) const { return u.aux == 0 ? W + (size_t)u.pn * 256 * 4096 : H + (size_t)u.pn * 256 * 4096; }
    __device__ __forceinline__ unsigned arow(const Unit&, int) const { return 0u; }
    static __device__ __forceinline__ bool keep_acc(const Unit&) { return false; }
};
struct EpiG1 {
    static constexpr bool PERM = true;
    unsigned char* ws; bool dry;
    __device__ __forceinline__ void operator()(f32x4 (&acc)[2][2][4][2], const Unit& u, int wr, int wc, int fr, int fq) const {
        if (dry) {
#pragma unroll
            for (int ai = 0; ai < 2; ++ai)
#pragma unroll
                for (int bj = 0; bj < 2; ++bj)
#pragma unroll
                    for (int m = 0; m < 4; ++m) asm volatile("" :: "v"(acc[ai][bj][m][0]), "v"(acc[ai][bj][m][1]));
            return; }
        if (u.aux == 0) {
            bf16* dst; int ld, colt, op;
            if (u.pn < 8) { dst = (bf16*)(ws + WS_ZQK); ld = 2048; colt = 256 * u.pn; op = 0; }
            else if (u.pn < 12) { dst = (bf16*)(ws + WS_OM); ld = 1024; colt = 256 * (u.pn - 8); op = 1; }
            else if (u.pn < 16) { dst = (bf16*)(ws + WS_QA); ld = 1024; colt = 256 * (u.pn - 12); op = 2; }
            else if (u.pn < 20) { dst = (bf16*)(ws + WS_KA); ld = 1024; colt = 256 * (u.pn - 16); op = 0; }
            else { dst = (bf16*)(ws + WS_SG); ld = 4096; colt = 256 * (u.pn - 20); op = 1; }
            const float scl = (op == 2) ? 0.12751743074602267f : 1.0f;
            const int row0 = u.pm * 256 + wr * 64 + fr, col0 = colt + wc * 32 + 8 * fq;
#pragma unroll
            for (int ai = 0; ai < 2; ++ai)
#pragma unroll
                for (int m = 0; m < 4; ++m) { bf16* rowp = dst + (size_t)(row0 + ai * 128 + m * 16) * ld + col0;
#pragma unroll
                    for (int bj = 0; bj < 2; ++bj) { f32x4 v0 = acc[ai][bj][m][0] * scl, v1 = acc[ai][bj][m][1] * scl;
                        if (op == 1) {
#pragma unroll
                            for (int j = 0; j < 4; ++j) { v0[j] = sigmoidf_(v0[j]); v1[j] = sigmoidf_(v1[j]); } }
                        u32x4 w; w.x = cvt_pk_bf16(v0[0], v0[1]); w.y = cvt_pk_bf16(v0[2], v0[3]); w.z = cvt_pk_bf16(v1[0], v1[1]); w.w = cvt_pk_bf16(v1[2], v1[3]);
                        *(u32x4*)(rowp + bj * 128) = w; } }
        } else {
            bf16* dst = (bf16*)(ws + (u.aux == 1 ? WS_VMT : WS_VAT));
            const int b = u.pn >> 3, s0 = (u.pn & 7) * 256 + wc * 32 + 8 * fq, rr0 = u.pm * 256 + wr * 64 + fr;
#pragma unroll
            for (int ai = 0; ai < 2; ++ai)
#pragma unroll
                for (int m = 0; m < 4; ++m) { const int rr = rr0 + ai * 128 + m * 16;
#pragma unroll
                    for (int bj = 0; bj < 2; ++bj) { const f32x4 v0 = acc[ai][bj][m][0], v1 = acc[ai][bj][m][1];
                        u32x4 w; w.x = cvt_pk_bf16(v0[0], v0[1]); w.y = cvt_pk_bf16(v0[2], v0[3]); w.z = cvt_pk_bf16(v1[0], v1[1]); w.w = cvt_pk_bf16(v1[2], v1[3]);
                        const int sq = s0 + bj * 128;
                        const size_t off = (u.aux == 1) ? (size_t)((((b * 4 + (rr >> 8)) * 32 + (sq >> 6)) * 2 + ((sq >> 5) & 1)) * 16 + ((rr & 255) >> 4)) * 512 + (size_t)((((sq >> 3) & 3) * 16 + (rr & 15)) * 8)
                                                        : (size_t)(b * 1024 + rr) * 2048 + sq;
                        *(u32x4*)(dst + off) = w; } }
        }
    }
};

__device__ __forceinline__ void gate_unit(ArgsP a, int l, LAS unsigned char* lds, int bh, int tid, int lane, int wave) {
    unsigned char* ws = a->ws;
    {
            const int b = bh >> 2, h = bh & 3;
            LAS float* bl = (LAS float*)lds; LAS float* amx = bl + 32; LAS float* mpv = bl + 64; LAS float* gcv = bl + 96;
            const float* ifg = (const float*)(ws + MS_IFG); const float* ifb = a->in[I_IFB] + l * 8;
            float A[4], Bs[4], CM[4];
#pragma unroll
            for (int cc = 0; cc < 4; ++cc) { const int c = wave + 8 * cc, s = 64 * c + lane; const size_t tok = (size_t)b * SEQ + s;
                const float ig = ifg[tok * 8 + h] + ifb[h], fg = ifg[tok * 8 + 4 + h] + ifb[4 + h];
                const float lf = fminf(fg, 0.f) - log1pf(expf(-fabsf(fg)));
                float bs = lf;
#pragma unroll
                for (int o = 1; o < 64; o <<= 1) { const float t = __shfl_up(bs, o); if (lane >= o) bs += t; }
                const float av = ig - bs; float cm = av;
#pragma unroll
                for (int o = 1; o < 64; o <<= 1) { const float t = __shfl_up(cm, o); if (lane >= o) cm = fmaxf(cm, t); }
                A[cc] = av; Bs[cc] = bs; CM[cc] = cm;
                if (lane == 63) { bl[c] = bs; amx[c] = cm; } }
            __syncthreads();
            if (tid == 0) { float m = 0.f;
#pragma unroll 1
                for (int c = 0; c < 32; ++c) { mpv[c] = m; const float Gm = fmaxf(m, amx[c]); gcv[c] = Gm; m = bl[c] + Gm; } }
            __syncthreads();
            float* AS = (float*)(ws + MS_AS) + bh * 2048; float* GT = (float*)(ws + MS_GT) + bh * 2048; float* WI = (float*)(ws + MS_WI) + bh * 2048;
            float* CL = (float*)(ws + MS_CL) + bh * 2048; float* WSs = (float*)(ws + MS_WS) + bh * 2048; float* DEC = (float*)(ws + MS_DEC) + bh * 32;
#pragma unroll
            for (int cc = 0; cc < 4; ++cc) { const int c = wave + 8 * cc, s = 64 * c + lane; const float mp = mpv[c], Gm = gcv[c], gt = fmaxf(mp, CM[cc]);
                AS[s] = A[cc]; GT[s] = gt; WI[s] = expf(mp - gt); CL[s] = expf(-(Bs[cc] + gt)); WSs[s] = expf(A[cc] - Gm);
                if (lane == 0) DEC[c] = expf(mp - Gm); }
        }
    __syncthreads();
}

__device__ __forceinline__ void conv_phase(ArgsP a, int l, LAS unsigned char* lds, int tid, int lane, int wave, int bid, int G) {
    unsigned char* ws = a->ws;
    u32x4 xv[5];
    const bf16* Z = (const bf16*)(ws + WS_ZQK);
#define CONV_LOAD(u_) do { const int cg_ = (u_) & 7, s0_ = 64 * (((u_) >> 3) & 31), b_ = (u_) >> 8; _Pragma("unroll") for (int i = 0; i < 5; ++i) { \
        const int idx = tid + NTHR * i, row = idx >> 5, ch = idx & 31, sq = s0_ - 3 + row; xv[i] = (u32x4){0u, 0u, 0u, 0u}; \
        if (idx < 67 * 32 && sq >= 0) xv[i] = *(const u32x4*)(Z + (size_t)(b_ * SEQ + sq) * 2048 + cg_ * 256 + ch * 8); } } while (0)
    if (bid < 1024) CONV_LOAD(bid);
    for (int u = bid; u < 1024 + 256; u += G) {
        if (u < 1024) {
            const int cg = u & 7, st = (u >> 3) & 31, b = u >> 8, s0 = 64 * st;
            LAS unsigned char* xt = lds; LAS unsigned char* kt = lds + 36864;
            asm volatile("" : "+v"(xv[0]), "+v"(xv[1]), "+v"(xv[2]), "+v"(xv[3]), "+v"(xv[4]));
#pragma unroll
            for (int i = 0; i < 5; ++i) { const int idx = tid + NTHR * i, row = idx >> 5, ch = idx & 31;
                if (idx < 67 * 32) *(LAS u32x4*)(xt + row * 512 + ch * 16) = xv[i]; }
            LAS float* wst = (LAS float*)(lds + 73728);
            if (cg >= 4 && tid < 64) wst[tid] = ((const float*)(ws + MS_WS))[(size_t)(b * 4 + cg - 4) * 2048 + s0 + tid];
            __syncthreads();
            if (u + G < 1024) CONV_LOAD(u + G);
            const int cp = tid & 127, tg = tid >> 7, c = 2 * cp, gc = cg * 256 + c;
            float w0[4], w1[4];
#pragma unroll
            for (int j = 0; j < 4; ++j) { w0[j] = a->in[I_CONVW][(size_t)(l * 4 + j) * 2048 + gc]; w1[j] = a->in[I_CONVW][(size_t)(l * 4 + j) * 2048 + gc + 1]; }
            bf16* QM = (bf16*)(ws + WS_QM); bf16* KM = (bf16*)(ws + WS_KM);
#pragma unroll 4
            for (int tt = 0; tt < 16; ++tt) { const int t = tg * 16 + tt; float a0 = 0.f, a1 = 0.f;
#pragma unroll
                for (int j = 0; j < 4; ++j) { const unsigned x = *(const LAS unsigned*)(xt + (t + j) * 512 + c * 2); a0 += w0[j] * bflo(x); a1 += w1[j] * bfhi(x); }
                float o0 = a0 * sigmoidf_(a0), o1 = a1 * sigmoidf_(a1);
                const size_t tok = (size_t)b * SEQ + s0 + t;
                if (cg < 4) { *(unsigned*)(QM + tok * 1024 + cg * 256 + c) = cvt_pk_bf16(o0, o1); }
                else { o0 *= 0.0625f; o1 *= 0.0625f; const unsigned p = cvt_pk_bf16(o0, o1);
                    *(unsigned*)(KM + tok * 1024 + (cg - 4) * 256 + c) = p;
                    const float wsv = wst[t]; const unsigned ps = cvt_pk_bf16(o0 * wsv, o1 * wsv);
                    *(LAS unsigned short*)(kt + c * 144 + t * 2) = (unsigned short)(ps & 0xffffu); *(LAS unsigned short*)(kt + (c + 1) * 144 + t * 2) = (unsigned short)(ps >> 16); }
            }
            if (cg >= 4) {
                __syncthreads();
                bf16* KMT = (bf16*)(ws + WS_KMT);
                for (int idx = tid; idx < 2048; idx += NTHR) {
                    const int ks = idx >> 10, dtl = (idx >> 6) & 15, ln = idx & 63, row = dtl * 16 + (ln & 15), ch = ks * 4 + (ln >> 4);
                    const u32x4 v = *(const LAS u32x4*)(kt + row * 144 + ch * 16);
                    *(u32x4*)(KMT + (size_t)(((b * 4 + cg - 4) * 32 + st) * 2) * 8192 + (size_t)idx * 8) = v; }
                if (tid < 256) {
                    float sm = 0.f;
#pragma unroll
                    for (int i = 0; i < 8; ++i) { const u32x4 v = *(const LAS u32x4*)(kt + tid * 144 + i * 16);
                        sm += (bflo(v.x) + bfhi(v.x)) + (bflo(v.y) + bfhi(v.y)) + (bflo(v.z) + bfhi(v.z)) + (bflo(v.w) + bfhi(v.w)); }
                    ((float*)(ws + MS_NST))[(size_t)((b * 4 + cg - 4) * 32 + st) * 256 + tid] = sm; }
            }
        } else if (u < 1280) {
            const int j = u - 1024, b = j >> 6, n = (j >> 3) & 7, h = j & 7;
            const bf16* KA = (const bf16*)(ws + WS_KA) + (size_t)(b * SEQ + n * 256 + wave * 32) * 1024 + h * 128 + 2 * lane;
            float s0 = 0.f, s1 = 0.f;
            unsigned xr[32];
#pragma unroll
            for (int r = 0; r < 32; ++r) xr[r] = *(const unsigned*)(KA + (size_t)r * 1024);
#pragma unroll
            for (int r = 0; r < 32; r += 8) asm volatile("" : "+v"(xr[r]), "+v"(xr[r + 1]), "+v"(xr[r + 2]), "+v"(xr[r + 3]), "+v"(xr[r + 4]), "+v"(xr[r + 5]), "+v"(xr[r + 6]), "+v"(xr[r + 7]));
#pragma unroll
            for (int r = 0; r < 32; ++r) { s0 += bflo(xr[r]); s1 += bfhi(xr[r]); }
            LAS float* part = (LAS float*)lds;
            part[wave * 128 + 2 * lane] = s0; part[wave * 128 + 2 * lane + 1] = s1;
            __syncthreads();
            if (tid < 128) { float t = 0.f;
#pragma unroll
                for (int w = 0; w < 8; ++w) t += part[w * 128 + tid];
                ((float*)(ws + MS_KMEAN))[(size_t)((b * 8 + h) * 8 + n) * 128 + tid] = t * (1.0f / 256.0f); }
        }
        __syncthreads();
    }
}

#undef CONV_LOAD
__device__ __forceinline__ void mlstm_ab_task(unsigned char* ws, int gw, int lane, const bool do_store = true) {
    const int bh = gw >> 7, piece = gw & 127, e0 = (piece >> 3) * 16, d0 = (piece & 7) * 32, q16 = lane & 15, g = lane >> 4;
    const bf16* ka = (const bf16*)(ws + WS_KMT) + (size_t)bh * 32 * 16384 + (size_t)(d0 >> 4) * 512 + lane * 8;
    const bf16* vb = (const bf16*)(ws + WS_VMT) + (size_t)bh * 32 * 16384 + (size_t)(e0 >> 4) * 512 + lane * 8;
    const float* DEC = (const float*)(ws + MS_DEC) + bh * 32;
    bf16* CST = (bf16*)(ws + WS_CST) + (size_t)bh * 32 * 65536 + (size_t)((d0 >> 5) * 16 + (e0 >> 4)) * 512 + (size_t)(((g >> 1) * 16 + q16) * 8 + 4 * (g & 1));
    f32x4 acc[2]; acc[0] = (f32x4){0.f, 0.f, 0.f, 0.f}; acc[1] = acc[0];
    const int decv = __builtin_bit_cast(int, DEC[lane & 31]);
    bf16x8 A0[2][2], B0[2], A1[2][2], B1[2], A2[2][2], B2[2], A3[2][2], B3[2], A4[2][2], B4[2];
#define AB_LOAD(c_, A_, B_) do { const int cc_ = (c_) < 31 ? (c_) : 31; _Pragma("unroll") for (int ks = 0; ks < 2; ++ks) { \
        A_[0][ks] = *(const bf16x8*)(ka + (size_t)cc_ * 16384 + ks * 8192); A_[1][ks] = *(const bf16x8*)(ka + (size_t)cc_ * 16384 + ks * 8192 + 512); B_[ks] = *(const bf16x8*)(vb + (size_t)cc_ * 16384 + ks * 8192); } } while (0)
#define AB_STEP(c_, A_, B_) do { \
        if (do_store) { _Pragma("unroll") for (int f = 0; f < 2; ++f) { u32x2 w; w.x = cvt_pk_bf16(acc[f][0], acc[f][1]); w.y = cvt_pk_bf16(acc[f][2], acc[f][3]); *(u32x2*)(CST + (size_t)(c_) * 65536 + 256 * f) = w; } } \
        const float dec = __builtin_bit_cast(float, __builtin_amdgcn_readlane(decv, (c_))); \
        acc[0] = acc[0] * dec; acc[1] = acc[1] * dec; \
        _Pragma("unroll") for (int ks = 0; ks < 2; ++ks) { \
            acc[0] = __builtin_amdgcn_mfma_f32_16x16x32_bf16(A_[0][ks], B_[ks], acc[0], 0, 0, 0); \
            acc[1] = __builtin_amdgcn_mfma_f32_16x16x32_bf16(A_[1][ks], B_[ks], acc[1], 0, 0, 0); } } while (0)
    AB_LOAD(0, A0, B0); AB_LOAD(1, A1, B1); AB_LOAD(2, A2, B2); AB_LOAD(3, A3, B3); AB_LOAD(4, A4, B4);
#pragma unroll 1
    for (int c = 0; c < 30; c += 5) {
        AB_STEP(c, A0, B0); AB_LOAD(c + 5, A0, B0);
        AB_STEP(c + 1, A1, B1); AB_LOAD(c + 6, A1, B1);
        AB_STEP(c + 2, A2, B2); AB_LOAD(c + 7, A2, B2);
        AB_STEP(c + 3, A3, B3); AB_LOAD(c + 8, A3, B3);
        AB_STEP(c + 4, A4, B4); AB_LOAD(c + 9, A4, B4);
    }
    AB_STEP(30, A0, B0); AB_STEP(31, A1, B1);
    if (!do_store) asm volatile("" :: "v"(acc[0]), "v"(acc[1]));
#undef AB_LOAD
#undef AB_STEP
}

__device__ __forceinline__ void nscan_task(unsigned char* ws, int t, int lane) {
    const int bh = t >> 2, d = (t & 3) * 64 + lane;
    const float* cs = (const float*)(ws + MS_NST) + (size_t)bh * 32 * 256 + d;
    float* nv = (float*)(ws + MS_NVEC) + (size_t)bh * 32 * 256 + d;
    const int decv = __builtin_bit_cast(int, ((const float*)(ws + MS_DEC))[bh * 32 + (lane & 31)]);
    float v[32];
#pragma unroll
    for (int j = 0; j < 32; ++j) v[j] = cs[j * 256];
    float n = 0.f;
#pragma unroll
    for (int j = 0; j < 32; ++j) { nv[j * 256] = n; n = __builtin_bit_cast(float, __builtin_amdgcn_readlane(decv, j)) * n + v[j]; }
}

__device__ __forceinline__ int rel_bucket_dev(int n) {
    if (n < 16) return n;
    int b = 16;
    b += (n >= 19); b += (n >= 21); b += (n >= 24); b += (n >= 27); b += (n >= 31); b += (n >= 35); b += (n >= 40); b += (n >= 46);
    b += (n >= 52); b += (n >= 59); b += (n >= 67); b += (n >= 77); b += (n >= 87); b += (n >= 99); b += (n >= 113);
    return b;
}
constexpr int AT_KT = 0, AT_VT = 34816, AT_TAB = 71680, AT_SEL = 72704, AT_TILES = 73216, AT_CTL = 73600, AT_KM = 73728;
__device__ __forceinline__ void attn_unit(ArgsP a, LAS unsigned char* lds, int uidx, int tid, int lane, int wave) {
    unsigned char* ws = a->ws;
    const int u256 = uidx & 255, second = uidx >> 8, bh = u256 >> 3, kk8 = u256 & 7, si = second ? 15 - kk8 : kk8, wgt = 16 - si;
    const int blk = (wgt - 1) >> 1, half = (wgt - 1) & 1, b = bh >> 3, h = bh & 7, q0 = blk * 256 + half * 128;
    const int q16 = lane & 15, g = lane >> 4;
    LAS float* tab = (LAS float*)(lds + AT_TAB); LAS unsigned* sels = (LAS unsigned*)(lds + AT_SEL); LAS int* tiles = (LAS int*)(lds + AT_TILES);
    LAS unsigned* ctl = (LAS unsigned*)(lds + AT_CTL); LAS float* kms = (LAS float*)(lds + AT_KM);
    const bf16* QA = (const bf16*)(ws + WS_QA); const bf16* KA = (const bf16*)(ws + WS_KA); const bf16* VAT = (const bf16*)(ws + WS_VAT);
    u32x4 sr[8], qst[4];
    const int row0 = tid >> 4, ch = tid & 15;
    const bf16* kbase = KA + (size_t)(b * SEQ + row0) * 1024 + h * 128 + ch * 8;
    const bf16* vbase = VAT + (size_t)(bh * 128 + row0) * 2048 + ch * 8;
#define AT_LOAD(ks0_) do { _Pragma("unroll") for (int i = 0; i < 4; ++i) { \
        sr[i] = *(const u32x4*)(kbase + (size_t)((ks0_) + 32 * i) * 1024); sr[4 + i] = *(const u32x4*)(vbase + (size_t)(32 * i) * 2048 + (ks0_)); } } while (0)
#pragma unroll
    for (int i = 0; i < 4; ++i) qst[i] = *(const u32x4*)(QA + (size_t)(b * SEQ + q0 + row0 + 32 * i) * 1024 + h * 128 + ch * 8);
    AT_LOAD(blk * 256);
    if (tid <= 128) tab[tid] = a->in[I_RELB][rel_bucket_dev(tid) * 8 + h] * 1.4426950408889634f;
    for (int idx = tid; idx < 1024; idx += NTHR) kms[idx] = ((const float*)(ws + MS_KMEAN))[bh * 1024 + idx];
    if (tid == 0) ctl[0] = 0u;
    __syncthreads();
    {
        const int q = tid >> 2, part = tid & 3;
        const bf16* qp = QA + (size_t)(b * SEQ + q0 + q) * 1024 + h * 128 + part * 32;
        float qf32[32];
#pragma unroll
        for (int i = 0; i < 4; ++i) { const u32x4 v = *(const u32x4*)(qp + 8 * i);
            qf32[8 * i + 0] = bflo(v.x); qf32[8 * i + 1] = bfhi(v.x); qf32[8 * i + 2] = bflo(v.y); qf32[8 * i + 3] = bfhi(v.y);
            qf32[8 * i + 4] = bflo(v.z); qf32[8 * i + 5] = bfhi(v.z); qf32[8 * i + 6] = bflo(v.w); qf32[8 * i + 7] = bfhi(v.w); }
        float gate[8];
#pragma unroll
        for (int n = 0; n < 8; ++n) { float s = 0.f;
            if (n < blk) {
#pragma unroll
                for (int d = 0; d < 32; d += 4) { const f32x4 kv = *(const LAS f32x4*)(kms + n * 128 + part * 32 + d);
                    s += (qf32[d] * kv.x + qf32[d + 1] * kv.y) + (qf32[d + 2] * kv.z + qf32[d + 3] * kv.w); }
            }
            s += __shfl_xor(s, 1); s += __shfl_xor(s, 2); gate[n] = s; }
        if (part == 0) {
            unsigned sel;
            if (blk <= 3) sel = (1u << blk) - 1u;
            else { sel = 0u;
#pragma unroll
                for (int it = 0; it < 3; ++it) { int best = 0; float bv = -3.0e38f;
#pragma unroll
                    for (int n = 0; n < 8; ++n) if (n < blk && !((sel >> n) & 1u) && gate[n] > bv) { bv = gate[n]; best = n; }
                    sel |= 1u << best; } }
            sels[q] = sel; atomicOr((unsigned*)ctl, sel);
        }
    }
    __syncthreads();
    if (tid == 0) { int nt = 0; const unsigned any = ctl[0];
        for (int j = 0; j < half + 1; ++j) tiles[nt++] = blk * 256 + 128 * j;
        for (int n = 0; n < blk; ++n) if ((any >> n) & 1u) for (int j = 0; j < 2; ++j) tiles[nt++] = n * 256 + 128 * j;
        ctl[1] = (unsigned)nt; }
    __syncthreads();
    const int ntiles = (int)ctl[1];
    const int qg = wave & 3, kp = wave >> 2;
    int qpos[2]; unsigned mysel[2];
#pragma unroll
    for (int f = 0; f < 2; ++f) { qpos[f] = q0 + 32 * qg + 16 * f + q16; mysel[f] = sels[32 * qg + 16 * f + q16]; }
    constexpr int AT_Q = 77824;
#pragma unroll
    for (int i = 0; i < 4; ++i) *(LAS u32x4*)(lds + AT_Q + (row0 + 32 * i) * 272 + ch * 16) = qst[i];
    const LAS unsigned char* qrow = lds + AT_Q + (32 * qg + q16) * 272 + 16 * g;
    float m_run[2] = {-1.0e30f, -1.0e30f}, l_run[2] = {0.f, 0.f};
    f32x4 oacc[2][8];
#pragma unroll
    for (int f = 0; f < 2; ++f)
#pragma unroll
        for (int m = 0; m < 8; ++m) oacc[f][m] = (f32x4){0.f, 0.f, 0.f, 0.f};
    const int vpos = (ch >> 2) * 32 + 16 * (ch & 1) + 4 * ((ch & 3) >> 1);
#define AT_WRITE() do { _Pragma("unroll") for (int i = 0; i < 4; ++i) { \
        *(LAS u32x4*)(lds + AT_KT + (row0 + 32 * i) * 272 + ch * 16) = sr[i]; \
        *(LAS u32x2*)(lds + AT_VT + (row0 + 32 * i) * 272 + vpos * 2) = (u32x2){sr[4 + i].x, sr[4 + i].y}; \
        *(LAS u32x2*)(lds + AT_VT + (row0 + 32 * i) * 272 + (vpos + 8) * 2) = (u32x2){sr[4 + i].z, sr[4 + i].w}; } } while (0)
    AT_WRITE();
    __syncthreads();
    if (ntiles > 1) { const int k1 = tiles[1]; AT_LOAD(k1); }
    for (int ti = 0; ti < ntiles; ++ti) {
        const int kstart = tiles[ti] + 64 * kp, nblk = kstart >> 8;
        const bool own = (nblk == blk);
        const bool any_ok = own ? true : (__any((((mysel[0] | mysel[1]) >> nblk) & 1u) != 0u) != 0);
        const bool active = own ? (kstart <= q0 + 32 * qg + 31) : any_ok;
        if (active) {
            const LAS unsigned char* kt = lds + AT_KT + 64 * kp * 272; const LAS unsigned char* vt = lds + AT_VT + 64 * kp * 2;
            f32x4 s[2][4];
#pragma unroll
            for (int n = 0; n < 4; ++n) { s[0][n] = (f32x4){0.f, 0.f, 0.f, 0.f}; s[1][n] = s[0][n]; }
#pragma unroll
            for (int ks = 0; ks < 4; ++ks) {
                bf16x8 q0f = *(const LAS bf16x8*)(qrow + 64 * ks), q1f = *(const LAS bf16x8*)(qrow + 16 * 272 + 64 * ks);
                bf16x8 kf[4];
#pragma unroll
                for (int n = 0; n < 4; ++n) kf[n] = *(const LAS bf16x8*)(kt + (16 * n + q16) * 272 + (32 * ks + 8 * g) * 2);
                asm volatile("" : "+v"(q0f), "+v"(q1f), "+v"(kf[0]), "+v"(kf[1]), "+v"(kf[2]), "+v"(kf[3]));
#pragma unroll
                for (int n = 0; n < 4; ++n) {
                    s[0][n] = __builtin_amdgcn_mfma_f32_16x16x32_bf16(kf[n], q0f, s[0][n], 0, 0, 0);
                    s[1][n] = __builtin_amdgcn_mfma_f32_16x16x32_bf16(kf[n], q1f, s[1][n], 0, 0, 0); } }
            const bool far = ((q0 + 32 * qg) - (kstart + 63)) >= 128;
            const float bfar = tab[128];
#pragma unroll
            for (int f = 0; f < 2; ++f) {
                const bool lane_ok = own ? true : (((mysel[f] >> nblk) & 1u) != 0u);
                float psum = 0.f, m_new;
#define AT_MNEW(mx_) fmaxf(((mx_) > m_run[f] + 8.0f) ? (mx_) : m_run[f], -1.0e29f)
                if (far) {
                    const float addc = lane_ok ? bfar : -1.0e30f;
                    float mx = -1.0e30f;
#pragma unroll
                    for (int n = 0; n < 4; ++n)
#pragma unroll
                        for (int r = 0; r < 4; ++r) mx = fmaxf(mx, s[f][n][r]);
                    mx = rows4_max(mx + addc);
                    m_new = AT_MNEW(mx);
                    const float cc = addc - m_new;
#pragma unroll
                    for (int n = 0; n < 4; ++n)
#pragma unroll
                        for (int r = 0; r < 4; ++r) { const float p = __builtin_amdgcn_exp2f(s[f][n][r] + cc); s[f][n][r] = p; psum += p; }
                } else {
                    const int kmax = lane_ok ? (own ? qpos[f] : 0x7fffffff) : -1;
                    float mx = -1.0e30f;
                    float bs[4][4];
#pragma unroll
                    for (int n = 0; n < 4; ++n)
#pragma unroll
                        for (int r = 0; r < 4; ++r) { int di = qpos[f] - (kstart + 16 * n + 4 * g + r); di = di < 0 ? 0 : di; di = di > 128 ? 128 : di; bs[n][r] = tab[di]; }
#pragma unroll
                    for (int n = 0; n < 4; ++n) asm volatile("" : "+v"(bs[n][0]), "+v"(bs[n][1]), "+v"(bs[n][2]), "+v"(bs[n][3]));
#pragma unroll
                    for (int n = 0; n < 4; ++n)
#pragma unroll
                        for (int r = 0; r < 4; ++r) { const int key = kstart + 16 * n + 4 * g + r;
                            const float v = (key <= kmax) ? s[f][n][r] + bs[n][r] : -1.0e30f;
                            s[f][n][r] = v; mx = fmaxf(mx, v); }
                    mx = rows4_max(mx);
                    m_new = AT_MNEW(mx);
#pragma unroll
                    for (int n = 0; n < 4; ++n)
#pragma unroll
                        for (int r = 0; r < 4; ++r) { const float p = __builtin_amdgcn_exp2f(s[f][n][r] - m_new); s[f][n][r] = p; psum += p; }
                }
#undef AT_MNEW
                const float alpha = __builtin_amdgcn_exp2f(m_run[f] - m_new);
                psum = rows4_sum(psum);
                l_run[f] = l_run[f] * alpha + psum;
                if (__any(m_new != m_run[f])) {
#pragma unroll
                    for (int m = 0; m < 8; ++m) oacc[f][m] = oacc[f][m] * alpha;
                }
                m_run[f] = m_new;
            }
#pragma unroll
            for (int k2 = 0; k2 < 2; ++k2) {
                bf16x8 pf[2];
#pragma unroll
                for (int f = 0; f < 2; ++f) { u32x4 pb; pb.x = cvt_pk_bf16(s[f][2 * k2][0], s[f][2 * k2][1]); pb.y = cvt_pk_bf16(s[f][2 * k2][2], s[f][2 * k2][3]);
                    pb.z = cvt_pk_bf16(s[f][2 * k2 + 1][0], s[f][2 * k2 + 1][1]); pb.w = cvt_pk_bf16(s[f][2 * k2 + 1][2], s[f][2 * k2 + 1][3]);
                    pf[f] = __builtin_bit_cast(bf16x8, pb); }
#pragma unroll
                for (int mh = 0; mh < 2; ++mh) {
                    bf16x8 af[4];
#pragma unroll
                    for (int m = 0; m < 4; ++m) af[m] = *(const LAS bf16x8*)(vt + (16 * (4 * mh + m) + q16) * 272 + (32 * k2 + 8 * g) * 2);
                    asm volatile("" : "+v"(af[0]), "+v"(af[1]), "+v"(af[2]), "+v"(af[3]));
#pragma unroll
                    for (int m = 0; m < 4; ++m) {
                        oacc[0][4 * mh + m] = __builtin_amdgcn_mfma_f32_16x16x32_bf16(af[m], pf[0], oacc[0][4 * mh + m], 0, 0, 0);
                        oacc[1][4 * mh + m] = __builtin_amdgcn_mfma_f32_16x16x32_bf16(af[m], pf[1], oacc[1][4 * mh + m], 0, 0, 0); } }
            }
        }
        __syncthreads();
        if (ti + 1 < ntiles) { AT_WRITE(); }
        __syncthreads();
        if (ti + 2 < ntiles) { const int kn = tiles[ti + 2]; AT_LOAD(kn); }
    }
    LAS float* mo = (LAS float*)lds; LAS float* ml = (LAS float*)(lds + 65536);
    if (kp == 1) {
#pragma unroll
        for (int f = 0; f < 2; ++f) {
#pragma unroll
            for (int m = 0; m < 8; ++m)
#pragma unroll
                for (int r = 0; r < 4; ++r) mo[((qg * 2 + f) * 8 + m) * 256 + r * 64 + lane] = oacc[f][m][r];
            ml[(qg * 2 + f) * 128 + lane] = m_run[f]; ml[(qg * 2 + f) * 128 + 64 + lane] = l_run[f]; }
    }
    __syncthreads();
    if (kp == 0) {
#pragma unroll
        for (int f = 0; f < 2; ++f) {
            const float m1 = ml[(qg * 2 + f) * 128 + lane], l1 = ml[(qg * 2 + f) * 128 + 64 + lane];
            const float mm = fmaxf(m_run[f], m1), a0 = __builtin_amdgcn_exp2f(m_run[f] - mm), a1 = __builtin_amdgcn_exp2f(m1 - mm);
            const float inv = __builtin_amdgcn_rcpf(l_run[f] * a0 + l1 * a1);
            bf16* HA = (bf16*)(ws + WS_HA) + (size_t)(b * SEQ + qpos[f]) * 1024 + h * 128 + 4 * g;
#pragma unroll
            for (int m = 0; m < 8; ++m) { float o[4];
#pragma unroll
                for (int r = 0; r < 4; ++r) o[r] = (oacc[f][m][r] * a0 + mo[((qg * 2 + f) * 8 + m) * 256 + r * 64 + lane] * a1) * inv;
                u32x2 w; w.x = cvt_pk_bf16(o[0], o[1]); w.y = cvt_pk_bf16(o[2], o[3]); *(u32x2*)(HA + 16 * m) = w; }
        }
    }
#undef AT_LOAD
#undef AT_WRITE
}

constexpr int MC_Q = 0, MC_K = 33792, MC_SP = 67584, MC_SC = 76800, MC_NV = 79104;
struct McRegs { u32x4 qr[4], kr[4]; float sc4[4]; float nv0; bf16x8 cb[8][2], vbf[2][2]; u32x2 ovv[8]; };
__device__ __forceinline__ void mc_load_qk(McRegs& R, const unsigned char* ws, int u, int tid) {
    const int bh = u >> 5, c = u & 31, b = bh >> 2, h = bh & 3; const size_t tok0 = (size_t)b * SEQ + 64 * c;
    const bf16* QM = (const bf16*)(ws + WS_QM); const bf16* KM = (const bf16*)(ws + WS_KM);
#pragma unroll
    for (int i = 0; i < 4; ++i) { const int idx = tid + NTHR * i, row = idx >> 5, ch = idx & 31;
        R.qr[i] = *(const u32x4*)(QM + (tok0 + row) * 1024 + h * 256 + ch * 8); R.kr[i] = *(const u32x4*)(KM + (tok0 + row) * 1024 + h * 256 + ch * 8); }
}
__device__ __forceinline__ void mc_load_sc(McRegs& R, const unsigned char* ws, int u, int tid) {
    const int bh = u >> 5, c = u & 31; const int s = bh * 2048 + 64 * c + (tid & 63);
    R.sc4[0] = ((const float*)(ws + MS_AS))[s]; R.sc4[1] = ((const float*)(ws + MS_GT))[s]; R.sc4[2] = ((const float*)(ws + MS_WI))[s]; R.sc4[3] = ((const float*)(ws + MS_CL))[s];
    R.nv0 = ((const float*)(ws + MS_NVEC))[(size_t)(bh * 32 + c) * 256 + (tid & 255)];
}
__device__ __forceinline__ void mc_load_cb(McRegs& R, const unsigned char* ws, int u, int lane, int wave) {
    const bf16* Cp = (const bf16*)(ws + WS_CST) + (size_t)u * 65536 + (size_t)(2 * wave) * 512 + lane * 8;
#pragma unroll
    for (int ks = 0; ks < 8; ++ks) { R.cb[ks][0] = *(const bf16x8*)(Cp + ks * 8192); R.cb[ks][1] = *(const bf16x8*)(Cp + ks * 8192 + 512); }
}
__device__ __forceinline__ void mc_load_v(McRegs& R, const unsigned char* ws, int u, int lane, int wave) {
    const bf16* Vp = (const bf16*)(ws + WS_VMT) + (size_t)u * 16384 + (size_t)(2 * wave) * 512 + lane * 8;
#pragma unroll
    for (int ks = 0; ks < 2; ++ks) { R.vbf[ks][0] = *(const bf16x8*)(Vp + ks * 8192); R.vbf[ks][1] = *(const bf16x8*)(Vp + ks * 8192 + 512); }
}
__device__ __forceinline__ void mc_load_ov(McRegs& R, const unsigned char* ws, int u, int lane, int wave) {
    const int bh = u >> 5, c = u & 31, b = bh >> 2, h = bh & 3; const size_t tok0 = (size_t)b * SEQ + 64 * c;
    const bf16* OM = (const bf16*)(ws + WS_OM);
#pragma unroll
    for (int i = 0; i < 8; ++i) R.ovv[i] = *(const u32x2*)(OM + (tok0 + 8 * wave + i) * 1024 + h * 256 + 4 * lane);
}
template <bool PF, bool HAVE>
__device__ __forceinline__ void mlstm_c_body(ArgsP a, int l, LAS unsigned char* lds, int u, int un, McRegs& R, int tid_, int lane_, int wave) {
    unsigned char* ws = a->ws;
    int tid = wave * 64 + lane_id(); asm volatile("" : "+v"(tid));
    const int lane = tid & 63; (void)tid_; (void)lane_;
    const int bh = u >> 5, c = u & 31, b = bh >> 2, h = bh & 3, t0 = 64 * c, q16 = lane & 15, g = lane >> 4;
    const size_t tok0 = (size_t)b * SEQ + t0;
    LAS unsigned char* Qs = lds + MC_Q; LAS unsigned char* Ks = lds + MC_K; LAS unsigned char* Sp = lds + MC_SP;
    LAS float* sc = (LAS float*)(lds + MC_SC); LAS float* as_ = sc; LAS float* gt_ = sc + 64; LAS float* wi_ = sc + 128; LAS float* cl_ = sc + 192; LAS float* qn_ = sc + 256; LAS float* denp = sc + 320;
    LAS float* nvec = (LAS float*)(lds + MC_NV);
    mc_load_qk(R, ws, u, tid); mc_load_sc(R, ws, u, tid);
    if (!HAVE) mc_load_cb(R, ws, u, lane, wave);
#pragma unroll
    for (int i = 0; i < 4; ++i) { const int idx = tid + NTHR * i, row = idx >> 5, ch = idx & 31;
        *(LAS u32x4*)(Qs + row * 528 + ch * 16) = R.qr[i]; *(LAS u32x4*)(Ks + row * 528 + ch * 16) = R.kr[i]; }
    mc_load_v(R, ws, u, lane, wave);
    if (tid < 64) { as_[tid] = R.sc4[0]; gt_[tid] = R.sc4[1]; wi_[tid] = R.sc4[2]; cl_[tid] = R.sc4[3]; }
    if (tid < 256) nvec[tid] = R.nv0;
    __syncthreads();
    f32x4 acc[4][2];
#pragma unroll
    for (int m = 0; m < 4; ++m) { acc[m][0] = (f32x4){0.f, 0.f, 0.f, 0.f}; acc[m][1] = acc[m][0]; }
    if (c > 0) {
#pragma unroll
        for (int ks = 0; ks < 8; ++ks) {
#pragma unroll
            for (int m = 0; m < 4; ++m) { const bf16x8 af = *(const LAS bf16x8*)(Qs + (16 * m + q16) * 528 + (32 * ks + 8 * g) * 2);
                acc[m][0] = __builtin_amdgcn_mfma_f32_16x16x32_bf16(af, R.cb[ks][0], acc[m][0], 0, 0, 0);
                acc[m][1] = __builtin_amdgcn_mfma_f32_16x16x32_bf16(af, R.cb[ks][1], acc[m][1], 0, 0, 0); }
        }
#pragma unroll
        for (int m = 0; m < 4; ++m)
#pragma unroll
            for (int r = 0; r < 4; ++r) { const float w = wi_[16 * m + 4 * g + r]; acc[m][0][r] *= w; acc[m][1][r] *= w; }
    }
    {
        const int mS = wave & 3, nS0 = 2 * (wave >> 2);
        f32x4 sacc[2]; sacc[0] = (f32x4){0.f, 0.f, 0.f, 0.f}; sacc[1] = sacc[0];
#pragma unroll
        for (int kh = 0; kh < 4; ++kh) {
            bf16x8 af[2], bq[2][2];
#pragma unroll
            for (int k2 = 0; k2 < 2; ++k2) { const int ks = 2 * kh + k2;
                af[k2] = *(const LAS bf16x8*)(Qs + (16 * mS + q16) * 528 + (32 * ks + 8 * g) * 2);
#pragma unroll
                for (int nn = 0; nn < 2; ++nn) bq[k2][nn] = *(const LAS bf16x8*)(Ks + (16 * (nS0 + nn) + q16) * 528 + (32 * ks + 8 * g) * 2); }
            asm volatile("" : "+v"(af[0]), "+v"(af[1]), "+v"(bq[0][0]), "+v"(bq[0][1]), "+v"(bq[1][0]), "+v"(bq[1][1]));
#pragma unroll
            for (int k2 = 0; k2 < 2; ++k2)
#pragma unroll
                for (int nn = 0; nn < 2; ++nn) sacc[nn] = __builtin_amdgcn_mfma_f32_16x16x32_bf16(af[k2], bq[k2][nn], sacc[nn], 0, 0, 0);
        }
#pragma unroll
        for (int nn = 0; nn < 2; ++nn) { const int s = 16 * (nS0 + nn) + q16; const float av = as_[s];
#pragma unroll
            for (int r = 0; r < 4; ++r) { const int t = 16 * mS + 4 * g + r;
                float val = (s <= t) ? sacc[nn][r] * __expf(av - gt_[t]) : 0.f;
                *(LAS unsigned short*)(Sp + t * 144 + s * 2) = (unsigned short)(cvt_pk_bf16(val, val) & 0xffffu);
                val += __shfl_xor(val, 1); val += __shfl_xor(val, 2); val += __shfl_xor(val, 4); val += __shfl_xor(val, 8);
                if (q16 == 0) denp[(nS0 + nn) * 64 + t] = val; } }
    }
    {
        const int t = tid >> 3, seg = tid & 7; float s = 0.f;
#pragma unroll
        for (int i = 0; i < 4; ++i) { const u32x4 v = *(const LAS u32x4*)(Qs + t * 528 + (seg * 32 + 8 * i) * 2); const LAS float* nv = nvec + seg * 32 + 8 * i;
            s += bflo(v.x) * nv[0] + bfhi(v.x) * nv[1] + bflo(v.y) * nv[2] + bfhi(v.y) * nv[3] + bflo(v.z) * nv[4] + bfhi(v.z) * nv[5] + bflo(v.w) * nv[6] + bfhi(v.w) * nv[7]; }
        s += __shfl_xor(s, 1); s += __shfl_xor(s, 2); s += __shfl_xor(s, 4);
        if (seg == 0) qn_[t] = s;
    }
    __syncthreads();
    if (PF) {
#pragma unroll
        for (int ks = 0; ks < 8; ++ks) asm volatile("" :: "v"(R.cb[ks][0]), "v"(R.cb[ks][1]));
        __builtin_amdgcn_sched_barrier(0);
        mc_load_cb(R, ws, un, lane, wave);
        __builtin_amdgcn_sched_barrier(0);
    }
    {
#pragma unroll
        for (int ks = 0; ks < 2; ++ks) {
            bf16x8 sf[4];
#pragma unroll
            for (int m = 0; m < 4; ++m) sf[m] = *(const LAS bf16x8*)(Sp + (16 * m + q16) * 144 + (32 * ks + 8 * g) * 2);
            asm volatile("" : "+v"(sf[0]), "+v"(sf[1]), "+v"(sf[2]), "+v"(sf[3]));
#pragma unroll
            for (int m = 0; m < 4; ++m) {
                acc[m][0] = __builtin_amdgcn_mfma_f32_16x16x32_bf16(sf[m], R.vbf[ks][0], acc[m][0], 0, 0, 0);
                acc[m][1] = __builtin_amdgcn_mfma_f32_16x16x32_bf16(sf[m], R.vbf[ks][1], acc[m][1], 0, 0, 0); }
        }
    }
    LAS float* NUM = (LAS float*)lds;
#pragma unroll
    for (int m = 0; m < 4; ++m)
#pragma unroll
        for (int r = 0; r < 4; ++r) { const int t = 16 * m + 4 * g + r;
            const float den = (denp[t] + denp[64 + t]) + (denp[128 + t] + denp[192 + t]) + wi_[t] * qn_[t];
            const float inv = __builtin_amdgcn_rcpf(fmaxf(fabsf(den), cl_[t]));
            NUM[t * 260 + 32 * wave + q16] = acc[m][0][r] * inv; NUM[t * 260 + 32 * wave + 16 + q16] = acc[m][1][r] * inv; }
    __syncthreads();
    {
        const float* mg = a->in[I_MNG] + l * 1024 + h * 256 + 4 * lane; const f32x4 gn = *(const f32x4*)mg;
        bf16* HM = (bf16*)(ws + WS_HM);
        mc_load_ov(R, ws, u, lane, wave);
        asm volatile("" : "+v"(R.ovv[0]), "+v"(R.ovv[1]), "+v"(R.ovv[2]), "+v"(R.ovv[3]), "+v"(R.ovv[4]), "+v"(R.ovv[5]), "+v"(R.ovv[6]), "+v"(R.ovv[7]));
#pragma unroll
        for (int i = 0; i < 8; ++i) { const int t = 8 * wave + i;
            const f32x4 v = *(const LAS f32x4*)(NUM + t * 260 + 4 * lane);
            const float mu = wave_sum((v.x + v.y) + (v.z + v.w)) * (1.0f / 256.0f);
            const f32x4 d = v - mu;
            const float var = wave_sum((d.x * d.x + d.y * d.y) + (d.z * d.z + d.w * d.w)) * (1.0f / 256.0f);
            const float rstd = __builtin_amdgcn_rsqf(var + LN_EPS);
            const u32x2 ov = R.ovv[i];
            u32x2 w; w.x = cvt_pk_bf16(d.x * rstd * gn.x * bflo(ov.x), d.y * rstd * gn.y * bfhi(ov.x)); w.y = cvt_pk_bf16(d.z * rstd * gn.z * bflo(ov.y), d.w * rstd * gn.w * bfhi(ov.y));
            *(u32x2*)(HM + (tok0 + t) * 1024 + h * 256 + 4 * lane) = w; }
    }
    __syncthreads();
}
__device__ __forceinline__ void mlstm_c_phase(ArgsP a, int l, LAS unsigned char* lds, int tid, int lane, int wave, int bid, int G) {
    int u = bid; if (u >= 512) return;
    McRegs R;
    if (u + G < 512 && u + 2 * G >= 512) {
        mlstm_c_body<true, false>(a, l, lds, u, u + G, R, tid, lane, wave);
        mlstm_c_body<false, true>(a, l, lds, u + G, u + G, R, tid, lane, wave);
    } else {
#pragma unroll 1
        for (; u < 512; u += G) mlstm_c_body<false, false>(a, l, lds, u, u, R, tid, lane, wave);
    }
}

struct SchedStd {
    static constexpr bool GATHER = false;
    const char* A; const char* B; int nM, nN, K, G, c;
    __device__ __forceinline__ bool next(int i, Unit& u) const { const int L = i * G + c; if (L >= nM * nN) return false; pg8::static_tile(L, nM, nN, u.pm, u.pn); u.aux = 0; return true; }
    __device__ __forceinline__ const char* abase(const Unit& u) const { return A + (size_t)u.pm * 512 * K; }
    __device__ __forceinline__ const char* bbase(const Unit& u) const { return B + (size_t)u.pn * 512 * K; }
    __device__ __forceinline__ unsigned arow(const Unit&, int) const { return 0u; }
    static __device__ __forceinline__ bool keep_acc(const Unit&) { return false; }
};
struct SchedBr {
    static constexpr bool GATHER = false;
    const char* HM; const char* HA; const char* WM; const char* WA; int G, c;
    __device__ __forceinline__ bool next(int i, Unit& u) const { const int L = (i >> 1) * G + c; if (L >= 256) return false; pg8::static_tile(L, 32, 8, u.pm, u.pn); u.aux = i & 1; return true; }
    __device__ __forceinline__ const char* abase(const Unit& u) const { return (u.aux ? HA : HM) + (size_t)u.pm * 512 * 1024; }
    __device__ __forceinline__ const char* bbase(const Unit& u) const { return (u.aux ? WA : WM) + (size_t)u.pn * 512 * 1024; }
    __device__ __forceinline__ unsigned arow(const Unit&, int) const { return 0u; }
    static __device__ __forceinline__ bool keep_acc(const Unit& u) { return u.aux == 0; }
};
struct EpiBr {
    static constexpr bool PERM = true;
    const bf16* SG; bf16* Y;
    __device__ __forceinline__ void operator()(f32x4 (&acc)[2][2][4][2], const Unit& u, int wr, int wc, int fr, int fq) const {
        const int row0 = u.pm * 256 + wr * 64 + fr, col0 = u.pn * 256 + wc * 32 + 8 * fq;
#pragma unroll
        for (int ai = 0; ai < 2; ++ai) {
            u32x4 sa[4][2], sm[4][2];
#pragma unroll
            for (int m = 0; m < 4; ++m) { const size_t row = row0 + ai * 128 + m * 16;
#pragma unroll
                for (int bj = 0; bj < 2; ++bj) { const int col = col0 + bj * 128;
                    sa[m][bj] = *(const u32x4*)(SG + row * 4096 + 2048 + col);
                    sm[m][bj] = *(const u32x4*)(SG + row * 4096 + (u.aux == 0 ? 0 : 2048) + col); } }
            asm volatile("" : "+v"(sa[0][0]), "+v"(sa[0][1]), "+v"(sa[1][0]), "+v"(sa[1][1]), "+v"(sa[2][0]), "+v"(sa[2][1]), "+v"(sa[3][0]), "+v"(sa[3][1]),
                              "+v"(sm[0][0]), "+v"(sm[0][1]), "+v"(sm[1][0]), "+v"(sm[1][1]), "+v"(sm[2][0]), "+v"(sm[2][1]), "+v"(sm[3][0]), "+v"(sm[3][1]));
#pragma unroll
            for (int m = 0; m < 4; ++m) { const size_t row = row0 + ai * 128 + m * 16;
#pragma unroll
                for (int bj = 0; bj < 2; ++bj) { const int col = col0 + bj * 128;
                    const u32x4 a4 = sa[m][bj], m4 = sm[m][bj];
                    const float ga[8] = {bflo(a4.x), bfhi(a4.x), bflo(a4.y), bfhi(a4.y), bflo(a4.z), bfhi(a4.z), bflo(a4.w), bfhi(a4.w)};
                    if (u.aux == 0) {
                        const float gm[8] = {bflo(m4.x), bfhi(m4.x), bflo(m4.y), bfhi(m4.y), bflo(m4.z), bfhi(m4.z), bflo(m4.w), bfhi(m4.w)};
#pragma unroll
                        for (int j = 0; j < 4; ++j) { acc[ai][bj][m][0][j] *= gm[j] * __builtin_amdgcn_rcpf(fmaxf(ga[j], 1.0e-30f)); acc[ai][bj][m][1][j] *= gm[4 + j] * __builtin_amdgcn_rcpf(fmaxf(ga[4 + j], 1.0e-30f)); }
                    } else {
                        const f32x4 v0 = acc[ai][bj][m][0], v1 = acc[ai][bj][m][1];
                        u32x4 w; w.x = cvt_pk_bf16(v0[0] * ga[0], v0[1] * ga[1]); w.y = cvt_pk_bf16(v0[2] * ga[2], v0[3] * ga[3]);
                        w.z = cvt_pk_bf16(v1[0] * ga[4], v1[1] * ga[5]); w.w = cvt_pk_bf16(v1[2] * ga[6], v1[3] * ga[7]);
                        *(u32x4*)(Y + row * 2048 + col) = w; }
                } }
        }
    }
};
struct EpiOut {
    static constexpr bool PERM = false;
    const float* res; float* out;
    __device__ __forceinline__ void operator()(f32x4 (&acc)[2][2][4][2], const Unit& u, int wr, int wc, int fr, int fq) const {
        const int row0 = u.pm * 256 + wr * 64 + fr, col0 = u.pn * 256 + wc * 32 + 4 * fq;
#pragma unroll
        for (int ai = 0; ai < 2; ++ai) {
            f32x4 rv[4][2][2];
#pragma unroll
            for (int m = 0; m < 4; ++m) { const size_t ro = (size_t)(row0 + ai * 128 + m * 16) * DM + col0;
#pragma unroll
                for (int bj = 0; bj < 2; ++bj)
#pragma unroll
                    for (int n = 0; n < 2; ++n) rv[m][bj][n] = *(const f32x4*)(res + ro + bj * 128 + n * 16); }
#pragma unroll
            for (int m = 0; m < 4; ++m) asm volatile("" : "+v"(rv[m][0][0]), "+v"(rv[m][0][1]), "+v"(rv[m][1][0]), "+v"(rv[m][1][1]));
#pragma unroll
            for (int m = 0; m < 4; ++m) { const size_t ro = (size_t)(row0 + ai * 128 + m * 16) * DM + col0;
#pragma unroll
                for (int bj = 0; bj < 2; ++bj)
#pragma unroll
                    for (int n = 0; n < 2; ++n) *(f32x4*)(out + ro + bj * 128 + n * 16) = rv[m][bj][n] + acc[ai][bj][m][n]; }
        }
    }
};
struct SchedMoe1 {
    static constexpr bool GATHER = true;
    const char* H; const char* W13; const int* LIST; const LAS int* te; const LAS int* tr0; const LAS int* cnt; int MT, G, c;
    __device__ __forceinline__ bool next(int i, Unit& u) const { const int L = i * G + c; if (L >= 2 * MT) return false; u.pm = L >> 1; u.pn = L & 1; u.aux = __builtin_amdgcn_readfirstlane(te[u.pm]); return true; }
    __device__ __forceinline__ const char* abase(const Unit&) const { return H; }
    __device__ __forceinline__ const char* bbase(const Unit& u) const { return W13 + ((size_t)u.aux * 512 + u.pn * 256) * 4096; }
    static __device__ __forceinline__ bool keep_acc(const Unit&) { return false; }
    __device__ __forceinline__ unsigned arow(const Unit& u, int r) const { const int rr = __builtin_amdgcn_readfirstlane(tr0[u.pm]) + r; return rr < __builtin_amdgcn_readfirstlane(cnt[u.aux]) ? (unsigned)LIST[u.aux * 8192 + rr] : 0u; }
};
struct EpiMoe1 {
    static constexpr bool PERM = true;
    bf16* HID; const float* PWL; const LAS int* tr0; const LAS int* cnt;
    __device__ __forceinline__ void operator()(f32x4 (&acc)[2][2][4][2], const Unit& u, int wr, int wc, int fr, int fq) const {
#pragma unroll
        for (int ai = 0; ai < 2; ++ai)
#pragma unroll
            for (int m = 0; m < 4; ++m) { const int r = ai * 128 + wr * 64 + m * 16 + fr;
                const float pw = 1.0f;
                float o[8];
#pragma unroll
                for (int n = 0; n < 2; ++n)
#pragma unroll
                    for (int j = 0; j < 4; ++j) { const float x1 = acc[ai][0][m][n][j], x3 = acc[ai][1][m][n][j]; o[4 * n + j] = x1 * sigmoidf_(x1) * x3 * pw; }
                u32x4 w; w.x = cvt_pk_bf16(o[0], o[1]); w.y = cvt_pk_bf16(o[2], o[3]); w.z = cvt_pk_bf16(o[4], o[5]); w.w = cvt_pk_bf16(o[6], o[7]);
                *(u32x4*)(HID + (size_t)(u.pm * 256 + r) * 256 + u.pn * 128 + wc * 32 + 8 * fq) = w; }
    }
};
struct SchedMoe2 {
    static constexpr bool GATHER = false;
    const char* HID; const char* W2; const LAS int* te; int MT, G, c;
    __device__ __forceinline__ bool next(int i, Unit& u) const { const int L = i * G + c; if (L >= 8 * MT) return false; u.pm = L >> 3; u.pn = L & 7; u.aux = __builtin_amdgcn_readfirstlane(te[u.pm]); return true; }
    __device__ __forceinline__ const char* abase(const Unit& u) const { return HID + (size_t)u.pm * 256 * 512; }
    __device__ __forceinline__ const char* bbase(const Unit& u) const { return W2 + ((size_t)u.aux * 2048 + u.pn * 256) * 512; }
    __device__ __forceinline__ unsigned arow(const Unit&, int) const { return 0u; }
    static __device__ __forceinline__ bool keep_acc(const Unit&) { return false; }
};
struct EpiMoe2 {
    static constexpr bool PERM = true;
    bf16* OP;
    __device__ __forceinline__ void operator()(f32x4 (&acc)[2][2][4][2], const Unit& u, int wr, int wc, int fr, int fq) const {
        const int row0 = u.pm * 256 + wr * 64 + fr, col0 = u.pn * 256 + wc * 32 + 8 * fq;
#pragma unroll
        for (int ai = 0; ai < 2; ++ai)
#pragma unroll
            for (int m = 0; m < 4; ++m) { bf16* rowp = OP + (size_t)(row0 + ai * 128 + m * 16) * DM + col0;
#pragma unroll
                for (int bj = 0; bj < 2; ++bj) { const f32x4 v0 = acc[ai][bj][m][0], v1 = acc[ai][bj][m][1];
                    u32x4 w; w.x = cvt_pk_bf16(v0[0], v0[1]); w.y = cvt_pk_bf16(v0[2], v0[3]); w.z = cvt_pk_bf16(v1[0], v1[1]); w.w = cvt_pk_bf16(v1[2], v1[3]);
                    *(u32x4*)(rowp + bj * 128) = w; } }
    }
};

constexpr int N_PHASES = 22;
__global__ void __launch_bounds__(NTHR, 2) fwd_kernel(Args a) {
    extern __shared__ __attribute__((aligned(16))) unsigned char lds_raw[];
    LAS unsigned char* lds0 = (LAS unsigned char*)lds_raw;
    const int tid0 = threadIdx.x, bid0 = blockIdx.x, G0 = gridDim.x;
    const int wave0 = __builtin_amdgcn_readfirstlane(tid0 >> 6);
#define PH_IDS() ArgsP ap = (ArgsP)__builtin_amdgcn_kernarg_segment_ptr(); asm volatile("" : "+s"(ap)); unsigned lb_ = 0u; asm volatile("" : "+s"(lb_)); LAS unsigned char* lds = lds0 + lb_; LAS unsigned char* misc = lds + MISC_OFF; (void)misc; unsigned char* ws = ap->ws; (void)ws; int bid = bid0, G = G0, wave = wave0; asm volatile("" : "+s"(bid), "+s"(G), "+s"(wave)); int tid = wave * 64 + lane_id(); asm volatile("" : "+v"(tid)); const int lane = tid & 63; (void)lane; (void)wave
    if (tid0 < 4) ((LAS unsigned*)(lds0 + MISC_OFF + MO_BAR))[tid0] = 0u;
    __syncthreads();
#if MK_LAUNCHES == 1
    XcdBarrier bar = xcd_barrier_post((unsigned*)(a.ws + WS_CTL) + CW_BAR, (volatile LAS unsigned*)(lds0 + MISC_OFF + MO_BAR));
#define GRID_BAR() xcd_barrier(bar)
#else
#define GRID_BAR() do { } while (0)
#endif
    const int lo = a.ph_lo, hi = a.ph_hi;
#ifndef PHMASK
#define PHMASK 0xFFFu
#endif
#define IN(k) (lo <= (k) && (k) < hi)
#define EN(b) ((PHMASK >> (b)) & 1u)
#ifndef DBLMASK
#define DBLMASK 0u
#endif
#define REP(b) _Pragma("unroll 1") for (int rep_ = 0; rep_ < (((DBLMASK >> (b)) & 1u) ? 2 : 1); ++rep_)
#define SEAM(k) do { if (IN(k) && IN((k) + 1)) { GRID_BAR(); if ((DBLMASK >> 12) & 1u) GRID_BAR(); } } while (0)

    if (EN(0) && IN(0)) { REP(0) { PH_IDS(); prologue_phase(ap, lds, tid, lane, wave, bid, G); __syncthreads(); }
#ifndef NO_NORM0
        { PH_IDS(); norm_phase<0>(ap, 0, lds, tid, lane, wave, bid, G); }
#endif
    }
    SEAM(0);
#pragma unroll 1
    for (int l = 0; l < 2; ++l) {
        const int pb = 1 + 10 * l;
        if (EN(1) && IN(pb + 0) && l == 1) { if ((DBLMASK >> 18) & 1u) { PH_IDS(); norm_phase<1>(ap, l, lds, tid, lane, wave, bid, G, true); } PH_IDS(); norm_phase<1>(ap, l, lds, tid, lane, wave, bid, G); }
        if (l == 1) SEAM(pb + 0);
        if (EN(2) && IN(pb + 1)) REP(2) { PH_IDS(); (void)tid;
#ifdef STAG
            for (int i = 0; i < ((bid >> 3) & 7); ++i) __builtin_amdgcn_s_sleep(STAG);
#endif
            SchedG1 S{(const char*)(ws + WS_H), (const char*)(ws + WS_WINT) + (size_t)l * 11264 * 4096, G, bid};
            EpiG1 E{ws, ((DBLMASK >> 21) & 1u) && rep_ == 1};
            pg8::gemm_phase<EpiG1, SchedG1>(lds, 2048, S, E, wave);
            for (int bh = G - 1 - bid; bh < 16; bh += G) gate_unit(ap, l, lds, bh, tid, tid & 63, wave);
            __syncthreads();
            if (G == 256 && bid >= 256 - SchedG1::NCV) prologue_phase(ap, lds, tid, tid & 63, wave, bid - (256 - SchedG1::NCV), SchedG1::NCV, 2 + l);
            else if (G != 256) prologue_phase(ap, lds, tid, tid & 63, wave, bid, G, 2 + l);
        }
        SEAM(pb + 1);
        if (EN(3) && IN(pb + 2)) REP(3) { PH_IDS(); conv_phase(ap, l, lds, tid, lane, wave, bid, G); }
        SEAM(pb + 2);
        if (EN(4) && IN(pb + 3)) REP(4) { PH_IDS();
            const int vb = (G % 8 == 0) ? (bid & 7) * (G >> 3) + (bid >> 3) : bid;
            REP(13) { for (int gw = vb * NWAVES + wave; gw < 2048; gw += G * NWAVES) mlstm_ab_task(ws, gw, lane, rep_ == 0 || !((DBLMASK >> 15) & 1u)); }
            if (wave == 0 && vb < 64) nscan_task(ws, vb, lane);
            __syncthreads();
            REP(14) { for (int u = vb; u < 512; u += G) { attn_unit(ap, lds, u, tid, lane, wave); __syncthreads(); if (((DBLMASK >> 16) & 1u) && u < 256) GRID_BAR(); } }
        }
        SEAM(pb + 3);
        if (EN(5) && IN(pb + 4)) REP(5) { PH_IDS(); mlstm_c_phase(ap, l, lds, tid, lane, wave, bid, G); }
        SEAM(pb + 4);
        if (EN(6) && IN(pb + 5)) REP(6) { PH_IDS(); (void)tid;
            SchedBr S{(const char*)(ws + WS_HM), (const char*)(ws + WS_HA), (const char*)(ws + WS_WBM) + (size_t)l * 2048 * 2048, (const char*)(ws + WS_WBA) + (size_t)l * 2048 * 2048, G, bid};
            EpiBr E{(const bf16*)(ws + WS_SG), (bf16*)(ws + WS_Y)};
            pg8::gemm_phase<EpiBr, SchedBr>(lds, 1024, S, E, wave);
        }
        SEAM(pb + 5);
        if (EN(7) && IN(pb + 6)) _Pragma("unroll 1") for (int rep_ = 0; rep_ < ((((DBLMASK >> 7) & 1u) && l == 0) ? 2 : 1); ++rep_) { PH_IDS(); (void)tid;
            SchedStd S{(const char*)(ws + WS_Y), (const char*)(ws + WS_WOUT) + (size_t)l * 2048 * 4096, 32, 8, 2048, G, bid};
            EpiOut E{l == 0 ? ap->in[I_X] : (const float*)ap->out, ap->out};
            pg8::gemm_phase<EpiOut, SchedStd>(lds, 2048, S, E, wave);
        }
        SEAM(pb + 6);
        if (EN(8) && IN(pb + 7)) { if ((DBLMASK >> 19) & 1u) { PH_IDS(); norm_phase<2>(ap, l, lds, tid, lane, wave, bid, G, true); } PH_IDS(); norm_phase<2>(ap, l, lds, tid, lane, wave, bid, G); }
        SEAM(pb + 7);
        if (EN(9) && IN(pb + 8)) REP(9) { PH_IDS();
            moe_tables(ws, l, misc, tid);
            SchedMoe1 S{(const char*)(ws + WS_H), (const char*)(ws + WS_W13) + (size_t)l * 32 * 512 * 4096, (const int*)(ws + MS_LIST),
                        (const LAS int*)(misc + MO_TE), (const LAS int*)(misc + MO_TR0), (const LAS int*)(misc + MO_CNT), __builtin_amdgcn_readfirstlane(((const LAS int*)(misc + MO_MT))[0]), G, bid};
            EpiMoe1 E{(bf16*)(ws + WS_HID), (const float*)(ws + MS_PWL), (const LAS int*)(misc + MO_TR0), (const LAS int*)(misc + MO_CNT)};
            pg8::gemm_phase<EpiMoe1, SchedMoe1>(lds, 2048, S, E, wave);
            if (bid >= 2 * S.MT) prologue_phase(ap, lds, tid, tid & 63, wave, bid - 2 * S.MT, G - 2 * S.MT, l == 0 ? 1 : 4);
        }
        SEAM(pb + 8);
        if (EN(10) && IN(pb + 9)) REP(10) { PH_IDS();
            moe_tables(ws, l, misc, tid);
#ifdef STAG
            for (int i = 0; i < ((bid >> 3) & 7); ++i) __builtin_amdgcn_s_sleep(STAG);
#endif
            SchedMoe2 S{(const char*)(ws + WS_HID), (const char*)(ws + WS_W2) + (size_t)l * 32 * 2048 * 512, (const LAS int*)(misc + MO_TE), __builtin_amdgcn_readfirstlane(((const LAS int*)(misc + MO_MT))[0]), G, bid};
            EpiMoe2 E{(bf16*)(ws + WS_OP)};
            pg8::gemm_phase<EpiMoe2, SchedMoe2>(lds, 256, S, E, wave);
        }
        SEAM(pb + 9);
    }
    if (EN(11) && IN(21)) { if ((DBLMASK >> 20) & 1u) { PH_IDS(); norm_phase<3>(ap, 1, lds, tid, lane, wave, bid, G, true); } PH_IDS(); norm_phase<3>(ap, 1, lds, tid, lane, wave, bid, G); }
#undef IN
#undef SEAM
}

extern "C" void kernel_launch(void* const* d_in, const int* in_sizes, int n_in, void* d_out, int out_size, void* d_ws, size_t ws_size, hipStream_t stream) {
    static int grid = 0;
    if (grid == 0) {
        if (n_in != 19 || out_size != NTOK * DM || ws_size < WS_END) { fprintf(stderr, "kernel_launch: unexpected shapes (n_in %d out %d ws %zu)\n", n_in, out_size, ws_size); grid = -1; return; }
        int dev = 0, cus = 0, per_cu = 0;
        if (hipGetDevice(&dev) != hipSuccess || hipDeviceGetAttribute(&cus, hipDeviceAttributeMultiprocessorCount, dev) != hipSuccess) { grid = -1; return; }
        if (hipFuncSetAttribute((const void*)fwd_kernel, hipFuncAttributeMaxDynamicSharedMemorySize, LDS_BYTES) != hipSuccess) { fprintf(stderr, "kernel_launch: hipFuncSetAttribute failed\n"); grid = -1; return; }
        if (hipOccupancyMaxActiveBlocksPerMultiprocessor(&per_cu, (const void*)fwd_kernel, NTHR, LDS_BYTES) != hipSuccess || per_cu < 1) { fprintf(stderr, "kernel_launch: occupancy query says %d\n", per_cu); }
        (void)hipGetLastError();
        grid = cus;
        if (grid > 256) grid = 256;
    }
    if (grid < 0) return;
    if (hipMemsetAsync((char*)d_ws + WS_CTL, 0, CTL_ZERO_BYTES, stream) != hipSuccess) return;
    Args a{};
    for (int i = 0; i < 19; ++i) a.in[i] = (const float*)d_in[i];
    a.out = (float*)d_out; a.ws = (unsigned char*)d_ws;
#if MK_LAUNCHES == 1
    a.ph_lo = 0; a.ph_hi = N_PHASES;
    hipLaunchKernelGGL(fwd_kernel, dim3(grid), dim3(NTHR), LDS_BYTES, stream, a);
#else
    for (int p = 0; p < N_PHASES; ++p) { a.ph_lo = p; a.ph_hi = p + 1; hipLaunchKernelGGL(fwd_kernel, dim3(grid), dim3(NTHR), LDS_BYTES, stream, a); }
#endif
}
```

```cpp
#define DBLMASK 0u
#include <hip/hip_runtime.h>
#include <stdint.h>
#include <stdio.h>

#ifndef MK_LAUNCHES
#define MK_LAUNCHES 1
#endif

#define GAS __attribute__((address_space(1)))
#define LAS __attribute__((address_space(3)))
typedef unsigned short bf16;
typedef short bf16x8 __attribute__((ext_vector_type(8)));
typedef short bf16x4 __attribute__((ext_vector_type(4)));
typedef float f32x4 __attribute__((ext_vector_type(4)));
typedef unsigned u32x4 __attribute__((ext_vector_type(4)));
typedef unsigned u32x2 __attribute__((ext_vector_type(2)));

constexpr int NTOK = 8192, DM = 2048, SEQ = 2048, NBATCH = 4;
constexpr int INCOLS = 11272;
constexpr int NWAVES = 8, NTHR = 512;
constexpr float RMS_EPS = 1e-6f, LN_EPS = 1e-5f;
constexpr int MPAD = 24576;

constexpr size_t MiB = 1u << 20;
constexpr size_t WS_CTL = 0, CTL_ZERO_BYTES = 1 * MiB;
constexpr size_t WS_MISC = 1 * MiB;
constexpr size_t MS_WIF = WS_MISC + 0;
constexpr size_t MS_WRT = WS_MISC + 256 * 1024;
constexpr size_t MS_IFG = WS_MISC + 1 * MiB;
constexpr size_t MS_KMEAN = MS_IFG + 256 * 1024;
constexpr size_t MS_AS = WS_MISC + 1536 * 1024;
constexpr size_t MS_GT = MS_AS + 128 * 1024;
constexpr size_t MS_WI = MS_GT + 128 * 1024;
constexpr size_t MS_CL = MS_WI + 128 * 1024;
constexpr size_t MS_WS = MS_CL + 128 * 1024;
constexpr size_t MS_DEC = MS_WS + 128 * 1024;
constexpr size_t MS_NST = WS_MISC + 2560 * 1024;
constexpr size_t MS_TOKE = WS_MISC + 3 * MiB;
constexpr size_t MS_TOKP = MS_TOKE + 64 * 1024;
constexpr size_t MS_TOKW = MS_TOKE + 128 * 1024;
constexpr size_t MS_LIST = WS_MISC + 4 * MiB;
constexpr size_t MS_PWL = WS_MISC + 5 * MiB;
constexpr size_t MS_NVEC = WS_MISC + 6 * MiB;
constexpr size_t WS_WINT = 16 * MiB;
constexpr size_t WS_WBM = 104 * MiB;
constexpr size_t WS_WBA = 112 * MiB;
constexpr size_t WS_WOUT = 120 * MiB;
constexpr size_t WS_W13 = 136 * MiB;
constexpr size_t WS_W2 = 264 * MiB;
constexpr size_t WS_H = 328 * MiB;
constexpr size_t WS_R = 360 * MiB;
constexpr size_t WS_ZQK = WS_R;
constexpr size_t WS_HM = WS_R, WS_HA = WS_R + 16 * MiB;
constexpr size_t WS_VMT = WS_R + 32 * MiB;
constexpr size_t WS_OM = WS_R + 48 * MiB;
constexpr size_t WS_QA = WS_R + 64 * MiB, WS_KA = WS_R + 80 * MiB;
constexpr size_t WS_Y = WS_QA;
constexpr size_t WS_VAT = WS_R + 96 * MiB;
constexpr size_t WS_SG = WS_R + 112 * MiB;
constexpr size_t WS_QM = WS_R + 176 * MiB, WS_KM = WS_R + 192 * MiB, WS_KMT = WS_R + 208 * MiB;
constexpr size_t WS_CST = WS_R + 224 * MiB;
constexpr size_t WS_HID = WS_R;
constexpr size_t WS_OP = WS_R + 16 * MiB;
constexpr size_t WS_END = 648 * MiB;
constexpr int CW_BAR = 4096;
constexpr int CW_CNT = 8192;

constexpr int RING_BYTES = 131072;
constexpr int MISC_OFF = 139264;
constexpr int LDS_BYTES = 147456;
constexpr int MO_BAR = 0, MO_CNT = 64, MO_NT = 64 + 128, MO_OFF = 64 + 256, MO_TE = 64 + 512, MO_TR0 = 64 + 1024, MO_MT = 64 + 1536, MO_LOG = 2048;

#define LDS_WAIT() asm volatile("s_waitcnt lgkmcnt(0)" ::: "memory")
#define VM_WAIT() asm volatile("s_waitcnt vmcnt(0)" ::: "memory")

__device__ __forceinline__ float bf2f(unsigned short b) { return __builtin_bit_cast(float, (unsigned)b << 16); }
__device__ __forceinline__ float bflo(unsigned u) { return __builtin_bit_cast(float, u << 16); }
__device__ __forceinline__ float bfhi(unsigned u) { return __builtin_bit_cast(float, u & 0xffff0000u); }
typedef __bf16 bf16x2v __attribute__((ext_vector_type(2)));
typedef float f32x2v __attribute__((ext_vector_type(2)));
typedef float f32x2 __attribute__((ext_vector_type(2)));
__device__ __forceinline__ unsigned cvt_pk_bf16(float lo, float hi) { const f32x2v f = {lo, hi}; const bf16x2v b = __builtin_convertvector(f, bf16x2v); return __builtin_bit_cast(unsigned, b); }
__device__ __forceinline__ float wave_sum(float v) {
#pragma unroll
    for (int o = 1; o < 64; o <<= 1) v += __shfl_xor(v, o);
    return v;
}
__device__ __forceinline__ float rows4_max(float x) { x = fmaxf(x, __shfl_xor(x, 16)); return fmaxf(x, __shfl_xor(x, 32)); }
__device__ __forceinline__ float rows4_sum(float x) { x += __shfl_xor(x, 16); return x + __shfl_xor(x, 32); }
__device__ __forceinline__ int lane_id() { int l; asm volatile("v_mbcnt_lo_u32_b32 %0, -1, 0\n\tv_mbcnt_hi_u32_b32 %0, -1, %0" : "=v"(l)); return l; }
__device__ __forceinline__ float sigmoidf_(float x) { return __builtin_amdgcn_rcpf(1.f + __expf(-x)); }

namespace pg8 {
constexpr int BM = 256, BK = 64, HALF = 128, HTB = HALF * BK * 2, STAGE_BYTES = 8 * HTB, NXCD = 8, WGM = 8;
__device__ __forceinline__ int lds_byte(int r, int c) { const int st = (r >> 4) * 2 + (c >> 5), rr = r & 15, cc = c & 31, ob = rr * 64 + cc * 2; return st * 1024 + (ob ^ (((ob >> 9) & 1) << 5)); }
__device__ __forceinline__ void stage_rc(int b, int& R, int& C) { const int st = b / 1024, sb = b % 1024, swz = sb ^ (((sb >> 9) & 1) << 5); R = (st >> 1) * 16 + swz / 64; C = (st & 1) * 32 + (swz % 64) / 2; }
__device__ __forceinline__ int perm32(int rho) { const int n = rho >> 4, i = rho & 15; return 8 * (i >> 2) + 4 * n + (i & 3); }
struct Unit { int pm, pn, aux; };

__device__ __forceinline__ void static_tile(int L, int nM, int nN, int& pm, int& pn) {
    const int nwg = nM * nN; int wgid = L;
    { const int q = nwg / NXCD, r = nwg % NXCD, xcd = wgid % NXCD, off = wgid / NXCD; wgid = (xcd < r ? xcd * (q + 1) : r * (q + 1) + (xcd - r) * q) + off; }
    const int nig = WGM * nN, gid = wgid / nig, fm = gid * WGM, gsz = (nM - fm) < WGM ? (nM - fm) : WGM;
    pm = fm + ((wgid % nig) % gsz); pn = (wgid % nig) / gsz;
}

template <class Epi, class Sched>
__device__ __forceinline__ void gemm_phase(LAS unsigned char* lds, const int K, const Sched& S, const Epi& E, const int wave0) {
    int tid_ = wave0 * 64 + lane_id(); asm volatile("" : "+v"(tid_));
    const int tid = tid_, wid = __builtin_amdgcn_readfirstlane(tid >> 6), lane = tid & 63, wr = wid >> 2, wc = wid & 3, fr = lane & 15, fq = lane >> 4;
    const int nt = K / BK;
    int RA[2], CA[2]; unsigned voffB[2];
#pragma unroll
    for (int i = 0; i < 2; ++i) { int R, C; stage_rc(tid * 16 + i * 8192, R, C); const int Rb = Epi::PERM ? ((R & ~31) + perm32(R & 31)) : R;
        RA[i] = R; CA[i] = C; voffB[i] = (unsigned)(Rb * K + C) * 2u; }
    const size_t kstep = (size_t)(BK * 2);
    const size_t hstep = (size_t)HALF * K * 2;
    const unsigned ldsw = (unsigned)wid * 1024u;
    const int aoff = lds_byte(wr * 64 + fr, fq * 8), boff = lds_byte(wc * 32 + fr, fq * 8);
#define PG8_SA(b, h) (((b) * 2 + (h)) * HTB)
#define PG8_SB(b, h) ((4 + (b) * 2 + (h)) * HTB)
#define PG8_STAGE(bufoff, gbase, v0, v1) do { \
        __builtin_amdgcn_global_load_lds((const unsigned*)((const char*)(gbase) + (v0)), (LAS unsigned*)(lds + (bufoff) + ldsw), 16, 0, 0); \
        __builtin_amdgcn_global_load_lds((const unsigned*)((const char*)(gbase) + (v1)), (LAS unsigned*)(lds + (bufoff) + ldsw + 8192), 16, 0, 0); } while (0)
#define PG8_STAGE_B(bufoff, gbase) PG8_STAGE(bufoff, gbase, voffB[0], voffB[1])
#define PG8_STAGE_A(bufoff, gbase, VO, h) PG8_STAGE(bufoff, gbase, VO[h][0], VO[h][1])
#define PG8_STAGE_A2(bufoff, gbase, h) do { if (Sched::GATHER && last) { PG8_STAGE_A(bufoff, gbase, vn, h); } else { PG8_STAGE_A(bufoff, gbase, vc, h); } } while (0)
#define PG8_LDA(dst, b, h) do { _Pragma("unroll") for (int m = 0; m < 4; ++m) _Pragma("unroll") for (int k = 0; k < 2; ++k) dst[m][k] = *(const LAS bf16x8*)(lds + PG8_SA(b, h) + aoff + m * 2048 + k * 1024); } while (0)
#define PG8_LDB(dst, b, h) do { _Pragma("unroll") for (int n = 0; n < 2; ++n) _Pragma("unroll") for (int k = 0; k < 2; ++k) dst[n][k] = *(const LAS bf16x8*)(lds + PG8_SB(b, h) + boff + n * 2048 + k * 1024); } while (0)
#define PG8_MMA(ai, bj, At, Bt) do { __builtin_amdgcn_s_setprio(1); _Pragma("unroll") for (int m = 0; m < 4; ++m) _Pragma("unroll") for (int n = 0; n < 2; ++n) _Pragma("unroll") for (int k = 0; k < 2; ++k) \
        acc[ai][bj][m][n] = __builtin_amdgcn_mfma_f32_16x16x32_bf16(Bt[n][k], At[m][k], acc[ai][bj][m][n], 0, 0, 0); __builtin_amdgcn_s_setprio(0); } while (0)
#define PG8_WAIT_V(n) asm volatile("s_waitcnt vmcnt(" #n ")" ::: "memory")
#define PG8_WAIT_L(n) asm volatile("s_waitcnt lgkmcnt(" #n ")" ::: "memory")
#define PG8_BAR __builtin_amdgcn_s_barrier()
#define PG8_SCHED __builtin_amdgcn_sched_barrier(0)
    Unit cur, nxt; int ui = 0;
    if (!S.next(0, cur)) return;
    f32x4 acc[2][2][4][2];
#pragma unroll
    for (int a = 0; a < 2; ++a)
#pragma unroll
        for (int b = 0; b < 2; ++b)
#pragma unroll
            for (int m = 0; m < 4; ++m)
#pragma unroll
                for (int n = 0; n < 2; ++n) acc[a][b][m][n] = (f32x4){0.f, 0.f, 0.f, 0.f};
    bf16x8 At[4][2], B0[2][2], B1[2][2];
    unsigned vc[2][2], vn[2][2];
#pragma unroll
    for (int h = 0; h < 2; ++h)
#pragma unroll
        for (int i = 0; i < 2; ++i) {
            if constexpr (Sched::GATHER) vc[h][i] = (unsigned)(S.arow(cur, h * HALF + RA[i]) * (unsigned)K + (unsigned)CA[i]) * 2u;
            else vc[h][i] = (unsigned)((h * HALF + RA[i]) * K + CA[i]) * 2u;
            vn[h][i] = vc[h][i];
        }
    const char* cA = S.abase(cur); const char* cB = S.bbase(cur);
    PG8_STAGE_B(PG8_SB(0, 0), cB); PG8_STAGE_A(PG8_SA(0, 0), cA, vc, 0); PG8_STAGE_B(PG8_SB(0, 1), cB + hstep); PG8_STAGE_A(PG8_SA(0, 1), cA, vc, 1);
    if (wr == 1) PG8_BAR;
    PG8_WAIT_V(4); PG8_BAR;
    PG8_STAGE_B(PG8_SB(1, 0), cB + kstep); PG8_STAGE_A(PG8_SA(1, 0), cA + kstep, vc, 0); PG8_STAGE_B(PG8_SB(1, 1), cB + hstep + kstep);
    PG8_WAIT_V(6); PG8_BAR;
    for (;;) {
        const bool has_next = S.next(ui + 1, nxt);
        const char* nA = has_next ? S.abase(nxt) : cA; const char* nB = has_next ? S.bbase(nxt) : cB;
        if constexpr (Sched::GATHER) {
            if (has_next) {
                int t2 = wave0 * 64 + lane_id(); asm volatile("" : "+v"(t2));
#pragma unroll
                for (int i = 0; i < 2; ++i) { int R, C; stage_rc(t2 * 16 + i * 8192, R, C);
#pragma unroll
                    for (int h = 0; h < 2; ++h) vn[h][i] = (unsigned)(S.arow(nxt, h * HALF + R) * (unsigned)K + (unsigned)C) * 2u; }
            }
        }
#pragma unroll 1
        for (int t = 0; t < nt; t += 2) {
            const bool last = (t == nt - 2);
            const char* a1 = cA + (size_t)(t + 1) * kstep;
            const char* a2 = last ? nA : cA + (size_t)(t + 2) * kstep; const char* b2 = last ? nB : cB + (size_t)(t + 2) * kstep;
            const char* a3 = a2 + kstep; const char* b3 = b2 + kstep;
            PG8_LDB(B0, 0, 0); PG8_SCHED; PG8_LDA(At, 0, 0); PG8_STAGE_A(PG8_SA(1, 1), a1, vc, 1);
            PG8_WAIT_L(8); PG8_BAR; PG8_WAIT_L(0); PG8_MMA(0, 0, At, B0); PG8_BAR; PG8_SCHED;
            PG8_LDB(B1, 0, 1); PG8_STAGE_B(PG8_SB(0, 0), b2);
            PG8_BAR; PG8_WAIT_L(0); PG8_MMA(0, 1, At, B1); PG8_BAR;
            PG8_LDA(At, 0, 1); PG8_STAGE_A2(PG8_SA(0, 0), a2, 0);
            PG8_BAR; PG8_WAIT_L(0); PG8_MMA(1, 0, At, B0); PG8_BAR; PG8_SCHED;
            PG8_STAGE_B(PG8_SB(0, 1), b2 + hstep);
            PG8_WAIT_V(6); PG8_BAR; PG8_MMA(1, 1, At, B1); PG8_BAR;
            PG8_LDB(B0, 1, 0); PG8_SCHED; PG8_LDA(At, 1, 0); PG8_STAGE_A2(PG8_SA(0, 1), a2, 1);
            PG8_WAIT_L(8); PG8_BAR; PG8_WAIT_L(0); PG8_MMA(0, 0, At, B0); PG8_BAR; PG8_SCHED;
            PG8_LDB(B1, 1, 1); PG8_STAGE_B(PG8_SB(1, 0), b3);
            PG8_BAR; PG8_WAIT_L(0); PG8_MMA(0, 1, At, B1); PG8_BAR;
            PG8_LDA(At, 1, 1); PG8_STAGE_A2(PG8_SA(1, 0), a3, 0);
            PG8_BAR; PG8_WAIT_L(0); PG8_MMA(1, 0, At, B0); PG8_BAR; PG8_SCHED;
            PG8_STAGE_B(PG8_SB(1, 1), b3 + hstep);
            PG8_WAIT_V(6); PG8_BAR; PG8_MMA(1, 1, At, B1); PG8_BAR;
        }
        { const int lz = lane_id(); E(acc, cur, wr, wc, lz & 15, lz >> 4); }
        if (!has_next) break;
        if (!Sched::keep_acc(cur)) {
#pragma unroll
        for (int a = 0; a < 2; ++a)
#pragma unroll
            for (int b = 0; b < 2; ++b)
#pragma unroll
                for (int m = 0; m < 4; ++m)
#pragma unroll
                    for (int n = 0; n < 2; ++n) acc[a][b][m][n] = (f32x4){0.f, 0.f, 0.f, 0.f};
        }
        cur = nxt; cA = nA; cB = nB; ++ui;
        if constexpr (Sched::GATHER) {
#pragma unroll
            for (int h = 0; h < 2; ++h)
#pragma unroll
                for (int i = 0; i < 2; ++i) vc[h][i] = vn[h][i];
        }
    }
    PG8_WAIT_V(0);
    if (wr == 0) PG8_BAR;
    PG8_BAR;
#undef PG8_SA
#undef PG8_SB
#undef PG8_STAGE
#undef PG8_STAGE_A
#undef PG8_STAGE_A2
#undef PG8_STAGE_B
#undef PG8_LDA
#undef PG8_LDB
#undef PG8_MMA
#undef PG8_WAIT_V
#undef PG8_WAIT_L
#undef PG8_BAR
#undef PG8_SCHED
}
}
using pg8::Unit;

#define XB_TMO      128
#define XB_XCNT(j)  (256  + 64 * (j))
#define XB_XSUB(j)  (1280 + 64 * (j))
#define XB_XGEN(j)  (2304 + 64 * (j))
#define XB_TOP      3328
#define XB_TOPGEN   3392
#define XCD_BAR_WORDS 3456
#define XB_SPIN_CAP (1u << 18)
__device__ __forceinline__ unsigned xb_ld(unsigned* p)              { return __hip_atomic_load(p, __ATOMIC_RELAXED, __HIP_MEMORY_SCOPE_AGENT); }
__device__ __forceinline__ unsigned xb_add(unsigned* p, unsigned v) { return __hip_atomic_fetch_add(p, v, __ATOMIC_RELAXED, __HIP_MEMORY_SCOPE_AGENT); }
__device__ __forceinline__ unsigned xb_xcc_id() { return (unsigned)__builtin_amdgcn_s_getreg((3 << 11) | 20) & 0xFu; }
#define XB_SPIN(cond, bar) do { unsigned _sp = 0; while (cond) { __builtin_amdgcn_s_sleep(1); \
    if ((++_sp & 255u) == 0u) { if (xb_ld(&(bar)[XB_TMO])) break; if (_sp > XB_SPIN_CAP) { atomicAdd(&(bar)[XB_TMO], 1u); break; } } } } while (0)
struct XcdBarrier { unsigned* bar; unsigned x; volatile LAS unsigned* st; };
__device__ __forceinline__ XcdBarrier xcd_barrier_post(unsigned* bar, volatile LAS unsigned* st) {
    XcdBarrier b; b.bar = bar; b.x = xb_xcc_id(); b.st = st;
    if (threadIdx.x == 0) (void)xb_add(&bar[XB_XCNT(b.x)], 1u);
    return b;
}
__device__ __forceinline__ void xcd_barrier_complete(unsigned* bar, unsigned x, unsigned& nloc, unsigned& nx) {
    const unsigned G = gridDim.x * gridDim.y * gridDim.z;
    unsigned sum, cnt, mine, sp = 0u;
    for (;;) {
        sum = 0u; cnt = 0u; mine = 0u;
#pragma unroll
        for (unsigned j = 0; j < 16; ++j) { const unsigned c = xb_ld(&bar[XB_XCNT(j)]); sum += c; cnt += (c > 0u) ? 1u : 0u; mine = (j == x) ? c : mine; }
        if (sum == G) break;
        __builtin_amdgcn_s_sleep(1);
        if ((++sp & 255u) == 0u) { if (xb_ld(&bar[XB_TMO])) break; if (sp > XB_SPIN_CAP) { atomicAdd(&bar[XB_TMO], 1u); break; } }
    }
    nloc = mine > 0u ? mine : 1u; nx = cnt > 0u ? cnt : 1u;
}
__device__ __forceinline__ void xcd_barrier(const XcdBarrier& b) {
    asm volatile("s_waitcnt vmcnt(0)" ::: "memory");
    __syncthreads();
    if (threadIdx.x == 0) {
        unsigned* bar = b.bar;
        __builtin_amdgcn_s_waitcnt(0);
        unsigned nloc = b.st[0], nx = b.st[1];
        if (nloc == 0u) { xcd_barrier_complete(bar, b.x, nloc, nx); b.st[0] = nloc; b.st[1] = nx; }
        const unsigned old = xb_add(&bar[XB_XSUB(b.x)], 1u);
        const unsigned gen = old / nloc;
        if (old + 1u == (gen + 1u) * nloc) {
            __builtin_amdgcn_fence(__ATOMIC_RELEASE, "agent");
            asm volatile("s_waitcnt vmcnt(0)" ::: "memory");
            const unsigned og = xb_add(&bar[XB_TOP], 1u);
            const unsigned tg = og / nx;
            if (og + 1u == (tg + 1u) * nx) xb_add(&bar[XB_TOPGEN], 1u);
            else XB_SPIN(xb_ld(&bar[XB_TOPGEN]) == tg, bar);
            __builtin_amdgcn_fence(__ATOMIC_ACQUIRE, "agent");
            xb_add(&bar[XB_XGEN(b.x)], 1u);
            asm volatile("s_waitcnt vmcnt(0)" ::: "memory");
        } else {
            XB_SPIN(xb_ld(&bar[XB_XGEN(b.x)]) == gen, bar);
            __builtin_amdgcn_fence(__ATOMIC_ACQUIRE, "agent");
            asm volatile("s_waitcnt vmcnt(0)" ::: "memory");
        }
    }
    __syncthreads();
}

struct Args { const float* in[19]; float* out; unsigned char* ws; int ph_lo, ph_hi; };
typedef const __attribute__((address_space(4))) Args* ArgsP;
enum { I_X = 0, I_N1G, I_WIN, I_CONVW, I_IFB, I_MNG, I_WBM, I_WBA, I_WOUT, I_RELB, I_N2G, I_WGRP, I_BGRP, I_WEXP, I_BEXP, I_W1, I_W3, I_W2, I_FG };


struct TrDesc { const float* W; bf16* WT; size_t ldn, ldk; int k0, n0, r0; };
__device__ __forceinline__ void tr_load(const TrDesc& d, f32x4 (&tv)[16], int lane) {
    const int nn4 = (lane & 15) * 4, kr = lane >> 4;
#pragma unroll
    for (int i = 0; i < 16; ++i) tv[i] = __builtin_nontemporal_load((const f32x4*)(d.W + (size_t)(d.k0 + 4 * i + kr) * d.ldn + d.n0 + nn4));
}
__device__ __forceinline__ void tr_finish(const TrDesc& d, f32x4 (&tv)[16], LAS float* scr, int lane) {
    const int nn4 = (lane & 15) * 4, kr = lane >> 4;
#pragma unroll
    for (int i = 0; i < 16; i += 4) asm volatile("" : "+v"(tv[i]), "+v"(tv[i + 1]), "+v"(tv[i + 2]), "+v"(tv[i + 3]));
#pragma unroll
    for (int i = 0; i < 16; ++i) { const int kk = 4 * i + kr; const f32x4 v = tv[i];
        LAS float* q = scr + kk * 65 + nn4; q[0] = v.x; q[1] = v.y; q[2] = v.z; q[3] = v.w; }
    LDS_WAIT();
    const int kc = (lane & 7) * 8;
#pragma unroll
    for (int p = 0; p < 8; ++p) { const int nn = 8 * p + (lane >> 3); const LAS float* sp = scr + kc * 65 + nn;
        u32x4 o; o.x = cvt_pk_bf16(sp[0], sp[65]); o.y = cvt_pk_bf16(sp[130], sp[195]); o.z = cvt_pk_bf16(sp[260], sp[325]); o.w = cvt_pk_bf16(sp[390], sp[455]);
        *(u32x4*)(d.WT + (size_t)(d.r0 + nn) * d.ldk + d.k0 + kc) = o; }
    LDS_WAIT();
}
__device__ __forceinline__ int win_src_col(int r) {
    if (r < 2048) return r;
    if (r < 3072) return r + 1024;
    if (r < 5120) return r + 1032;
    if (r < 9216) return r + 2056;
    if (r < 10240) return r - 7168;
    return r - 4088;
}
__device__ __forceinline__ TrDesc tr_decode(ArgsP a, unsigned char* ws, int it) {
    constexpr int PER_LAYER = 5632 + 512 + 512 + 1024 + 4096 + 4096 + 4096;
    const int l = it / PER_LAYER; int r = it % PER_LAYER;
    TrDesc d;
    if (r < 5632) { const int kb = r / 176, ng = r % 176;
        d.W = a->in[I_WIN] + (size_t)l * DM * INCOLS; d.ldn = INCOLS; d.k0 = 64 * kb; d.n0 = win_src_col(64 * ng); d.WT = (bf16*)(ws + WS_WINT) + (size_t)l * 11264 * 2048; d.ldk = 2048; d.r0 = 64 * ng; return d; }
    r -= 5632;
    if (r < 512) { const int kb = r / 32, ng = r % 32;
        d.W = a->in[I_WBM] + (size_t)l * 1024 * 2048; d.ldn = 2048; d.k0 = 64 * kb; d.n0 = 64 * ng; d.WT = (bf16*)(ws + WS_WBM) + (size_t)l * 2048 * 1024; d.ldk = 1024; d.r0 = 64 * ng; return d; }
    r -= 512;
    if (r < 512) { const int kb = r / 32, ng = r % 32;
        d.W = a->in[I_WBA] + (size_t)l * 1024 * 2048; d.ldn = 2048; d.k0 = 64 * kb; d.n0 = 64 * ng; d.WT = (bf16*)(ws + WS_WBA) + (size_t)l * 2048 * 1024; d.ldk = 1024; d.r0 = 64 * ng; return d; }
    r -= 512;
    if (r < 1024) { const int kb = r / 32, ng = r % 32;
        d.W = a->in[I_WOUT] + (size_t)l * 2048 * 2048; d.ldn = 2048; d.k0 = 64 * kb; d.n0 = 64 * ng; d.WT = (bf16*)(ws + WS_WOUT) + (size_t)l * 2048 * 2048; d.ldk = 2048; d.r0 = 64 * ng; return d; }
    r -= 1024;
    if (r < 8192) { const int w3 = r >= 4096; const int q = r & 4095; const int e = q >> 7, rr = q & 127, kb = rr >> 2, ng = rr & 3;
        d.W = a->in[w3 ? I_W3 : I_W1] + (size_t)(l * 32 + e) * 2048 * 256; d.ldn = 256; d.k0 = 64 * kb; d.n0 = 64 * ng;
        d.WT = (bf16*)(ws + WS_W13) + (size_t)(l * 32 + e) * 512 * 2048; d.ldk = 2048; d.r0 = 256 * (ng >> 1) + 64 * (ng & 1) + (w3 ? 128 : 0); return d; }
    r -= 8192;
    { const int e = r >> 7, rr = r & 127, kb = rr >> 5, ng = rr & 31;
        d.W = a->in[I_W2] + (size_t)(l * 32 + e) * 256 * 2048; d.ldn = 2048; d.k0 = 64 * kb; d.n0 = 64 * ng; d.WT = (bf16*)(ws + WS_W2) + (size_t)(l * 32 + e) * 2048 * 256; d.ldk = 256; d.r0 = 64 * ng; return d; }
}
#ifndef CVX
#define CVX 4096
#endif
__device__ __forceinline__ void prologue_phase(ArgsP a, LAS unsigned char* lds, int tid, int lane, int wave, int bid, int G, const int part = 0, const int gwx = -1, const int ngwx = 0) {
    unsigned char* ws = a->ws;
    LAS float* scr = (LAS float*)(lds + wave * 16640);
    const int gw = gwx >= 0 ? gwx : bid * NWAVES + wave, NGW = gwx >= 0 ? ngwx : G * NWAVES;
    constexpr int PER_LAYER = 5632 + 512 + 512 + 1024 + 4096 + 4096 + 4096;
    constexpr int W0 = 5632, W2I = PER_LAYER - 4096;
    const int v_lo = part == 0 ? 0 : part == 1 ? PER_LAYER : part == 2 ? W0 + CVX : part == 3 ? PER_LAYER + W0 : part == 4 ? PER_LAYER + W2I : W0;
    const int v_hi = part == 0 ? W0 : part == 1 ? PER_LAYER + W0 : part == 2 ? PER_LAYER : part == 3 ? PER_LAYER + W2I : part == 4 ? 2 * PER_LAYER : W0 + CVX;
#define CV_ITEM(v) (v)
    f32x4 tvA[16], tvB[16]; TrDesc dA, dB;
    int it = v_lo + gw;
    if (it < v_hi) {
        int rem = (v_hi - 1 - it) / NGW;
        dA = tr_decode(a, ws, CV_ITEM(it)); tr_load(dA, tvA, lane);
#pragma unroll 1
        while (rem >= 2) {
            dB = tr_decode(a, ws, CV_ITEM(it + NGW)); tr_load(dB, tvB, lane);
            tr_finish(dA, tvA, scr, lane);
            it += 2 * NGW;
            dA = tr_decode(a, ws, CV_ITEM(it)); tr_load(dA, tvA, lane);
            tr_finish(dB, tvB, scr, lane);
            rem -= 2;
        }
        if (rem == 1) { dB = tr_decode(a, ws, CV_ITEM(it + NGW)); tr_load(dB, tvB, lane); tr_finish(dA, tvA, scr, lane); tr_finish(dB, tvB, scr, lane); }
        else tr_finish(dA, tvA, scr, lane);
    }
#undef CV_ITEM
    if (part != 0) return;
    const int gt = bid * NTHR + tid, NGT = G * NTHR;
    float* wrt = (float*)(ws + MS_WRT);
    for (int i = gt; i < 2 * 36 * 2048; i += NGT) { const int l = i / (36 * 2048), rr = i % (36 * 2048), n = rr >> 11, k = rr & 2047;
        wrt[i] = n < 4 ? a->in[I_WGRP][((size_t)l * DM + k) * 4 + n] : a->in[I_WEXP][((size_t)l * DM + k) * 32 + (n - 4)]; }
}

__device__ __forceinline__ void moe_tables(unsigned char* ws, int l, LAS unsigned char* misc, int tid) {
    LAS int* cnt = (LAS int*)(misc + MO_CNT); LAS int* ntl = (LAS int*)(misc + MO_NT); LAS int* off = (LAS int*)(misc + MO_OFF);
    LAS int* te = (LAS int*)(misc + MO_TE); LAS int* tr0 = (LAS int*)(misc + MO_TR0); LAS int* mt = (LAS int*)(misc + MO_MT);
    __syncthreads();
    if (tid < 32) { const int c = (int)__hip_atomic_load((unsigned*)(ws + WS_CTL) + CW_CNT + 32 * l + tid, __ATOMIC_RELAXED, __HIP_MEMORY_SCOPE_AGENT); cnt[tid] = c; ntl[tid] = (c + 255) >> 8; }
    __syncthreads();
    if (tid == 0) { int o = 0;
#pragma unroll 1
        for (int e = 0; e < 32; ++e) { off[e] = o; const int n = ntl[e];
#pragma unroll 1
            for (int j = 0; j < n; ++j) { te[o + j] = e; tr0[o + j] = 256 * j; } o += n; } off[32] = o; mt[0] = o; }
    __syncthreads();
}

#ifndef DRYX
#define DRYX 0
#endif
template <int MODE>
__device__ __forceinline__ void norm_phase(ArgsP a, int l, LAS unsigned char* lds, int tid, int lane, int wave, int bid, int G, const bool dry = false) {
    unsigned char* ws = a->ws;
    LAS unsigned char* misc = lds + MISC_OFF;
    if (MODE == 1 || MODE == 3) moe_tables(ws, MODE == 1 ? 0 : 1, misc, tid);
    const LAS int* off = (const LAS int*)(misc + MO_OFF);
    const float* src = (MODE == 0) ? a->in[I_X] : a->out;
    const float* gain = (MODE < 2) ? a->in[I_N1G] + l * DM : (MODE == 2 ? a->in[I_N2G] + l * DM : a->in[I_FG]);
    const int* toke = (const int*)(ws + MS_TOKE); const int* tokp = (const int*)(ws + MS_TOKP);
    const bf16* OP = (const bf16*)(ws + WS_OP);
    bf16* H = (bf16*)(ws + WS_H);
    const int gw = bid * NWAVES + wave, NGW = G * NWAVES;
    constexpr int RP = (MODE == 2) ? 4 : 2;
    LAS float* gwl = (LAS float*)lds;
    if (MODE < 2) {
        const float* wg = a->in[I_WIN] + (size_t)l * DM * INCOLS + 4096;
        f32x4 t0[4], t1[4];
#pragma unroll
        for (int i = 0; i < 4; ++i) { const float* wp = wg + (size_t)(tid + NTHR * i) * INCOLS; t0[i] = *(const f32x4*)wp; t1[i] = *(const f32x4*)(wp + 4); }
#pragma unroll
        for (int i = 0; i < 4; ++i) { const int k = tid + NTHR * i;
            gwl[k] = t0[i].x; gwl[2048 + k] = t0[i].y; gwl[4096 + k] = t0[i].z; gwl[6144 + k] = t0[i].w;
            gwl[8192 + k] = t1[i].x; gwl[10240 + k] = t1[i].y; gwl[12288 + k] = t1[i].z; gwl[14336 + k] = t1[i].w; }
        __syncthreads();
    }
    const int npass = (NTOK + NGW * RP - 1) / (NGW * RP);
    for (int m0_ = gw * RP, it = 0; (MODE == 2) ? (it < npass) : (m0_ < NTOK); m0_ += NGW * RP, ++it) {
        const bool valid = (MODE != 2) || (m0_ < NTOK);
        const int m0 = valid ? m0_ : NTOK - RP;
        f32x4 v[RP][8];
        const bf16* orow[RP][2]; float cw[RP][2];
        if (MODE == 1 || MODE == 3) {
#pragma unroll
            for (int r = 0; r < RP; ++r) { const int m = m0 + r;
                const int e0 = toke[2 * m], e1 = toke[2 * m + 1], p0 = tokp[2 * m], p1 = tokp[2 * m + 1];
                cw[r][0] = ((const float*)(ws + MS_TOKW))[2 * m]; cw[r][1] = ((const float*)(ws + MS_TOKW))[2 * m + 1];
                orow[r][0] = OP + (size_t)(off[e0] * 256 + p0) * DM + 4 * lane; orow[r][1] = OP + (size_t)(off[e1] * 256 + p1) * DM + 4 * lane; }
        }
#pragma unroll
        for (int r = 0; r < RP; ++r)
#pragma unroll
            for (int j = 0; j < 8; ++j) v[r][j] = *(const f32x4*)(src + (size_t)(m0 + r) * DM + 256 * j + 4 * lane);
        if (MODE == 1 || MODE == 3) {
            u32x2 ow[RP][2][8];
#pragma unroll
            for (int r = 0; r < RP; ++r)
#pragma unroll
                for (int j = 0; j < 8; ++j) { ow[r][0][j] = *(const u32x2*)(orow[r][0] + 256 * j); ow[r][1][j] = *(const u32x2*)(orow[r][1] + 256 * j); }
#pragma unroll
            for (int r = 0; r < RP; ++r)
                asm volatile("" : "+v"(ow[r][0][0]), "+v"(ow[r][0][1]), "+v"(ow[r][0][2]), "+v"(ow[r][0][3]), "+v"(ow[r][0][4]), "+v"(ow[r][0][5]), "+v"(ow[r][0][6]), "+v"(ow[r][0][7]),
                                  "+v"(ow[r][1][0]), "+v"(ow[r][1][1]), "+v"(ow[r][1][2]), "+v"(ow[r][1][3]), "+v"(ow[r][1][4]), "+v"(ow[r][1][5]), "+v"(ow[r][1][6]), "+v"(ow[r][1][7]));
#pragma unroll
            for (int r = 0; r < RP; ++r) { const int m = m0 + r; const float cw0 = cw[r][0], cw1 = cw[r][1];
#pragma unroll
                for (int j = 0; j < 8; ++j) { const u32x2 w0 = ow[r][0][j], w1 = ow[r][1][j];
                    v[r][j].x += cw0 * bflo(w0.x) + cw1 * bflo(w1.x); v[r][j].y += cw0 * bfhi(w0.x) + cw1 * bfhi(w1.x); v[r][j].z += cw0 * bflo(w0.y) + cw1 * bflo(w1.y); v[r][j].w += cw0 * bfhi(w0.y) + cw1 * bfhi(w1.y); }
                if (MODE == 1 && !dry) {
#pragma unroll
                    for (int j = 0; j < 8; ++j) *(f32x4*)(a->out + (size_t)m * DM + 256 * j + 4 * lane) = v[r][j]; }
            }
        }
        float rs[RP];
#pragma unroll
        for (int r = 0; r < RP; ++r) { float ss = 0.f;
#pragma unroll
            for (int j = 0; j < 8; ++j) ss += (v[r][j].x * v[r][j].x + v[r][j].y * v[r][j].y) + (v[r][j].z * v[r][j].z + v[r][j].w * v[r][j].w);
            rs[r] = __builtin_amdgcn_rsqf(wave_sum(ss) * (1.0f / DM) + RMS_EPS); }
        {
            f32x4 gv[8];
            int l4 = 4 * lane; asm volatile("" : "+v"(l4)); const float* gp = gain + l4;
#pragma unroll
            for (int j = 0; j < 8; ++j) gv[j] = *(const f32x4*)(gp + 256 * j);
            asm volatile("" : "+v"(gv[0]), "+v"(gv[1]), "+v"(gv[2]), "+v"(gv[3]), "+v"(gv[4]), "+v"(gv[5]), "+v"(gv[6]), "+v"(gv[7]));
#pragma unroll
            for (int j = 0; j < 8; ++j)
#pragma unroll
                for (int r = 0; r < RP; ++r) v[r][j] = v[r][j] * rs[r] * gv[j];
        }
        if (MODE == 3) {
#pragma unroll
            for (int r = 0; r < RP; ++r)
#pragma unroll
                for (int j = 0; j < 8; ++j) { if (!dry) *(f32x4*)(a->out + (size_t)(m0 + r) * DM + 256 * j + 4 * lane) = v[r][j]; else asm volatile("" :: "v"(v[r][j])); }
            continue;
        }
#pragma unroll
        for (int r = 0; r < RP; ++r)
#pragma unroll
            for (int j = 0; j < 8; ++j) { u32x2 w; w.x = cvt_pk_bf16(v[r][j].x, v[r][j].y); w.y = cvt_pk_bf16(v[r][j].z, v[r][j].w);
                if (!dry && valid) *(u32x2*)(H + (size_t)(m0 + r) * DM + 256 * j + 4 * lane) = w; else asm volatile("" :: "v"(w)); }
        float keep[RP]; _Pragma("unroll") for (int r = 0; r < RP; ++r) keep[r] = 0.f;
        if (MODE < 2) {
            float a8[RP][8];
#pragma unroll
            for (int r = 0; r < RP; ++r)
#pragma unroll
                for (int n = 0; n < 8; ++n) a8[r][n] = 0.f;
#pragma unroll
            for (int j = 0; j < 8; ++j) {
#pragma unroll
                for (int nh = 0; nh < 2; ++nh) {
                    f32x4 wn[4];
#pragma unroll
                    for (int n = 0; n < 4; ++n) wn[n] = *(const LAS f32x4*)(gwl + (4 * nh + n) * 2048 + 256 * j + 4 * lane);
                    asm volatile("" : "+v"(wn[0]), "+v"(wn[1]), "+v"(wn[2]), "+v"(wn[3]));
#pragma unroll
                    for (int r = 0; r < RP; ++r)
#pragma unroll
                        for (int n = 0; n < 4; ++n) a8[r][4 * nh + n] += (v[r][j].x * wn[n].x + v[r][j].y * wn[n].y) + (v[r][j].z * wn[n].z + v[r][j].w * wn[n].w);
                }
            }
#pragma unroll
            for (int r = 0; r < RP; ++r)
#pragma unroll
                for (int n = 0; n < 8; ++n) { const float d = wave_sum(a8[r][n]); keep[r] = (lane == n) ? d : keep[r]; }
        } else {
            const float* W = (const float*)(ws + MS_WRT) + (size_t)l * 36 * 2048;
            LAS float* logl = (LAS float*)(misc + MO_LOG) + wave * 160;
            LAS float* wb = (LAS float*)lds;
#define RT_STAGE(g_, buf_) do { _Pragma("unroll") for (int i = 0; i < 4; ++i) \
                __builtin_amdgcn_global_load_lds((const unsigned*)(W + (size_t)(g_) * 8192 + (wave * 4 + i) * 256 + 4 * lane), (LAS unsigned*)(wb + (buf_) * 8192 + (wave * 4 + i) * 256), 16, 0, 0); } while (0)
            RT_STAGE(0, 0);
            asm volatile("s_waitcnt vmcnt(0)" ::: "memory");
            __syncthreads();
#pragma unroll 1
            for (int grp = 0; grp < 9; ++grp) {
                float val[16];
                if (grp < 8) RT_STAGE(grp + 1, (grp + 1) & 1);
                const LAS float* wg = wb + (grp & 1) * 8192 + 4 * lane;
#pragma unroll
                for (int nl = 0; nl < 4; ++nl) {
                    f32x2 d[4] = {(f32x2){0.f, 0.f}, (f32x2){0.f, 0.f}, (f32x2){0.f, 0.f}, (f32x2){0.f, 0.f}};
                    f32x4 wv[8];
#pragma unroll
                    for (int j = 0; j < 8; ++j) wv[j] = *(const LAS f32x4*)(wg + nl * 2048 + 256 * j);
                    asm volatile("" : "+v"(wv[0]), "+v"(wv[1]), "+v"(wv[2]), "+v"(wv[3]), "+v"(wv[4]), "+v"(wv[5]), "+v"(wv[6]), "+v"(wv[7]));
#pragma unroll
                    for (int j = 0; j < 8; ++j) { const f32x4 w = wv[j];
#pragma unroll
                        for (int r = 0; r < 4; ++r) { d[r] = __builtin_elementwise_fma((f32x2){v[r][j].x, v[r][j].y}, (f32x2){w.x, w.y}, d[r]); d[r] = __builtin_elementwise_fma((f32x2){v[r][j].z, v[r][j].w}, (f32x2){w.z, w.w}, d[r]); } }
#pragma unroll
                    for (int r = 0; r < 4; ++r) val[4 * nl + r] = d[r].x + d[r].y;
                    __builtin_amdgcn_sched_barrier(0);
                }
                asm volatile("s_waitcnt vmcnt(0)" ::: "memory");
                __syncthreads();
#pragma unroll
                for (int i = 0; i < 8; ++i) { const bool hi = (lane & 32) != 0; const float snd = hi ? val[i] : val[i + 8]; const float kp = hi ? val[i + 8] : val[i]; val[i] = kp + __shfl_xor(snd, 32); }
#pragma unroll
                for (int i = 0; i < 4; ++i) { const bool hi = (lane & 16) != 0; const float snd = hi ? val[i] : val[i + 4]; const float kp = hi ? val[i + 4] : val[i]; val[i] = kp + __shfl_xor(snd, 16); }
#pragma unroll
                for (int i = 0; i < 2; ++i) { const bool hi = (lane & 8) != 0; const float snd = hi ? val[i] : val[i + 2]; const float kp = hi ? val[i + 2] : val[i]; val[i] = kp + __shfl_xor(snd, 8); }
                { const bool hi = (lane & 4) != 0; const float snd = hi ? val[0] : val[1]; const float kp = hi ? val[1] : val[0]; val[0] = kp + __shfl_xor(snd, 4); }
                float f = val[0]; f += __shfl_xor(f, 2); f += __shfl_xor(f, 1);
                const int vi = lane >> 2;
                if ((lane & 3) == 0) logl[(vi & 3) * 40 + 4 * grp + (vi >> 2)] = f;
            }
        }
        if (MODE < 2) {
            float* ifg = (float*)(ws + MS_IFG);
            if (lane < 8) {
#pragma unroll
                for (int r = 0; r < RP; ++r) { if (!dry) ifg[(size_t)(m0 + r) * 8 + lane] = keep[r]; else asm volatile("" :: "v"(keep[r])); } }
        } else {
            LAS float* logl = (LAS float*)(misc + MO_LOG) + wave * 160;
            LDS_WAIT();
            if (dry) { asm volatile("" :: "v"(keep[0])); }
            if (lane < RP && !dry && valid) {
                const int m = m0 + lane; const LAS float* lg = logl + lane * 40;
                const float* bg = a->in[I_BGRP] + l * 4; const float* be = a->in[I_BEXP] + l * 32;
                float gv[4]; int gsel = 0;
#pragma unroll
                for (int j = 0; j < 4; ++j) gv[j] = lg[j] + bg[j];
                float gmax = gv[0];
#pragma unroll
                for (int j = 1; j < 4; ++j) if (gv[j] > gmax) { gmax = gv[j]; gsel = j; }
                float gs = 0.f;
#pragma unroll
                for (int j = 0; j < 4; ++j) gs += expf(gv[j] - gmax);
                const float pg = 1.0f / gs;
                float ev[8];
#pragma unroll
                for (int j = 0; j < 8; ++j) ev[j] = lg[4 + 8 * gsel + j] + be[8 * gsel + j];
                int e0 = 0; float m0v = ev[0];
#pragma unroll
                for (int j = 1; j < 8; ++j) if (ev[j] > m0v) { m0v = ev[j]; e0 = j; }
                int e1 = -1; float m1v = -3.0e38f;
#pragma unroll
                for (int j = 0; j < 8; ++j) if (j != e0 && ev[j] > m1v) { m1v = ev[j]; e1 = j; }
                const float p1 = expf(m1v - m0v); const float w0 = pg / (1.0f + p1), w1 = pg * p1 / (1.0f + p1);
                unsigned* cnt = (unsigned*)(ws + WS_CTL) + CW_CNT + 32 * l;
                int* list = (int*)(ws + MS_LIST); float* pwl = (float*)(ws + MS_PWL); int* tke = (int*)(ws + MS_TOKE); int* tkp = (int*)(ws + MS_TOKP);
                const int id0 = 8 * gsel + e0, id1 = 8 * gsel + e1;
                const int q0 = (int)__hip_atomic_fetch_add(cnt + id0, 1u, __ATOMIC_RELAXED, __HIP_MEMORY_SCOPE_AGENT);
                const int q1 = (int)__hip_atomic_fetch_add(cnt + id1, 1u, __ATOMIC_RELAXED, __HIP_MEMORY_SCOPE_AGENT);
                list[id0 * 8192 + q0] = m; pwl[id0 * 8192 + q0] = w0; list[id1 * 8192 + q1] = m; pwl[id1 * 8192 + q1] = w1;
                tke[2 * m] = id0; tke[2 * m + 1] = id1; tkp[2 * m] = q0; tkp[2 * m + 1] = q1;
                ((float*)(ws + MS_TOKW))[2 * m] = w0; ((float*)(ws + MS_TOKW))[2 * m + 1] = w1;
            }
            LDS_WAIT();
        }
    }
}

struct SchedG1 {
    static constexpr bool GATHER = false;
    const char* H; const char* W; int G, c;
    static constexpr int NCV = 21;
    __device__ __forceinline__ bool next(int i, Unit& u) const {
        int L = i * G + c;
        if (G == 256) {
            if (c >= 256 - NCV) return false;
            if (c >= 128 && i == 5) { const int k = c - 128; if (k >= 5 * NCV) return false; L = (k % 5) * 256 + (256 - NCV) + k / 5; }
            else if (i > 5) return false;
        }
        if (L < 1152) { pg8::static_tile(L, 32, 36, u.pm, u.pn); u.aux = 0; return true; }
        const int r = L - 1152; if (r >= 256) return false;
        u.aux = 1 + (r >> 7); const int q = r & 127; u.pm = q & 3; u.pn = q >> 2; return true;
    }
    __device__ __forceinline__ const char* abase(const Unit& u) const { return u.aux == 0 ? H + (size_t)u.pm * 256 * 4096 : W + (size_t)(9216 + (u.aux - 1) * 1024 + u.pm * 256) * 4096; }
    __device__ __forceinline__ const char* bbase(const Unit& u) const { return u.aux == 0 ? W + (size_t)u.pn * 256 * 4096 : H + (size_t)u.pn * 256 * 4096; }
    __device__ __forceinline__ unsigned arow(const Unit&, int) const { return 0u; }
    static __device__ __forceinline__ bool keep_acc(const Unit&) { return false; }
};
struct EpiG1 {
    static constexpr bool PERM = true;
    unsigned char* ws; bool dry;
    __device__ __forceinline__ void operator()(f32x4 (&acc)[2][2][4][2], const Unit& u, int wr, int wc, int fr, int fq) const {
        if (dry) {
#pragma unroll
            for (int ai = 0; ai < 2; ++ai)
#pragma unroll
                for (int bj = 0; bj < 2; ++bj)
#pragma unroll
                    for (int m = 0; m < 4; ++m) asm volatile("" :: "v"(acc[ai][bj][m][0]), "v"(acc[ai][bj][m][1]));
            return; }
        if (u.aux == 0) {
            bf16* dst; int ld, colt, op;
            if (u.pn < 8) { dst = (bf16*)(ws + WS_ZQK); ld = 2048; colt = 256 * u.pn; op = 0; }
            else if (u.pn < 12) { dst = (bf16*)(ws + WS_OM); ld = 1024; colt = 256 * (u.pn - 8); op = 1; }
            else if (u.pn < 16) { dst = (bf16*)(ws + WS_QA); ld = 1024; colt = 256 * (u.pn - 12); op = 2; }
            else if (u.pn < 20) { dst = (bf16*)(ws + WS_KA); ld = 1024; colt = 256 * (u.pn - 16); op = 0; }
            else { dst = (bf16*)(ws + WS_SG); ld = 4096; colt = 256 * (u.pn - 20); op = 1; }
            const float scl = (op == 2) ? 0.12751743074602267f : 1.0f;
            const int row0 = u.pm * 256 + wr * 64 + fr, col0 = colt + wc * 32 + 8 * fq;
#pragma unroll
            for (int ai = 0; ai < 2; ++ai)
#pragma unroll
                for (int m = 0; m < 4; ++m) { bf16* rowp = dst + (size_t)(row0 + ai * 128 + m * 16) * ld + col0;
#pragma unroll
                    for (int bj = 0; bj < 2; ++bj) { f32x4 v0 = acc[ai][bj][m][0] * scl, v1 = acc[ai][bj][m][1] * scl;
                        if (op == 1) {
#pragma unroll
                            for (int j = 0; j < 4; ++j) { v0[j] = sigmoidf_(v0[j]); v1[j] = sigmoidf_(v1[j]); } }
                        u32x4 w; w.x = cvt_pk_bf16(v0[0], v0[1]); w.y = cvt_pk_bf16(v0[2], v0[3]); w.z = cvt_pk_bf16(v1[0], v1[1]); w.w = cvt_pk_bf16(v1[2], v1[3]);
                        *(u32x4*)(rowp + bj * 128) = w; } }
        } else {
            bf16* dst = (bf16*)(ws + (u.aux == 1 ? WS_VMT : WS_VAT));
            const int b = u.pn >> 3, s0 = (u.pn & 7) * 256 + wc * 32 + 8 * fq, rr0 = u.pm * 256 + wr * 64 + fr;
#pragma unroll
            for (int ai = 0; ai < 2; ++ai)
#pragma unroll
                for (int m = 0; m < 4; ++m) { const int rr = rr0 + ai * 128 + m * 16;
#pragma unroll
                    for (int bj = 0; bj < 2; ++bj) { const f32x4 v0 = acc[ai][bj][m][0], v1 = acc[ai][bj][m][1];
                        u32x4 w; w.x = cvt_pk_bf16(v0[0], v0[1]); w.y = cvt_pk_bf16(v0[2], v0[3]); w.z = cvt_pk_bf16(v1[0], v1[1]); w.w = cvt_pk_bf16(v1[2], v1[3]);
                        const int sq = s0 + bj * 128;
                        const size_t off = (u.aux == 1) ? (size_t)((((b * 4 + (rr >> 8)) * 32 + (sq >> 6)) * 2 + ((sq >> 5) & 1)) * 16 + ((rr & 255) >> 4)) * 512 + (size_t)((((sq >> 3) & 3) * 16 + (rr & 15)) * 8)
                                                        : (size_t)(b * 1024 + rr) * 2048 + sq;
                        *(u32x4*)(dst + off) = w; } }
        }
    }
};

__device__ __forceinline__ void gate_unit(ArgsP a, int l, LAS unsigned char* lds, int bh, int tid, int lane, int wave) {
    unsigned char* ws = a->ws;
    {
            const int b = bh >> 2, h = bh & 3;
            LAS float* bl = (LAS float*)lds; LAS float* amx = bl + 32; LAS float* mpv = bl + 64; LAS float* gcv = bl + 96;
            const float* ifg = (const float*)(ws + MS_IFG); const float* ifb = a->in[I_IFB] + l * 8;
            float A[4], Bs[4], CM[4];
#pragma unroll
            for (int cc = 0; cc < 4; ++cc) { const int c = wave + 8 * cc, s = 64 * c + lane; const size_t tok = (size_t)b * SEQ + s;
                const float ig = ifg[tok * 8 + h] + ifb[h], fg = ifg[tok * 8 + 4 + h] + ifb[4 + h];
                const float lf = fminf(fg, 0.f) - log1pf(expf(-fabsf(fg)));
                float bs = lf;
#pragma unroll
                for (int o = 1; o < 64; o <<= 1) { const float t = __shfl_up(bs, o); if (lane >= o) bs += t; }
                const float av = ig - bs; float cm = av;
#pragma unroll
                for (int o = 1; o < 64; o <<= 1) { const float t = __shfl_up(cm, o); if (lane >= o) cm = fmaxf(cm, t); }
                A[cc] = av; Bs[cc] = bs; CM[cc] = cm;
                if (lane == 63) { bl[c] = bs; amx[c] = cm; } }
            __syncthreads();
            if (tid == 0) { float m = 0.f;
#pragma unroll 1
                for (int c = 0; c < 32; ++c) { mpv[c] = m; const float Gm = fmaxf(m, amx[c]); gcv[c] = Gm; m = bl[c] + Gm; } }
            __syncthreads();
            float* AS = (float*)(ws + MS_AS) + bh * 2048; float* GT = (float*)(ws + MS_GT) + bh * 2048; float* WI = (float*)(ws + MS_WI) + bh * 2048;
            float* CL = (float*)(ws + MS_CL) + bh * 2048; float* WSs = (float*)(ws + MS_WS) + bh * 2048; float* DEC = (float*)(ws + MS_DEC) + bh * 32;
#pragma unroll
            for (int cc = 0; cc < 4; ++cc) { const int c = wave + 8 * cc, s = 64 * c + lane; const float mp = mpv[c], Gm = gcv[c], gt = fmaxf(mp, CM[cc]);
                AS[s] = A[cc]; GT[s] = gt; WI[s] = expf(mp - gt); CL[s] = expf(-(Bs[cc] + gt)); WSs[s] = expf(A[cc] - Gm);
                if (lane == 0) DEC[c] = expf(mp - Gm); }
        }
    __syncthreads();
}

__device__ __forceinline__ void conv_phase(ArgsP a, int l, LAS unsigned char* lds, int tid, int lane, int wave, int bid, int G) {
    unsigned char* ws = a->ws;
    u32x4 xv[5];
    const bf16* Z = (const bf16*)(ws + WS_ZQK);
#define CONV_LOAD(u_) do { const int cg_ = (u_) & 7, s0_ = 64 * (((u_) >> 3) & 31), b_ = (u_) >> 8; _Pragma("unroll") for (int i = 0; i < 5; ++i) { \
        const int idx = tid + NTHR * i, row = idx >> 5, ch = idx & 31, sq = s0_ - 3 + row; xv[i] = (u32x4){0u, 0u, 0u, 0u}; \
        if (idx < 67 * 32 && sq >= 0) xv[i] = *(const u32x4*)(Z + (size_t)(b_ * SEQ + sq) * 2048 + cg_ * 256 + ch * 8); } } while (0)
    if (bid < 1024) CONV_LOAD(bid);
    for (int u = bid; u < 1024 + 256; u += G) {
        if (u < 1024) {
            const int cg = u & 7, st = (u >> 3) & 31, b = u >> 8, s0 = 64 * st;
            LAS unsigned char* xt = lds; LAS unsigned char* kt = lds + 36864;
            asm volatile("" : "+v"(xv[0]), "+v"(xv[1]), "+v"(xv[2]), "+v"(xv[3]), "+v"(xv[4]));
#pragma unroll
            for (int i = 0; i < 5; ++i) { const int idx = tid + NTHR * i, row = idx >> 5, ch = idx & 31;
                if (idx < 67 * 32) *(LAS u32x4*)(xt + row * 512 + ch * 16) = xv[i]; }
            LAS float* wst = (LAS float*)(lds + 73728);
            if (cg >= 4 && tid < 64) wst[tid] = ((const float*)(ws + MS_WS))[(size_t)(b * 4 + cg - 4) * 2048 + s0 + tid];
            __syncthreads();
            if (u + G < 1024) CONV_LOAD(u + G);
            const int cp = tid & 127, tg = tid >> 7, c = 2 * cp, gc = cg * 256 + c;
            float w0[4], w1[4];
#pragma unroll
            for (int j = 0; j < 4; ++j) { w0[j] = a->in[I_CONVW][(size_t)(l * 4 + j) * 2048 + gc]; w1[j] = a->in[I_CONVW][(size_t)(l * 4 + j) * 2048 + gc + 1]; }
            bf16* QM = (bf16*)(ws + WS_QM); bf16* KM = (bf16*)(ws + WS_KM);
#pragma unroll 4
            for (int tt = 0; tt < 16; ++tt) { const int t = tg * 16 + tt; float a0 = 0.f, a1 = 0.f;
#pragma unroll
                for (int j = 0; j < 4; ++j) { const unsigned x = *(const LAS unsigned*)(xt + (t + j) * 512 + c * 2); a0 += w0[j] * bflo(x); a1 += w1[j] * bfhi(x); }
                float o0 = a0 * sigmoidf_(a0), o1 = a1 * sigmoidf_(a1);
                const size_t tok = (size_t)b * SEQ + s0 + t;
                if (cg < 4) { *(unsigned*)(QM + tok * 1024 + cg * 256 + c) = cvt_pk_bf16(o0, o1); }
                else { o0 *= 0.0625f; o1 *= 0.0625f; const unsigned p = cvt_pk_bf16(o0, o1);
                    *(unsigned*)(KM + tok * 1024 + (cg - 4) * 256 + c) = p;
                    const float wsv = wst[t]; const unsigned ps = cvt_pk_bf16(o0 * wsv, o1 * wsv);
                    *(LAS unsigned short*)(kt + c * 144 + t * 2) = (unsigned short)(ps & 0xffffu); *(LAS unsigned short*)(kt + (c + 1) * 144 + t * 2) = (unsigned short)(ps >> 16); }
            }
            if (cg >= 4) {
                __syncthreads();
                bf16* KMT = (bf16*)(ws + WS_KMT);
                for (int idx = tid; idx < 2048; idx += NTHR) {
                    const int ks = idx >> 10, dtl = (idx >> 6) & 15, ln = idx & 63, row = dtl * 16 + (ln & 15), ch = ks * 4 + (ln >> 4);
                    const u32x4 v = *(const LAS u32x4*)(kt + row * 144 + ch * 16);
                    *(u32x4*)(KMT + (size_t)(((b * 4 + cg - 4) * 32 + st) * 2) * 8192 + (size_t)idx * 8) = v; }
                if (tid < 256) {
                    float sm = 0.f;
#pragma unroll
                    for (int i = 0; i < 8; ++i) { const u32x4 v = *(const LAS u32x4*)(kt + tid * 144 + i * 16);
                        sm += (bflo(v.x) + bfhi(v.x)) + (bflo(v.y) + bfhi(v.y)) + (bflo(v.z) + bfhi(v.z)) + (bflo(v.w) + bfhi(v.w)); }
                    ((float*)(ws + MS_NST))[(size_t)((b * 4 + cg - 4) * 32 + st) * 256 + tid] = sm; }
            }
        } else if (u < 1280) {
            const int j = u - 1024, b = j >> 6, n = (j >> 3) & 7, h = j & 7;
            const bf16* KA = (const bf16*)(ws + WS_KA) + (size_t)(b * SEQ + n * 256 + wave * 32) * 1024 + h * 128 + 2 * lane;
            float s0 = 0.f, s1 = 0.f;
            unsigned xr[32];
#pragma unroll
            for (int r = 0; r < 32; ++r) xr[r] = *(const unsigned*)(KA + (size_t)r * 1024);
#pragma unroll
            for (int r = 0; r < 32; r += 8) asm volatile("" : "+v"(xr[r]), "+v"(xr[r + 1]), "+v"(xr[r + 2]), "+v"(xr[r + 3]), "+v"(xr[r + 4]), "+v"(xr[r + 5]), "+v"(xr[r + 6]), "+v"(xr[r + 7]));
#pragma unroll
            for (int r = 0; r < 32; ++r) { s0 += bflo(xr[r]); s1 += bfhi(xr[r]); }
            LAS float* part = (LAS float*)lds;
            part[wave * 128 + 2 * lane] = s0; part[wave * 128 + 2 * lane + 1] = s1;
            __syncthreads();
            if (tid < 128) { float t = 0.f;
#pragma unroll
                for (int w = 0; w < 8; ++w) t += part[w * 128 + tid];
                ((float*)(ws + MS_KMEAN))[(size_t)((b * 8 + h) * 8 + n) * 128 + tid] = t * (1.0f / 256.0f); }
        }
        __syncthreads();
    }
}

#undef CONV_LOAD
__device__ __forceinline__ void mlstm_ab_task(unsigned char* ws, int gw, int lane, const bool do_store = true) {
    const int bh = gw >> 6, piece = gw & 63, e0 = (piece >> 3) * 32, d0 = (piece & 7) * 32, q16 = lane & 15, g = lane >> 4;
    const bf16* ka = (const bf16*)(ws + WS_KMT) + (size_t)bh * 32 * 16384 + (size_t)(d0 >> 4) * 512 + lane * 8;
    const bf16* vb = (const bf16*)(ws + WS_VMT) + (size_t)bh * 32 * 16384 + (size_t)(e0 >> 4) * 512 + lane * 8;
    const float* DEC = (const float*)(ws + MS_DEC) + bh * 32;
    bf16* CST = (bf16*)(ws + WS_CST) + (size_t)bh * 32 * 65536 + (size_t)((d0 >> 5) * 16 + (e0 >> 4)) * 512 + (size_t)(((g >> 1) * 16 + q16) * 8 + 4 * (g & 1));
    f32x4 acc[2][2];
#pragma unroll
    for (int t = 0; t < 2; ++t) { acc[t][0] = (f32x4){0.f, 0.f, 0.f, 0.f}; acc[t][1] = acc[t][0]; }
    const int decv = __builtin_bit_cast(int, DEC[lane & 31]);
    bf16x8 A0[2][2], B0[2][2], A1[2][2], B1[2][2], A2[2][2], B2[2][2], A3[2][2], B3[2][2], A4[2][2], B4[2][2];
#define AB_LOAD(c_, A_, B_) do { const int cc_ = (c_) < 31 ? (c_) : 31; _Pragma("unroll") for (int ks = 0; ks < 2; ++ks) { \
        A_[0][ks] = *(const bf16x8*)(ka + (size_t)cc_ * 16384 + ks * 8192); A_[1][ks] = *(const bf16x8*)(ka + (size_t)cc_ * 16384 + ks * 8192 + 512); \
        B_[0][ks] = *(const bf16x8*)(vb + (size_t)cc_ * 16384 + ks * 8192); B_[1][ks] = *(const bf16x8*)(vb + (size_t)cc_ * 16384 + ks * 8192 + 512); } } while (0)
#define AB_STEP(c_, A_, B_) do { \
        if (do_store) { _Pragma("unroll") for (int t = 0; t < 2; ++t) _Pragma("unroll") for (int f = 0; f < 2; ++f) { u32x2 w; w.x = cvt_pk_bf16(acc[t][f][0], acc[t][f][1]); w.y = cvt_pk_bf16(acc[t][f][2], acc[t][f][3]); \
            *(u32x2*)(CST + (size_t)(c_) * 65536 + 512 * t + 256 * f) = w; } } \
        const float dec = __builtin_bit_cast(float, __builtin_amdgcn_readlane(decv, (c_))); \
        _Pragma("unroll") for (int t = 0; t < 2; ++t) { acc[t][0] = acc[t][0] * dec; acc[t][1] = acc[t][1] * dec; } \
        _Pragma("unroll") for (int ks = 0; ks < 2; ++ks) _Pragma("unroll") for (int t = 0; t < 2; ++t) { \
            acc[t][0] = __builtin_amdgcn_mfma_f32_16x16x32_bf16(A_[0][ks], B_[t][ks], acc[t][0], 0, 0, 0); \
            acc[t][1] = __builtin_amdgcn_mfma_f32_16x16x32_bf16(A_[1][ks], B_[t][ks], acc[t][1], 0, 0, 0); } } while (0)
    AB_LOAD(0, A0, B0); AB_LOAD(1, A1, B1); AB_LOAD(2, A2, B2); AB_LOAD(3, A3, B3); AB_LOAD(4, A4, B4);
#pragma unroll 1
    for (int c = 0; c < 30; c += 5) {
        AB_STEP(c, A0, B0); AB_LOAD(c + 5, A0, B0);
        AB_STEP(c + 1, A1, B1); AB_LOAD(c + 6, A1, B1);
        AB_STEP(c + 2, A2, B2); AB_LOAD(c + 7, A2, B2);
        AB_STEP(c + 3, A3, B3); AB_LOAD(c + 8, A3, B3);
        AB_STEP(c + 4, A4, B4); AB_LOAD(c + 9, A4, B4);
    }
    AB_STEP(30, A0, B0); AB_STEP(31, A1, B1);
    if (!do_store) asm volatile("" :: "v"(acc[0][0]), "v"(acc[0][1]), "v"(acc[1][0]), "v"(acc[1][1]));
#undef AB_LOAD
#undef AB_STEP
}

__device__ __forceinline__ void nscan_task(unsigned char* ws, int t, int lane) {
    const int bh = t >> 2, d = (t & 3) * 64 + lane;
    const float* cs = (const float*)(ws + MS_NST) + (size_t)bh * 32 * 256 + d;
    float* nv = (float*)(ws + MS_NVEC) + (size_t)bh * 32 * 256 + d;
    const int decv = __builtin_bit_cast(int, ((const float*)(ws + MS_DEC))[bh * 32 + (lane & 31)]);
    float v[32];
#pragma unroll
    for (int j = 0; j < 32; ++j) v[j] = cs[j * 256];
    float n = 0.f;
#pragma unroll
    for (int j = 0; j < 32; ++j) { nv[j * 256] = n; n = __builtin_bit_cast(float, __builtin_amdgcn_readlane(decv, j)) * n + v[j]; }
}

__device__ __forceinline__ int rel_bucket_dev(int n) {
    if (n < 16) return n;
    int b = 16;
    b += (n >= 19); b += (n >= 21); b += (n >= 24); b += (n >= 27); b += (n >= 31); b += (n >= 35); b += (n >= 40); b += (n >= 46);
    b += (n >= 52); b += (n >= 59); b += (n >= 67); b += (n >= 77); b += (n >= 87); b += (n >= 99); b += (n >= 113);
    return b;
}
constexpr int AT_KT = 0, AT_VT = 34816, AT_TAB = 71680, AT_SEL = 72704, AT_TILES = 73216, AT_CTL = 73600, AT_KM = 73728;
__device__ __forceinline__ void attn_unit(ArgsP a, LAS unsigned char* lds, int uidx, int tid, int lane, int wave) {
    unsigned char* ws = a->ws;
    const int u256 = uidx & 255, second = uidx >> 8, bh = u256 >> 3, kk8 = u256 & 7, si = second ? 15 - kk8 : kk8, wgt = 16 - si;
    const int blk = (wgt - 1) >> 1, half = (wgt - 1) & 1, b = bh >> 3, h = bh & 7, q0 = blk * 256 + half * 128;
    const int q16 = lane & 15, g = lane >> 4;
    LAS float* tab = (LAS float*)(lds + AT_TAB); LAS unsigned* sels = (LAS unsigned*)(lds + AT_SEL); LAS int* tiles = (LAS int*)(lds + AT_TILES);
    LAS unsigned* ctl = (LAS unsigned*)(lds + AT_CTL); LAS float* kms = (LAS float*)(lds + AT_KM);
    const bf16* QA = (const bf16*)(ws + WS_QA); const bf16* KA = (const bf16*)(ws + WS_KA); const bf16* VAT = (const bf16*)(ws + WS_VAT);
    u32x4 sr[8], qst[4];
    const int row0 = tid >> 4, ch = tid & 15;
    const bf16* kbase = KA + (size_t)(b * SEQ + row0) * 1024 + h * 128 + ch * 8;
    const bf16* vbase = VAT + (size_t)(bh * 128 + row0) * 2048 + ch * 8;
#define AT_LOAD(ks0_) do { _Pragma("unroll") for (int i = 0; i < 4; ++i) { \
        sr[i] = *(const u32x4*)(kbase + (size_t)((ks0_) + 32 * i) * 1024); sr[4 + i] = *(const u32x4*)(vbase + (size_t)(32 * i) * 2048 + (ks0_)); } } while (0)
#pragma unroll
    for (int i = 0; i < 4; ++i) qst[i] = *(const u32x4*)(QA + (size_t)(b * SEQ + q0 + row0 + 32 * i) * 1024 + h * 128 + ch * 8);
    AT_LOAD(blk * 256);
    if (tid <= 128) tab[tid] = a->in[I_RELB][rel_bucket_dev(tid) * 8 + h] * 1.4426950408889634f;
    for (int idx = tid; idx < 1024; idx += NTHR) kms[idx] = ((const float*)(ws + MS_KMEAN))[bh * 1024 + idx];
    if (tid == 0) ctl[0] = 0u;
    __syncthreads();
    {
        const int q = tid >> 2, part = tid & 3;
        const bf16* qp = QA + (size_t)(b * SEQ + q0 + q) * 1024 + h * 128 + part * 32;
        float qf32[32];
#pragma unroll
        for (int i = 0; i < 4; ++i) { const u32x4 v = *(const u32x4*)(qp + 8 * i);
            qf32[8 * i + 0] = bflo(v.x); qf32[8 * i + 1] = bfhi(v.x); qf32[8 * i + 2] = bflo(v.y); qf32[8 * i + 3] = bfhi(v.y);
            qf32[8 * i + 4] = bflo(v.z); qf32[8 * i + 5] = bfhi(v.z); qf32[8 * i + 6] = bflo(v.w); qf32[8 * i + 7] = bfhi(v.w); }
        float gate[8];
#pragma unroll
        for (int n = 0; n < 8; ++n) { float s = 0.f;
            if (n < blk) {
#pragma unroll
                for (int d = 0; d < 32; d += 4) { const f32x4 kv = *(const LAS f32x4*)(kms + n * 128 + part * 32 + d);
                    s += (qf32[d] * kv.x + qf32[d + 1] * kv.y) + (qf32[d + 2] * kv.z + qf32[d + 3] * kv.w); }
            }
            s += __shfl_xor(s, 1); s += __shfl_xor(s, 2); gate[n] = s; }
        if (part == 0) {
            unsigned sel;
            if (blk <= 3) sel = (1u << blk) - 1u;
            else { sel = 0u;
#pragma unroll
                for (int it = 0; it < 3; ++it) { int best = 0; float bv = -3.0e38f;
#pragma unroll
                    for (int n = 0; n < 8; ++n) if (n < blk && !((sel >> n) & 1u) && gate[n] > bv) { bv = gate[n]; best = n; }
                    sel |= 1u << best; } }
            sels[q] = sel; atomicOr((unsigned*)ctl, sel);
        }
    }
    __syncthreads();
    if (tid == 0) { int nt = 0; const unsigned any = ctl[0];
        for (int j = 0; j < half + 1; ++j) tiles[nt++] = blk * 256 + 128 * j;
        for (int n = 0; n < blk; ++n) if ((any >> n) & 1u) for (int j = 0; j < 2; ++j) tiles[nt++] = n * 256 + 128 * j;
        ctl[1] = (unsigned)nt; }
    __syncthreads();
    const int ntiles = (int)ctl[1];
    const int qg = wave & 3, kp = wave >> 2;
    int qpos[2]; unsigned mysel[2];
#pragma unroll
    for (int f = 0; f < 2; ++f) { qpos[f] = q0 + 32 * qg + 16 * f + q16; mysel[f] = sels[32 * qg + 16 * f + q16]; }
    constexpr int AT_Q = 77824;
#pragma unroll
    for (int i = 0; i < 4; ++i) *(LAS u32x4*)(lds + AT_Q + (row0 + 32 * i) * 272 + ch * 16) = qst[i];
    const LAS unsigned char* qrow = lds + AT_Q + (32 * qg + q16) * 272 + 16 * g;
    float m_run[2] = {-1.0e30f, -1.0e30f}, l_run[2] = {0.f, 0.f};
    f32x4 oacc[2][8];
#pragma unroll
    for (int f = 0; f < 2; ++f)
#pragma unroll
        for (int m = 0; m < 8; ++m) oacc[f][m] = (f32x4){0.f, 0.f, 0.f, 0.f};
    const int vpos = (ch >> 2) * 32 + 16 * (ch & 1) + 4 * ((ch & 3) >> 1);
#define AT_WRITE() do { _Pragma("unroll") for (int i = 0; i < 4; ++i) { \
        *(LAS u32x4*)(lds + AT_KT + (row0 + 32 * i) * 272 + ch * 16) = sr[i]; \
        *(LAS u32x2*)(lds + AT_VT + (row0 + 32 * i) * 272 + vpos * 2) = (u32x2){sr[4 + i].x, sr[4 + i].y}; \
        *(LAS u32x2*)(lds + AT_VT + (row0 + 32 * i) * 272 + (vpos + 8) * 2) = (u32x2){sr[4 + i].z, sr[4 + i].w}; } } while (0)
    AT_WRITE();
    __syncthreads();
    if (ntiles > 1) { const int k1 = tiles[1]; AT_LOAD(k1); }
    for (int ti = 0; ti < ntiles; ++ti) {
        const int kstart = tiles[ti] + 64 * kp, nblk = kstart >> 8;
        const bool own = (nblk == blk);
        const bool any_ok = own ? true : (__any((((mysel[0] | mysel[1]) >> nblk) & 1u) != 0u) != 0);
        const bool active = own ? (kstart <= q0 + 32 * qg + 31) : any_ok;
        if (active) {
            const LAS unsigned char* kt = lds + AT_KT + 64 * kp * 272; const LAS unsigned char* vt = lds + AT_VT + 64 * kp * 2;
            f32x4 s[2][4];
#pragma unroll
            for (int n = 0; n < 4; ++n) { s[0][n] = (f32x4){0.f, 0.f, 0.f, 0.f}; s[1][n] = s[0][n]; }
#pragma unroll
            for (int ks = 0; ks < 4; ++ks) {
                bf16x8 q0f = *(const LAS bf16x8*)(qrow + 64 * ks), q1f = *(const LAS bf16x8*)(qrow + 16 * 272 + 64 * ks);
                bf16x8 kf[4];
#pragma unroll
                for (int n = 0; n < 4; ++n) kf[n] = *(const LAS bf16x8*)(kt + (16 * n + q16) * 272 + (32 * ks + 8 * g) * 2);
                asm volatile("" : "+v"(q0f), "+v"(q1f), "+v"(kf[0]), "+v"(kf[1]), "+v"(kf[2]), "+v"(kf[3]));
#pragma unroll
                for (int n = 0; n < 4; ++n) {
                    s[0][n] = __builtin_amdgcn_mfma_f32_16x16x32_bf16(kf[n], q0f, s[0][n], 0, 0, 0);
                    s[1][n] = __builtin_amdgcn_mfma_f32_16x16x32_bf16(kf[n], q1f, s[1][n], 0, 0, 0); } }
            const bool far = ((q0 + 32 * qg) - (kstart + 63)) >= 128;
            const float bfar = tab[128];
#pragma unroll
            for (int f = 0; f < 2; ++f) {
                const bool lane_ok = own ? true : (((mysel[f] >> nblk) & 1u) != 0u);
                float psum = 0.f, m_new;
#define AT_MNEW(mx_) fmaxf(((mx_) > m_run[f] + 8.0f) ? (mx_) : m_run[f], -1.0e29f)
                if (far) {
                    const float addc = lane_ok ? bfar : -1.0e30f;
                    float mx = -1.0e30f;
#pragma unroll
                    for (int n = 0; n < 4; ++n)
#pragma unroll
                        for (int r = 0; r < 4; ++r) mx = fmaxf(mx, s[f][n][r]);
                    mx = rows4_max(mx + addc);
                    m_new = AT_MNEW(mx);
                    const float cc = addc - m_new;
#pragma unroll
                    for (int n = 0; n < 4; ++n)
#pragma unroll
                        for (int r = 0; r < 4; ++r) { const float p = __builtin_amdgcn_exp2f(s[f][n][r] + cc); s[f][n][r] = p; psum += p; }
                } else {
                    const int kmax = lane_ok ? (own ? qpos[f] : 0x7fffffff) : -1;
                    float mx = -1.0e30f;
                    float bs[4][4];
#pragma unroll
                    for (int n = 0; n < 4; ++n)
#pragma unroll
                        for (int r = 0; r < 4; ++r) { int di = qpos[f] - (kstart + 16 * n + 4 * g + r); di = di < 0 ? 0 : di; di = di > 128 ? 128 : di; bs[n][r] = tab[di]; }
#pragma unroll
                    for (int n = 0; n < 4; ++n) asm volatile("" : "+v"(bs[n][0]), "+v"(bs[n][1]), "+v"(bs[n][2]), "+v"(bs[n][3]));
#pragma unroll
                    for (int n = 0; n < 4; ++n)
#pragma unroll
                        for (int r = 0; r < 4; ++r) { const int key = kstart + 16 * n + 4 * g + r;
                            const float v = (key <= kmax) ? s[f][n][r] + bs[n][r] : -1.0e30f;
                            s[f][n][r] = v; mx = fmaxf(mx, v); }
                    mx = rows4_max(mx);
                    m_new = AT_MNEW(mx);
#pragma unroll
                    for (int n = 0; n < 4; ++n)
#pragma unroll
                        for (int r = 0; r < 4; ++r) { const float p = __builtin_amdgcn_exp2f(s[f][n][r] - m_new); s[f][n][r] = p; psum += p; }
                }
#undef AT_MNEW
                const float alpha = __builtin_amdgcn_exp2f(m_run[f] - m_new);
                psum = rows4_sum(psum);
                l_run[f] = l_run[f] * alpha + psum;
                if (__any(m_new != m_run[f])) {
#pragma unroll
                    for (int m = 0; m < 8; ++m) oacc[f][m] = oacc[f][m] * alpha;
                }
                m_run[f] = m_new;
            }
#pragma unroll
            for (int k2 = 0; k2 < 2; ++k2) {
                bf16x8 pf[2];
#pragma unroll
                for (int f = 0; f < 2; ++f) { u32x4 pb; pb.x = cvt_pk_bf16(s[f][2 * k2][0], s[f][2 * k2][1]); pb.y = cvt_pk_bf16(s[f][2 * k2][2], s[f][2 * k2][3]);
                    pb.z = cvt_pk_bf16(s[f][2 * k2 + 1][0], s[f][2 * k2 + 1][1]); pb.w = cvt_pk_bf16(s[f][2 * k2 + 1][2], s[f][2 * k2 + 1][3]);
                    pf[f] = __builtin_bit_cast(bf16x8, pb); }
#pragma unroll
                for (int mh = 0; mh < 2; ++mh) {
                    bf16x8 af[4];
#pragma unroll
                    for (int m = 0; m < 4; ++m) af[m] = *(const LAS bf16x8*)(vt + (16 * (4 * mh + m) + q16) * 272 + (32 * k2 + 8 * g) * 2);
                    asm volatile("" : "+v"(af[0]), "+v"(af[1]), "+v"(af[2]), "+v"(af[3]));
#pragma unroll
                    for (int m = 0; m < 4; ++m) {
                        oacc[0][4 * mh + m] = __builtin_amdgcn_mfma_f32_16x16x32_bf16(af[m], pf[0], oacc[0][4 * mh + m], 0, 0, 0);
                        oacc[1][4 * mh + m] = __builtin_amdgcn_mfma_f32_16x16x32_bf16(af[m], pf[1], oacc[1][4 * mh + m], 0, 0, 0); } }
            }
        }
        __syncthreads();
        if (ti + 1 < ntiles) { AT_WRITE(); }
        __syncthreads();
        if (ti + 2 < ntiles) { const int kn = tiles[ti + 2]; AT_LOAD(kn); }
    }
    LAS float* mo = (LAS float*)lds; LAS float* ml = (LAS float*)(lds + 65536);
    if (kp == 1) {
#pragma unroll
        for (int f = 0; f < 2; ++f) {
#pragma unroll
            for (int m = 0; m < 8; ++m)
#pragma unroll
                for (int r = 0; r < 4; ++r) mo[((qg * 2 + f) * 8 + m) * 256 + r * 64 + lane] = oacc[f][m][r];
            ml[(qg * 2 + f) * 128 + lane] = m_run[f]; ml[(qg * 2 + f) * 128 + 64 + lane] = l_run[f]; }
    }
    __syncthreads();
    if (kp == 0) {
#pragma unroll
        for (int f = 0; f < 2; ++f) {
            const float m1 = ml[(qg * 2 + f) * 128 + lane], l1 = ml[(qg * 2 + f) * 128 + 64 + lane];
            const float mm = fmaxf(m_run[f], m1), a0 = __builtin_amdgcn_exp2f(m_run[f] - mm), a1 = __builtin_amdgcn_exp2f(m1 - mm);
            const float inv = __builtin_amdgcn_rcpf(l_run[f] * a0 + l1 * a1);
            bf16* HA = (bf16*)(ws + WS_HA) + (size_t)(b * SEQ + qpos[f]) * 1024 + h * 128 + 4 * g;
#pragma unroll
            for (int m = 0; m < 8; ++m) { float o[4];
#pragma unroll
                for (int r = 0; r < 4; ++r) o[r] = (oacc[f][m][r] * a0 + mo[((qg * 2 + f) * 8 + m) * 256 + r * 64 + lane] * a1) * inv;
                u32x2 w; w.x = cvt_pk_bf16(o[0], o[1]); w.y = cvt_pk_bf16(o[2], o[3]); *(u32x2*)(HA + 16 * m) = w; }
        }
    }
#undef AT_LOAD
#undef AT_WRITE
}

constexpr int MC_Q = 0, MC_K = 33792, MC_SP = 67584, MC_SC = 76800, MC_NV = 79104;
struct McRegs { u32x4 qr[4], kr[4]; float sc4[4]; float nv0; bf16x8 cb[8][2], vbf[2][2]; u32x2 ovv[8]; };
__device__ __forceinline__ void mc_load_qk(McRegs& R, const unsigned char* ws, int u, int tid) {
    const int bh = u >> 5, c = u & 31, b = bh >> 2, h = bh & 3; const size_t tok0 = (size_t)b * SEQ + 64 * c;
    const bf16* QM = (const bf16*)(ws + WS_QM); const bf16* KM = (const bf16*)(ws + WS_KM);
#pragma unroll
    for (int i = 0; i < 4; ++i) { const int idx = tid + NTHR * i, row = idx >> 5, ch = idx & 31;
        R.qr[i] = *(const u32x4*)(QM + (tok0 + row) * 1024 + h * 256 + ch * 8); R.kr[i] = *(const u32x4*)(KM + (tok0 + row) * 1024 + h * 256 + ch * 8); }
}
__device__ __forceinline__ void mc_load_sc(McRegs& R, const unsigned char* ws, int u, int tid) {
    const int bh = u >> 5, c = u & 31; const int s = bh * 2048 + 64 * c + (tid & 63);
    R.sc4[0] = ((const float*)(ws + MS_AS))[s]; R.sc4[1] = ((const float*)(ws + MS_GT))[s]; R.sc4[2] = ((const float*)(ws + MS_WI))[s]; R.sc4[3] = ((const float*)(ws + MS_CL))[s];
    R.nv0 = ((const float*)(ws + MS_NVEC))[(size_t)(bh * 32 + c) * 256 + (tid & 255)];
}
__device__ __forceinline__ void mc_load_cb(McRegs& R, const unsigned char* ws, int u, int lane, int wave) {
    const bf16* Cp = (const bf16*)(ws + WS_CST) + (size_t)u * 65536 + (size_t)(2 * wave) * 512 + lane * 8;
#pragma unroll
    for (int ks = 0; ks < 8; ++ks) { R.cb[ks][0] = *(const bf16x8*)(Cp + ks * 8192); R.cb[ks][1] = *(const bf16x8*)(Cp + ks * 8192 + 512); }
}
__device__ __forceinline__ void mc_load_v(McRegs& R, const unsigned char* ws, int u, int lane, int wave) {
    const bf16* Vp = (const bf16*)(ws + WS_VMT) + (size_t)u * 16384 + (size_t)(2 * wave) * 512 + lane * 8;
#pragma unroll
    for (int ks = 0; ks < 2; ++ks) { R.vbf[ks][0] = *(const bf16x8*)(Vp + ks * 8192); R.vbf[ks][1] = *(const bf16x8*)(Vp + ks * 8192 + 512); }
}
__device__ __forceinline__ void mc_load_ov(McRegs& R, const unsigned char* ws, int u, int lane, int wave) {
    const int bh = u >> 5, c = u & 31, b = bh >> 2, h = bh & 3; const size_t tok0 = (size_t)b * SEQ + 64 * c;
    const bf16* OM = (const bf16*)(ws + WS_OM);
#pragma unroll
    for (int i = 0; i < 8; ++i) R.ovv[i] = *(const u32x2*)(OM + (tok0 + 8 * wave + i) * 1024 + h * 256 + 4 * lane);
}
template <bool PF, bool HAVE>
__device__ __forceinline__ void mlstm_c_body(ArgsP a, int l, LAS unsigned char* lds, int u, int un, McRegs& R, int tid_, int lane_, int wave) {
    unsigned char* ws = a->ws;
    int tid = wave * 64 + lane_id(); asm volatile("" : "+v"(tid));
    const int lane = tid & 63; (void)tid_; (void)lane_;
    const int bh = u >> 5, c = u & 31, b = bh >> 2, h = bh & 3, t0 = 64 * c, q16 = lane & 15, g = lane >> 4;
    const size_t tok0 = (size_t)b * SEQ + t0;
    LAS unsigned char* Qs = lds + MC_Q; LAS unsigned char* Ks = lds + MC_K; LAS unsigned char* Sp = lds + MC_SP;
    LAS float* sc = (LAS float*)(lds + MC_SC); LAS float* as_ = sc; LAS float* gt_ = sc + 64; LAS float* wi_ = sc + 128; LAS float* cl_ = sc + 192; LAS float* qn_ = sc + 256; LAS float* denp = sc + 320;
    LAS float* nvec = (LAS float*)(lds + MC_NV);
    mc_load_qk(R, ws, u, tid); mc_load_sc(R, ws, u, tid);
    if (!HAVE) mc_load_cb(R, ws, u, lane, wave);
#pragma unroll
    for (int i = 0; i < 4; ++i) { const int idx = tid + NTHR * i, row = idx >> 5, ch = idx & 31;
        *(LAS u32x4*)(Qs + row * 528 + ch * 16) = R.qr[i]; *(LAS u32x4*)(Ks + row * 528 + ch * 16) = R.kr[i]; }
    mc_load_v(R, ws, u, lane, wave);
    if (tid < 64) { as_[tid] = R.sc4[0]; gt_[tid] = R.sc4[1]; wi_[tid] = R.sc4[2]; cl_[tid] = R.sc4[3]; }
    if (tid < 256) nvec[tid] = R.nv0;
    __syncthreads();
    f32x4 acc[4][2];
#pragma unroll
    for (int m = 0; m < 4; ++m) { acc[m][0] = (f32x4){0.f, 0.f, 0.f, 0.f}; acc[m][1] = acc[m][0]; }
    if (c > 0) {
#pragma unroll
        for (int ks = 0; ks < 8; ++ks) {
#pragma unroll
            for (int m = 0; m < 4; ++m) { const bf16x8 af = *(const LAS bf16x8*)(Qs + (16 * m + q16) * 528 + (32 * ks + 8 * g) * 2);
                acc[m][0] = __builtin_amdgcn_mfma_f32_16x16x32_bf16(af, R.cb[ks][0], acc[m][0], 0, 0, 0);
                acc[m][1] = __builtin_amdgcn_mfma_f32_16x16x32_bf16(af, R.cb[ks][1], acc[m][1], 0, 0, 0); }
        }
#pragma unroll
        for (int m = 0; m < 4; ++m)
#pragma unroll
            for (int r = 0; r < 4; ++r) { const float w = wi_[16 * m + 4 * g + r]; acc[m][0][r] *= w; acc[m][1][r] *= w; }
    }
    {
        const int mS = wave & 3, nS0 = 2 * (wave >> 2);
        f32x4 sacc[2]; sacc[0] = (f32x4){0.f, 0.f, 0.f, 0.f}; sacc[1] = sacc[0];
#pragma unroll
        for (int kh = 0; kh < 4; ++kh) {
            bf16x8 af[2], bq[2][2];
#pragma unroll
            for (int k2 = 0; k2 < 2; ++k2) { const int ks = 2 * kh + k2;
                af[k2] = *(const LAS bf16x8*)(Qs + (16 * mS + q16) * 528 + (32 * ks + 8 * g) * 2);
#pragma unroll
                for (int nn = 0; nn < 2; ++nn) bq[k2][nn] = *(const LAS bf16x8*)(Ks + (16 * (nS0 + nn) + q16) * 528 + (32 * ks + 8 * g) * 2); }
            asm volatile("" : "+v"(af[0]), "+v"(af[1]), "+v"(bq[0][0]), "+v"(bq[0][1]), "+v"(bq[1][0]), "+v"(bq[1][1]));
#pragma unroll
            for (int k2 = 0; k2 < 2; ++k2)
#pragma unroll
                for (int nn = 0; nn < 2; ++nn) sacc[nn] = __builtin_amdgcn_mfma_f32_16x16x32_bf16(af[k2], bq[k2][nn], sacc[nn], 0, 0, 0);
        }
#pragma unroll
        for (int nn = 0; nn < 2; ++nn) { const int s = 16 * (nS0 + nn) + q16; const float av = as_[s];
#pragma unroll
            for (int r = 0; r < 4; ++r) { const int t = 16 * mS + 4 * g + r;
                float val = (s <= t) ? sacc[nn][r] * __expf(av - gt_[t]) : 0.f;
                *(LAS unsigned short*)(Sp + t * 144 + s * 2) = (unsigned short)(cvt_pk_bf16(val, val) & 0xffffu);
                val += __shfl_xor(val, 1); val += __shfl_xor(val, 2); val += __shfl_xor(val, 4); val += __shfl_xor(val, 8);
                if (q16 == 0) denp[(nS0 + nn) * 64 + t] = val; } }
    }
    {
        const int t = tid >> 3, seg = tid & 7; float s = 0.f;
#pragma unroll
        for (int i = 0; i < 4; ++i) { const u32x4 v = *(const LAS u32x4*)(Qs + t * 528 + (seg * 32 + 8 * i) * 2); const LAS float* nv = nvec + seg * 32 + 8 * i;
            s += bflo(v.x) * nv[0] + bfhi(v.x) * nv[1] + bflo(v.y) * nv[2] + bfhi(v.y) * nv[3] + bflo(v.z) * nv[4] + bfhi(v.z) * nv[5] + bflo(v.w) * nv[6] + bfhi(v.w) * nv[7]; }
        s += __shfl_xor(s, 1); s += __shfl_xor(s, 2); s += __shfl_xor(s, 4);
        if (seg == 0) qn_[t] = s;
    }
    __syncthreads();
    if (PF) {
#pragma unroll
        for (int ks = 0; ks < 8; ++ks) asm volatile("" :: "v"(R.cb[ks][0]), "v"(R.cb[ks][1]));
        __builtin_amdgcn_sched_barrier(0);
        mc_load_cb(R, ws, un, lane, wave);
        __builtin_amdgcn_sched_barrier(0);
    }
    {
#pragma unroll
        for (int ks = 0; ks < 2; ++ks) {
            bf16x8 sf[4];
#pragma unroll
            for (int m = 0; m < 4; ++m) sf[m] = *(const LAS bf16x8*)(Sp + (16 * m + q16) * 144 + (32 * ks + 8 * g) * 2);
            asm volatile("" : "+v"(sf[0]), "+v"(sf[1]), "+v"(sf[2]), "+v"(sf[3]));
#pragma unroll
            for (int m = 0; m < 4; ++m) {
                acc[m][0] = __builtin_amdgcn_mfma_f32_16x16x32_bf16(sf[m], R.vbf[ks][0], acc[m][0], 0, 0, 0);
                acc[m][1] = __builtin_amdgcn_mfma_f32_16x16x32_bf16(sf[m], R.vbf[ks][1], acc[m][1], 0, 0, 0); }
        }
    }
    LAS float* NUM = (LAS float*)lds;
#pragma unroll
    for (int m = 0; m < 4; ++m)
#pragma unroll
        for (int r = 0; r < 4; ++r) { const int t = 16 * m + 4 * g + r;
            const float den = (denp[t] + denp[64 + t]) + (denp[128 + t] + denp[192 + t]) + wi_[t] * qn_[t];
            const float inv = __builtin_amdgcn_rcpf(fmaxf(fabsf(den), cl_[t]));
            NUM[t * 260 + 32 * wave + q16] = acc[m][0][r] * inv; NUM[t * 260 + 32 * wave + 16 + q16] = acc[m][1][r] * inv; }
    __syncthreads();
    {
        const float* mg = a->in[I_MNG] + l * 1024 + h * 256 + 4 * lane; const f32x4 gn = *(const f32x4*)mg;
        bf16* HM = (bf16*)(ws + WS_HM);
        mc_load_ov(R, ws, u, lane, wave);
        asm volatile("" : "+v"(R.ovv[0]), "+v"(R.ovv[1]), "+v"(R.ovv[2]), "+v"(R.ovv[3]), "+v"(R.ovv[4]), "+v"(R.ovv[5]), "+v"(R.ovv[6]), "+v"(R.ovv[7]));
#pragma unroll
        for (int i = 0; i < 8; ++i) { const int t = 8 * wave + i;
            const f32x4 v = *(const LAS f32x4*)(NUM + t * 260 + 4 * lane);
            const float mu = wave_sum((v.x + v.y) + (v.z + v.w)) * (1.0f / 256.0f);
            const f32x4 d = v - mu;
            const float var = wave_sum((d.x * d.x + d.y * d.y) + (d.z * d.z + d.w * d.w)) * (1.0f / 256.0f);
            const float rstd = __builtin_amdgcn_rsqf(var + LN_EPS);
            const u32x2 ov = R.ovv[i];
            u32x2 w; w.x = cvt_pk_bf16(d.x * rstd * gn.x * bflo(ov.x), d.y * rstd * gn.y * bfhi(ov.x)); w.y = cvt_pk_bf16(d.z * rstd * gn.z * bflo(ov.y), d.w * rstd * gn.w * bfhi(ov.y));
            *(u32x2*)(HM + (tok0 + t) * 1024 + h * 256 + 4 * lane) = w; }
    }
    __syncthreads();
}
__device__ __forceinline__ void mlstm_c_phase(ArgsP a, int l, LAS unsigned char* lds, int tid, int lane, int wave, int bid, int G) {
    int u = bid; if (u >= 512) return;
    McRegs R;
    if (u + G < 512 && u + 2 * G >= 512) {
        mlstm_c_body<true, false>(a, l, lds, u, u + G, R, tid, lane, wave);
        mlstm_c_body<false, true>(a, l, lds, u + G, u + G, R, tid, lane, wave);
    } else {
#pragma unroll 1
        for (; u < 512; u += G) mlstm_c_body<false, false>(a, l, lds, u, u, R, tid, lane, wave);
    }
}

struct SchedStd {
    static constexpr bool GATHER = false;
    const char* A; const char* B; int nM, nN, K, G, c;
    __device__ __forceinline__ bool next(int i, Unit& u) const { const int L = i * G + c; if (L >= nM * nN) return false; pg8::static_tile(L, nM, nN, u.pm, u.pn); u.aux = 0; return true; }
    __device__ __forceinline__ const char* abase(const Unit& u) const { return A + (size_t)u.pm * 512 * K; }
    __device__ __forceinline__ const char* bbase(const Unit& u) const { return B + (size_t)u.pn * 512 * K; }
    __device__ __forceinline__ unsigned arow(const Unit&, int) const { return 0u; }
    static __device__ __forceinline__ bool keep_acc(const Unit&) { return false; }
};
struct SchedBr {
    static constexpr bool GATHER = false;
    const char* HM; const char* HA; const char* WM; const char* WA; int G, c;
    __device__ __forceinline__ bool next(int i, Unit& u) const { const int L = (i >> 1) * G + c; if (L >= 256) return false; pg8::static_tile(L, 32, 8, u.pm, u.pn); u.aux = i & 1; return true; }
    __device__ __forceinline__ const char* abase(const Unit& u) const { return (u.aux ? HA : HM) + (size_t)u.pm * 512 * 1024; }
    __device__ __forceinline__ const char* bbase(const Unit& u) const { return (u.aux ? WA : WM) + (size_t)u.pn * 512 * 1024; }
    __device__ __forceinline__ unsigned arow(const Unit&, int) const { return 0u; }
    static __device__ __forceinline__ bool keep_acc(const Unit& u) { return u.aux == 0; }
};
struct EpiBr {
    static constexpr bool PERM = true;
    const bf16* SG; bf16* Y;
    __device__ __forceinline__ void operator()(f32x4 (&acc)[2][2][4][2], const Unit& u, int wr, int wc, int fr, int fq) const {
        const int row0 = u.pm * 256 + wr * 64 + fr, col0 = u.pn * 256 + wc * 32 + 8 * fq;
#pragma unroll
        for (int ai = 0; ai < 2; ++ai) {
            u32x4 sa[4][2], sm[4][2];
#pragma unroll
            for (int m = 0; m < 4; ++m) { const size_t row = row0 + ai * 128 + m * 16;
#pragma unroll
                for (int bj = 0; bj < 2; ++bj) { const int col = col0 + bj * 128;
                    sa[m][bj] = *(const u32x4*)(SG + row * 4096 + 2048 + col);
                    sm[m][bj] = *(const u32x4*)(SG + row * 4096 + (u.aux == 0 ? 0 : 2048) + col); } }
            asm volatile("" : "+v"(sa[0][0]), "+v"(sa[0][1]), "+v"(sa[1][0]), "+v"(sa[1][1]), "+v"(sa[2][0]), "+v"(sa[2][1]), "+v"(sa[3][0]), "+v"(sa[3][1]),
                              "+v"(sm[0][0]), "+v"(sm[0][1]), "+v"(sm[1][0]), "+v"(sm[1][1]), "+v"(sm[2][0]), "+v"(sm[2][1]), "+v"(sm[3][0]), "+v"(sm[3][1]));
#pragma unroll
            for (int m = 0; m < 4; ++m) { const size_t row = row0 + ai * 128 + m * 16;
#pragma unroll
                for (int bj = 0; bj < 2; ++bj) { const int col = col0 + bj * 128;
                    const u32x4 a4 = sa[m][bj], m4 = sm[m][bj];
                    const float ga[8] = {bflo(a4.x), bfhi(a4.x), bflo(a4.y), bfhi(a4.y), bflo(a4.z), bfhi(a4.z), bflo(a4.w), bfhi(a4.w)};
                    if (u.aux == 0) {
                        const float gm[8] = {bflo(m4.x), bfhi(m4.x), bflo(m4.y), bfhi(m4.y), bflo(m4.z), bfhi(m4.z), bflo(m4.w), bfhi(m4.w)};
#pragma unroll
                        for (int j = 0; j < 4; ++j) { acc[ai][bj][m][0][j] *= gm[j] * __builtin_amdgcn_rcpf(fmaxf(ga[j], 1.0e-30f)); acc[ai][bj][m][1][j] *= gm[4 + j] * __builtin_amdgcn_rcpf(fmaxf(ga[4 + j], 1.0e-30f)); }
                    } else {
                        const f32x4 v0 = acc[ai][bj][m][0], v1 = acc[ai][bj][m][1];
                        u32x4 w; w.x = cvt_pk_bf16(v0[0] * ga[0], v0[1] * ga[1]); w.y = cvt_pk_bf16(v0[2] * ga[2], v0[3] * ga[3]);
                        w.z = cvt_pk_bf16(v1[0] * ga[4], v1[1] * ga[5]); w.w = cvt_pk_bf16(v1[2] * ga[6], v1[3] * ga[7]);
                        *(u32x4*)(Y + row * 2048 + col) = w; }
                } }
        }
    }
};
struct EpiOut {
    static constexpr bool PERM = false;
    const float* res; float* out;
    __device__ __forceinline__ void operator()(f32x4 (&acc)[2][2][4][2], const Unit& u, int wr, int wc, int fr, int fq) const {
        const int row0 = u.pm * 256 + wr * 64 + fr, col0 = u.pn * 256 + wc * 32 + 4 * fq;
#pragma unroll
        for (int ai = 0; ai < 2; ++ai) {
            f32x4 rv[4][2][2];
#pragma unroll
            for (int m = 0; m < 4; ++m) { const size_t ro = (size_t)(row0 + ai * 128 + m * 16) * DM + col0;
#pragma unroll
                for (int bj = 0; bj < 2; ++bj)
#pragma unroll
                    for (int n = 0; n < 2; ++n) rv[m][bj][n] = *(const f32x4*)(res + ro + bj * 128 + n * 16); }
#pragma unroll
            for (int m = 0; m < 4; ++m) asm volatile("" : "+v"(rv[m][0][0]), "+v"(rv[m][0][1]), "+v"(rv[m][1][0]), "+v"(rv[m][1][1]));
#pragma unroll
            for (int m = 0; m < 4; ++m) { const size_t ro = (size_t)(row0 + ai * 128 + m * 16) * DM + col0;
#pragma unroll
                for (int bj = 0; bj < 2; ++bj)
#pragma unroll
                    for (int n = 0; n < 2; ++n) *(f32x4*)(out + ro + bj * 128 + n * 16) = rv[m][bj][n] + acc[ai][bj][m][n]; }
        }
    }
};
struct SchedMoe1 {
    static constexpr bool GATHER = true;
    const char* H; const char* W13; const int* LIST; const LAS int* te; const LAS int* tr0; const LAS int* cnt; int MT, G, c;
    __device__ __forceinline__ bool next(int i, Unit& u) const { const int L = i * G + c; if (L >= 2 * MT) return false; u.pm = L >> 1; u.pn = L & 1; u.aux = __builtin_amdgcn_readfirstlane(te[u.pm]); return true; }
    __device__ __forceinline__ const char* abase(const Unit&) const { return H; }
    __device__ __forceinline__ const char* bbase(const Unit& u) const { return W13 + ((size_t)u.aux * 512 + u.pn * 256) * 4096; }
    static __device__ __forceinline__ bool keep_acc(const Unit&) { return false; }
    __device__ __forceinline__ unsigned arow(const Unit& u, int r) const { const int rr = __builtin_amdgcn_readfirstlane(tr0[u.pm]) + r; return rr < __builtin_amdgcn_readfirstlane(cnt[u.aux]) ? (unsigned)LIST[u.aux * 8192 + rr] : 0u; }
};
struct EpiMoe1 {
    static constexpr bool PERM = true;
    bf16* HID; const float* PWL; const LAS int* tr0; const LAS int* cnt;
    __device__ __forceinline__ void operator()(f32x4 (&acc)[2][2][4][2], const Unit& u, int wr, int wc, int fr, int fq) const {
#pragma unroll
        for (int ai = 0; ai < 2; ++ai)
#pragma unroll
            for (int m = 0; m < 4; ++m) { const int r = ai * 128 + wr * 64 + m * 16 + fr;
                const float pw = 1.0f;
                float o[8];
#pragma unroll
                for (int n = 0; n < 2; ++n)
#pragma unroll
                    for (int j = 0; j < 4; ++j) { const float x1 = acc[ai][0][m][n][j], x3 = acc[ai][1][m][n][j]; o[4 * n + j] = x1 * sigmoidf_(x1) * x3 * pw; }
                u32x4 w; w.x = cvt_pk_bf16(o[0], o[1]); w.y = cvt_pk_bf16(o[2], o[3]); w.z = cvt_pk_bf16(o[4], o[5]); w.w = cvt_pk_bf16(o[6], o[7]);
                *(u32x4*)(HID + (size_t)(u.pm * 256 + r) * 256 + u.pn * 128 + wc * 32 + 8 * fq) = w; }
    }
};
struct SchedMoe2 {
    static constexpr bool GATHER = false;
    const char* HID; const char* W2; const LAS int* te; int MT, G, c;
    __device__ __forceinline__ bool next(int i, Unit& u) const { const int L = i * G + c; if (L >= 8 * MT) return false; u.pm = L >> 3; u.pn = L & 7; u.aux = __builtin_amdgcn_readfirstlane(te[u.pm]); return true; }
    __device__ __forceinline__ const char* abase(const Unit& u) const { return HID + (size_t)u.pm * 256 * 512; }
    __device__ __forceinline__ const char* bbase(const Unit& u) const { return W2 + ((size_t)u.aux * 2048 + u.pn * 256) * 512; }
    __device__ __forceinline__ unsigned arow(const Unit&, int) const { return 0u; }
    static __device__ __forceinline__ bool keep_acc(const Unit&) { return false; }
};
struct EpiMoe2 {
    static constexpr bool PERM = true;
    bf16* OP;
    __device__ __forceinline__ void operator()(f32x4 (&acc)[2][2][4][2], const Unit& u, int wr, int wc, int fr, int fq) const {
        const int row0 = u.pm * 256 + wr * 64 + fr, col0 = u.pn * 256 + wc * 32 + 8 * fq;
#pragma unroll
        for (int ai = 0; ai < 2; ++ai)
#pragma unroll
            for (int m = 0; m < 4; ++m) { bf16* rowp = OP + (size_t)(row0 + ai * 128 + m * 16) * DM + col0;
#pragma unroll
                for (int bj = 0; bj < 2; ++bj) { const f32x4 v0 = acc[ai][bj][m][0], v1 = acc[ai][bj][m][1];
                    u32x4 w; w.x = cvt_pk_bf16(v0[0], v0[1]); w.y = cvt_pk_bf16(v0[2], v0[3]); w.z = cvt_pk_bf16(v1[0], v1[1]); w.w = cvt_pk_bf16(v1[2], v1[3]);
                    *(u32x4*)(rowp + bj * 128) = w; } }
    }
};

constexpr int N_PHASES = 22;
__global__ void __launch_bounds__(NTHR, 2) fwd_kernel(Args a) {
    extern __shared__ __attribute__((aligned(16))) unsigned char lds_raw[];
    LAS unsigned char* lds0 = (LAS unsigned char*)lds_raw;
    const int tid0 = threadIdx.x, bid0 = blockIdx.x, G0 = gridDim.x;
    const int wave0 = __builtin_amdgcn_readfirstlane(tid0 >> 6);
#define PH_IDS() ArgsP ap = (ArgsP)__builtin_amdgcn_kernarg_segment_ptr(); asm volatile("" : "+s"(ap)); unsigned lb_ = 0u; asm volatile("" : "+s"(lb_)); LAS unsigned char* lds = lds0 + lb_; LAS unsigned char* misc = lds + MISC_OFF; (void)misc; unsigned char* ws = ap->ws; (void)ws; int bid = bid0, G = G0, wave = wave0; asm volatile("" : "+s"(bid), "+s"(G), "+s"(wave)); int tid = wave * 64 + lane_id(); asm volatile("" : "+v"(tid)); const int lane = tid & 63; (void)lane; (void)wave
    if (tid0 < 4) ((LAS unsigned*)(lds0 + MISC_OFF + MO_BAR))[tid0] = 0u;
    __syncthreads();
#if MK_LAUNCHES == 1
    XcdBarrier bar = xcd_barrier_post((unsigned*)(a.ws + WS_CTL) + CW_BAR, (volatile LAS unsigned*)(lds0 + MISC_OFF + MO_BAR));
#define GRID_BAR() xcd_barrier(bar)
#else
#define GRID_BAR() do { } while (0)
#endif
    const int lo = a.ph_lo, hi = a.ph_hi;
#ifndef PHMASK
#define PHMASK 0xFFFu
#endif
#define IN(k) (lo <= (k) && (k) < hi)
#define EN(b) ((PHMASK >> (b)) & 1u)
#ifndef DBLMASK
#define DBLMASK 0u
#endif
#define REP(b) _Pragma("unroll 1") for (int rep_ = 0; rep_ < (((DBLMASK >> (b)) & 1u) ? 2 : 1); ++rep_)
#define SEAM(k) do { if (IN(k) && IN((k) + 1)) { GRID_BAR(); if ((DBLMASK >> 12) & 1u) GRID_BAR(); } } while (0)

    if (EN(0) && IN(0)) { REP(0) { PH_IDS(); prologue_phase(ap, lds, tid, lane, wave, bid, G); __syncthreads(); }
#ifndef NO_NORM0
        { PH_IDS(); norm_phase<0>(ap, 0, lds, tid, lane, wave, bid, G); }
#endif
    }
    SEAM(0);
#pragma unroll 1
    for (int l = 0; l < 2; ++l) {
        const int pb = 1 + 10 * l;
        if (EN(1) && IN(pb + 0) && l == 1) { if ((DBLMASK >> 18) & 1u) { PH_IDS(); norm_phase<1>(ap, l, lds, tid, lane, wave, bid, G, true); } PH_IDS(); norm_phase<1>(ap, l, lds, tid, lane, wave, bid, G); }
        if (l == 1) SEAM(pb + 0);
        if (EN(2) && IN(pb + 1)) REP(2) { PH_IDS(); (void)tid;
#ifdef STAG
            for (int i = 0; i < ((bid >> 3) & 7); ++i) __builtin_amdgcn_s_sleep(STAG);
#endif
            SchedG1 S{(const char*)(ws + WS_H), (const char*)(ws + WS_WINT) + (size_t)l * 11264 * 4096, G, bid};
            EpiG1 E{ws, ((DBLMASK >> 21) & 1u) && rep_ == 1};
            pg8::gemm_phase<EpiG1, SchedG1>(lds, 2048, S, E, wave);
            for (int bh = G - 1 - bid; bh < 16; bh += G) gate_unit(ap, l, lds, bh, tid, tid & 63, wave);
            __syncthreads();
            if (G == 256 && bid >= 256 - SchedG1::NCV) prologue_phase(ap, lds, tid, tid & 63, wave, bid - (256 - SchedG1::NCV), SchedG1::NCV, 2 + l);
            else if (G != 256) prologue_phase(ap, lds, tid, tid & 63, wave, bid, G, 2 + l);
        }
        SEAM(pb + 1);
        if (EN(3) && IN(pb + 2)) REP(3) { PH_IDS(); conv_phase(ap, l, lds, tid, lane, wave, bid, G); }
        SEAM(pb + 2);
        if (EN(4) && IN(pb + 3)) REP(4) { PH_IDS();
            const int vb = (G % 8 == 0) ? (bid & 7) * (G >> 3) + (bid >> 3) : bid;
            REP(13) { if (wave < 4) for (int gw = vb * 4 + wave; gw < 1024; gw += G * 4) mlstm_ab_task(ws, gw, lane, rep_ == 0 || !((DBLMASK >> 15) & 1u)); }
            if (wave == 4) for (int t = vb; t < 64; t += G) nscan_task(ws, t, lane);
            if (l == 0 && wave >= 4) prologue_phase(ap, lds, tid, lane, wave, bid, G, 6, bid * 4 + (wave - 4), G * 4);
            __syncthreads();
            REP(14) { for (int u = vb; u < 512; u += G) { attn_unit(ap, lds, u, tid, lane, wave); __syncthreads(); if (((DBLMASK >> 16) & 1u) && u < 256) GRID_BAR(); } }
        }
        SEAM(pb + 3);
        if (EN(5) && IN(pb + 4)) REP(5) { PH_IDS(); mlstm_c_phase(ap, l, lds, tid, lane, wave, bid, G); }
        SEAM(pb + 4);
        if (EN(6) && IN(pb + 5)) REP(6) { PH_IDS(); (void)tid;
            SchedBr S{(const char*)(ws + WS_HM), (const char*)(ws + WS_HA), (const char*)(ws + WS_WBM) + (size_t)l * 2048 * 2048, (const char*)(ws + WS_WBA) + (size_t)l * 2048 * 2048, G, bid};
            EpiBr E{(const bf16*)(ws + WS_SG), (bf16*)(ws + WS_Y)};
            pg8::gemm_phase<EpiBr, SchedBr>(lds, 1024, S, E, wave);
        }
        SEAM(pb + 5);
        if (EN(7) && IN(pb + 6)) _Pragma("unroll 1") for (int rep_ = 0; rep_ < ((((DBLMASK >> 7) & 1u) && l == 0) ? 2 : 1); ++rep_) { PH_IDS(); (void)tid;
            SchedStd S{(const char*)(ws + WS_Y), (const char*)(ws + WS_WOUT) + (size_t)l * 2048 * 4096, 32, 8, 2048, G, bid};
            EpiOut E{l == 0 ? ap->in[I_X] : (const float*)ap->out, ap->out};
            pg8::gemm_phase<EpiOut, SchedStd>(lds, 2048, S, E, wave);
        }
        SEAM(pb + 6);
        if (EN(8) && IN(pb + 7)) { if ((DBLMASK >> 19) & 1u) { PH_IDS(); norm_phase<2>(ap, l, lds, tid, lane, wave, bid, G, true); } PH_IDS(); norm_phase<2>(ap, l, lds, tid, lane, wave, bid, G); }
        SEAM(pb + 7);
        if (EN(9) && IN(pb + 8)) REP(9) { PH_IDS();
            moe_tables(ws, l, misc, tid);
            SchedMoe1 S{(const char*)(ws + WS_H), (const char*)(ws + WS_W13) + (size_t)l * 32 * 512 * 4096, (const int*)(ws + MS_LIST),
                        (const LAS int*)(misc + MO_TE), (const LAS int*)(misc + MO_TR0), (const LAS int*)(misc + MO_CNT), __builtin_amdgcn_readfirstlane(((const LAS int*)(misc + MO_MT))[0]), G, bid};
            EpiMoe1 E{(bf16*)(ws + WS_HID), (const float*)(ws + MS_PWL), (const LAS int*)(misc + MO_TR0), (const LAS int*)(misc + MO_CNT)};
            pg8::gemm_phase<EpiMoe1, SchedMoe1>(lds, 2048, S, E, wave);
            if (bid >= 2 * S.MT) prologue_phase(ap, lds, tid, tid & 63, wave, bid - 2 * S.MT, G - 2 * S.MT, l == 0 ? 1 : 4);
        }
        SEAM(pb + 8);
        if (EN(10) && IN(pb + 9)) REP(10) { PH_IDS();
            moe_tables(ws, l, misc, tid);
#ifdef STAG
            for (int i = 0; i < ((bid >> 3) & 7); ++i) __builtin_amdgcn_s_sleep(STAG);
#endif
            SchedMoe2 S{(const char*)(ws + WS_HID), (const char*)(ws + WS_W2) + (size_t)l * 32 * 2048 * 512, (const LAS int*)(misc + MO_TE), __builtin_amdgcn_readfirstlane(((const LAS int*)(misc + MO_MT))[0]), G, bid};
            EpiMoe2 E{(bf16*)(ws + WS_OP)};
            pg8::gemm_phase<EpiMoe2, SchedMoe2>(lds, 256, S, E, wave);
        }
        SEAM(pb + 9);
    }
    if (EN(11) && IN(21)) { if ((DBLMASK >> 20) & 1u) { PH_IDS(); norm_phase<3>(ap, 1, lds, tid, lane, wave, bid, G, true); } PH_IDS(); norm_phase<3>(ap, 1, lds, tid, lane, wave, bid, G); }
#undef IN
#undef SEAM
}

extern "C" void kernel_launch(void* const* d_in, const int* in_sizes, int n_in, void* d_out, int out_size, void* d_ws, size_t ws_size, hipStream_t stream) {
    static int grid = 0;
    if (grid == 0) {
        if (n_in != 19 || out_size != NTOK * DM || ws_size < WS_END) { fprintf(stderr, "kernel_launch: unexpected shapes (n_in %d out %d ws %zu)\n", n_in, out_size, ws_size); grid = -1; return; }
        int dev = 0, cus = 0, per_cu = 0;
        if (hipGetDevice(&dev) != hipSuccess || hipDeviceGetAttribute(&cus, hipDeviceAttributeMultiprocessorCount, dev) != hipSuccess) { grid = -1; return; }
        if (hipFuncSetAttribute((const void*)fwd_kernel, hipFuncAttributeMaxDynamicSharedMemorySize, LDS_BYTES) != hipSuccess) { fprintf(stderr, "kernel_launch: hipFuncSetAttribute failed\n"); grid = -1; return; }
        if (hipOccupancyMaxActiveBlocksPerMultiprocessor(&per_cu, (const void*)fwd_kernel, NTHR, LDS_BYTES) != hipSuccess || per_cu < 1) { fprintf(stderr, "kernel_launch: occupancy query says %d\n", per_cu); }
        (void)hipGetLastError();
        grid = cus;
        if (grid > 256) grid = 256;
    }
    if (grid < 0) return;
    if (hipMemsetAsync((char*)d_ws + WS_CTL, 0, CTL_ZERO_BYTES, stream) != hipSuccess) return;
    Args a{};
    for (int i = 0; i < 19; ++i) a.in[i] = (const float*)d_in[i];
    a.out = (float*)d_out; a.ws = (unsigned char*)d_ws;
#if MK_LAUNCHES == 1
    a.ph_lo = 0; a.ph_hi = N_PHASES;
    hipLaunchKernelGGL(fwd_kernel, dim3(grid), dim3(NTHR), LDS_BYTES, stream, a);
#else
    for (int p = 0; p < N_PHASES; ++p) { a.ph_lo = p; a.ph_hi = p + 1; hipLaunchKernelGGL(fwd_kernel, dim3(grid), dim3(NTHR), LDS_BYTES, stream, a); }
#endif
}
```

```cpp
#define DBLMASK 0u
#include <hip/hip_runtime.h>
#include <stdint.h>
#include <stdio.h>

#ifndef MK_LAUNCHES
#define MK_LAUNCHES 1
#endif

#define GAS __attribute__((address_space(1)))
#define LAS __attribute__((address_space(3)))
typedef unsigned short bf16;
typedef short bf16x8 __attribute__((ext_vector_type(8)));
typedef short bf16x4 __attribute__((ext_vector_type(4)));
typedef float f32x4 __attribute__((ext_vector_type(4)));
typedef unsigned u32x4 __attribute__((ext_vector_type(4)));
typedef unsigned u32x2 __attribute__((ext_vector_type(2)));

constexpr int NTOK = 8192, DM = 2048, SEQ = 2048, NBATCH = 4;
constexpr int INCOLS = 11272;
constexpr int NWAVES = 8, NTHR = 512;
constexpr float RMS_EPS = 1e-6f, LN_EPS = 1e-5f;
constexpr int MPAD = 24576;

constexpr size_t MiB = 1u << 20;
constexpr size_t WS_CTL = 0, CTL_ZERO_BYTES = 1 * MiB;
constexpr size_t WS_MISC = 1 * MiB;
constexpr size_t MS_WIF = WS_MISC + 0;
constexpr size_t MS_WRT = WS_MISC + 256 * 1024;
constexpr size_t MS_IFG = WS_MISC + 1 * MiB;
constexpr size_t MS_KMEAN = MS_IFG + 256 * 1024;
constexpr size_t MS_AS = WS_MISC + 1536 * 1024;
constexpr size_t MS_GT = MS_AS + 128 * 1024;
constexpr size_t MS_WI = MS_GT + 128 * 1024;
constexpr size_t MS_CL = MS_WI + 128 * 1024;
constexpr size_t MS_WS = MS_CL + 128 * 1024;
constexpr size_t MS_DEC = MS_WS + 128 * 1024;
constexpr size_t MS_NST = WS_MISC + 2560 * 1024;
constexpr size_t MS_TOKE = WS_MISC + 3 * MiB;
constexpr size_t MS_TOKP = MS_TOKE + 64 * 1024;
constexpr size_t MS_TOKW = MS_TOKE + 128 * 1024;
constexpr size_t MS_LIST = WS_MISC + 4 * MiB;
constexpr size_t MS_PWL = WS_MISC + 5 * MiB;
constexpr size_t MS_NVEC = WS_MISC + 6 * MiB;
constexpr size_t WS_WINT = 16 * MiB;
constexpr size_t WS_WBM = 104 * MiB;
constexpr size_t WS_WBA = 112 * MiB;
constexpr size_t WS_WOUT = 120 * MiB;
constexpr size_t WS_W13 = 136 * MiB;
constexpr size_t WS_W2 = 264 * MiB;
constexpr size_t WS_H = 328 * MiB;
constexpr size_t WS_R = 360 * MiB;
constexpr size_t WS_ZQK = WS_R;
constexpr size_t WS_HM = WS_R, WS_HA = WS_R + 16 * MiB;
constexpr size_t WS_VMT = WS_R + 32 * MiB;
constexpr size_t WS_OM = WS_R + 48 * MiB;
constexpr size_t WS_QA = WS_R + 64 * MiB, WS_KA = WS_R + 80 * MiB;
constexpr size_t WS_Y = WS_QA;
constexpr size_t WS_VAT = WS_R + 96 * MiB;
constexpr size_t WS_SG = WS_R + 112 * MiB;
constexpr size_t WS_QM = WS_R + 176 * MiB, WS_KM = WS_R + 192 * MiB, WS_KMT = WS_R + 208 * MiB;
constexpr size_t WS_CST = WS_R + 224 * MiB;
constexpr size_t WS_HID = WS_R;
constexpr size_t WS_OP = WS_R + 16 * MiB;
constexpr size_t WS_END = 648 * MiB;
constexpr int CW_BAR = 4096;
constexpr int CW_CNT = 8192;

constexpr int RING_BYTES = 131072;
constexpr int MISC_OFF = 139264;
constexpr int LDS_BYTES = 147456;
constexpr int MO_BAR = 0, MO_CNT = 64, MO_NT = 64 + 128, MO_OFF = 64 + 256, MO_TE = 64 + 512, MO_TR0 = 64 + 1024, MO_MT = 64 + 1536, MO_LOG = 2048;

#define LDS_WAIT() asm volatile("s_waitcnt lgkmcnt(0)" ::: "memory")
#define VM_WAIT() asm volatile("s_waitcnt vmcnt(0)" ::: "memory")

__device__ __forceinline__ float bf2f(unsigned short b) { return __builtin_bit_cast(float, (unsigned)b << 16); }
__device__ __forceinline__ float bflo(unsigned u) { return __builtin_bit_cast(float, u << 16); }
__device__ __forceinline__ float bfhi(unsigned u) { return __builtin_bit_cast(float, u & 0xffff0000u); }
typedef __bf16 bf16x2v __attribute__((ext_vector_type(2)));
typedef float f32x2v __attribute__((ext_vector_type(2)));
typedef float f32x2 __attribute__((ext_vector_type(2)));
__device__ __forceinline__ unsigned cvt_pk_bf16(float lo, float hi) { const f32x2v f = {lo, hi}; const bf16x2v b = __builtin_convertvector(f, bf16x2v); return __builtin_bit_cast(unsigned, b); }
__device__ __forceinline__ float wave_sum(float v) {
#pragma unroll
    for (int o = 1; o < 64; o <<= 1) v += __shfl_xor(v, o);
    return v;
}
__device__ __forceinline__ float rows4_max(float x) { x = fmaxf(x, __shfl_xor(x, 16)); return fmaxf(x, __shfl_xor(x, 32)); }
__device__ __forceinline__ float rows4_sum(float x) { x += __shfl_xor(x, 16); return x + __shfl_xor(x, 32); }
__device__ __forceinline__ int lane_id() { int l; asm volatile("v_mbcnt_lo_u32_b32 %0, -1, 0\n\tv_mbcnt_hi_u32_b32 %0, -1, %0" : "=v"(l)); return l; }
__device__ __forceinline__ float sigmoidf_(float x) { return __builtin_amdgcn_rcpf(1.f + __expf(-x)); }

namespace pg8 {
constexpr int BM = 256, BK = 64, HALF = 128, HTB = HALF * BK * 2, STAGE_BYTES = 8 * HTB, NXCD = 8, WGM = 8;
__device__ __forceinline__ int lds_byte(int r, int c) { const int st = (r >> 4) * 2 + (c >> 5), rr = r & 15, cc = c & 31, ob = rr * 64 + cc * 2; return st * 1024 + (ob ^ (((ob >> 9) & 1) << 5)); }
__device__ __forceinline__ void stage_rc(int b, int& R, int& C) { const int st = b / 1024, sb = b % 1024, swz = sb ^ (((sb >> 9) & 1) << 5); R = (st >> 1) * 16 + swz / 64; C = (st & 1) * 32 + (swz % 64) / 2; }
__device__ __forceinline__ int perm32(int rho) { const int n = rho >> 4, i = rho & 15; return 8 * (i >> 2) + 4 * n + (i & 3); }
struct Unit { int pm, pn, aux; };

__device__ __forceinline__ void static_tile(int L, int nM, int nN, int& pm, int& pn) {
    const int nwg = nM * nN; int wgid = L;
    { const int q = nwg / NXCD, r = nwg % NXCD, xcd = wgid % NXCD, off = wgid / NXCD; wgid = (xcd < r ? xcd * (q + 1) : r * (q + 1) + (xcd - r) * q) + off; }
    const int nig = WGM * nN, gid = wgid / nig, fm = gid * WGM, gsz = (nM - fm) < WGM ? (nM - fm) : WGM;
    pm = fm + ((wgid % nig) % gsz); pn = (wgid % nig) / gsz;
}

template <class Epi, class Sched>
__device__ __forceinline__ void gemm_phase(LAS unsigned char* lds, const int K, const Sched& S, const Epi& E, const int wave0) {
    int tid_ = wave0 * 64 + lane_id(); asm volatile("" : "+v"(tid_));
    const int tid = tid_, wid = __builtin_amdgcn_readfirstlane(tid >> 6), lane = tid & 63, wr = wid >> 2, wc = wid & 3, fr = lane & 15, fq = lane >> 4;
    const int nt = K / BK;
    int RA[2], CA[2]; unsigned voffB[2];
#pragma unroll
    for (int i = 0; i < 2; ++i) { int R, C; stage_rc(tid * 16 + i * 8192, R, C); const int Rb = Epi::PERM ? ((R & ~31) + perm32(R & 31)) : R;
        RA[i] = R; CA[i] = C; voffB[i] = (unsigned)(Rb * K + C) * 2u; }
    const size_t kstep = (size_t)(BK * 2);
    const size_t hstep = (size_t)HALF * K * 2;
    const unsigned ldsw = (unsigned)wid * 1024u;
    const int aoff = lds_byte(wr * 64 + fr, fq * 8), boff = lds_byte(wc * 32 + fr, fq * 8);
#define PG8_SA(b, h) (((b) * 2 + (h)) * HTB)
#define PG8_SB(b, h) ((4 + (b) * 2 + (h)) * HTB)
#define PG8_STAGE(bufoff, gbase, v0, v1) do { \
        __builtin_amdgcn_global_load_lds((const unsigned*)((const char*)(gbase) + (v0)), (LAS unsigned*)(lds + (bufoff) + ldsw), 16, 0, 0); \
        __builtin_amdgcn_global_load_lds((const unsigned*)((const char*)(gbase) + (v1)), (LAS unsigned*)(lds + (bufoff) + ldsw + 8192), 16, 0, 0); } while (0)
#define PG8_STAGE_B(bufoff, gbase) PG8_STAGE(bufoff, gbase, voffB[0], voffB[1])
#define PG8_STAGE_A(bufoff, gbase, VO, h) PG8_STAGE(bufoff, gbase, VO[h][0], VO[h][1])
#define PG8_STAGE_A2(bufoff, gbase, h) do { if (Sched::GATHER && last) { PG8_STAGE_A(bufoff, gbase, vn, h); } else { PG8_STAGE_A(bufoff, gbase, vc, h); } } while (0)
#define PG8_LDA(dst, b, h) do { _Pragma("unroll") for (int m = 0; m < 4; ++m) _Pragma("unroll") for (int k = 0; k < 2; ++k) dst[m][k] = *(const LAS bf16x8*)(lds + PG8_SA(b, h) + aoff + m * 2048 + k * 1024); } while (0)
#define PG8_LDB(dst, b, h) do { _Pragma("unroll") for (int n = 0; n < 2; ++n) _Pragma("unroll") for (int k = 0; k < 2; ++k) dst[n][k] = *(const LAS bf16x8*)(lds + PG8_SB(b, h) + boff + n * 2048 + k * 1024); } while (0)
#define PG8_MMA(ai, bj, At, Bt) do { __builtin_amdgcn_s_setprio(1); _Pragma("unroll") for (int m = 0; m < 4; ++m) _Pragma("unroll") for (int n = 0; n < 2; ++n) _Pragma("unroll") for (int k = 0; k < 2; ++k) \
        acc[ai][bj][m][n] = __builtin_amdgcn_mfma_f32_16x16x32_bf16(Bt[n][k], At[m][k], acc[ai][bj][m][n], 0, 0, 0); __builtin_amdgcn_s_setprio(0); } while (0)
#define PG8_WAIT_V(n) asm volatile("s_waitcnt vmcnt(" #n ")" ::: "memory")
#define PG8_WAIT_L(n) asm volatile("s_waitcnt lgkmcnt(" #n ")" ::: "memory")
#define PG8_BAR __builtin_amdgcn_s_barrier()
#define PG8_SCHED __builtin_amdgcn_sched_barrier(0)
    Unit cur, nxt; int ui = 0;
    if (!S.next(0, cur)) return;
    f32x4 acc[2][2][4][2];
#pragma unroll
    for (int a = 0; a < 2; ++a)
#pragma unroll
        for (int b = 0; b < 2; ++b)
#pragma unroll
            for (int m = 0; m < 4; ++m)
#pragma unroll
                for (int n = 0; n < 2; ++n) acc[a][b][m][n] = (f32x4){0.f, 0.f, 0.f, 0.f};
    bf16x8 At[4][2], B0[2][2], B1[2][2];
    unsigned vc[2][2], vn[2][2];
#pragma unroll
    for (int h = 0; h < 2; ++h)
#pragma unroll
        for (int i = 0; i < 2; ++i) {
            if constexpr (Sched::GATHER) vc[h][i] = (unsigned)(S.arow(cur, h * HALF + RA[i]) * (unsigned)K + (unsigned)CA[i]) * 2u;
            else vc[h][i] = (unsigned)((h * HALF + RA[i]) * K + CA[i]) * 2u;
            vn[h][i] = vc[h][i];
        }
    const char* cA = S.abase(cur); const char* cB = S.bbase(cur);
    PG8_STAGE_B(PG8_SB(0, 0), cB); PG8_STAGE_A(PG8_SA(0, 0), cA, vc, 0); PG8_STAGE_B(PG8_SB(0, 1), cB + hstep); PG8_STAGE_A(PG8_SA(0, 1), cA, vc, 1);
    if (wr == 1) PG8_BAR;
    PG8_WAIT_V(4); PG8_BAR;
    PG8_STAGE_B(PG8_SB(1, 0), cB + kstep); PG8_STAGE_A(PG8_SA(1, 0), cA + kstep, vc, 0); PG8_STAGE_B(PG8_SB(1, 1), cB + hstep + kstep);
    PG8_WAIT_V(6); PG8_BAR;
    for (;;) {
        const bool has_next = S.next(ui + 1, nxt);
        const char* nA = has_next ? S.abase(nxt) : cA; const char* nB = has_next ? S.bbase(nxt) : cB;
        if constexpr (Sched::GATHER) {
            if (has_next) {
                int t2 = wave0 * 64 + lane_id(); asm volatile("" : "+v"(t2));
#pragma unroll
                for (int i = 0; i < 2; ++i) { int R, C; stage_rc(t2 * 16 + i * 8192, R, C);
#pragma unroll
                    for (int h = 0; h < 2; ++h) vn[h][i] = (unsigned)(S.arow(nxt, h * HALF + R) * (unsigned)K + (unsigned)C) * 2u; }
            }
        }
#pragma unroll 1
        for (int t = 0; t < nt; t += 2) {
            const bool last = (t == nt - 2);
            const char* a1 = cA + (size_t)(t + 1) * kstep;
            const char* a2 = last ? nA : cA + (size_t)(t + 2) * kstep; const char* b2 = last ? nB : cB + (size_t)(t + 2) * kstep;
            const char* a3 = a2 + kstep; const char* b3 = b2 + kstep;
            PG8_LDB(B0, 0, 0); PG8_SCHED; PG8_LDA(At, 0, 0); PG8_STAGE_A(PG8_SA(1, 1), a1, vc, 1);
            PG8_WAIT_L(8); PG8_BAR; PG8_WAIT_L(0); PG8_MMA(0, 0, At, B0); PG8_BAR; PG8_SCHED;
            PG8_LDB(B1, 0, 1); PG8_STAGE_B(PG8_SB(0, 0), b2);
            PG8_BAR; PG8_WAIT_L(0); PG8_MMA(0, 1, At, B1); PG8_BAR;
            PG8_LDA(At, 0, 1); PG8_STAGE_A2(PG8_SA(0, 0), a2, 0);
            PG8_BAR; PG8_WAIT_L(0); PG8_MMA(1, 0, At, B0); PG8_BAR; PG8_SCHED;
            PG8_STAGE_B(PG8_SB(0, 1), b2 + hstep);
            PG8_WAIT_V(6); PG8_BAR; PG8_MMA(1, 1, At, B1); PG8_BAR;
            PG8_LDB(B0, 1, 0); PG8_SCHED; PG8_LDA(At, 1, 0); PG8_STAGE_A2(PG8_SA(0, 1), a2, 1);
            PG8_WAIT_L(8); PG8_BAR; PG8_WAIT_L(0); PG8_MMA(0, 0, At, B0); PG8_BAR; PG8_SCHED;
            PG8_LDB(B1, 1, 1); PG8_STAGE_B(PG8_SB(1, 0), b3);
            PG8_BAR; PG8_WAIT_L(0); PG8_MMA(0, 1, At, B1); PG8_BAR;
            PG8_LDA(At, 1, 1); PG8_STAGE_A2(PG8_SA(1, 0), a3, 0);
            PG8_BAR; PG8_WAIT_L(0); PG8_MMA(1, 0, At, B0); PG8_BAR; PG8_SCHED;
            PG8_STAGE_B(PG8_SB(1, 1), b3 + hstep);
            PG8_WAIT_V(6); PG8_BAR; PG8_MMA(1, 1, At, B1); PG8_BAR;
        }
        { const int lz = lane_id(); E(acc, cur, wr, wc, lz & 15, lz >> 4); }
        if (!has_next) break;
        if (!Sched::keep_acc(cur)) {
#pragma unroll
        for (int a = 0; a < 2; ++a)
#pragma unroll
            for (int b = 0; b < 2; ++b)
#pragma unroll
                for (int m = 0; m < 4; ++m)
#pragma unroll
                    for (int n = 0; n < 2; ++n) acc[a][b][m][n] = (f32x4){0.f, 0.f, 0.f, 0.f};
        }
        cur = nxt; cA = nA; cB = nB; ++ui;
        if constexpr (Sched::GATHER) {
#pragma unroll
            for (int h = 0; h < 2; ++h)
#pragma unroll
                for (int i = 0; i < 2; ++i) vc[h][i] = vn[h][i];
        }
    }
    PG8_WAIT_V(0);
    if (wr == 0) PG8_BAR;
    PG8_BAR;
#undef PG8_SA
#undef PG8_SB
#undef PG8_STAGE
#undef PG8_STAGE_A
#undef PG8_STAGE_A2
#undef PG8_STAGE_B
#undef PG8_LDA
#undef PG8_LDB
#undef PG8_MMA
#undef PG8_WAIT_V
#undef PG8_WAIT_L
#undef PG8_BAR
#undef PG8_SCHED
}
}
using pg8::Unit;

#define XB_TMO      128
#define XB_XCNT(j)  (256  + 64 * (j))
#define XB_XSUB(j)  (1280 + 64 * (j))
#define XB_XGEN(j)  (2304 + 64 * (j))
#define XB_TOP      3328
#define XB_TOPGEN   3392
#define XCD_BAR_WORDS 3456
#define XB_SPIN_CAP (1u << 18)
__device__ __forceinline__ unsigned xb_ld(unsigned* p)              { return __hip_atomic_load(p, __ATOMIC_RELAXED, __HIP_MEMORY_SCOPE_AGENT); }
__device__ __forceinline__ unsigned xb_add(unsigned* p, unsigned v) { return __hip_atomic_fetch_add(p, v, __ATOMIC_RELAXED, __HIP_MEMORY_SCOPE_AGENT); }
__device__ __forceinline__ unsigned xb_xcc_id() { return (unsigned)__builtin_amdgcn_s_getreg((3 << 11) | 20) & 0xFu; }
#define XB_SPIN(cond, bar) do { unsigned _sp = 0; while (cond) { __builtin_amdgcn_s_sleep(1); \
    if ((++_sp & 255u) == 0u) { if (xb_ld(&(bar)[XB_TMO])) break; if (_sp > XB_SPIN_CAP) { atomicAdd(&(bar)[XB_TMO], 1u); break; } } } } while (0)
struct XcdBarrier { unsigned* bar; unsigned x; volatile LAS unsigned* st; };
__device__ __forceinline__ XcdBarrier xcd_barrier_post(unsigned* bar, volatile LAS unsigned* st) {
    XcdBarrier b; b.bar = bar; b.x = xb_xcc_id(); b.st = st;
    if (threadIdx.x == 0) (void)xb_add(&bar[XB_XCNT(b.x)], 1u);
    return b;
}
__device__ __forceinline__ void xcd_barrier_complete(unsigned* bar, unsigned x, unsigned& nloc, unsigned& nx) {
    const unsigned G = gridDim.x * gridDim.y * gridDim.z;
    unsigned sum, cnt, mine, sp = 0u;
    for (;;) {
        sum = 0u; cnt = 0u; mine = 0u;
#pragma unroll
        for (unsigned j = 0; j < 16; ++j) { const unsigned c = xb_ld(&bar[XB_XCNT(j)]); sum += c; cnt += (c > 0u) ? 1u : 0u; mine = (j == x) ? c : mine; }
        if (sum == G) break;
        __builtin_amdgcn_s_sleep(1);
        if ((++sp & 255u) == 0u) { if (xb_ld(&bar[XB_TMO])) break; if (sp > XB_SPIN_CAP) { atomicAdd(&bar[XB_TMO], 1u); break; } }
    }
    nloc = mine > 0u ? mine : 1u; nx = cnt > 0u ? cnt : 1u;
}
__device__ __forceinline__ void xcd_barrier(const XcdBarrier& b) {
    asm volatile("s_waitcnt vmcnt(0)" ::: "memory");
    __syncthreads();
    if (threadIdx.x == 0) {
        unsigned* bar = b.bar;
        __builtin_amdgcn_s_waitcnt(0);
        unsigned nloc = b.st[0], nx = b.st[1];
        if (nloc == 0u) { xcd_barrier_complete(bar, b.x, nloc, nx); b.st[0] = nloc; b.st[1] = nx; }
        const unsigned old = xb_add(&bar[XB_XSUB(b.x)], 1u);
        const unsigned gen = old / nloc;
        if (old + 1u == (gen + 1u) * nloc) {
            __builtin_amdgcn_fence(__ATOMIC_RELEASE, "agent");
            asm volatile("s_waitcnt vmcnt(0)" ::: "memory");
            const unsigned og = xb_add(&bar[XB_TOP], 1u);
            const unsigned tg = og / nx;
            if (og + 1u == (tg + 1u) * nx) xb_add(&bar[XB_TOPGEN], 1u);
            else XB_SPIN(xb_ld(&bar[XB_TOPGEN]) == tg, bar);
            __builtin_amdgcn_fence(__ATOMIC_ACQUIRE, "agent");
            xb_add(&bar[XB_XGEN(b.x)], 1u);
            asm volatile("s_waitcnt vmcnt(0)" ::: "memory");
        } else {
            XB_SPIN(xb_ld(&bar[XB_XGEN(b.x)]) == gen, bar);
            __builtin_amdgcn_fence(__ATOMIC_ACQUIRE, "agent");
            asm volatile("s_waitcnt vmcnt(0)" ::: "memory");
        }
    }
    __syncthreads();
}

struct Args { const float* in[19]; float* out; unsigned char* ws; int ph_lo, ph_hi; };
typedef const __attribute__((address_space(4))) Args* ArgsP;
enum { I_X = 0, I_N1G, I_WIN, I_CONVW, I_IFB, I_MNG, I_WBM, I_WBA, I_WOUT, I_RELB, I_N2G, I_WGRP, I_BGRP, I_WEXP, I_BEXP, I_W1, I_W3, I_W2, I_FG };


struct TrDesc { const float* W; bf16* WT; size_t ldn, ldk; int k0, n0, r0; };
__device__ __forceinline__ void tr_load(const TrDesc& d, f32x4 (&tv)[16], int lane) {
    const int nn4 = (lane & 15) * 4, kr = lane >> 4;
#pragma unroll
    for (int i = 0; i < 16; ++i) tv[i] = __builtin_nontemporal_load((const f32x4*)(d.W + (size_t)(d.k0 + 4 * i + kr) * d.ldn + d.n0 + nn4));
}
__device__ __forceinline__ void tr_finish(const TrDesc& d, f32x4 (&tv)[16], LAS float* scr, int lane) {
    const int nn4 = (lane & 15) * 4, kr = lane >> 4;
#pragma unroll
    for (int i = 0; i < 16; i += 4) asm volatile("" : "+v"(tv[i]), "+v"(tv[i + 1]), "+v"(tv[i + 2]), "+v"(tv[i + 3]));
#pragma unroll
    for (int i = 0; i < 16; ++i) { const int kk = 4 * i + kr; const f32x4 v = tv[i];
        LAS float* q = scr + kk * 65 + nn4; q[0] = v.x; q[1] = v.y; q[2] = v.z; q[3] = v.w; }
    LDS_WAIT();
    const int kc = (lane & 7) * 8;
#pragma unroll
    for (int p = 0; p < 8; ++p) { const int nn = 8 * p + (lane >> 3); const LAS float* sp = scr + kc * 65 + nn;
        u32x4 o; o.x = cvt_pk_bf16(sp[0], sp[65]); o.y = cvt_pk_bf16(sp[130], sp[195]); o.z = cvt_pk_bf16(sp[260], sp[325]); o.w = cvt_pk_bf16(sp[390], sp[455]);
        *(u32x4*)(d.WT + (size_t)(d.r0 + nn) * d.ldk + d.k0 + kc) = o; }
    LDS_WAIT();
}
__device__ __forceinline__ int win_src_col(int r) {
    if (r < 2048) return r;
    if (r < 3072) return r + 1024;
    if (r < 5120) return r + 1032;
    if (r < 9216) return r + 2056;
    if (r < 10240) return r - 7168;
    return r - 4088;
}
__device__ __forceinline__ TrDesc tr_decode(ArgsP a, unsigned char* ws, int it) {
    constexpr int PER_LAYER = 5632 + 512 + 512 + 1024 + 4096 + 4096 + 4096;
    const int l = it / PER_LAYER; int r = it % PER_LAYER;
    TrDesc d;
    if (r < 5632) { const int kb = r / 176, ng = r % 176;
        d.W = a->in[I_WIN] + (size_t)l * DM * INCOLS; d.ldn = INCOLS; d.k0 = 64 * kb; d.n0 = win_src_col(64 * ng); d.WT = (bf16*)(ws + WS_WINT) + (size_t)l * 11264 * 2048; d.ldk = 2048; d.r0 = 64 * ng; return d; }
    r -= 5632;
    if (r < 512) { const int kb = r / 32, ng = r % 32;
        d.W = a->in[I_WBM] + (size_t)l * 1024 * 2048; d.ldn = 2048; d.k0 = 64 * kb; d.n0 = 64 * ng; d.WT = (bf16*)(ws + WS_WBM) + (size_t)l * 2048 * 1024; d.ldk = 1024; d.r0 = 64 * ng; return d; }
    r -= 512;
    if (r < 512) { const int kb = r / 32, ng = r % 32;
        d.W = a->in[I_WBA] + (size_t)l * 1024 * 2048; d.ldn = 2048; d.k0 = 64 * kb; d.n0 = 64 * ng; d.WT = (bf16*)(ws + WS_WBA) + (size_t)l * 2048 * 1024; d.ldk = 1024; d.r0 = 64 * ng; return d; }
    r -= 512;
    if (r < 1024) { const int kb = r / 32, ng = r % 32;
        d.W = a->in[I_WOUT] + (size_t)l * 2048 * 2048; d.ldn = 2048; d.k0 = 64 * kb; d.n0 = 64 * ng; d.WT = (bf16*)(ws + WS_WOUT) + (size_t)l * 2048 * 2048; d.ldk = 2048; d.r0 = 64 * ng; return d; }
    r -= 1024;
    if (r < 8192) { const int w3 = r >= 4096; const int q = r & 4095; const int e = q >> 7, rr = q & 127, kb = rr >> 2, ng = rr & 3;
        d.W = a->in[w3 ? I_W3 : I_W1] + (size_t)(l * 32 + e) * 2048 * 256; d.ldn = 256; d.k0 = 64 * kb; d.n0 = 64 * ng;
        d.WT = (bf16*)(ws + WS_W13) + (size_t)(l * 32 + e) * 512 * 2048; d.ldk = 2048; d.r0 = 256 * (ng >> 1) + 64 * (ng & 1) + (w3 ? 128 : 0); return d; }
    r -= 8192;
    { const int e = r >> 7, rr = r & 127, kb = rr >> 5, ng = rr & 31;
        d.W = a->in[I_W2] + (size_t)(l * 32 + e) * 256 * 2048; d.ldn = 2048; d.k0 = 64 * kb; d.n0 = 64 * ng; d.WT = (bf16*)(ws + WS_W2) + (size_t)(l * 32 + e) * 2048 * 256; d.ldk = 256; d.r0 = 64 * ng; return d; }
}
#ifndef CVX
#define CVX 4096
#endif
__device__ __forceinline__ void prologue_phase(ArgsP a, LAS unsigned char* lds, int tid, int lane, int wave, int bid, int G, const int part = 0, const int gwx = -1, const int ngwx = 0) {
    unsigned char* ws = a->ws;
    LAS float* scr = (LAS float*)(lds + wave * 16640);
    const int gw = gwx >= 0 ? gwx : bid * NWAVES + wave, NGW = gwx >= 0 ? ngwx : G * NWAVES;
    constexpr int PER_LAYER = 5632 + 512 + 512 + 1024 + 4096 + 4096 + 4096;
    constexpr int W0 = 5632, W2I = PER_LAYER - 4096;
    const int v_lo = part == 0 ? 0 : part == 1 ? PER_LAYER : part == 2 ? W0 + CVX : part == 3 ? PER_LAYER + W0 : part == 4 ? PER_LAYER + W2I : W0;
    const int v_hi = part == 0 ? W0 : part == 1 ? PER_LAYER + W0 : part == 2 ? PER_LAYER : part == 3 ? PER_LAYER + W2I : part == 4 ? 2 * PER_LAYER : W0 + CVX;
#define CV_ITEM(v) (v)
    f32x4 tvA[16], tvB[16]; TrDesc dA, dB;
    int it = v_lo + gw;
    if (it < v_hi) {
        int rem = (v_hi - 1 - it) / NGW;
        dA = tr_decode(a, ws, CV_ITEM(it)); tr_load(dA, tvA, lane);
#pragma unroll 1
        while (rem >= 2) {
            dB = tr_decode(a, ws, CV_ITEM(it + NGW)); tr_load(dB, tvB, lane);
            tr_finish(dA, tvA, scr, lane);
            it += 2 * NGW;
            dA = tr_decode(a, ws, CV_ITEM(it)); tr_load(dA, tvA, lane);
            tr_finish(dB, tvB, scr, lane);
            rem -= 2;
        }
        if (rem == 1) { dB = tr_decode(a, ws, CV_ITEM(it + NGW)); tr_load(dB, tvB, lane); tr_finish(dA, tvA, scr, lane); tr_finish(dB, tvB, scr, lane); }
        else tr_finish(dA, tvA, scr, lane);
    }
#undef CV_ITEM
    if (part != 0) return;
    const int gt = bid * NTHR + tid, NGT = G * NTHR;
    float* wrt = (float*)(ws + MS_WRT);
    for (int i = gt; i < 2 * 36 * 2048; i += NGT) { const int l = i / (36 * 2048), rr = i % (36 * 2048), n = rr >> 11, k = rr & 2047;
        wrt[i] = n < 4 ? a->in[I_WGRP][((size_t)l * DM + k) * 4 + n] : a->in[I_WEXP][((size_t)l * DM + k) * 32 + (n - 4)]; }
}

__device__ __forceinline__ void moe_tables(unsigned char* ws, int l, LAS unsigned char* misc, int tid) {
    LAS int* cnt = (LAS int*)(misc + MO_CNT); LAS int* ntl = (LAS int*)(misc + MO_NT); LAS int* off = (LAS int*)(misc + MO_OFF);
    LAS int* te = (LAS int*)(misc + MO_TE); LAS int* tr0 = (LAS int*)(misc + MO_TR0); LAS int* mt = (LAS int*)(misc + MO_MT);
    __syncthreads();
    if (tid < 32) { const int c = (int)__hip_atomic_load((unsigned*)(ws + WS_CTL) + CW_CNT + 32 * l + tid, __ATOMIC_RELAXED, __HIP_MEMORY_SCOPE_AGENT); cnt[tid] = c; ntl[tid] = (c + 255) >> 8; }
    __syncthreads();
    if (tid == 0) { int o = 0;
#pragma unroll 1
        for (int e = 0; e < 32; ++e) { off[e] = o; const int n = ntl[e];
#pragma unroll 1
            for (int j = 0; j < n; ++j) { te[o + j] = e; tr0[o + j] = 256 * j; } o += n; } off[32] = o; mt[0] = o; }
    __syncthreads();
}

#ifndef DRYX
#define DRYX 0
#endif
template <int MODE>
__device__ __forceinline__ void norm_phase(ArgsP a, int l, LAS unsigned char* lds, int tid, int lane, int wave, int bid, int G, const bool dry = false) {
    unsigned char* ws = a->ws;
    LAS unsigned char* misc = lds + MISC_OFF;
    if (MODE == 1 || MODE == 3) moe_tables(ws, MODE == 1 ? 0 : 1, misc, tid);
    const LAS int* off = (const LAS int*)(misc + MO_OFF);
    const float* src = (MODE == 0) ? a->in[I_X] : a->out;
    const float* gain = (MODE < 2) ? a->in[I_N1G] + l * DM : (MODE == 2 ? a->in[I_N2G] + l * DM : a->in[I_FG]);
    const int* toke = (const int*)(ws + MS_TOKE); const int* tokp = (const int*)(ws + MS_TOKP);
    const bf16* OP = (const bf16*)(ws + WS_OP);
    bf16* H = (bf16*)(ws + WS_H);
    const int gw = bid * NWAVES + wave, NGW = G * NWAVES;
    constexpr int RP = (MODE == 2) ? 4 : 2;
    LAS float* gwl = (LAS float*)lds;
    if (MODE < 2) {
        const float* wg = a->in[I_WIN] + (size_t)l * DM * INCOLS + 4096;
        f32x4 t0[4], t1[4];
#pragma unroll
        for (int i = 0; i < 4; ++i) { const float* wp = wg + (size_t)(tid + NTHR * i) * INCOLS; t0[i] = *(const f32x4*)wp; t1[i] = *(const f32x4*)(wp + 4); }
#pragma unroll
        for (int i = 0; i < 4; ++i) { const int k = tid + NTHR * i;
            gwl[k] = t0[i].x; gwl[2048 + k] = t0[i].y; gwl[4096 + k] = t0[i].z; gwl[6144 + k] = t0[i].w;
            gwl[8192 + k] = t1[i].x; gwl[10240 + k] = t1[i].y; gwl[12288 + k] = t1[i].z; gwl[14336 + k] = t1[i].w; }
        __syncthreads();
    }
    const int npass = (NTOK + NGW * RP - 1) / (NGW * RP);
    for (int m0_ = gw * RP, it = 0; (MODE == 2) ? (it < npass) : (m0_ < NTOK); m0_ += NGW * RP, ++it) {
        const bool valid = (MODE != 2) || (m0_ < NTOK);
        const int m0 = valid ? m0_ : NTOK - RP;
        f32x4 v[RP][8];
        const bf16* orow[RP][2]; float cw[RP][2];
        if (MODE == 1 || MODE == 3) {
#pragma unroll
            for (int r = 0; r < RP; ++r) { const int m = m0 + r;
                const int e0 = toke[2 * m], e1 = toke[2 * m + 1], p0 = tokp[2 * m], p1 = tokp[2 * m + 1];
                cw[r][0] = ((const float*)(ws + MS_TOKW))[2 * m]; cw[r][1] = ((const float*)(ws + MS_TOKW))[2 * m + 1];
                orow[r][0] = OP + (size_t)(off[e0] * 256 + p0) * DM + 4 * lane; orow[r][1] = OP + (size_t)(off[e1] * 256 + p1) * DM + 4 * lane; }
        }
#pragma unroll
        for (int r = 0; r < RP; ++r)
#pragma unroll
            for (int j = 0; j < 8; ++j) v[r][j] = *(const f32x4*)(src + (size_t)(m0 + r) * DM + 256 * j + 4 * lane);
        if (MODE == 1 || MODE == 3) {
            u32x2 ow[RP][2][8];
#pragma unroll
            for (int r = 0; r < RP; ++r)
#pragma unroll
                for (int j = 0; j < 8; ++j) { ow[r][0][j] = *(const u32x2*)(orow[r][0] + 256 * j); ow[r][1][j] = *(const u32x2*)(orow[r][1] + 256 * j); }
#pragma unroll
            for (int r = 0; r < RP; ++r)
                asm volatile("" : "+v"(ow[r][0][0]), "+v"(ow[r][0][1]), "+v"(ow[r][0][2]), "+v"(ow[r][0][3]), "+v"(ow[r][0][4]), "+v"(ow[r][0][5]), "+v"(ow[r][0][6]), "+v"(ow[r][0][7]),
                                  "+v"(ow[r][1][0]), "+v"(ow[r][1][1]), "+v"(ow[r][1][2]), "+v"(ow[r][1][3]), "+v"(ow[r][1][4]), "+v"(ow[r][1][5]), "+v"(ow[r][1][6]), "+v"(ow[r][1][7]));
#pragma unroll
            for (int r = 0; r < RP; ++r) { const int m = m0 + r; const float cw0 = cw[r][0], cw1 = cw[r][1];
#pragma unroll
                for (int j = 0; j < 8; ++j) { const u32x2 w0 = ow[r][0][j], w1 = ow[r][1][j];
                    v[r][j].x += cw0 * bflo(w0.x) + cw1 * bflo(w1.x); v[r][j].y += cw0 * bfhi(w0.x) + cw1 * bfhi(w1.x); v[r][j].z += cw0 * bflo(w0.y) + cw1 * bflo(w1.y); v[r][j].w += cw0 * bfhi(w0.y) + cw1 * bfhi(w1.y); }
                if (MODE == 1 && !dry) {
#pragma unroll
                    for (int j = 0; j < 8; ++j) *(f32x4*)(a->out + (size_t)m * DM + 256 * j + 4 * lane) = v[r][j]; }
            }
        }
        float rs[RP];
#pragma unroll
        for (int r = 0; r < RP; ++r) { float ss = 0.f;
#pragma unroll
            for (int j = 0; j < 8; ++j) ss += (v[r][j].x * v[r][j].x + v[r][j].y * v[r][j].y) + (v[r][j].z * v[r][j].z + v[r][j].w * v[r][j].w);
            rs[r] = __builtin_amdgcn_rsqf(wave_sum(ss) * (1.0f / DM) + RMS_EPS); }
        {
            f32x4 gv[8];
            int l4 = 4 * lane; asm volatile("" : "+v"(l4)); const float* gp = gain + l4;
#pragma unroll
            for (int j = 0; j < 8; ++j) gv[j] = *(const f32x4*)(gp + 256 * j);
            asm volatile("" : "+v"(gv[0]), "+v"(gv[1]), "+v"(gv[2]), "+v"(gv[3]), "+v"(gv[4]), "+v"(gv[5]), "+v"(gv[6]), "+v"(gv[7]));
#pragma unroll
            for (int j = 0; j < 8; ++j)
#pragma unroll
                for (int r = 0; r < RP; ++r) v[r][j] = v[r][j] * rs[r] * gv[j];
        }
        if (MODE == 3) {
#pragma unroll
            for (int r = 0; r < RP; ++r)
#pragma unroll
                for (int j = 0; j < 8; ++j) { if (!dry) *(f32x4*)(a->out + (size_t)(m0 + r) * DM + 256 * j + 4 * lane) = v[r][j]; else asm volatile("" :: "v"(v[r][j])); }
            continue;
        }
#pragma unroll
        for (int r = 0; r < RP; ++r)
#pragma unroll
            for (int j = 0; j < 8; ++j) { u32x2 w; w.x = cvt_pk_bf16(v[r][j].x, v[r][j].y); w.y = cvt_pk_bf16(v[r][j].z, v[r][j].w);
                if (!dry && valid) *(u32x2*)(H + (size_t)(m0 + r) * DM + 256 * j + 4 * lane) = w; else asm volatile("" :: "v"(w)); }
        float keep[RP]; _Pragma("unroll") for (int r = 0; r < RP; ++r) keep[r] = 0.f;
        if (MODE < 2) {
            float a8[RP][8];
#pragma unroll
            for (int r = 0; r < RP; ++r)
#pragma unroll
                for (int n = 0; n < 8; ++n) a8[r][n] = 0.f;
#pragma unroll
            for (int j = 0; j < 8; ++j) {
#pragma unroll
                for (int nh = 0; nh < 2; ++nh) {
                    f32x4 wn[4];
#pragma unroll
                    for (int n = 0; n < 4; ++n) wn[n] = *(const LAS f32x4*)(gwl + (4 * nh + n) * 2048 + 256 * j + 4 * lane);
                    asm volatile("" : "+v"(wn[0]), "+v"(wn[1]), "+v"(wn[2]), "+v"(wn[3]));
#pragma unroll
                    for (int r = 0; r < RP; ++r)
#pragma unroll
                        for (int n = 0; n < 4; ++n) a8[r][4 * nh + n] += (v[r][j].x * wn[n].x + v[r][j].y * wn[n].y) + (v[r][j].z * wn[n].z + v[r][j].w * wn[n].w);
                }
            }
#pragma unroll
            for (int r = 0; r < RP; ++r)
#pragma unroll
                for (int n = 0; n < 8; ++n) { const float d = wave_sum(a8[r][n]); keep[r] = (lane == n) ? d : keep[r]; }
        } else {
            const float* W = (const float*)(ws + MS_WRT) + (size_t)l * 36 * 2048;
            LAS float* logl = (LAS float*)(misc + MO_LOG) + wave * 160;
            LAS float* wb = (LAS float*)lds;
#define RT_STAGE(g_, buf_) do { _Pragma("unroll") for (int i = 0; i < 4; ++i) \
                __builtin_amdgcn_global_load_lds((const unsigned*)(W + (size_t)(g_) * 8192 + (wave * 4 + i) * 256 + 4 * lane), (LAS unsigned*)(wb + (buf_) * 8192 + (wave * 4 + i) * 256), 16, 0, 0); } while (0)
            RT_STAGE(0, 0);
            asm volatile("s_waitcnt vmcnt(0)" ::: "memory");
            __syncthreads();
#pragma unroll 1
            for (int grp = 0; grp < 9; ++grp) {
                float val[16];
                if (grp < 8) RT_STAGE(grp + 1, (grp + 1) & 1);
                const LAS float* wg = wb + (grp & 1) * 8192 + 4 * lane;
#pragma unroll
                for (int nl = 0; nl < 4; ++nl) {
                    f32x2 d[4] = {(f32x2){0.f, 0.f}, (f32x2){0.f, 0.f}, (f32x2){0.f, 0.f}, (f32x2){0.f, 0.f}};
                    f32x4 wv[8];
#pragma unroll
                    for (int j = 0; j < 8; ++j) wv[j] = *(const LAS f32x4*)(wg + nl * 2048 + 256 * j);
                    asm volatile("" : "+v"(wv[0]), "+v"(wv[1]), "+v"(wv[2]), "+v"(wv[3]), "+v"(wv[4]), "+v"(wv[5]), "+v"(wv[6]), "+v"(wv[7]));
#pragma unroll
                    for (int j = 0; j < 8; ++j) { const f32x4 w = wv[j];
#pragma unroll
                        for (int r = 0; r < 4; ++r) { d[r] = __builtin_elementwise_fma((f32x2){v[r][j].x, v[r][j].y}, (f32x2){w.x, w.y}, d[r]); d[r] = __builtin_elementwise_fma((f32x2){v[r][j].z, v[r][j].w}, (f32x2){w.z, w.w}, d[r]); } }
#pragma unroll
                    for (int r = 0; r < 4; ++r) val[4 * nl + r] = d[r].x + d[r].y;
                    __builtin_amdgcn_sched_barrier(0);
                }
                asm volatile("s_waitcnt vmcnt(0)" ::: "memory");
                __syncthreads();
#pragma unroll
                for (int i = 0; i < 8; ++i) { const bool hi = (lane & 32) != 0; const float snd = hi ? val[i] : val[i + 8]; const float kp = hi ? val[i + 8] : val[i]; val[i] = kp + __shfl_xor(snd, 32); }
#pragma unroll
                for (int i = 0; i < 4; ++i) { const bool hi = (lane & 16) != 0; const float snd = hi ? val[i] : val[i + 4]; const float kp = hi ? val[i + 4] : val[i]; val[i] = kp + __shfl_xor(snd, 16); }
#pragma unroll
                for (int i = 0; i < 2; ++i) { const bool hi = (lane & 8) != 0; const float snd = hi ? val[i] : val[i + 2]; const float kp = hi ? val[i + 2] : val[i]; val[i] = kp + __shfl_xor(snd, 8); }
                { const bool hi = (lane & 4) != 0; const float snd = hi ? val[0] : val[1]; const float kp = hi ? val[1] : val[0]; val[0] = kp + __shfl_xor(snd, 4); }
                float f = val[0]; f += __shfl_xor(f, 2); f += __shfl_xor(f, 1);
                const int vi = lane >> 2;
                if ((lane & 3) == 0) logl[(vi & 3) * 40 + 4 * grp + (vi >> 2)] = f;
            }
        }
        if (MODE < 2) {
            float* ifg = (float*)(ws + MS_IFG);
            if (lane < 8) {
#pragma unroll
                for (int r = 0; r < RP; ++r) { if (!dry) ifg[(size_t)(m0 + r) * 8 + lane] = keep[r]; else asm volatile("" :: "v"(keep[r])); } }
        } else {
            LAS float* logl = (LAS float*)(misc + MO_LOG) + wave * 160;
            LDS_WAIT();
            if (dry) { asm volatile("" :: "v"(keep[0])); }
            if (lane < RP && !dry && valid) {
                const int m = m0 + lane; const LAS float* lg = logl + lane * 40;
                const float* bg = a->in[I_BGRP] + l * 4; const float* be = a->in[I_BEXP] + l * 32;
                float gv[4]; int gsel = 0;
#pragma unroll
                for (int j = 0; j < 4; ++j) gv[j] = lg[j] + bg[j];
                float gmax = gv[0];
#pragma unroll
                for (int j = 1; j < 4; ++j) if (gv[j] > gmax) { gmax = gv[j]; gsel = j; }
                float gs = 0.f;
#pragma unroll
                for (int j = 0; j < 4; ++j) gs += expf(gv[j] - gmax);
                const float pg = 1.0f / gs;
                float ev[8];
#pragma unroll
                for (int j = 0; j < 8; ++j) ev[j] = lg[4 + 8 * gsel + j] + be[8 * gsel + j];
                int e0 = 0; float m0v = ev[0];
#pragma unroll
                for (int j = 1; j < 8; ++j) if (ev[j] > m0v) { m0v = ev[j]; e0 = j; }
                int e1 = -1; float m1v = -3.0e38f;
#pragma unroll
                for (int j = 0; j < 8; ++j) if (j != e0 && ev[j] > m1v) { m1v = ev[j]; e1 = j; }
                const float p1 = expf(m1v - m0v); const float w0 = pg / (1.0f + p1), w1 = pg * p1 / (1.0f + p1);
                unsigned* cnt = (unsigned*)(ws + WS_CTL) + CW_CNT + 32 * l;
                int* list = (int*)(ws + MS_LIST); float* pwl = (float*)(ws + MS_PWL); int* tke = (int*)(ws + MS_TOKE); int* tkp = (int*)(ws + MS_TOKP);
                const int id0 = 8 * gsel + e0, id1 = 8 * gsel + e1;
                const int q0 = (int)__hip_atomic_fetch_add(cnt + id0, 1u, __ATOMIC_RELAXED, __HIP_MEMORY_SCOPE_AGENT);
                const int q1 = (int)__hip_atomic_fetch_add(cnt + id1, 1u, __ATOMIC_RELAXED, __HIP_MEMORY_SCOPE_AGENT);
                list[id0 * 8192 + q0] = m; pwl[id0 * 8192 + q0] = w0; list[id1 * 8192 + q1] = m; pwl[id1 * 8192 + q1] = w1;
                tke[2 * m] = id0; tke[2 * m + 1] = id1; tkp[2 * m] = q0; tkp[2 * m + 1] = q1;
                ((float*)(ws + MS_TOKW))[2 * m] = w0; ((float*)(ws + MS_TOKW))[2 * m + 1] = w1;
            }
            LDS_WAIT();
        }
    }
}

struct SchedG1 {
    static constexpr bool GATHER = false;
    const char* H; const char* W; int G, c;
    static constexpr int NCV = 21;
    __device__ __forceinline__ bool next(int i, Unit& u) const {
        int L = i * G + c;
        if (G == 256) {
            if (c >= 256 - NCV) return false;
            if (c >= 128 && i == 5) { const int k = c - 128; if (k >= 5 * NCV) return false; L = (k % 5) * 256 + (256 - NCV) + k / 5; }
            else if (i > 5) return false;
        }
        if (L < 1152) { pg8::static_tile(L, 32, 36, u.pm, u.pn); u.aux = 0; return true; }
        const int r = L - 1152; if (r >= 256) return false;
        u.aux = 1 + (r >> 7); const int q = r & 127; u.pm = q & 3; u.pn = q >> 2; return true;
    }
    __device__ __forceinline__ const char* abase(const Unit& u) const { return u.aux == 0 ? H + (size_t)u.pm * 256 * 4096 : W + (size_t)(9216 + (u.aux - 1) * 1024 + u.pm * 256) * 4096; }
    __device__ __forceinline__ const char* bbase(const Unit& u) const { return u.aux == 0 ? W + (size_t)u.pn * 256 * 4096 : H + (size_t)u.pn * 256 * 4096; }
    __device__ __forceinline__ unsigned arow(const Unit&, int) const { return 0u; }
    static __device__ __forceinline__ bool keep_acc(const Unit&) { return false; }
};
struct EpiG1 {
    static constexpr bool PERM = true;
    unsigned char* ws; bool dry;
    __device__ __forceinline__ void operator()(f32x4 (&acc)[2][2][4][2], const Unit& u, int wr, int wc, int fr, int fq) const {
        if (dry) {
#pragma unroll
            for (int ai = 0; ai < 2; ++ai)
#pragma unroll
                for (int bj = 0; bj < 2; ++bj)
#pragma unroll
                    for (int m = 0; m < 4; ++m) asm volatile("" :: "v"(acc[ai][bj][m][0]), "v"(acc[ai][bj][m][1]));
            return; }
        if (u.aux == 0) {
            bf16* dst; int ld, colt, op;
            if (u.pn < 8) { dst = (bf16*)(ws + WS_ZQK); ld = 2048; colt = 256 * u.pn; op = 0; }
            else if (u.pn < 12) { dst = (bf16*)(ws + WS_OM); ld = 1024; colt = 256 * (u.pn - 8); op = 1; }
            else if (u.pn < 16) { dst = (bf16*)(ws + WS_QA); ld = 1024; colt = 256 * (u.pn - 12); op = 2; }
            else if (u.pn < 20) { dst = (bf16*)(ws + WS_KA); ld = 1024; colt = 256 * (u.pn - 16); op = 0; }
            else { dst = (bf16*)(ws + WS_SG); ld = 4096; colt = 256 * (u.pn - 20); op = 1; }
            const float scl = (op == 2) ? 0.12751743074602267f : 1.0f;
            const int row0 = u.pm * 256 + wr * 64 + fr, col0 = colt + wc * 32 + 8 * fq;
#pragma unroll
            for (int ai = 0; ai < 2; ++ai)
#pragma unroll
                for (int m = 0; m < 4; ++m) { bf16* rowp = dst + (size_t)(row0 + ai * 128 + m * 16) * ld + col0;
#pragma unroll
                    for (int bj = 0; bj < 2; ++bj) { f32x4 v0 = acc[ai][bj][m][0] * scl, v1 = acc[ai][bj][m][1] * scl;
                        if (op == 1) {
#pragma unroll
                            for (int j = 0; j < 4; ++j) { v0[j] = sigmoidf_(v0[j]); v1[j] = sigmoidf_(v1[j]); } }
                        u32x4 w; w.x = cvt_pk_bf16(v0[0], v0[1]); w.y = cvt_pk_bf16(v0[2], v0[3]); w.z = cvt_pk_bf16(v1[0], v1[1]); w.w = cvt_pk_bf16(v1[2], v1[3]);
                        *(u32x4*)(rowp + bj * 128) = w; } }
        } else {
            bf16* dst = (bf16*)(ws + (u.aux == 1 ? WS_VMT : WS_VAT));
            const int b = u.pn >> 3, s0 = (u.pn & 7) * 256 + wc * 32 + 8 * fq, rr0 = u.pm * 256 + wr * 64 + fr;
#pragma unroll
            for (int ai = 0; ai < 2; ++ai)
#pragma unroll
                for (int m = 0; m < 4; ++m) { const int rr = rr0 + ai * 128 + m * 16;
#pragma unroll
                    for (int bj = 0; bj < 2; ++bj) { const f32x4 v0 = acc[ai][bj][m][0], v1 = acc[ai][bj][m][1];
                        u32x4 w; w.x = cvt_pk_bf16(v0[0], v0[1]); w.y = cvt_pk_bf16(v0[2], v0[3]); w.z = cvt_pk_bf16(v1[0], v1[1]); w.w = cvt_pk_bf16(v1[2], v1[3]);
                        const int sq = s0 + bj * 128;
                        const size_t off = (u.aux == 1) ? (size_t)((((b * 4 + (rr >> 8)) * 32 + (sq >> 6)) * 2 + ((sq >> 5) & 1)) * 16 + ((rr & 255) >> 4)) * 512 + (size_t)((((sq >> 3) & 3) * 16 + (rr & 15)) * 8)
                                                        : (size_t)(b * 1024 + rr) * 2048 + sq;
                        *(u32x4*)(dst + off) = w; } }
        }
    }
};

__device__ __forceinline__ void gate_unit(ArgsP a, int l, LAS unsigned char* lds, int bh, int tid, int lane, int wave) {
    unsigned char* ws = a->ws;
    {
            const int b = bh >> 2, h = bh & 3;
            LAS float* bl = (LAS float*)lds; LAS float* amx = bl + 32; LAS float* mpv = bl + 64; LAS float* gcv = bl + 96;
            const float* ifg = (const float*)(ws + MS_IFG); const float* ifb = a->in[I_IFB] + l * 8;
            float A[4], Bs[4], CM[4];
#pragma unroll
            for (int cc = 0; cc < 4; ++cc) { const int c = wave + 8 * cc, s = 64 * c + lane; const size_t tok = (size_t)b * SEQ + s;
                const float ig = ifg[tok * 8 + h] + ifb[h], fg = ifg[tok * 8 + 4 + h] + ifb[4 + h];
                const float lf = fminf(fg, 0.f) - log1pf(expf(-fabsf(fg)));
                float bs = lf;
#pragma unroll
                for (int o = 1; o < 64; o <<= 1) { const float t = __shfl_up(bs, o); if (lane >= o) bs += t; }
                const float av = ig - bs; float cm = av;
#pragma unroll
                for (int o = 1; o < 64; o <<= 1) { const float t = __shfl_up(cm, o); if (lane >= o) cm = fmaxf(cm, t); }
                A[cc] = av; Bs[cc] = bs; CM[cc] = cm;
                if (lane == 63) { bl[c] = bs; amx[c] = cm; } }
            __syncthreads();
            if (tid == 0) { float m = 0.f;
#pragma unroll 1
                for (int c = 0; c < 32; ++c) { mpv[c] = m; const float Gm = fmaxf(m, amx[c]); gcv[c] = Gm; m = bl[c] + Gm; } }
            __syncthreads();
            float* AS = (float*)(ws + MS_AS) + bh * 2048; float* GT = (float*)(ws + MS_GT) + bh * 2048; float* WI = (float*)(ws + MS_WI) + bh * 2048;
            float* CL = (float*)(ws + MS_CL) + bh * 2048; float* WSs = (float*)(ws + MS_WS) + bh * 2048; float* DEC = (float*)(ws + MS_DEC) + bh * 32;
#pragma unroll
            for (int cc = 0; cc < 4; ++cc) { const int c = wave + 8 * cc, s = 64 * c + lane; const float mp = mpv[c], Gm = gcv[c], gt = fmaxf(mp, CM[cc]);
                AS[s] = A[cc]; GT[s] = gt; WI[s] = expf(mp - gt); CL[s] = expf(-(Bs[cc] + gt)); WSs[s] = expf(A[cc] - Gm);
                if (lane == 0) DEC[c] = expf(mp - Gm); }
        }
    __syncthreads();
}

__device__ __forceinline__ void conv_phase(ArgsP a, int l, LAS unsigned char* lds, int tid, int lane, int wave, int bid, int G) {
    unsigned char* ws = a->ws;
    u32x4 xv[5];
    const bf16* Z = (const bf16*)(ws + WS_ZQK);
#define CONV_LOAD(u_) do { const int cg_ = (u_) & 7, s0_ = 64 * (((u_) >> 3) & 31), b_ = (u_) >> 8; _Pragma("unroll") for (int i = 0; i < 5; ++i) { \
        const int idx = tid + NTHR * i, row = idx >> 5, ch = idx & 31, sq = s0_ - 3 + row; xv[i] = (u32x4){0u, 0u, 0u, 0u}; \
        if (idx < 67 * 32 && sq >= 0) xv[i] = *(const u32x4*)(Z + (size_t)(b_ * SEQ + sq) * 2048 + cg_ * 256 + ch * 8); } \
        wsn = ((const float*)(ws + MS_WS))[(size_t)(b_ * 4 + ((cg_ - 4) & 3)) * 2048 + s0_ + (tid & 63)]; } while (0)
    float wsn = 0.f;
    if (bid < 1024) CONV_LOAD(bid);
    for (int u = bid; u < 1024 + 256; u += G) {
        if (u < 1024) {
            const int cg = u & 7, st = (u >> 3) & 31, b = u >> 8, s0 = 64 * st;
            LAS unsigned char* xt = lds; LAS unsigned char* kt = lds + 36864;
            const int cp = tid & 127, tg = tid >> 7, c = 2 * cp, gc = cg * 256 + c;
            float w0[4], w1[4];
#pragma unroll
            for (int j = 0; j < 4; ++j) { w0[j] = a->in[I_CONVW][(size_t)(l * 4 + j) * 2048 + gc]; w1[j] = a->in[I_CONVW][(size_t)(l * 4 + j) * 2048 + gc + 1]; }
            asm volatile("" : "+v"(xv[0]), "+v"(xv[1]), "+v"(xv[2]), "+v"(xv[3]), "+v"(xv[4]));
#pragma unroll
            for (int i = 0; i < 5; ++i) { const int idx = tid + NTHR * i, row = idx >> 5, ch = idx & 31;
                if (idx < 67 * 32) *(LAS u32x4*)(xt + row * 512 + ch * 16) = xv[i]; }
            LAS float* wst = (LAS float*)(lds + 73728);
            if (cg >= 4 && tid < 64) wst[tid] = wsn;
            __syncthreads();
            if (u + G < 1024) CONV_LOAD(u + G);
            bf16* QM = (bf16*)(ws + WS_QM); bf16* KM = (bf16*)(ws + WS_KM);
#pragma unroll 4
            for (int tt = 0; tt < 16; ++tt) { const int t = tg * 16 + tt; float a0 = 0.f, a1 = 0.f;
#pragma unroll
                for (int j = 0; j < 4; ++j) { const unsigned x = *(const LAS unsigned*)(xt + (t + j) * 512 + c * 2); a0 += w0[j] * bflo(x); a1 += w1[j] * bfhi(x); }
                float o0 = a0 * sigmoidf_(a0), o1 = a1 * sigmoidf_(a1);
                const size_t tok = (size_t)b * SEQ + s0 + t;
                if (cg < 4) { *(unsigned*)(QM + tok * 1024 + cg * 256 + c) = cvt_pk_bf16(o0, o1); }
                else { o0 *= 0.0625f; o1 *= 0.0625f; const unsigned p = cvt_pk_bf16(o0, o1);
                    *(unsigned*)(KM + tok * 1024 + (cg - 4) * 256 + c) = p;
                    const float wsv = wst[t]; const unsigned ps = cvt_pk_bf16(o0 * wsv, o1 * wsv);
                    *(LAS unsigned short*)(kt + c * 144 + t * 2) = (unsigned short)(ps & 0xffffu); *(LAS unsigned short*)(kt + (c + 1) * 144 + t * 2) = (unsigned short)(ps >> 16); }
            }
            if (cg >= 4) {
                __syncthreads();
                bf16* KMT = (bf16*)(ws + WS_KMT);
                for (int idx = tid; idx < 2048; idx += NTHR) {
                    const int ks = idx >> 10, dtl = (idx >> 6) & 15, ln = idx & 63, row = dtl * 16 + (ln & 15), ch = ks * 4 + (ln >> 4);
                    const u32x4 v = *(const LAS u32x4*)(kt + row * 144 + ch * 16);
                    *(u32x4*)(KMT + (size_t)(((b * 4 + cg - 4) * 32 + st) * 2) * 8192 + (size_t)idx * 8) = v; }
                if (tid < 256) {
                    float sm = 0.f;
#pragma unroll
                    for (int i = 0; i < 8; ++i) { const u32x4 v = *(const LAS u32x4*)(kt + tid * 144 + i * 16);
                        sm += (bflo(v.x) + bfhi(v.x)) + (bflo(v.y) + bfhi(v.y)) + (bflo(v.z) + bfhi(v.z)) + (bflo(v.w) + bfhi(v.w)); }
                    ((float*)(ws + MS_NST))[(size_t)((b * 4 + cg - 4) * 32 + st) * 256 + tid] = sm; }
            }
        } else if (u < 1280) {
            const int j = u - 1024, b = j >> 6, n = (j >> 3) & 7, h = j & 7;
            const bf16* KA = (const bf16*)(ws + WS_KA) + (size_t)(b * SEQ + n * 256 + wave * 32) * 1024 + h * 128 + 2 * lane;
            float s0 = 0.f, s1 = 0.f;
            unsigned xr[32];
#pragma unroll
            for (int r = 0; r < 32; ++r) xr[r] = *(const unsigned*)(KA + (size_t)r * 1024);
#pragma unroll
            for (int r = 0; r < 32; r += 8) asm volatile("" : "+v"(xr[r]), "+v"(xr[r + 1]), "+v"(xr[r + 2]), "+v"(xr[r + 3]), "+v"(xr[r + 4]), "+v"(xr[r + 5]), "+v"(xr[r + 6]), "+v"(xr[r + 7]));
#pragma unroll
            for (int r = 0; r < 32; ++r) { s0 += bflo(xr[r]); s1 += bfhi(xr[r]); }
            LAS float* part = (LAS float*)lds;
            part[wave * 128 + 2 * lane] = s0; part[wave * 128 + 2 * lane + 1] = s1;
            __syncthreads();
            if (tid < 128) { float t = 0.f;
#pragma unroll
                for (int w = 0; w < 8; ++w) t += part[w * 128 + tid];
                ((float*)(ws + MS_KMEAN))[(size_t)((b * 8 + h) * 8 + n) * 128 + tid] = t * (1.0f / 256.0f); }
        }
        __syncthreads();
    }
}

#undef CONV_LOAD
__device__ __forceinline__ void mlstm_ab_task(unsigned char* ws, int gw, int lane, const bool do_store = true) {
    const int bh = gw >> 6, piece = gw & 63, e0 = (piece >> 3) * 32, d0 = (piece & 7) * 32, q16 = lane & 15, g = lane >> 4;
    const bf16* ka = (const bf16*)(ws + WS_KMT) + (size_t)bh * 32 * 16384 + (size_t)(d0 >> 4) * 512 + lane * 8;
    const bf16* vb = (const bf16*)(ws + WS_VMT) + (size_t)bh * 32 * 16384 + (size_t)(e0 >> 4) * 512 + lane * 8;
    const float* DEC = (const float*)(ws + MS_DEC) + bh * 32;
    bf16* CST = (bf16*)(ws + WS_CST) + (size_t)bh * 32 * 65536 + (size_t)((d0 >> 5) * 16 + (e0 >> 4)) * 512 + (size_t)(((g >> 1) * 16 + q16) * 8 + 4 * (g & 1));
    f32x4 acc[2][2];
#pragma unroll
    for (int t = 0; t < 2; ++t) { acc[t][0] = (f32x4){0.f, 0.f, 0.f, 0.f}; acc[t][1] = acc[t][0]; }
    const int decv = __builtin_bit_cast(int, DEC[lane & 31]);
    bf16x8 A0[2][2], B0[2][2], A1[2][2], B1[2][2], A2[2][2], B2[2][2], A3[2][2], B3[2][2], A4[2][2], B4[2][2];
#define AB_LOAD(c_, A_, B_) do { const int cc_ = (c_) < 31 ? (c_) : 31; _Pragma("unroll") for (int ks = 0; ks < 2; ++ks) { \
        A_[0][ks] = *(const bf16x8*)(ka + (size_t)cc_ * 16384 + ks * 8192); A_[1][ks] = *(const bf16x8*)(ka + (size_t)cc_ * 16384 + ks * 8192 + 512); \
        B_[0][ks] = *(const bf16x8*)(vb + (size_t)cc_ * 16384 + ks * 8192); B_[1][ks] = *(const bf16x8*)(vb + (size_t)cc_ * 16384 + ks * 8192 + 512); } } while (0)
#define AB_STEP(c_, A_, B_) do { \
        if (do_store) { _Pragma("unroll") for (int t = 0; t < 2; ++t) _Pragma("unroll") for (int f = 0; f < 2; ++f) { u32x2 w; w.x = cvt_pk_bf16(acc[t][f][0], acc[t][f][1]); w.y = cvt_pk_bf16(acc[t][f][2], acc[t][f][3]); \
            *(u32x2*)(CST + (size_t)(c_) * 65536 + 512 * t + 256 * f) = w; } } \
        const float dec = __builtin_bit_cast(float, __builtin_amdgcn_readlane(decv, (c_))); \
        _Pragma("unroll") for (int t = 0; t < 2; ++t) { acc[t][0] = acc[t][0] * dec; acc[t][1] = acc[t][1] * dec; } \
        _Pragma("unroll") for (int ks = 0; ks < 2; ++ks) _Pragma("unroll") for (int t = 0; t < 2; ++t) { \
            acc[t][0] = __builtin_amdgcn_mfma_f32_16x16x32_bf16(A_[0][ks], B_[t][ks], acc[t][0], 0, 0, 0); \
            acc[t][1] = __builtin_amdgcn_mfma_f32_16x16x32_bf16(A_[1][ks], B_[t][ks], acc[t][1], 0, 0, 0); } } while (0)
    AB_LOAD(0, A0, B0); AB_LOAD(1, A1, B1); AB_LOAD(2, A2, B2); AB_LOAD(3, A3, B3); AB_LOAD(4, A4, B4);
#pragma unroll 1
    for (int c = 0; c < 30; c += 5) {
        AB_STEP(c, A0, B0); AB_LOAD(c + 5, A0, B0);
        AB_STEP(c + 1, A1, B1); AB_LOAD(c + 6, A1, B1);
        AB_STEP(c + 2, A2, B2); AB_LOAD(c + 7, A2, B2);
        AB_STEP(c + 3, A3, B3); AB_LOAD(c + 8, A3, B3);
        AB_STEP(c + 4, A4, B4); AB_LOAD(c + 9, A4, B4);
    }
    AB_STEP(30, A0, B0); AB_STEP(31, A1, B1);
    if (!do_store) asm volatile("" :: "v"(acc[0][0]), "v"(acc[0][1]), "v"(acc[1][0]), "v"(acc[1][1]));
#undef AB_LOAD
#undef AB_STEP
}

__device__ __forceinline__ void nscan_task(unsigned char* ws, int t, int lane) {
    const int bh = t >> 2, d = (t & 3) * 64 + lane;
    const float* cs = (const float*)(ws + MS_NST) + (size_t)bh * 32 * 256 + d;
    float* nv = (float*)(ws + MS_NVEC) + (size_t)bh * 32 * 256 + d;
    const int decv = __builtin_bit_cast(int, ((const float*)(ws + MS_DEC))[bh * 32 + (lane & 31)]);
    float v[32];
#pragma unroll
    for (int j = 0; j < 32; ++j) v[j] = cs[j * 256];
    float n = 0.f;
#pragma unroll
    for (int j = 0; j < 32; ++j) { nv[j * 256] = n; n = __builtin_bit_cast(float, __builtin_amdgcn_readlane(decv, j)) * n + v[j]; }
}

__device__ __forceinline__ int rel_bucket_dev(int n) {
    if (n < 16) return n;
    int b = 16;
    b += (n >= 19); b += (n >= 21); b += (n >= 24); b += (n >= 27); b += (n >= 31); b += (n >= 35); b += (n >= 40); b += (n >= 46);
    b += (n >= 52); b += (n >= 59); b += (n >= 67); b += (n >= 77); b += (n >= 87); b += (n >= 99); b += (n >= 113);
    return b;
}
constexpr int AT_KT = 0, AT_VT = 34816, AT_TAB = 71680, AT_SEL = 72704, AT_TILES = 73216, AT_CTL = 73600, AT_KM = 73728;
__device__ __forceinline__ void attn_unit(ArgsP a, LAS unsigned char* lds, int uidx, int tid, int lane, int wave) {
    unsigned char* ws = a->ws;
    const int u256 = uidx & 255, second = uidx >> 8, bh = u256 >> 3, kk8 = u256 & 7, si = second ? 15 - kk8 : kk8, wgt = 16 - si;
    const int blk = (wgt - 1) >> 1, half = (wgt - 1) & 1, b = bh >> 3, h = bh & 7, q0 = blk * 256 + half * 128;
    const int q16 = lane & 15, g = lane >> 4;
    LAS float* tab = (LAS float*)(lds + AT_TAB); LAS unsigned* sels = (LAS unsigned*)(lds + AT_SEL); LAS int* tiles = (LAS int*)(lds + AT_TILES);
    LAS unsigned* ctl = (LAS unsigned*)(lds + AT_CTL); LAS float* kms = (LAS float*)(lds + AT_KM);
    const bf16* QA = (const bf16*)(ws + WS_QA); const bf16* KA = (const bf16*)(ws + WS_KA); const bf16* VAT = (const bf16*)(ws + WS_VAT);
    u32x4 sr[8], qst[4];
    const int row0 = tid >> 4, ch = tid & 15;
    const bf16* kbase = KA + (size_t)(b * SEQ + row0) * 1024 + h * 128 + ch * 8;
    const bf16* vbase = VAT + (size_t)(bh * 128 + row0) * 2048 + ch * 8;
#define AT_LOAD(ks0_) do { _Pragma("unroll") for (int i = 0; i < 4; ++i) { \
        sr[i] = *(const u32x4*)(kbase + (size_t)((ks0_) + 32 * i) * 1024); sr[4 + i] = *(const u32x4*)(vbase + (size_t)(32 * i) * 2048 + (ks0_)); } } while (0)
#pragma unroll
    for (int i = 0; i < 4; ++i) qst[i] = *(const u32x4*)(QA + (size_t)(b * SEQ + q0 + row0 + 32 * i) * 1024 + h * 128 + ch * 8);
    AT_LOAD(blk * 256);
    if (tid <= 128) tab[tid] = a->in[I_RELB][rel_bucket_dev(tid) * 8 + h] * 1.4426950408889634f;
    for (int idx = tid; idx < 1024; idx += NTHR) kms[idx] = ((const float*)(ws + MS_KMEAN))[bh * 1024 + idx];
    if (tid == 0) ctl[0] = 0u;
    __syncthreads();
    {
        const int q = tid >> 2, part = tid & 3;
        const bf16* qp = QA + (size_t)(b * SEQ + q0 + q) * 1024 + h * 128 + part * 32;
        float qf32[32];
#pragma unroll
        for (int i = 0; i < 4; ++i) { const u32x4 v = *(const u32x4*)(qp + 8 * i);
            qf32[8 * i + 0] = bflo(v.x); qf32[8 * i + 1] = bfhi(v.x); qf32[8 * i + 2] = bflo(v.y); qf32[8 * i + 3] = bfhi(v.y);
            qf32[8 * i + 4] = bflo(v.z); qf32[8 * i + 5] = bfhi(v.z); qf32[8 * i + 6] = bflo(v.w); qf32[8 * i + 7] = bfhi(v.w); }
        float gate[8];
#pragma unroll
        for (int n = 0; n < 8; ++n) { float s = 0.f;
            if (n < blk) {
#pragma unroll
                for (int d = 0; d < 32; d += 4) { const f32x4 kv = *(const LAS f32x4*)(kms + n * 128 + part * 32 + d);
                    s += (qf32[d] * kv.x + qf32[d + 1] * kv.y) + (qf32[d + 2] * kv.z + qf32[d + 3] * kv.w); }
            }
            s += __shfl_xor(s, 1); s += __shfl_xor(s, 2); gate[n] = s; }
        if (part == 0) {
            unsigned sel;
            if (blk <= 3) sel = (1u << blk) - 1u;
            else { sel = 0u;
#pragma unroll
                for (int it = 0; it < 3; ++it) { int best = 0; float bv = -3.0e38f;
#pragma unroll
                    for (int n = 0; n < 8; ++n) if (n < blk && !((sel >> n) & 1u) && gate[n] > bv) { bv = gate[n]; best = n; }
                    sel |= 1u << best; } }
            sels[q] = sel; atomicOr((unsigned*)ctl, sel);
        }
    }
    __syncthreads();
    if (tid == 0) { int nt = 0; const unsigned any = ctl[0];
        for (int j = 0; j < half + 1; ++j) tiles[nt++] = blk * 256 + 128 * j;
        for (int n = 0; n < blk; ++n) if ((any >> n) & 1u) for (int j = 0; j < 2; ++j) tiles[nt++] = n * 256 + 128 * j;
        ctl[1] = (unsigned)nt; }
    __syncthreads();
    const int ntiles = (int)ctl[1];
    const int qg = wave & 3, kp = wave >> 2;
    int qpos[2]; unsigned mysel[2];
#pragma unroll
    for (int f = 0; f < 2; ++f) { qpos[f] = q0 + 32 * qg + 16 * f + q16; mysel[f] = sels[32 * qg + 16 * f + q16]; }
    constexpr int AT_Q = 77824;
#pragma unroll
    for (int i = 0; i < 4; ++i) *(LAS u32x4*)(lds + AT_Q + (row0 + 32 * i) * 272 + ch * 16) = qst[i];
    const LAS unsigned char* qrow = lds + AT_Q + (32 * qg + q16) * 272 + 16 * g;
    float m_run[2] = {-1.0e30f, -1.0e30f}, l_run[2] = {0.f, 0.f};
    f32x4 oacc[2][8];
#pragma unroll
    for (int f = 0; f < 2; ++f)
#pragma unroll
        for (int m = 0; m < 8; ++m) oacc[f][m] = (f32x4){0.f, 0.f, 0.f, 0.f};
    const int vpos = (ch >> 2) * 32 + 16 * (ch & 1) + 4 * ((ch & 3) >> 1);
#define AT_WRITE() do { _Pragma("unroll") for (int i = 0; i < 4; ++i) { \
        *(LAS u32x4*)(lds + AT_KT + (row0 + 32 * i) * 272 + ch * 16) = sr[i]; \
        *(LAS u32x2*)(lds + AT_VT + (row0 + 32 * i) * 272 + vpos * 2) = (u32x2){sr[4 + i].x, sr[4 + i].y}; \
        *(LAS u32x2*)(lds + AT_VT + (row0 + 32 * i) * 272 + (vpos + 8) * 2) = (u32x2){sr[4 + i].z, sr[4 + i].w}; } } while (0)
    AT_WRITE();
    __syncthreads();
    if (ntiles > 1) { const int k1 = tiles[1]; AT_LOAD(k1); }
    for (int ti = 0; ti < ntiles; ++ti) {
        const int kstart = tiles[ti] + 64 * kp, nblk = kstart >> 8;
        const bool own = (nblk == blk);
        const bool any_ok = own ? true : (__any((((mysel[0] | mysel[1]) >> nblk) & 1u) != 0u) != 0);
        const bool active = own ? (kstart <= q0 + 32 * qg + 31) : any_ok;
        if (active) {
            const LAS unsigned char* kt = lds + AT_KT + 64 * kp * 272; const LAS unsigned char* vt = lds + AT_VT + 64 * kp * 2;
            f32x4 s[2][4];
#pragma unroll
            for (int n = 0; n < 4; ++n) { s[0][n] = (f32x4){0.f, 0.f, 0.f, 0.f}; s[1][n] = s[0][n]; }
#pragma unroll
            for (int ks = 0; ks < 4; ++ks) {
                bf16x8 q0f = *(const LAS bf16x8*)(qrow + 64 * ks), q1f = *(const LAS bf16x8*)(qrow + 16 * 272 + 64 * ks);
                bf16x8 kf[4];
#pragma unroll
                for (int n = 0; n < 4; ++n) kf[n] = *(const LAS bf16x8*)(kt + (16 * n + q16) * 272 + (32 * ks + 8 * g) * 2);
                asm volatile("" : "+v"(q0f), "+v"(q1f), "+v"(kf[0]), "+v"(kf[1]), "+v"(kf[2]), "+v"(kf[3]));
#pragma unroll
                for (int n = 0; n < 4; ++n) {
                    s[0][n] = __builtin_amdgcn_mfma_f32_16x16x32_bf16(kf[n], q0f, s[0][n], 0, 0, 0);
                    s[1][n] = __builtin_amdgcn_mfma_f32_16x16x32_bf16(kf[n], q1f, s[1][n], 0, 0, 0); } }
            const bool far = ((q0 + 32 * qg) - (kstart + 63)) >= 128;
            const float bfar = tab[128];
#pragma unroll
            for (int f = 0; f < 2; ++f) {
                const bool lane_ok = own ? true : (((mysel[f] >> nblk) & 1u) != 0u);
                float psum = 0.f, m_new;
#define AT_MNEW(mx_) fmaxf(((mx_) > m_run[f] + 8.0f) ? (mx_) : m_run[f], -1.0e29f)
                if (far) {
                    const float addc = lane_ok ? bfar : -1.0e30f;
                    float mx = -1.0e30f;
#pragma unroll
                    for (int n = 0; n < 4; ++n)
#pragma unroll
                        for (int r = 0; r < 4; ++r) mx = fmaxf(mx, s[f][n][r]);
                    mx = rows4_max(mx + addc);
                    m_new = AT_MNEW(mx);
                    const float cc = addc - m_new;
#pragma unroll
                    for (int n = 0; n < 4; ++n)
#pragma unroll
                        for (int r = 0; r < 4; ++r) { const float p = __builtin_amdgcn_exp2f(s[f][n][r] + cc); s[f][n][r] = p; psum += p; }
                } else {
                    const int kmax = lane_ok ? (own ? qpos[f] : 0x7fffffff) : -1;
                    float mx = -1.0e30f;
                    float bs[4][4];
#pragma unroll
                    for (int n = 0; n < 4; ++n)
#pragma unroll
                        for (int r = 0; r < 4; ++r) { int di = qpos[f] - (kstart + 16 * n + 4 * g + r); di = di < 0 ? 0 : di; di = di > 128 ? 128 : di; bs[n][r] = tab[di]; }
#pragma unroll
                    for (int n = 0; n < 4; ++n) asm volatile("" : "+v"(bs[n][0]), "+v"(bs[n][1]), "+v"(bs[n][2]), "+v"(bs[n][3]));
#pragma unroll
                    for (int n = 0; n < 4; ++n)
#pragma unroll
                        for (int r = 0; r < 4; ++r) { const int key = kstart + 16 * n + 4 * g + r;
                            const float v = (key <= kmax) ? s[f][n][r] + bs[n][r] : -1.0e30f;
                            s[f][n][r] = v; mx = fmaxf(mx, v); }
                    mx = rows4_max(mx);
                    m_new = AT_MNEW(mx);
#pragma unroll
                    for (int n = 0; n < 4; ++n)
#pragma unroll
                        for (int r = 0; r < 4; ++r) { const float p = __builtin_amdgcn_exp2f(s[f][n][r] - m_new); s[f][n][r] = p; psum += p; }
                }
#undef AT_MNEW
                const float alpha = __builtin_amdgcn_exp2f(m_run[f] - m_new);
                psum = rows4_sum(psum);
                l_run[f] = l_run[f] * alpha + psum;
                if (__any(m_new != m_run[f])) {
#pragma unroll
                    for (int m = 0; m < 8; ++m) oacc[f][m] = oacc[f][m] * alpha;
                }
                m_run[f] = m_new;
            }
#pragma unroll
            for (int k2 = 0; k2 < 2; ++k2) {
                bf16x8 pf[2];
#pragma unroll
                for (int f = 0; f < 2; ++f) { u32x4 pb; pb.x = cvt_pk_bf16(s[f][2 * k2][0], s[f][2 * k2][1]); pb.y = cvt_pk_bf16(s[f][2 * k2][2], s[f][2 * k2][3]);
                    pb.z = cvt_pk_bf16(s[f][2 * k2 + 1][0], s[f][2 * k2 + 1][1]); pb.w = cvt_pk_bf16(s[f][2 * k2 + 1][2], s[f][2 * k2 + 1][3]);
                    pf[f] = __builtin_bit_cast(bf16x8, pb); }
#pragma unroll
                for (int mh = 0; mh < 2; ++mh) {
                    bf16x8 af[4];
#pragma unroll
                    for (int m = 0; m < 4; ++m) af[m] = *(const LAS bf16x8*)(vt + (16 * (4 * mh + m) + q16) * 272 + (32 * k2 + 8 * g) * 2);
                    asm volatile("" : "+v"(af[0]), "+v"(af[1]), "+v"(af[2]), "+v"(af[3]));
#pragma unroll
                    for (int m = 0; m < 4; ++m) {
                        oacc[0][4 * mh + m] = __builtin_amdgcn_mfma_f32_16x16x32_bf16(af[m], pf[0], oacc[0][4 * mh + m], 0, 0, 0);
                        oacc[1][4 * mh + m] = __builtin_amdgcn_mfma_f32_16x16x32_bf16(af[m], pf[1], oacc[1][4 * mh + m], 0, 0, 0); } }
            }
        }
        __syncthreads();
        if (ti + 1 < ntiles) { AT_WRITE(); }
        __syncthreads();
        if (ti + 2 < ntiles) { const int kn = tiles[ti + 2]; AT_LOAD(kn); }
    }
    LAS float* mo = (LAS float*)lds; LAS float* ml = (LAS float*)(lds + 65536);
    if (kp == 1) {
#pragma unroll
        for (int f = 0; f < 2; ++f) {
#pragma unroll
            for (int m = 0; m < 8; ++m)
#pragma unroll
                for (int r = 0; r < 4; ++r) mo[((qg * 2 + f) * 8 + m) * 256 + r * 64 + lane] = oacc[f][m][r];
            ml[(qg * 2 + f) * 128 + lane] = m_run[f]; ml[(qg * 2 + f) * 128 + 64 + lane] = l_run[f]; }
    }
    __syncthreads();
    if (kp == 0) {
#pragma unroll
        for (int f = 0; f < 2; ++f) {
            const float m1 = ml[(qg * 2 + f) * 128 + lane], l1 = ml[(qg * 2 + f) * 128 + 64 + lane];
            const float mm = fmaxf(m_run[f], m1), a0 = __builtin_amdgcn_exp2f(m_run[f] - mm), a1 = __builtin_amdgcn_exp2f(m1 - mm);
            const float inv = __builtin_amdgcn_rcpf(l_run[f] * a0 + l1 * a1);
            bf16* HA = (bf16*)(ws + WS_HA) + (size_t)(b * SEQ + qpos[f]) * 1024 + h * 128 + 4 * g;
#pragma unroll
            for (int m = 0; m < 8; ++m) { float o[4];
#pragma unroll
                for (int r = 0; r < 4; ++r) o[r] = (oacc[f][m][r] * a0 + mo[((qg * 2 + f) * 8 + m) * 256 + r * 64 + lane] * a1) * inv;
                u32x2 w; w.x = cvt_pk_bf16(o[0], o[1]); w.y = cvt_pk_bf16(o[2], o[3]); *(u32x2*)(HA + 16 * m) = w; }
        }
    }
#undef AT_LOAD
#undef AT_WRITE
}

constexpr int MC_Q = 0, MC_K = 33792, MC_SP = 67584, MC_SC = 76800, MC_NV = 79104;
struct McRegs { u32x4 qr[4], kr[4]; float sc4[4]; float nv0; bf16x8 cb[8][2], vbf[2][2]; u32x2 ovv[8]; };
__device__ __forceinline__ void mc_load_qk(McRegs& R, const unsigned char* ws, int u, int tid) {
    const int bh = u >> 5, c = u & 31, b = bh >> 2, h = bh & 3; const size_t tok0 = (size_t)b * SEQ + 64 * c;
    const bf16* QM = (const bf16*)(ws + WS_QM); const bf16* KM = (const bf16*)(ws + WS_KM);
#pragma unroll
    for (int i = 0; i < 4; ++i) { const int idx = tid + NTHR * i, row = idx >> 5, ch = idx & 31;
        R.qr[i] = *(const u32x4*)(QM + (tok0 + row) * 1024 + h * 256 + ch * 8); R.kr[i] = *(const u32x4*)(KM + (tok0 + row) * 1024 + h * 256 + ch * 8); }
}
__device__ __forceinline__ void mc_load_sc(McRegs& R, const unsigned char* ws, int u, int tid) {
    const int bh = u >> 5, c = u & 31; const int s = bh * 2048 + 64 * c + (tid & 63);
    R.sc4[0] = ((const float*)(ws + MS_AS))[s]; R.sc4[1] = ((const float*)(ws + MS_GT))[s]; R.sc4[2] = ((const float*)(ws + MS_WI))[s]; R.sc4[3] = ((const float*)(ws + MS_CL))[s];
    R.nv0 = ((const float*)(ws + MS_NVEC))[(size_t)(bh * 32 + c) * 256 + (tid & 255)];
}
__device__ __forceinline__ void mc_load_cb(McRegs& R, const unsigned char* ws, int u, int lane, int wave) {
    const bf16* Cp = (const bf16*)(ws + WS_CST) + (size_t)u * 65536 + (size_t)(2 * wave) * 512 + lane * 8;
#pragma unroll
    for (int ks = 0; ks < 8; ++ks) { R.cb[ks][0] = *(const bf16x8*)(Cp + ks * 8192); R.cb[ks][1] = *(const bf16x8*)(Cp + ks * 8192 + 512); }
}
__device__ __forceinline__ void mc_load_v(McRegs& R, const unsigned char* ws, int u, int lane, int wave) {
    const bf16* Vp = (const bf16*)(ws + WS_VMT) + (size_t)u * 16384 + (size_t)(2 * wave) * 512 + lane * 8;
#pragma unroll
    for (int ks = 0; ks < 2; ++ks) { R.vbf[ks][0] = *(const bf16x8*)(Vp + ks * 8192); R.vbf[ks][1] = *(const bf16x8*)(Vp + ks * 8192 + 512); }
}
__device__ __forceinline__ void mc_load_ov(McRegs& R, const unsigned char* ws, int u, int lane, int wave) {
    const int bh = u >> 5, c = u & 31, b = bh >> 2, h = bh & 3; const size_t tok0 = (size_t)b * SEQ + 64 * c;
    const bf16* OM = (const bf16*)(ws + WS_OM);
#pragma unroll
    for (int i = 0; i < 8; ++i) R.ovv[i] = *(const u32x2*)(OM + (tok0 + 8 * wave + i) * 1024 + h * 256 + 4 * lane);
}
template <bool PF, bool HAVE>
__device__ __forceinline__ void mlstm_c_body(ArgsP a, int l, LAS unsigned char* lds, int u, int un, McRegs& R, int tid_, int lane_, int wave) {
    unsigned char* ws = a->ws;
    int tid = wave * 64 + lane_id(); asm volatile("" : "+v"(tid));
    const int lane = tid & 63; (void)tid_; (void)lane_;
    const int bh = u >> 5, c = u & 31, b = bh >> 2, h = bh & 3, t0 = 64 * c, q16 = lane & 15, g = lane >> 4;
    const size_t tok0 = (size_t)b * SEQ + t0;
    LAS unsigned char* Qs = lds + MC_Q; LAS unsigned char* Ks = lds + MC_K; LAS unsigned char* Sp = lds + MC_SP;
    LAS float* sc = (LAS float*)(lds + MC_SC); LAS float* as_ = sc; LAS float* gt_ = sc + 64; LAS float* wi_ = sc + 128; LAS float* cl_ = sc + 192; LAS float* qn_ = sc + 256; LAS float* denp = sc + 320;
    LAS float* nvec = (LAS float*)(lds + MC_NV);
    mc_load_qk(R, ws, u, tid); mc_load_sc(R, ws, u, tid);
    if (!HAVE) mc_load_cb(R, ws, u, lane, wave);
#pragma unroll
    for (int i = 0; i < 4; ++i) { const int idx = tid + NTHR * i, row = idx >> 5, ch = idx & 31;
        *(LAS u32x4*)(Qs + row * 528 + ch * 16) = R.qr[i]; *(LAS u32x4*)(Ks + row * 528 + ch * 16) = R.kr[i]; }
    mc_load_v(R, ws, u, lane, wave);
    if (tid < 64) { as_[tid] = R.sc4[0]; gt_[tid] = R.sc4[1]; wi_[tid] = R.sc4[2]; cl_[tid] = R.sc4[3]; }
    if (tid < 256) nvec[tid] = R.nv0;
    __syncthreads();
    f32x4 acc[4][2];
#pragma unroll
    for (int m = 0; m < 4; ++m) { acc[m][0] = (f32x4){0.f, 0.f, 0.f, 0.f}; acc[m][1] = acc[m][0]; }
    if (c > 0) {
#pragma unroll
        for (int ks = 0; ks < 8; ++ks) {
#pragma unroll
            for (int m = 0; m < 4; ++m) { const bf16x8 af = *(const LAS bf16x8*)(Qs + (16 * m + q16) * 528 + (32 * ks + 8 * g) * 2);
                acc[m][0] = __builtin_amdgcn_mfma_f32_16x16x32_bf16(af, R.cb[ks][0], acc[m][0], 0, 0, 0);
                acc[m][1] = __builtin_amdgcn_mfma_f32_16x16x32_bf16(af, R.cb[ks][1], acc[m][1], 0, 0, 0); }
        }
#pragma unroll
        for (int m = 0; m < 4; ++m)
#pragma unroll
            for (int r = 0; r < 4; ++r) { const float w = wi_[16 * m + 4 * g + r]; acc[m][0][r] *= w; acc[m][1][r] *= w; }
    }
    {
        const int mS = wave & 3, nS0 = 2 * (wave >> 2);
        f32x4 sacc[2]; sacc[0] = (f32x4){0.f, 0.f, 0.f, 0.f}; sacc[1] = sacc[0];
#pragma unroll
        for (int kh = 0; kh < 4; ++kh) {
            bf16x8 af[2], bq[2][2];
#pragma unroll
            for (int k2 = 0; k2 < 2; ++k2) { const int ks = 2 * kh + k2;
                af[k2] = *(const LAS bf16x8*)(Qs + (16 * mS + q16) * 528 + (32 * ks + 8 * g) * 2);
#pragma unroll
                for (int nn = 0; nn < 2; ++nn) bq[k2][nn] = *(const LAS bf16x8*)(Ks + (16 * (nS0 + nn) + q16) * 528 + (32 * ks + 8 * g) * 2); }
            asm volatile("" : "+v"(af[0]), "+v"(af[1]), "+v"(bq[0][0]), "+v"(bq[0][1]), "+v"(bq[1][0]), "+v"(bq[1][1]));
#pragma unroll
            for (int k2 = 0; k2 < 2; ++k2)
#pragma unroll
                for (int nn = 0; nn < 2; ++nn) sacc[nn] = __builtin_amdgcn_mfma_f32_16x16x32_bf16(af[k2], bq[k2][nn], sacc[nn], 0, 0, 0);
        }
#pragma unroll
        for (int nn = 0; nn < 2; ++nn) { const int s = 16 * (nS0 + nn) + q16; const float av = as_[s];
#pragma unroll
            for (int r = 0; r < 4; ++r) { const int t = 16 * mS + 4 * g + r;
                float val = (s <= t) ? sacc[nn][r] * __expf(av - gt_[t]) : 0.f;
                *(LAS unsigned short*)(Sp + t * 144 + s * 2) = (unsigned short)(cvt_pk_bf16(val, val) & 0xffffu);
                val += __shfl_xor(val, 1); val += __shfl_xor(val, 2); val += __shfl_xor(val, 4); val += __shfl_xor(val, 8);
                if (q16 == 0) denp[(nS0 + nn) * 64 + t] = val; } }
    }
    {
        const int t = tid >> 3, seg = tid & 7; float s = 0.f;
#pragma unroll
        for (int i = 0; i < 4; ++i) { const u32x4 v = *(const LAS u32x4*)(Qs + t * 528 + (seg * 32 + 8 * i) * 2); const LAS float* nv = nvec + seg * 32 + 8 * i;
            s += bflo(v.x) * nv[0] + bfhi(v.x) * nv[1] + bflo(v.y) * nv[2] + bfhi(v.y) * nv[3] + bflo(v.z) * nv[4] + bfhi(v.z) * nv[5] + bflo(v.w) * nv[6] + bfhi(v.w) * nv[7]; }
        s += __shfl_xor(s, 1); s += __shfl_xor(s, 2); s += __shfl_xor(s, 4);
        if (seg == 0) qn_[t] = s;
    }
    __syncthreads();
    if (PF) {
#pragma unroll
        for (int ks = 0; ks < 8; ++ks) asm volatile("" :: "v"(R.cb[ks][0]), "v"(R.cb[ks][1]));
        __builtin_amdgcn_sched_barrier(0);
        mc_load_cb(R, ws, un, lane, wave);
        __builtin_amdgcn_sched_barrier(0);
    }
    {
#pragma unroll
        for (int ks = 0; ks < 2; ++ks) {
            bf16x8 sf[4];
#pragma unroll
            for (int m = 0; m < 4; ++m) sf[m] = *(const LAS bf16x8*)(Sp + (16 * m + q16) * 144 + (32 * ks + 8 * g) * 2);
            asm volatile("" : "+v"(sf[0]), "+v"(sf[1]), "+v"(sf[2]), "+v"(sf[3]));
#pragma unroll
            for (int m = 0; m < 4; ++m) {
                acc[m][0] = __builtin_amdgcn_mfma_f32_16x16x32_bf16(sf[m], R.vbf[ks][0], acc[m][0], 0, 0, 0);
                acc[m][1] = __builtin_amdgcn_mfma_f32_16x16x32_bf16(sf[m], R.vbf[ks][1], acc[m][1], 0, 0, 0); }
        }
    }
    LAS float* NUM = (LAS float*)lds;
#pragma unroll
    for (int m = 0; m < 4; ++m)
#pragma unroll
        for (int r = 0; r < 4; ++r) { const int t = 16 * m + 4 * g + r;
            const float den = (denp[t] + denp[64 + t]) + (denp[128 + t] + denp[192 + t]) + wi_[t] * qn_[t];
            const float inv = __builtin_amdgcn_rcpf(fmaxf(fabsf(den), cl_[t]));
            NUM[t * 260 + 32 * wave + q16] = acc[m][0][r] * inv; NUM[t * 260 + 32 * wave + 16 + q16] = acc[m][1][r] * inv; }
    __syncthreads();
    {
        const float* mg = a->in[I_MNG] + l * 1024 + h * 256 + 4 * lane; const f32x4 gn = *(const f32x4*)mg;
        bf16* HM = (bf16*)(ws + WS_HM);
        mc_load_ov(R, ws, u, lane, wave);
        asm volatile("" : "+v"(R.ovv[0]), "+v"(R.ovv[1]), "+v"(R.ovv[2]), "+v"(R.ovv[3]), "+v"(R.ovv[4]), "+v"(R.ovv[5]), "+v"(R.ovv[6]), "+v"(R.ovv[7]));
#pragma unroll
        for (int i = 0; i < 8; ++i) { const int t = 8 * wave + i;
            const f32x4 v = *(const LAS f32x4*)(NUM + t * 260 + 4 * lane);
            const float mu = wave_sum((v.x + v.y) + (v.z + v.w)) * (1.0f / 256.0f);
            const f32x4 d = v - mu;
            const float var = wave_sum((d.x * d.x + d.y * d.y) + (d.z * d.z + d.w * d.w)) * (1.0f / 256.0f);
            const float rstd = __builtin_amdgcn_rsqf(var + LN_EPS);
            const u32x2 ov = R.ovv[i];
            u32x2 w; w.x = cvt_pk_bf16(d.x * rstd * gn.x * bflo(ov.x), d.y * rstd * gn.y * bfhi(ov.x)); w.y = cvt_pk_bf16(d.z * rstd * gn.z * bflo(ov.y), d.w * rstd * gn.w * bfhi(ov.y));
            *(u32x2*)(HM + (tok0 + t) * 1024 + h * 256 + 4 * lane) = w; }
    }
    __syncthreads();
}
__device__ __forceinline__ void mlstm_c_phase(ArgsP a, int l, LAS unsigned char* lds, int tid, int lane, int wave, int bid, int G) {
    int u = bid; if (u >= 512) return;
    McRegs R;
    if (u + G < 512 && u + 2 * G >= 512) {
        mlstm_c_body<true, false>(a, l, lds, u, u + G, R, tid, lane, wave);
        mlstm_c_body<false, true>(a, l, lds, u + G, u + G, R, tid, lane, wave);
    } else {
#pragma unroll 1
        for (; u < 512; u += G) mlstm_c_body<false, false>(a, l, lds, u, u, R, tid, lane, wave);
    }
}

struct SchedStd {
    static constexpr bool GATHER = false;
    const char* A; const char* B; int nM, nN, K, G, c;
    __device__ __forceinline__ bool next(int i, Unit& u) const { const int L = i * G + c; if (L >= nM * nN) return false; pg8::static_tile(L, nM, nN, u.pm, u.pn); u.aux = 0; return true; }
    __device__ __forceinline__ const char* abase(const Unit& u) const { return A + (size_t)u.pm * 512 * K; }
    __device__ __forceinline__ const char* bbase(const Unit& u) const { return B + (size_t)u.pn * 512 * K; }
    __device__ __forceinline__ unsigned arow(const Unit&, int) const { return 0u; }
    static __device__ __forceinline__ bool keep_acc(const Unit&) { return false; }
};
struct SchedBr {
    static constexpr bool GATHER = false;
    const char* HM; const char* HA; const char* WM; const char* WA; int G, c;
    __device__ __forceinline__ bool next(int i, Unit& u) const { const int L = (i >> 1) * G + c; if (L >= 256) return false; pg8::static_tile(L, 32, 8, u.pm, u.pn); u.aux = i & 1; return true; }
    __device__ __forceinline__ const char* abase(const Unit& u) const { return (u.aux ? HA : HM) + (size_t)u.pm * 512 * 1024; }
    __device__ __forceinline__ const char* bbase(const Unit& u) const { return (u.aux ? WA : WM) + (size_t)u.pn * 512 * 1024; }
    __device__ __forceinline__ unsigned arow(const Unit&, int) const { return 0u; }
    static __device__ __forceinline__ bool keep_acc(const Unit& u) { return u.aux == 0; }
};
struct EpiBr {
    static constexpr bool PERM = true;
    const bf16* SG; bf16* Y;
    __device__ __forceinline__ void operator()(f32x4 (&acc)[2][2][4][2], const Unit& u, int wr, int wc, int fr, int fq) const {
        const int row0 = u.pm * 256 + wr * 64 + fr, col0 = u.pn * 256 + wc * 32 + 8 * fq;
#pragma unroll
        for (int ai = 0; ai < 2; ++ai) {
            u32x4 sa[4][2], sm[4][2];
#pragma unroll
            for (int m = 0; m < 4; ++m) { const size_t row = row0 + ai * 128 + m * 16;
#pragma unroll
                for (int bj = 0; bj < 2; ++bj) { const int col = col0 + bj * 128;
                    sa[m][bj] = *(const u32x4*)(SG + row * 4096 + 2048 + col);
                    sm[m][bj] = *(const u32x4*)(SG + row * 4096 + (u.aux == 0 ? 0 : 2048) + col); } }
            asm volatile("" : "+v"(sa[0][0]), "+v"(sa[0][1]), "+v"(sa[1][0]), "+v"(sa[1][1]), "+v"(sa[2][0]), "+v"(sa[2][1]), "+v"(sa[3][0]), "+v"(sa[3][1]),
                              "+v"(sm[0][0]), "+v"(sm[0][1]), "+v"(sm[1][0]), "+v"(sm[1][1]), "+v"(sm[2][0]), "+v"(sm[2][1]), "+v"(sm[3][0]), "+v"(sm[3][1]));
#pragma unroll
            for (int m = 0; m < 4; ++m) { const size_t row = row0 + ai * 128 + m * 16;
#pragma unroll
                for (int bj = 0; bj < 2; ++bj) { const int col = col0 + bj * 128;
                    const u32x4 a4 = sa[m][bj], m4 = sm[m][bj];
                    const float ga[8] = {bflo(a4.x), bfhi(a4.x), bflo(a4.y), bfhi(a4.y), bflo(a4.z), bfhi(a4.z), bflo(a4.w), bfhi(a4.w)};
                    if (u.aux == 0) {
                        const float gm[8] = {bflo(m4.x), bfhi(m4.x), bflo(m4.y), bfhi(m4.y), bflo(m4.z), bfhi(m4.z), bflo(m4.w), bfhi(m4.w)};
#pragma unroll
                        for (int j = 0; j < 4; ++j) { acc[ai][bj][m][0][j] *= gm[j] * __builtin_amdgcn_rcpf(fmaxf(ga[j], 1.0e-30f)); acc[ai][bj][m][1][j] *= gm[4 + j] * __builtin_amdgcn_rcpf(fmaxf(ga[4 + j], 1.0e-30f)); }
                    } else {
                        const f32x4 v0 = acc[ai][bj][m][0], v1 = acc[ai][bj][m][1];
                        u32x4 w; w.x = cvt_pk_bf16(v0[0] * ga[0], v0[1] * ga[1]); w.y = cvt_pk_bf16(v0[2] * ga[2], v0[3] * ga[3]);
                        w.z = cvt_pk_bf16(v1[0] * ga[4], v1[1] * ga[5]); w.w = cvt_pk_bf16(v1[2] * ga[6], v1[3] * ga[7]);
                        *(u32x4*)(Y + row * 2048 + col) = w; }
                } }
        }
    }
};
struct EpiOut {
    static constexpr bool PERM = false;
    const float* res; float* out;
    __device__ __forceinline__ void operator()(f32x4 (&acc)[2][2][4][2], const Unit& u, int wr, int wc, int fr, int fq) const {
        const int row0 = u.pm * 256 + wr * 64 + fr, col0 = u.pn * 256 + wc * 32 + 4 * fq;
#pragma unroll
        for (int ai = 0; ai < 2; ++ai) {
            f32x4 rv[4][2][2];
#pragma unroll
            for (int m = 0; m < 4; ++m) { const size_t ro = (size_t)(row0 + ai * 128 + m * 16) * DM + col0;
#pragma unroll
                for (int bj = 0; bj < 2; ++bj)
#pragma unroll
                    for (int n = 0; n < 2; ++n) rv[m][bj][n] = *(const f32x4*)(res + ro + bj * 128 + n * 16); }
#pragma unroll
            for (int m = 0; m < 4; ++m) asm volatile("" : "+v"(rv[m][0][0]), "+v"(rv[m][0][1]), "+v"(rv[m][1][0]), "+v"(rv[m][1][1]));
#pragma unroll
            for (int m = 0; m < 4; ++m) { const size_t ro = (size_t)(row0 + ai * 128 + m * 16) * DM + col0;
#pragma unroll
                for (int bj = 0; bj < 2; ++bj)
#pragma unroll
                    for (int n = 0; n < 2; ++n) *(f32x4*)(out + ro + bj * 128 + n * 16) = rv[m][bj][n] + acc[ai][bj][m][n]; }
        }
    }
};
struct SchedMoe1 {
    static constexpr bool GATHER = true;
    const char* H; const char* W13; const int* LIST; const LAS int* te; const LAS int* tr0; const LAS int* cnt; int MT, G, c;
    __device__ __forceinline__ bool next(int i, Unit& u) const { const int L = i * G + c; if (L >= 2 * MT) return false; u.pm = L >> 1; u.pn = L & 1; u.aux = __builtin_amdgcn_readfirstlane(te[u.pm]); return true; }
    __device__ __forceinline__ const char* abase(const Unit&) const { return H; }
    __device__ __forceinline__ const char* bbase(const Unit& u) const { return W13 + ((size_t)u.aux * 512 + u.pn * 256) * 4096; }
    static __device__ __forceinline__ bool keep_acc(const Unit&) { return false; }
    __device__ __forceinline__ unsigned arow(const Unit& u, int r) const { const int rr = __builtin_amdgcn_readfirstlane(tr0[u.pm]) + r; return rr < __builtin_amdgcn_readfirstlane(cnt[u.aux]) ? (unsigned)LIST[u.aux * 8192 + rr] : 0u; }
};
struct EpiMoe1 {
    static constexpr bool PERM = true;
    bf16* HID; const float* PWL; const LAS int* tr0; const LAS int* cnt;
    __device__ __forceinline__ void operator()(f32x4 (&acc)[2][2][4][2], const Unit& u, int wr, int wc, int fr, int fq) const {
#pragma unroll
        for (int ai = 0; ai < 2; ++ai)
#pragma unroll
            for (int m = 0; m < 4; ++m) { const int r = ai * 128 + wr * 64 + m * 16 + fr;
                const float pw = 1.0f;
                float o[8];
#pragma unroll
                for (int n = 0; n < 2; ++n)
#pragma unroll
                    for (int j = 0; j < 4; ++j) { const float x1 = acc[ai][0][m][n][j], x3 = acc[ai][1][m][n][j]; o[4 * n + j] = x1 * sigmoidf_(x1) * x3 * pw; }
                u32x4 w; w.x = cvt_pk_bf16(o[0], o[1]); w.y = cvt_pk_bf16(o[2], o[3]); w.z = cvt_pk_bf16(o[4], o[5]); w.w = cvt_pk_bf16(o[6], o[7]);
                *(u32x4*)(HID + (size_t)(u.pm * 256 + r) * 256 + u.pn * 128 + wc * 32 + 8 * fq) = w; }
    }
};
struct SchedMoe2 {
    static constexpr bool GATHER = false;
    const char* HID; const char* W2; const LAS int* te; int MT, G, c;
    __device__ __forceinline__ bool next(int i, Unit& u) const { const int L = i * G + c; if (L >= 8 * MT) return false; u.pm = L >> 3; u.pn = L & 7; u.aux = __builtin_amdgcn_readfirstlane(te[u.pm]); return true; }
    __device__ __forceinline__ const char* abase(const Unit& u) const { return HID + (size_t)u.pm * 256 * 512; }
    __device__ __forceinline__ const char* bbase(const Unit& u) const { return W2 + ((size_t)u.aux * 2048 + u.pn * 256) * 512; }
    __device__ __forceinline__ unsigned arow(const Unit&, int) const { return 0u; }
    static __device__ __forceinline__ bool keep_acc(const Unit&) { return false; }
};
struct EpiMoe2 {
    static constexpr bool PERM = true;
    bf16* OP;
    __device__ __forceinline__ void operator()(f32x4 (&acc)[2][2][4][2], const Unit& u, int wr, int wc, int fr, int fq) const {
        const int row0 = u.pm * 256 + wr * 64 + fr, col0 = u.pn * 256 + wc * 32 + 8 * fq;
#pragma unroll
        for (int ai = 0; ai < 2; ++ai)
#pragma unroll
            for (int m = 0; m < 4; ++m) { bf16* rowp = OP + (size_t)(row0 + ai * 128 + m * 16) * DM + col0;
#pragma unroll
                for (int bj = 0; bj < 2; ++bj) { const f32x4 v0 = acc[ai][bj][m][0], v1 = acc[ai][bj][m][1];
                    u32x4 w; w.x = cvt_pk_bf16(v0[0], v0[1]); w.y = cvt_pk_bf16(v0[2], v0[3]); w.z = cvt_pk_bf16(v1[0], v1[1]); w.w = cvt_pk_bf16(v1[2], v1[3]);
                    *(u32x4*)(rowp + bj * 128) = w; } }
    }
};

constexpr int N_PHASES = 22;
__global__ void __launch_bounds__(NTHR, 2) fwd_kernel(Args a) {
    extern __shared__ __attribute__((aligned(16))) unsigned char lds_raw[];
    LAS unsigned char* lds0 = (LAS unsigned char*)lds_raw;
    const int tid0 = threadIdx.x, bid0 = blockIdx.x, G0 = gridDim.x;
    const int wave0 = __builtin_amdgcn_readfirstlane(tid0 >> 6);
#define PH_IDS() ArgsP ap = (ArgsP)__builtin_amdgcn_kernarg_segment_ptr(); asm volatile("" : "+s"(ap)); unsigned lb_ = 0u; asm volatile("" : "+s"(lb_)); LAS unsigned char* lds = lds0 + lb_; LAS unsigned char* misc = lds + MISC_OFF; (void)misc; unsigned char* ws = ap->ws; (void)ws; int bid = bid0, G = G0, wave = wave0; asm volatile("" : "+s"(bid), "+s"(G), "+s"(wave)); int tid = wave * 64 + lane_id(); asm volatile("" : "+v"(tid)); const int lane = tid & 63; (void)lane; (void)wave
    if (tid0 < 4) ((LAS unsigned*)(lds0 + MISC_OFF + MO_BAR))[tid0] = 0u;
    __syncthreads();
#if MK_LAUNCHES == 1
    XcdBarrier bar = xcd_barrier_post((unsigned*)(a.ws + WS_CTL) + CW_BAR, (volatile LAS unsigned*)(lds0 + MISC_OFF + MO_BAR));
#define GRID_BAR() xcd_barrier(bar)
#else
#define GRID_BAR() do { } while (0)
#endif
    const int lo = a.ph_lo, hi = a.ph_hi;
#ifndef PHMASK
#define PHMASK 0xFFFu
#endif
#define IN(k) (lo <= (k) && (k) < hi)
#define EN(b) ((PHMASK >> (b)) & 1u)
#ifndef DBLMASK
#define DBLMASK 0u
#endif
#define REP(b) _Pragma("unroll 1") for (int rep_ = 0; rep_ < (((DBLMASK >> (b)) & 1u) ? 2 : 1); ++rep_)
#define SEAM(k) do { if (IN(k) && IN((k) + 1)) { GRID_BAR(); if ((DBLMASK >> 12) & 1u) GRID_BAR(); } } while (0)

    if (EN(0) && IN(0)) { REP(0) { PH_IDS(); prologue_phase(ap, lds, tid, lane, wave, bid, G); __syncthreads(); }
#ifndef NO_NORM0
        { PH_IDS(); norm_phase<0>(ap, 0, lds, tid, lane, wave, bid, G); }
#endif
    }
    SEAM(0);
#pragma unroll 1
    for (int l = 0; l < 2; ++l) {
        const int pb = 1 + 10 * l;
        if (EN(1) && IN(pb + 0) && l == 1) { if ((DBLMASK >> 18) & 1u) { PH_IDS(); norm_phase<1>(ap, l, lds, tid, lane, wave, bid, G, true); } PH_IDS(); norm_phase<1>(ap, l, lds, tid, lane, wave, bid, G); }
        if (l == 1) SEAM(pb + 0);
        if (EN(2) && IN(pb + 1)) REP(2) { PH_IDS(); (void)tid;
#ifdef STAG
            for (int i = 0; i < ((bid >> 3) & 7); ++i) __builtin_amdgcn_s_sleep(STAG);
#endif
            SchedG1 S{(const char*)(ws + WS_H), (const char*)(ws + WS_WINT) + (size_t)l * 11264 * 4096, G, bid};
            EpiG1 E{ws, ((DBLMASK >> 21) & 1u) && rep_ == 1};
            pg8::gemm_phase<EpiG1, SchedG1>(lds, 2048, S, E, wave);
            for (int bh = G - 1 - bid; bh < 16; bh += G) gate_unit(ap, l, lds, bh, tid, tid & 63, wave);
            __syncthreads();
            if (G == 256 && bid >= 256 - SchedG1::NCV) prologue_phase(ap, lds, tid, tid & 63, wave, bid - (256 - SchedG1::NCV), SchedG1::NCV, 2 + l);
            else if (G != 256) prologue_phase(ap, lds, tid, tid & 63, wave, bid, G, 2 + l);
        }
        SEAM(pb + 1);
        if (EN(3) && IN(pb + 2)) REP(3) { PH_IDS(); conv_phase(ap, l, lds, tid, lane, wave, bid, G); }
        SEAM(pb + 2);
        if (EN(4) && IN(pb + 3)) REP(4) { PH_IDS();
            const int vb = (G % 8 == 0) ? (bid & 7) * (G >> 3) + (bid >> 3) : bid;
            REP(13) { if (wave < 4) for (int gw = vb * 4 + wave; gw < 1024; gw += G * 4) mlstm_ab_task(ws, gw, lane, rep_ == 0 || !((DBLMASK >> 15) & 1u)); }
            if (wave == 4) for (int t = vb; t < 64; t += G) nscan_task(ws, t, lane);
            if (l == 0 && wave >= 4) prologue_phase(ap, lds, tid, lane, wave, bid, G, 6, bid * 4 + (wave - 4), G * 4);
            __syncthreads();
            REP(14) { for (int u = vb; u < 512; u += G) { attn_unit(ap, lds, u, tid, lane, wave); __syncthreads(); if (((DBLMASK >> 16) & 1u) && u < 256) GRID_BAR(); } }
        }
        SEAM(pb + 3);
        if (EN(5) && IN(pb + 4)) REP(5) { PH_IDS(); mlstm_c_phase(ap, l, lds, tid, lane, wave, bid, G); }
        SEAM(pb + 4);
        if (EN(6) && IN(pb + 5)) REP(6) { PH_IDS(); (void)tid;
            SchedBr S{(const char*)(ws + WS_HM), (const char*)(ws + WS_HA), (const char*)(ws + WS_WBM) + (size_t)l * 2048 * 2048, (const char*)(ws + WS_WBA) + (size_t)l * 2048 * 2048, G, bid};
            EpiBr E{(const bf16*)(ws + WS_SG), (bf16*)(ws + WS_Y)};
            pg8::gemm_phase<EpiBr, SchedBr>(lds, 1024, S, E, wave);
        }
        SEAM(pb + 5);
        if (EN(7) && IN(pb + 6)) _Pragma("unroll 1") for (int rep_ = 0; rep_ < ((((DBLMASK >> 7) & 1u) && l == 0) ? 2 : 1); ++rep_) { PH_IDS(); (void)tid;
            SchedStd S{(const char*)(ws + WS_Y), (const char*)(ws + WS_WOUT) + (size_t)l * 2048 * 4096, 32, 8, 2048, G, bid};
            EpiOut E{l == 0 ? ap->in[I_X] : (const float*)ap->out, ap->out};
            pg8::gemm_phase<EpiOut, SchedStd>(lds, 2048, S, E, wave);
        }
        SEAM(pb + 6);
        if (EN(8) && IN(pb + 7)) { if ((DBLMASK >> 19) & 1u) { PH_IDS(); norm_phase<2>(ap, l, lds, tid, lane, wave, bid, G, true); } PH_IDS(); norm_phase<2>(ap, l, lds, tid, lane, wave, bid, G); }
        SEAM(pb + 7);
        if (EN(9) && IN(pb + 8)) REP(9) { PH_IDS();
            moe_tables(ws, l, misc, tid);
            SchedMoe1 S{(const char*)(ws + WS_H), (const char*)(ws + WS_W13) + (size_t)l * 32 * 512 * 4096, (const int*)(ws + MS_LIST),
                        (const LAS int*)(misc + MO_TE), (const LAS int*)(misc + MO_TR0), (const LAS int*)(misc + MO_CNT), __builtin_amdgcn_readfirstlane(((const LAS int*)(misc + MO_MT))[0]), G, bid};
            EpiMoe1 E{(bf16*)(ws + WS_HID), (const float*)(ws + MS_PWL), (const LAS int*)(misc + MO_TR0), (const LAS int*)(misc + MO_CNT)};
            pg8::gemm_phase<EpiMoe1, SchedMoe1>(lds, 2048, S, E, wave);
            if (bid >= 2 * S.MT) prologue_phase(ap, lds, tid, tid & 63, wave, bid - 2 * S.MT, G - 2 * S.MT, l == 0 ? 1 : 4);
        }
        SEAM(pb + 8);
        if (EN(10) && IN(pb + 9)) REP(10) { PH_IDS();
            moe_tables(ws, l, misc, tid);
#ifdef STAG
            for (int i = 0; i < ((bid >> 3) & 7); ++i) __builtin_amdgcn_s_sleep(STAG);
#endif
            SchedMoe2 S{(const char*)(ws + WS_HID), (const char*)(ws + WS_W2) + (size_t)l * 32 * 2048 * 512, (const LAS int*)(misc + MO_TE), __builtin_amdgcn_readfirstlane(((const LAS int*)(misc + MO_MT))[0]), G, bid};
            EpiMoe2 E{(bf16*)(ws + WS_OP)};
            pg8::gemm_phase<EpiMoe2, SchedMoe2>(lds, 256, S, E, wave);
        }
        SEAM(pb + 9);
    }
    if (EN(11) && IN(21)) { if ((DBLMASK >> 20) & 1u) { PH_IDS(); norm_phase<3>(ap, 1, lds, tid, lane, wave, bid, G, true); } PH_IDS(); norm_phase<3>(ap, 1, lds, tid, lane, wave, bid, G); }
#undef IN
#undef SEAM
}

extern "C" void kernel_launch(void* const* d_in, const int* in_sizes, int n_in, void* d_out, int out_size, void* d_ws, size_t ws_size, hipStream_t stream) {
    static int grid = 0;
    if (grid == 0) {
        if (n_in != 19 || out_size != NTOK * DM || ws_size < WS_END) { fprintf(stderr, "kernel_launch: unexpected shapes (n_in %d out %d ws %zu)\n", n_in, out_size, ws_size); grid = -1; return; }
        int dev = 0, cus = 0, per_cu = 0;
        if (hipGetDevice(&dev) != hipSuccess || hipDeviceGetAttribute(&cus, hipDeviceAttributeMultiprocessorCount, dev) != hipSuccess) { grid = -1; return; }
        if (hipFuncSetAttribute((const void*)fwd_kernel, hipFuncAttributeMaxDynamicSharedMemorySize, LDS_BYTES) != hipSuccess) { fprintf(stderr, "kernel_launch: hipFuncSetAttribute failed\n"); grid = -1; return; }
        if (hipOccupancyMaxActiveBlocksPerMultiprocessor(&per_cu, (const void*)fwd_kernel, NTHR, LDS_BYTES) != hipSuccess || per_cu < 1) { fprintf(stderr, "kernel_launch: occupancy query says %d\n", per_cu); }
        (void)hipGetLastError();
        grid = cus;
        if (grid > 256) grid = 256;
    }
    if (grid < 0) return;
    if (hipMemsetAsync((char*)d_ws + WS_CTL, 0, CTL_ZERO_BYTES, stream) != hipSuccess) return;
    Args a{};
    for (int i = 0; i < 19; ++i) a.in[i] = (const float*)d_in[i];
    a.out = (float*)d_out; a.ws = (unsigned char*)d_ws;
#if MK_LAUNCHES == 1
    a.ph_lo = 0; a.ph_hi = N_PHASES;
    hipLaunchKernelGGL(fwd_kernel, dim3(grid), dim3(NTHR), LDS_BYTES, stream, a);
#else
    for (int p = 0; p < N_PHASES; ++p) { a.ph_lo = p; a.ph_hi = p + 1; hipLaunchKernelGGL(fwd_kernel, dim3(grid), dim3(NTHR), LDS_BYTES, stream, a); }
#endif
}
```

```cpp
#define DBLMASK 0u
#include <hip/hip_runtime.h>
#include <stdint.h>
#include <stdio.h>

#ifndef MK_LAUNCHES
#define MK_LAUNCHES 1
#endif

#define GAS __attribute__((address_space(1)))
#define LAS __attribute__((address_space(3)))
typedef unsigned short bf16;
typedef short bf16x8 __attribute__((ext_vector_type(8)));
typedef short bf16x4 __attribute__((ext_vector_type(4)));
typedef float f32x4 __attribute__((ext_vector_type(4)));
typedef unsigned u32x4 __attribute__((ext_vector_type(4)));
typedef unsigned u32x2 __attribute__((ext_vector_type(2)));

constexpr int NTOK = 8192, DM = 2048, SEQ = 2048, NBATCH = 4;
constexpr int INCOLS = 11272;
constexpr int NWAVES = 8, NTHR = 512;
constexpr float RMS_EPS = 1e-6f, LN_EPS = 1e-5f;
constexpr int MPAD = 24576;

constexpr size_t MiB = 1u << 20;
constexpr size_t WS_CTL = 0, CTL_ZERO_BYTES = 1 * MiB;
constexpr size_t WS_MISC = 1 * MiB;
constexpr size_t MS_WIF = WS_MISC + 0;
constexpr size_t MS_WRT = WS_MISC + 256 * 1024;
constexpr size_t MS_IFG = WS_MISC + 1 * MiB;
constexpr size_t MS_KMEAN = MS_IFG + 256 * 1024;
constexpr size_t MS_AS = WS_MISC + 1536 * 1024;
constexpr size_t MS_GT = MS_AS + 128 * 1024;
constexpr size_t MS_WI = MS_GT + 128 * 1024;
constexpr size_t MS_CL = MS_WI + 128 * 1024;
constexpr size_t MS_WS = MS_CL + 128 * 1024;
constexpr size_t MS_DEC = MS_WS + 128 * 1024;
constexpr size_t MS_NST = WS_MISC + 2560 * 1024;
constexpr size_t MS_TOKE = WS_MISC + 3 * MiB;
constexpr size_t MS_TOKP = MS_TOKE + 64 * 1024;
constexpr size_t MS_TOKW = MS_TOKE + 128 * 1024;
constexpr size_t MS_LIST = WS_MISC + 4 * MiB;
constexpr size_t MS_PWL = WS_MISC + 5 * MiB;
constexpr size_t MS_NVEC = WS_MISC + 6 * MiB;
constexpr size_t WS_WINT = 16 * MiB;
constexpr size_t WS_WBM = 104 * MiB;
constexpr size_t WS_WBA = 112 * MiB;
constexpr size_t WS_WOUT = 120 * MiB;
constexpr size_t WS_W13 = 136 * MiB;
constexpr size_t WS_W2 = 264 * MiB;
constexpr size_t WS_H = 328 * MiB;
constexpr size_t WS_R = 360 * MiB;
constexpr size_t WS_ZQK = WS_R;
constexpr size_t WS_HM = WS_R, WS_HA = WS_R + 16 * MiB;
constexpr size_t WS_VMT = WS_R + 32 * MiB;
constexpr size_t WS_OM = WS_R + 48 * MiB;
constexpr size_t WS_QA = WS_R + 64 * MiB, WS_KA = WS_R + 80 * MiB;
constexpr size_t WS_Y = WS_QA;
constexpr size_t WS_VAT = WS_R + 96 * MiB;
constexpr size_t WS_SG = WS_R + 112 * MiB;
constexpr size_t WS_QM = WS_R + 176 * MiB, WS_KM = WS_R + 192 * MiB, WS_KMT = WS_R + 208 * MiB;
constexpr size_t WS_CST = WS_R + 224 * MiB;
constexpr size_t WS_HID = WS_R;
constexpr size_t WS_OP = WS_R + 16 * MiB;
constexpr size_t WS_END = 648 * MiB;
constexpr int CW_BAR = 4096;
constexpr int CW_CNT = 8192;

constexpr int RING_BYTES = 131072;
constexpr int MISC_OFF = 139264;
constexpr int LDS_BYTES = 147456;
constexpr int MO_BAR = 0, MO_CNT = 64, MO_NT = 64 + 128, MO_OFF = 64 + 256, MO_TE = 64 + 512, MO_TR0 = 64 + 1024, MO_MT = 64 + 1536, MO_LOG = 2048;

#define LDS_WAIT() asm volatile("s_waitcnt lgkmcnt(0)" ::: "memory")
#define VM_WAIT() asm volatile("s_waitcnt vmcnt(0)" ::: "memory")

__device__ __forceinline__ float bf2f(unsigned short b) { return __builtin_bit_cast(float, (unsigned)b << 16); }
__device__ __forceinline__ float bflo(unsigned u) { return __builtin_bit_cast(float, u << 16); }
__device__ __forceinline__ float bfhi(unsigned u) { return __builtin_bit_cast(float, u & 0xffff0000u); }
typedef __bf16 bf16x2v __attribute__((ext_vector_type(2)));
typedef float f32x2v __attribute__((ext_vector_type(2)));
typedef float f32x2 __attribute__((ext_vector_type(2)));
__device__ __forceinline__ unsigned cvt_pk_bf16(float lo, float hi) { const f32x2v f = {lo, hi}; const bf16x2v b = __builtin_convertvector(f, bf16x2v); return __builtin_bit_cast(unsigned, b); }
__device__ __forceinline__ float wave_sum(float v) {
#pragma unroll
    for (int o = 1; o < 64; o <<= 1) v += __shfl_xor(v, o);
    return v;
}
__device__ __forceinline__ float rows4_max(float x) { x = fmaxf(x, __shfl_xor(x, 16)); return fmaxf(x, __shfl_xor(x, 32)); }
__device__ __forceinline__ float rows4_sum(float x) { x += __shfl_xor(x, 16); return x + __shfl_xor(x, 32); }
__device__ __forceinline__ int lane_id() { int l; asm volatile("v_mbcnt_lo_u32_b32 %0, -1, 0\n\tv_mbcnt_hi_u32_b32 %0, -1, %0" : "=v"(l)); return l; }
__device__ __forceinline__ float sigmoidf_(float x) { return __builtin_amdgcn_rcpf(1.f + __expf(-x)); }

namespace pg8 {
constexpr int BM = 256, BK = 64, HALF = 128, HTB = HALF * BK * 2, STAGE_BYTES = 8 * HTB, NXCD = 8, WGM = 8;
__device__ __forceinline__ int lds_byte(int r, int c) { const int st = (r >> 4) * 2 + (c >> 5), rr = r & 15, cc = c & 31, ob = rr * 64 + cc * 2; return st * 1024 + (ob ^ (((ob >> 9) & 1) << 5)); }
__device__ __forceinline__ void stage_rc(int b, int& R, int& C) { const int st = b / 1024, sb = b % 1024, swz = sb ^ (((sb >> 9) & 1) << 5); R = (st >> 1) * 16 + swz / 64; C = (st & 1) * 32 + (swz % 64) / 2; }
__device__ __forceinline__ int perm32(int rho) { const int n = rho >> 4, i = rho & 15; return 8 * (i >> 2) + 4 * n + (i & 3); }
struct Unit { int pm, pn, aux; };

__device__ __forceinline__ void static_tile(int L, int nM, int nN, int& pm, int& pn) {
    const int nwg = nM * nN; int wgid = L;
    { const int q = nwg / NXCD, r = nwg % NXCD, xcd = wgid % NXCD, off = wgid / NXCD; wgid = (xcd < r ? xcd * (q + 1) : r * (q + 1) + (xcd - r) * q) + off; }
    const int nig = WGM * nN, gid = wgid / nig, fm = gid * WGM, gsz = (nM - fm) < WGM ? (nM - fm) : WGM;
    pm = fm + ((wgid % nig) % gsz); pn = (wgid % nig) / gsz;
}

template <class Epi, class Sched>
__device__ __forceinline__ void gemm_phase(LAS unsigned char* lds, const int K, const Sched& S, const Epi& E, const int wave0) {
    int tid_ = wave0 * 64 + lane_id(); asm volatile("" : "+v"(tid_));
    const int tid = tid_, wid = __builtin_amdgcn_readfirstlane(tid >> 6), lane = tid & 63, wr = wid >> 2, wc = wid & 3, fr = lane & 15, fq = lane >> 4;
    const int nt = K / BK;
    int RA[2], CA[2]; unsigned voffB[2];
#pragma unroll
    for (int i = 0; i < 2; ++i) { int R, C; stage_rc(tid * 16 + i * 8192, R, C); const int Rb = Epi::PERM ? ((R & ~31) + perm32(R & 31)) : R;
        RA[i] = R; CA[i] = C; voffB[i] = (unsigned)(Rb * K + C) * 2u; }
    const size_t kstep = (size_t)(BK * 2);
    const size_t hstep = (size_t)HALF * K * 2;
    const unsigned ldsw = (unsigned)wid * 1024u;
    const int aoff = lds_byte(wr * 64 + fr, fq * 8), boff = lds_byte(wc * 32 + fr, fq * 8);
#define PG8_SA(b, h) (((b) * 2 + (h)) * HTB)
#define PG8_SB(b, h) ((4 + (b) * 2 + (h)) * HTB)
#define PG8_STAGE(bufoff, gbase, v0, v1) do { \
        __builtin_amdgcn_global_load_lds((const unsigned*)((const char*)(gbase) + (v0)), (LAS unsigned*)(lds + (bufoff) + ldsw), 16, 0, 0); \
        __builtin_amdgcn_global_load_lds((const unsigned*)((const char*)(gbase) + (v1)), (LAS unsigned*)(lds + (bufoff) + ldsw + 8192), 16, 0, 0); } while (0)
#define PG8_STAGE_B(bufoff, gbase) PG8_STAGE(bufoff, gbase, voffB[0], voffB[1])
#define PG8_STAGE_A(bufoff, gbase, VO, h) PG8_STAGE(bufoff, gbase, VO[h][0], VO[h][1])
#define PG8_STAGE_A2(bufoff, gbase, h) do { if (Sched::GATHER && last) { PG8_STAGE_A(bufoff, gbase, vn, h); } else { PG8_STAGE_A(bufoff, gbase, vc, h); } } while (0)
#define PG8_LDA(dst, b, h) do { _Pragma("unroll") for (int m = 0; m < 4; ++m) _Pragma("unroll") for (int k = 0; k < 2; ++k) dst[m][k] = *(const LAS bf16x8*)(lds + PG8_SA(b, h) + aoff + m * 2048 + k * 1024); } while (0)
#define PG8_LDB(dst, b, h) do { _Pragma("unroll") for (int n = 0; n < 2; ++n) _Pragma("unroll") for (int k = 0; k < 2; ++k) dst[n][k] = *(const LAS bf16x8*)(lds + PG8_SB(b, h) + boff + n * 2048 + k * 1024); } while (0)
#define PG8_MMA(ai, bj, At, Bt) do { __builtin_amdgcn_s_setprio(1); _Pragma("unroll") for (int m = 0; m < 4; ++m) _Pragma("unroll") for (int n = 0; n < 2; ++n) _Pragma("unroll") for (int k = 0; k < 2; ++k) \
        acc[ai][bj][m][n] = __builtin_amdgcn_mfma_f32_16x16x32_bf16(Bt[n][k], At[m][k], acc[ai][bj][m][n], 0, 0, 0); __builtin_amdgcn_s_setprio(0); } while (0)
#define PG8_WAIT_V(n) asm volatile("s_waitcnt vmcnt(" #n ")" ::: "memory")
#define PG8_WAIT_L(n) asm volatile("s_waitcnt lgkmcnt(" #n ")" ::: "memory")
#define PG8_BAR __builtin_amdgcn_s_barrier()
#define PG8_SCHED __builtin_amdgcn_sched_barrier(0)
    Unit cur, nxt; int ui = 0;
    if (!S.next(0, cur)) return;
    f32x4 acc[2][2][4][2];
#pragma unroll
    for (int a = 0; a < 2; ++a)
#pragma unroll
        for (int b = 0; b < 2; ++b)
#pragma unroll
            for (int m = 0; m < 4; ++m)
#pragma unroll
                for (int n = 0; n < 2; ++n) acc[a][b][m][n] = (f32x4){0.f, 0.f, 0.f, 0.f};
    bf16x8 At[4][2], B0[2][2], B1[2][2];
    unsigned vc[2][2], vn[2][2];
#pragma unroll
    for (int h = 0; h < 2; ++h)
#pragma unroll
        for (int i = 0; i < 2; ++i) {
            if constexpr (Sched::GATHER) vc[h][i] = (unsigned)(S.arow(cur, h * HALF + RA[i]) * (unsigned)K + (unsigned)CA[i]) * 2u;
            else vc[h][i] = (unsigned)((h * HALF + RA[i]) * K + CA[i]) * 2u;
            vn[h][i] = vc[h][i];
        }
    const char* cA = S.abase(cur); const char* cB = S.bbase(cur);
    PG8_STAGE_B(PG8_SB(0, 0), cB); PG8_STAGE_A(PG8_SA(0, 0), cA, vc, 0); PG8_STAGE_B(PG8_SB(0, 1), cB + hstep); PG8_STAGE_A(PG8_SA(0, 1), cA, vc, 1);
    if (wr == 1) PG8_BAR;
    PG8_WAIT_V(4); PG8_BAR;
    PG8_STAGE_B(PG8_SB(1, 0), cB + kstep); PG8_STAGE_A(PG8_SA(1, 0), cA + kstep, vc, 0); PG8_STAGE_B(PG8_SB(1, 1), cB + hstep + kstep);
    PG8_WAIT_V(6); PG8_BAR;
    for (;;) {
        const bool has_next = S.next(ui + 1, nxt);
        const char* nA = has_next ? S.abase(nxt) : cA; const char* nB = has_next ? S.bbase(nxt) : cB;
        if constexpr (Sched::GATHER) {
            if (has_next) {
                int t2 = wave0 * 64 + lane_id(); asm volatile("" : "+v"(t2));
#pragma unroll
                for (int i = 0; i < 2; ++i) { int R, C; stage_rc(t2 * 16 + i * 8192, R, C);
#pragma unroll
                    for (int h = 0; h < 2; ++h) vn[h][i] = (unsigned)(S.arow(nxt, h * HALF + R) * (unsigned)K + (unsigned)C) * 2u; }
            }
        }
#pragma unroll 1
        for (int t = 0; t < nt; t += 2) {
            const bool last = (t == nt - 2);
            const char* a1 = cA + (size_t)(t + 1) * kstep;
            const char* a2 = last ? nA : cA + (size_t)(t + 2) * kstep; const char* b2 = last ? nB : cB + (size_t)(t + 2) * kstep;
            const char* a3 = a2 + kstep; const char* b3 = b2 + kstep;
            PG8_LDB(B0, 0, 0); PG8_SCHED; PG8_LDA(At, 0, 0); PG8_STAGE_A(PG8_SA(1, 1), a1, vc, 1);
            PG8_WAIT_L(8); PG8_BAR; PG8_WAIT_L(0); PG8_MMA(0, 0, At, B0); PG8_BAR; PG8_SCHED;
            PG8_LDB(B1, 0, 1); PG8_STAGE_B(PG8_SB(0, 0), b2);
            PG8_BAR; PG8_WAIT_L(0); PG8_MMA(0, 1, At, B1); PG8_BAR;
            PG8_LDA(At, 0, 1); PG8_STAGE_A2(PG8_SA(0, 0), a2, 0);
            PG8_BAR; PG8_WAIT_L(0); PG8_MMA(1, 0, At, B0); PG8_BAR; PG8_SCHED;
            PG8_STAGE_B(PG8_SB(0, 1), b2 + hstep);
            PG8_WAIT_V(6); PG8_BAR; PG8_MMA(1, 1, At, B1); PG8_BAR;
            PG8_LDB(B0, 1, 0); PG8_SCHED; PG8_LDA(At, 1, 0); PG8_STAGE_A2(PG8_SA(0, 1), a2, 1);
            PG8_WAIT_L(8); PG8_BAR; PG8_WAIT_L(0); PG8_MMA(0, 0, At, B0); PG8_BAR; PG8_SCHED;
            PG8_LDB(B1, 1, 1); PG8_STAGE_B(PG8_SB(1, 0), b3);
            PG8_BAR; PG8_WAIT_L(0); PG8_MMA(0, 1, At, B1); PG8_BAR;
            PG8_LDA(At, 1, 1); PG8_STAGE_A2(PG8_SA(1, 0), a3, 0);
            PG8_BAR; PG8_WAIT_L(0); PG8_MMA(1, 0, At, B0); PG8_BAR; PG8_SCHED;
            PG8_STAGE_B(PG8_SB(1, 1), b3 + hstep);
            PG8_WAIT_V(6); PG8_BAR; PG8_MMA(1, 1, At, B1); PG8_BAR;
        }
        { const int lz = lane_id(); E(acc, cur, wr, wc, lz & 15, lz >> 4); }
        if (!has_next) break;
        if (!Sched::keep_acc(cur)) {
#pragma unroll
        for (int a = 0; a < 2; ++a)
#pragma unroll
            for (int b = 0; b < 2; ++b)
#pragma unroll
                for (int m = 0; m < 4; ++m)
#pragma unroll
                    for (int n = 0; n < 2; ++n) acc[a][b][m][n] = (f32x4){0.f, 0.f, 0.f, 0.f};
        }
        cur = nxt; cA = nA; cB = nB; ++ui;
        if constexpr (Sched::GATHER) {
#pragma unroll
            for (int h = 0; h < 2; ++h)
#pragma unroll
                for (int i = 0; i < 2; ++i) vc[h][i] = vn[h][i];
        }
    }
    PG8_WAIT_V(0);
    if (wr == 0) PG8_BAR;
    PG8_BAR;
#undef PG8_SA
#undef PG8_SB
#undef PG8_STAGE
#undef PG8_STAGE_A
#undef PG8_STAGE_A2
#undef PG8_STAGE_B
#undef PG8_LDA
#undef PG8_LDB
#undef PG8_MMA
#undef PG8_WAIT_V
#undef PG8_WAIT_L
#undef PG8_BAR
#undef PG8_SCHED
}
}
using pg8::Unit;

#define XB_TMO      128
#define XB_XCNT(j)  (256  + 64 * (j))
#define XB_XSUB(j)  (1280 + 64 * (j))
#define XB_XGEN(j)  (2304 + 64 * (j))
#define XB_TOP      3328
#define XB_TOPGEN   3392
#define XCD_BAR_WORDS 3456
#define XB_SPIN_CAP (1u << 18)
__device__ __forceinline__ unsigned xb_ld(unsigned* p)              { return __hip_atomic_load(p, __ATOMIC_RELAXED, __HIP_MEMORY_SCOPE_AGENT); }
__device__ __forceinline__ unsigned xb_add(unsigned* p, unsigned v) { return __hip_atomic_fetch_add(p, v, __ATOMIC_RELAXED, __HIP_MEMORY_SCOPE_AGENT); }
__device__ __forceinline__ unsigned xb_xcc_id() { return (unsigned)__builtin_amdgcn_s_getreg((3 << 11) | 20) & 0xFu; }
#define XB_SPIN(cond, bar) do { unsigned _sp = 0; while (cond) { __builtin_amdgcn_s_sleep(1); \
    if ((++_sp & 255u) == 0u) { if (xb_ld(&(bar)[XB_TMO])) break; if (_sp > XB_SPIN_CAP) { atomicAdd(&(bar)[XB_TMO], 1u); break; } } } } while (0)
struct XcdBarrier { unsigned* bar; unsigned x; volatile LAS unsigned* st; };
__device__ __forceinline__ XcdBarrier xcd_barrier_post(unsigned* bar, volatile LAS unsigned* st) {
    XcdBarrier b; b.bar = bar; b.x = xb_xcc_id(); b.st = st;
    if (threadIdx.x == 0) (void)xb_add(&bar[XB_XCNT(b.x)], 1u);
    return b;
}
__device__ __forceinline__ void xcd_barrier_complete(unsigned* bar, unsigned x, unsigned& nloc, unsigned& nx) {
    const unsigned G = gridDim.x * gridDim.y * gridDim.z;
    unsigned sum, cnt, mine, sp = 0u;
    for (;;) {
        sum = 0u; cnt = 0u; mine = 0u;
#pragma unroll
        for (unsigned j = 0; j < 16; ++j) { const unsigned c = xb_ld(&bar[XB_XCNT(j)]); sum += c; cnt += (c > 0u) ? 1u : 0u; mine = (j == x) ? c : mine; }
        if (sum == G) break;
        __builtin_amdgcn_s_sleep(1);
        if ((++sp & 255u) == 0u) { if (xb_ld(&bar[XB_TMO])) break; if (sp > XB_SPIN_CAP) { atomicAdd(&bar[XB_TMO], 1u); break; } }
    }
    nloc = mine > 0u ? mine : 1u; nx = cnt > 0u ? cnt : 1u;
}
__device__ __forceinline__ void xcd_barrier(const XcdBarrier& b) {
    asm volatile("s_waitcnt vmcnt(0)" ::: "memory");
    __syncthreads();
    if (threadIdx.x == 0) {
        unsigned* bar = b.bar;
        __builtin_amdgcn_s_waitcnt(0);
        unsigned nloc = b.st[0], nx = b.st[1];
        if (nloc == 0u) { xcd_barrier_complete(bar, b.x, nloc, nx); b.st[0] = nloc; b.st[1] = nx; }
        const unsigned old = xb_add(&bar[XB_XSUB(b.x)], 1u);
        const unsigned gen = old / nloc;
        if (old + 1u == (gen + 1u) * nloc) {
            __builtin_amdgcn_fence(__ATOMIC_RELEASE, "agent");
            asm volatile("s_waitcnt vmcnt(0)" ::: "memory");
            const unsigned og = xb_add(&bar[XB_TOP], 1u);
            const unsigned tg = og / nx;
            if (og + 1u == (tg + 1u) * nx) xb_add(&bar[XB_TOPGEN], 1u);
            else XB_SPIN(xb_ld(&bar[XB_TOPGEN]) == tg, bar);
            __builtin_amdgcn_fence(__ATOMIC_ACQUIRE, "agent");
            xb_add(&bar[XB_XGEN(b.x)], 1u);
            asm volatile("s_waitcnt vmcnt(0)" ::: "memory");
        } else {
            XB_SPIN(xb_ld(&bar[XB_XGEN(b.x)]) == gen, bar);
            __builtin_amdgcn_fence(__ATOMIC_ACQUIRE, "agent");
            asm volatile("s_waitcnt vmcnt(0)" ::: "memory");
        }
    }
    __syncthreads();
}

struct Args { const float* in[19]; float* out; unsigned char* ws; int ph_lo, ph_hi; };
typedef const __attribute__((address_space(4))) Args* ArgsP;
enum { I_X = 0, I_N1G, I_WIN, I_CONVW, I_IFB, I_MNG, I_WBM, I_WBA, I_WOUT, I_RELB, I_N2G, I_WGRP, I_BGRP, I_WEXP, I_BEXP, I_W1, I_W3, I_W2, I_FG };


struct TrDesc { const float* W; bf16* WT; size_t ldn, ldk; int k0, n0, r0; };
__device__ __forceinline__ void tr_load(const TrDesc& d, f32x4 (&tv)[16], int lane) {
    const int nn4 = (lane & 15) * 4, kr = lane >> 4;
#pragma unroll
    for (int i = 0; i < 16; ++i) tv[i] = __builtin_nontemporal_load((const f32x4*)(d.W + (size_t)(d.k0 + 4 * i + kr) * d.ldn + d.n0 + nn4));
}
__device__ __forceinline__ void tr_finish(const TrDesc& d, f32x4 (&tv)[16], LAS float* scr, int lane) {
    const int nn4 = (lane & 15) * 4, kr = lane >> 4;
#pragma unroll
    for (int i = 0; i < 16; i += 4) asm volatile("" : "+v"(tv[i]), "+v"(tv[i + 1]), "+v"(tv[i + 2]), "+v"(tv[i + 3]));
#pragma unroll
    for (int i = 0; i < 16; ++i) { const int kk = 4 * i + kr; const f32x4 v = tv[i];
        LAS float* q = scr + kk * 65 + nn4; q[0] = v.x; q[1] = v.y; q[2] = v.z; q[3] = v.w; }
    LDS_WAIT();
    const int kc = (lane & 7) * 8;
#pragma unroll
    for (int p = 0; p < 8; ++p) { const int nn = 8 * p + (lane >> 3); const LAS float* sp = scr + kc * 65 + nn;
        u32x4 o; o.x = cvt_pk_bf16(sp[0], sp[65]); o.y = cvt_pk_bf16(sp[130], sp[195]); o.z = cvt_pk_bf16(sp[260], sp[325]); o.w = cvt_pk_bf16(sp[390], sp[455]);
        *(u32x4*)(d.WT + (size_t)(d.r0 + nn) * d.ldk + d.k0 + kc) = o; }
    LDS_WAIT();
}
__device__ __forceinline__ int win_src_col(int r) {
    if (r < 2048) return r;
    if (r < 3072) return r + 1024;
    if (r < 5120) return r + 1032;
    if (r < 9216) return r + 2056;
    if (r < 10240) return r - 7168;
    return r - 4088;
}
__device__ __forceinline__ TrDesc tr_decode(ArgsP a, unsigned char* ws, int it) {
    constexpr int PER_LAYER = 5632 + 512 + 512 + 1024 + 4096 + 4096 + 4096;
    const int l = it / PER_LAYER; int r = it % PER_LAYER;
    TrDesc d;
    if (r < 5632) { const int kb = r / 176, ng = r % 176;
        d.W = a->in[I_WIN] + (size_t)l * DM * INCOLS; d.ldn = INCOLS; d.k0 = 64 * kb; d.n0 = win_src_col(64 * ng); d.WT = (bf16*)(ws + WS_WINT) + (size_t)l * 11264 * 2048; d.ldk = 2048; d.r0 = 64 * ng; return d; }
    r -= 5632;
    if (r < 512) { const int kb = r / 32, ng = r % 32;
        d.W = a->in[I_WBM] + (size_t)l * 1024 * 2048; d.ldn = 2048; d.k0 = 64 * kb; d.n0 = 64 * ng; d.WT = (bf16*)(ws + WS_WBM) + (size_t)l * 2048 * 1024; d.ldk = 1024; d.r0 = 64 * ng; return d; }
    r -= 512;
    if (r < 512) { const int kb = r / 32, ng = r % 32;
        d.W = a->in[I_WBA] + (size_t)l * 1024 * 2048; d.ldn = 2048; d.k0 = 64 * kb; d.n0 = 64 * ng; d.WT = (bf16*)(ws + WS_WBA) + (size_t)l * 2048 * 1024; d.ldk = 1024; d.r0 = 64 * ng; return d; }
    r -= 512;
    if (r < 1024) { const int kb = r / 32, ng = r % 32;
        d.W = a->in[I_WOUT] + (size_t)l * 2048 * 2048; d.ldn = 2048; d.k0 = 64 * kb; d.n0 = 64 * ng; d.WT = (bf16*)(ws + WS_WOUT) + (size_t)l * 2048 * 2048; d.ldk = 2048; d.r0 = 64 * ng; return d; }
    r -= 1024;
    if (r < 8192) { const int w3 = r >= 4096; const int q = r & 4095; const int e = q >> 7, rr = q & 127, kb = rr >> 2, ng = rr & 3;
        d.W = a->in[w3 ? I_W3 : I_W1] + (size_t)(l * 32 + e) * 2048 * 256; d.ldn = 256; d.k0 = 64 * kb; d.n0 = 64 * ng;
        d.WT = (bf16*)(ws + WS_W13) + (size_t)(l * 32 + e) * 512 * 2048; d.ldk = 2048; d.r0 = 256 * (ng >> 1) + 64 * (ng & 1) + (w3 ? 128 : 0); return d; }
    r -= 8192;
    { const int e = r >> 7, rr = r & 127, kb = rr >> 5, ng = rr & 31;
        d.W = a->in[I_W2] + (size_t)(l * 32 + e) * 256 * 2048; d.ldn = 2048; d.k0 = 64 * kb; d.n0 = 64 * ng; d.WT = (bf16*)(ws + WS_W2) + (size_t)(l * 32 + e) * 2048 * 256; d.ldk = 256; d.r0 = 64 * ng; return d; }
}
#ifndef CVX
#define CVX 4096
#endif
__device__ __forceinline__ void prologue_phase(ArgsP a, LAS unsigned char* lds, int tid, int lane, int wave, int bid, int G, const int part = 0, const int gwx = -1, const int ngwx = 0) {
    unsigned char* ws = a->ws;
    LAS float* scr = (LAS float*)(lds + wave * 16640);
    const int gw = gwx >= 0 ? gwx : bid * NWAVES + wave, NGW = gwx >= 0 ? ngwx : G * NWAVES;
    constexpr int PER_LAYER = 5632 + 512 + 512 + 1024 + 4096 + 4096 + 4096;
    constexpr int W0 = 5632, W2I = PER_LAYER - 4096;
    const int v_lo = part == 0 ? 0 : part == 1 ? PER_LAYER : part == 2 ? W0 + CVX : part == 3 ? PER_LAYER + W0 : part == 4 ? PER_LAYER + W2I : W0;
    const int v_hi = part == 0 ? W0 : part == 1 ? PER_LAYER + W0 : part == 2 ? PER_LAYER : part == 3 ? PER_LAYER + W2I : part == 4 ? 2 * PER_LAYER : W0 + CVX;
#define CV_ITEM(v) (v)
    f32x4 tvA[16], tvB[16]; TrDesc dA, dB;
    int it = v_lo + gw;
    if (it < v_hi) {
        int rem = (v_hi - 1 - it) / NGW;
        dA = tr_decode(a, ws, CV_ITEM(it)); tr_load(dA, tvA, lane);
#pragma unroll 1
        while (rem >= 2) {
            dB = tr_decode(a, ws, CV_ITEM(it + NGW)); tr_load(dB, tvB, lane);
            tr_finish(dA, tvA, scr, lane);
            it += 2 * NGW;
            dA = tr_decode(a, ws, CV_ITEM(it)); tr_load(dA, tvA, lane);
            tr_finish(dB, tvB, scr, lane);
            rem -= 2;
        }
        if (rem == 1) { dB = tr_decode(a, ws, CV_ITEM(it + NGW)); tr_load(dB, tvB, lane); tr_finish(dA, tvA, scr, lane); tr_finish(dB, tvB, scr, lane); }
        else tr_finish(dA, tvA, scr, lane);
    }
#undef CV_ITEM
    if (part != 0) return;
    const int gt = bid * NTHR + tid, NGT = G * NTHR;
    float* wrt = (float*)(ws + MS_WRT);
    for (int i = gt; i < 2 * 36 * 2048; i += NGT) { const int l = i / (36 * 2048), rr = i % (36 * 2048), n = rr >> 11, k = rr & 2047;
        wrt[i] = n < 4 ? a->in[I_WGRP][((size_t)l * DM + k) * 4 + n] : a->in[I_WEXP][((size_t)l * DM + k) * 32 + (n - 4)]; }
}

__device__ __forceinline__ void moe_tables(unsigned char* ws, int l, LAS unsigned char* misc, int tid) {
    LAS int* cnt = (LAS int*)(misc + MO_CNT); LAS int* ntl = (LAS int*)(misc + MO_NT); LAS int* off = (LAS int*)(misc + MO_OFF);
    LAS int* te = (LAS int*)(misc + MO_TE); LAS int* tr0 = (LAS int*)(misc + MO_TR0); LAS int* mt = (LAS int*)(misc + MO_MT);
    __syncthreads();
    if (tid < 64) {
        const int c = tid < 32 ? (int)__hip_atomic_load((unsigned*)(ws + WS_CTL) + CW_CNT + 32 * l + tid, __ATOMIC_RELAXED, __HIP_MEMORY_SCOPE_AGENT) : 0;
        const int n = (c + 255) >> 8;
        int x = n;
#pragma unroll
        for (int o = 1; o < 32; o <<= 1) { const int t = __shfl_up(x, o); if (tid >= o) x += t; }
        const int o0 = x - n;
        if (tid < 32) { cnt[tid] = c; ntl[tid] = n; off[tid] = o0;
#pragma unroll 1
            for (int j = 0; j < n; ++j) { te[o0 + j] = tid; tr0[o0 + j] = 256 * j; } }
        if (tid == 31) { off[32] = x; mt[0] = x; }
    }
    __syncthreads();
}

#ifndef DRYX
#define DRYX 0
#endif
template <int MODE>
__device__ __forceinline__ void norm_phase(ArgsP a, int l, LAS unsigned char* lds, int tid, int lane, int wave, int bid, int G, const bool dry = false) {
    unsigned char* ws = a->ws;
    LAS unsigned char* misc = lds + MISC_OFF;
    if (MODE == 1 || MODE == 3) moe_tables(ws, MODE == 1 ? 0 : 1, misc, tid);
    const LAS int* off = (const LAS int*)(misc + MO_OFF);
    const float* src = (MODE == 0) ? a->in[I_X] : a->out;
    const float* gain = (MODE < 2) ? a->in[I_N1G] + l * DM : (MODE == 2 ? a->in[I_N2G] + l * DM : a->in[I_FG]);
    const int* toke = (const int*)(ws + MS_TOKE); const int* tokp = (const int*)(ws + MS_TOKP);
    const bf16* OP = (const bf16*)(ws + WS_OP);
    bf16* H = (bf16*)(ws + WS_H);
    const int gw = bid * NWAVES + wave, NGW = G * NWAVES;
    constexpr int RP = (MODE == 2) ? 4 : 2;
    LAS float* gwl = (LAS float*)lds;
    if (MODE < 2) {
        const float* wg = a->in[I_WIN] + (size_t)l * DM * INCOLS + 4096;
        f32x4 t0[4], t1[4];
#pragma unroll
        for (int i = 0; i < 4; ++i) { const float* wp = wg + (size_t)(tid + NTHR * i) * INCOLS; t0[i] = *(const f32x4*)wp; t1[i] = *(const f32x4*)(wp + 4); }
#pragma unroll
        for (int i = 0; i < 4; ++i) { const int k = tid + NTHR * i;
            gwl[k] = t0[i].x; gwl[2048 + k] = t0[i].y; gwl[4096 + k] = t0[i].z; gwl[6144 + k] = t0[i].w;
            gwl[8192 + k] = t1[i].x; gwl[10240 + k] = t1[i].y; gwl[12288 + k] = t1[i].z; gwl[14336 + k] = t1[i].w; }
        __syncthreads();
    }
    const int npass = (NTOK + NGW * RP - 1) / (NGW * RP);
    for (int m0_ = gw * RP, it = 0; (MODE == 2) ? (it < npass) : (m0_ < NTOK); m0_ += NGW * RP, ++it) {
        const bool valid = (MODE != 2) || (m0_ < NTOK);
        const int m0 = valid ? m0_ : NTOK - RP;
        f32x4 v[RP][8];
        const bf16* orow[RP][2]; float cw[RP][2];
        if (MODE == 1 || MODE == 3) {
#pragma unroll
            for (int r = 0; r < RP; ++r) { const int m = m0 + r;
                const int e0 = toke[2 * m], e1 = toke[2 * m + 1], p0 = tokp[2 * m], p1 = tokp[2 * m + 1];
                cw[r][0] = ((const float*)(ws + MS_TOKW))[2 * m]; cw[r][1] = ((const float*)(ws + MS_TOKW))[2 * m + 1];
                orow[r][0] = OP + (size_t)(off[e0] * 256 + p0) * DM + 4 * lane; orow[r][1] = OP + (size_t)(off[e1] * 256 + p1) * DM + 4 * lane; }
        }
#pragma unroll
        for (int r = 0; r < RP; ++r)
#pragma unroll
            for (int j = 0; j < 8; ++j) v[r][j] = *(const f32x4*)(src + (size_t)(m0 + r) * DM + 256 * j + 4 * lane);
        if (MODE == 1 || MODE == 3) {
            u32x2 ow[RP][2][8];
#pragma unroll
            for (int r = 0; r < RP; ++r)
#pragma unroll
                for (int j = 0; j < 8; ++j) { ow[r][0][j] = *(const u32x2*)(orow[r][0] + 256 * j); ow[r][1][j] = *(const u32x2*)(orow[r][1] + 256 * j); }
#pragma unroll
            for (int r = 0; r < RP; ++r)
                asm volatile("" : "+v"(ow[r][0][0]), "+v"(ow[r][0][1]), "+v"(ow[r][0][2]), "+v"(ow[r][0][3]), "+v"(ow[r][0][4]), "+v"(ow[r][0][5]), "+v"(ow[r][0][6]), "+v"(ow[r][0][7]),
                                  "+v"(ow[r][1][0]), "+v"(ow[r][1][1]), "+v"(ow[r][1][2]), "+v"(ow[r][1][3]), "+v"(ow[r][1][4]), "+v"(ow[r][1][5]), "+v"(ow[r][1][6]), "+v"(ow[r][1][7]));
#pragma unroll
            for (int r = 0; r < RP; ++r) { const int m = m0 + r; const float cw0 = cw[r][0], cw1 = cw[r][1];
#pragma unroll
                for (int j = 0; j < 8; ++j) { const u32x2 w0 = ow[r][0][j], w1 = ow[r][1][j];
                    v[r][j].x += cw0 * bflo(w0.x) + cw1 * bflo(w1.x); v[r][j].y += cw0 * bfhi(w0.x) + cw1 * bfhi(w1.x); v[r][j].z += cw0 * bflo(w0.y) + cw1 * bflo(w1.y); v[r][j].w += cw0 * bfhi(w0.y) + cw1 * bfhi(w1.y); }
                if (MODE == 1 && !dry) {
#pragma unroll
                    for (int j = 0; j < 8; ++j) *(f32x4*)(a->out + (size_t)m * DM + 256 * j + 4 * lane) = v[r][j]; }
            }
        }
        float rs[RP];
#pragma unroll
        for (int r = 0; r < RP; ++r) { float ss = 0.f;
#pragma unroll
            for (int j = 0; j < 8; ++j) ss += (v[r][j].x * v[r][j].x + v[r][j].y * v[r][j].y) + (v[r][j].z * v[r][j].z + v[r][j].w * v[r][j].w);
            rs[r] = __builtin_amdgcn_rsqf(wave_sum(ss) * (1.0f / DM) + RMS_EPS); }
        {
            f32x4 gv[8];
            int l4 = 4 * lane; asm volatile("" : "+v"(l4)); const float* gp = gain + l4;
#pragma unroll
            for (int j = 0; j < 8; ++j) gv[j] = *(const f32x4*)(gp + 256 * j);
            asm volatile("" : "+v"(gv[0]), "+v"(gv[1]), "+v"(gv[2]), "+v"(gv[3]), "+v"(gv[4]), "+v"(gv[5]), "+v"(gv[6]), "+v"(gv[7]));
#pragma unroll
            for (int j = 0; j < 8; ++j)
#pragma unroll
                for (int r = 0; r < RP; ++r) v[r][j] = v[r][j] * rs[r] * gv[j];
        }
        if (MODE == 3) {
#pragma unroll
            for (int r = 0; r < RP; ++r)
#pragma unroll
                for (int j = 0; j < 8; ++j) { if (!dry) *(f32x4*)(a->out + (size_t)(m0 + r) * DM + 256 * j + 4 * lane) = v[r][j]; else asm volatile("" :: "v"(v[r][j])); }
            continue;
        }
#pragma unroll
        for (int r = 0; r < RP; ++r)
#pragma unroll
            for (int j = 0; j < 8; ++j) { u32x2 w; w.x = cvt_pk_bf16(v[r][j].x, v[r][j].y); w.y = cvt_pk_bf16(v[r][j].z, v[r][j].w);
                if (!dry && valid) *(u32x2*)(H + (size_t)(m0 + r) * DM + 256 * j + 4 * lane) = w; else asm volatile("" :: "v"(w)); }
        float keep[RP]; _Pragma("unroll") for (int r = 0; r < RP; ++r) keep[r] = 0.f;
        if (MODE < 2) {
            float a8[RP][8];
#pragma unroll
            for (int r = 0; r < RP; ++r)
#pragma unroll
                for (int n = 0; n < 8; ++n) a8[r][n] = 0.f;
#pragma unroll
            for (int j = 0; j < 8; ++j) {
#pragma unroll
                for (int nh = 0; nh < 2; ++nh) {
                    f32x4 wn[4];
#pragma unroll
                    for (int n = 0; n < 4; ++n) wn[n] = *(const LAS f32x4*)(gwl + (4 * nh + n) * 2048 + 256 * j + 4 * lane);
                    asm volatile("" : "+v"(wn[0]), "+v"(wn[1]), "+v"(wn[2]), "+v"(wn[3]));
#pragma unroll
                    for (int r = 0; r < RP; ++r)
#pragma unroll
                        for (int n = 0; n < 4; ++n) a8[r][4 * nh + n] += (v[r][j].x * wn[n].x + v[r][j].y * wn[n].y) + (v[r][j].z * wn[n].z + v[r][j].w * wn[n].w);
                }
            }
#pragma unroll
            for (int r = 0; r < RP; ++r)
#pragma unroll
                for (int n = 0; n < 8; ++n) { const float d = wave_sum(a8[r][n]); keep[r] = (lane == n) ? d : keep[r]; }
        } else {
            const float* W = (const float*)(ws + MS_WRT) + (size_t)l * 36 * 2048;
            LAS float* logl = (LAS float*)(misc + MO_LOG) + wave * 160;
            LAS float* wb = (LAS float*)lds;
#define RT_STAGE(g_, buf_) do { _Pragma("unroll") for (int i = 0; i < 4; ++i) \
                __builtin_amdgcn_global_load_lds((const unsigned*)(W + (size_t)(g_) * 8192 + (wave * 4 + i) * 256 + 4 * lane), (LAS unsigned*)(wb + (buf_) * 8192 + (wave * 4 + i) * 256), 16, 0, 0); } while (0)
            RT_STAGE(0, 0);
            asm volatile("s_waitcnt vmcnt(0)" ::: "memory");
            __syncthreads();
#pragma unroll 1
            for (int grp = 0; grp < 9; ++grp) {
                float val[16];
                if (grp < 8) RT_STAGE(grp + 1, (grp + 1) & 1);
                const LAS float* wg = wb + (grp & 1) * 8192 + 4 * lane;
#pragma unroll
                for (int nl = 0; nl < 4; ++nl) {
                    f32x2 d[4] = {(f32x2){0.f, 0.f}, (f32x2){0.f, 0.f}, (f32x2){0.f, 0.f}, (f32x2){0.f, 0.f}};
                    f32x4 wv[8];
#pragma unroll
                    for (int j = 0; j < 8; ++j) wv[j] = *(const LAS f32x4*)(wg + nl * 2048 + 256 * j);
                    asm volatile("" : "+v"(wv[0]), "+v"(wv[1]), "+v"(wv[2]), "+v"(wv[3]), "+v"(wv[4]), "+v"(wv[5]), "+v"(wv[6]), "+v"(wv[7]));
#pragma unroll
                    for (int j = 0; j < 8; ++j) { const f32x4 w = wv[j];
#pragma unroll
                        for (int r = 0; r < 4; ++r) { d[r] = __builtin_elementwise_fma((f32x2){v[r][j].x, v[r][j].y}, (f32x2){w.x, w.y}, d[r]); d[r] = __builtin_elementwise_fma((f32x2){v[r][j].z, v[r][j].w}, (f32x2){w.z, w.w}, d[r]); } }
#pragma unroll
                    for (int r = 0; r < 4; ++r) val[4 * nl + r] = d[r].x + d[r].y;
                    __builtin_amdgcn_sched_barrier(0);
                }
                asm volatile("s_waitcnt vmcnt(0)" ::: "memory");
                __syncthreads();
#pragma unroll
                for (int i = 0; i < 8; ++i) { const bool hi = (lane & 32) != 0; const float snd = hi ? val[i] : val[i + 8]; const float kp = hi ? val[i + 8] : val[i]; val[i] = kp + __shfl_xor(snd, 32); }
#pragma unroll
                for (int i = 0; i < 4; ++i) { const bool hi = (lane & 16) != 0; const float snd = hi ? val[i] : val[i + 4]; const float kp = hi ? val[i + 4] : val[i]; val[i] = kp + __shfl_xor(snd, 16); }
#pragma unroll
                for (int i = 0; i < 2; ++i) { const bool hi = (lane & 8) != 0; const float snd = hi ? val[i] : val[i + 2]; const float kp = hi ? val[i + 2] : val[i]; val[i] = kp + __shfl_xor(snd, 8); }
                { const bool hi = (lane & 4) != 0; const float snd = hi ? val[0] : val[1]; const float kp = hi ? val[1] : val[0]; val[0] = kp + __shfl_xor(snd, 4); }
                float f = val[0]; f += __shfl_xor(f, 2); f += __shfl_xor(f, 1);
                const int vi = lane >> 2;
                if ((lane & 3) == 0) logl[(vi & 3) * 40 + 4 * grp + (vi >> 2)] = f;
            }
        }
        if (MODE < 2) {
            float* ifg = (float*)(ws + MS_IFG);
            if (lane < 8) {
#pragma unroll
                for (int r = 0; r < RP; ++r) { if (!dry) ifg[(size_t)(m0 + r) * 8 + lane] = keep[r]; else asm volatile("" :: "v"(keep[r])); } }
        } else {
            LAS float* logl = (LAS float*)(misc + MO_LOG) + wave * 160;
            LDS_WAIT();
            if (dry) { asm volatile("" :: "v"(keep[0])); }
            if (lane < RP && !dry && valid) {
                const int m = m0 + lane; const LAS float* lg = logl + lane * 40;
                const float* bg = a->in[I_BGRP] + l * 4; const float* be = a->in[I_BEXP] + l * 32;
                float gv[4]; int gsel = 0;
#pragma unroll
                for (int j = 0; j < 4; ++j) gv[j] = lg[j] + bg[j];
                float gmax = gv[0];
#pragma unroll
                for (int j = 1; j < 4; ++j) if (gv[j] > gmax) { gmax = gv[j]; gsel = j; }
                float gs = 0.f;
#pragma unroll
                for (int j = 0; j < 4; ++j) gs += expf(gv[j] - gmax);
                const float pg = 1.0f / gs;
                float ev[8];
#pragma unroll
                for (int j = 0; j < 8; ++j) ev[j] = lg[4 + 8 * gsel + j] + be[8 * gsel + j];
                int e0 = 0; float m0v = ev[0];
#pragma unroll
                for (int j = 1; j < 8; ++j) if (ev[j] > m0v) { m0v = ev[j]; e0 = j; }
                int e1 = -1; float m1v = -3.0e38f;
#pragma unroll
                for (int j = 0; j < 8; ++j) if (j != e0 && ev[j] > m1v) { m1v = ev[j]; e1 = j; }
                const float p1 = expf(m1v - m0v); const float w0 = pg / (1.0f + p1), w1 = pg * p1 / (1.0f + p1);
                unsigned* cnt = (unsigned*)(ws + WS_CTL) + CW_CNT + 32 * l;
                int* list = (int*)(ws + MS_LIST); float* pwl = (float*)(ws + MS_PWL); int* tke = (int*)(ws + MS_TOKE); int* tkp = (int*)(ws + MS_TOKP);
                const int id0 = 8 * gsel + e0, id1 = 8 * gsel + e1;
                const int q0 = (int)__hip_atomic_fetch_add(cnt + id0, 1u, __ATOMIC_RELAXED, __HIP_MEMORY_SCOPE_AGENT);
                const int q1 = (int)__hip_atomic_fetch_add(cnt + id1, 1u, __ATOMIC_RELAXED, __HIP_MEMORY_SCOPE_AGENT);
                list[id0 * 8192 + q0] = m; pwl[id0 * 8192 + q0] = w0; list[id1 * 8192 + q1] = m; pwl[id1 * 8192 + q1] = w1;
                tke[2 * m] = id0; tke[2 * m + 1] = id1; tkp[2 * m] = q0; tkp[2 * m + 1] = q1;
                ((float*)(ws + MS_TOKW))[2 * m] = w0; ((float*)(ws + MS_TOKW))[2 * m + 1] = w1;
            }
            LDS_WAIT();
        }
    }
}

struct SchedG1 {
    static constexpr bool GATHER = false;
    const char* H; const char* W; int G, c;
    static constexpr int NCV = 21;
    __device__ __forceinline__ bool next(int i, Unit& u) const {
        int L = i * G + c;
        if (G == 256) {
            if (c >= 256 - NCV) return false;
            if (c >= 128 && i == 5) { const int k = c - 128; if (k >= 5 * NCV) return false; L = (k % 5) * 256 + (256 - NCV) + k / 5; }
            else if (i > 5) return false;
        }
        if (L < 1152) { pg8::static_tile(L, 32, 36, u.pm, u.pn); u.aux = 0; return true; }
        const int r = L - 1152; if (r >= 256) return false;
        u.aux = 1 + (r >> 7); const int q = r & 127; u.pm = q & 3; u.pn = q >> 2; return true;
    }
    __device__ __forceinline__ const char* abase(const Unit& u) const { return u.aux == 0 ? H + (size_t)u.pm * 256 * 4096 : W + (size_t)(9216 + (u.aux - 1) * 1024 + u.pm * 256) * 4096; }
    __device__ __forceinline__ const char* bbase(const Unit& u) const { return u.aux == 0 ? W + (size_t)u.pn * 256 * 4096 : H + (size_t)u.pn * 256 * 4096; }
    __device__ __forceinline__ unsigned arow(const Unit&, int) const { return 0u; }
    static __device__ __forceinline__ bool keep_acc(const Unit&) { return false; }
};
struct EpiG1 {
    static constexpr bool PERM = true;
    unsigned char* ws; bool dry;
    __device__ __forceinline__ void operator()(f32x4 (&acc)[2][2][4][2], const Unit& u, int wr, int wc, int fr, int fq) const {
        if (dry) {
#pragma unroll
            for (int ai = 0; ai < 2; ++ai)
#pragma unroll
                for (int bj = 0; bj < 2; ++bj)
#pragma unroll
                    for (int m = 0; m < 4; ++m) asm volatile("" :: "v"(acc[ai][bj][m][0]), "v"(acc[ai][bj][m][1]));
            return; }
        if (u.aux == 0) {
            bf16* dst; int ld, colt, op;
            if (u.pn < 8) { dst = (bf16*)(ws + WS_ZQK); ld = 2048; colt = 256 * u.pn; op = 0; }
            else if (u.pn < 12) { dst = (bf16*)(ws + WS_OM); ld = 1024; colt = 256 * (u.pn - 8); op = 1; }
            else if (u.pn < 16) { dst = (bf16*)(ws + WS_QA); ld = 1024; colt = 256 * (u.pn - 12); op = 2; }
            else if (u.pn < 20) { dst = (bf16*)(ws + WS_KA); ld = 1024; colt = 256 * (u.pn - 16); op = 0; }
            else { dst = (bf16*)(ws + WS_SG); ld = 4096; colt = 256 * (u.pn - 20); op = 1; }
            const float scl = (op == 2) ? 0.12751743074602267f : 1.0f;
            const int row0 = u.pm * 256 + wr * 64 + fr, col0 = colt + wc * 32 + 8 * fq;
#pragma unroll
            for (int ai = 0; ai < 2; ++ai)
#pragma unroll
                for (int m = 0; m < 4; ++m) { bf16* rowp = dst + (size_t)(row0 + ai * 128 + m * 16) * ld + col0;
#pragma unroll
                    for (int bj = 0; bj < 2; ++bj) { f32x4 v0 = acc[ai][bj][m][0] * scl, v1 = acc[ai][bj][m][1] * scl;
                        if (op == 1) {
#pragma unroll
                            for (int j = 0; j < 4; ++j) { v0[j] = sigmoidf_(v0[j]); v1[j] = sigmoidf_(v1[j]); } }
                        u32x4 w; w.x = cvt_pk_bf16(v0[0], v0[1]); w.y = cvt_pk_bf16(v0[2], v0[3]); w.z = cvt_pk_bf16(v1[0], v1[1]); w.w = cvt_pk_bf16(v1[2], v1[3]);
                        *(u32x4*)(rowp + bj * 128) = w; } }
        } else {
            bf16* dst = (bf16*)(ws + (u.aux == 1 ? WS_VMT : WS_VAT));
            const int b = u.pn >> 3, s0 = (u.pn & 7) * 256 + wc * 32 + 8 * fq, rr0 = u.pm * 256 + wr * 64 + fr;
#pragma unroll
            for (int ai = 0; ai < 2; ++ai)
#pragma unroll
                for (int m = 0; m < 4; ++m) { const int rr = rr0 + ai * 128 + m * 16;
#pragma unroll
                    for (int bj = 0; bj < 2; ++bj) { const f32x4 v0 = acc[ai][bj][m][0], v1 = acc[ai][bj][m][1];
                        u32x4 w; w.x = cvt_pk_bf16(v0[0], v0[1]); w.y = cvt_pk_bf16(v0[2], v0[3]); w.z = cvt_pk_bf16(v1[0], v1[1]); w.w = cvt_pk_bf16(v1[2], v1[3]);
                        const int sq = s0 + bj * 128;
                        const size_t off = (u.aux == 1) ? (size_t)((((b * 4 + (rr >> 8)) * 32 + (sq >> 6)) * 2 + ((sq >> 5) & 1)) * 16 + ((rr & 255) >> 4)) * 512 + (size_t)((((sq >> 3) & 3) * 16 + (rr & 15)) * 8)
                                                        : (size_t)(b * 1024 + rr) * 2048 + sq;
                        *(u32x4*)(dst + off) = w; } }
        }
    }
};

__device__ __forceinline__ void gate_unit(ArgsP a, int l, LAS unsigned char* lds, int bh, int tid, int lane, int wave) {
    unsigned char* ws = a->ws;
    {
            const int b = bh >> 2, h = bh & 3;
            LAS float* bl = (LAS float*)lds; LAS float* amx = bl + 32; LAS float* mpv = bl + 64; LAS float* gcv = bl + 96;
            const float* ifg = (const float*)(ws + MS_IFG); const float* ifb = a->in[I_IFB] + l * 8;
            float A[4], Bs[4], CM[4];
#pragma unroll
            for (int cc = 0; cc < 4; ++cc) { const int c = wave + 8 * cc, s = 64 * c + lane; const size_t tok = (size_t)b * SEQ + s;
                const float ig = ifg[tok * 8 + h] + ifb[h], fg = ifg[tok * 8 + 4 + h] + ifb[4 + h];
                const float lf = fminf(fg, 0.f) - log1pf(expf(-fabsf(fg)));
                float bs = lf;
#pragma unroll
                for (int o = 1; o < 64; o <<= 1) { const float t = __shfl_up(bs, o); if (lane >= o) bs += t; }
                const float av = ig - bs; float cm = av;
#pragma unroll
                for (int o = 1; o < 64; o <<= 1) { const float t = __shfl_up(cm, o); if (lane >= o) cm = fmaxf(cm, t); }
                A[cc] = av; Bs[cc] = bs; CM[cc] = cm;
                if (lane == 63) { bl[c] = bs; amx[c] = cm; } }
            __syncthreads();
            if (tid == 0) { float m = 0.f;
#pragma unroll 1
                for (int c = 0; c < 32; ++c) { mpv[c] = m; const float Gm = fmaxf(m, amx[c]); gcv[c] = Gm; m = bl[c] + Gm; } }
            __syncthreads();
            float* AS = (float*)(ws + MS_AS) + bh * 2048; float* GT = (float*)(ws + MS_GT) + bh * 2048; float* WI = (float*)(ws + MS_WI) + bh * 2048;
            float* CL = (float*)(ws + MS_CL) + bh * 2048; float* WSs = (float*)(ws + MS_WS) + bh * 2048; float* DEC = (float*)(ws + MS_DEC) + bh * 32;
#pragma unroll
            for (int cc = 0; cc < 4; ++cc) { const int c = wave + 8 * cc, s = 64 * c + lane; const float mp = mpv[c], Gm = gcv[c], gt = fmaxf(mp, CM[cc]);
                AS[s] = A[cc]; GT[s] = gt; WI[s] = expf(mp - gt); CL[s] = expf(-(Bs[cc] + gt)); WSs[s] = expf(A[cc] - Gm);
                if (lane == 0) DEC[c] = expf(mp - Gm); }
        }
    __syncthreads();
}

__device__ __forceinline__ void conv_phase(ArgsP a, int l, LAS unsigned char* lds, int tid, int lane, int wave, int bid, int G) {
    unsigned char* ws = a->ws;
    u32x4 xv[5];
    const bf16* Z = (const bf16*)(ws + WS_ZQK);
#define CONV_LOAD(u_) do { const int cg_ = (u_) & 7, s0_ = 64 * (((u_) >> 3) & 31), b_ = (u_) >> 8; _Pragma("unroll") for (int i = 0; i < 5; ++i) { \
        const int idx = tid + NTHR * i, row = idx >> 5, ch = idx & 31, sq = s0_ - 3 + row; xv[i] = (u32x4){0u, 0u, 0u, 0u}; \
        if (idx < 67 * 32 && sq >= 0) xv[i] = *(const u32x4*)(Z + (size_t)(b_ * SEQ + sq) * 2048 + cg_ * 256 + ch * 8); } \
        wsn = ((const float*)(ws + MS_WS))[(size_t)(b_ * 4 + ((cg_ - 4) & 3)) * 2048 + s0_ + (tid & 63)]; } while (0)
    float wsn = 0.f;
    if (bid < 1024) CONV_LOAD(bid);
    for (int u = bid; u < 1024 + 256; u += G) {
        if (u < 1024) {
            const int cg = u & 7, st = (u >> 3) & 31, b = u >> 8, s0 = 64 * st;
            LAS unsigned char* xt = lds; LAS unsigned char* kt = lds + 36864;
            const int cp = tid & 127, tg = tid >> 7, c = 2 * cp, gc = cg * 256 + c;
            float w0[4], w1[4];
#pragma unroll
            for (int j = 0; j < 4; ++j) { w0[j] = a->in[I_CONVW][(size_t)(l * 4 + j) * 2048 + gc]; w1[j] = a->in[I_CONVW][(size_t)(l * 4 + j) * 2048 + gc + 1]; }
            asm volatile("" : "+v"(xv[0]), "+v"(xv[1]), "+v"(xv[2]), "+v"(xv[3]), "+v"(xv[4]));
#pragma unroll
            for (int i = 0; i < 5; ++i) { const int idx = tid + NTHR * i, row = idx >> 5, ch = idx & 31;
                if (idx < 67 * 32) *(LAS u32x4*)(xt + row * 512 + ch * 16) = xv[i]; }
            LAS float* wst = (LAS float*)(lds + 73728);
            if (cg >= 4 && tid < 64) wst[tid] = wsn;
            __syncthreads();
            if (u + G < 1024) CONV_LOAD(u + G);
            bf16* QM = (bf16*)(ws + WS_QM); bf16* KM = (bf16*)(ws + WS_KM);
#pragma unroll 4
            for (int tt = 0; tt < 16; ++tt) { const int t = tg * 16 + tt; float a0 = 0.f, a1 = 0.f;
#pragma unroll
                for (int j = 0; j < 4; ++j) { const unsigned x = *(const LAS unsigned*)(xt + (t + j) * 512 + c * 2); a0 += w0[j] * bflo(x); a1 += w1[j] * bfhi(x); }
                float o0 = a0 * sigmoidf_(a0), o1 = a1 * sigmoidf_(a1);
                const size_t tok = (size_t)b * SEQ + s0 + t;
                if (cg < 4) { *(unsigned*)(QM + tok * 1024 + cg * 256 + c) = cvt_pk_bf16(o0, o1); }
                else { o0 *= 0.0625f; o1 *= 0.0625f; const unsigned p = cvt_pk_bf16(o0, o1);
                    *(unsigned*)(KM + tok * 1024 + (cg - 4) * 256 + c) = p;
                    const float wsv = wst[t]; const unsigned ps = cvt_pk_bf16(o0 * wsv, o1 * wsv);
                    *(LAS unsigned short*)(kt + c * 144 + t * 2) = (unsigned short)(ps & 0xffffu); *(LAS unsigned short*)(kt + (c + 1) * 144 + t * 2) = (unsigned short)(ps >> 16); }
            }
            if (cg >= 4) {
                __syncthreads();
                bf16* KMT = (bf16*)(ws + WS_KMT);
                for (int idx = tid; idx < 2048; idx += NTHR) {
                    const int ks = idx >> 10, dtl = (idx >> 6) & 15, ln = idx & 63, row = dtl * 16 + (ln & 15), ch = ks * 4 + (ln >> 4);
                    const u32x4 v = *(const LAS u32x4*)(kt + row * 144 + ch * 16);
                    *(u32x4*)(KMT + (size_t)(((b * 4 + cg - 4) * 32 + st) * 2) * 8192 + (size_t)idx * 8) = v; }
                if (tid < 256) {
                    float sm = 0.f;
#pragma unroll
                    for (int i = 0; i < 8; ++i) { const u32x4 v = *(const LAS u32x4*)(kt + tid * 144 + i * 16);
                        sm += (bflo(v.x) + bfhi(v.x)) + (bflo(v.y) + bfhi(v.y)) + (bflo(v.z) + bfhi(v.z)) + (bflo(v.w) + bfhi(v.w)); }
                    ((float*)(ws + MS_NST))[(size_t)((b * 4 + cg - 4) * 32 + st) * 256 + tid] = sm; }
            }
        } else if (u < 1280) {
            const int j = u - 1024, b = j >> 6, n = (j >> 3) & 7, h = j & 7;
            const bf16* KA = (const bf16*)(ws + WS_KA) + (size_t)(b * SEQ + n * 256 + wave * 32) * 1024 + h * 128 + 2 * lane;
            float s0 = 0.f, s1 = 0.f;
            unsigned xr[32];
#pragma unroll
            for (int r = 0; r < 32; ++r) xr[r] = *(const unsigned*)(KA + (size_t)r * 1024);
#pragma unroll
            for (int r = 0; r < 32; r += 8) asm volatile("" : "+v"(xr[r]), "+v"(xr[r + 1]), "+v"(xr[r + 2]), "+v"(xr[r + 3]), "+v"(xr[r + 4]), "+v"(xr[r + 5]), "+v"(xr[r + 6]), "+v"(xr[r + 7]));
#pragma unroll
            for (int r = 0; r < 32; ++r) { s0 += bflo(xr[r]); s1 += bfhi(xr[r]); }
            LAS float* part = (LAS float*)lds;
            part[wave * 128 + 2 * lane] = s0; part[wave * 128 + 2 * lane + 1] = s1;
            __syncthreads();
            if (tid < 128) { float t = 0.f;
#pragma unroll
                for (int w = 0; w < 8; ++w) t += part[w * 128 + tid];
                ((float*)(ws + MS_KMEAN))[(size_t)((b * 8 + h) * 8 + n) * 128 + tid] = t * (1.0f / 256.0f); }
        }
        __syncthreads();
    }
}

#undef CONV_LOAD
__device__ __forceinline__ void mlstm_ab_task(unsigned char* ws, int gw, int lane, const bool do_store = true) {
    const int bh = gw >> 6, piece = gw & 63, e0 = (piece >> 3) * 32, d0 = (piece & 7) * 32, q16 = lane & 15, g = lane >> 4;
    const bf16* ka = (const bf16*)(ws + WS_KMT) + (size_t)bh * 32 * 16384 + (size_t)(d0 >> 4) * 512 + lane * 8;
    const bf16* vb = (const bf16*)(ws + WS_VMT) + (size_t)bh * 32 * 16384 + (size_t)(e0 >> 4) * 512 + lane * 8;
    const float* DEC = (const float*)(ws + MS_DEC) + bh * 32;
    bf16* CST = (bf16*)(ws + WS_CST) + (size_t)bh * 32 * 65536 + (size_t)((d0 >> 5) * 16 + (e0 >> 4)) * 512 + (size_t)(((g >> 1) * 16 + q16) * 8 + 4 * (g & 1));
    f32x4 acc[2][2];
#pragma unroll
    for (int t = 0; t < 2; ++t) { acc[t][0] = (f32x4){0.f, 0.f, 0.f, 0.f}; acc[t][1] = acc[t][0]; }
    const int decv = __builtin_bit_cast(int, DEC[lane & 31]);
    bf16x8 A0[2][2], B0[2][2], A1[2][2], B1[2][2], A2[2][2], B2[2][2], A3[2][2], B3[2][2], A4[2][2], B4[2][2];
#define AB_LOAD(c_, A_, B_) do { const int cc_ = (c_) < 31 ? (c_) : 31; _Pragma("unroll") for (int ks = 0; ks < 2; ++ks) { \
        A_[0][ks] = *(const bf16x8*)(ka + (size_t)cc_ * 16384 + ks * 8192); A_[1][ks] = *(const bf16x8*)(ka + (size_t)cc_ * 16384 + ks * 8192 + 512); \
        B_[0][ks] = *(const bf16x8*)(vb + (size_t)cc_ * 16384 + ks * 8192); B_[1][ks] = *(const bf16x8*)(vb + (size_t)cc_ * 16384 + ks * 8192 + 512); } } while (0)
#define AB_STEP(c_, A_, B_) do { \
        if (do_store) { _Pragma("unroll") for (int t = 0; t < 2; ++t) _Pragma("unroll") for (int f = 0; f < 2; ++f) { u32x2 w; w.x = cvt_pk_bf16(acc[t][f][0], acc[t][f][1]); w.y = cvt_pk_bf16(acc[t][f][2], acc[t][f][3]); \
            *(u32x2*)(CST + (size_t)(c_) * 65536 + 512 * t + 256 * f) = w; } } \
        const float dec = __builtin_bit_cast(float, __builtin_amdgcn_readlane(decv, (c_))); \
        _Pragma("unroll") for (int t = 0; t < 2; ++t) { acc[t][0] = acc[t][0] * dec; acc[t][1] = acc[t][1] * dec; } \
        _Pragma("unroll") for (int ks = 0; ks < 2; ++ks) _Pragma("unroll") for (int t = 0; t < 2; ++t) { \
            acc[t][0] = __builtin_amdgcn_mfma_f32_16x16x32_bf16(A_[0][ks], B_[t][ks], acc[t][0], 0, 0, 0); \
            acc[t][1] = __builtin_amdgcn_mfma_f32_16x16x32_bf16(A_[1][ks], B_[t][ks], acc[t][1], 0, 0, 0); } } while (0)
    AB_LOAD(0, A0, B0); AB_LOAD(1, A1, B1); AB_LOAD(2, A2, B2); AB_LOAD(3, A3, B3); AB_LOAD(4, A4, B4);
#pragma unroll 1
    for (int c = 0; c < 30; c += 5) {
        AB_STEP(c, A0, B0); AB_LOAD(c + 5, A0, B0);
        AB_STEP(c + 1, A1, B1); AB_LOAD(c + 6, A1, B1);
        AB_STEP(c + 2, A2, B2); AB_LOAD(c + 7, A2, B2);
        AB_STEP(c + 3, A3, B3); AB_LOAD(c + 8, A3, B3);
        AB_STEP(c + 4, A4, B4); AB_LOAD(c + 9, A4, B4);
    }
    AB_STEP(30, A0, B0); AB_STEP(31, A1, B1);
    if (!do_store) asm volatile("" :: "v"(acc[0][0]), "v"(acc[0][1]), "v"(acc[1][0]), "v"(acc[1][1]));
#undef AB_LOAD
#undef AB_STEP
}

__device__ __forceinline__ void nscan_task(unsigned char* ws, int t, int lane) {
    const int bh = t >> 2, d = (t & 3) * 64 + lane;
    const float* cs = (const float*)(ws + MS_NST) + (size_t)bh * 32 * 256 + d;
    float* nv = (float*)(ws + MS_NVEC) + (size_t)bh * 32 * 256 + d;
    const int decv = __builtin_bit_cast(int, ((const float*)(ws + MS_DEC))[bh * 32 + (lane & 31)]);
    float v[32];
#pragma unroll
    for (int j = 0; j < 32; ++j) v[j] = cs[j * 256];
    float n = 0.f;
#pragma unroll
    for (int j = 0; j < 32; ++j) { nv[j * 256] = n; n = __builtin_bit_cast(float, __builtin_amdgcn_readlane(decv, j)) * n + v[j]; }
}

__device__ __forceinline__ int rel_bucket_dev(int n) {
    if (n < 16) return n;
    int b = 16;
    b += (n >= 19); b += (n >= 21); b += (n >= 24); b += (n >= 27); b += (n >= 31); b += (n >= 35); b += (n >= 40); b += (n >= 46);
    b += (n >= 52); b += (n >= 59); b += (n >= 67); b += (n >= 77); b += (n >= 87); b += (n >= 99); b += (n >= 113);
    return b;
}
constexpr int AT_KT = 0, AT_VT = 34816, AT_TAB = 71680, AT_SEL = 72704, AT_TILES = 73216, AT_CTL = 73600, AT_KM = 73728;
__device__ __forceinline__ void attn_unit(ArgsP a, LAS unsigned char* lds, int uidx, int tid, int lane, int wave) {
    unsigned char* ws = a->ws;
    const int u256 = uidx & 255, second = uidx >> 8, bh = u256 >> 3, kk8 = u256 & 7, si = second ? 15 - kk8 : kk8, wgt = 16 - si;
    const int blk = (wgt - 1) >> 1, half = (wgt - 1) & 1, b = bh >> 3, h = bh & 7, q0 = blk * 256 + half * 128;
    const int q16 = lane & 15, g = lane >> 4;
    LAS float* tab = (LAS float*)(lds + AT_TAB); LAS unsigned* sels = (LAS unsigned*)(lds + AT_SEL); LAS int* tiles = (LAS int*)(lds + AT_TILES);
    LAS unsigned* ctl = (LAS unsigned*)(lds + AT_CTL); LAS float* kms = (LAS float*)(lds + AT_KM);
    const bf16* QA = (const bf16*)(ws + WS_QA); const bf16* KA = (const bf16*)(ws + WS_KA); const bf16* VAT = (const bf16*)(ws + WS_VAT);
    u32x4 sr[8], qst[4];
    const int row0 = tid >> 4, ch = tid & 15;
    const bf16* kbase = KA + (size_t)(b * SEQ + row0) * 1024 + h * 128 + ch * 8;
    const bf16* vbase = VAT + (size_t)(bh * 128 + row0) * 2048 + ch * 8;
#define AT_LOAD(ks0_) do { _Pragma("unroll") for (int i = 0; i < 4; ++i) { \
        sr[i] = *(const u32x4*)(kbase + (size_t)((ks0_) + 32 * i) * 1024); sr[4 + i] = *(const u32x4*)(vbase + (size_t)(32 * i) * 2048 + (ks0_)); } } while (0)
#pragma unroll
    for (int i = 0; i < 4; ++i) qst[i] = *(const u32x4*)(QA + (size_t)(b * SEQ + q0 + row0 + 32 * i) * 1024 + h * 128 + ch * 8);
    AT_LOAD(blk * 256);
    if (tid <= 128) tab[tid] = a->in[I_RELB][rel_bucket_dev(tid) * 8 + h] * 1.4426950408889634f;
    for (int idx = tid; idx < 1024; idx += NTHR) kms[idx] = ((const float*)(ws + MS_KMEAN))[bh * 1024 + idx];
    if (tid == 0) ctl[0] = 0u;
    __syncthreads();
    {
        const int q = tid >> 2, part = tid & 3;
        const bf16* qp = QA + (size_t)(b * SEQ + q0 + q) * 1024 + h * 128 + part * 32;
        float qf32[32];
#pragma unroll
        for (int i = 0; i < 4; ++i) { const u32x4 v = *(const u32x4*)(qp + 8 * i);
            qf32[8 * i + 0] = bflo(v.x); qf32[8 * i + 1] = bfhi(v.x); qf32[8 * i + 2] = bflo(v.y); qf32[8 * i + 3] = bfhi(v.y);
            qf32[8 * i + 4] = bflo(v.z); qf32[8 * i + 5] = bfhi(v.z); qf32[8 * i + 6] = bflo(v.w); qf32[8 * i + 7] = bfhi(v.w); }
        float gate[8];
#pragma unroll
        for (int n = 0; n < 8; ++n) { float s = 0.f;
            if (n < blk) {
#pragma unroll
                for (int d = 0; d < 32; d += 4) { const f32x4 kv = *(const LAS f32x4*)(kms + n * 128 + part * 32 + d);
                    s += (qf32[d] * kv.x + qf32[d + 1] * kv.y) + (qf32[d + 2] * kv.z + qf32[d + 3] * kv.w); }
            }
            s += __shfl_xor(s, 1); s += __shfl_xor(s, 2); gate[n] = s; }
        if (part == 0) {
            unsigned sel;
            if (blk <= 3) sel = (1u << blk) - 1u;
            else { sel = 0u;
#pragma unroll
                for (int it = 0; it < 3; ++it) { int best = 0; float bv = -3.0e38f;
#pragma unroll
                    for (int n = 0; n < 8; ++n) if (n < blk && !((sel >> n) & 1u) && gate[n] > bv) { bv = gate[n]; best = n; }
                    sel |= 1u << best; } }
            sels[q] = sel; atomicOr((unsigned*)ctl, sel);
        }
    }
    __syncthreads();
    if (tid == 0) { int nt = 0; const unsigned any = ctl[0];
        for (int j = 0; j < half + 1; ++j) tiles[nt++] = blk * 256 + 128 * j;
        for (int n = 0; n < blk; ++n) if ((any >> n) & 1u) for (int j = 0; j < 2; ++j) tiles[nt++] = n * 256 + 128 * j;
        ctl[1] = (unsigned)nt; }
    __syncthreads();
    const int ntiles = (int)ctl[1];
    const int qg = wave & 3, kp = wave >> 2;
    int qpos[2]; unsigned mysel[2];
#pragma unroll
    for (int f = 0; f < 2; ++f) { qpos[f] = q0 + 32 * qg + 16 * f + q16; mysel[f] = sels[32 * qg + 16 * f + q16]; }
    constexpr int AT_Q = 77824;
#pragma unroll
    for (int i = 0; i < 4; ++i) *(LAS u32x4*)(lds + AT_Q + (row0 + 32 * i) * 272 + ch * 16) = qst[i];
    const LAS unsigned char* qrow = lds + AT_Q + (32 * qg + q16) * 272 + 16 * g;
    float m_run[2] = {-1.0e30f, -1.0e30f}, l_run[2] = {0.f, 0.f};
    f32x4 oacc[2][8];
#pragma unroll
    for (int f = 0; f < 2; ++f)
#pragma unroll
        for (int m = 0; m < 8; ++m) oacc[f][m] = (f32x4){0.f, 0.f, 0.f, 0.f};
    const int vpos = (ch >> 2) * 32 + 16 * (ch & 1) + 4 * ((ch & 3) >> 1);
#define AT_WRITE() do { _Pragma("unroll") for (int i = 0; i < 4; ++i) { \
        *(LAS u32x4*)(lds + AT_KT + (row0 + 32 * i) * 272 + ch * 16) = sr[i]; \
        *(LAS u32x2*)(lds + AT_VT + (row0 + 32 * i) * 272 + vpos * 2) = (u32x2){sr[4 + i].x, sr[4 + i].y}; \
        *(LAS u32x2*)(lds + AT_VT + (row0 + 32 * i) * 272 + (vpos + 8) * 2) = (u32x2){sr[4 + i].z, sr[4 + i].w}; } } while (0)
    AT_WRITE();
    __syncthreads();
    if (ntiles > 1) { const int k1 = tiles[1]; AT_LOAD(k1); }
    for (int ti = 0; ti < ntiles; ++ti) {
        const int kstart = tiles[ti] + 64 * kp, nblk = kstart >> 8;
        const bool own = (nblk == blk);
        const bool any_ok = own ? true : (__any((((mysel[0] | mysel[1]) >> nblk) & 1u) != 0u) != 0);
        const bool active = own ? (kstart <= q0 + 32 * qg + 31) : any_ok;
        if (active) {
            const LAS unsigned char* kt = lds + AT_KT + 64 * kp * 272; const LAS unsigned char* vt = lds + AT_VT + 64 * kp * 2;
            f32x4 s[2][4];
#pragma unroll
            for (int n = 0; n < 4; ++n) { s[0][n] = (f32x4){0.f, 0.f, 0.f, 0.f}; s[1][n] = s[0][n]; }
#pragma unroll
            for (int ks = 0; ks < 4; ++ks) {
                bf16x8 q0f = *(const LAS bf16x8*)(qrow + 64 * ks), q1f = *(const LAS bf16x8*)(qrow + 16 * 272 + 64 * ks);
                bf16x8 kf[4];
#pragma unroll
                for (int n = 0; n < 4; ++n) kf[n] = *(const LAS bf16x8*)(kt + (16 * n + q16) * 272 + (32 * ks + 8 * g) * 2);
                asm volatile("" : "+v"(q0f), "+v"(q1f), "+v"(kf[0]), "+v"(kf[1]), "+v"(kf[2]), "+v"(kf[3]));
#pragma unroll
                for (int n = 0; n < 4; ++n) {
                    s[0][n] = __builtin_amdgcn_mfma_f32_16x16x32_bf16(kf[n], q0f, s[0][n], 0, 0, 0);
                    s[1][n] = __builtin_amdgcn_mfma_f32_16x16x32_bf16(kf[n], q1f, s[1][n], 0, 0, 0); } }
            const bool far = ((q0 + 32 * qg) - (kstart + 63)) >= 128;
            const float bfar = tab[128];
#pragma unroll
            for (int f = 0; f < 2; ++f) {
                const bool lane_ok = own ? true : (((mysel[f] >> nblk) & 1u) != 0u);
                float psum = 0.f, m_new;
#define AT_MNEW(mx_) fmaxf(((mx_) > m_run[f] + 8.0f) ? (mx_) : m_run[f], -1.0e29f)
                if (far) {
                    const float addc = lane_ok ? bfar : -1.0e30f;
                    float mx = -1.0e30f;
#pragma unroll
                    for (int n = 0; n < 4; ++n)
#pragma unroll
                        for (int r = 0; r < 4; ++r) mx = fmaxf(mx, s[f][n][r]);
                    mx = rows4_max(mx + addc);
                    m_new = AT_MNEW(mx);
                    const float cc = addc - m_new;
#pragma unroll
                    for (int n = 0; n < 4; ++n)
#pragma unroll
                        for (int r = 0; r < 4; ++r) { const float p = __builtin_amdgcn_exp2f(s[f][n][r] + cc); s[f][n][r] = p; psum += p; }
                } else {
                    const int kmax = lane_ok ? (own ? qpos[f] : 0x7fffffff) : -1;
                    float mx = -1.0e30f;
                    float bs[4][4];
#pragma unroll
                    for (int n = 0; n < 4; ++n)
#pragma unroll
                        for (int r = 0; r < 4; ++r) { int di = qpos[f] - (kstart + 16 * n + 4 * g + r); di = di < 0 ? 0 : di; di = di > 128 ? 128 : di; bs[n][r] = tab[di]; }
#pragma unroll
                    for (int n = 0; n < 4; ++n) asm volatile("" : "+v"(bs[n][0]), "+v"(bs[n][1]), "+v"(bs[n][2]), "+v"(bs[n][3]));
#pragma unroll
                    for (int n = 0; n < 4; ++n)
#pragma unroll
                        for (int r = 0; r < 4; ++r) { const int key = kstart + 16 * n + 4 * g + r;
                            const float v = (key <= kmax) ? s[f][n][r] + bs[n][r] : -1.0e30f;
                            s[f][n][r] = v; mx = fmaxf(mx, v); }
                    mx = rows4_max(mx);
                    m_new = AT_MNEW(mx);
#pragma unroll
                    for (int n = 0; n < 4; ++n)
#pragma unroll
                        for (int r = 0; r < 4; ++r) { const float p = __builtin_amdgcn_exp2f(s[f][n][r] - m_new); s[f][n][r] = p; psum += p; }
                }
#undef AT_MNEW
                const float alpha = __builtin_amdgcn_exp2f(m_run[f] - m_new);
                psum = rows4_sum(psum);
                l_run[f] = l_run[f] * alpha + psum;
                if (__any(m_new != m_run[f])) {
#pragma unroll
                    for (int m = 0; m < 8; ++m) oacc[f][m] = oacc[f][m] * alpha;
                }
                m_run[f] = m_new;
            }
#pragma unroll
            for (int k2 = 0; k2 < 2; ++k2) {
                bf16x8 pf[2];
#pragma unroll
                for (int f = 0; f < 2; ++f) { u32x4 pb; pb.x = cvt_pk_bf16(s[f][2 * k2][0], s[f][2 * k2][1]); pb.y = cvt_pk_bf16(s[f][2 * k2][2], s[f][2 * k2][3]);
                    pb.z = cvt_pk_bf16(s[f][2 * k2 + 1][0], s[f][2 * k2 + 1][1]); pb.w = cvt_pk_bf16(s[f][2 * k2 + 1][2], s[f][2 * k2 + 1][3]);
                    pf[f] = __builtin_bit_cast(bf16x8, pb); }
#pragma unroll
                for (int mh = 0; mh < 2; ++mh) {
                    bf16x8 af[4];
#pragma unroll
                    for (int m = 0; m < 4; ++m) af[m] = *(const LAS bf16x8*)(vt + (16 * (4 * mh + m) + q16) * 272 + (32 * k2 + 8 * g) * 2);
                    asm volatile("" : "+v"(af[0]), "+v"(af[1]), "+v"(af[2]), "+v"(af[3]));
#pragma unroll
                    for (int m = 0; m < 4; ++m) {
                        oacc[0][4 * mh + m] = __builtin_amdgcn_mfma_f32_16x16x32_bf16(af[m], pf[0], oacc[0][4 * mh + m], 0, 0, 0);
                        oacc[1][4 * mh + m] = __builtin_amdgcn_mfma_f32_16x16x32_bf16(af[m], pf[1], oacc[1][4 * mh + m], 0, 0, 0); } }
            }
        }
        __syncthreads();
        if (ti + 1 < ntiles) { AT_WRITE(); }
        __syncthreads();
        if (ti + 2 < ntiles) { const int kn = tiles[ti + 2]; AT_LOAD(kn); }
    }
    LAS float* mo = (LAS float*)lds; LAS float* ml = (LAS float*)(lds + 65536);
    if (kp == 1) {
#pragma unroll
        for (int f = 0; f < 2; ++f) {
#pragma unroll
            for (int m = 0; m < 8; ++m)
#pragma unroll
                for (int r = 0; r < 4; ++r) mo[((qg * 2 + f) * 8 + m) * 256 + r * 64 + lane] = oacc[f][m][r];
            ml[(qg * 2 + f) * 128 + lane] = m_run[f]; ml[(qg * 2 + f) * 128 + 64 + lane] = l_run[f]; }
    }
    __syncthreads();
    if (kp == 0) {
#pragma unroll
        for (int f = 0; f < 2; ++f) {
            const float m1 = ml[(qg * 2 + f) * 128 + lane], l1 = ml[(qg * 2 + f) * 128 + 64 + lane];
            const float mm = fmaxf(m_run[f], m1), a0 = __builtin_amdgcn_exp2f(m_run[f] - mm), a1 = __builtin_amdgcn_exp2f(m1 - mm);
            const float inv = __builtin_amdgcn_rcpf(l_run[f] * a0 + l1 * a1);
            bf16* HA = (bf16*)(ws + WS_HA) + (size_t)(b * SEQ + qpos[f]) * 1024 + h * 128 + 4 * g;
#pragma unroll
            for (int m = 0; m < 8; ++m) { float o[4];
#pragma unroll
                for (int r = 0; r < 4; ++r) o[r] = (oacc[f][m][r] * a0 + mo[((qg * 2 + f) * 8 + m) * 256 + r * 64 + lane] * a1) * inv;
                u32x2 w; w.x = cvt_pk_bf16(o[0], o[1]); w.y = cvt_pk_bf16(o[2], o[3]); *(u32x2*)(HA + 16 * m) = w; }
        }
    }
#undef AT_LOAD
#undef AT_WRITE
}

constexpr int MC_Q = 0, MC_K = 33792, MC_SP = 67584, MC_SC = 76800, MC_NV = 79104;
struct McRegs { u32x4 qr[4], kr[4]; float sc4[4]; float nv0; bf16x8 cb[8][2], vbf[2][2]; u32x2 ovv[8]; };
__device__ __forceinline__ void mc_load_qk(McRegs& R, const unsigned char* ws, int u, int tid) {
    const int bh = u >> 5, c = u & 31, b = bh >> 2, h = bh & 3; const size_t tok0 = (size_t)b * SEQ + 64 * c;
    const bf16* QM = (const bf16*)(ws + WS_QM); const bf16* KM = (const bf16*)(ws + WS_KM);
#pragma unroll
    for (int i = 0; i < 4; ++i) { const int idx = tid + NTHR * i, row = idx >> 5, ch = idx & 31;
        R.qr[i] = *(const u32x4*)(QM + (tok0 + row) * 1024 + h * 256 + ch * 8); R.kr[i] = *(const u32x4*)(KM + (tok0 + row) * 1024 + h * 256 + ch * 8); }
}
__device__ __forceinline__ void mc_load_sc(McRegs& R, const unsigned char* ws, int u, int tid) {
    const int bh = u >> 5, c = u & 31; const int s = bh * 2048 + 64 * c + (tid & 63);
    R.sc4[0] = ((const float*)(ws + MS_AS))[s]; R.sc4[1] = ((const float*)(ws + MS_GT))[s]; R.sc4[2] = ((const float*)(ws + MS_WI))[s]; R.sc4[3] = ((const float*)(ws + MS_CL))[s];
    R.nv0 = ((const float*)(ws + MS_NVEC))[(size_t)(bh * 32 + c) * 256 + (tid & 255)];
}
__device__ __forceinline__ void mc_load_cb(McRegs& R, const unsigned char* ws, int u, int lane, int wave) {
    const bf16* Cp = (const bf16*)(ws + WS_CST) + (size_t)u * 65536 + (size_t)(2 * wave) * 512 + lane * 8;
#pragma unroll
    for (int ks = 0; ks < 8; ++ks) { R.cb[ks][0] = *(const bf16x8*)(Cp + ks * 8192); R.cb[ks][1] = *(const bf16x8*)(Cp + ks * 8192 + 512); }
}
__device__ __forceinline__ void mc_load_v(McRegs& R, const unsigned char* ws, int u, int lane, int wave) {
    const bf16* Vp = (const bf16*)(ws + WS_VMT) + (size_t)u * 16384 + (size_t)(2 * wave) * 512 + lane * 8;
#pragma unroll
    for (int ks = 0; ks < 2; ++ks) { R.vbf[ks][0] = *(const bf16x8*)(Vp + ks * 8192); R.vbf[ks][1] = *(const bf16x8*)(Vp + ks * 8192 + 512); }
}
__device__ __forceinline__ void mc_load_ov(McRegs& R, const unsigned char* ws, int u, int lane, int wave) {
    const int bh = u >> 5, c = u & 31, b = bh >> 2, h = bh & 3; const size_t tok0 = (size_t)b * SEQ + 64 * c;
    const bf16* OM = (const bf16*)(ws + WS_OM);
#pragma unroll
    for (int i = 0; i < 8; ++i) R.ovv[i] = *(const u32x2*)(OM + (tok0 + 8 * wave + i) * 1024 + h * 256 + 4 * lane);
}
template <bool PF, bool HAVE>
__device__ __forceinline__ void mlstm_c_body(ArgsP a, int l, LAS unsigned char* lds, int u, int un, McRegs& R, int tid_, int lane_, int wave) {
    unsigned char* ws = a->ws;
    int tid = wave * 64 + lane_id(); asm volatile("" : "+v"(tid));
    const int lane = tid & 63; (void)tid_; (void)lane_;
    const int bh = u >> 5, c = u & 31, b = bh >> 2, h = bh & 3, t0 = 64 * c, q16 = lane & 15, g = lane >> 4;
    const size_t tok0 = (size_t)b * SEQ + t0;
    LAS unsigned char* Qs = lds + MC_Q; LAS unsigned char* Ks = lds + MC_K; LAS unsigned char* Sp = lds + MC_SP;
    LAS float* sc = (LAS float*)(lds + MC_SC); LAS float* as_ = sc; LAS float* gt_ = sc + 64; LAS float* wi_ = sc + 128; LAS float* cl_ = sc + 192; LAS float* qn_ = sc + 256; LAS float* denp = sc + 320;
    LAS float* nvec = (LAS float*)(lds + MC_NV);
    mc_load_qk(R, ws, u, tid); mc_load_sc(R, ws, u, tid);
    if (!HAVE) mc_load_cb(R, ws, u, lane, wave);
#pragma unroll
    for (int i = 0; i < 4; ++i) { const int idx = tid + NTHR * i, row = idx >> 5, ch = idx & 31;
        *(LAS u32x4*)(Qs + row * 528 + ch * 16) = R.qr[i]; *(LAS u32x4*)(Ks + row * 528 + ch * 16) = R.kr[i]; }
    mc_load_v(R, ws, u, lane, wave);
    if (tid < 64) { as_[tid] = R.sc4[0]; gt_[tid] = R.sc4[1]; wi_[tid] = R.sc4[2]; cl_[tid] = R.sc4[3]; }
    if (tid < 256) nvec[tid] = R.nv0;
    __syncthreads();
    f32x4 acc[4][2];
#pragma unroll
    for (int m = 0; m < 4; ++m) { acc[m][0] = (f32x4){0.f, 0.f, 0.f, 0.f}; acc[m][1] = acc[m][0]; }
    if (c > 0) {
#pragma unroll
        for (int ks = 0; ks < 8; ++ks) {
#pragma unroll
            for (int m = 0; m < 4; ++m) { const bf16x8 af = *(const LAS bf16x8*)(Qs + (16 * m + q16) * 528 + (32 * ks + 8 * g) * 2);
                acc[m][0] = __builtin_amdgcn_mfma_f32_16x16x32_bf16(af, R.cb[ks][0], acc[m][0], 0, 0, 0);
                acc[m][1] = __builtin_amdgcn_mfma_f32_16x16x32_bf16(af, R.cb[ks][1], acc[m][1], 0, 0, 0); }
        }
#pragma unroll
        for (int m = 0; m < 4; ++m)
#pragma unroll
            for (int r = 0; r < 4; ++r) { const float w = wi_[16 * m + 4 * g + r]; acc[m][0][r] *= w; acc[m][1][r] *= w; }
    }
    {
        const int mS = wave & 3, nS0 = 2 * (wave >> 2);
        f32x4 sacc[2]; sacc[0] = (f32x4){0.f, 0.f, 0.f, 0.f}; sacc[1] = sacc[0];
#pragma unroll
        for (int kh = 0; kh < 4; ++kh) {
            bf16x8 af[2], bq[2][2];
#pragma unroll
            for (int k2 = 0; k2 < 2; ++k2) { const int ks = 2 * kh + k2;
                af[k2] = *(const LAS bf16x8*)(Qs + (16 * mS + q16) * 528 + (32 * ks + 8 * g) * 2);
#pragma unroll
                for (int nn = 0; nn < 2; ++nn) bq[k2][nn] = *(const LAS bf16x8*)(Ks + (16 * (nS0 + nn) + q16) * 528 + (32 * ks + 8 * g) * 2); }
            asm volatile("" : "+v"(af[0]), "+v"(af[1]), "+v"(bq[0][0]), "+v"(bq[0][1]), "+v"(bq[1][0]), "+v"(bq[1][1]));
#pragma unroll
            for (int k2 = 0; k2 < 2; ++k2)
#pragma unroll
                for (int nn = 0; nn < 2; ++nn) sacc[nn] = __builtin_amdgcn_mfma_f32_16x16x32_bf16(af[k2], bq[k2][nn], sacc[nn], 0, 0, 0);
        }
#pragma unroll
        for (int nn = 0; nn < 2; ++nn) { const int s = 16 * (nS0 + nn) + q16; const float av = as_[s];
#pragma unroll
            for (int r = 0; r < 4; ++r) { const int t = 16 * mS + 4 * g + r;
                float val = (s <= t) ? sacc[nn][r] * __expf(av - gt_[t]) : 0.f;
                *(LAS unsigned short*)(Sp + t * 144 + s * 2) = (unsigned short)(cvt_pk_bf16(val, val) & 0xffffu);
                val += __shfl_xor(val, 1); val += __shfl_xor(val, 2); val += __shfl_xor(val, 4); val += __shfl_xor(val, 8);
                if (q16 == 0) denp[(nS0 + nn) * 64 + t] = val; } }
    }
    {
        const int t = tid >> 3, seg = tid & 7; float s = 0.f;
#pragma unroll
        for (int i = 0; i < 4; ++i) { const u32x4 v = *(const LAS u32x4*)(Qs + t * 528 + (seg * 32 + 8 * i) * 2); const LAS float* nv = nvec + seg * 32 + 8 * i;
            s += bflo(v.x) * nv[0] + bfhi(v.x) * nv[1] + bflo(v.y) * nv[2] + bfhi(v.y) * nv[3] + bflo(v.z) * nv[4] + bfhi(v.z) * nv[5] + bflo(v.w) * nv[6] + bfhi(v.w) * nv[7]; }
        s += __shfl_xor(s, 1); s += __shfl_xor(s, 2); s += __shfl_xor(s, 4);
        if (seg == 0) qn_[t] = s;
    }
    __syncthreads();
    if (PF) {
#pragma unroll
        for (int ks = 0; ks < 8; ++ks) asm volatile("" :: "v"(R.cb[ks][0]), "v"(R.cb[ks][1]));
        __builtin_amdgcn_sched_barrier(0);
        mc_load_cb(R, ws, un, lane, wave);
        __builtin_amdgcn_sched_barrier(0);
    }
    {
#pragma unroll
        for (int ks = 0; ks < 2; ++ks) {
            bf16x8 sf[4];
#pragma unroll
            for (int m = 0; m < 4; ++m) sf[m] = *(const LAS bf16x8*)(Sp + (16 * m + q16) * 144 + (32 * ks + 8 * g) * 2);
            asm volatile("" : "+v"(sf[0]), "+v"(sf[1]), "+v"(sf[2]), "+v"(sf[3]));
#pragma unroll
            for (int m = 0; m < 4; ++m) {
                acc[m][0] = __builtin_amdgcn_mfma_f32_16x16x32_bf16(sf[m], R.vbf[ks][0], acc[m][0], 0, 0, 0);
                acc[m][1] = __builtin_amdgcn_mfma_f32_16x16x32_bf16(sf[m], R.vbf[ks][1], acc[m][1], 0, 0, 0); }
        }
    }
    LAS float* NUM = (LAS float*)lds;
#pragma unroll
    for (int m = 0; m < 4; ++m)
#pragma unroll
        for (int r = 0; r < 4; ++r) { const int t = 16 * m + 4 * g + r;
            const float den = (denp[t] + denp[64 + t]) + (denp[128 + t] + denp[192 + t]) + wi_[t] * qn_[t];
            const float inv = __builtin_amdgcn_rcpf(fmaxf(fabsf(den), cl_[t]));
            NUM[t * 260 + 32 * wave + q16] = acc[m][0][r] * inv; NUM[t * 260 + 32 * wave + 16 + q16] = acc[m][1][r] * inv; }
    __syncthreads();
    {
        const float* mg = a->in[I_MNG] + l * 1024 + h * 256 + 4 * lane; const f32x4 gn = *(const f32x4*)mg;
        bf16* HM = (bf16*)(ws + WS_HM);
        mc_load_ov(R, ws, u, lane, wave);
        asm volatile("" : "+v"(R.ovv[0]), "+v"(R.ovv[1]), "+v"(R.ovv[2]), "+v"(R.ovv[3]), "+v"(R.ovv[4]), "+v"(R.ovv[5]), "+v"(R.ovv[6]), "+v"(R.ovv[7]));
#pragma unroll
        for (int i = 0; i < 8; ++i) { const int t = 8 * wave + i;
            const f32x4 v = *(const LAS f32x4*)(NUM + t * 260 + 4 * lane);
            const float mu = wave_sum((v.x + v.y) + (v.z + v.w)) * (1.0f / 256.0f);
            const f32x4 d = v - mu;
            const float var = wave_sum((d.x * d.x + d.y * d.y) + (d.z * d.z + d.w * d.w)) * (1.0f / 256.0f);
            const float rstd = __builtin_amdgcn_rsqf(var + LN_EPS);
            const u32x2 ov = R.ovv[i];
            u32x2 w; w.x = cvt_pk_bf16(d.x * rstd * gn.x * bflo(ov.x), d.y * rstd * gn.y * bfhi(ov.x)); w.y = cvt_pk_bf16(d.z * rstd * gn.z * bflo(ov.y), d.w * rstd * gn.w * bfhi(ov.y));
            *(u32x2*)(HM + (tok0 + t) * 1024 + h * 256 + 4 * lane) = w; }
    }
    __syncthreads();
}
__device__ __forceinline__ void mlstm_c_phase(ArgsP a, int l, LAS unsigned char* lds, int tid, int lane, int wave, int bid, int G) {
    int u = bid; if (u >= 512) return;
    McRegs R;
    if (u + G < 512 && u + 2 * G >= 512) {
        mlstm_c_body<true, false>(a, l, lds, u, u + G, R, tid, lane, wave);
        mlstm_c_body<false, true>(a, l, lds, u + G, u + G, R, tid, lane, wave);
    } else {
#pragma unroll 1
        for (; u < 512; u += G) mlstm_c_body<false, false>(a, l, lds, u, u, R, tid, lane, wave);
    }
}

struct SchedStd {
    static constexpr bool GATHER = false;
    const char* A; const char* B; int nM, nN, K, G, c;
    __device__ __forceinline__ bool next(int i, Unit& u) const { const int L = i * G + c; if (L >= nM * nN) return false; pg8::static_tile(L, nM, nN, u.pm, u.pn); u.aux = 0; return true; }
    __device__ __forceinline__ const char* abase(const Unit& u) const { return A + (size_t)u.pm * 512 * K; }
    __device__ __forceinline__ const char* bbase(const Unit& u) const { return B + (size_t)u.pn * 512 * K; }
    __device__ __forceinline__ unsigned arow(const Unit&, int) const { return 0u; }
    static __device__ __forceinline__ bool keep_acc(const Unit&) { return false; }
};
struct SchedBr {
    static constexpr bool GATHER = false;
    const char* HM; const char* HA; const char* WM; const char* WA; int G, c;
    __device__ __forceinline__ bool next(int i, Unit& u) const { const int L = (i >> 1) * G + c; if (L >= 256) return false; pg8::static_tile(L, 32, 8, u.pm, u.pn); u.aux = i & 1; return true; }
    __device__ __forceinline__ const char* abase(const Unit& u) const { return (u.aux ? HA : HM) + (size_t)u.pm * 512 * 1024; }
    __device__ __forceinline__ const char* bbase(const Unit& u) const { return (u.aux ? WA : WM) + (size_t)u.pn * 512 * 1024; }
    __device__ __forceinline__ unsigned arow(const Unit&, int) const { return 0u; }
    static __device__ __forceinline__ bool keep_acc(const Unit& u) { return u.aux == 0; }
};
struct EpiBr {
    static constexpr bool PERM = true;
    const bf16* SG; bf16* Y;
    __device__ __forceinline__ void operator()(f32x4 (&acc)[2][2][4][2], const Unit& u, int wr, int wc, int fr, int fq) const {
        const int row0 = u.pm * 256 + wr * 64 + fr, col0 = u.pn * 256 + wc * 32 + 8 * fq;
#pragma unroll
        for (int ai = 0; ai < 2; ++ai) {
            u32x4 sa[4][2], sm[4][2];
#pragma unroll
            for (int m = 0; m < 4; ++m) { const size_t row = row0 + ai * 128 + m * 16;
#pragma unroll
                for (int bj = 0; bj < 2; ++bj) { const int col = col0 + bj * 128;
                    sa[m][bj] = *(const u32x4*)(SG + row * 4096 + 2048 + col);
                    sm[m][bj] = *(const u32x4*)(SG + row * 4096 + (u.aux == 0 ? 0 : 2048) + col); } }
            asm volatile("" : "+v"(sa[0][0]), "+v"(sa[0][1]), "+v"(sa[1][0]), "+v"(sa[1][1]), "+v"(sa[2][0]), "+v"(sa[2][1]), "+v"(sa[3][0]), "+v"(sa[3][1]),
                              "+v"(sm[0][0]), "+v"(sm[0][1]), "+v"(sm[1][0]), "+v"(sm[1][1]), "+v"(sm[2][0]), "+v"(sm[2][1]), "+v"(sm[3][0]), "+v"(sm[3][1]));
#pragma unroll
            for (int m = 0; m < 4; ++m) { const size_t row = row0 + ai * 128 + m * 16;
#pragma unroll
                for (int bj = 0; bj < 2; ++bj) { const int col = col0 + bj * 128;
                    const u32x4 a4 = sa[m][bj], m4 = sm[m][bj];
                    const float ga[8] = {bflo(a4.x), bfhi(a4.x), bflo(a4.y), bfhi(a4.y), bflo(a4.z), bfhi(a4.z), bflo(a4.w), bfhi(a4.w)};
                    if (u.aux == 0) {
                        const float gm[8] = {bflo(m4.x), bfhi(m4.x), bflo(m4.y), bfhi(m4.y), bflo(m4.z), bfhi(m4.z), bflo(m4.w), bfhi(m4.w)};
#pragma unroll
                        for (int j = 0; j < 4; ++j) { acc[ai][bj][m][0][j] *= gm[j] * __builtin_amdgcn_rcpf(fmaxf(ga[j], 1.0e-30f)); acc[ai][bj][m][1][j] *= gm[4 + j] * __builtin_amdgcn_rcpf(fmaxf(ga[4 + j], 1.0e-30f)); }
                    } else {
                        const f32x4 v0 = acc[ai][bj][m][0], v1 = acc[ai][bj][m][1];
                        u32x4 w; w.x = cvt_pk_bf16(v0[0] * ga[0], v0[1] * ga[1]); w.y = cvt_pk_bf16(v0[2] * ga[2], v0[3] * ga[3]);
                        w.z = cvt_pk_bf16(v1[0] * ga[4], v1[1] * ga[5]); w.w = cvt_pk_bf16(v1[2] * ga[6], v1[3] * ga[7]);
                        *(u32x4*)(Y + row * 2048 + col) = w; }
                } }
        }
    }
};
struct EpiOut {
    static constexpr bool PERM = false;
    const float* res; float* out;
    __device__ __forceinline__ void operator()(f32x4 (&acc)[2][2][4][2], const Unit& u, int wr, int wc, int fr, int fq) const {
        const int row0 = u.pm * 256 + wr * 64 + fr, col0 = u.pn * 256 + wc * 32 + 4 * fq;
#pragma unroll
        for (int ai = 0; ai < 2; ++ai) {
            f32x4 rv[4][2][2];
#pragma unroll
            for (int m = 0; m < 4; ++m) { const size_t ro = (size_t)(row0 + ai * 128 + m * 16) * DM + col0;
#pragma unroll
                for (int bj = 0; bj < 2; ++bj)
#pragma unroll
                    for (int n = 0; n < 2; ++n) rv[m][bj][n] = *(const f32x4*)(res + ro + bj * 128 + n * 16); }
#pragma unroll
            for (int m = 0; m < 4; ++m) asm volatile("" : "+v"(rv[m][0][0]), "+v"(rv[m][0][1]), "+v"(rv[m][1][0]), "+v"(rv[m][1][1]));
#pragma unroll
            for (int m = 0; m < 4; ++m) { const size_t ro = (size_t)(row0 + ai * 128 + m * 16) * DM + col0;
#pragma unroll
                for (int bj = 0; bj < 2; ++bj)
#pragma unroll
                    for (int n = 0; n < 2; ++n) *(f32x4*)(out + ro + bj * 128 + n * 16) = rv[m][bj][n] + acc[ai][bj][m][n]; }
        }
    }
};
struct SchedMoe1 {
    static constexpr bool GATHER = true;
    const char* H; const char* W13; const int* LIST; const LAS int* te; const LAS int* tr0; const LAS int* cnt; int MT, G, c;
    __device__ __forceinline__ bool next(int i, Unit& u) const { const int L = i * G + c; if (L >= 2 * MT) return false; u.pm = L >> 1; u.pn = L & 1; u.aux = __builtin_amdgcn_readfirstlane(te[u.pm]); return true; }
    __device__ __forceinline__ const char* abase(const Unit&) const { return H; }
    __device__ __forceinline__ const char* bbase(const Unit& u) const { return W13 + ((size_t)u.aux * 512 + u.pn * 256) * 4096; }
    static __device__ __forceinline__ bool keep_acc(const Unit&) { return false; }
    __device__ __forceinline__ unsigned arow(const Unit& u, int r) const { const int rr = __builtin_amdgcn_readfirstlane(tr0[u.pm]) + r; return rr < __builtin_amdgcn_readfirstlane(cnt[u.aux]) ? (unsigned)LIST[u.aux * 8192 + rr] : 0u; }
};
struct EpiMoe1 {
    static constexpr bool PERM = true;
    bf16* HID; const float* PWL; const LAS int* tr0; const LAS int* cnt;
    __device__ __forceinline__ void operator()(f32x4 (&acc)[2][2][4][2], const Unit& u, int wr, int wc, int fr, int fq) const {
#pragma unroll
        for (int ai = 0; ai < 2; ++ai)
#pragma unroll
            for (int m = 0; m < 4; ++m) { const int r = ai * 128 + wr * 64 + m * 16 + fr;
                const float pw = 1.0f;
                float o[8];
#pragma unroll
                for (int n = 0; n < 2; ++n)
#pragma unroll
                    for (int j = 0; j < 4; ++j) { const float x1 = acc[ai][0][m][n][j], x3 = acc[ai][1][m][n][j]; o[4 * n + j] = x1 * sigmoidf_(x1) * x3 * pw; }
                u32x4 w; w.x = cvt_pk_bf16(o[0], o[1]); w.y = cvt_pk_bf16(o[2], o[3]); w.z = cvt_pk_bf16(o[4], o[5]); w.w = cvt_pk_bf16(o[6], o[7]);
                *(u32x4*)(HID + (size_t)(u.pm * 256 + r) * 256 + u.pn * 128 + wc * 32 + 8 * fq) = w; }
    }
};
struct SchedMoe2 {
    static constexpr bool GATHER = false;
    const char* HID; const char* W2; const LAS int* te; int MT, G, c;
    __device__ __forceinline__ bool next(int i, Unit& u) const { const int L = i * G + c; if (L >= 8 * MT) return false; u.pm = L >> 3; u.pn = L & 7; u.aux = __builtin_amdgcn_readfirstlane(te[u.pm]); return true; }
    __device__ __forceinline__ const char* abase(const Unit& u) const { return HID + (size_t)u.pm * 256 * 512; }
    __device__ __forceinline__ const char* bbase(const Unit& u) const { return W2 + ((size_t)u.aux * 2048 + u.pn * 256) * 512; }
    __device__ __forceinline__ unsigned arow(const Unit&, int) const { return 0u; }
    static __device__ __forceinline__ bool keep_acc(const Unit&) { return false; }
};
struct EpiMoe2 {
    static constexpr bool PERM = true;
    bf16* OP;
    __device__ __forceinline__ void operator()(f32x4 (&acc)[2][2][4][2], const Unit& u, int wr, int wc, int fr, int fq) const {
        const int row0 = u.pm * 256 + wr * 64 + fr, col0 = u.pn * 256 + wc * 32 + 8 * fq;
#pragma unroll
        for (int ai = 0; ai < 2; ++ai)
#pragma unroll
            for (int m = 0; m < 4; ++m) { bf16* rowp = OP + (size_t)(row0 + ai * 128 + m * 16) * DM + col0;
#pragma unroll
                for (int bj = 0; bj < 2; ++bj) { const f32x4 v0 = acc[ai][bj][m][0], v1 = acc[ai][bj][m][1];
                    u32x4 w; w.x = cvt_pk_bf16(v0[0], v0[1]); w.y = cvt_pk_bf16(v0[2], v0[3]); w.z = cvt_pk_bf16(v1[0], v1[1]); w.w = cvt_pk_bf16(v1[2], v1[3]);
                    *(u32x4*)(rowp + bj * 128) = w; } }
    }
};

constexpr int N_PHASES = 22;
__global__ void __launch_bounds__(NTHR, 2) fwd_kernel(Args a) {
    extern __shared__ __attribute__((aligned(16))) unsigned char lds_raw[];
    LAS unsigned char* lds0 = (LAS unsigned char*)lds_raw;
    const int tid0 = threadIdx.x, bid0 = blockIdx.x, G0 = gridDim.x;
    const int wave0 = __builtin_amdgcn_readfirstlane(tid0 >> 6);
#define PH_IDS() ArgsP ap = (ArgsP)__builtin_amdgcn_kernarg_segment_ptr(); asm volatile("" : "+s"(ap)); unsigned lb_ = 0u; asm volatile("" : "+s"(lb_)); LAS unsigned char* lds = lds0 + lb_; LAS unsigned char* misc = lds + MISC_OFF; (void)misc; unsigned char* ws = ap->ws; (void)ws; int bid = bid0, G = G0, wave = wave0; asm volatile("" : "+s"(bid), "+s"(G), "+s"(wave)); int tid = wave * 64 + lane_id(); asm volatile("" : "+v"(tid)); const int lane = tid & 63; (void)lane; (void)wave
    if (tid0 < 4) ((LAS unsigned*)(lds0 + MISC_OFF + MO_BAR))[tid0] = 0u;
    __syncthreads();
#if MK_LAUNCHES == 1
    XcdBarrier bar = xcd_barrier_post((unsigned*)(a.ws + WS_CTL) + CW_BAR, (volatile LAS unsigned*)(lds0 + MISC_OFF + MO_BAR));
#define GRID_BAR() xcd_barrier(bar)
#else
#define GRID_BAR() do { } while (0)
#endif
    const int lo = a.ph_lo, hi = a.ph_hi;
#ifndef PHMASK
#define PHMASK 0xFFFu
#endif
#define IN(k) (lo <= (k) && (k) < hi)
#define EN(b) ((PHMASK >> (b)) & 1u)
#ifndef DBLMASK
#define DBLMASK 0u
#endif
#define REP(b) _Pragma("unroll 1") for (int rep_ = 0; rep_ < (((DBLMASK >> (b)) & 1u) ? 2 : 1); ++rep_)
#define SEAM(k) do { if (IN(k) && IN((k) + 1)) { GRID_BAR(); if ((DBLMASK >> 12) & 1u) GRID_BAR(); } } while (0)

    if (EN(0) && IN(0)) { REP(0) { PH_IDS(); prologue_phase(ap, lds, tid, lane, wave, bid, G); __syncthreads(); }
#ifndef NO_NORM0
        { PH_IDS(); norm_phase<0>(ap, 0, lds, tid, lane, wave, bid, G); }
#endif
    }
    SEAM(0);
#pragma unroll 1
    for (int l = 0; l < 2; ++l) {
        const int pb = 1 + 10 * l;
        if (EN(1) && IN(pb + 0) && l == 1) { if ((DBLMASK >> 18) & 1u) { PH_IDS(); norm_phase<1>(ap, l, lds, tid, lane, wave, bid, G, true); } PH_IDS(); norm_phase<1>(ap, l, lds, tid, lane, wave, bid, G); }
        if (l == 1) SEAM(pb + 0);
        if (EN(2) && IN(pb + 1)) REP(2) { PH_IDS(); (void)tid;
#ifdef STAG
            for (int i = 0; i < ((bid >> 3) & 7); ++i) __builtin_amdgcn_s_sleep(STAG);
#endif
            SchedG1 S{(const char*)(ws + WS_H), (const char*)(ws + WS_WINT) + (size_t)l * 11264 * 4096, G, bid};
            EpiG1 E{ws, ((DBLMASK >> 21) & 1u) && rep_ == 1};
            pg8::gemm_phase<EpiG1, SchedG1>(lds, 2048, S, E, wave);
            for (int bh = G - 1 - bid; bh < 16; bh += G) gate_unit(ap, l, lds, bh, tid, tid & 63, wave);
            __syncthreads();
            if (G == 256 && bid >= 256 - SchedG1::NCV) prologue_phase(ap, lds, tid, tid & 63, wave, bid - (256 - SchedG1::NCV), SchedG1::NCV, 2 + l);
            else if (G != 256) prologue_phase(ap, lds, tid, tid & 63, wave, bid, G, 2 + l);
        }
        SEAM(pb + 1);
        if (EN(3) && IN(pb + 2)) REP(3) { PH_IDS(); conv_phase(ap, l, lds, tid, lane, wave, bid, G); }
        SEAM(pb + 2);
        if (EN(4) && IN(pb + 3)) REP(4) { PH_IDS();
            const int vb = (G % 8 == 0) ? (bid & 7) * (G >> 3) + (bid >> 3) : bid;
            REP(13) { if (wave < 4) for (int gw = vb * 4 + wave; gw < 1024; gw += G * 4) mlstm_ab_task(ws, gw, lane, rep_ == 0 || !((DBLMASK >> 15) & 1u)); }
            if (wave == 4) for (int t = vb; t < 64; t += G) nscan_task(ws, t, lane);
            if (l == 0 && wave >= 4) prologue_phase(ap, lds, tid, lane, wave, bid, G, 6, bid * 4 + (wave - 4), G * 4);
            __syncthreads();
            REP(14) { for (int u = vb; u < 512; u += G) { attn_unit(ap, lds, u, tid, lane, wave); __syncthreads(); if (((DBLMASK >> 16) & 1u) && u < 256) GRID_BAR(); } }
        }
        SEAM(pb + 3);
        if (EN(5) && IN(pb + 4)) REP(5) { PH_IDS(); mlstm_c_phase(ap, l, lds, tid, lane, wave, bid, G); }
        SEAM(pb + 4);
        if (EN(6) && IN(pb + 5)) REP(6) { PH_IDS(); (void)tid;
            SchedBr S{(const char*)(ws + WS_HM), (const char*)(ws + WS_HA), (const char*)(ws + WS_WBM) + (size_t)l * 2048 * 2048, (const char*)(ws + WS_WBA) + (size_t)l * 2048 * 2048, G, bid};
            EpiBr E{(const bf16*)(ws + WS_SG), (bf16*)(ws + WS_Y)};
            pg8::gemm_phase<EpiBr, SchedBr>(lds, 1024, S, E, wave);
        }
        SEAM(pb + 5);
        if (EN(7) && IN(pb + 6)) _Pragma("unroll 1") for (int rep_ = 0; rep_ < ((((DBLMASK >> 7) & 1u) && l == 0) ? 2 : 1); ++rep_) { PH_IDS(); (void)tid;
            SchedStd S{(const char*)(ws + WS_Y), (const char*)(ws + WS_WOUT) + (size_t)l * 2048 * 4096, 32, 8, 2048, G, bid};
            EpiOut E{l == 0 ? ap->in[I_X] : (const float*)ap->out, ap->out};
            pg8::gemm_phase<EpiOut, SchedStd>(lds, 2048, S, E, wave);
        }
        SEAM(pb + 6);
        if (EN(8) && IN(pb + 7)) { if ((DBLMASK >> 19) & 1u) { PH_IDS(); norm_phase<2>(ap, l, lds, tid, lane, wave, bid, G, true); } PH_IDS(); norm_phase<2>(ap, l, lds, tid, lane, wave, bid, G); }
        SEAM(pb + 7);
        if (EN(9) && IN(pb + 8)) REP(9) { PH_IDS();
            moe_tables(ws, l, misc, tid);
            SchedMoe1 S{(const char*)(ws + WS_H), (const char*)(ws + WS_W13) + (size_t)l * 32 * 512 * 4096, (const int*)(ws + MS_LIST),
                        (const LAS int*)(misc + MO_TE), (const LAS int*)(misc + MO_TR0), (const LAS int*)(misc + MO_CNT), __builtin_amdgcn_readfirstlane(((const LAS int*)(misc + MO_MT))[0]), G, bid};
            EpiMoe1 E{(bf16*)(ws + WS_HID), (const float*)(ws + MS_PWL), (const LAS int*)(misc + MO_TR0), (const LAS int*)(misc + MO_CNT)};
            pg8::gemm_phase<EpiMoe1, SchedMoe1>(lds, 2048, S, E, wave);
            if (bid >= 2 * S.MT) prologue_phase(ap, lds, tid, tid & 63, wave, bid - 2 * S.MT, G - 2 * S.MT, l == 0 ? 1 : 4);
        }
        SEAM(pb + 8);
        if (EN(10) && IN(pb + 9)) REP(10) { PH_IDS();
            moe_tables(ws, l, misc, tid);
#ifdef STAG
            for (int i = 0; i < ((bid >> 3) & 7); ++i) __builtin_amdgcn_s_sleep(STAG);
#endif
            SchedMoe2 S{(const char*)(ws + WS_HID), (const char*)(ws + WS_W2) + (size_t)l * 32 * 2048 * 512, (const LAS int*)(misc + MO_TE), __builtin_amdgcn_readfirstlane(((const LAS int*)(misc + MO_MT))[0]), G, bid};
            EpiMoe2 E{(bf16*)(ws + WS_OP)};
            pg8::gemm_phase<EpiMoe2, SchedMoe2>(lds, 256, S, E, wave);
        }
        SEAM(pb + 9);
    }
    if (EN(11) && IN(21)) { if ((DBLMASK >> 20) & 1u) { PH_IDS(); norm_phase<3>(ap, 1, lds, tid, lane, wave, bid, G, true); } PH_IDS(); norm_phase<3>(ap, 1, lds, tid, lane, wave, bid, G); }
#undef IN
#undef SEAM
}

extern "C" void kernel_launch(void* const* d_in, const int* in_sizes, int n_in, void* d_out, int out_size, void* d_ws, size_t ws_size, hipStream_t stream) {
    static int grid = 0;
    if (grid == 0) {
        if (n_in != 19 || out_size != NTOK * DM || ws_size < WS_END) { fprintf(stderr, "kernel_launch: unexpected shapes (n_in %d out %d ws %zu)\n", n_in, out_size, ws_size); grid = -1; return; }
        int dev = 0, cus = 0, per_cu = 0;
        if (hipGetDevice(&dev) != hipSuccess || hipDeviceGetAttribute(&cus, hipDeviceAttributeMultiprocessorCount, dev) != hipSuccess) { grid = -1; return; }
        if (hipFuncSetAttribute((const void*)fwd_kernel, hipFuncAttributeMaxDynamicSharedMemorySize, LDS_BYTES) != hipSuccess) { fprintf(stderr, "kernel_launch: hipFuncSetAttribute failed\n"); grid = -1; return; }
        if (hipOccupancyMaxActiveBlocksPerMultiprocessor(&per_cu, (const void*)fwd_kernel, NTHR, LDS_BYTES) != hipSuccess || per_cu < 1) { fprintf(stderr, "kernel_launch: occupancy query says %d\n", per_cu); }
        (void)hipGetLastError();
        grid = cus;
        if (grid > 256) grid = 256;
    }
    if (grid < 0) return;
    if (hipMemsetAsync((char*)d_ws + WS_CTL, 0, CTL_ZERO_BYTES, stream) != hipSuccess) return;
    Args a{};
    for (int i = 0; i < 19; ++i) a.in[i] = (const float*)d_in[i];
    a.out = (float*)d_out; a.ws = (unsigned char*)d_ws;
#if MK_LAUNCHES == 1
    a.ph_lo = 0; a.ph_hi = N_PHASES;
    hipLaunchKernelGGL(fwd_kernel, dim3(grid), dim3(NTHR), LDS_BYTES, stream, a);
#else
    for (int p = 0; p < N_PHASES; ++p) { a.ph_lo = p; a.ph_hi = p + 1; hipLaunchKernelGGL(fwd_kernel, dim3(grid), dim3(NTHR), LDS_BYTES, stream, a); }
#endif
}
```

```cpp
#define DBLMASK 0u
#include <hip/hip_runtime.h>
#include <stdint.h>
#include <stdio.h>

#ifndef MK_LAUNCHES
#define MK_LAUNCHES 1
#endif

#define GAS __attribute__((address_space(1)))
#define LAS __attribute__((address_space(3)))
typedef unsigned short bf16;
typedef short bf16x8 __attribute__((ext_vector_type(8)));
typedef short bf16x4 __attribute__((ext_vector_type(4)));
typedef float f32x4 __attribute__((ext_vector_type(4)));
typedef int i32x4 __attribute__((ext_vector_type(4)));
typedef int i32x8 __attribute__((ext_vector_type(8)));
typedef unsigned u32x4 __attribute__((ext_vector_type(4)));
typedef unsigned u32x2 __attribute__((ext_vector_type(2)));

constexpr int NTOK = 8192, DM = 2048, SEQ = 2048, NBATCH = 4;
constexpr int INCOLS = 11272;
constexpr int NWAVES = 8, NTHR = 512;
constexpr float RMS_EPS = 1e-6f, LN_EPS = 1e-5f;
constexpr int MPAD = 24576;

constexpr size_t MiB = 1u << 20;
constexpr size_t WS_CTL = 0, CTL_ZERO_BYTES = 64 * 1024;
constexpr size_t WS_MISC = 1 * MiB;
constexpr size_t MS_WIF = WS_MISC + 0;
constexpr size_t MS_WRT = WS_MISC + 256 * 1024;
constexpr size_t MS_IFG = WS_MISC + 1 * MiB;
constexpr size_t MS_KMEAN = MS_IFG + 256 * 1024;
constexpr size_t MS_AS = WS_MISC + 1536 * 1024;
constexpr size_t MS_GT = MS_AS + 128 * 1024;
constexpr size_t MS_WI = MS_GT + 128 * 1024;
constexpr size_t MS_CL = MS_WI + 128 * 1024;
constexpr size_t MS_WS = MS_CL + 128 * 1024;
constexpr size_t MS_DEC = MS_WS + 128 * 1024;
constexpr size_t MS_NST = WS_MISC + 2560 * 1024;
constexpr size_t MS_TOKE = WS_MISC + 3 * MiB;
constexpr size_t MS_TOKP = MS_TOKE + 64 * 1024;
constexpr size_t MS_TOKW = MS_TOKE + 128 * 1024;
constexpr size_t MS_LIST = WS_MISC + 4 * MiB;
constexpr size_t MS_PWL = WS_MISC + 5 * MiB;
constexpr size_t MS_NVEC = WS_MISC + 6 * MiB;
constexpr size_t WS_WINT = 16 * MiB;
constexpr size_t WS_WBM = 104 * MiB;
constexpr size_t WS_WBA = 112 * MiB;
constexpr size_t WS_WOUT = 120 * MiB;
constexpr size_t WS_W13 = 136 * MiB;
constexpr size_t WS_W2 = 264 * MiB;
constexpr size_t WS_H = 328 * MiB;
constexpr size_t WS_R = 360 * MiB;
constexpr size_t WS_ZQK = WS_R;
constexpr size_t WS_HM = WS_R, WS_HA = WS_R + 16 * MiB;
constexpr size_t WS_VMT = WS_R + 32 * MiB;
constexpr size_t WS_OM = WS_R + 48 * MiB;
constexpr size_t WS_QA = WS_R + 64 * MiB, WS_KA = WS_R + 80 * MiB;
constexpr size_t WS_Y = WS_QA;
constexpr size_t WS_VAT = WS_R + 96 * MiB;
constexpr size_t WS_SG = WS_R + 112 * MiB;
constexpr size_t WS_QM = WS_R + 176 * MiB, WS_KM = WS_R + 192 * MiB, WS_KMT = WS_R + 208 * MiB;
constexpr size_t WS_CST = WS_R + 224 * MiB;
constexpr size_t WS_HID = WS_R;
constexpr size_t WS_OP = WS_R + 16 * MiB;
constexpr size_t WS_END = 648 * MiB;
constexpr int CW_BAR = 4096;
constexpr int CW_CNT = 8192;

constexpr int RING_BYTES = 131072;
constexpr int MISC_OFF = 139264;
constexpr int LDS_BYTES = 147456;
constexpr int MO_BAR = 0, MO_CNT = 64, MO_NT = 64 + 128, MO_OFF = 64 + 256, MO_TE = 64 + 512, MO_TR0 = 64 + 1024, MO_MT = 64 + 1536, MO_LOG = 2048;

#define LDS_WAIT() asm volatile("s_waitcnt lgkmcnt(0)" ::: "memory")
#define VM_WAIT() asm volatile("s_waitcnt vmcnt(0)" ::: "memory")

__device__ __forceinline__ float bf2f(unsigned short b) { return __builtin_bit_cast(float, (unsigned)b << 16); }
__device__ __forceinline__ float bflo(unsigned u) { return __builtin_bit_cast(float, u << 16); }
__device__ __forceinline__ float bfhi(unsigned u) { return __builtin_bit_cast(float, u & 0xffff0000u); }
typedef __bf16 bf16x2v __attribute__((ext_vector_type(2)));
typedef float f32x2v __attribute__((ext_vector_type(2)));
typedef float f32x2 __attribute__((ext_vector_type(2)));
__device__ __forceinline__ unsigned cvt_pk_bf16(float lo, float hi) { const f32x2v f = {lo, hi}; const bf16x2v b = __builtin_convertvector(f, bf16x2v); return __builtin_bit_cast(unsigned, b); }
__device__ __forceinline__ int lane_id_l() { int l; asm volatile("v_mbcnt_lo_u32_b32 %0, -1, 0\n\tv_mbcnt_hi_u32_b32 %0, -1, %0" : "=v"(l)); return l; }
__device__ __forceinline__ float shx(float v, int o) { return __builtin_bit_cast(float, __builtin_amdgcn_ds_bpermute((lane_id_l() ^ o) << 2, __builtin_bit_cast(int, v))); }
__device__ __forceinline__ int shx(int v, int o) { return __builtin_amdgcn_ds_bpermute((lane_id_l() ^ o) << 2, v); }
__device__ __forceinline__ float shu(float v, int o) { const int l = lane_id_l(); return __builtin_bit_cast(float, __builtin_amdgcn_ds_bpermute((l >= o ? l - o : l) << 2, __builtin_bit_cast(int, v))); }
__device__ __forceinline__ int shu(int v, int o) { const int l = lane_id_l(); return __builtin_amdgcn_ds_bpermute((l >= o ? l - o : l) << 2, v); }
__device__ __forceinline__ float wave_sum(float v) {
#pragma unroll
    for (int o = 1; o < 64; o <<= 1) v += shx(v, o);
    return v;
}
__device__ __forceinline__ void wave_sum8(float (&a)[8], int lane) {
    { const bool hi = (lane & 32) != 0;
#pragma unroll
      for (int i = 0; i < 4; ++i) { const float snd = hi ? a[i] : a[i + 4], kp = hi ? a[i + 4] : a[i]; a[i] = kp + shx(snd, 32); } }
    { const bool hi = (lane & 16) != 0;
#pragma unroll
      for (int i = 0; i < 2; ++i) { const float snd = hi ? a[i] : a[i + 2], kp = hi ? a[i + 2] : a[i]; a[i] = kp + shx(snd, 16); } }
    { const bool hi = (lane & 8) != 0; const float snd = hi ? a[0] : a[1], kp = hi ? a[1] : a[0]; a[0] = kp + shx(snd, 8); }
    float f = a[0]; f += shx(f, 4); f += shx(f, 2); f += shx(f, 1);
    const int fi = __builtin_bit_cast(int, f);
#pragma unroll
    for (int i = 0; i < 8; ++i) a[i] = __builtin_bit_cast(float, __builtin_amdgcn_readlane(fi, (i >> 2) * 32 + ((i >> 1) & 1) * 16 + (i & 1) * 8));
}
__device__ __forceinline__ unsigned pk4_fp8(float a, float b, float c, float d) { int p = __builtin_amdgcn_cvt_pk_fp8_f32(a, b, 0, false); p = __builtin_amdgcn_cvt_pk_fp8_f32(c, d, p, true); return (unsigned)p; }
__device__ __forceinline__ float rows4_max(float x) { x = fmaxf(x, shx(x, 16)); return fmaxf(x, shx(x, 32)); }
__device__ __forceinline__ float rows4_sum(float x) { x += shx(x, 16); return x + shx(x, 32); }
__device__ __forceinline__ int lane_id() { int l; asm volatile("v_mbcnt_lo_u32_b32 %0, -1, 0\n\tv_mbcnt_hi_u32_b32 %0, -1, %0" : "=v"(l)); return l; }
__device__ __forceinline__ float sigmoidf_(float x) { return __builtin_amdgcn_rcpf(1.f + __expf(-x)); }

namespace pg8 {
constexpr int BM = 256, BK = 64, HALF = 128, HTB = HALF * BK * 2, STAGE_BYTES = 8 * HTB, NXCD = 8, WGM = 8;
__device__ __forceinline__ int lds_byte(int r, int c) { const int st = (r >> 4) * 2 + (c >> 5), rr = r & 15, cc = c & 31, ob = rr * 64 + cc * 2; return st * 1024 + (ob ^ (((ob >> 9) & 1) << 5)); }
__device__ __forceinline__ void stage_rc(int b, int& R, int& C) { const int st = b / 1024, sb = b % 1024, swz = sb ^ (((sb >> 9) & 1) << 5); R = (st >> 1) * 16 + swz / 64; C = (st & 1) * 32 + (swz % 64) / 2; }
__device__ __forceinline__ int perm32(int rho) { const int n = rho >> 4, i = rho & 15; return 8 * (i >> 2) + 4 * n + (i & 3); }
struct Unit { int pm, pn, aux; };

__device__ __forceinline__ void static_tile(int L, int nM, int nN, int& pm, int& pn, const int WGM = 8) {
    const int nwg = nM * nN; int wgid = L;
    { const int q = nwg / NXCD, r = nwg % NXCD, xcd = wgid % NXCD, off = wgid / NXCD; wgid = (xcd < r ? xcd * (q + 1) : r * (q + 1) + (xcd - r) * q) + off; }
    const int nig = WGM * nN, gid = wgid / nig, fm = gid * WGM, gsz = (nM - fm) < WGM ? (nM - fm) : WGM;
    pm = fm + ((wgid % nig) % gsz); pn = (wgid % nig) / gsz;
}

template <class Epi, class Sched>
__device__ __forceinline__ void gemm_phase(LAS unsigned char* lds, const int K, const Sched& S, const Epi& E, const int wave0) {
    int tid_ = wave0 * 64 + lane_id(); asm volatile("" : "+v"(tid_));
    const int tid = tid_, wid = __builtin_amdgcn_readfirstlane(tid >> 6), lane = tid & 63, wr = wid >> 2, wc = wid & 3, fr = lane & 15, fq = lane >> 4;
    const int nt = K / BK;
    int RA[2], CA[2]; unsigned voffB[2];
#pragma unroll
    for (int i = 0; i < 2; ++i) { int R, C; stage_rc(tid * 16 + i * 8192, R, C); const int Rb = Epi::PERM ? ((R & ~31) + perm32(R & 31)) : R;
        RA[i] = R; CA[i] = C; voffB[i] = (unsigned)(Rb * K + C) * 2u; }
    const size_t kstep = (size_t)(BK * 2);
    const size_t hstep = (size_t)HALF * K * 2, qstep = (size_t)64 * K * 2;
    const unsigned ldsw = (unsigned)wid * 1024u;
    const int aoff = lds_byte(wr * 64 + fr, fq * 8), boff = lds_byte(wc * 32 + fr, fq * 8);
#define PG8_SA(b, h) (((b) * 2 + (h)) * HTB)
#define PG8_SB(b, h) ((4 + (b) * 2 + (h)) * HTB)
#define PG8_STAGE(bufoff, gbase, v0, v1) do { \
        __builtin_amdgcn_global_load_lds((const unsigned*)((const char*)(gbase) + (v0)), (LAS unsigned*)(lds + (bufoff) + ldsw), 16, 0, 0); \
        __builtin_amdgcn_global_load_lds((const unsigned*)((const char*)(gbase) + (v1)), (LAS unsigned*)(lds + (bufoff) + ldsw + 8192), 16, 0, 0); } while (0)
#define PG8_STAGE1(bufoff, gbase, v0) do {   \
        __builtin_amdgcn_global_load_lds((const unsigned*)((const char*)(gbase) + (v0)), (LAS unsigned*)(lds + (bufoff) + ldsw), 16, 0, 0); \
        __builtin_amdgcn_global_load_lds((const unsigned*)((const char*)(gbase) + qstep + (v0)), (LAS unsigned*)(lds + (bufoff) + ldsw + 8192), 16, 0, 0); } while (0)
#define PG8_STAGE_B(bufoff, gbase) PG8_STAGE1(bufoff, gbase, voffB[0])
#define PG8_STAGE_A(bufoff, gbase, VO, h) do { if constexpr (Sched::GATHER) { PG8_STAGE(bufoff, gbase, VO[h][0], VO[h][1]); } else { PG8_STAGE1(bufoff, (const char*)(gbase) + (h) * hstep, vc[0][0]); } } while (0)
#define PG8_STAGE_A2(bufoff, gbase, h) do { if (Sched::GATHER && last) { PG8_STAGE_A(bufoff, gbase, vn, h); } else { PG8_STAGE_A(bufoff, gbase, vc, h); } } while (0)
#define PG8_LDA(dst, b, h) do { _Pragma("unroll") for (int m = 0; m < 4; ++m) { if constexpr (Sched::FP8) { \
            dst##8[m].lo = *(const LAS i32x4*)(lds + PG8_SA(b, h) + aoff + m * 2048); dst##8[m].hi = *(const LAS i32x4*)(lds + PG8_SA(b, h) + aoff + m * 2048 + 1024); } \
        else { _Pragma("unroll") for (int k = 0; k < 2; ++k) dst[m][k] = *(const LAS bf16x8*)(lds + PG8_SA(b, h) + aoff + m * 2048 + k * 1024); } } } while (0)
#define PG8_LDB(dst, b, h) do { _Pragma("unroll") for (int n = 0; n < 2; ++n) { if constexpr (Sched::FP8) { \
            dst##8[n].lo = *(const LAS i32x4*)(lds + PG8_SB(b, h) + boff + n * 2048); dst##8[n].hi = *(const LAS i32x4*)(lds + PG8_SB(b, h) + boff + n * 2048 + 1024); } \
        else { _Pragma("unroll") for (int k = 0; k < 2; ++k) dst[n][k] = *(const LAS bf16x8*)(lds + PG8_SB(b, h) + boff + n * 2048 + k * 1024); } } } while (0)
#define PG8_MMA(ai, bj, At, Bt) do { __builtin_amdgcn_s_setprio(1); _Pragma("unroll") for (int m = 0; m < 4; ++m) _Pragma("unroll") for (int n = 0; n < 2; ++n) { \
        if constexpr (Sched::FP8) {   \
            acc[ai][bj][m][n] = __builtin_amdgcn_mfma_scale_f32_16x16x128_f8f6f4(Bt##8[n], At##8[m], acc[ai][bj][m][n], 0, 0, 0, 121, 0, 127); \
        } else { _Pragma("unroll") for (int k = 0; k < 2; ++k) acc[ai][bj][m][n] = __builtin_amdgcn_mfma_f32_16x16x32_bf16(Bt[n][k], At[m][k], acc[ai][bj][m][n], 0, 0, 0); } } \
        __builtin_amdgcn_s_setprio(0); } while (0)
#define PG8_WAIT_V(n) asm volatile("s_waitcnt vmcnt(" #n ")" ::: "memory")
#define PG8_WAIT_L(n) asm volatile("s_waitcnt lgkmcnt(" #n ")" ::: "memory")
#define PG8_BAR __builtin_amdgcn_s_barrier()
#define PG8_SCHED __builtin_amdgcn_sched_barrier(0)
    Unit cur, nxt; int ui = 0;
    if (!S.next(0, cur)) return;
    f32x4 acc[2][2][4][2];
#pragma unroll
    for (int a = 0; a < 2; ++a)
#pragma unroll
        for (int b = 0; b < 2; ++b)
#pragma unroll
            for (int m = 0; m < 4; ++m)
#pragma unroll
                for (int n = 0; n < 2; ++n) { float z; asm volatile("v_mov_b32 %0, 0" : "=v"(z)); acc[a][b][m][n] = (f32x4){z, z, z, z}; }
    bf16x8 At[4][2], B0[2][2], B1[2][2]; i32x8 At8[2], B08[2], B18[2];
    unsigned vc[2][2], vn[2][2];
#pragma unroll
    for (int h = 0; h < 2; ++h)
#pragma unroll
        for (int i = 0; i < 2; ++i) {
            if constexpr (Sched::GATHER) vc[h][i] = (unsigned)(S.arow(cur, h * HALF + RA[i]) * (unsigned)K + (unsigned)CA[i]) * 2u;
            else vc[h][i] = (unsigned)((h * HALF + RA[i]) * K + CA[i]) * 2u;
            vn[h][i] = vc[h][i];
        }
    const char* cA = S.abase(cur); const char* cB = S.bbase(cur);
    PG8_STAGE_B(PG8_SB(0, 0), cB); PG8_STAGE_A(PG8_SA(0, 0), cA, vc, 0); PG8_STAGE_B(PG8_SB(0, 1), cB + hstep); PG8_STAGE_A(PG8_SA(0, 1), cA, vc, 1);
    if (wr == 1) PG8_BAR;
    if constexpr (Sched::FP8) PG8_WAIT_V(0); else PG8_WAIT_V(4);
    PG8_BAR;
    PG8_STAGE_B(PG8_SB(1, 0), cB + kstep); PG8_STAGE_A(PG8_SA(1, 0), cA + kstep, vc, 0); PG8_STAGE_B(PG8_SB(1, 1), cB + hstep + kstep);
    PG8_WAIT_V(6); PG8_BAR;
    for (;;) {
        const bool has_next = S.next(ui + 1, nxt);
        const char* nA = has_next ? S.abase(nxt) : cA; const char* nB = has_next ? S.bbase(nxt) : cB;
        if constexpr (Sched::GATHER) {
            if (has_next) {
                int t2 = wave0 * 64 + lane_id(); asm volatile("" : "+v"(t2));
#pragma unroll
                for (int i = 0; i < 2; ++i) { int R, C; stage_rc(t2 * 16 + i * 8192, R, C);
#pragma unroll
                    for (int h = 0; h < 2; ++h) vn[h][i] = (unsigned)(S.arow(nxt, h * HALF + R) * (unsigned)K + (unsigned)C) * 2u; }
            }
        }
#pragma unroll 1
        for (int t = 0; t < nt; t += 2) {
            const bool last = (t == nt - 2);
            const char* a1 = cA + (size_t)(t + 1) * kstep;
            const char* a2 = last ? nA : cA + (size_t)(t + 2) * kstep; const char* b2 = last ? nB : cB + (size_t)(t + 2) * kstep;
            const char* a3 = a2 + kstep; const char* b3 = b2 + kstep;
            if constexpr (Sched::FP8) {
#define PG8_LDA2(b, h, mb) do { _Pragma("unroll") for (int mm = 0; mm < 2; ++mm) { \
                At8[mm].lo = *(const LAS i32x4*)(lds + PG8_SA(b, h) + aoff + ((mb) + mm) * 2048); At8[mm].hi = *(const LAS i32x4*)(lds + PG8_SA(b, h) + aoff + ((mb) + mm) * 2048 + 1024); } } while (0)
#define PG8_MMA2(ai, mb) do { __builtin_amdgcn_s_setprio(1); _Pragma("unroll") for (int mm = 0; mm < 2; ++mm) _Pragma("unroll") for (int n = 0; n < 2; ++n) { \
                acc[ai][0][(mb) + mm][n] = __builtin_amdgcn_mfma_scale_f32_16x16x128_f8f6f4(B08[n], At8[mm], acc[ai][0][(mb) + mm][n], 0, 0, 0, 121, 0, 127); \
                acc[ai][1][(mb) + mm][n] = __builtin_amdgcn_mfma_scale_f32_16x16x128_f8f6f4(B18[n], At8[mm], acc[ai][1][(mb) + mm][n], 0, 0, 0, 121, 0, 127); } \
                __builtin_amdgcn_s_setprio(0); } while (0)
            PG8_LDB(B0, 0, 0); PG8_SCHED; PG8_LDB(B1, 0, 1); PG8_LDA2(0, 0, 0); PG8_STAGE_A(PG8_SA(1, 1), a1, vc, 1);
            PG8_WAIT_L(8); PG8_BAR; PG8_WAIT_L(0); PG8_MMA2(0, 0); PG8_BAR; PG8_SCHED;
            PG8_LDA2(0, 0, 2); PG8_STAGE_B(PG8_SB(0, 0), b2);
            PG8_WAIT_L(0); PG8_BAR; PG8_MMA2(0, 2); PG8_BAR;
            PG8_LDA2(0, 1, 0); PG8_STAGE_A2(PG8_SA(0, 0), a2, 0);
            PG8_BAR; PG8_WAIT_L(0); PG8_MMA2(1, 0); PG8_BAR; PG8_SCHED;
            PG8_LDA2(0, 1, 2); PG8_STAGE_B(PG8_SB(0, 1), b2 + hstep);
            PG8_WAIT_V(6); PG8_WAIT_L(0); PG8_BAR; PG8_MMA2(1, 2); PG8_BAR;
            PG8_LDB(B0, 1, 0); PG8_SCHED; PG8_LDB(B1, 1, 1); PG8_LDA2(1, 0, 0); PG8_STAGE_A2(PG8_SA(0, 1), a2, 1);
            PG8_WAIT_L(8); PG8_BAR; PG8_WAIT_L(0); PG8_MMA2(0, 0); PG8_BAR; PG8_SCHED;
            PG8_LDA2(1, 0, 2); PG8_STAGE_B(PG8_SB(1, 0), b3);
            PG8_WAIT_L(0); PG8_BAR; PG8_MMA2(0, 2); PG8_BAR;
            PG8_LDA2(1, 1, 0); PG8_STAGE_A2(PG8_SA(1, 0), a3, 0);
            PG8_BAR; PG8_WAIT_L(0); PG8_MMA2(1, 0); PG8_BAR; PG8_SCHED;
            PG8_LDA2(1, 1, 2); PG8_STAGE_B(PG8_SB(1, 1), b3 + hstep);
            PG8_WAIT_V(6); PG8_WAIT_L(0); PG8_BAR; PG8_MMA2(1, 2); PG8_BAR;
#undef PG8_LDA2
#undef PG8_MMA2
            } else {
            PG8_LDB(B0, 0, 0); PG8_SCHED; PG8_LDA(At, 0, 0); PG8_STAGE_A(PG8_SA(1, 1), a1, vc, 1);
            PG8_WAIT_L(8); PG8_BAR; PG8_WAIT_L(0); PG8_MMA(0, 0, At, B0); PG8_BAR; PG8_SCHED;
            PG8_LDB(B1, 0, 1); PG8_STAGE_B(PG8_SB(0, 0), b2);
            PG8_BAR; PG8_WAIT_L(0); PG8_MMA(0, 1, At, B1); PG8_BAR;
            PG8_LDA(At, 0, 1); PG8_STAGE_A2(PG8_SA(0, 0), a2, 0);
            PG8_BAR; PG8_WAIT_L(0); PG8_MMA(1, 0, At, B0); PG8_BAR; PG8_SCHED;
            PG8_STAGE_B(PG8_SB(0, 1), b2 + hstep);
            PG8_WAIT_V(6); PG8_BAR; PG8_MMA(1, 1, At, B1); PG8_BAR;
            PG8_LDB(B0, 1, 0); PG8_SCHED; PG8_LDA(At, 1, 0); PG8_STAGE_A2(PG8_SA(0, 1), a2, 1);
            PG8_WAIT_L(8); PG8_BAR; PG8_WAIT_L(0); PG8_MMA(0, 0, At, B0); PG8_BAR; PG8_SCHED;
            PG8_LDB(B1, 1, 1); PG8_STAGE_B(PG8_SB(1, 0), b3);
            PG8_BAR; PG8_WAIT_L(0); PG8_MMA(0, 1, At, B1); PG8_BAR;
            PG8_LDA(At, 1, 1); PG8_STAGE_A2(PG8_SA(1, 0), a3, 0);
            PG8_BAR; PG8_WAIT_L(0); PG8_MMA(1, 0, At, B0); PG8_BAR; PG8_SCHED;
            PG8_STAGE_B(PG8_SB(1, 1), b3 + hstep);
            PG8_WAIT_V(6); PG8_BAR; PG8_MMA(1, 1, At, B1); PG8_BAR;
            }
        }
        { const int lz = lane_id(); E(acc, cur, wr, wc, lz & 15, lz >> 4); }
        if (!has_next) break;
        if (!Sched::keep_acc(cur)) {
#pragma unroll
        for (int a = 0; a < 2; ++a)
#pragma unroll
            for (int b = 0; b < 2; ++b)
#pragma unroll
                for (int m = 0; m < 4; ++m)
#pragma unroll
                    for (int n = 0; n < 2; ++n) { float z; asm volatile("v_mov_b32 %0, 0" : "=v"(z)); acc[a][b][m][n] = (f32x4){z, z, z, z}; }
        }
        cur = nxt; cA = nA; cB = nB; ++ui;
        if constexpr (Sched::GATHER) {
#pragma unroll
            for (int h = 0; h < 2; ++h)
#pragma unroll
                for (int i = 0; i < 2; ++i) vc[h][i] = vn[h][i];
        }
    }
    PG8_WAIT_V(0);
    if (wr == 0) PG8_BAR;
    PG8_BAR;
#undef PG8_SA
#undef PG8_SB
#undef PG8_STAGE
#undef PG8_STAGE_A
#undef PG8_STAGE_A2
#undef PG8_STAGE_B
#undef PG8_LDA
#undef PG8_LDB
#undef PG8_MMA
#undef PG8_WAIT_V
#undef PG8_WAIT_L
#undef PG8_BAR
#undef PG8_SCHED
}
}
using pg8::Unit;

#define XB_TMO      128
#define XB_XCNT(j)  (256  + 64 * (j))
#define XB_XSUB(j)  (1280 + 64 * (j))
#define XB_XGEN(j)  (2304 + 64 * (j))
#define XB_TOP      3328
#define XB_TOPGEN   3392
#define XCD_BAR_WORDS 3456
#define XB_SPIN_CAP (1u << 18)
__device__ __forceinline__ unsigned xb_ld(unsigned* p)              { return __hip_atomic_load(p, __ATOMIC_RELAXED, __HIP_MEMORY_SCOPE_AGENT); }
__device__ __forceinline__ unsigned xb_add(unsigned* p, unsigned v) { return __hip_atomic_fetch_add(p, v, __ATOMIC_RELAXED, __HIP_MEMORY_SCOPE_AGENT); }
__device__ __forceinline__ unsigned xb_xcc_id() { return (unsigned)__builtin_amdgcn_s_getreg((3 << 11) | 20) & 0xFu; }
#define XB_SPIN(cond, bar) do { unsigned _sp = 0; while (cond) { __builtin_amdgcn_s_sleep(1); \
    if ((++_sp & 255u) == 0u) { if (xb_ld(&(bar)[XB_TMO])) break; if (_sp > XB_SPIN_CAP) { atomicAdd(&(bar)[XB_TMO], 1u); break; } } } } while (0)
struct XcdBarrier { unsigned* bar; unsigned x; volatile LAS unsigned* st; };
__device__ __forceinline__ XcdBarrier xcd_barrier_post(unsigned* bar, volatile LAS unsigned* st) {
    XcdBarrier b; b.bar = bar; b.x = xb_xcc_id(); b.st = st;
    if (threadIdx.x == 0) (void)xb_add(&bar[XB_XCNT(b.x)], 1u);
    return b;
}
__device__ __forceinline__ void xcd_barrier_complete(unsigned* bar, unsigned x, unsigned& nloc, unsigned& nx) {
    const unsigned G = gridDim.x * gridDim.y * gridDim.z;
    unsigned sum, cnt, mine, sp = 0u;
    for (;;) {
        sum = 0u; cnt = 0u; mine = 0u;
#pragma unroll
        for (unsigned j = 0; j < 16; ++j) { const unsigned c = xb_ld(&bar[XB_XCNT(j)]); sum += c; cnt += (c > 0u) ? 1u : 0u; mine = (j == x) ? c : mine; }
        if (sum == G) break;
        __builtin_amdgcn_s_sleep(1);
        if ((++sp & 255u) == 0u) { if (xb_ld(&bar[XB_TMO])) break; if (sp > XB_SPIN_CAP) { atomicAdd(&bar[XB_TMO], 1u); break; } }
    }
    nloc = mine > 0u ? mine : 1u; nx = cnt > 0u ? cnt : 1u;
}
__device__ __forceinline__ void xcd_barrier(const XcdBarrier& b) {
    asm volatile("s_waitcnt vmcnt(0)" ::: "memory");
    __syncthreads();
    if (threadIdx.x == 0) {
        unsigned* bar = b.bar;
        __builtin_amdgcn_s_waitcnt(0);
        unsigned nloc = b.st[0], nx = b.st[1];
        if (nloc == 0u) { xcd_barrier_complete(bar, b.x, nloc, nx); b.st[0] = nloc; b.st[1] = nx; }
        const unsigned old = xb_add(&bar[XB_XSUB(b.x)], 1u);
        const unsigned gen = old / nloc;
        if (old + 1u == (gen + 1u) * nloc) {
            __builtin_amdgcn_fence(__ATOMIC_RELEASE, "agent");
            asm volatile("s_waitcnt vmcnt(0)" ::: "memory");
            const unsigned og = xb_add(&bar[XB_TOP], 1u);
            const unsigned tg = og / nx;
            if (og + 1u == (tg + 1u) * nx) xb_add(&bar[XB_TOPGEN], 1u);
            else XB_SPIN(xb_ld(&bar[XB_TOPGEN]) == tg, bar);
            __builtin_amdgcn_fence(__ATOMIC_ACQUIRE, "agent");
            xb_add(&bar[XB_XGEN(b.x)], 1u);
            asm volatile("s_waitcnt vmcnt(0)" ::: "memory");
        } else {
            XB_SPIN(xb_ld(&bar[XB_XGEN(b.x)]) == gen, bar);
            __builtin_amdgcn_fence(__ATOMIC_ACQUIRE, "agent");
            asm volatile("s_waitcnt vmcnt(0)" ::: "memory");
        }
    }
    __syncthreads();
}

struct Args { const float* in[19]; float* out; unsigned char* ws; int ph_lo, ph_hi; };
typedef const __attribute__((address_space(4))) Args* ArgsP;
enum { I_X = 0, I_N1G, I_WIN, I_CONVW, I_IFB, I_MNG, I_WBM, I_WBA, I_WOUT, I_RELB, I_N2G, I_WGRP, I_BGRP, I_WEXP, I_BEXP, I_W1, I_W3, I_W2, I_FG };


struct TrDesc { const float* W; bf16* WT; size_t ldn, ldk; int k0, n0, r0, q8; };
__device__ __forceinline__ void tr_load(const TrDesc& d, f32x4 (&tv)[16], int lane) {
    const int nn4 = (lane & 15) * 4, kr = lane >> 4;
#pragma unroll
    for (int i = 0; i < 16; ++i) tv[i] = __builtin_nontemporal_load((const f32x4*)(d.W + (size_t)(d.k0 + 4 * i + kr) * d.ldn + d.n0 + nn4));
}
__device__ __forceinline__ void tr_finish(const TrDesc& d, f32x4 (&tv)[16], LAS float* scr, int lane) {
    const int nn4 = (lane & 15) * 4, kr = lane >> 4;
#pragma unroll
    for (int i = 0; i < 16; i += 4) asm volatile("" : "+v"(tv[i]), "+v"(tv[i + 1]), "+v"(tv[i + 2]), "+v"(tv[i + 3]));
#pragma unroll
    for (int i = 0; i < 16; ++i) { const int kk = 4 * i + kr; const f32x4 v = tv[i];
        LAS float* q = scr + kk * 65 + nn4; q[0] = v.x; q[1] = v.y; q[2] = v.z; q[3] = v.w; }
    LDS_WAIT();
    const int kc = (lane & 7) * 8;
#pragma unroll
    for (int p = 0; p < 8; ++p) { const int nn = 8 * p + (lane >> 3); const LAS float* sp = scr + kc * 65 + nn;
        if (d.q8) {
            u32x2 o8; o8.x = pk4_fp8(sp[0] * 64.f, sp[65] * 64.f, sp[130] * 64.f, sp[195] * 64.f); o8.y = pk4_fp8(sp[260] * 64.f, sp[325] * 64.f, sp[390] * 64.f, sp[455] * 64.f);
            *(u32x2*)((unsigned char*)d.WT + (size_t)(d.r0 + nn) * 2048 + d.k0 + kc) = o8; continue; }
        u32x4 o; o.x = cvt_pk_bf16(sp[0], sp[65]); o.y = cvt_pk_bf16(sp[130], sp[195]); o.z = cvt_pk_bf16(sp[260], sp[325]); o.w = cvt_pk_bf16(sp[390], sp[455]);
        *(u32x4*)(d.WT + (size_t)(d.r0 + nn) * d.ldk + d.k0 + kc) = o; }
    LDS_WAIT();
}
__device__ __forceinline__ int win_src_col(int r) {
    if (r < 2048) return r;
    if (r < 3072) return r + 1024;
    if (r < 5120) return r + 1032;
    if (r < 9216) return r + 2056;
    if (r < 10240) return r - 7168;
    return r - 4088;
}
__device__ __forceinline__ TrDesc tr_decode(ArgsP a, unsigned char* ws, int it) {
    constexpr int PER_LAYER = 5632 + 512 + 512 + 1024 + 4096 + 4096 + 4096;
    const int l = it / PER_LAYER; int r = it % PER_LAYER;
    TrDesc d; d.q8 = 0;
    if (r < 5632) { d.q8 = 1; const int kb = r / 176, ng = r % 176;
        d.W = a->in[I_WIN] + (size_t)l * DM * INCOLS; d.ldn = INCOLS; d.k0 = 64 * kb; d.n0 = win_src_col(64 * ng); d.WT = (bf16*)(ws + WS_WINT + (size_t)l * 11264 * 2048); d.ldk = 2048; d.r0 = 64 * ng; return d; }
    r -= 5632;
    if (r < 512) { const int kb = r / 32, ng = r % 32;
        d.W = a->in[I_WBM] + (size_t)l * 1024 * 2048; d.ldn = 2048; d.k0 = 64 * kb; d.n0 = 64 * ng; d.WT = (bf16*)(ws + WS_WBM) + (size_t)l * 2048 * 1024; d.ldk = 1024; d.r0 = 64 * ng; return d; }
    r -= 512;
    if (r < 512) { const int kb = r / 32, ng = r % 32;
        d.W = a->in[I_WBA] + (size_t)l * 1024 * 2048; d.ldn = 2048; d.k0 = 64 * kb; d.n0 = 64 * ng; d.WT = (bf16*)(ws + WS_WBA) + (size_t)l * 2048 * 1024; d.ldk = 1024; d.r0 = 64 * ng; return d; }
    r -= 512;
    if (r < 1024) { const int kb = r / 32, ng = r % 32;
        d.W = a->in[I_WOUT] + (size_t)l * 2048 * 2048; d.ldn = 2048; d.k0 = 64 * kb; d.n0 = 64 * ng; d.WT = (bf16*)(ws + WS_WOUT) + (size_t)l * 2048 * 2048; d.ldk = 2048; d.r0 = 64 * ng; return d; }
    r -= 1024;
    if (r < 8192) { const int w3 = r >= 4096; const int q = r & 4095; const int e = q >> 7, rr = q & 127, kb = rr >> 2, ng = rr & 3;
        d.W = a->in[w3 ? I_W3 : I_W1] + (size_t)(l * 32 + e) * 2048 * 256; d.ldn = 256; d.k0 = 64 * kb; d.n0 = 64 * ng;
        d.WT = (bf16*)(ws + WS_W13) + (size_t)(l * 32 + e) * 512 * 2048; d.ldk = 2048; d.r0 = 256 * (ng >> 1) + 64 * (ng & 1) + (w3 ? 128 : 0); return d; }
    r -= 8192;
    { const int e = r >> 7, rr = r & 127, kb = rr >> 5, ng = rr & 31;
        d.W = a->in[I_W2] + (size_t)(l * 32 + e) * 256 * 2048; d.ldn = 2048; d.k0 = 64 * kb; d.n0 = 64 * ng; d.WT = (bf16*)(ws + WS_W2) + (size_t)(l * 32 + e) * 2048 * 256; d.ldk = 256; d.r0 = 64 * ng; return d; }
}
#ifndef CVX
#define CVX 8192
#define CVX1 6144
#endif
__device__ __forceinline__ void prologue_phase(ArgsP a, LAS unsigned char* lds, int tid, int lane, int wave, int bid, int G, const int part = 0, const int gwx = -1, const int ngwx = 0) {
    unsigned char* ws = a->ws;
    LAS float* scr = (LAS float*)(lds + wave * 16640);
    const int gw = gwx >= 0 ? gwx : bid * NWAVES + wave, NGW = gwx >= 0 ? ngwx : G * NWAVES;
    constexpr int PER_LAYER = 5632 + 512 + 512 + 1024 + 4096 + 4096 + 4096;
    constexpr int W0 = 5632, W2I = PER_LAYER - 4096;
    const int v_lo = part == 0 ? 0 : part == 1 ? PER_LAYER - 2048 : part == 2 ? W0 + CVX : part == 3 ? PER_LAYER + W0 + CVX1 : part == 4 ? PER_LAYER + W2I : part == 6 ? W0 : PER_LAYER + W0;
    const int v_hi = part == 0 ? W0 : part == 1 ? PER_LAYER + W0 : part == 2 ? PER_LAYER - 2048 : part == 3 ? PER_LAYER + W2I : part == 4 ? 2 * PER_LAYER : part == 6 ? W0 + CVX : PER_LAYER + W0 + CVX1;
#define CV_ITEM(v) (v)
    f32x4 tvA[16], tvB[16]; TrDesc dA, dB;
    int it = v_lo + gw;
    if (it < v_hi) {
        int rem = (v_hi - 1 - it) / NGW;
        dA = tr_decode(a, ws, CV_ITEM(it)); tr_load(dA, tvA, lane);
#pragma unroll 1
        while (rem >= 2) {
            dB = tr_decode(a, ws, CV_ITEM(it + NGW)); tr_load(dB, tvB, lane);
            tr_finish(dA, tvA, scr, lane);
            it += 2 * NGW;
            dA = tr_decode(a, ws, CV_ITEM(it)); tr_load(dA, tvA, lane);
            tr_finish(dB, tvB, scr, lane);
            rem -= 2;
        }
        if (rem == 1) { dB = tr_decode(a, ws, CV_ITEM(it + NGW)); tr_load(dB, tvB, lane); tr_finish(dA, tvA, scr, lane); tr_finish(dB, tvB, scr, lane); }
        else tr_finish(dA, tvA, scr, lane);
    }
#undef CV_ITEM
    if (part != 0) return;
    const int gt = bid * NTHR + tid, NGT = G * NTHR;
    float* wrt = (float*)(ws + MS_WRT);
    for (int i = gt; i < 2 * 36 * 2048; i += NGT) { const int l = i / (36 * 2048), rr = i % (36 * 2048), n = rr >> 11, k = rr & 2047;
        wrt[i] = n < 4 ? a->in[I_WGRP][((size_t)l * DM + k) * 4 + n] : a->in[I_WEXP][((size_t)l * DM + k) * 32 + (n - 4)]; }
}

__device__ __forceinline__ void moe_tables(unsigned char* ws, int l, LAS unsigned char* misc, int tid) {
    LAS int* cnt = (LAS int*)(misc + MO_CNT); LAS int* ntl = (LAS int*)(misc + MO_NT); LAS int* off = (LAS int*)(misc + MO_OFF);
    LAS int* te = (LAS int*)(misc + MO_TE); LAS int* tr0 = (LAS int*)(misc + MO_TR0); LAS int* mt = (LAS int*)(misc + MO_MT);
    __syncthreads();
    if (tid < 64) {
        const int c = tid < 32 ? (int)__hip_atomic_load((unsigned*)(ws + WS_CTL) + CW_CNT + 32 * l + tid, __ATOMIC_RELAXED, __HIP_MEMORY_SCOPE_AGENT) : 0;
        const int n = (c + 255) >> 8;
        int x = n;
#pragma unroll
        for (int o = 1; o < 32; o <<= 1) { const int t = shu(x, o); if (tid >= o) x += t; }
        const int o0 = x - n;
        if (tid < 32) { cnt[tid] = c; ntl[tid] = n; off[tid] = o0;
#pragma unroll 1
            for (int j = 0; j < n; ++j) { te[o0 + j] = tid; tr0[o0 + j] = 256 * j; } }
        if (tid == 31) { off[32] = x; mt[0] = x; }
    }
    __syncthreads();
}

#ifndef DRYX
#define DRYX 0
#endif
template <int MODE>
__device__ __forceinline__ void norm_phase(ArgsP a, int l, LAS unsigned char* lds, int tid, int lane, int wave, int bid, int G, const bool dry = false) {
    unsigned char* ws = a->ws;
    LAS unsigned char* misc = lds + MISC_OFF;
    if (MODE == 1 || MODE == 3) moe_tables(ws, MODE == 1 ? 0 : 1, misc, tid);
    const LAS int* off = (const LAS int*)(misc + MO_OFF);
    const float* src = (MODE == 0) ? a->in[I_X] : a->out;
    const float* gain = (MODE < 2) ? a->in[I_N1G] + l * DM : (MODE == 2 ? a->in[I_N2G] + l * DM : a->in[I_FG]);
    const int* toke = (const int*)(ws + MS_TOKE); const int* tokp = (const int*)(ws + MS_TOKP);
    const bf16* OP = (const bf16*)(ws + WS_OP);
    bf16* H = (bf16*)(ws + WS_H);
    const int gw = bid * NWAVES + wave, NGW = G * NWAVES;
    constexpr int RP = (MODE == 2) ? 4 : 2;
    LAS float* gwl = (LAS float*)lds;
    if (MODE < 2) {
        const float* wg = a->in[I_WIN] + (size_t)l * DM * INCOLS + 4096;
        f32x4 t0[4], t1[4];
#pragma unroll
        for (int i = 0; i < 4; ++i) { const float* wp = wg + (size_t)(tid + NTHR * i) * INCOLS; t0[i] = *(const f32x4*)wp; t1[i] = *(const f32x4*)(wp + 4); }
#pragma unroll
        for (int i = 0; i < 4; ++i) { const int k = tid + NTHR * i;
            gwl[k] = t0[i].x; gwl[2048 + k] = t0[i].y; gwl[4096 + k] = t0[i].z; gwl[6144 + k] = t0[i].w;
            gwl[8192 + k] = t1[i].x; gwl[10240 + k] = t1[i].y; gwl[12288 + k] = t1[i].z; gwl[14336 + k] = t1[i].w; }
        __syncthreads();
    }
    const int npass = (NTOK + NGW * RP - 1) / (NGW * RP);
    for (int m0_ = gw * RP, it = 0; (MODE == 2) ? (it < npass) : (m0_ < NTOK); m0_ += NGW * RP, ++it) {
        const bool valid = (MODE != 2) || (m0_ < NTOK);
        const int m0 = valid ? m0_ : NTOK - RP;
        f32x4 v[RP][8];
        const bf16* orow[RP][2]; float cw[RP][2];
        if (MODE == 1 || MODE == 3) {
#pragma unroll
            for (int r = 0; r < RP; ++r) { const int m = m0 + r;
                const int e0 = toke[2 * m], e1 = toke[2 * m + 1], p0 = tokp[2 * m], p1 = tokp[2 * m + 1];
                cw[r][0] = ((const float*)(ws + MS_TOKW))[2 * m]; cw[r][1] = ((const float*)(ws + MS_TOKW))[2 * m + 1];
                orow[r][0] = OP + (size_t)(off[e0] * 256 + p0) * DM + 4 * lane; orow[r][1] = OP + (size_t)(off[e1] * 256 + p1) * DM + 4 * lane; }
        }
#pragma unroll
        for (int r = 0; r < RP; ++r)
#pragma unroll
            for (int j = 0; j < 8; ++j) v[r][j] = *(const f32x4*)(src + (size_t)(m0 + r) * DM + 256 * j + 4 * lane);
        if (MODE == 1 || MODE == 3) {
            u32x2 ow[RP][2][8];
#pragma unroll
            for (int r = 0; r < RP; ++r)
#pragma unroll
                for (int j = 0; j < 8; ++j) { ow[r][0][j] = *(const u32x2*)(orow[r][0] + 256 * j); ow[r][1][j] = *(const u32x2*)(orow[r][1] + 256 * j); }
#pragma unroll
            for (int r = 0; r < RP; ++r)
                asm volatile("" : "+v"(ow[r][0][0]), "+v"(ow[r][0][1]), "+v"(ow[r][0][2]), "+v"(ow[r][0][3]), "+v"(ow[r][0][4]), "+v"(ow[r][0][5]), "+v"(ow[r][0][6]), "+v"(ow[r][0][7]),
                                  "+v"(ow[r][1][0]), "+v"(ow[r][1][1]), "+v"(ow[r][1][2]), "+v"(ow[r][1][3]), "+v"(ow[r][1][4]), "+v"(ow[r][1][5]), "+v"(ow[r][1][6]), "+v"(ow[r][1][7]));
#pragma unroll
            for (int r = 0; r < RP; ++r) { const int m = m0 + r; const float cw0 = cw[r][0], cw1 = cw[r][1];
#pragma unroll
                for (int j = 0; j < 8; ++j) { const u32x2 w0 = ow[r][0][j], w1 = ow[r][1][j];
                    v[r][j].x += cw0 * bflo(w0.x) + cw1 * bflo(w1.x); v[r][j].y += cw0 * bfhi(w0.x) + cw1 * bfhi(w1.x); v[r][j].z += cw0 * bflo(w0.y) + cw1 * bflo(w1.y); v[r][j].w += cw0 * bfhi(w0.y) + cw1 * bfhi(w1.y); }
                if (MODE == 1 && !dry) {
#pragma unroll
                    for (int j = 0; j < 8; ++j) *(f32x4*)(a->out + (size_t)m * DM + 256 * j + 4 * lane) = v[r][j]; }
            }
        }
        float rs[RP];
#pragma unroll
        for (int r = 0; r < RP; ++r) { float ss = 0.f;
#pragma unroll
            for (int j = 0; j < 8; ++j) ss += (v[r][j].x * v[r][j].x + v[r][j].y * v[r][j].y) + (v[r][j].z * v[r][j].z + v[r][j].w * v[r][j].w);
            rs[r] = __builtin_amdgcn_rsqf(wave_sum(ss) * (1.0f / DM) + RMS_EPS); }
        {
            f32x4 gv[8];
            int l4 = 4 * lane; asm volatile("" : "+v"(l4)); const float* gp = gain + l4;
#pragma unroll
            for (int j = 0; j < 8; ++j) gv[j] = *(const f32x4*)(gp + 256 * j);
            asm volatile("" : "+v"(gv[0]), "+v"(gv[1]), "+v"(gv[2]), "+v"(gv[3]), "+v"(gv[4]), "+v"(gv[5]), "+v"(gv[6]), "+v"(gv[7]));
#pragma unroll
            for (int j = 0; j < 8; ++j)
#pragma unroll
                for (int r = 0; r < RP; ++r) v[r][j] = v[r][j] * rs[r] * gv[j];
        }
        if (MODE == 3) {
#pragma unroll
            for (int r = 0; r < RP; ++r)
#pragma unroll
                for (int j = 0; j < 8; ++j) { if (!dry) *(f32x4*)(a->out + (size_t)(m0 + r) * DM + 256 * j + 4 * lane) = v[r][j]; else asm volatile("" :: "v"(v[r][j])); }
            continue;
        }
#pragma unroll
        for (int r = 0; r < RP; ++r)
#pragma unroll
            for (int j = 0; j < 8; ++j) { u32x2 w;
                if (MODE < 2) {
                    const unsigned w8 = pk4_fp8(v[r][j].x, v[r][j].y, v[r][j].z, v[r][j].w);
                    if (!dry) *(unsigned*)((unsigned char*)H + (size_t)(m0 + r) * DM + 256 * j + 4 * lane) = w8; else asm volatile("" :: "v"(w8));
                    continue; }
                w.x = cvt_pk_bf16(v[r][j].x, v[r][j].y); w.y = cvt_pk_bf16(v[r][j].z, v[r][j].w);
                if (!dry && valid) *(u32x2*)(H + (size_t)(m0 + r) * DM + 256 * j + 4 * lane) = w; else asm volatile("" :: "v"(w)); }
        float keep[RP]; _Pragma("unroll") for (int r = 0; r < RP; ++r) keep[r] = 0.f;
        if (MODE < 2) {
            float a8[RP][8];
#pragma unroll
            for (int r = 0; r < RP; ++r)
#pragma unroll
                for (int n = 0; n < 8; ++n) a8[r][n] = 0.f;
#pragma unroll
            for (int j = 0; j < 8; ++j) {
#pragma unroll
                for (int nh = 0; nh < 2; ++nh) {
                    f32x4 wn[4];
#pragma unroll
                    for (int n = 0; n < 4; ++n) wn[n] = *(const LAS f32x4*)(gwl + (4 * nh + n) * 2048 + 256 * j + 4 * lane);
                    asm volatile("" : "+v"(wn[0]), "+v"(wn[1]), "+v"(wn[2]), "+v"(wn[3]));
#pragma unroll
                    for (int r = 0; r < RP; ++r)
#pragma unroll
                        for (int n = 0; n < 4; ++n) a8[r][4 * nh + n] += (v[r][j].x * wn[n].x + v[r][j].y * wn[n].y) + (v[r][j].z * wn[n].z + v[r][j].w * wn[n].w);
                }
            }
#pragma unroll
            for (int r = 0; r < RP; ++r)
#pragma unroll
                for (int n = 0; n < 8; ++n) { const float d = wave_sum(a8[r][n]); keep[r] = (lane == n) ? d : keep[r]; }
        } else {
            const float* W = (const float*)(ws + MS_WRT) + (size_t)l * 36 * 2048;
            LAS float* logl = (LAS float*)(misc + MO_LOG) + wave * 160;
            LAS float* wb = (LAS float*)lds;
#define RT_STAGE(g_, buf_) do { _Pragma("unroll") for (int i = 0; i < 4; ++i) \
                __builtin_amdgcn_global_load_lds((const unsigned*)(W + (size_t)(g_) * 8192 + (wave * 4 + i) * 256 + 4 * lane), (LAS unsigned*)(wb + (buf_) * 8192 + (wave * 4 + i) * 256), 16, 0, 0); } while (0)
            RT_STAGE(0, 0);
            asm volatile("s_waitcnt vmcnt(0)" ::: "memory");
            __syncthreads();
#pragma unroll 1
            for (int grp = 0; grp < 9; ++grp) {
                float val[16];
                if (grp < 8) RT_STAGE(grp + 1, (grp + 1) & 1);
                const LAS float* wg = wb + (grp & 1) * 8192 + 4 * lane;
#pragma unroll
                for (int nl = 0; nl < 4; ++nl) {
                    f32x2 d[4] = {(f32x2){0.f, 0.f}, (f32x2){0.f, 0.f}, (f32x2){0.f, 0.f}, (f32x2){0.f, 0.f}};
                    f32x4 wv[8];
#pragma unroll
                    for (int j = 0; j < 8; ++j) wv[j] = *(const LAS f32x4*)(wg + nl * 2048 + 256 * j);
                    asm volatile("" : "+v"(wv[0]), "+v"(wv[1]), "+v"(wv[2]), "+v"(wv[3]), "+v"(wv[4]), "+v"(wv[5]), "+v"(wv[6]), "+v"(wv[7]));
#pragma unroll
                    for (int j = 0; j < 8; ++j) { const f32x4 w = wv[j];
#pragma unroll
                        for (int r = 0; r < 4; ++r) { d[r] = __builtin_elementwise_fma((f32x2){v[r][j].x, v[r][j].y}, (f32x2){w.x, w.y}, d[r]); d[r] = __builtin_elementwise_fma((f32x2){v[r][j].z, v[r][j].w}, (f32x2){w.z, w.w}, d[r]); } }
#pragma unroll
                    for (int r = 0; r < 4; ++r) val[4 * nl + r] = d[r].x + d[r].y;
                    __builtin_amdgcn_sched_barrier(0);
                }
                asm volatile("s_waitcnt vmcnt(0)" ::: "memory");
                __syncthreads();
#pragma unroll
                for (int i = 0; i < 8; ++i) { const bool hi = (lane & 32) != 0; const float snd = hi ? val[i] : val[i + 8]; const float kp = hi ? val[i + 8] : val[i]; val[i] = kp + shx(snd, 32); }
#pragma unroll
                for (int i = 0; i < 4; ++i) { const bool hi = (lane & 16) != 0; const float snd = hi ? val[i] : val[i + 4]; const float kp = hi ? val[i + 4] : val[i]; val[i] = kp + shx(snd, 16); }
#pragma unroll
                for (int i = 0; i < 2; ++i) { const bool hi = (lane & 8) != 0; const float snd = hi ? val[i] : val[i + 2]; const float kp = hi ? val[i + 2] : val[i]; val[i] = kp + shx(snd, 8); }
                { const bool hi = (lane & 4) != 0; const float snd = hi ? val[0] : val[1]; const float kp = hi ? val[1] : val[0]; val[0] = kp + shx(snd, 4); }
                float f = val[0]; f += shx(f, 2); f += shx(f, 1);
                const int vi = lane >> 2;
                if ((lane & 3) == 0) logl[(vi & 3) * 40 + 4 * grp + (vi >> 2)] = f;
            }
        }
        if (MODE < 2) {
            float* ifg = (float*)(ws + MS_IFG);
            if (lane < 8) {
#pragma unroll
                for (int r = 0; r < RP; ++r) { if (!dry) ifg[(size_t)(m0 + r) * 8 + lane] = keep[r]; else asm volatile("" :: "v"(keep[r])); } }
        } else {
            LAS float* logl = (LAS float*)(misc + MO_LOG) + wave * 160;
            LDS_WAIT();
            if (dry) { asm volatile("" :: "v"(keep[0])); }
            if (lane < RP && !dry && valid) {
                const int m = m0 + lane; const LAS float* lg = logl + lane * 40;
                const float* bg = a->in[I_BGRP] + l * 4; const float* be = a->in[I_BEXP] + l * 32;
                float gv[4]; int gsel = 0;
#pragma unroll
                for (int j = 0; j < 4; ++j) gv[j] = lg[j] + bg[j];
                float gmax = gv[0];
#pragma unroll
                for (int j = 1; j < 4; ++j) if (gv[j] > gmax) { gmax = gv[j]; gsel = j; }
                float gs = 0.f;
#pragma unroll
                for (int j = 0; j < 4; ++j) gs += expf(gv[j] - gmax);
                const float pg = 1.0f / gs;
                float ev[8];
#pragma unroll
                for (int j = 0; j < 8; ++j) ev[j] = lg[4 + 8 * gsel + j] + be[8 * gsel + j];
                int e0 = 0; float m0v = ev[0];
#pragma unroll
                for (int j = 1; j < 8; ++j) if (ev[j] > m0v) { m0v = ev[j]; e0 = j; }
                int e1 = -1; float m1v = -3.0e38f;
#pragma unroll
                for (int j = 0; j < 8; ++j) if (j != e0 && ev[j] > m1v) { m1v = ev[j]; e1 = j; }
                const float p1 = expf(m1v - m0v); const float w0 = pg / (1.0f + p1), w1 = pg * p1 / (1.0f + p1);
                unsigned* cnt = (unsigned*)(ws + WS_CTL) + CW_CNT + 32 * l;
                int* list = (int*)(ws + MS_LIST); float* pwl = (float*)(ws + MS_PWL); int* tke = (int*)(ws + MS_TOKE); int* tkp = (int*)(ws + MS_TOKP);
                const int id0 = 8 * gsel + e0, id1 = 8 * gsel + e1;
                const int q0 = (int)__hip_atomic_fetch_add(cnt + id0, 1u, __ATOMIC_RELAXED, __HIP_MEMORY_SCOPE_AGENT);
                const int q1 = (int)__hip_atomic_fetch_add(cnt + id1, 1u, __ATOMIC_RELAXED, __HIP_MEMORY_SCOPE_AGENT);
                list[id0 * 8192 + q0] = m; pwl[id0 * 8192 + q0] = w0; list[id1 * 8192 + q1] = m; pwl[id1 * 8192 + q1] = w1;
                tke[2 * m] = id0; tke[2 * m + 1] = id1; tkp[2 * m] = q0; tkp[2 * m + 1] = q1;
                ((float*)(ws + MS_TOKW))[2 * m] = w0; ((float*)(ws + MS_TOKW))[2 * m + 1] = w1;
            }
            LDS_WAIT();
        }
    }
}

#ifndef WGM_G1
#define WGM_G1 4
#endif
#ifndef WGM_OUT
#define WGM_OUT 4
#endif
#ifndef WGM_BR
#define WGM_BR 4
#endif
struct SchedG1 {
    static constexpr bool GATHER = false; static constexpr bool FP8 = true;
    const char* H; const char* W; int G, c;
    static constexpr int NCV = 21;
    __device__ __forceinline__ bool next(int i, Unit& u) const {
        int L = i * G + c;
        if (G == 256) {
            if (c >= 256 - NCV) return false;
            if (c >= 128 && i == 5) { const int k = c - 128; if (k >= 5 * NCV) return false; L = (k % 5) * 256 + (256 - NCV) + k / 5; }
            else if (i > 5) return false;
        }
        if (L < 1152) { pg8::static_tile(L, 36, 32, u.pn, u.pm, WGM_G1); u.aux = 0; return true; }
        const int r = L - 1152; if (r >= 256) return false;
        u.aux = 1 + (r >> 7); const int q = r & 127; u.pm = q & 3; u.pn = q >> 2; return true;
    }
    __device__ __forceinline__ const char* abase(const Unit& u) const { return u.aux == 0 ? H + (size_t)u.pm * 256 * 2048 : W + (size_t)(9216 + (u.aux - 1) * 1024 + u.pm * 256) * 2048; }
    __device__ __forceinline__ const char* bbase(const Unit& u) const { return u.aux == 0 ? W + (size_t)u.pn * 256 * 2048 : H + (size_t)u.pn * 256 * 2048; }
    __device__ __forceinline__ unsigned arow(const Unit&, int) const { return 0u; }
    static __device__ __forceinline__ bool keep_acc(const Unit&) { return false; }
};
struct EpiG1 {
    static constexpr bool PERM = true;
    unsigned char* ws; bool dry;
    __device__ __forceinline__ void operator()(f32x4 (&acc)[2][2][4][2], const Unit& u, int wr, int wc, int fr, int fq) const {
        if (dry) {
#pragma unroll
            for (int ai = 0; ai < 2; ++ai)
#pragma unroll
                for (int bj = 0; bj < 2; ++bj)
#pragma unroll
                    for (int m = 0; m < 4; ++m) asm volatile("" :: "v"(acc[ai][bj][m][0]), "v"(acc[ai][bj][m][1]));
            return; }
        if (u.aux == 0) {
            bf16* dst; int ld, colt, op;
            if (u.pn < 8) { dst = (bf16*)(ws + WS_ZQK); ld = 2048; colt = 256 * u.pn; op = 0; }
            else if (u.pn < 12) { dst = (bf16*)(ws + WS_OM); ld = 1024; colt = 256 * (u.pn - 8); op = 1; }
            else if (u.pn < 16) { dst = (bf16*)(ws + WS_QA); ld = 1024; colt = 256 * (u.pn - 12); op = 2; }
            else if (u.pn < 20) { dst = (bf16*)(ws + WS_KA); ld = 1024; colt = 256 * (u.pn - 16); op = 0; }
            else { dst = (bf16*)(ws + WS_SG); ld = 4096; colt = 256 * (u.pn - 20); op = 1; }
            const float scl = (op == 2) ? 0.12751743074602267f : 1.0f;
            const int row0 = u.pm * 256 + wr * 64 + fr, col0 = colt + wc * 32 + 8 * fq;
#pragma unroll
            for (int ai = 0; ai < 2; ++ai)
#pragma unroll
                for (int m = 0; m < 4; ++m) { bf16* rowp = dst + (size_t)(row0 + ai * 128 + m * 16) * ld + col0;
#pragma unroll
                    for (int bj = 0; bj < 2; ++bj) { f32x4 v0 = acc[ai][bj][m][0] * scl, v1 = acc[ai][bj][m][1] * scl;
                        if (op == 1) {
#pragma unroll
                            for (int j = 0; j < 4; ++j) { v0[j] = sigmoidf_(v0[j]); v1[j] = sigmoidf_(v1[j]); } }
                        u32x4 w; w.x = cvt_pk_bf16(v0[0], v0[1]); w.y = cvt_pk_bf16(v0[2], v0[3]); w.z = cvt_pk_bf16(v1[0], v1[1]); w.w = cvt_pk_bf16(v1[2], v1[3]);
                        *(u32x4*)(rowp + bj * 128) = w; } }
        } else {
            bf16* dst = (bf16*)(ws + (u.aux == 1 ? WS_VMT : WS_VAT));
            const int b = u.pn >> 3, s0 = (u.pn & 7) * 256 + wc * 32 + 8 * fq, rr0 = u.pm * 256 + wr * 64 + fr;
#pragma unroll
            for (int ai = 0; ai < 2; ++ai)
#pragma unroll
                for (int m = 0; m < 4; ++m) { const int rr = rr0 + ai * 128 + m * 16;
#pragma unroll
                    for (int bj = 0; bj < 2; ++bj) { const f32x4 v0 = acc[ai][bj][m][0], v1 = acc[ai][bj][m][1];
                        u32x4 w; w.x = cvt_pk_bf16(v0[0], v0[1]); w.y = cvt_pk_bf16(v0[2], v0[3]); w.z = cvt_pk_bf16(v1[0], v1[1]); w.w = cvt_pk_bf16(v1[2], v1[3]);
                        const int sq = s0 + bj * 128;
                        const size_t off = (u.aux == 1) ? (size_t)((((b * 4 + (rr >> 8)) * 32 + (sq >> 6)) * 2 + ((sq >> 5) & 1)) * 16 + ((rr & 255) >> 4)) * 512 + (size_t)((((sq >> 3) & 3) * 16 + (rr & 15)) * 8)
                                                        : (size_t)(b * 1024 + rr) * 2048 + sq;
                        *(u32x4*)(dst + off) = w; } }
        }
    }
};

__device__ __forceinline__ void gate_unit(ArgsP a, int l, LAS unsigned char* lds, int bh, int tid, int lane, int wave) {
    unsigned char* ws = a->ws;
    {
            const int b = bh >> 2, h = bh & 3;
            LAS float* bl = (LAS float*)lds; LAS float* amx = bl + 32; LAS float* mpv = bl + 64; LAS float* gcv = bl + 96;
            const float* ifg = (const float*)(ws + MS_IFG); const float* ifb = a->in[I_IFB] + l * 8;
            float A[4], Bs[4], CM[4];
#pragma unroll
            for (int cc = 0; cc < 4; ++cc) { const int c = wave + 8 * cc, s = 64 * c + lane; const size_t tok = (size_t)b * SEQ + s;
                const float ig = ifg[tok * 8 + h] + ifb[h], fg = ifg[tok * 8 + 4 + h] + ifb[4 + h];
                const float lf = fminf(fg, 0.f) - log1pf(expf(-fabsf(fg)));
                float bs = lf;
#pragma unroll
                for (int o = 1; o < 64; o <<= 1) { const float t = shu(bs, o); if (lane >= o) bs += t; }
                const float av = ig - bs; float cm = av;
#pragma unroll
                for (int o = 1; o < 64; o <<= 1) { const float t = shu(cm, o); if (lane >= o) cm = fmaxf(cm, t); }
                A[cc] = av; Bs[cc] = bs; CM[cc] = cm;
                if (lane == 63) { bl[c] = bs; amx[c] = cm; } }
            __syncthreads();
            if (tid == 0) { float m = 0.f;
#pragma unroll 1
                for (int c = 0; c < 32; ++c) { mpv[c] = m; const float Gm = fmaxf(m, amx[c]); gcv[c] = Gm; m = bl[c] + Gm; } }
            __syncthreads();
            float* AS = (float*)(ws + MS_AS) + bh * 2048; float* GT = (float*)(ws + MS_GT) + bh * 2048; float* WI = (float*)(ws + MS_WI) + bh * 2048;
            float* CL = (float*)(ws + MS_CL) + bh * 2048; float* WSs = (float*)(ws + MS_WS) + bh * 2048; float* DEC = (float*)(ws + MS_DEC) + bh * 32;
#pragma unroll
            for (int cc = 0; cc < 4; ++cc) { const int c = wave + 8 * cc, s = 64 * c + lane; const float mp = mpv[c], Gm = gcv[c], gt = fmaxf(mp, CM[cc]);
                AS[s] = A[cc]; GT[s] = gt; WI[s] = expf(mp - gt); CL[s] = expf(-(Bs[cc] + gt)); WSs[s] = expf(A[cc] - Gm);
                if (lane == 0) DEC[c] = expf(mp - Gm); }
        }
    __syncthreads();
}

__device__ __forceinline__ void conv_phase(ArgsP a, int l, LAS unsigned char* lds, int tid, int lane, int wave, int bid, int G) {
    unsigned char* ws = a->ws;
    u32x4 xv[5];
    const bf16* Z = (const bf16*)(ws + WS_ZQK);
#define CONV_LOAD(u_) do { const int cg_ = ((u_) ^ ((((u_) >> 8) & 1) << 2)) & 7, s0_ = 64 * (((u_) >> 3) & 31), b_ = (u_) >> 8; _Pragma("unroll") for (int i = 0; i < 5; ++i) { \
        const int idx = tid + NTHR * i, row = idx >> 5, ch = idx & 31, sq = s0_ - 3 + row; xv[i] = (u32x4){0u, 0u, 0u, 0u}; \
        if (idx < 67 * 32 && sq >= 0) xv[i] = *(const u32x4*)(Z + (size_t)(b_ * SEQ + sq) * 2048 + cg_ * 256 + ch * 8); } \
        wsn = ((const float*)(ws + MS_WS))[(size_t)(b_ * 4 + ((cg_ - 4) & 3)) * 2048 + s0_ + (tid & 63)]; } while (0)
    float wsn = 0.f;
    if (bid < 1024) CONV_LOAD(bid);
    for (int u = bid; u < 1024 + 256; u += G) {
        if (u < 1024) {
            const int cg = (u ^ (((u >> 8) & 1) << 2)) & 7, st = (u >> 3) & 31, b = u >> 8, s0 = 64 * st;
            LAS unsigned char* xt = lds; LAS unsigned char* kt = lds + 36864;
            const int cp = tid & 127, tg = tid >> 7, c = 2 * cp, gc = cg * 256 + c;
            float w0[4], w1[4];
#pragma unroll
            for (int j = 0; j < 4; ++j) { w0[j] = a->in[I_CONVW][(size_t)(l * 4 + j) * 2048 + gc]; w1[j] = a->in[I_CONVW][(size_t)(l * 4 + j) * 2048 + gc + 1]; }
            asm volatile("" : "+v"(xv[0]), "+v"(xv[1]), "+v"(xv[2]), "+v"(xv[3]), "+v"(xv[4]));
#pragma unroll
            for (int i = 0; i < 5; ++i) { const int idx = tid + NTHR * i, row = idx >> 5, ch = idx & 31;
                if (idx < 67 * 32) *(LAS u32x4*)(xt + row * 512 + ch * 16) = xv[i]; }
            LAS float* wst = (LAS float*)(lds + 73728);
            if (cg >= 4 && tid < 64) wst[tid] = wsn;
            __syncthreads();
            if (u + G < 1024) CONV_LOAD(u + G);
            bf16* QM = (bf16*)(ws + WS_QM); bf16* KM = (bf16*)(ws + WS_KM);
            unsigned xw[19];
#pragma unroll
            for (int j = 0; j < 19; ++j) xw[j] = *(const LAS unsigned*)(xt + (tg * 16 + j) * 512 + c * 2);
#pragma unroll
            for (int tt = 0; tt < 16; ++tt) { const int t = tg * 16 + tt; float a0 = 0.f, a1 = 0.f;
#pragma unroll
                for (int j = 0; j < 4; ++j) { const unsigned x = xw[tt + j]; a0 += w0[j] * bflo(x); a1 += w1[j] * bfhi(x); }
                float o0 = a0 * sigmoidf_(a0), o1 = a1 * sigmoidf_(a1);
                const size_t tok = (size_t)b * SEQ + s0 + t;
                if (cg < 4) { *(unsigned*)(QM + tok * 1024 + cg * 256 + c) = cvt_pk_bf16(o0, o1); }
                else { o0 *= 0.0625f; o1 *= 0.0625f; const unsigned p = cvt_pk_bf16(o0, o1);
                    *(unsigned*)(KM + tok * 1024 + (cg - 4) * 256 + c) = p;
                    const float wsv = wst[t]; const unsigned ps = cvt_pk_bf16(o0 * wsv, o1 * wsv);
                    *(LAS unsigned short*)(kt + c * 144 + t * 2) = (unsigned short)(ps & 0xffffu); *(LAS unsigned short*)(kt + (c + 1) * 144 + t * 2) = (unsigned short)(ps >> 16); }
            }
            if (cg >= 4) {
                __syncthreads();
                bf16* KMT = (bf16*)(ws + WS_KMT);
                for (int idx = tid; idx < 2048; idx += NTHR) {
                    const int ks = idx >> 10, dtl = (idx >> 6) & 15, ln = idx & 63, row = dtl * 16 + (ln & 15), ch = ks * 4 + (ln >> 4);
                    const u32x4 v = *(const LAS u32x4*)(kt + row * 144 + ch * 16);
                    *(u32x4*)(KMT + (size_t)(((b * 4 + cg - 4) * 32 + st) * 2) * 8192 + (size_t)idx * 8) = v; }
                if (tid < 256) {
                    float sm = 0.f;
#pragma unroll
                    for (int i = 0; i < 8; ++i) { const u32x4 v = *(const LAS u32x4*)(kt + tid * 144 + i * 16);
                        sm += (bflo(v.x) + bfhi(v.x)) + (bflo(v.y) + bfhi(v.y)) + (bflo(v.z) + bfhi(v.z)) + (bflo(v.w) + bfhi(v.w)); }
                    ((float*)(ws + MS_NST))[(size_t)((b * 4 + cg - 4) * 32 + st) * 256 + tid] = sm; }
            }
        } else if (u < 1280) {
            const int j = u - 1024, b = j >> 6, n = (j >> 3) & 7, h = j & 7;
            const bf16* KA = (const bf16*)(ws + WS_KA) + (size_t)(b * SEQ + n * 256 + wave * 32) * 1024 + h * 128 + 2 * lane;
            float s0 = 0.f, s1 = 0.f;
            unsigned xr[32];
#pragma unroll
            for (int r = 0; r < 32; ++r) xr[r] = *(const unsigned*)(KA + (size_t)r * 1024);
#pragma unroll
            for (int r = 0; r < 32; r += 8) asm volatile("" : "+v"(xr[r]), "+v"(xr[r + 1]), "+v"(xr[r + 2]), "+v"(xr[r + 3]), "+v"(xr[r + 4]), "+v"(xr[r + 5]), "+v"(xr[r + 6]), "+v"(xr[r + 7]));
#pragma unroll
            for (int r = 0; r < 32; ++r) { s0 += bflo(xr[r]); s1 += bfhi(xr[r]); }
            LAS float* part = (LAS float*)lds;
            part[wave * 128 + 2 * lane] = s0; part[wave * 128 + 2 * lane + 1] = s1;
            __syncthreads();
            if (tid < 128) { float t = 0.f;
#pragma unroll
                for (int w = 0; w < 8; ++w) t += part[w * 128 + tid];
                ((float*)(ws + MS_KMEAN))[(size_t)((b * 8 + h) * 8 + n) * 128 + tid] = t * (1.0f / 256.0f); }
        }
        __syncthreads();
    }
}

#undef CONV_LOAD
__device__ __forceinline__ void mlstm_ab_task(unsigned char* ws, int gw, int lane, const bool do_store = true) {
    const int bh = gw >> 6, piece = gw & 63, e0 = (piece >> 3) * 32, d0 = (piece & 7) * 32, q16 = lane & 15, g = lane >> 4;
    const bf16* ka = (const bf16*)(ws + WS_KMT) + (size_t)bh * 32 * 16384 + (size_t)(d0 >> 4) * 512 + lane * 8;
    const bf16* vb = (const bf16*)(ws + WS_VMT) + (size_t)bh * 32 * 16384 + (size_t)(e0 >> 4) * 512 + lane * 8;
    const float* DEC = (const float*)(ws + MS_DEC) + bh * 32;
    bf16* CST = (bf16*)(ws + WS_CST) + (size_t)bh * 32 * 65536 + (size_t)((d0 >> 5) * 16 + (e0 >> 4)) * 512 + (size_t)(((g >> 1) * 16 + q16) * 8 + 4 * (g & 1));
    f32x4 acc[2][2];
#pragma unroll
    for (int t = 0; t < 2; ++t) { acc[t][0] = (f32x4){0.f, 0.f, 0.f, 0.f}; acc[t][1] = acc[t][0]; }
    const int decv = __builtin_bit_cast(int, DEC[lane & 31]);
    bf16x8 A0[2][2], B0[2][2], A1[2][2], B1[2][2], A2[2][2], B2[2][2], A3[2][2], B3[2][2], A4[2][2], B4[2][2];
#define AB_LOAD(c_, A_, B_) do { const int cc_ = (c_) < 31 ? (c_) : 31; _Pragma("unroll") for (int ks = 0; ks < 2; ++ks) { \
        A_[0][ks] = *(const bf16x8*)(ka + (size_t)cc_ * 16384 + ks * 8192); A_[1][ks] = *(const bf16x8*)(ka + (size_t)cc_ * 16384 + ks * 8192 + 512); \
        B_[0][ks] = *(const bf16x8*)(vb + (size_t)cc_ * 16384 + ks * 8192); B_[1][ks] = *(const bf16x8*)(vb + (size_t)cc_ * 16384 + ks * 8192 + 512); } } while (0)
#define AB_STEP(c_, A_, B_) do { \
        if (do_store) { _Pragma("unroll") for (int t = 0; t < 2; ++t) _Pragma("unroll") for (int f = 0; f < 2; ++f) { u32x2 w; w.x = cvt_pk_bf16(acc[t][f][0], acc[t][f][1]); w.y = cvt_pk_bf16(acc[t][f][2], acc[t][f][3]); \
            *(u32x2*)(CST + (size_t)(c_) * 65536 + 512 * t + 256 * f) = w; } } \
        const float dec = __builtin_bit_cast(float, __builtin_amdgcn_readlane(decv, (c_))); \
        _Pragma("unroll") for (int t = 0; t < 2; ++t) { acc[t][0] = acc[t][0] * dec; acc[t][1] = acc[t][1] * dec; } \
        _Pragma("unroll") for (int ks = 0; ks < 2; ++ks) _Pragma("unroll") for (int t = 0; t < 2; ++t) { \
            acc[t][0] = __builtin_amdgcn_mfma_f32_16x16x32_bf16(A_[0][ks], B_[t][ks], acc[t][0], 0, 0, 0); \
            acc[t][1] = __builtin_amdgcn_mfma_f32_16x16x32_bf16(A_[1][ks], B_[t][ks], acc[t][1], 0, 0, 0); } } while (0)
    AB_LOAD(0, A0, B0); AB_LOAD(1, A1, B1); AB_LOAD(2, A2, B2); AB_LOAD(3, A3, B3); AB_LOAD(4, A4, B4);
#pragma unroll 1
    for (int c = 0; c < 30; c += 5) {
        AB_STEP(c, A0, B0); AB_LOAD(c + 5, A0, B0);
        AB_STEP(c + 1, A1, B1); AB_LOAD(c + 6, A1, B1);
        AB_STEP(c + 2, A2, B2); AB_LOAD(c + 7, A2, B2);
        AB_STEP(c + 3, A3, B3); AB_LOAD(c + 8, A3, B3);
        AB_STEP(c + 4, A4, B4); AB_LOAD(c + 9, A4, B4);
    }
    AB_STEP(30, A0, B0); AB_STEP(31, A1, B1);
    if (!do_store) asm volatile("" :: "v"(acc[0][0]), "v"(acc[0][1]), "v"(acc[1][0]), "v"(acc[1][1]));
#undef AB_LOAD
#undef AB_STEP
}

__device__ __forceinline__ void nscan_task(unsigned char* ws, int t, int lane) {
    const int bh = t >> 2, d = (t & 3) * 64 + lane;
    const float* cs = (const float*)(ws + MS_NST) + (size_t)bh * 32 * 256 + d;
    float* nv = (float*)(ws + MS_NVEC) + (size_t)bh * 32 * 256 + d;
    const int decv = __builtin_bit_cast(int, ((const float*)(ws + MS_DEC))[bh * 32 + (lane & 31)]);
    float v[32];
#pragma unroll
    for (int j = 0; j < 32; ++j) v[j] = cs[j * 256];
    float n = 0.f;
#pragma unroll
    for (int j = 0; j < 32; ++j) { nv[j * 256] = n; n = __builtin_bit_cast(float, __builtin_amdgcn_readlane(decv, j)) * n + v[j]; }
}

__device__ __forceinline__ int rel_bucket_dev(int n) {
    if (n < 16) return n;
    int b = 16;
    b += (n >= 19); b += (n >= 21); b += (n >= 24); b += (n >= 27); b += (n >= 31); b += (n >= 35); b += (n >= 40); b += (n >= 46);
    b += (n >= 52); b += (n >= 59); b += (n >= 67); b += (n >= 77); b += (n >= 87); b += (n >= 99); b += (n >= 113);
    return b;
}
constexpr int AT_KT = 0, AT_VT = 34816, AT_TAB = 71680, AT_SEL = 72704, AT_TILES = 73216, AT_CTL = 73600, AT_KM = 73728;
__device__ __forceinline__ void attn_unit(ArgsP a, LAS unsigned char* lds, int uidx, int tid, int lane, int wave) {
    unsigned char* ws = a->ws;
    const int u256 = uidx & 255, second = uidx >> 8, bh = u256 >> 3, kk8 = u256 & 7, si = second ? 15 - kk8 : kk8, wgt = 16 - si;
    const int blk = (wgt - 1) >> 1, half = (wgt - 1) & 1, b = bh >> 3, h = bh & 7, q0 = blk * 256 + half * 128;
    const int q16 = lane & 15, g = lane >> 4;
    LAS float* tab = (LAS float*)(lds + AT_TAB); LAS unsigned* sels = (LAS unsigned*)(lds + AT_SEL); LAS int* tiles = (LAS int*)(lds + AT_TILES);
    LAS unsigned* ctl = (LAS unsigned*)(lds + AT_CTL); LAS float* kms = (LAS float*)(lds + AT_KM);
    const bf16* QA = (const bf16*)(ws + WS_QA); const bf16* KA = (const bf16*)(ws + WS_KA); const bf16* VAT = (const bf16*)(ws + WS_VAT);
    u32x4 kreg[4], vreg[4], qst[4];
    const int row0 = tid >> 4, ch = tid & 15;
    const int tl = tid & 255, kpt = tid >> 8, krow = 64 * kpt + (tl >> 4), kch = tl & 15, vrow = tl >> 3, vch = 8 * kpt + (tl & 7);
    const bf16* kbase = KA + (size_t)(b * SEQ + krow) * 1024 + h * 128 + kch * 8;
    const bf16* vbase = VAT + (size_t)(bh * 128 + vrow) * 2048 + vch * 8;
#define AT_LOADK(ks0_) do { _Pragma("unroll") for (int i = 0; i < 4; ++i) kreg[i] = *(const u32x4*)(kbase + (size_t)((ks0_) + 16 * i) * 1024); } while (0)
#define AT_LOADV(ks0_) do { _Pragma("unroll") for (int i = 0; i < 4; ++i) vreg[i] = *(const u32x4*)(vbase + (size_t)(32 * i) * 2048 + (ks0_)); } while (0)
#pragma unroll
    for (int i = 0; i < 4; ++i) qst[i] = *(const u32x4*)(QA + (size_t)(b * SEQ + q0 + row0 + 32 * i) * 1024 + h * 128 + ch * 8);
    AT_LOADK(blk * 256); AT_LOADV(blk * 256);
    if (tid <= 128) tab[tid] = a->in[I_RELB][rel_bucket_dev(tid) * 8 + h] * 1.4426950408889634f;
    for (int idx = tid; idx < 1024; idx += NTHR) kms[idx] = ((const float*)(ws + MS_KMEAN))[bh * 1024 + idx];
    if (tid == 0) ctl[0] = 0u;
    __syncthreads();
    {
        const int q = tid >> 2, part = tid & 3;
        const bf16* qp = QA + (size_t)(b * SEQ + q0 + q) * 1024 + h * 128 + part * 32;
        float qf32[32];
#pragma unroll
        for (int i = 0; i < 4; ++i) { const u32x4 v = *(const u32x4*)(qp + 8 * i);
            qf32[8 * i + 0] = bflo(v.x); qf32[8 * i + 1] = bfhi(v.x); qf32[8 * i + 2] = bflo(v.y); qf32[8 * i + 3] = bfhi(v.y);
            qf32[8 * i + 4] = bflo(v.z); qf32[8 * i + 5] = bfhi(v.z); qf32[8 * i + 6] = bflo(v.w); qf32[8 * i + 7] = bfhi(v.w); }
        float gate[8];
#pragma unroll
        for (int n = 0; n < 8; ++n) { float s = 0.f;
            if (n < blk) {
#pragma unroll
                for (int d = 0; d < 32; d += 4) { const f32x4 kv = *(const LAS f32x4*)(kms + n * 128 + part * 32 + d);
                    s += (qf32[d] * kv.x + qf32[d + 1] * kv.y) + (qf32[d + 2] * kv.z + qf32[d + 3] * kv.w); }
            }
            s += shx(s, 1); s += shx(s, 2); gate[n] = s; }
        if (part == 0) {
            unsigned sel;
            if (blk <= 3) sel = (1u << blk) - 1u;
            else { sel = 0u;
#pragma unroll
                for (int it = 0; it < 3; ++it) { int best = 0; float bv = -3.0e38f;
#pragma unroll
                    for (int n = 0; n < 8; ++n) if (n < blk && !((sel >> n) & 1u) && gate[n] > bv) { bv = gate[n]; best = n; }
                    sel |= 1u << best; } }
            sels[q] = sel; atomicOr((unsigned*)ctl, sel);
        }
    }
    __syncthreads();
    if (tid == 0) { int nt = 0; const unsigned any = ctl[0];
        for (int j = 0; j < half + 1; ++j) tiles[nt++] = blk * 256 + 128 * j;
        for (int n = 0; n < blk; ++n) if ((any >> n) & 1u) for (int j = 0; j < 2; ++j) tiles[nt++] = n * 256 + 128 * j;
        ctl[1] = (unsigned)nt; }
    __syncthreads();
    const int ntiles = (int)ctl[1];
    const int qg = wave & 3, kp = wave >> 2;
    int qpos[2]; unsigned mysel[2];
#pragma unroll
    for (int f = 0; f < 2; ++f) { qpos[f] = q0 + 32 * qg + 16 * f + q16; mysel[f] = sels[32 * qg + 16 * f + q16]; }
    constexpr int AT_Q = 77824;
#pragma unroll
    for (int i = 0; i < 4; ++i) *(LAS u32x4*)(lds + AT_Q + (row0 + 32 * i) * 272 + ch * 16) = qst[i];
    const LAS unsigned char* qrow = lds + AT_Q + (32 * qg + q16) * 272 + 16 * g;
    float m_run[2] = {-1.0e30f, -1.0e30f}, l_run[2] = {0.f, 0.f};
    f32x4 oacc[2][8];
#pragma unroll
    for (int f = 0; f < 2; ++f)
#pragma unroll
        for (int m = 0; m < 8; ++m) oacc[f][m] = (f32x4){0.f, 0.f, 0.f, 0.f};
    const int vpos = (vch >> 2) * 32 + 16 * (vch & 1) + 4 * ((vch & 3) >> 1);
#define AT_WRITEK() do { _Pragma("unroll") for (int i = 0; i < 4; ++i) *(LAS u32x4*)(lds + AT_KT + (krow + 16 * i) * 272 + kch * 16) = kreg[i]; } while (0)
#define AT_WRITEV() do { _Pragma("unroll") for (int i = 0; i < 4; ++i) { \
        *(LAS u32x2*)(lds + AT_VT + (vrow + 32 * i) * 272 + vpos * 2) = (u32x2){vreg[i].x, vreg[i].y}; \
        *(LAS u32x2*)(lds + AT_VT + (vrow + 32 * i) * 272 + (vpos + 8) * 2) = (u32x2){vreg[i].z, vreg[i].w}; } } while (0)
    AT_WRITEK();
    __syncthreads();
    if (ntiles > 1) { const int k1 = tiles[1]; AT_LOADK(k1); }
    for (int ti = 0; ti < ntiles; ++ti) {
        const int kstart = tiles[ti] + 64 * kp, nblk = kstart >> 8;
        const bool own = (nblk == blk);
        const bool any_ok = own ? true : (__any((((mysel[0] | mysel[1]) >> nblk) & 1u) != 0u) != 0);
        const bool active = own ? (kstart <= q0 + 32 * qg + 31) : any_ok;
        const LAS unsigned char* kt = lds + AT_KT + 64 * kp * 272; const LAS unsigned char* vt = lds + AT_VT + 64 * kp * 2;
        bf16x8 pf[2][2];
        AT_WRITEV();
        if (ti + 1 < ntiles) { const int kn = tiles[ti + 1]; AT_LOADV(kn); }
        if (active) {
            f32x4 s[2][4];
#pragma unroll
            for (int n = 0; n < 4; ++n) { s[0][n] = (f32x4){0.f, 0.f, 0.f, 0.f}; s[1][n] = s[0][n]; }
            bf16x8 qa[2], ka[4], qb[2], kb[4];
#define AT_QKLOAD(Q_, K_, ks_) do { Q_[0] = *(const LAS bf16x8*)(qrow + 64 * (ks_)); Q_[1] = *(const LAS bf16x8*)(qrow + 16 * 272 + 64 * (ks_)); \
                _Pragma("unroll") for (int n = 0; n < 4; ++n) K_[n] = *(const LAS bf16x8*)(kt + (16 * n + q16) * 272 + (32 * (ks_) + 8 * g) * 2); } while (0)
#define AT_QKMMA(Q_, K_) do { _Pragma("unroll") for (int n = 0; n < 4; ++n) { \
                s[0][n] = __builtin_amdgcn_mfma_f32_16x16x32_bf16(K_[n], Q_[0], s[0][n], 0, 0, 0); s[1][n] = __builtin_amdgcn_mfma_f32_16x16x32_bf16(K_[n], Q_[1], s[1][n], 0, 0, 0); } } while (0)
#define AT_VLOAD(A_, k2_, mh_) do { _Pragma("unroll") for (int m = 0; m < 4; ++m) A_[m] = *(const LAS bf16x8*)(vt + (16 * (4 * (mh_) + m) + q16) * 272 + (32 * (k2_) + 8 * g) * 2); } while (0)
#define AT_PVMMA(A_, k2_, mh_) do { _Pragma("unroll") for (int m = 0; m < 4; ++m) { \
                oacc[0][4 * (mh_) + m] = __builtin_amdgcn_mfma_f32_16x16x32_bf16(A_[m], pf[k2_][0], oacc[0][4 * (mh_) + m], 0, 0, 0); \
                oacc[1][4 * (mh_) + m] = __builtin_amdgcn_mfma_f32_16x16x32_bf16(A_[m], pf[k2_][1], oacc[1][4 * (mh_) + m], 0, 0, 0); } } while (0)
#define AT_SB() __builtin_amdgcn_sched_barrier(0)
            AT_QKLOAD(qa, ka, 0);
            AT_QKLOAD(qb, kb, 1); AT_SB(); AT_QKMMA(qa, ka); AT_SB();
            AT_QKLOAD(qa, ka, 2); AT_SB(); AT_QKMMA(qb, kb); AT_SB();
            AT_QKLOAD(qb, kb, 3); AT_SB(); AT_QKMMA(qa, ka); AT_SB();
            AT_QKMMA(qb, kb); AT_SB();
            const bool far = ((q0 + 32 * qg) - (kstart + 63)) >= 128;
            const float bfar = tab[128];
#pragma unroll
            for (int f = 0; f < 2; ++f) {
                const bool lane_ok = own ? true : (((mysel[f] >> nblk) & 1u) != 0u);
                float psum = 0.f, m_new;
#define AT_MNEW(mx_) fmaxf(((mx_) > m_run[f] + 8.0f) ? (mx_) : m_run[f], -1.0e29f)
                if (far) {
                    const float addc = lane_ok ? bfar : -1.0e30f;
                    float mx = -1.0e30f;
#pragma unroll
                    for (int n = 0; n < 4; ++n)
#pragma unroll
                        for (int r = 0; r < 4; ++r) mx = fmaxf(mx, s[f][n][r]);
                    mx = rows4_max(mx + addc);
                    m_new = AT_MNEW(mx);
                    const float cc = addc - m_new;
#pragma unroll
                    for (int n = 0; n < 4; ++n)
#pragma unroll
                        for (int r = 0; r < 4; ++r) { const float p = __builtin_amdgcn_exp2f(s[f][n][r] + cc); s[f][n][r] = p; psum += p; }
                } else {
                    const int kmax = lane_ok ? (own ? qpos[f] : 0x7fffffff) : -1;
                    float mx = -1.0e30f;
                    float bs[4][4];
#pragma unroll
                    for (int n = 0; n < 4; ++n)
#pragma unroll
                        for (int r = 0; r < 4; ++r) { int di = qpos[f] - (kstart + 16 * n + 4 * g + r); di = di < 0 ? 0 : di; di = di > 128 ? 128 : di; bs[n][r] = tab[di]; }
#pragma unroll
                    for (int n = 0; n < 4; ++n) asm volatile("" : "+v"(bs[n][0]), "+v"(bs[n][1]), "+v"(bs[n][2]), "+v"(bs[n][3]));
#pragma unroll
                    for (int n = 0; n < 4; ++n)
#pragma unroll
                        for (int r = 0; r < 4; ++r) { const int key = kstart + 16 * n + 4 * g + r;
                            const float v = (key <= kmax) ? s[f][n][r] + bs[n][r] : -1.0e30f;
                            s[f][n][r] = v; mx = fmaxf(mx, v); }
                    mx = rows4_max(mx);
                    m_new = AT_MNEW(mx);
#pragma unroll
                    for (int n = 0; n < 4; ++n)
#pragma unroll
                        for (int r = 0; r < 4; ++r) { const float p = __builtin_amdgcn_exp2f(s[f][n][r] - m_new); s[f][n][r] = p; psum += p; }
                }
#undef AT_MNEW
                const float alpha = __builtin_amdgcn_exp2f(m_run[f] - m_new);
                psum = rows4_sum(psum);
                l_run[f] = l_run[f] * alpha + psum;
                if (__any(m_new != m_run[f])) {
#pragma unroll
                    for (int m = 0; m < 8; ++m) oacc[f][m] = oacc[f][m] * alpha;
                }
                m_run[f] = m_new;
            }
#pragma unroll
            for (int k2 = 0; k2 < 2; ++k2)
#pragma unroll
                for (int f = 0; f < 2; ++f) { u32x4 pb; pb.x = cvt_pk_bf16(s[f][2 * k2][0], s[f][2 * k2][1]); pb.y = cvt_pk_bf16(s[f][2 * k2][2], s[f][2 * k2][3]);
                    pb.z = cvt_pk_bf16(s[f][2 * k2 + 1][0], s[f][2 * k2 + 1][1]); pb.w = cvt_pk_bf16(s[f][2 * k2 + 1][2], s[f][2 * k2 + 1][3]);
                    pf[k2][f] = __builtin_bit_cast(bf16x8, pb); }
        }
        __syncthreads();
        if (ti + 1 < ntiles) { AT_WRITEK(); }
        if (ti + 2 < ntiles) { const int kn = tiles[ti + 2]; AT_LOADK(kn); }
        if (active) {
            bf16x8 afA[4], afB[4];
            AT_VLOAD(afA, 0, 0);
            AT_VLOAD(afB, 0, 1); AT_SB(); AT_PVMMA(afA, 0, 0); AT_SB();
            AT_VLOAD(afA, 1, 0); AT_SB(); AT_PVMMA(afB, 0, 1); AT_SB();
            AT_VLOAD(afB, 1, 1); AT_SB(); AT_PVMMA(afA, 1, 0); AT_SB();
            AT_PVMMA(afB, 1, 1);
#undef AT_QKLOAD
#undef AT_QKMMA
#undef AT_VLOAD
#undef AT_PVMMA
#undef AT_SB
        }
        __syncthreads();
    }
    LAS float* mo = (LAS float*)lds; LAS float* ml = (LAS float*)(lds + 65536);
    if (kp == 1) {
#pragma unroll
        for (int f = 0; f < 2; ++f) {
#pragma unroll
            for (int m = 0; m < 8; ++m)
#pragma unroll
                for (int r = 0; r < 4; ++r) mo[((qg * 2 + f) * 8 + m) * 256 + r * 64 + lane] = oacc[f][m][r];
            ml[(qg * 2 + f) * 128 + lane] = m_run[f]; ml[(qg * 2 + f) * 128 + 64 + lane] = l_run[f]; }
    }
    __syncthreads();
    if (kp == 0) {
#pragma unroll
        for (int f = 0; f < 2; ++f) {
            const float m1 = ml[(qg * 2 + f) * 128 + lane], l1 = ml[(qg * 2 + f) * 128 + 64 + lane];
            const float mm = fmaxf(m_run[f], m1), a0 = __builtin_amdgcn_exp2f(m_run[f] - mm), a1 = __builtin_amdgcn_exp2f(m1 - mm);
            const float inv = __builtin_amdgcn_rcpf(l_run[f] * a0 + l1 * a1);
            int qp_ = qpos[f] * 1024 + 4 * g; asm volatile("" : "+v"(qp_));
            bf16* HA = (bf16*)(ws + WS_HA) + (size_t)b * SEQ * 1024 + h * 128 + qp_;
#pragma unroll
            for (int m = 0; m < 8; ++m) { float o[4];
#pragma unroll
                for (int r = 0; r < 4; ++r) o[r] = (oacc[f][m][r] * a0 + mo[((qg * 2 + f) * 8 + m) * 256 + r * 64 + lane] * a1) * inv;
                u32x2 w; w.x = cvt_pk_bf16(o[0], o[1]); w.y = cvt_pk_bf16(o[2], o[3]); *(u32x2*)(HA + 16 * m) = w; }
        }
    }
#undef AT_LOADK
#undef AT_LOADV
#undef AT_WRITEK
#undef AT_WRITEV
}

constexpr int MC_Q = 0, MC_K = 33792, MC_SP = 67584, MC_SC = 76800, MC_NV = 79104;
struct McRegs { u32x4 qr[4], kr[4]; float sc4[4]; float nv0; bf16x8 cb[8][2], vbf[2][2]; u32x2 ovv[8]; };
__device__ __forceinline__ void mc_load_qk(McRegs& R, const unsigned char* ws, int u, int tid) {
    const int bh = u >> 5, c = u & 31, b = bh >> 2, h = bh & 3; const size_t tok0 = (size_t)b * SEQ + 64 * c;
    const bf16* QM = (const bf16*)(ws + WS_QM); const bf16* KM = (const bf16*)(ws + WS_KM);
#pragma unroll
    for (int i = 0; i < 4; ++i) { const int idx = tid + NTHR * i, row = idx >> 5, ch = idx & 31;
        R.qr[i] = *(const u32x4*)(QM + (tok0 + row) * 1024 + h * 256 + ch * 8); R.kr[i] = *(const u32x4*)(KM + (tok0 + row) * 1024 + h * 256 + ch * 8); }
}
__device__ __forceinline__ void mc_load_sc(McRegs& R, const unsigned char* ws, int u, int tid) {
    const int bh = u >> 5, c = u & 31; const int s = bh * 2048 + 64 * c + (tid & 63);
    R.sc4[0] = ((const float*)(ws + MS_AS))[s]; R.sc4[1] = ((const float*)(ws + MS_GT))[s]; R.sc4[2] = ((const float*)(ws + MS_WI))[s]; R.sc4[3] = ((const float*)(ws + MS_CL))[s];
    R.nv0 = ((const float*)(ws + MS_NVEC))[(size_t)(bh * 32 + c) * 256 + (tid & 255)];
}
__device__ __forceinline__ void mc_load_cb(McRegs& R, const unsigned char* ws, int u, int lane, int wave) {
    const bf16* Cp = (const bf16*)(ws + WS_CST) + (size_t)u * 65536 + (size_t)(2 * wave) * 512 + lane * 8;
#pragma unroll
    for (int ks = 0; ks < 8; ++ks) { R.cb[ks][0] = *(const bf16x8*)(Cp + ks * 8192); R.cb[ks][1] = *(const bf16x8*)(Cp + ks * 8192 + 512); }
}
__device__ __forceinline__ void mc_load_v(McRegs& R, const unsigned char* ws, int u, int lane, int wave) {
    const bf16* Vp = (const bf16*)(ws + WS_VMT) + (size_t)u * 16384 + (size_t)(2 * wave) * 512 + lane * 8;
#pragma unroll
    for (int ks = 0; ks < 2; ++ks) { R.vbf[ks][0] = *(const bf16x8*)(Vp + ks * 8192); R.vbf[ks][1] = *(const bf16x8*)(Vp + ks * 8192 + 512); }
}
__device__ __forceinline__ void mc_load_ov(McRegs& R, const unsigned char* ws, int u, int lane, int wave) {
    const int bh = u >> 5, c = u & 31, b = bh >> 2, h = bh & 3; const size_t tok0 = (size_t)b * SEQ + 64 * c;
    const bf16* OM = (const bf16*)(ws + WS_OM);
#pragma unroll
    for (int i = 0; i < 8; ++i) R.ovv[i] = *(const u32x2*)(OM + (tok0 + 8 * wave + i) * 1024 + h * 256 + 4 * lane);
}
template <bool PF, bool HAVE>
__device__ __forceinline__ void mlstm_c_body(ArgsP a, int l, LAS unsigned char* lds, int u, int un, McRegs& R, int tid_, int lane_, int wave) {
    unsigned char* ws = a->ws;
    int tid = wave * 64 + lane_id(); asm volatile("" : "+v"(tid));
    const int lane = tid & 63; (void)tid_; (void)lane_;
    const int bh = u >> 5, c = u & 31, b = bh >> 2, h = bh & 3, t0 = 64 * c, q16 = lane & 15, g = lane >> 4;
    const size_t tok0 = (size_t)b * SEQ + t0;
    LAS unsigned char* Qs = lds + MC_Q; LAS unsigned char* Ks = lds + MC_K; LAS unsigned char* Sp = lds + MC_SP;
    LAS float* sc = (LAS float*)(lds + MC_SC); LAS float* as_ = sc; LAS float* gt_ = sc + 64; LAS float* wi_ = sc + 128; LAS float* cl_ = sc + 192; LAS float* qn_ = sc + 256; LAS float* denp = sc + 320;
    LAS float* nvec = (LAS float*)(lds + MC_NV);
    mc_load_qk(R, ws, u, tid); mc_load_sc(R, ws, u, tid);
    if (!HAVE) mc_load_cb(R, ws, u, lane, wave);
#pragma unroll
    for (int i = 0; i < 4; ++i) { const int idx = tid + NTHR * i, row = idx >> 5, ch = idx & 31;
        *(LAS u32x4*)(Qs + row * 528 + ch * 16) = R.qr[i]; *(LAS u32x4*)(Ks + row * 528 + ch * 16) = R.kr[i]; }
    mc_load_v(R, ws, u, lane, wave);
    if (tid < 64) { as_[tid] = R.sc4[0]; gt_[tid] = R.sc4[1]; wi_[tid] = R.sc4[2]; cl_[tid] = R.sc4[3]; }
    if (tid < 256) nvec[tid] = R.nv0;
    __syncthreads();
    f32x4 acc[4][2];
#pragma unroll
    for (int m = 0; m < 4; ++m) { acc[m][0] = (f32x4){0.f, 0.f, 0.f, 0.f}; acc[m][1] = acc[m][0]; }
    if (c > 0) {
        bf16x8 qfA[4], qfB[4];
#define MC_QLOAD(F_, ks_) do { _Pragma("unroll") for (int m = 0; m < 4; ++m) F_[m] = *(const LAS bf16x8*)(Qs + (16 * m + q16) * 528 + (32 * (ks_) + 8 * g) * 2); } while (0)
#define MC_QMMA(F_, ks_) do { _Pragma("unroll") for (int m = 0; m < 4; ++m) { \
            acc[m][0] = __builtin_amdgcn_mfma_f32_16x16x32_bf16(F_[m], R.cb[ks_][0], acc[m][0], 0, 0, 0); acc[m][1] = __builtin_amdgcn_mfma_f32_16x16x32_bf16(F_[m], R.cb[ks_][1], acc[m][1], 0, 0, 0); } } while (0)
        MC_QLOAD(qfA, 0);
#pragma unroll
        for (int ks = 0; ks < 8; ks += 2) {
            MC_QLOAD(qfB, ks + 1); __builtin_amdgcn_sched_barrier(0); MC_QMMA(qfA, ks); __builtin_amdgcn_sched_barrier(0);
            if (ks + 2 < 8) MC_QLOAD(qfA, ks + 2);
            __builtin_amdgcn_sched_barrier(0); MC_QMMA(qfB, ks + 1); __builtin_amdgcn_sched_barrier(0);
        }
#undef MC_QLOAD
#undef MC_QMMA
#pragma unroll
        for (int m = 0; m < 4; ++m)
#pragma unroll
            for (int r = 0; r < 4; ++r) { const float w = wi_[16 * m + 4 * g + r]; acc[m][0][r] *= w; acc[m][1][r] *= w; }
    }
    {
        const int mS = wave & 3, nS0 = 2 * (wave >> 2);
        f32x4 sacc[2]; sacc[0] = (f32x4){0.f, 0.f, 0.f, 0.f}; sacc[1] = sacc[0];
#pragma unroll
        for (int kh = 0; kh < 4; ++kh) {
            bf16x8 af[2], bq[2][2];
#pragma unroll
            for (int k2 = 0; k2 < 2; ++k2) { const int ks = 2 * kh + k2;
                af[k2] = *(const LAS bf16x8*)(Qs + (16 * mS + q16) * 528 + (32 * ks + 8 * g) * 2);
#pragma unroll
                for (int nn = 0; nn < 2; ++nn) bq[k2][nn] = *(const LAS bf16x8*)(Ks + (16 * (nS0 + nn) + q16) * 528 + (32 * ks + 8 * g) * 2); }
            asm volatile("" : "+v"(af[0]), "+v"(af[1]), "+v"(bq[0][0]), "+v"(bq[0][1]), "+v"(bq[1][0]), "+v"(bq[1][1]));
#pragma unroll
            for (int k2 = 0; k2 < 2; ++k2)
#pragma unroll
                for (int nn = 0; nn < 2; ++nn) sacc[nn] = __builtin_amdgcn_mfma_f32_16x16x32_bf16(af[k2], bq[k2][nn], sacc[nn], 0, 0, 0);
        }
        float rsum[8];
#pragma unroll
        for (int nn = 0; nn < 2; ++nn) { const int s = 16 * (nS0 + nn) + q16; const float av = as_[s];
#pragma unroll
            for (int r = 0; r < 4; ++r) { const int t = 16 * mS + 4 * g + r;
                const float val = (s <= t) ? sacc[nn][r] * __expf(av - gt_[t]) : 0.f;
                *(LAS unsigned short*)(Sp + t * 144 + s * 2) = (unsigned short)(cvt_pk_bf16(val, val) & 0xffffu);
                rsum[4 * nn + r] = val; } }
        { const bool hi = (q16 & 8) != 0;
#pragma unroll
          for (int i = 0; i < 4; ++i) { const float snd = hi ? rsum[i] : rsum[i + 4], kp = hi ? rsum[i + 4] : rsum[i]; rsum[i] = kp + shx(snd, 8); } }
        { const bool hi = (q16 & 4) != 0;
#pragma unroll
          for (int i = 0; i < 2; ++i) { const float snd = hi ? rsum[i] : rsum[i + 2], kp = hi ? rsum[i + 2] : rsum[i]; rsum[i] = kp + shx(snd, 4); } }
        { const bool hi = (q16 & 2) != 0; const float snd = hi ? rsum[0] : rsum[1], kp = hi ? rsum[1] : rsum[0]; rsum[0] = kp + shx(snd, 2); }
        const float rs = rsum[0] + shx(rsum[0], 1);
        const int vi = ((q16 >> 3) & 1) * 4 + ((q16 >> 2) & 1) * 2 + ((q16 >> 1) & 1);
        if ((q16 & 1) == 0) denp[(nS0 + (vi >> 2)) * 64 + 16 * mS + 4 * g + (vi & 3)] = rs;
    }
    {
        const int t = tid >> 3, seg = tid & 7; float s = 0.f;
#pragma unroll
        for (int i = 0; i < 4; ++i) { const u32x4 v = *(const LAS u32x4*)(Qs + t * 528 + (seg * 32 + 8 * i) * 2); const LAS float* nv = nvec + seg * 32 + 8 * i;
            s += bflo(v.x) * nv[0] + bfhi(v.x) * nv[1] + bflo(v.y) * nv[2] + bfhi(v.y) * nv[3] + bflo(v.z) * nv[4] + bfhi(v.z) * nv[5] + bflo(v.w) * nv[6] + bfhi(v.w) * nv[7]; }
        s += shx(s, 1); s += shx(s, 2); s += shx(s, 4);
        if (seg == 0) qn_[t] = s;
    }
    __syncthreads();
    if (PF) {
#pragma unroll
        for (int ks = 0; ks < 8; ++ks) asm volatile("" :: "v"(R.cb[ks][0]), "v"(R.cb[ks][1]));
        __builtin_amdgcn_sched_barrier(0);
        mc_load_cb(R, ws, un, lane, wave);
        __builtin_amdgcn_sched_barrier(0);
    }
    {
#pragma unroll
        for (int ks = 0; ks < 2; ++ks) {
            bf16x8 sf[4];
#pragma unroll
            for (int m = 0; m < 4; ++m) sf[m] = *(const LAS bf16x8*)(Sp + (16 * m + q16) * 144 + (32 * ks + 8 * g) * 2);
            asm volatile("" : "+v"(sf[0]), "+v"(sf[1]), "+v"(sf[2]), "+v"(sf[3]));
#pragma unroll
            for (int m = 0; m < 4; ++m) {
                acc[m][0] = __builtin_amdgcn_mfma_f32_16x16x32_bf16(sf[m], R.vbf[ks][0], acc[m][0], 0, 0, 0);
                acc[m][1] = __builtin_amdgcn_mfma_f32_16x16x32_bf16(sf[m], R.vbf[ks][1], acc[m][1], 0, 0, 0); }
        }
    }
    LAS float* NUM = (LAS float*)lds;
    {
        LAS float* invs = (LAS float*)(lds + 80128) + wave * 64;
        const float den = (denp[lane] + denp[64 + lane]) + (denp[128 + lane] + denp[192 + lane]) + wi_[lane] * qn_[lane];
        invs[lane] = __builtin_amdgcn_rcpf(fmaxf(fabsf(den), cl_[lane]));
#pragma unroll
        for (int m = 0; m < 4; ++m) { const f32x4 iv = *(const LAS f32x4*)(invs + 16 * m + 4 * g);
#pragma unroll
            for (int r = 0; r < 4; ++r) { const int t = 16 * m + 4 * g + r;
                NUM[t * 260 + 32 * wave + q16] = acc[m][0][r] * iv[r]; NUM[t * 260 + 32 * wave + 16 + q16] = acc[m][1][r] * iv[r]; } }
    }
    __syncthreads();
    {
        const float* mg = a->in[I_MNG] + l * 1024 + h * 256 + 4 * lane; const f32x4 gn = *(const f32x4*)mg;
        bf16* HM = (bf16*)(ws + WS_HM);
        mc_load_ov(R, ws, u, lane, wave);
        asm volatile("" : "+v"(R.ovv[0]), "+v"(R.ovv[1]), "+v"(R.ovv[2]), "+v"(R.ovv[3]), "+v"(R.ovv[4]), "+v"(R.ovv[5]), "+v"(R.ovv[6]), "+v"(R.ovv[7]));
        f32x4 vv[8]; float red[8];
#pragma unroll
        for (int i = 0; i < 8; ++i) vv[i] = *(const LAS f32x4*)(NUM + (8 * wave + i) * 260 + 4 * lane);
#pragma unroll
        for (int i = 0; i < 8; ++i) red[i] = (vv[i].x + vv[i].y) + (vv[i].z + vv[i].w);
        wave_sum8(red, lane);
#pragma unroll
        for (int i = 0; i < 8; ++i) { vv[i] = vv[i] - red[i] * (1.0f / 256.0f); red[i] = (vv[i].x * vv[i].x + vv[i].y * vv[i].y) + (vv[i].z * vv[i].z + vv[i].w * vv[i].w); }
        wave_sum8(red, lane);
#pragma unroll
        for (int i = 0; i < 8; ++i) { const int t = 8 * wave + i; const f32x4 d = vv[i];
            const float rstd = __builtin_amdgcn_rsqf(red[i] * (1.0f / 256.0f) + LN_EPS);
            const u32x2 ov = R.ovv[i];
            u32x2 w; w.x = cvt_pk_bf16(d.x * rstd * gn.x * bflo(ov.x), d.y * rstd * gn.y * bfhi(ov.x)); w.y = cvt_pk_bf16(d.z * rstd * gn.z * bflo(ov.y), d.w * rstd * gn.w * bfhi(ov.y));
            *(u32x2*)(HM + (tok0 + t) * 1024 + h * 256 + 4 * lane) = w; }
    }
    __syncthreads();
}
__device__ __forceinline__ void mlstm_c_phase(ArgsP a, int l, LAS unsigned char* lds, int tid, int lane, int wave, int bid, int G) {
    int u = bid; if (u >= 512) return;
    McRegs R;
    if (u + G < 512 && u + 2 * G >= 512) {
        mlstm_c_body<true, false>(a, l, lds, u, u + G, R, tid, lane, wave);
        mlstm_c_body<false, true>(a, l, lds, u + G, u + G, R, tid, lane, wave);
    } else {
#pragma unroll 1
        for (; u < 512; u += G) mlstm_c_body<false, false>(a, l, lds, u, u, R, tid, lane, wave);
    }
}

struct SchedStd {
    static constexpr bool GATHER = false; static constexpr bool FP8 = false;
    const char* A; const char* B; int nM, nN, K, G, c;
    __device__ __forceinline__ bool next(int i, Unit& u) const { const int L = i * G + c; if (L >= nM * nN) return false; pg8::static_tile(L, nM, nN, u.pm, u.pn, WGM_OUT); u.aux = 0; return true; }
    __device__ __forceinline__ const char* abase(const Unit& u) const { return A + (size_t)u.pm * 512 * K; }
    __device__ __forceinline__ const char* bbase(const Unit& u) const { return B + (size_t)u.pn * 512 * K; }
    __device__ __forceinline__ unsigned arow(const Unit&, int) const { return 0u; }
    static __device__ __forceinline__ bool keep_acc(const Unit&) { return false; }
};
struct SchedBr {
    static constexpr bool GATHER = false; static constexpr bool FP8 = false;
    const char* HM; const char* HA; const char* WM; const char* WA; int G, c;
    __device__ __forceinline__ bool next(int i, Unit& u) const { const int L = (i >> 1) * G + c; if (L >= 256) return false; pg8::static_tile(L, 32, 8, u.pm, u.pn, WGM_BR); u.aux = i & 1; return true; }
    __device__ __forceinline__ const char* abase(const Unit& u) const { return (u.aux ? HA : HM) + (size_t)u.pm * 512 * 1024; }
    __device__ __forceinline__ const char* bbase(const Unit& u) const { return (u.aux ? WA : WM) + (size_t)u.pn * 512 * 1024; }
    __device__ __forceinline__ unsigned arow(const Unit&, int) const { return 0u; }
    static __device__ __forceinline__ bool keep_acc(const Unit& u) { return u.aux == 0; }
};
struct EpiBr {
    static constexpr bool PERM = true;
    const bf16* SG; bf16* Y;
    __device__ __forceinline__ void operator()(f32x4 (&acc)[2][2][4][2], const Unit& u, int wr, int wc, int fr, int fq) const {
        const int row0 = u.pm * 256 + wr * 64 + fr, col0 = u.pn * 256 + wc * 32 + 8 * fq;
#pragma unroll
        for (int ai = 0; ai < 2; ++ai) {
            u32x4 sa[4][2], sm[4][2];
#pragma unroll
            for (int m = 0; m < 4; ++m) { const size_t row = row0 + ai * 128 + m * 16;
#pragma unroll
                for (int bj = 0; bj < 2; ++bj) { const int col = col0 + bj * 128;
                    sa[m][bj] = *(const u32x4*)(SG + row * 4096 + 2048 + col);
                    sm[m][bj] = *(const u32x4*)(SG + row * 4096 + (u.aux == 0 ? 0 : 2048) + col); } }
            asm volatile("" : "+v"(sa[0][0]), "+v"(sa[0][1]), "+v"(sa[1][0]), "+v"(sa[1][1]), "+v"(sa[2][0]), "+v"(sa[2][1]), "+v"(sa[3][0]), "+v"(sa[3][1]),
                              "+v"(sm[0][0]), "+v"(sm[0][1]), "+v"(sm[1][0]), "+v"(sm[1][1]), "+v"(sm[2][0]), "+v"(sm[2][1]), "+v"(sm[3][0]), "+v"(sm[3][1]));
#pragma unroll
            for (int m = 0; m < 4; ++m) { const size_t row = row0 + ai * 128 + m * 16;
#pragma unroll
                for (int bj = 0; bj < 2; ++bj) { const int col = col0 + bj * 128;
                    const u32x4 a4 = sa[m][bj], m4 = sm[m][bj];
                    const float ga[8] = {bflo(a4.x), bfhi(a4.x), bflo(a4.y), bfhi(a4.y), bflo(a4.z), bfhi(a4.z), bflo(a4.w), bfhi(a4.w)};
                    if (u.aux == 0) {
                        const float gm[8] = {bflo(m4.x), bfhi(m4.x), bflo(m4.y), bfhi(m4.y), bflo(m4.z), bfhi(m4.z), bflo(m4.w), bfhi(m4.w)};
#pragma unroll
                        for (int j = 0; j < 4; ++j) { acc[ai][bj][m][0][j] *= gm[j] * __builtin_amdgcn_rcpf(fmaxf(ga[j], 1.0e-30f)); acc[ai][bj][m][1][j] *= gm[4 + j] * __builtin_amdgcn_rcpf(fmaxf(ga[4 + j], 1.0e-30f)); }
                    } else {
                        const f32x4 v0 = acc[ai][bj][m][0], v1 = acc[ai][bj][m][1];
                        u32x4 w; w.x = cvt_pk_bf16(v0[0] * ga[0], v0[1] * ga[1]); w.y = cvt_pk_bf16(v0[2] * ga[2], v0[3] * ga[3]);
                        w.z = cvt_pk_bf16(v1[0] * ga[4], v1[1] * ga[5]); w.w = cvt_pk_bf16(v1[2] * ga[6], v1[3] * ga[7]);
                        *(u32x4*)(Y + row * 2048 + col) = w; }
                } }
        }
    }
};
struct EpiOut {
    static constexpr bool PERM = false;
    const float* res; float* out;
    __device__ __forceinline__ void operator()(f32x4 (&acc)[2][2][4][2], const Unit& u, int wr, int wc, int fr, int fq) const {
        const int row0 = u.pm * 256 + wr * 64 + fr, col0 = u.pn * 256 + wc * 32 + 4 * fq;
#pragma unroll
        for (int ai = 0; ai < 2; ++ai) {
            f32x4 rv[4][2][2];
#pragma unroll
            for (int m = 0; m < 4; ++m) { const size_t ro = (size_t)(row0 + ai * 128 + m * 16) * DM + col0;
#pragma unroll
                for (int bj = 0; bj < 2; ++bj)
#pragma unroll
                    for (int n = 0; n < 2; ++n) rv[m][bj][n] = *(const f32x4*)(res + ro + bj * 128 + n * 16); }
#pragma unroll
            for (int m = 0; m < 4; ++m) asm volatile("" : "+v"(rv[m][0][0]), "+v"(rv[m][0][1]), "+v"(rv[m][1][0]), "+v"(rv[m][1][1]));
#pragma unroll
            for (int m = 0; m < 4; ++m) { const size_t ro = (size_t)(row0 + ai * 128 + m * 16) * DM + col0;
#pragma unroll
                for (int bj = 0; bj < 2; ++bj)
#pragma unroll
                    for (int n = 0; n < 2; ++n) *(f32x4*)(out + ro + bj * 128 + n * 16) = rv[m][bj][n] + acc[ai][bj][m][n]; }
        }
    }
};
struct SchedMoe1 {
    static constexpr bool GATHER = true; static constexpr bool FP8 = false;
    const char* H; const char* W13; const int* LIST; const LAS int* te; const LAS int* tr0; const LAS int* cnt; int MT, G, c;
    __device__ __forceinline__ bool next(int i, Unit& u) const { const int L = i * G + c; if (L >= 2 * MT) return false; u.pm = L >> 1; u.pn = L & 1; u.aux = __builtin_amdgcn_readfirstlane(te[u.pm]); return true; }
    __device__ __forceinline__ const char* abase(const Unit&) const { return H; }
    __device__ __forceinline__ const char* bbase(const Unit& u) const { return W13 + ((size_t)u.aux * 512 + u.pn * 256) * 4096; }
    static __device__ __forceinline__ bool keep_acc(const Unit&) { return false; }
    __device__ __forceinline__ unsigned arow(const Unit& u, int r) const { const int rr = __builtin_amdgcn_readfirstlane(tr0[u.pm]) + r; return rr < __builtin_amdgcn_readfirstlane(cnt[u.aux]) ? (unsigned)LIST[u.aux * 8192 + rr] : 0u; }
};
struct EpiMoe1 {
    static constexpr bool PERM = true;
    bf16* HID; const float* PWL; const LAS int* tr0; const LAS int* cnt;
    __device__ __forceinline__ void operator()(f32x4 (&acc)[2][2][4][2], const Unit& u, int wr, int wc, int fr, int fq) const {
#pragma unroll
        for (int ai = 0; ai < 2; ++ai)
#pragma unroll
            for (int m = 0; m < 4; ++m) { const int r = ai * 128 + wr * 64 + m * 16 + fr;
                const float pw = 1.0f;
                float o[8];
#pragma unroll
                for (int n = 0; n < 2; ++n)
#pragma unroll
                    for (int j = 0; j < 4; ++j) { const float x1 = acc[ai][0][m][n][j], x3 = acc[ai][1][m][n][j]; o[4 * n + j] = x1 * sigmoidf_(x1) * x3 * pw; }
                u32x4 w; w.x = cvt_pk_bf16(o[0], o[1]); w.y = cvt_pk_bf16(o[2], o[3]); w.z = cvt_pk_bf16(o[4], o[5]); w.w = cvt_pk_bf16(o[6], o[7]);
                *(u32x4*)(HID + (size_t)(u.pm * 256 + r) * 256 + u.pn * 128 + wc * 32 + 8 * fq) = w; }
    }
};
struct SchedMoe2 {
    static constexpr bool GATHER = false; static constexpr bool FP8 = false;
    const char* HID; const char* W2; const LAS int* te; int MT, G, c;
    __device__ __forceinline__ bool next(int i, Unit& u) const { const int L = i * G + c; if (L >= 8 * MT) return false; u.pm = L >> 3; u.pn = L & 7; u.aux = __builtin_amdgcn_readfirstlane(te[u.pm]); return true; }
    __device__ __forceinline__ const char* abase(const Unit& u) const { return HID + (size_t)u.pm * 256 * 512; }
    __device__ __forceinline__ const char* bbase(const Unit& u) const { return W2 + ((size_t)u.aux * 2048 + u.pn * 256) * 512; }
    __device__ __forceinline__ unsigned arow(const Unit&, int) const { return 0u; }
    static __device__ __forceinline__ bool keep_acc(const Unit&) { return false; }
};
struct EpiMoe2 {
    static constexpr bool PERM = true;
    bf16* OP; const LAS int* tr0; const LAS int* cnt;
    __device__ __forceinline__ void operator()(f32x4 (&acc)[2][2][4][2], const Unit& u, int wr, int wc, int fr, int fq) const {
        const int row0 = u.pm * 256 + wr * 64 + fr, col0 = u.pn * 256 + wc * 32 + 8 * fq;
        const int valid = __builtin_amdgcn_readfirstlane(cnt[u.aux]) - __builtin_amdgcn_readfirstlane(tr0[u.pm]);
#pragma unroll
        for (int ai = 0; ai < 2; ++ai)
#pragma unroll
            for (int m = 0; m < 4; ++m) { bf16* rowp = OP + (size_t)(row0 + ai * 128 + m * 16) * DM + col0;
                if (wr * 64 + fr + ai * 128 + m * 16 >= valid) continue;
#pragma unroll
                for (int bj = 0; bj < 2; ++bj) { const f32x4 v0 = acc[ai][bj][m][0], v1 = acc[ai][bj][m][1];
                    u32x4 w; w.x = cvt_pk_bf16(v0[0], v0[1]); w.y = cvt_pk_bf16(v0[2], v0[3]); w.z = cvt_pk_bf16(v1[0], v1[1]); w.w = cvt_pk_bf16(v1[2], v1[3]);
                    *(u32x4*)(rowp + bj * 128) = w; } }
    }
};

constexpr int N_PHASES = 22;
__global__ void __launch_bounds__(NTHR, 2) fwd_kernel(Args a) {
    extern __shared__ __attribute__((aligned(16))) unsigned char lds_raw[];
    LAS unsigned char* lds0 = (LAS unsigned char*)lds_raw;
    const int tid0 = threadIdx.x, bid0 = blockIdx.x, G0 = gridDim.x;
    const int wave0 = __builtin_amdgcn_readfirstlane(tid0 >> 6);
#define PH_IDS() ArgsP ap = (ArgsP)__builtin_amdgcn_kernarg_segment_ptr(); asm volatile("" : "+s"(ap)); unsigned lb_ = 0u; asm volatile("" : "+s"(lb_)); LAS unsigned char* lds = lds0 + lb_; LAS unsigned char* misc = lds + MISC_OFF; (void)misc; unsigned char* ws = ap->ws; (void)ws; int bid = bid0, G = G0, wave = wave0; asm volatile("" : "+s"(bid), "+s"(G), "+s"(wave)); int tid = wave * 64 + lane_id(); asm volatile("" : "+v"(tid)); const int lane = tid & 63; (void)lane; (void)wave
    if (tid0 < 4) ((LAS unsigned*)(lds0 + MISC_OFF + MO_BAR))[tid0] = 0u;
    __syncthreads();
#if MK_LAUNCHES == 1
    XcdBarrier bar = xcd_barrier_post((unsigned*)(a.ws + WS_CTL) + CW_BAR, (volatile LAS unsigned*)(lds0 + MISC_OFF + MO_BAR));
#define GRID_BAR() xcd_barrier(bar)
#else
#define GRID_BAR() do { } while (0)
#endif
    const int lo = a.ph_lo, hi = a.ph_hi;
#ifndef PHMASK
#define PHMASK 0xFFFu
#endif
#define IN(k) (lo <= (k) && (k) < hi)
#define EN(b) ((PHMASK >> (b)) & 1u)
#ifndef DBLMASK
#define DBLMASK 0u
#endif
#define REP(b) _Pragma("unroll 1") for (int rep_ = 0; rep_ < (((DBLMASK >> (b)) & 1u) ? 2 : 1); ++rep_)
#define SEAM(k) do { if (IN(k) && IN((k) + 1)) { GRID_BAR(); if ((DBLMASK >> 12) & 1u) GRID_BAR(); } } while (0)

    if (EN(0) && IN(0)) { REP(0) { PH_IDS(); prologue_phase(ap, lds, tid, lane, wave, bid, G); __syncthreads(); }
#ifndef NO_NORM0
        { PH_IDS(); norm_phase<0>(ap, 0, lds, tid, lane, wave, bid, G); }
#endif
    }
    SEAM(0);
#pragma unroll 1
    for (int l = 0; l < 2; ++l) {
        const int pb = 1 + 10 * l;
        if (EN(1) && IN(pb + 0) && l == 1) { if ((DBLMASK >> 18) & 1u) { PH_IDS(); norm_phase<1>(ap, l, lds, tid, lane, wave, bid, G, true); } PH_IDS(); norm_phase<1>(ap, l, lds, tid, lane, wave, bid, G); }
        if (l == 1) SEAM(pb + 0);
        if (EN(2) && IN(pb + 1)) REP(2) { PH_IDS(); (void)tid;
#ifdef STAG
            for (int i = 0; i < ((bid >> 3) & 7); ++i) __builtin_amdgcn_s_sleep(STAG);
#endif
            SchedG1 S{(const char*)(ws + WS_H), (const char*)(ws + WS_WINT) + (size_t)l * 11264 * 2048, G, bid};
            EpiG1 E{ws, ((DBLMASK >> 21) & 1u) && rep_ == 1};
            pg8::gemm_phase<EpiG1, SchedG1>(lds, 1024, S, E, wave);
            { PH_IDS(); (void)lane; (void)misc; (void)ws;
            for (int bh = G - 1 - bid; bh < 16; bh += G) gate_unit(ap, l, lds, bh, tid, tid & 63, wave);
            __syncthreads();
            if (G == 256 && bid >= 256 - SchedG1::NCV) prologue_phase(ap, lds, tid, tid & 63, wave, bid - (256 - SchedG1::NCV), SchedG1::NCV, 2 + l);
            else if (G != 256) prologue_phase(ap, lds, tid, tid & 63, wave, bid, G, 2 + l); }
        }
        SEAM(pb + 1);
        if (EN(3) && IN(pb + 2)) REP(3) { PH_IDS(); conv_phase(ap, l, lds, tid, lane, wave, bid, G); }
        SEAM(pb + 2);
        if (EN(4) && IN(pb + 3)) REP(4) { PH_IDS();
            const int vb = (G % 8 == 0) ? (bid & 7) * (G >> 3) + (bid >> 3) : bid;
            REP(13) { if (wave < 4) for (int gw = vb * 4 + wave; gw < 1024; gw += G * 4) mlstm_ab_task(ws, gw, lane, rep_ == 0 || !((DBLMASK >> 15) & 1u)); }
            if (wave == 4) for (int t = vb; t < 64; t += G) nscan_task(ws, t, lane);
            if (wave >= 4) prologue_phase(ap, lds, tid, lane, wave, bid, G, l == 0 ? 6 : 7, bid * 4 + (wave - 4), G * 4);
            __syncthreads();
            REP(14) { for (int u = vb; u < 512; u += G) { attn_unit(ap, lds, u, tid, lane, wave); __syncthreads(); if (((DBLMASK >> 16) & 1u) && u < 256) GRID_BAR(); } }
        }
        SEAM(pb + 3);
        if (EN(5) && IN(pb + 4)) REP(5) { PH_IDS(); mlstm_c_phase(ap, l, lds, tid, lane, wave, bid, G); }
        SEAM(pb + 4);
        if (EN(6) && IN(pb + 5)) REP(6) { PH_IDS(); (void)tid;
            SchedBr S{(const char*)(ws + WS_HM), (const char*)(ws + WS_HA), (const char*)(ws + WS_WBM) + (size_t)l * 2048 * 2048, (const char*)(ws + WS_WBA) + (size_t)l * 2048 * 2048, G, bid};
            EpiBr E{(const bf16*)(ws + WS_SG), (bf16*)(ws + WS_Y)};
            pg8::gemm_phase<EpiBr, SchedBr>(lds, 1024, S, E, wave);
        }
        SEAM(pb + 5);
        if (EN(7) && IN(pb + 6)) _Pragma("unroll 1") for (int rep_ = 0; rep_ < ((((DBLMASK >> 7) & 1u) && l == 0) ? 2 : 1); ++rep_) { PH_IDS(); (void)tid;
            SchedStd S{(const char*)(ws + WS_Y), (const char*)(ws + WS_WOUT) + (size_t)l * 2048 * 4096, 32, 8, 2048, G, bid};
            EpiOut E{l == 0 ? ap->in[I_X] : (const float*)ap->out, ap->out};
            pg8::gemm_phase<EpiOut, SchedStd>(lds, 2048, S, E, wave);
        }
        SEAM(pb + 6);
        if (EN(8) && IN(pb + 7)) { if ((DBLMASK >> 19) & 1u) { PH_IDS(); norm_phase<2>(ap, l, lds, tid, lane, wave, bid, G, true); } PH_IDS(); norm_phase<2>(ap, l, lds, tid, lane, wave, bid, G); }
        SEAM(pb + 7);
        if (EN(9) && IN(pb + 8)) REP(9) { PH_IDS();
            moe_tables(ws, l, misc, tid);
            SchedMoe1 S{(const char*)(ws + WS_H), (const char*)(ws + WS_W13) + (size_t)l * 32 * 512 * 4096, (const int*)(ws + MS_LIST),
                        (const LAS int*)(misc + MO_TE), (const LAS int*)(misc + MO_TR0), (const LAS int*)(misc + MO_CNT), __builtin_amdgcn_readfirstlane(((const LAS int*)(misc + MO_MT))[0]), G, bid};
            EpiMoe1 E{(bf16*)(ws + WS_HID), (const float*)(ws + MS_PWL), (const LAS int*)(misc + MO_TR0), (const LAS int*)(misc + MO_CNT)};
            pg8::gemm_phase<EpiMoe1, SchedMoe1>(lds, 2048, S, E, wave);
            if (bid >= 2 * S.MT) prologue_phase(ap, lds, tid, tid & 63, wave, bid - 2 * S.MT, G - 2 * S.MT, l == 0 ? 1 : 4);
        }
        SEAM(pb + 8);
        if (EN(10) && IN(pb + 9)) REP(10) { PH_IDS();
            moe_tables(ws, l, misc, tid);
#ifdef STAG
            for (int i = 0; i < ((bid >> 3) & 7); ++i) __builtin_amdgcn_s_sleep(STAG);
#endif
            SchedMoe2 S{(const char*)(ws + WS_HID), (const char*)(ws + WS_W2) + (size_t)l * 32 * 2048 * 512, (const LAS int*)(misc + MO_TE), __builtin_amdgcn_readfirstlane(((const LAS int*)(misc + MO_MT))[0]), G, bid};
            EpiMoe2 E{(bf16*)(ws + WS_OP), (const LAS int*)(misc + MO_TR0), (const LAS int*)(misc + MO_CNT)};
            pg8::gemm_phase<EpiMoe2, SchedMoe2>(lds, 256, S, E, wave);
        }
        SEAM(pb + 9);
    }
    if (EN(11) && IN(21)) { if ((DBLMASK >> 20) & 1u) { PH_IDS(); norm_phase<3>(ap, 1, lds, tid, lane, wave, bid, G, true); } PH_IDS(); norm_phase<3>(ap, 1, lds, tid, lane, wave, bid, G); }
#undef IN
#undef SEAM
}

extern "C" void kernel_launch(void* const* d_in, const int* in_sizes, int n_in, void* d_out, int out_size, void* d_ws, size_t ws_size, hipStream_t stream) {
    static int grid = 0;
    if (grid == 0) {
        if (n_in != 19 || out_size != NTOK * DM || ws_size < WS_END) { fprintf(stderr, "kernel_launch: unexpected shapes (n_in %d out %d ws %zu)\n", n_in, out_size, ws_size); grid = -1; return; }
        int dev = 0, cus = 0, per_cu = 0;
        if (hipGetDevice(&dev) != hipSuccess || hipDeviceGetAttribute(&cus, hipDeviceAttributeMultiprocessorCount, dev) != hipSuccess) { grid = -1; return; }
        if (hipFuncSetAttribute((const void*)fwd_kernel, hipFuncAttributeMaxDynamicSharedMemorySize, LDS_BYTES) != hipSuccess) { fprintf(stderr, "kernel_launch: hipFuncSetAttribute failed\n"); grid = -1; return; }
        if (hipOccupancyMaxActiveBlocksPerMultiprocessor(&per_cu, (const void*)fwd_kernel, NTHR, LDS_BYTES) != hipSuccess || per_cu < 1) { fprintf(stderr, "kernel_launch: occupancy query says %d\n", per_cu); }
        (void)hipGetLastError();
        grid = cus;
        if (grid > 256) grid = 256;
    }
    if (grid < 0) return;
    if (hipMemsetAsync((char*)d_ws + WS_CTL, 0, CTL_ZERO_BYTES, stream) != hipSuccess) return;
    Args a{};
    for (int i = 0; i < 19; ++i) a.in[i] = (const float*)d_in[i];
    a.out = (float*)d_out; a.ws = (unsigned char*)d_ws;
#if MK_LAUNCHES == 1
    a.ph_lo = 0; a.ph_hi = N_PHASES;
    hipLaunchKernelGGL(fwd_kernel, dim3(grid), dim3(NTHR), LDS_BYTES, stream, a);
#else
    for (int p = 0; p < N_PHASES; ++p) { a.ph_lo = p; a.ph_hi = p + 1; hipLaunchKernelGGL(fwd_kernel, dim3(grid), dim3(NTHR), LDS_BYTES, stream, a); }
#endif
}
```
